# Optimizing an MI355X kernel written in HIP

```python
import jax, jax.numpy as jnp
from jax import lax
import numpy as np

D_MODEL = 1024
BATCH = 2
SEQ = 8192
DEPTH = 2

HEAD_DIM = 64
ROPE_THETA = 10000.0
NORM_EPS = 1e-6

NSA_HEADS = 6
NSA_KV_HEADS = 2
NSA_GROUP = NSA_HEADS // NSA_KV_HEADS
NSA_WIDTH = NSA_HEADS * HEAD_DIM
NSA_KV_WIDTH = NSA_KV_HEADS * HEAD_DIM
CMP_BLOCK = 32
CMP_STRIDE = 16
SLC_BLOCK = 64
SLC_TOPN = 16
WINDOW = 512
NSA_Q_BLOCK = 128
FORCE_SCORE = 1e6

MOBA_HEADS = 4
MOBA_WIDTH = MOBA_HEADS * HEAD_DIM
MOBA_BLOCK = 256
MOBA_TOPK = 3
MOBA_Q_BLOCK = 64

RWKV_WIDTH = D_MODEL - NSA_WIDTH - MOBA_WIDTH
RWKV_HEADS = RWKV_WIDTH // HEAD_DIM
DECAY_LORA = 64
AAA_LORA = 64
GATE_LORA = 128
RWKV_SHIFT_COLS = 3 * RWKV_WIDTH + DECAY_LORA + AAA_LORA + GATE_LORA
DECAY_SCALE = 0.606531
GN_EPS = 64e-5

MIX_WIDTH = NSA_WIDTH + MOBA_WIDTH + RWKV_WIDTH
IN_SPLITS = (NSA_WIDTH,) + (NSA_KV_WIDTH,) * 6 + (NSA_HEADS * 3,) + (MOBA_WIDTH,) * 3 + (RWKV_SHIFT_COLS,)
IN_COLS = sum(IN_SPLITS)

N_EXPERTS = 16
N_EXPERT_GROUPS = 4
EXPERTS_PER_GROUP = N_EXPERTS // N_EXPERT_GROUPS
TOP_K = 2
EXPERT_FF = 256

kernel_name = 'hybrid_nsa_moba_rwkv7_groupmoe'


def split_cols(t, sizes):
    offs, acc = [], 0
    for s in sizes[:-1]:
        acc += s
        offs.append(acc)
    return jnp.split(t, offs, axis=-1)


def rms_norm(x, gain):
    xf = x.astype(jnp.float32)
    y = xf * lax.rsqrt(jnp.mean(xf * xf, axis=-1, keepdims=True) + NORM_EPS)
    return (y * gain.astype(jnp.float32)).astype(x.dtype)


def rope_tables(positions):
    inv = ROPE_THETA ** (-jnp.arange(0, HEAD_DIM, 2, dtype=jnp.float32) / HEAD_DIM)
    ang = positions.astype(jnp.float32)[..., None] * inv
    return jnp.cos(ang), jnp.sin(ang)


def apply_rope(x, cos, sin):
    x1, x2 = jnp.split(x, 2, axis=-1)
    c = cos[:, :, None, :].astype(x.dtype)
    s = sin[:, :, None, :].astype(x.dtype)
    return jnp.concatenate([x1 * c - x2 * s, x2 * c + x1 * s], axis=-1)


def masked_softmax(s, mask):
    s = jnp.where(mask, s.astype(jnp.float32), -jnp.inf)
    m = jnp.max(s, axis=-1, keepdims=True)
    e = jnp.where(mask, jnp.exp(s - jnp.where(jnp.isfinite(m), m, 0.0)), 0.0)
    return e / jnp.maximum(jnp.sum(e, axis=-1, keepdims=True), 1e-30)


def gather_blocks(blocks, idx):
    return jax.vmap(jax.vmap(lambda bl, ix: bl[ix]))(blocks, idx)


def nsa_compress(t, w1, w2, pos):
    S = t.shape[1]
    n_cmp = (S - CMP_BLOCK) // CMP_STRIDE + 1
    idx = jnp.arange(n_cmp)[:, None] * CMP_STRIDE + jnp.arange(CMP_BLOCK)[None, :]
    blk = t[:, idx] + pos[None, None, :, None, :]
    h = jax.nn.gelu(jnp.einsum('bnlhd,lde->bnhe', blk, w1))
    return jnp.einsum('bnhe,ef->bnhf', h, w2)


def nsa_mixer(q, kc, vc, ks, vs, kw, vw, gates, cos, sin, phi_w1, phi_w2, phi_pos):
    B, S = q.shape[:2]
    KV, G, QB = NSA_KV_HEADS, NSA_GROUP, NSA_Q_BLOCK
    scale = HEAD_DIM ** -0.5
    n_cmp = (S - CMP_BLOCK) // CMP_STRIDE + 1
    n_slc = S // SLC_BLOCK
    n_top = min(SLC_TOPN, n_slc)
    cmp_end = jnp.arange(n_cmp) * CMP_STRIDE + CMP_BLOCK - 1
    k_cmp = apply_rope(nsa_compress(kc, phi_w1[0], phi_w2[0], phi_pos[0]), cos[:, cmp_end], sin[:, cmp_end])
    v_cmp = nsa_compress(vc, phi_w1[1], phi_w2[1], phi_pos[1])
    c_start = jnp.arange(n_cmp) * CMP_STRIDE
    s_start = jnp.arange(n_slc) * SLC_BLOCK
    overlap = (jnp.minimum(c_start[:, None] + CMP_BLOCK, s_start[None, :] + SLC_BLOCK)
               - jnp.maximum(c_start[:, None], s_start[None, :]))
    cmp_to_slc = jnp.clip(overlap, 0, None).astype(jnp.float32) / CMP_BLOCK
    ks_blk = ks.reshape(B, n_slc, SLC_BLOCK, KV, HEAD_DIM).transpose(0, 3, 1, 2, 4)
    vs_blk = vs.reshape(B, n_slc, SLC_BLOCK, KV, HEAD_DIM).transpose(0, 3, 1, 2, 4)
    kw_pad = jnp.pad(kw, ((0, 0), (WINDOW, 0), (0, 0), (0, 0)))
    vw_pad = jnp.pad(vw, ((0, 0), (WINDOW, 0), (0, 0), (0, 0)))
    blk_id = jnp.arange(n_slc)

    def chunk(ci):
        s0 = ci * QB
        t = s0 + jnp.arange(QB)
        qb = lax.dynamic_slice_in_dim(q, s0, QB, axis=1).reshape(B, QB, KV, G, HEAD_DIM)
        gb = jax.nn.sigmoid(lax.dynamic_slice_in_dim(gates, s0, QB, axis=1)).reshape(B, QB, KV, G, 3)
        s_c = jnp.einsum('bqhgd,bnhd->bhgqn', qb, k_cmp) * scale
        p_c = masked_softmax(s_c, cmp_end[None, :] <= t[:, None])
        o_c = jnp.einsum('bhgqn,bnhd->bqhgd', p_c.astype(v_cmp.dtype), v_cmp)
        imp = jnp.einsum('bhgqn,ns->bhqs', p_c, cmp_to_slc)
        cur = t // SLC_BLOCK
        cand = blk_id[None, :] <= cur[:, None]
        forced = (blk_id[None, :] == 0) | (blk_id[None, :] == cur[:, None]) | (blk_id[None, :] == cur[:, None] - 1)
        score = jnp.where(cand, jnp.where(forced, FORCE_SCORE, imp), -1.0)
        _, idx = lax.top_k(score, n_top)
        k_sel = gather_blocks(ks_blk, idx)
        v_sel = gather_blocks(vs_blk, idx)
        kpos = idx[..., None] * SLC_BLOCK + jnp.arange(SLC_BLOCK)
        m_s = (idx <= cur[:, None])[..., None] & (kpos <= t[:, None, None])
        n_keys = n_top * SLC_BLOCK
        s_s = jnp.einsum('bqhgd,bhqnkd->bhgqnk', qb, k_sel) * scale
        p_s = masked_softmax(s_s.reshape(B, KV, G, QB, n_keys), m_s.reshape(B, KV, 1, QB, n_keys))
        o_s = jnp.einsum('bhgqm,bhqmd->bqhgd', p_s.astype(vs.dtype), v_sel.reshape(B, KV, QB, n_keys, HEAD_DIM))
        kwb = lax.dynamic_slice_in_dim(kw_pad, s0, QB + WINDOW, axis=1)
        vwb = lax.dynamic_slice_in_dim(vw_pad, s0, QB + WINDOW, axis=1)
        kpos_w = s0 - WINDOW + jnp.arange(QB + WINDOW)
        dist = t[:, None] - kpos_w[None, :]
        m_w = (kpos_w[None, :] >= 0) & (dist >= 0) & (dist < WINDOW)
        s_w = jnp.einsum('bqhgd,bkhd->bhgqk', qb, kwb) * scale
        p_w = masked_softmax(s_w, m_w)
        o_w = jnp.einsum('bhgqk,bkhd->bqhgd', p_w.astype(vw.dtype), vwb)
        o = gb[..., 0:1] * o_c + gb[..., 1:2] * o_s + gb[..., 2:3] * o_w
        return o.reshape(B, QB, NSA_WIDTH)

    out = lax.map(chunk, jnp.arange(S // QB))
    return jnp.moveaxis(out, 0, 1).reshape(B, S, NSA_WIDTH)


def moba_mixer(q, k, v):
    B, S = q.shape[:2]
    H, QB = MOBA_HEADS, MOBA_Q_BLOCK
    scale = HEAD_DIM ** -0.5
    nb = -(-S // MOBA_BLOCK)
    pad = nb * MOBA_BLOCK - S
    kp = jnp.pad(k, ((0, 0), (0, pad), (0, 0), (0, 0)))
    vp = jnp.pad(v, ((0, 0), (0, pad), (0, 0), (0, 0)))
    k_blk = kp.reshape(B, nb, MOBA_BLOCK, H, HEAD_DIM).transpose(0, 3, 1, 2, 4)
    v_blk = vp.reshape(B, nb, MOBA_BLOCK, H, HEAD_DIM).transpose(0, 3, 1, 2, 4)
    k_mean = jnp.mean(k_blk.astype(jnp.float32), axis=3).astype(k.dtype)
    n_top = min(MOBA_TOPK, nb)
    n_sel = n_top * MOBA_BLOCK
    blk_id = jnp.arange(nb)

    def chunk(ci):
        s0 = ci * QB
        t = s0 + jnp.arange(QB)
        own = s0 // MOBA_BLOCK
        qb = lax.dynamic_slice_in_dim(q, s0, QB, axis=1)
        gate = jnp.einsum('bqhd,bhnd->bhqn', qb, k_mean).astype(jnp.float32)
        gate = jnp.where(blk_id < own, gate, -jnp.inf)
        _, idx = lax.top_k(gate, n_top)
        valid = idx < own
        k_sel = gather_blocks(k_blk, idx)
        v_sel = gather_blocks(v_blk, idx)
        s_sel = jnp.einsum('bqhd,bhqnkd->bhqnk', qb, k_sel).reshape(B, H, QB, n_sel)
        m_sel = jnp.broadcast_to(valid[..., None], (B, H, QB, n_top, MOBA_BLOCK)).reshape(B, H, QB, n_sel)
        k_own = lax.dynamic_slice_in_dim(kp, own * MOBA_BLOCK, MOBA_BLOCK, axis=1)
        v_own = lax.dynamic_slice_in_dim(vp, own * MOBA_BLOCK, MOBA_BLOCK, axis=1)
        s_own = jnp.einsum('bqhd,bkhd->bhqk', qb, k_own)
        m_own = jnp.broadcast_to((own * MOBA_BLOCK + jnp.arange(MOBA_BLOCK))[None, :] <= t[:, None], (B, H, QB, MOBA_BLOCK))
        p = masked_softmax(jnp.concatenate([s_sel, s_own], axis=-1) * scale,
                           jnp.concatenate([m_sel, m_own], axis=-1)).astype(v.dtype)
        o = (jnp.einsum('bhqm,bhqmd->bqhd', p[..., :n_sel], v_sel.reshape(B, H, QB, n_sel, HEAD_DIM))
             + jnp.einsum('bhqk,bkhd->bqhd', p[..., n_sel:], v_own))
        return o.reshape(B, QB, MOBA_WIDTH)

    out = lax.map(chunk, jnp.arange(S // QB))
    return jnp.moveaxis(out, 0, 1).reshape(B, S, MOBA_WIDTH)


def _rwkv7_step(state, inp):
    r_t, w_t, k_t, v_t, kk_t, a_t = inp
    sa = jnp.einsum('bhvk,bhk->bhv', state, -kk_t)
    state = (state * w_t[:, :, None, :] + sa[..., None] * (kk_t * a_t)[:, :, None, :]
             + v_t[..., None] * k_t[:, :, None, :])
    return state, jnp.einsum('bhvk,bhk->bhv', state, r_t)


def rwkv7_mixer(feat, mu, w_up, w0, a_up, a0, g_up, k_k, k_a, r_k, ln_w, ln_b):
    B, S, _ = feat.shape
    H, N = RWKV_HEADS, HEAD_DIM
    prev = jnp.pad(feat, ((0, 0), (1, 0), (0, 0)))[:, :-1]
    feat = feat + (prev - feat) * mu
    r, k, v, wd, ad, gd = split_cols(feat, (RWKV_WIDTH,) * 3 + (DECAY_LORA, AAA_LORA, GATE_LORA))
    decay = jnp.exp(-DECAY_SCALE * jax.nn.sigmoid((w0 + jnp.tanh(wd) @ w_up).astype(jnp.float32)))
    a = jax.nn.sigmoid(a0 + ad @ a_up)
    g = jax.nn.sigmoid(gd) @ g_up
    heads = lambda t: t.reshape(B, S, H, N).astype(jnp.float32)
    kk = heads(k * k_k)
    kk = kk / jnp.maximum(jnp.sqrt(jnp.sum(kk * kk, axis=-1, keepdims=True)), 1e-12)
    k = k * (1 + (a - 1) * k_a)
    rh, kh, vh = heads(r), heads(k), heads(v)
    xs = tuple(jnp.moveaxis(t, 1, 0) for t in (rh, heads(decay), kh, vh, kk, heads(a)))
    _, ys = lax.scan(_rwkv7_step, jnp.zeros((B, H, N, N), jnp.float32), xs)
    y = jnp.moveaxis(ys, 0, 1)
    mean = jnp.mean(y, axis=-1, keepdims=True)
    var = jnp.mean(jnp.square(y - mean), axis=-1, keepdims=True)
    y = ((y - mean) * lax.rsqrt(var + GN_EPS)).reshape(B, S, RWKV_WIDTH) * ln_w + ln_b
    bonus = (jnp.sum(rh * kh * r_k, axis=-1, keepdims=True) * vh).reshape(B, S, RWKV_WIDTH)
    return ((y + bonus) * g).astype(feat.dtype)


def moe_ffn(h, w_router, router_bias, w_gate, w_up, w_down):
    B, S, D = h.shape
    ht = h.reshape(B * S, D)
    T = ht.shape[0]
    aff = jax.nn.sigmoid((ht @ w_router).astype(jnp.float32))
    biased = (aff + router_bias.astype(jnp.float32)).reshape(T, N_EXPERT_GROUPS, EXPERTS_PER_GROUP)
    grp_score = jnp.sum(lax.top_k(biased, TOP_K)[0], axis=-1)
    best = jnp.argmax(grp_score, axis=-1)
    in_grp = jnp.take_along_axis(biased, best[:, None, None], axis=1)[:, 0]
    _, loc = lax.top_k(in_grp, TOP_K)
    eidx = best[:, None] * EXPERTS_PER_GROUP + loc
    wsel = jnp.take_along_axis(aff, eidx, axis=-1)
    wsel = wsel / jnp.sum(wsel, axis=-1, keepdims=True)
    combine = jnp.sum(jax.nn.one_hot(eidx, N_EXPERTS, dtype=jnp.float32) * wsel[..., None], axis=1).astype(ht.dtype)
    y = jnp.zeros_like(ht)
    for e in range(N_EXPERTS):
        he = jax.nn.silu(ht @ w_gate[e]) * (ht @ w_up[e])
        y = y + combine[:, e:e + 1] * (he @ w_down[e])
    return y.reshape(B, S, D)


def setup_inputs(seed: int = 0) -> dict:
    key = jax.random.key(seed)
    ks = jax.random.split(key, 40)
    f32 = jnp.float32
    nrm = lambda k, shape, s: jax.random.normal(k, shape, f32) * s
    D, L = D_MODEL, DEPTH
    offset = jax.random.randint(ks[2], (BATCH, 1), 0, 4096, dtype=jnp.int32)
    return {
        'x': nrm(ks[0], (BATCH, SEQ, D), 1.0),
        'c': nrm(ks[1], (BATCH, D), 1.0),
        'positions': offset + jnp.arange(SEQ, dtype=jnp.int32)[None, :],
        'w_mod': nrm(ks[3], (L, D, 6 * D), 0.5 * D ** -0.5),
        'b_mod': nrm(ks[4], (L, 6 * D), 0.02),
        'norm_mix': 1.0 + nrm(ks[5], (L, D), 0.05),
        'norm_ffn': 1.0 + nrm(ks[6], (L, D), 0.05),
        'w_in': nrm(ks[7], (L, D, IN_COLS), D ** -0.5),
        'nsa_phi_w1': nrm(ks[8], (L, 2, CMP_BLOCK, HEAD_DIM, HEAD_DIM), (CMP_BLOCK * HEAD_DIM) ** -0.5),
        'nsa_phi_w2': nrm(ks[9], (L, 2, HEAD_DIM, HEAD_DIM), HEAD_DIM ** -0.5),
        'nsa_phi_pos': nrm(ks[10], (L, 2, CMP_BLOCK, HEAD_DIM), 0.1),
        'rwkv_mu': jax.random.uniform(ks[11], (L, RWKV_SHIFT_COLS), f32),
        'rwkv_w_up': nrm(ks[12], (L, DECAY_LORA, RWKV_WIDTH), DECAY_LORA ** -0.5),
        'rwkv_w0': nrm(ks[13], (L, RWKV_WIDTH), 0.5),
        'rwkv_a_up': nrm(ks[14], (L, AAA_LORA, RWKV_WIDTH), 0.5 * AAA_LORA ** -0.5),
        'rwkv_a0': nrm(ks[15], (L, RWKV_WIDTH), 0.5),
        'rwkv_g_up': nrm(ks[16], (L, GATE_LORA, RWKV_WIDTH), GATE_LORA ** -0.5),
        'rwkv_k_k': 0.85 + nrm(ks[17], (L, RWKV_WIDTH), 0.05),
        'rwkv_k_a': 1.0 + nrm(ks[18], (L, RWKV_WIDTH), 0.05),
        'rwkv_r_k': nrm(ks[19], (L, RWKV_HEADS, HEAD_DIM), 0.1),
        'rwkv_ln_w': 1.0 + nrm(ks[20], (L, RWKV_WIDTH), 0.05),
        'rwkv_ln_b': nrm(ks[21], (L, RWKV_WIDTH), 0.02),
        'norm_nsa_out': 1.0 + nrm(ks[22], (L, NSA_WIDTH), 0.05),
        'norm_moba_out': 1.0 + nrm(ks[23], (L, MOBA_WIDTH), 0.05),
        'w_out': nrm(ks[24], (L, MIX_WIDTH, D), MIX_WIDTH ** -0.5),
        'w_router': nrm(ks[25], (D, N_EXPERTS), D ** -0.5),
        'router_bias': nrm(ks[26], (N_EXPERTS,), 0.01),
        'moe_w_gate': nrm(ks[27], (L, N_EXPERTS, D, EXPERT_FF), D ** -0.5),
        'moe_w_up': nrm(ks[28], (L, N_EXPERTS, D, EXPERT_FF), D ** -0.5),
        'moe_w_down': nrm(ks[29], (L, N_EXPERTS, EXPERT_FF, D), EXPERT_FF ** -0.5),
        'norm_final': 1.0 + nrm(ks[30], (D,), 0.05),
    }


def reference(x, c, positions, w_mod, b_mod, norm_mix, norm_ffn, w_in, nsa_phi_w1, nsa_phi_w2,
              nsa_phi_pos, rwkv_mu, rwkv_w_up, rwkv_w0, rwkv_a_up, rwkv_a0, rwkv_g_up, rwkv_k_k,
              rwkv_k_a, rwkv_r_k, rwkv_ln_w, rwkv_ln_b, norm_nsa_out, norm_moba_out, w_out,
              w_router, router_bias, moe_w_gate, moe_w_up, moe_w_down, norm_final):
    B, S, D = x.shape
    cos, sin = rope_tables(positions)
    c_act = jax.nn.silu(c)
    for l in range(DEPTH):
        mod = (c_act @ w_mod[l] + b_mod[l])[:, None, :]
        sh1, sc1, g1, sh2, sc2, g2 = jnp.split(mod, 6, axis=-1)
        h = rms_norm(x, norm_mix[l]) * (1 + sc1) + sh1
        proj = h @ w_in[l]
        (nq, nkc, nvc, nks, nvs, nkw, nvw, ngate, mq, mk, mv, rfeat) = split_cols(proj, IN_SPLITS)
        kvh = lambda t: t.reshape(B, S, NSA_KV_HEADS, HEAD_DIM)
        mh = lambda t: t.reshape(B, S, MOBA_HEADS, HEAD_DIM)
        o_nsa = nsa_mixer(apply_rope(nq.reshape(B, S, NSA_HEADS, HEAD_DIM), cos, sin),
                          kvh(nkc), kvh(nvc), apply_rope(kvh(nks), cos, sin), kvh(nvs),
                          apply_rope(kvh(nkw), cos, sin), kvh(nvw),
                          ngate.reshape(B, S, NSA_HEADS, 3), cos, sin,
                          nsa_phi_w1[l], nsa_phi_w2[l], nsa_phi_pos[l])
        o_moba = moba_mixer(apply_rope(mh(mq), cos, sin), apply_rope(mh(mk), cos, sin), mh(mv))
        o_rwkv = rwkv7_mixer(rfeat, rwkv_mu[l], rwkv_w_up[l], rwkv_w0[l], rwkv_a_up[l], rwkv_a0[l],
                             rwkv_g_up[l], rwkv_k_k[l], rwkv_k_a[l], rwkv_r_k[l], rwkv_ln_w[l], rwkv_ln_b[l])
        mix = jnp.concatenate([rms_norm(o_nsa, norm_nsa_out[l]), rms_norm(o_moba, norm_moba_out[l]), o_rwkv], axis=-1)
        x = x + g1 * (mix @ w_out[l])
        h2 = rms_norm(x, norm_ffn[l]) * (1 + sc2) + sh2
        x = x + g2 * moe_ffn(h2, w_router, router_bias, moe_w_gate[l], moe_w_up[l], moe_w_down[l])
    return rms_norm(x, norm_final)
```

```cpp
#include <hip/hip_runtime.h>
#include <cstdio>
#include <cstdint>
#include <cmath>
#ifndef PH_MASK
#define PH_MASK 0xfff
#endif
#define PH_EN(k) ((PH_MASK >> (k)) & 1)
#ifndef MK_PER_PHASE
#define MK_PER_PHASE 0
#endif
namespace pg8 {
#define PG8_LAS __attribute__((address_space(3)))
typedef unsigned short bf16_t;
typedef short bf16x8 __attribute__((ext_vector_type(8)));
typedef float f32x4 __attribute__((ext_vector_type(4)));
typedef unsigned u32x4 __attribute__((ext_vector_type(4)));
constexpr int BM = 256, BK = 64, HALF = 128, HTB = HALF * BK * 2  , STAGE_BYTES = 8 * HTB, NXCD = 8, WGM = 8;

__host__ __device__ __forceinline__ int lds_byte(int r, int c) { const int st = (r >> 4) * 2 + (c >> 5), rr = r & 15, cc = c & 31, ob = rr * 64 + cc * 2; return st * 1024 + (ob ^ (((ob >> 9) & 1) << 5)); }
__host__ __device__ __forceinline__ void stage_rc(int b, int& R, int& C) { const int st = b / 1024, sb = b % 1024, swz = sb ^ (((sb >> 9) & 1) << 5); R = (st >> 1) * 16 + swz / 64; C = (st & 1) * 32 + (swz % 64) / 2; }
__host__ __device__ __forceinline__ int perm32(int rho) { const int n = rho >> 4, i = rho & 15; return 8 * (i >> 2) + 4 * n + (i & 3); }

struct Unit { int pm, pn; };
struct Gemm { const bf16_t* A; const bf16_t* Bt; int M, N, K; };

struct StaticOrder {
    int nM, nN, nwg, G, c;
    __host__ __device__ void init(int M, int N, int G_, int c_) { nM = M / BM; nN = N / BM; nwg = nM * nN; G = G_; c = c_; }
    __host__ __device__ bool next(int i, Unit& u) const {
        const long L = (long)i * G + c; if (L >= nwg) return false;
        int wgid = (int)L; { const int q = nwg / NXCD, r = nwg % NXCD, xcd = wgid % NXCD, off = wgid / NXCD; wgid = (xcd < r ? xcd * (q + 1) : r * (q + 1) + (xcd - r) * q) + off; }
        const int nig = WGM * nN, gid = wgid / nig, fm = gid * WGM, gsz = (nM - fm) < WGM ? (nM - fm) : WGM;
        u.pm = fm + ((wgid % nig) % gsz); u.pn = (wgid % nig) / gsz; return true;
    }
    __device__ __forceinline__ void a_ready(const Unit&) const {}
    __device__ __forceinline__ size_t boff(const Unit&) const { return 0; }
    __device__ __forceinline__ void done(const Unit&) const {}
};

template <class Epi, class Sched, bool ALIGN_EPI = false, bool SP2 = false>
__device__ __forceinline__ void gemm_phase(PG8_LAS unsigned char* lds, const Gemm g, const Sched& S, const Epi& E, const int tid_in) {
    const int tid = tid_in, wid = __builtin_amdgcn_readfirstlane(tid >> 6), lane = tid & 63, wr = wid >> 2, wc = wid & 3, fr = lane & 15, fq = lane >> 4;
    const int K = g.K, nt = K / BK;
    unsigned voffA[2], voffB[2];
#pragma unroll
    for (int i = 0; i < 2; ++i) { int R, C; stage_rc(tid * 16 + i * 8192, R, C); const int Rb = Epi::PERM ? ((R & ~31) + perm32(R & 31)) : R;
        voffA[i] = (unsigned)(R * K + C) * 2u; voffB[i] = (unsigned)(Rb * K + C) * 2u; }
    const size_t kstep = (size_t)(BK * 2);
    const size_t hstep = (size_t)HALF * K * 2;
    const size_t tstep = 2 * hstep;
    const unsigned ldsw = (unsigned)wid * 1024u;
    const int aoff = lds_byte(wr * 64 + fr, fq * 8), boff = lds_byte(wc * 32 + fr, fq * 8);
#define PG8_SA(b, h) (((b) * 2 + (h)) * HTB)
#define PG8_SB(b, h) ((4 + (b) * 2 + (h)) * HTB)
#define PG8_STAGE(bufoff, gbase, voff) do { _Pragma("unroll") for (int _i = 0; _i < 2; ++_i) \
        __builtin_amdgcn_global_load_lds((const unsigned*)((const char*)(gbase) + (voff)[_i]), (PG8_LAS unsigned*)(lds + (bufoff) + ldsw + _i * 8192), 16, 0, 0); } while (0)
#define PG8_LDA(dst, b, h) do { _Pragma("unroll") for (int m = 0; m < 4; ++m) _Pragma("unroll") for (int k = 0; k < 2; ++k) dst[m][k] = *(const PG8_LAS bf16x8*)(lds + PG8_SA(b, h) + aoff + m * 2048 + k * 1024); } while (0)
#define PG8_LDB(dst, b, h) do { _Pragma("unroll") for (int n = 0; n < 2; ++n) _Pragma("unroll") for (int k = 0; k < 2; ++k) dst[n][k] = *(const PG8_LAS bf16x8*)(lds + PG8_SB(b, h) + boff + n * 2048 + k * 1024); } while (0)
#define PG8_MMA(ai, bj, At, Bt) do { __builtin_amdgcn_s_setprio(1); _Pragma("unroll") for (int m = 0; m < 4; ++m) _Pragma("unroll") for (int n = 0; n < 2; ++n) _Pragma("unroll") for (int k = 0; k < 2; ++k) \
        acc[ai][bj][m][n] = __builtin_amdgcn_mfma_f32_16x16x32_bf16(Bt[n][k], At[m][k], acc[ai][bj][m][n], 0, 0, 0); __builtin_amdgcn_s_setprio(0); } while (0)
#define PG8_WAIT_V(n) asm volatile("s_waitcnt vmcnt(" #n ")" ::: "memory")
#define PG8_WAIT_L(n) asm volatile("s_waitcnt lgkmcnt(" #n ")" ::: "memory")
#define PG8_BAR __builtin_amdgcn_s_barrier()
#define PG8_SCHED __builtin_amdgcn_sched_barrier(0)
    Unit cur, nxt; int ui = 0;
    if (!S.next(0, cur)) return;
    f32x4 acc[2][2][4][2];
#pragma unroll
    for (int a = 0; a < 2; ++a)
#pragma unroll
        for (int b = 0; b < 2; ++b)
#pragma unroll
            for (int m = 0; m < 4; ++m)
#pragma unroll
                for (int n = 0; n < 2; ++n) acc[a][b][m][n] = (f32x4){0.f, 0.f, 0.f, 0.f};
    bf16x8 At[4][2], B0[2][2], B1[2][2];
    const char* cA = (const char*)g.A + (size_t)cur.pm * tstep; const char* cB = (const char*)g.Bt + S.boff(cur) + (size_t)cur.pn * tstep;
    S.a_ready(cur);
    if constexpr (SP2) {
        PG8_STAGE(PG8_SB(0, 0), cB, voffB); PG8_STAGE(PG8_SB(0, 1), cB + hstep, voffB); PG8_STAGE(PG8_SA(0, 0), cA, voffA); PG8_STAGE(PG8_SA(0, 1), cA + hstep, voffA);
        if (wr == 1) PG8_BAR;
        PG8_WAIT_V(2); PG8_BAR;
        PG8_STAGE(PG8_SB(1, 0), cB + kstep, voffB); PG8_STAGE(PG8_SA(1, 0), cA + kstep, voffA); PG8_STAGE(PG8_SB(1, 1), cB + hstep + kstep, voffB);
        PG8_WAIT_V(6); PG8_BAR;
    } else {
        PG8_STAGE(PG8_SB(0, 0), cB, voffB); PG8_STAGE(PG8_SA(0, 0), cA, voffA); PG8_STAGE(PG8_SB(0, 1), cB + hstep, voffB); PG8_STAGE(PG8_SA(0, 1), cA + hstep, voffA);
        if (wr == 1) PG8_BAR;
        PG8_WAIT_V(4); PG8_BAR;
        PG8_STAGE(PG8_SB(1, 0), cB + kstep, voffB); PG8_STAGE(PG8_SA(1, 0), cA + kstep, voffA); PG8_STAGE(PG8_SB(1, 1), cB + hstep + kstep, voffB);
        PG8_WAIT_V(6); PG8_BAR;
    }
    for (;;) {
        const bool has_next = S.next(ui + 1, nxt);
        const char* nA = has_next ? (const char*)g.A + (size_t)nxt.pm * tstep : cA; const char* nB = has_next ? (const char*)g.Bt + S.boff(nxt) + (size_t)nxt.pn * tstep : cB;
        for (int t = 0; t < nt; t += 2) {
            const bool last = (t == nt - 2);
            const char* a1 = cA + (size_t)(t + 1) * kstep;
            const char* a2 = last ? nA : cA + (size_t)(t + 2) * kstep; const char* b2 = last ? nB : cB + (size_t)(t + 2) * kstep;
            const char* a3 = a2 + kstep; const char* b3 = b2 + kstep;
            if (last && has_next) S.a_ready(nxt);
            if constexpr (SP2) {
            PG8_LDB(B0, 0, 0); PG8_LDB(B1, 0, 1); PG8_SCHED; PG8_LDA(At, 0, 0); PG8_STAGE(PG8_SA(1, 1), a1 + hstep, voffA);
            PG8_WAIT_V(8); PG8_WAIT_L(0); PG8_BAR; PG8_MMA(0, 0, At, B0); PG8_MMA(0, 1, At, B1); PG8_BAR; PG8_SCHED;
            PG8_LDA(At, 0, 1); PG8_STAGE(PG8_SB(0, 0), b2, voffB); PG8_STAGE(PG8_SB(0, 1), b2 + hstep, voffB); PG8_STAGE(PG8_SA(0, 0), a2, voffA);
            PG8_WAIT_V(8); PG8_WAIT_L(0); PG8_BAR; PG8_MMA(1, 0, At, B0); PG8_MMA(1, 1, At, B1); PG8_BAR; PG8_SCHED;
            PG8_LDB(B0, 1, 0); PG8_LDB(B1, 1, 1); PG8_SCHED; PG8_LDA(At, 1, 0); PG8_STAGE(PG8_SA(0, 1), a2 + hstep, voffA);
            PG8_WAIT_V(8); PG8_WAIT_L(0); PG8_BAR; PG8_MMA(0, 0, At, B0); PG8_MMA(0, 1, At, B1); PG8_BAR; PG8_SCHED;
            PG8_LDA(At, 1, 1); PG8_STAGE(PG8_SB(1, 0), b3, voffB); PG8_STAGE(PG8_SB(1, 1), b3 + hstep, voffB); PG8_STAGE(PG8_SA(1, 0), a3, voffA);
            PG8_WAIT_V(8); PG8_WAIT_L(0); PG8_BAR; PG8_MMA(1, 0, At, B0); PG8_MMA(1, 1, At, B1); PG8_BAR; PG8_SCHED;
            } else {
            PG8_LDB(B0, 0, 0); PG8_SCHED; PG8_LDA(At, 0, 0); PG8_STAGE(PG8_SA(1, 1), a1 + hstep, voffA);
            PG8_WAIT_L(8); PG8_BAR; PG8_WAIT_L(0); PG8_MMA(0, 0, At, B0); PG8_BAR; PG8_SCHED;
            PG8_LDB(B1, 0, 1); PG8_STAGE(PG8_SB(0, 0), b2, voffB);
            PG8_BAR; PG8_WAIT_L(0); PG8_MMA(0, 1, At, B1); PG8_BAR;
            PG8_LDA(At, 0, 1); PG8_STAGE(PG8_SA(0, 0), a2, voffA);
            PG8_BAR; PG8_WAIT_L(0); PG8_MMA(1, 0, At, B0); PG8_BAR; PG8_SCHED;
            PG8_STAGE(PG8_SB(0, 1), b2 + hstep, voffB);
            PG8_WAIT_V(6); PG8_BAR; PG8_MMA(1, 1, At, B1); PG8_BAR;
            PG8_LDB(B0, 1, 0); PG8_SCHED; PG8_LDA(At, 1, 0); PG8_STAGE(PG8_SA(0, 1), a2 + hstep, voffA);
            PG8_WAIT_L(8); PG8_BAR; PG8_WAIT_L(0); PG8_MMA(0, 0, At, B0); PG8_BAR; PG8_SCHED;
            PG8_LDB(B1, 1, 1); PG8_STAGE(PG8_SB(1, 0), b3, voffB);
            PG8_BAR; PG8_WAIT_L(0); PG8_MMA(0, 1, At, B1); PG8_BAR;
            PG8_LDA(At, 1, 1); PG8_STAGE(PG8_SA(1, 0), a3, voffA);
            PG8_BAR; PG8_WAIT_L(0); PG8_MMA(1, 0, At, B0); PG8_BAR; PG8_SCHED;
            PG8_STAGE(PG8_SB(1, 1), b3 + hstep, voffB);
            PG8_WAIT_V(6); PG8_BAR; PG8_MMA(1, 1, At, B1); PG8_BAR;
            }
        }
        if constexpr (ALIGN_EPI) { if (wr == 0) PG8_BAR; }
        if constexpr (!Epi::AFTER_DRAIN) { E(acc, cur, wr, wc, 0, 0); S.done(cur); }
        if (!has_next) break;
#pragma unroll
        for (int a = 0; a < 2; ++a)
#pragma unroll
            for (int b = 0; b < 2; ++b)
#pragma unroll
                for (int m = 0; m < 4; ++m)
#pragma unroll
                    for (int n = 0; n < 2; ++n) acc[a][b][m][n] = (f32x4){0.f, 0.f, 0.f, 0.f};
        cur = nxt; cA = nA; cB = nB; ++ui;
        if constexpr (ALIGN_EPI) { if (wr == 1) PG8_BAR; }
    }
    PG8_WAIT_V(0);
    if constexpr (!ALIGN_EPI) { if (wr == 0) PG8_BAR; }
    PG8_BAR;
    if constexpr (Epi::AFTER_DRAIN) { E.fused(acc, cur, wr, wc, fr, fq, lds, wid, lane); S.done(cur); }
#undef PG8_SA
#undef PG8_SB
#undef PG8_STAGE
#undef PG8_LDA
#undef PG8_LDB
#undef PG8_MMA
#undef PG8_WAIT_V
#undef PG8_WAIT_L
#undef PG8_BAR
#undef PG8_SCHED
}
}

constexpr int BATCH = 2, SEQ = 8192, T = BATCH * SEQ, D = 1024, NL = 2;
constexpr int NPAD = 3584, RW = 1408, INCOLS = 3346;
constexpr int NWAVES = 8, NTHR = 512;
constexpr float LOG2E = 1.4426950408889634f;
constexpr float NORM_EPS = 1e-6f;

#define GAS __attribute__((address_space(1)))
#define LAS __attribute__((address_space(3)))
typedef unsigned short bf16_t;
typedef short bf16x8 __attribute__((ext_vector_type(8)));
typedef short s16x4 __attribute__((ext_vector_type(4)));
typedef short v4i16_t __attribute__((ext_vector_type(4)));
typedef float f32x4 __attribute__((ext_vector_type(4)));
typedef float f32x16 __attribute__((ext_vector_type(16)));
typedef unsigned u32x4 __attribute__((ext_vector_type(4)));
typedef unsigned u32x2 __attribute__((ext_vector_type(2)));
typedef GAS unsigned gu32;

constexpr size_t MiB = 1u << 20, KiB = 1u << 10;
constexpr size_t WS_CTL = 0, CTL_ZERO_BYTES = 64 * KiB;
constexpr size_t WS_COS = 1 * MiB, WS_SIN = 3 * MiB;
constexpr size_t WS_MOD = 5 * MiB;
constexpr size_t WS_PHIB = WS_MOD + 128 * KiB;
constexpr size_t WS_KMEAN = WS_MOD + 192 * KiB;
constexpr size_t WS_KCMP = WS_MOD + 256 * KiB;
constexpr size_t WS_VCMP = WS_KCMP + 256 * KiB;
constexpr size_t WS_BONUS = 6 * MiB;
constexpr size_t WS_GATE = 7 * MiB;
constexpr size_t WS_ROUTE = 9 * MiB;
constexpr size_t WS_ROWINFO = 10 * MiB;
constexpr size_t ROWINFO_LSTRIDE = 512 * KiB;
constexpr int MAXROWS = 36864;
constexpr size_t WS_WIN = 12 * MiB;
constexpr size_t WS_WOUT = 19 * MiB;
constexpr size_t WS_WUP = 21 * MiB;
constexpr size_t WS_WDN = 37 * MiB;
constexpr size_t WS_PHIW = 45 * MiB;
constexpr size_t WS_GUPT = 45 * MiB + 512 * KiB;
constexpr size_t WS_HM = 46 * MiB;
constexpr size_t WS_NQ = 78 * MiB;
constexpr size_t WS_KV6 = 90 * MiB;
constexpr size_t KV6_STRIDE = (size_t)BATCH * 2 * SEQ * 64;
constexpr size_t WS_MQKV = 114 * MiB;
constexpr size_t MQKV_STRIDE = (size_t)BATCH * 4 * SEQ * 64;
constexpr size_t WS_RFEAT = 138 * MiB;
constexpr size_t WS_SORTA = 78 * MiB;
constexpr size_t WS_HID = 150 * MiB;
constexpr size_t WS_PT = 182 * MiB;
constexpr size_t WS_ZS = 194 * MiB;
constexpr size_t WS_YT = 206 * MiB;
constexpr size_t WS_Y0 = 218 * MiB;
constexpr size_t WS_YS = 182 * MiB;
constexpr size_t WS_END = 246 * MiB;
constexpr int CW_Q = 64;
constexpr int CW_CNT = 1024;
constexpr int CW_BAR = 4096;
constexpr int CW_DBG = 3072;
#ifndef DBG_MODE
#define DBG_MODE 0
#endif
#ifndef DBG_SUB
#define DBG_SUB 4
#endif
#ifndef DBG_P
#define DBG_P 4
#endif
#ifndef DBG_CNT
#define DBG_CNT 1
#endif

#define RLX_AGENT __ATOMIC_RELAXED, __HIP_MEMORY_SCOPE_AGENT
#define LDS_WAIT() asm volatile("s_waitcnt lgkmcnt(0)" ::: "memory")
#define VM_WAIT() asm volatile("s_waitcnt vmcnt(0)" ::: "memory")
__device__ __forceinline__ float bf2f(bf16_t h) { return __uint_as_float(((unsigned)h) << 16); }
typedef float f32x2_t __attribute__((ext_vector_type(2)));
typedef __bf16 bf16x2_t __attribute__((ext_vector_type(2)));
__device__ __forceinline__ unsigned pk2(float lo, float hi) { const f32x2_t v = {lo, hi}; return __builtin_bit_cast(unsigned, __builtin_convertvector(v, bf16x2_t)); }
__device__ __forceinline__ bf16_t f2bf(float f) { return (bf16_t)(pk2(f, 0.f) & 0xffffu); }
__device__ __forceinline__ float shx(float v, int mask, int lane) { return __uint_as_float(__builtin_amdgcn_ds_bpermute((lane ^ mask) << 2, __float_as_uint(v))); }
__device__ __forceinline__ int shxi(int v, int mask, int lane) { return __builtin_amdgcn_ds_bpermute((lane ^ mask) << 2, v); }
__device__ __forceinline__ float wave_sum(float v, int lane) {
#pragma unroll
    for (int o = 1; o < 64; o <<= 1) v += shx(v, o, lane);
    return v;
}
__device__ __forceinline__ float sigm(float x) { return 1.f / (1.f + __expf(-x)); }
__device__ __forceinline__ int ld_ctl(const int* p) { return __hip_atomic_load(p, RLX_AGENT); }
__device__ __forceinline__ float ld_ctlf(const float* p) { return __uint_as_float(__hip_atomic_load((const unsigned*)p, RLX_AGENT)); }
#define MFMA16(a, b, c) __builtin_amdgcn_mfma_f32_16x16x32_bf16(a, b, c, 0, 0, 0)
#define MFMA32(a, b, c) __builtin_amdgcn_mfma_f32_32x32x16_bf16(a, b, c, 0, 0, 0)

#define XB_TMO      128
#define XB_XCNT(j)  (256  + 64 * (j))
#define XB_XSUB(j)  (1280 + 64 * (j))
#define XB_XGEN(j)  (2304 + 64 * (j))
#define XB_TOP      3328
#define XB_TOPGEN   3392
#define XCD_BAR_WORDS 3456
#define XB_SPIN_CAP (1u << 22)
__device__ __forceinline__ unsigned xb_ld(unsigned* p)              { return __hip_atomic_load(p, __ATOMIC_RELAXED, __HIP_MEMORY_SCOPE_AGENT); }
__device__ __forceinline__ unsigned xb_add(unsigned* p, unsigned v) { return __hip_atomic_fetch_add(p, v, __ATOMIC_RELAXED, __HIP_MEMORY_SCOPE_AGENT); }
__device__ __forceinline__ unsigned xb_xcc_id() { return (unsigned)__builtin_amdgcn_s_getreg((3 << 11) | 20) & 0xFu; }
#define XB_SPIN(cond, bar) do { unsigned _sp = 0; while (cond) { __builtin_amdgcn_s_sleep(1); \
    if ((++_sp & 255u) == 0u) { if (xb_ld(&(bar)[XB_TMO])) break; if (_sp > XB_SPIN_CAP) { atomicAdd(&(bar)[XB_TMO], 1u); break; } } } } while (0)
struct XcdBarrier { unsigned* bar; unsigned x; volatile LAS unsigned* st; };
__device__ __forceinline__ XcdBarrier xcd_barrier_post(unsigned* bar, volatile LAS unsigned* st) {
    XcdBarrier b; b.bar = bar; b.x = xb_xcc_id(); b.st = st;
    if (threadIdx.x == 0) (void)xb_add(&bar[XB_XCNT(b.x)], 1u);
    return b;
}
__device__ __forceinline__ void xcd_barrier_complete(unsigned* bar, unsigned x, unsigned& nloc, unsigned& nx) {
    const unsigned G = gridDim.x * gridDim.y * gridDim.z;
    unsigned sum, cnt, mine, sp = 0u;
    for (;;) {
        sum = 0u; cnt = 0u; mine = 0u;
#pragma unroll
        for (unsigned j = 0; j < 16; ++j) { const unsigned c = xb_ld(&bar[XB_XCNT(j)]); sum += c; cnt += (c > 0u) ? 1u : 0u; mine = (j == x) ? c : mine; }
        if (sum == G) break;
        __builtin_amdgcn_s_sleep(1);
        if ((++sp & 255u) == 0u) { if (xb_ld(&bar[XB_TMO])) break; if (sp > XB_SPIN_CAP) { atomicAdd(&bar[XB_TMO], 1u); break; } }
    }
    nloc = mine > 0u ? mine : 1u; nx = cnt > 0u ? cnt : 1u;
}
__device__ __forceinline__ void xcd_barrier(const XcdBarrier& b, const int tid) {
    asm volatile("s_waitcnt vmcnt(0)" ::: "memory");
    __syncthreads();
    if (tid == 0) {
        unsigned* bar = b.bar;
        __builtin_amdgcn_s_waitcnt(0);
        unsigned nloc = b.st[0], nx = b.st[1];
        if (nloc == 0u) { xcd_barrier_complete(bar, b.x, nloc, nx); b.st[0] = nloc; b.st[1] = nx; }
        const unsigned old = xb_add(&bar[XB_XSUB(b.x)], 1u);
        const unsigned gen = old / nloc;
        if (old + 1u == (gen + 1u) * nloc) {
            __builtin_amdgcn_fence(__ATOMIC_RELEASE, "agent");
            asm volatile("s_waitcnt vmcnt(0)" ::: "memory");
            const unsigned og = xb_add(&bar[XB_TOP], 1u);
            const unsigned tg = og / nx;
            if (og + 1u == (tg + 1u) * nx) xb_add(&bar[XB_TOPGEN], 1u);
            else XB_SPIN(xb_ld(&bar[XB_TOPGEN]) == tg, bar);
            __builtin_amdgcn_fence(__ATOMIC_ACQUIRE, "agent");
            xb_add(&bar[XB_XGEN(b.x)], 1u);
            asm volatile("s_waitcnt vmcnt(0)" ::: "memory");
        } else {
            XB_SPIN(xb_ld(&bar[XB_XGEN(b.x)]) == gen, bar);
            __builtin_amdgcn_fence(__ATOMIC_ACQUIRE, "agent");
            asm volatile("s_waitcnt vmcnt(0)" ::: "memory");
        }
    }
    __syncthreads();
}

constexpr int RING_BYTES = 131072, MISC_OFF = RING_BYTES + 320, LDS_BYTES = 147456;
struct Frame {
    LAS unsigned char* lds;
    volatile LAS unsigned* MISC;
    unsigned* ctl;
    int tid, lane, wave, G, bid;
    unsigned char* ws;
    float* out;
};
constexpr int IN_OFF = RING_BYTES + 1024;
__device__ __forceinline__ const float* inptr(const LAS unsigned char* lds, int k) {
    int z = 0; asm volatile("" : "+v"(z));
    const LAS unsigned* p = (const LAS unsigned*)(lds + IN_OFF + z) + 2 * k;
    const unsigned lo = __builtin_amdgcn_readfirstlane(p[0]), hi = __builtin_amdgcn_readfirstlane(p[1]);
    return (const float*)(((unsigned long long)hi << 32) | lo); }
#define INF(F, k) inptr((F).lds, k)
#define LAUNDER(F) do { unsigned char* w_ = (F).ws; float* o_ = (F).out; int g_ = (F).G, b_ = (F).bid, wv_ = (F).wave, z_ = 0; asm volatile("" : "+s"(w_), "+s"(o_), "+s"(g_), "+s"(b_), "+s"(wv_), "+s"(z_)); \
    int l_ = (int)__builtin_amdgcn_mbcnt_hi(~0u, __builtin_amdgcn_mbcnt_lo(~0u, (unsigned)z_)); asm volatile("" : "+v"(l_)); \
    (F).ws = w_; (F).out = o_; (F).ctl = (unsigned*)w_; (F).G = g_; (F).bid = b_; (F).wave = wv_; (F).lane = l_; (F).tid = wv_ * 64 + l_; } while (0)
enum { I_X = 0, I_C, I_POS, I_WMOD, I_BMOD, I_NMIX, I_NFFN, I_WIN, I_PHIW1, I_PHIW2, I_PHIPOS, I_MU, I_WUP, I_W0, I_AUP, I_A0, I_GUP, I_KK, I_KA, I_RK, I_LNW, I_LNB,
       I_NNSA, I_NMOBA, I_WOUT, I_WROUTER, I_RBIAS, I_MGATE, I_MUP, I_MDOWN, I_NFINAL };

__device__ const float g_invf[32] = {1.000000000e+00f, 7.498942018e-01f, 5.623413324e-01f, 4.216965139e-01f, 3.162277639e-01f, 2.371373773e-01f, 1.778279394e-01f, 1.333521456e-01f,
    1.000000015e-01f, 7.498942316e-02f, 5.623413250e-02f, 4.216964915e-02f, 3.162277490e-02f, 2.371373773e-02f, 1.778279431e-02f, 1.333521400e-02f, 9.999999776e-03f, 7.498942316e-03f,
    5.623413250e-03f, 4.216964822e-03f, 3.162277630e-03f, 2.371373819e-03f, 1.778279431e-03f, 1.333521446e-03f, 1.000000047e-03f, 7.498941850e-04f, 5.623413017e-04f, 4.216965172e-04f,
    3.162277571e-04f, 2.371373703e-04f, 1.778279402e-04f, 1.333521504e-04f};
__device__ __forceinline__ void phase_pro(Frame& F) {
    const int* pos = (const int*)INF(F, I_POS);
    float* cosT = (float*)(F.ws + WS_COS); float* sinT = (float*)(F.ws + WS_SIN);
    for (int idx = F.bid * NTHR + F.tid; idx < T * 32; idx += F.G * NTHR) {
        const int row = idx >> 5, i = idx & 31;
        const float ang = (float)pos[row] * g_invf[i];
        float sv, cv; sincosf(ang, &sv, &cv);
        cosT[idx] = cv; sinT[idx] = sv;
    }
    LAS float* red = (LAS float*)F.lds;
    for (int chunk = F.bid; chunk < NL * 96; chunk += F.G) {
        const int l = chunk / 96, j0 = (chunk % 96) * 64;
        const float* W = INF(F, I_WMOD) + (size_t)l * D * 6144 + j0 + F.lane;
        const float* c = INF(F, I_C);
        float a0 = 0.f, a1 = 0.f;
        const int k0 = F.wave * 128;
#pragma unroll 8
        for (int k = 0; k < 128; ++k) {
            const float w = W[(size_t)(k0 + k) * 6144];
            const float c0 = c[k0 + k], c1 = c[D + k0 + k];
            a0 += w * (c0 * sigm(c0)); a1 += w * (c1 * sigm(c1));
        }
        red[(F.wave * 2 + 0) * 64 + F.lane] = a0; red[(F.wave * 2 + 1) * 64 + F.lane] = a1;
        __syncthreads();
        if (F.wave < 2) {
            float s = INF(F, I_BMOD)[l * 6144 + j0 + F.lane];
#pragma unroll
            for (int w = 0; w < 8; ++w) s += red[(w * 2 + F.wave) * 64 + F.lane];
            ((float*)(F.ws + WS_MOD))[((size_t)l * BATCH + F.wave) * 6144 + j0 + F.lane] = s;
        }
        __syncthreads();
    }
}

__device__ __forceinline__ void transpose_item(int ldw, int K, bf16_t* WT, int n0, int k0, LAS float* scr, int lane, const float* src) {
#pragma unroll 8
    for (int i = 0; i < 32; ++i) { const int kk = 2 * i + (lane >> 5); scr[kk * 33 + (lane & 31)] = src ? src[(size_t)(k0 + kk) * ldw] : 0.f; }
    LDS_WAIT(); asm volatile("" ::: "memory");
    const int c = lane & 7;
#pragma unroll
    for (int j = 0; j < 4; ++j) { const int n = (lane >> 3) + 8 * j; const LAS float* s = scr + (8 * c) * 33 + n;
        u32x4 o; o.x = pk2(s[0 * 33], s[1 * 33]); o.y = pk2(s[2 * 33], s[3 * 33]); o.z = pk2(s[4 * 33], s[5 * 33]); o.w = pk2(s[6 * 33], s[7 * 33]);
        *(u32x4*)(WT + (size_t)(n0 + n) * K + k0 + 8 * c) = o; }
    LDS_WAIT(); asm volatile("" ::: "memory");
}
__device__ __forceinline__ const float* cm_in(const float* W, int pos) {
        const int G = pos >> 6, p = pos & 63, w = p >> 5, n = (p >> 4) & 1, q = p & 15, d = 16 * w + q + 32 * n;
        int sc;
        if (G < 6) sc = G * 64 + d; else if (G < 18) sc = 384 + (G - 6) * 64 + d; else if (G < 30) sc = 1170 + (G - 18) * 64 + d;
        else if (G < 52) sc = 1938 + (G - 30) * 64 + d; else if (G == 52 && d < 18) sc = 1152 + d; else return nullptr;
        return W + sc; }
__device__ __forceinline__ const float* cm_up(const float* Wg, const float* Wu, int pos) { const int Wd = pos >> 5, n = (pos >> 4) & 1, q = pos & 15, f = 16 * Wd + q; return (n ? Wu : Wg) + f; }

__device__ __forceinline__ void norm_rows(Frame& F, int layer, bool final_) {
    const float* xin = INF(F, I_X);
    const bf16_t* ys = (const bf16_t*)(F.ws + WS_YS);
    const float* mod = (const float*)(F.ws + WS_MOD);
    bf16_t* H = (bf16_t*)(F.ws + WS_HM);
    const int gw = F.bid * NWAVES + F.wave, NGW = F.G * NWAVES;
    for (int m = gw; m < T; m += NGW) {
        const int b = m >> 13;
        f32x4 v[4]; float ss = 0.f;
        if (layer == 0 && !final_) {
#pragma unroll
            for (int j = 0; j < 4; ++j) v[j] = *(const f32x4*)(xin + (size_t)m * D + 4 * F.lane + 256 * j);
        } else {
            const int pl = final_ ? NL - 1 : layer - 1;
            const float* g2 = mod + ((size_t)pl * BATCH + b) * 6144 + 5120;
#pragma unroll
            for (int j = 0; j < 4; ++j) {
                const int col = 4 * F.lane + 256 * j;
                f32x4 x = *(const f32x4*)(F.out + (size_t)m * D + col);
                const u32x2 a = *(const u32x2*)(ys + (size_t)m * D + col), c = *(const u32x2*)(ys + (size_t)(T + m) * D + col);
                const f32x4 g = *(const f32x4*)(g2 + col);
                x.x += g.x * (__uint_as_float(a.x << 16) + __uint_as_float(c.x << 16));
                x.y += g.y * (__uint_as_float(a.x & 0xffff0000u) + __uint_as_float(c.x & 0xffff0000u));
                x.z += g.z * (__uint_as_float(a.y << 16) + __uint_as_float(c.y << 16));
                x.w += g.w * (__uint_as_float(a.y & 0xffff0000u) + __uint_as_float(c.y & 0xffff0000u));
                v[j] = x;
                if (!final_) *(f32x4*)(F.out + (size_t)m * D + col) = x;
            }
        }
#pragma unroll
        for (int j = 0; j < 4; ++j) ss += (v[j].x * v[j].x + v[j].y * v[j].y) + (v[j].z * v[j].z + v[j].w * v[j].w);
        const float rstd = rsqrtf(wave_sum(ss, F.lane) * (1.f / D) + NORM_EPS);
#if DBG_MODE == 1
        if (final_) { float bad = 0.f;
#pragma unroll
            for (int j = 0; j < 4; ++j) { bad += (fabsf(v[j].x) <= 3e38f) ? 0.f : 1.f; bad += (fabsf(v[j].y) <= 3e38f) ? 0.f : 1.f; bad += (fabsf(v[j].z) <= 3e38f) ? 0.f : 1.f; bad += (fabsf(v[j].w) <= 3e38f) ? 0.f : 1.f; }
            bad = wave_sum(bad, F.lane); if (F.lane == 0 && bad > 0.f) atomicAdd(F.ctl + CW_DBG, (unsigned)bad); }
#endif
        if (final_) {
            const float* gn = INF(F, I_NFINAL);
#pragma unroll
            for (int j = 0; j < 4; ++j) { const int col = 4 * F.lane + 256 * j; const f32x4 g = *(const f32x4*)(gn + col);
                f32x4 o; o.x = v[j].x * rstd * g.x; o.y = v[j].y * rstd * g.y; o.z = v[j].z * rstd * g.z; o.w = v[j].w * rstd * g.w;
                *(f32x4*)(F.out + (size_t)m * D + col) = o; }
        } else {
            const float* gn = INF(F, I_NMIX) + layer * D;
            const float* sh = mod + ((size_t)layer * BATCH + b) * 6144; const float* sc = sh + 1024;
#pragma unroll
            for (int j = 0; j < 4; ++j) { const int col = 4 * F.lane + 256 * j;
                const f32x4 g = *(const f32x4*)(gn + col), s1 = *(const f32x4*)(sc + col), s0 = *(const f32x4*)(sh + col);
                u32x2 o; o.x = pk2(v[j].x * rstd * g.x * (1.f + s1.x) + s0.x, v[j].y * rstd * g.y * (1.f + s1.y) + s0.y);
                o.y = pk2(v[j].z * rstd * g.z * (1.f + s1.z) + s0.z, v[j].w * rstd * g.w * (1.f + s1.w) + s0.w);
                *(u32x2*)(H + (size_t)m * D + col) = o; }
        }
    }
}
__device__ __forceinline__ void phase_a(Frame& F, int layer) {
    norm_rows(F, layer, false);
    LAUNDER(F);
    LAS float* scr = (LAS float*)(F.lds + F.wave * 16384);
    const int gw = F.bid * NWAVES + F.wave, NGW = F.G * NWAVES;
    constexpr int I_IN = 16 * 112, I_OUT = 16 * 32, I_UPI = 16 * 16 * 16, I_DN = 16 * 4 * 32, I_PHI = 2 * 32 * 2, I_GU = 2 * 12;
    constexpr int NIT = I_IN + I_OUT + I_UPI + I_DN + I_PHI + I_GU;
    for (int it = gw; it < NIT; it += NGW) {
        int r = it;
        const int l31 = F.lane & 31;
        if (r < I_IN) { const int kb = r / 112, nb = r % 112;
            transpose_item(INCOLS, D, (bf16_t*)(F.ws + WS_WIN), nb * 32, kb * 64, scr, F.lane, cm_in(INF(F, I_WIN) + (size_t)layer * D * INCOLS, nb * 32 + l31)); continue; } r -= I_IN;
        if (r < I_OUT) { const int kb = r / 32, nb = r % 32;
            transpose_item(D, D, (bf16_t*)(F.ws + WS_WOUT), nb * 32, kb * 64, scr, F.lane, INF(F, I_WOUT) + (size_t)layer * D * D + nb * 32 + l31); continue; } r -= I_OUT;
        if (r < I_UPI) { const int e = r / 256, q = r % 256, kb = q / 16, nb = q % 16;
            transpose_item(256, D, (bf16_t*)(F.ws + WS_WUP) + (size_t)e * 512 * D, nb * 32, kb * 64, scr, F.lane,
                           cm_up(INF(F, I_MGATE) + ((size_t)layer * 16 + e) * D * 256, INF(F, I_MUP) + ((size_t)layer * 16 + e) * D * 256, nb * 32 + l31)); continue; } r -= I_UPI;
        if (r < I_DN) { const int e = r / 128, q = r % 128, kb = q / 32, nb = q % 32;
            transpose_item(D, 256, (bf16_t*)(F.ws + WS_WDN) + (size_t)e * D * 256, nb * 32, kb * 64, scr, F.lane, INF(F, I_MDOWN) + ((size_t)layer * 16 + e) * 256 * D + nb * 32 + l31); continue; } r -= I_DN;
        if (r < I_PHI) { const int kv = r / 64, q = r % 64, kb = q / 2, nb = q % 2;
            transpose_item(64, 2048, (bf16_t*)(F.ws + WS_PHIW) + (size_t)kv * 64 * 2048, nb * 32, kb * 64, scr, F.lane, INF(F, I_PHIW1) + ((size_t)layer * 2 + kv) * 2048 * 64 + nb * 32 + l31); continue; } r -= I_PHI;
        { const int kb = r / 12, nb = r % 12;
            transpose_item(384, 128, (bf16_t*)(F.ws + WS_GUPT), nb * 32, kb * 64, scr, F.lane, INF(F, I_GUP) + (size_t)layer * 128 * 384 + nb * 32 + l31); }
    }
    LAUNDER(F);
    if (F.bid == F.G - 1 && F.wave < 2) {
        const int kv = F.wave;
        const float* w1 = INF(F, I_PHIW1) + ((size_t)layer * 2 + kv) * 2048 * 64; const float* pp = INF(F, I_PHIPOS) + ((size_t)layer * 2 + kv) * 2048;
        float a[4] = {0.f, 0.f, 0.f, 0.f};
        for (int k = 0; k < 2048; k += 4) {
#pragma unroll
            for (int u = 0; u < 4; ++u) a[u] += pp[k + u] * w1[(size_t)(k + u) * 64 + F.lane];
        }
        ((float*)(F.ws + WS_PHIB))[(layer * 2 + kv) * 64 + F.lane] = (a[0] + a[1]) + (a[2] + a[3]);
    }
}

struct EpiInProj {
    static constexpr bool PERM = false, AFTER_DRAIN = false;
    bf16_t* nq; bf16_t* kv6; bf16_t* mqkv; bf16_t* rfeat; float* gate; const float* cosT; const float* sinT;
    __device__ __forceinline__ void operator()(const f32x4 (&acc)[2][2][4][2], const pg8::Unit& u, int wr, int wc, int fr_, int fq_) const {
        int z_ = 0; asm volatile("" : "+s"(z_)); int l_ = (int)__builtin_amdgcn_mbcnt_hi(~0u, __builtin_amdgcn_mbcnt_lo(~0u, (unsigned)z_)); asm volatile("" : "+v"(l_)); const int fr = l_ & 15, fq = l_ >> 4; (void)fr_; (void)fq_;
#pragma unroll
        for (int bj = 0; bj < 2; ++bj) {
            const int G = 4 * u.pn + 2 * bj + (wc >> 1), w = wc & 1;
            if (G >= 53) continue;
            const int d0 = 16 * w + 4 * fq;
            const bool rope = (G < 6) || (G == 10) || (G == 11) || (G == 14) || (G == 15) || (G >= 18 && G < 26);
            const float scl = (G < 6 || (G >= 18 && G < 22)) ? 0.125f : 1.0f;
#pragma unroll
            for (int ai = 0; ai < 2; ++ai)
#pragma unroll
                for (int m = 0; m < 4; ++m) {
                    const int row = 256 * u.pm + 128 * ai + 64 * wr + 16 * m + fr, b = row >> 13, t = row & (SEQ - 1);
                    f32x4 x1 = acc[ai][bj][m][0], x2 = acc[ai][bj][m][1];
                    if (rope) {
                        const f32x4 c = *(const f32x4*)(cosT + (size_t)row * 32 + d0), s = *(const f32x4*)(sinT + (size_t)row * 32 + d0);
                        const f32x4 y1 = (x1 * c - x2 * s) * scl, y2 = (x2 * c + x1 * s) * scl; x1 = y1; x2 = y2;
                    }
                    if (G == 52) {
                        float* gp = gate + (size_t)row * 32;
                        *(f32x4*)(gp + d0) = x1;
                        continue;
                    }
                    bf16_t* dst;
                    if (G < 6) dst = nq + ((size_t)(b * 6 + G) * SEQ + t) * 64;
                    else if (G < 18) dst = kv6 + (size_t)((G - 6) >> 1) * KV6_STRIDE + ((size_t)(b * 2 + ((G - 6) & 1)) * SEQ + t) * 64;
                    else if (G < 30) dst = mqkv + (size_t)((G - 18) >> 2) * MQKV_STRIDE + ((size_t)(b * 4 + ((G - 18) & 3)) * SEQ + t) * 64;
                    else dst = rfeat + (size_t)row * RW + (G - 30) * 64;
                    u32x2 o1, o2; o1.x = pk2(x1.x, x1.y); o1.y = pk2(x1.z, x1.w); o2.x = pk2(x2.x, x2.y); o2.y = pk2(x2.z, x2.w);
                    *(u32x2*)(dst + d0) = o1; *(u32x2*)(dst + d0 + 32) = o2;
                }
        }
    }
};
struct EpiOutProj {
    static constexpr bool PERM = false, AFTER_DRAIN = false;
    const float* xold; float* xnew; const float* g1;
    __device__ __forceinline__ void operator()(const f32x4 (&acc)[2][2][4][2], const pg8::Unit& u, int wr, int wc, int fr_, int fq_) const {
        int z_ = 0; asm volatile("" : "+s"(z_)); int l_ = (int)__builtin_amdgcn_mbcnt_hi(~0u, __builtin_amdgcn_mbcnt_lo(~0u, (unsigned)z_)); asm volatile("" : "+v"(l_)); const int fr = l_ & 15, fq = l_ >> 4; (void)fr_; (void)fq_;
#pragma unroll
        for (int ai = 0; ai < 2; ++ai)
#pragma unroll
            for (int m = 0; m < 4; ++m) {
                const int row = 256 * u.pm + 128 * ai + 64 * wr + 16 * m + fr, b = row >> 13;
#pragma unroll
                for (int bj = 0; bj < 2; ++bj)
#pragma unroll
                    for (int n = 0; n < 2; ++n) {
                        const int col = 256 * u.pn + 128 * bj + 32 * wc + 16 * n + 4 * fq;
                        const f32x4 g = *(const f32x4*)(g1 + (size_t)b * 6144 + col);
                        const f32x4 xo = *(const f32x4*)(xold + (size_t)row * D + col);
                        *(f32x4*)(xnew + (size_t)row * D + col) = xo + g * acc[ai][bj][m][n];
                    }
            }
    }
};
struct EpiMoeUp {
    static constexpr bool PERM = false, AFTER_DRAIN = false;
    bf16_t* hid;
    __device__ __forceinline__ void operator()(const f32x4 (&acc)[2][2][4][2], const pg8::Unit& u, int wr, int wc, int fr_, int fq_) const {
        int z_ = 0; asm volatile("" : "+s"(z_)); int l_ = (int)__builtin_amdgcn_mbcnt_hi(~0u, __builtin_amdgcn_mbcnt_lo(~0u, (unsigned)z_)); asm volatile("" : "+v"(l_)); const int fr = l_ & 15, fq = l_ >> 4; (void)fr_; (void)fq_;
#pragma unroll
        for (int ai = 0; ai < 2; ++ai)
#pragma unroll
            for (int m = 0; m < 4; ++m) {
                const int row = 256 * u.pm + 128 * ai + 64 * wr + 16 * m + fr;
#pragma unroll
                for (int bj = 0; bj < 2; ++bj) {
                    const int f0 = 16 * (8 * u.pn + 4 * bj + wc) + 4 * fq;
                    const f32x4 g = acc[ai][bj][m][0], up = acc[ai][bj][m][1];
                    u32x2 o; o.x = pk2(g.x * sigm(g.x) * up.x, g.y * sigm(g.y) * up.y); o.y = pk2(g.z * sigm(g.z) * up.z, g.w * sigm(g.w) * up.w);
                    *(u32x2*)(hid + (size_t)row * 256 + f0) = o;
                }
            }
    }
};
struct EpiMoeDown {
    static constexpr bool PERM = false, AFTER_DRAIN = false;
    bf16_t* ys; const int* rowinfo; const float* roww;
    __device__ __forceinline__ void operator()(const f32x4 (&acc)[2][2][4][2], const pg8::Unit& u, int wr, int wc, int fr_, int fq_) const {
        int z_ = 0; asm volatile("" : "+s"(z_)); int l_ = (int)__builtin_amdgcn_mbcnt_hi(~0u, __builtin_amdgcn_mbcnt_lo(~0u, (unsigned)z_)); asm volatile("" : "+v"(l_)); const int fr = l_ & 15, fq = l_ >> 4; (void)fr_; (void)fq_;
#pragma unroll
        for (int ai = 0; ai < 2; ++ai)
#pragma unroll
            for (int m = 0; m < 4; ++m) {
                const int row = 256 * u.pm + 128 * ai + 64 * wr + 16 * m + fr;
                const int ri = ld_ctl(rowinfo + row); const float w = ld_ctlf(roww + row);
                if (ri < 0) continue;
                bf16_t* dst = ys + ((size_t)(ri & 1) * T + (ri >> 1)) * D;
#pragma unroll
                for (int bj = 0; bj < 2; ++bj)
#pragma unroll
                    for (int n = 0; n < 2; ++n) {
                        const int col = 256 * u.pn + 128 * bj + 32 * wc + 16 * n + 4 * fq;
                        const f32x4 v = acc[ai][bj][m][n] * w;
                        u32x2 o; o.x = pk2(v.x, v.y); o.y = pk2(v.z, v.w);
                        *(u32x2*)(dst + col) = o;
                    }
            }
    }
};
struct MoeOrder {
    int ntiles, nN, G, c; const int* tile_e; size_t estride;
    __device__ __forceinline__ bool next(int i, pg8::Unit& u) const { const int L = i * G + c; if (L >= ntiles * nN) return false; u.pm = L / nN; u.pn = L % nN; return true; }
    __device__ __forceinline__ void a_ready(const pg8::Unit&) const {}
    __device__ __forceinline__ size_t boff(const pg8::Unit& u) const { return (size_t)__builtin_amdgcn_readfirstlane(ld_ctl(tile_e + u.pm)) * estride; }
    __device__ __forceinline__ void done(const pg8::Unit&) const {}
};

__device__ __forceinline__ float gelu_tanh(float x) { const float u = 0.7978845608028654f * (x + 0.044715f * x * x * x); return 0.5f * x * (1.f + tanhf(u)); }

__device__ __forceinline__ void compress_unit(Frame& F, int layer, int u) {
    const int kvsel = u >> 5, b = (u >> 4) & 1, kvh = (u >> 3) & 1, rt = u & 7, i0 = 64 * rt;
    const bf16_t* src = (const bf16_t*)(F.ws + WS_KV6) + (size_t)kvsel * KV6_STRIDE + (size_t)(b * 2 + kvh) * SEQ * 64;
    const bf16_t* w1t = (const bf16_t*)(F.ws + WS_PHIW) + (size_t)kvsel * 64 * 2048;
    const int lane = F.lane, r = lane & 15, kg = lane >> 4;
    f32x4 acc[4][4];
#pragma unroll
    for (int a = 0; a < 4; ++a)
#pragma unroll
        for (int c = 0; c < 4; ++c) acc[a][c] = (f32x4){0.f, 0.f, 0.f, 0.f};
    for (int lq = 0; lq < 4; ++lq) {
        const int l = 4 * F.wave + lq;
#pragma unroll
        for (int ks = 0; ks < 2; ++ks) {
            bf16x8 af[4], bfr[4];
#pragma unroll
            for (int mt = 0; mt < 4; ++mt) af[mt] = *(const bf16x8*)(src + ((size_t)(16 * (i0 + 16 * mt + r) + l)) * 64 + 32 * ks + 8 * kg);
#pragma unroll
            for (int nt = 0; nt < 4; ++nt) bfr[nt] = *(const bf16x8*)(w1t + (size_t)(16 * nt + r) * 2048 + l * 64 + 32 * ks + 8 * kg);
#pragma unroll
            for (int mt = 0; mt < 4; ++mt)
#pragma unroll
                for (int nt = 0; nt < 4; ++nt) acc[mt][nt] = MFMA16(af[mt], bfr[nt], acc[mt][nt]);
        }
    }
    LAS float* part = (LAS float*)F.lds;
#pragma unroll
    for (int mt = 0; mt < 4; ++mt)
#pragma unroll
        for (int nt = 0; nt < 4; ++nt)
#pragma unroll
            for (int q = 0; q < 4; ++q) part[(F.wave * 64 + 16 * mt + 4 * kg + q) * 64 + 16 * nt + r] = acc[mt][nt][q];
    __syncthreads();
    const float* phib = (const float*)(F.ws + WS_PHIB) + (layer * 2 + kvsel) * 64;
    float hv[8];
    const int row = F.tid >> 3, e0 = (F.tid & 7) * 8;
#pragma unroll
    for (int k = 0; k < 8; ++k) { float s = phib[e0 + k];
#pragma unroll
        for (int w = 0; w < 8; ++w) s += part[(w * 64 + row) * 64 + e0 + k];
        hv[k] = gelu_tanh(s); }
    __syncthreads();
    LAS float* hb = (LAS float*)F.lds;
    LAS float* ob = (LAS float*)(F.lds + 32768);
#pragma unroll
    for (int k = 0; k < 8; ++k) hb[row * 65 + e0 + k] = hv[k];
    __syncthreads();
    const float* w2 = INF(F, I_PHIW2) + ((size_t)layer * 2 + kvsel) * 64 * 64;
    float o[8];
#pragma unroll
    for (int k = 0; k < 8; ++k) o[k] = 0.f;
    for (int e = 0; e < 64; ++e) { const float h = hb[row * 65 + e]; const f32x4 wa = *(const f32x4*)(w2 + e * 64 + e0), wb = *(const f32x4*)(w2 + e * 64 + e0 + 4);
        o[0] += h * wa.x; o[1] += h * wa.y; o[2] += h * wa.z; o[3] += h * wa.w; o[4] += h * wb.x; o[5] += h * wb.y; o[6] += h * wb.z; o[7] += h * wb.w; }
#pragma unroll
    for (int k = 0; k < 8; ++k) ob[row * 65 + e0 + k] = o[k];
    __syncthreads();
    const int i = i0 + row;
    bf16_t* dst = (bf16_t*)(F.ws + (kvsel ? WS_VCMP : WS_KCMP)) + ((size_t)(b * 2 + kvh) * 512 + i) * 64 + e0;
    float y[8];
    if (i >= 511) {
#pragma unroll
        for (int k = 0; k < 8; ++k) y[k] = 0.f;
    } else if (kvsel == 0) {
        const size_t pr = (size_t)b * SEQ + 16 * i + 31;
        const float* cs = (const float*)(F.ws + WS_COS) + pr * 32; const float* sn = (const float*)(F.ws + WS_SIN) + pr * 32;
#pragma unroll
        for (int k = 0; k < 8; ++k) { const int d = e0 + k, f = d & 31; const float x1 = ob[row * 65 + f], x2 = ob[row * 65 + f + 32];
            y[k] = (d < 32) ? (x1 * cs[f] - x2 * sn[f]) : (x2 * cs[f] + x1 * sn[f]); }
    } else {
#pragma unroll
        for (int k = 0; k < 8; ++k) y[k] = o[k];
    }
    u32x4 pk; pk.x = pk2(y[0], y[1]); pk.y = pk2(y[2], y[3]); pk.z = pk2(y[4], y[5]); pk.w = pk2(y[6], y[7]);
    *(u32x4*)dst = pk;
    __syncthreads();
}
__device__ __forceinline__ void kmean_task(Frame& F, int wt) {
    const int b = wt >> 7, h = (wt >> 5) & 3, blk = wt & 31, sub = F.lane >> 3, ch = F.lane & 7;
    const bf16_t* mk = (const bf16_t*)(F.ws + WS_MQKV) + MQKV_STRIDE + ((size_t)(b * 4 + h) * SEQ + 256 * blk) * 64;
    float a[8];
#pragma unroll
    for (int k = 0; k < 8; ++k) a[k] = 0.f;
    for (int it = 0; it < 32; ++it) {
        const u32x4 v = *(const u32x4*)(mk + (size_t)(8 * it + sub) * 64 + 8 * ch);
        a[0] += __uint_as_float(v.x << 16); a[1] += __uint_as_float(v.x & 0xffff0000u); a[2] += __uint_as_float(v.y << 16); a[3] += __uint_as_float(v.y & 0xffff0000u);
        a[4] += __uint_as_float(v.z << 16); a[5] += __uint_as_float(v.z & 0xffff0000u); a[6] += __uint_as_float(v.w << 16); a[7] += __uint_as_float(v.w & 0xffff0000u);
    }
#pragma unroll
    for (int k = 0; k < 8; ++k) { a[k] += shx(a[k], 8, F.lane); a[k] += shx(a[k], 16, F.lane); a[k] += shx(a[k], 32, F.lane); a[k] *= (1.f / 256.f); }
    if (sub == 0) { u32x4 o; o.x = pk2(a[0], a[1]); o.y = pk2(a[2], a[3]); o.z = pk2(a[4], a[5]); o.w = pk2(a[6], a[7]);
        *(u32x4*)((bf16_t*)(F.ws + WS_KMEAN) + ((size_t)(b * 4 + h) * 32 + blk) * 64 + 8 * ch) = o; }
}

constexpr int R1_TASK_OFF = 32768, R1_TASK_BYTES = 12288;
__device__ __forceinline__ void r1_block(Frame& F, int layer, int bt) {
    const int chain = bt >> 5, b = chain / 6, h = chain % 6, c0 = 4 * (bt & 31), lane0 = F.lane;
    LAS float* wup = (LAS float*)F.lds; LAS float* aup = (LAS float*)(F.lds + 16384);
    { const float* WU = INF(F, I_WUP) + (size_t)layer * 64 * 384 + h * 64; const float* AU = INF(F, I_AUP) + (size_t)layer * 64 * 384 + h * 64;
      for (int idx = F.tid; idx < 4096; idx += NTHR) { const int j = idx >> 6, c = idx & 63; wup[idx] = WU[j * 384 + c]; aup[idx] = AU[j * 384 + c]; } }
    __syncthreads();
    const int tk = F.wave >> 1, role = F.wave & 1, chunk = c0 + tk, task = chain * 128 + chunk;
    LAS float* tb = (LAS float*)(F.lds + R1_TASK_OFF + tk * R1_TASK_BYTES);
    LAS float* Lr = tb; LAS float* Lw = tb + 512; LAS float* Lk = tb + 1024; LAS float* Lkk = tb + 1536; LAS float* Lbb = tb + 2048; LAS float* Lv = tb + 2560;
    const bf16_t* rf = (const bf16_t*)(F.ws + WS_RFEAT);
    const float* mu = INF(F, I_MU) + layer * RW;
    float* bonus = (float*)(F.ws + WS_BONUS);
    bf16_t* yout = (bf16_t*)(F.ws + (role ? WS_Y0 : WS_YT)) + (size_t)task * 4096;
    float st[64];
#pragma unroll
    for (int c = 0; c < 64; ++c) st[c] = (role == 0 && c == lane0) ? 1.f : 0.f;
#pragma unroll 1
    for (int sub = 0; sub < 8; ++sub) {
        int lane = lane0, hc = h * 64 + lane0; asm volatile("" : "+v"(lane), "+v"(hc));
#pragma unroll 1
        for (int q = 0; q < 4; ++q) {
            const int tt = 4 * role + q, t = 64 * chunk + 8 * sub + tt; const size_t row = (size_t)b * SEQ + t;
            const bf16_t* cur = rf + row * RW; const bf16_t* prv = cur - RW; const bool hp = t > 0;
            const float mu_r = mu[hc], mu_k = mu[384 + hc], mu_v = mu[768 + hc], mu_w = mu[1152 + lane], mu_a = mu[1216 + lane];
            const float w0 = INF(F, I_W0)[layer * 384 + hc], a0 = INF(F, I_A0)[layer * 384 + hc], k_k = INF(F, I_KK)[layer * 384 + hc], k_a = INF(F, I_KA)[layer * 384 + hc], r_k = INF(F, I_RK)[layer * 384 + hc];
            const float rc = bf2f(cur[hc]), kc = bf2f(cur[384 + hc]), vc = bf2f(cur[768 + hc]), wc_ = bf2f(cur[1152 + lane]), ac = bf2f(cur[1216 + lane]);
            const float rp = hp ? bf2f(prv[hc]) : 0.f, kp = hp ? bf2f(prv[384 + hc]) : 0.f, vp = hp ? bf2f(prv[768 + hc]) : 0.f, wp = hp ? bf2f(prv[1152 + lane]) : 0.f, ap = hp ? bf2f(prv[1216 + lane]) : 0.f;
            const float rs = rc + (rp - rc) * mu_r, ks = kc + (kp - kc) * mu_k, vs = vc + (vp - vc) * mu_v;
            const float tw = tanhf(wc_ + (wp - wc_) * mu_w), ad = ac + (ap - ac) * mu_a;
            float aw = w0, aa = a0;
#pragma unroll 16
            for (int j = 0; j < 64; ++j) {
                const float sw = __uint_as_float(__builtin_amdgcn_readlane(__float_as_uint(tw), j)), sa = __uint_as_float(__builtin_amdgcn_readlane(__float_as_uint(ad), j));
                aw += sw * wup[j * 64 + lane]; aa += sa * aup[j * 64 + lane];
            }
            const float dec = __expf(-0.606531f * sigm(aw)), a = sigm(aa);
            float kk = ks * k_k; const float n2 = wave_sum(kk * kk, lane); kk = kk / fmaxf(sqrtf(n2), 1e-12f);
            const float km = ks * (1.f + (a - 1.f) * k_a);
            const float bn = wave_sum(rs * km * r_k, lane);
            Lr[tt * 64 + lane] = rs; Lw[tt * 64 + lane] = dec; Lk[tt * 64 + lane] = km; Lkk[tt * 64 + lane] = kk; Lbb[tt * 64 + lane] = kk * a; Lv[tt * 64 + lane] = vs;
            if (lane == 0) bonus[row * 8 + h] = bn;
        }
        __syncthreads();
#pragma unroll 1
        for (int tt = 0; tt < 8; ++tt) {
            const LAS f32x4* pkk = (const LAS f32x4*)(Lkk + tt * 64); const LAS f32x4* pw = (const LAS f32x4*)(Lw + tt * 64);
            const LAS f32x4* pbb = (const LAS f32x4*)(Lbb + tt * 64); const LAS f32x4* pr = (const LAS f32x4*)(Lr + tt * 64); const LAS f32x4* pk = (const LAS f32x4*)(Lk + tt * 64);
            float s0 = 0.f, s1 = 0.f, s2 = 0.f, s3 = 0.f;
#pragma unroll
            for (int i = 0; i < 16; ++i) { const f32x4 k4 = pkk[i]; s0 += st[4 * i] * k4.x; s1 += st[4 * i + 1] * k4.y; s2 += st[4 * i + 2] * k4.z; s3 += st[4 * i + 3] * k4.w; }
            const float sa = -((s0 + s1) + (s2 + s3));
            const float vv = role ? Lv[tt * 64 + lane] : 0.f;
            float y0 = 0.f, y1 = 0.f, y2 = 0.f, y3 = 0.f;
#pragma unroll
            for (int i = 0; i < 16; ++i) {
                const f32x4 w4 = pw[i], b4 = pbb[i], r4 = pr[i];
                float n0 = st[4 * i] * w4.x + sa * b4.x, n1 = st[4 * i + 1] * w4.y + sa * b4.y, n2 = st[4 * i + 2] * w4.z + sa * b4.z, n3 = st[4 * i + 3] * w4.w + sa * b4.w;
                if (role) { const f32x4 k4 = pk[i]; n0 += vv * k4.x; n1 += vv * k4.y; n2 += vv * k4.z; n3 += vv * k4.w; }
                st[4 * i] = n0; st[4 * i + 1] = n1; st[4 * i + 2] = n2; st[4 * i + 3] = n3;
                y0 += n0 * r4.x; y1 += n1 * r4.y; y2 += n2 * r4.z; y3 += n3 * r4.w;
            }
            yout[(8 * sub + tt) * 64 + lane] = f2bf((y0 + y1) + (y2 + y3));
        }
        __syncthreads();
    }
    if (role == 0) {
        bf16_t* PT = (bf16_t*)(F.ws + WS_PT) + (size_t)task * 4096;
#pragma unroll
        for (int c = 0; c < 64; ++c) PT[c * 64 + lane0] = f2bf(st[c]);
    } else {
        bf16_t* Z = (bf16_t*)(F.ws + WS_ZS) + (size_t)task * 4096 + lane0 * 64;
#pragma unroll
        for (int c = 0; c < 64; c += 8) { u32x4 o; o.x = pk2(st[c], st[c + 1]); o.y = pk2(st[c + 2], st[c + 3]); o.z = pk2(st[c + 4], st[c + 5]); o.w = pk2(st[c + 6], st[c + 7]); *(u32x4*)(Z + c) = o; }
    }
    __syncthreads();
}
__device__ __forceinline__ void phase_c(Frame& F, int layer) {
#ifndef C_SUB
#define C_SUB 7
#endif
    if (C_SUB & 1) for (int bt = F.bid; bt < 384; bt += F.G) r1_block(F, layer, bt);
    LAUNDER(F);
    if (C_SUB & 2) if (F.bid >= 128 && F.bid < 192) compress_unit(F, layer, F.bid - 128);
    LAUNDER(F);
    if (C_SUB & 4) if (F.bid >= 192 && F.bid < 224) kmean_task(F, (F.bid - 192) * 8 + F.wave);
}

constexpr int KP = 72;
constexpr int TILE_B = 64 * KP * 2;
constexpr int AT_K0 = 0, AT_V0 = 2 * TILE_B;
constexpr int AT_IMP = 4 * TILE_B;
constexpr int AT_MISC = AT_IMP + 8 * 8192;
constexpr int AT_KMEAN = AT_MISC + 256;
constexpr int R2_SBUF = 0;

__device__ __forceinline__ bf16x8 lds_frag(const LAS bf16_t* tile, int row, int col) { return *(const LAS bf16x8*)(tile + row * KP + col); }
__device__ __forceinline__ s16x4 lds_tr(const LAS bf16_t* p) { return __builtin_bit_cast(s16x4, __builtin_amdgcn_ds_read_tr16_b64_v4i16((LAS v4i16_t*)p)); }
__device__ __forceinline__ bf16x8 cat8(s16x4 a, s16x4 b) { bf16x8 r; r[0] = a[0]; r[1] = a[1]; r[2] = a[2]; r[3] = a[3]; r[4] = b[0]; r[5] = b[1]; r[6] = b[2]; r[7] = b[3]; return r; }
__device__ __forceinline__ bf16x8 pack8(const f32x4& a, const f32x4& b) { u32x4 u; u.x = pk2(a.x, a.y); u.y = pk2(a.z, a.w); u.z = pk2(b.x, b.y); u.w = pk2(b.z, b.w); return __builtin_bit_cast(bf16x8, u); }

template <int NH>
__device__ __forceinline__ void qk_tile(const LAS bf16_t* Kt, const bf16x8 (&qf)[NH][2], f32x4 (&st)[NH][4], int lane) {
    const int r = lane & 15, kg = lane >> 4;
#pragma unroll
    for (int kt = 0; kt < 4; ++kt) {
        const bf16x8 k0 = lds_frag(Kt, 16 * kt + r, 8 * kg), k1 = lds_frag(Kt, 16 * kt + r, 32 + 8 * kg);
#pragma unroll
        for (int g = 0; g < NH; ++g) { f32x4 z = (f32x4){0.f, 0.f, 0.f, 0.f}; z = MFMA16(k0, qf[g][0], z); st[g][kt] = MFMA16(k1, qf[g][1], z); }
    }
}
template <int NH>
__device__ __forceinline__ void pv_tile(const LAS bf16_t* Vt, const f32x4 (&p)[NH][4], f32x4 (&o)[NH][4], int lane) {
    const int kg = lane >> 4, rr = (lane & 15) >> 2, cc = 4 * (lane & 3);
#pragma unroll
    for (int i = 0; i < 2; ++i) {
        bf16x8 pf[NH];
#pragma unroll
        for (int g = 0; g < NH; ++g) pf[g] = pack8(p[g][2 * i], p[g][2 * i + 1]);
#pragma unroll
        for (int dt = 0; dt < 4; ++dt) {
            const s16x4 lo = lds_tr(Vt + (32 * i + 4 * kg + rr) * KP + 16 * dt + cc), hi = lds_tr(Vt + (32 * i + 16 + 4 * kg + rr) * KP + 16 * dt + cc);
            const bf16x8 vf = cat8(lo, hi);
#pragma unroll
            for (int g = 0; g < NH; ++g) o[g][dt] = MFMA16(vf, pf[g], o[g][dt]);
        }
    }
}
__device__ __forceinline__ void softmax_tile(f32x4 (&st)[4], f32x4 (&o)[4], float& m, float& l, int lane) {
    float mx = -INFINITY;
#pragma unroll
    for (int kt = 0; kt < 4; ++kt) mx = fmaxf(fmaxf(mx, fmaxf(st[kt].x, st[kt].y)), fmaxf(st[kt].z, st[kt].w));
    mx = fmaxf(mx, shx(mx, 16, lane)); mx = fmaxf(mx, shx(mx, 32, lane));
    const float mn = fmaxf(m, mx), ms = (mn == -INFINITY) ? 0.f : mn;
    const float alpha = __builtin_amdgcn_exp2f(m - ms);
    float s = 0.f;
#pragma unroll
    for (int kt = 0; kt < 4; ++kt) {
        st[kt].x = __builtin_amdgcn_exp2f(st[kt].x - ms); st[kt].y = __builtin_amdgcn_exp2f(st[kt].y - ms);
        st[kt].z = __builtin_amdgcn_exp2f(st[kt].z - ms); st[kt].w = __builtin_amdgcn_exp2f(st[kt].w - ms);
        s += (st[kt].x + st[kt].y) + (st[kt].z + st[kt].w);
    }
    l = l * alpha + s; m = mn;
#pragma unroll
    for (int dt = 0; dt < 4; ++dt) o[dt] = o[dt] * alpha;
}
__device__ __forceinline__ void acc_pk(u32x2& d, const f32x4& v) {
    const float a = __uint_as_float(d.x << 16) + v.x, b = __uint_as_float(d.x & 0xffff0000u) + v.y, c = __uint_as_float(d.y << 16) + v.z, e = __uint_as_float(d.y & 0xffff0000u) + v.w;
    d.x = pk2(a, b); d.y = pk2(c, e); }
__device__ __forceinline__ u32x4 tile_load(const bf16_t* g, int tid) { const int off = (tid >> 3) * 64 + (tid & 7) * 8; return *(const u32x4*)(g + off); }
__device__ __forceinline__ void tile_store(LAS bf16_t* t, int tid, u32x4 v) { *(LAS u32x4*)(t + (tid >> 3) * KP + (tid & 7) * 8) = v; }

__device__ __forceinline__ void nsa_task(Frame& F, int b, int kvh, int J) {
    const int lane = F.lane, tid = F.tid, wv = F.wave, q = lane & 15, kg = lane >> 4;
    const int t0 = 128 * J, tw0 = t0 + 16 * wv, tq_abs = tw0 + q, cur = tw0 >> 6, tq = tq_abs & 63;
    LAS bf16_t* Kb = (LAS bf16_t*)(F.lds + AT_K0); LAS bf16_t* Vb = (LAS bf16_t*)(F.lds + AT_V0);
    LAS float* imp = (LAS float*)(F.lds + AT_IMP + wv * 8192);
    const bf16_t* kvbase = (const bf16_t*)(F.ws + WS_KV6);
    const size_t slab = (size_t)(b * 2 + kvh) * SEQ * 64;
    const bf16_t* Kcmp = (const bf16_t*)(F.ws + WS_KCMP) + (size_t)(b * 2 + kvh) * 512 * 64;
    const bf16_t* Vcmp = (const bf16_t*)(F.ws + WS_VCMP) + (size_t)(b * 2 + kvh) * 512 * 64;
    const bf16_t* Ks = kvbase + 2 * KV6_STRIDE + slab; const bf16_t* Vs = kvbase + 3 * KV6_STRIDE + slab;
    const bf16_t* Kw = kvbase + 4 * KV6_STRIDE + slab; const bf16_t* Vw = kvbase + 5 * KV6_STRIDE + slab;
    bf16x8 qf[3][2];
#pragma unroll
    for (int g = 0; g < 3; ++g) { const bf16_t* qp = (const bf16_t*)(F.ws + WS_NQ) + (((b * 6 + 3 * kvh + g) * SEQ + tq_abs) * 64 + 8 * kg);
        qf[g][0] = *(const bf16x8*)qp; qf[g][1] = *(const bf16x8*)(qp + 32); }
#define NSA_GATEP ((const float*)(F.ws + WS_GATE) + ((b * SEQ + tq_abs) * 32 + 9 * kvh))
    for (int i = lane; i < 2048; i += 64) imp[i] = 0.f;
    const int imax_blk = (t0 + 127 - 31) >> 4;
    const int ntc = (imax_blk >> 6) + 1;
    const int imax_w = (tw0 + 15 >= 31) ? ((tw0 + 15 - 31) >> 4) : -1;
    const int ivis = (tq_abs >= 31) ? ((tq_abs - 31) >> 4) : -1;
    float m[3] = {-INFINITY, -INFINITY, -INFINITY}, l[3] = {0.f, 0.f, 0.f};
    f32x4 st[3][4];
    f32x4 ob[3][4];
#pragma unroll
    for (int g = 0; g < 3; ++g)
#pragma unroll
        for (int dt = 0; dt < 4; ++dt) ob[g][dt] = (f32x4){0.f, 0.f, 0.f, 0.f};
    {
        u32x4 kr = tile_load(Kcmp, tid);
        tile_store(Kb, tid, kr); __syncthreads();
        for (int ct = 0; ct < ntc; ++ct) {
            if (ct + 1 < ntc) kr = tile_load(Kcmp + (ct + 1) * 4096, tid);
            const LAS bf16_t* Kt = Kb + (ct & 1) * (TILE_B / 2);
            if (64 * ct <= imax_w) {
                qk_tile<3>(Kt, qf, st, lane);
#pragma unroll
                for (int g = 0; g < 3; ++g) {
#pragma unroll
                    for (int kt = 0; kt < 4; ++kt)
#pragma unroll
                        for (int r = 0; r < 4; ++r) { const int i = 64 * ct + 16 * kt + 4 * kg + r; st[g][kt][r] = (i <= ivis) ? st[g][kt][r] * LOG2E : -INFINITY; }
                    softmax_tile(st[g], ob[g], m[g], l[g], lane);
                }
            }
            if (ct + 1 < ntc) tile_store(Kb + ((ct + 1) & 1) * (TILE_B / 2), tid, kr);
            __syncthreads();
        }
    }
    float msafe[3], invl[3];
#pragma unroll
    for (int g = 0; g < 3; ++g) { float lt = l[g]; lt += shx(lt, 16, lane); lt += shx(lt, 32, lane); msafe[g] = (m[g] == -INFINITY) ? 0.f : m[g]; invl[g] = 1.f / fmaxf(lt, 1e-30f); }
    {
        u32x4 kr = tile_load(Kcmp, tid), vr = tile_load(Vcmp, tid);
        tile_store(Kb, tid, kr); tile_store(Vb, tid, vr); __syncthreads();
        for (int ct = 0; ct < ntc; ++ct) {
            if (ct + 1 < ntc) { kr = tile_load(Kcmp + (ct + 1) * 4096, tid); vr = tile_load(Vcmp + (ct + 1) * 4096, tid); }
            const LAS bf16_t* Kt = Kb + (ct & 1) * (TILE_B / 2); const LAS bf16_t* Vt = Vb + (ct & 1) * (TILE_B / 2);
            if (64 * ct <= imax_w) {
                qk_tile<3>(Kt, qf, st, lane);
#pragma unroll
                for (int g = 0; g < 3; ++g)
#pragma unroll
                    for (int kt = 0; kt < 4; ++kt)
#pragma unroll
                        for (int r = 0; r < 4; ++r) { const int i = 64 * ct + 16 * kt + 4 * kg + r;
                            st[g][kt][r] = (i <= ivis) ? __builtin_amdgcn_exp2f(st[g][kt][r] * LOG2E - msafe[g]) * invl[g] : 0.f; }
#pragma unroll
                for (int kt = 0; kt < 4; ++kt) {
                    float a = 0.f, c = 0.f;
#pragma unroll
                    for (int g = 0; g < 3; ++g) { a += (st[g][kt].x + st[g][kt].y) + st[g][kt].z; c += st[g][kt].w; }
                    c *= 0.5f; a += c;
                    const float recv = __uint_as_float(__builtin_amdgcn_ds_bpermute(((lane + 48) & 63) << 2, __float_as_uint(c)));
                    const int ktp = 4 * ct + kt;
                    imp[ktp * 64 + lane] += a + (kg != 0 ? recv : 0.f);
                    if (kg == 0 && ktp + 1 < 32) imp[(ktp + 1) * 64 + lane] += recv;
                }
                pv_tile<3>(Vt, st, ob, lane);
            }
            if (ct + 1 < ntc) { tile_store(Kb + ((ct + 1) & 1) * (TILE_B / 2), tid, kr); tile_store(Vb + ((ct + 1) & 1) * (TILE_B / 2), tid, vr); }
            __syncthreads();
        }
    }
#pragma unroll
    for (int g = 0; g < 3; ++g) { const float sc = sigm(NSA_GATEP[3 * g + 0]);
#pragma unroll
        for (int dt = 0; dt < 4; ++dt) ob[g][dt] = ob[g][dt] * sc; }
    unsigned msk[4] = {0u, 0u, 0u, 0u};
    if (cur <= 15) {
        msk[0] = (cur == 31) ? 0xffffffffu : ((1u << (cur + 1)) - 1u);
    } else {
        float iv[32];
#pragma unroll
        for (int k = 0; k < 32; ++k) { const int s = 4 * k + kg; const float v = imp[k * 64 + lane]; iv[k] = (s >= 1 && s <= cur - 2) ? v : -1.f; }
        msk[0] = 1u; msk[cur >> 5] |= 1u << (cur & 31); msk[(cur - 1) >> 5] |= 1u << ((cur - 1) & 31);
        for (int it = 0; it < 13; ++it) {
            float bv = -2.f; int bs = 1 << 20;
#pragma unroll
            for (int k = 0; k < 32; ++k) { if (iv[k] > bv) { bv = iv[k]; bs = 4 * k + kg; } }
#pragma unroll
            for (int sh = 16; sh <= 32; sh <<= 1) { const float ov = shx(bv, sh, lane); const int os = shxi(bs, sh, lane); if (ov > bv || (ov == bv && os < bs)) { bv = ov; bs = os; } }
#pragma unroll
            for (int k = 0; k < 32; ++k) if (4 * k + kg == bs) iv[k] = -1.f;
#pragma unroll
            for (int wd = 0; wd < 4; ++wd) if ((bs >> 5) == wd) msk[wd] |= 1u << (bs & 31);
        }
    }
    LAS u32x2* otp = (LAS u32x2*)imp;
#pragma unroll
    for (int g = 0; g < 3; ++g)
#pragma unroll
        for (int dt = 0; dt < 4; ++dt) { u32x2 o; o.x = pk2(ob[g][dt].x, ob[g][dt].y); o.y = pk2(ob[g][dt].z, ob[g][dt].w); otp[(g * 4 + dt) * 64 + lane] = o; }
    {
#pragma unroll
        for (int g = 0; g < 3; ++g) { m[g] = -INFINITY; l[g] = 0.f;
#pragma unroll
            for (int dt = 0; dt < 4; ++dt) ob[g][dt] = (f32x4){0.f, 0.f, 0.f, 0.f}; }
        const int nb = 2 * J + 2;
        u32x4 kr = tile_load(Ks, tid), vr = tile_load(Vs, tid);
        tile_store(Kb, tid, kr); tile_store(Vb, tid, vr); __syncthreads();
        for (int s = 0; s < nb; ++s) {
            if (s + 1 < nb) { kr = tile_load(Ks + (s + 1) * 4096, tid); vr = tile_load(Vs + (s + 1) * 4096, tid); }
            const LAS bf16_t* Kt = Kb + (s & 1) * (TILE_B / 2); const LAS bf16_t* Vt = Vb + (s & 1) * (TILE_B / 2);
            const bool sel = (s <= cur) && (((s < 32) ? (msk[0] >> s) : (s < 64) ? (msk[1] >> (s - 32)) : (s < 96) ? (msk[2] >> (s - 64)) : (msk[3] >> (s - 96))) & 1u);
            if (__any(sel)) {
                qk_tile<3>(Kt, qf, st, lane);
#pragma unroll
                for (int g = 0; g < 3; ++g) {
#pragma unroll
                    for (int kt = 0; kt < 4; ++kt)
#pragma unroll
                        for (int r = 0; r < 4; ++r) { const int kk = 16 * kt + 4 * kg + r; const bool ok = sel && (s < cur || kk <= tq); st[g][kt][r] = ok ? st[g][kt][r] * LOG2E : -INFINITY; }
                    softmax_tile(st[g], ob[g], m[g], l[g], lane);
                }
                pv_tile<3>(Vt, st, ob, lane);
            }
            if (s + 1 < nb) { tile_store(Kb + ((s + 1) & 1) * (TILE_B / 2), tid, kr); tile_store(Vb + ((s + 1) & 1) * (TILE_B / 2), tid, vr); }
            __syncthreads();
        }
#pragma unroll
        for (int g = 0; g < 3; ++g) { float lt = l[g]; lt += shx(lt, 16, lane); lt += shx(lt, 32, lane); const float sc = sigm(NSA_GATEP[3 * g + 1]) / fmaxf(lt, 1e-30f);
#pragma unroll
            for (int dt = 0; dt < 4; ++dt) { u32x2 o = otp[(g * 4 + dt) * 64 + lane]; acc_pk(o, ob[g][dt] * sc); otp[(g * 4 + dt) * 64 + lane] = o; } }
    }
    {
#pragma unroll
        for (int g = 0; g < 3; ++g) { m[g] = -INFINITY; l[g] = 0.f;
#pragma unroll
            for (int dt = 0; dt < 4; ++dt) ob[g][dt] = (f32x4){0.f, 0.f, 0.f, 0.f}; }
        const int s_lo = (2 * J - 8 > 0) ? 2 * J - 8 : 0, s_hi = 2 * J + 1, nb = s_hi - s_lo + 1;
        u32x4 kr = tile_load(Kw + s_lo * 4096, tid), vr = tile_load(Vw + s_lo * 4096, tid);
        tile_store(Kb, tid, kr); tile_store(Vb, tid, vr); __syncthreads();
        for (int it = 0; it < nb; ++it) {
            const int s = s_lo + it;
            if (it + 1 < nb) { kr = tile_load(Kw + (s + 1) * 4096, tid); vr = tile_load(Vw + (s + 1) * 4096, tid); }
            const LAS bf16_t* Kt = Kb + (it & 1) * (TILE_B / 2); const LAS bf16_t* Vt = Vb + (it & 1) * (TILE_B / 2);
            if (s <= cur && s >= cur - 8) {
                qk_tile<3>(Kt, qf, st, lane);
#pragma unroll
                for (int g = 0; g < 3; ++g) {
#pragma unroll
                    for (int kt = 0; kt < 4; ++kt)
#pragma unroll
                        for (int r = 0; r < 4; ++r) { const int kk = 16 * kt + 4 * kg + r; const bool ok = (s == cur) ? (kk <= tq) : (s == cur - 8) ? (kk > tq) : true; st[g][kt][r] = ok ? st[g][kt][r] * LOG2E : -INFINITY; }
                    softmax_tile(st[g], ob[g], m[g], l[g], lane);
                }
                pv_tile<3>(Vt, st, ob, lane);
            }
            if (it + 1 < nb) { tile_store(Kb + ((it + 1) & 1) * (TILE_B / 2), tid, kr); tile_store(Vb + ((it + 1) & 1) * (TILE_B / 2), tid, vr); }
            __syncthreads();
        }
        bf16_t* mixp = (bf16_t*)(F.ws + WS_HM) + ((b * SEQ + tq_abs) * D + 3 * kvh * 64 + 4 * kg);
#pragma unroll
        for (int g = 0; g < 3; ++g) { float lt = l[g]; lt += shx(lt, 16, lane); lt += shx(lt, 32, lane); const float sc = sigm(NSA_GATEP[3 * g + 2]) / fmaxf(lt, 1e-30f);
#pragma unroll
            for (int dt = 0; dt < 4; ++dt) { u32x2 o = otp[(g * 4 + dt) * 64 + lane]; acc_pk(o, ob[g][dt] * sc); *(u32x2*)(mixp + g * 64 + 16 * dt) = o; } }
    }
}

__device__ __forceinline__ void moba_task(Frame& F, int b, int h, int own) {
    const int lane = F.lane, tid = F.tid, wv = F.wave, q = lane & 15, kg = lane >> 4;
    LAS bf16_t* Kb = (LAS bf16_t*)(F.lds + AT_K0); LAS bf16_t* Vb = (LAS bf16_t*)(F.lds + AT_V0); LAS bf16_t* Km = (LAS bf16_t*)(F.lds + AT_KMEAN);
    const size_t slab = (size_t)(b * 4 + h) * SEQ * 64;
    const bf16_t* Qg = (const bf16_t*)(F.ws + WS_MQKV) + slab; const bf16_t* Kg = Qg + MQKV_STRIDE; const bf16_t* Vg = Kg + MQKV_STRIDE;
    const int tw0 = 256 * own + 32 * wv;
    bf16x8 qf[2][2];
#pragma unroll
    for (int rt = 0; rt < 2; ++rt) { const bf16_t* qp = Qg + ((tw0 + 16 * rt + q) * 64 + 8 * kg); qf[rt][0] = *(const bf16x8*)qp; qf[rt][1] = *(const bf16x8*)(qp + 32); }
    if (tid < 256) { const u32x4 v = *(const u32x4*)((const bf16_t*)(F.ws + WS_KMEAN) + (size_t)(b * 4 + h) * 2048 + (tid >> 3) * 64 + (tid & 7) * 8); *(LAS u32x4*)(Km + (tid >> 3) * KP + (tid & 7) * 8) = v; }
    __syncthreads();
    unsigned msk[2] = {0u, 0u};
    {
        f32x4 gs[2][2];
#pragma unroll
        for (int kt = 0; kt < 2; ++kt) { const bf16x8 k0 = lds_frag(Km, 16 * kt + q, 8 * kg), k1 = lds_frag(Km, 16 * kt + q, 32 + 8 * kg);
#pragma unroll
            for (int rt = 0; rt < 2; ++rt) { f32x4 z = (f32x4){0.f, 0.f, 0.f, 0.f}; z = MFMA16(k0, qf[rt][0], z); gs[rt][kt] = MFMA16(k1, qf[rt][1], z); } }
#pragma unroll
        for (int rt = 0; rt < 2; ++rt) {
            float gv[8];
#pragma unroll
            for (int kt = 0; kt < 2; ++kt)
#pragma unroll
                for (int r = 0; r < 4; ++r) { const int blk = 16 * kt + 4 * kg + r; gv[4 * kt + r] = (blk < own) ? gs[rt][kt][r] : -INFINITY; }
            for (int it = 0; it < 3; ++it) {
                float bv = -INFINITY; int bs = 1 << 20;
#pragma unroll
                for (int k = 0; k < 8; ++k) { const int blk = 16 * (k >> 2) + 4 * kg + (k & 3); if (gv[k] > bv) { bv = gv[k]; bs = blk; } }
#pragma unroll
                for (int sh = 16; sh <= 32; sh <<= 1) { const float ov = shx(bv, sh, lane); const int os = shxi(bs, sh, lane); if (ov > bv || (ov == bv && os < bs)) { bv = ov; bs = os; } }
                if (bs < 32) { msk[rt] |= 1u << bs;
#pragma unroll
                    for (int k = 0; k < 8; ++k) if (16 * (k >> 2) + 4 * kg + (k & 3) == bs) gv[k] = -INFINITY; }
            }
        }
    }
    float m[2] = {-INFINITY, -INFINITY}, l[2] = {0.f, 0.f};
    f32x4 ob[2][4], st[2][4];
#pragma unroll
    for (int rt = 0; rt < 2; ++rt)
#pragma unroll
        for (int dt = 0; dt < 4; ++dt) ob[rt][dt] = (f32x4){0.f, 0.f, 0.f, 0.f};
    const int ntile = 4 * own + 4;
    u32x4 kr = tile_load(Kg, tid), vr = tile_load(Vg, tid);
    tile_store(Kb, tid, kr); tile_store(Vb, tid, vr); __syncthreads();
    for (int tau = 0; tau < ntile; ++tau) {
        if (tau + 1 < ntile) { kr = tile_load(Kg + (tau + 1) * 4096, tid); vr = tile_load(Vg + (tau + 1) * 4096, tid); }
        const LAS bf16_t* Kt = Kb + (tau & 1) * (TILE_B / 2); const LAS bf16_t* Vt = Vb + (tau & 1) * (TILE_B / 2);
        const int blk = tau >> 2;
        bool sel[2]; bool anyv = false;
#pragma unroll
        for (int rt = 0; rt < 2; ++rt) { sel[rt] = (blk < own) ? ((msk[rt] >> blk) & 1u) : (64 * (tau & 3) <= 32 * wv + 16 * rt + q); anyv = anyv || sel[rt]; }
        if (__any(anyv)) {
            qk_tile<2>(Kt, qf, st, lane);
#pragma unroll
            for (int rt = 0; rt < 2; ++rt) {
                const int trel = 32 * wv + 16 * rt + q;
#pragma unroll
                for (int kt = 0; kt < 4; ++kt)
#pragma unroll
                    for (int r = 0; r < 4; ++r) { const int kk = 64 * (tau & 3) + 16 * kt + 4 * kg + r; const bool ok = (blk < own) ? sel[rt] : (kk <= trel); st[rt][kt][r] = ok ? st[rt][kt][r] * LOG2E : -INFINITY; }
                softmax_tile(st[rt], ob[rt], m[rt], l[rt], lane);
            }
            pv_tile<2>(Vt, st, ob, lane);
        }
        if (tau + 1 < ntile) { tile_store(Kb + ((tau + 1) & 1) * (TILE_B / 2), tid, kr); tile_store(Vb + ((tau + 1) & 1) * (TILE_B / 2), tid, vr); }
        __syncthreads();
    }
#pragma unroll
    for (int rt = 0; rt < 2; ++rt) {
        float lt = l[rt]; lt += shx(lt, 16, lane); lt += shx(lt, 32, lane); const float sc = 1.f / fmaxf(lt, 1e-30f);
        bf16_t* mix = (bf16_t*)(F.ws + WS_HM) + ((b * SEQ + tw0 + 16 * rt + q) * D + 384 + h * 64 + 4 * kg);
#pragma unroll
        for (int dt = 0; dt < 4; ++dt) { const f32x4 v = ob[rt][dt] * sc; u32x2 o; o.x = pk2(v.x, v.y); o.y = pk2(v.z, v.w); *(u32x2*)(mix + 16 * dt) = o; }
    }
}

__device__ __forceinline__ void r2_wave(Frame& F, int widx) {
    const int chain = widx >> 1, half = widx & 1, lane = F.lane, c31 = lane & 31, hi = lane >> 5;
    LAS bf16_t* sb = (LAS bf16_t*)(F.lds + R2_SBUF + F.wave * (32 * KP * 2));
    for (int i = lane; i < 32 * KP / 2; i += 64) ((LAS unsigned*)sb)[i] = 0u;
    const bf16_t* PT = (const bf16_t*)(F.ws + WS_PT) + (size_t)chain * 128 * 4096;
    bf16_t* ZS = (bf16_t*)(F.ws + WS_ZS) + (size_t)chain * 128 * 4096;
    for (int c = 0; c < 128; ++c) {
        const bf16_t* pt = PT + (size_t)c * 4096; bf16_t* zs = ZS + (size_t)c * 4096 + (size_t)(32 * half) * 64;
        f32x16 acc[2];
#pragma unroll
        for (int nt = 0; nt < 2; ++nt)
#pragma unroll
            for (int r = 0; r < 16; ++r) acc[nt][r] = bf2f(zs[((r & 3) + 8 * (r >> 2) + 4 * hi) * 64 + 32 * nt + c31]);
        bf16x8 bfr[2][4];
#pragma unroll
        for (int nt = 0; nt < 2; ++nt)
#pragma unroll
            for (int ks = 0; ks < 4; ++ks) bfr[nt][ks] = *(const bf16x8*)(pt + (32 * nt + c31) * 64 + 16 * ks + 8 * hi);
        LDS_WAIT();
#pragma unroll
        for (int ks = 0; ks < 4; ++ks) {
            const bf16x8 a = *(const LAS bf16x8*)(sb + c31 * KP + 16 * ks + 8 * hi);
#pragma unroll
            for (int nt = 0; nt < 2; ++nt) acc[nt] = MFMA32(a, bfr[nt][ks], acc[nt]);
        }
#pragma unroll
        for (int nt = 0; nt < 2; ++nt)
#pragma unroll
            for (int r = 0; r < 16; ++r) sb[((r & 3) + 8 * (r >> 2) + 4 * hi) * KP + 32 * nt + c31] = f2bf(acc[nt][r]);
        LDS_WAIT();
#pragma unroll
        for (int j = 0; j < 4; ++j) { const int qd = lane + 64 * j, row = qd >> 3, ch = qd & 7; *(u32x4*)(zs + row * 64 + ch * 8) = *(const LAS u32x4*)(sb + row * KP + ch * 8); }
    }
}

struct TaskTable { unsigned short v[512]; };
constexpr TaskTable make_tasks() {
    TaskTable t{}; int n = 0, a = 63, am = 0, c = 31, cm = 0;
    while (a >= 0 || c >= 0) {
        const int ca = (a >= 0) ? 96 * a + 1344 : -1, cc = (c >= 0) ? 128 * c + 128 : -1;
        if (ca >= cc) { t.v[n++] = (unsigned short)(0 * 512 + am * 64 + a); if (++am == 4) { am = 0; --a; } }
        else { t.v[n++] = (unsigned short)(1 * 512 + cm * 64 + c); if (++cm == 8) { cm = 0; --c; } }
    }
    return t;
}
__device__ const TaskTable g_tasks = make_tasks();

__device__ __forceinline__ void phase_d(Frame& F, int layer) {
    if (F.bid < 3) { r2_wave(F, F.bid * 8 + F.wave); __syncthreads(); }
    LAUNDER(F);
    volatile LAS int* tw = (volatile LAS int*)(F.lds + AT_MISC);
    unsigned* qh = F.ctl + CW_Q + 64 * layer;
    for (;;) {
        if (F.tid == 0) tw[0] = (int)__hip_atomic_fetch_add(qh, 1u, RLX_AGENT);
        __syncthreads();
        const int k = __builtin_amdgcn_readfirstlane(tw[0]);
        __syncthreads();
        if (k >= 512) break;
        const int code = g_tasks.v[k], ty = code >> 9, mm = (code >> 6) & 7, jj = code & 63;
        LAUNDER(F);
        if (ty == 0) nsa_task(F, mm >> 1, mm & 1, jj); else moba_task(F, mm >> 2, mm & 3, jj);
    }
}

__device__ __forceinline__ void r3_task(Frame& F, int layer, int task) {
    const int chain = task >> 7, c = task & 127, b = chain / 6, h = chain % 6, lane = F.lane, c31 = lane & 31, hi = lane >> 5;
    const bf16_t* S0 = (const bf16_t*)(F.ws + WS_ZS) + (size_t)(task - 1) * 4096;
    const bf16_t* YT = (const bf16_t*)(F.ws + WS_YT) + (size_t)task * 4096;
    const bf16_t* Y0 = (const bf16_t*)(F.ws + WS_Y0) + (size_t)task * 4096;
    const bf16_t* rf = (const bf16_t*)(F.ws + WS_RFEAT);
    const bf16_t* gut = (const bf16_t*)(F.ws + WS_GUPT) + (size_t)(h * 64) * 128;
    const float* mu = INF(F, I_MU) + layer * RW;
    f32x16 acc[2][2], gacc[2][2];
#pragma unroll
    for (int a = 0; a < 2; ++a)
#pragma unroll
        for (int n = 0; n < 2; ++n)
#pragma unroll
            for (int r = 0; r < 16; ++r) { acc[a][n][r] = 0.f; gacc[a][n][r] = 0.f; }
    if (c > 0) {
#pragma unroll
        for (int ks = 0; ks < 4; ++ks) {
            bf16x8 af[2], bfr[2];
#pragma unroll
            for (int mt = 0; mt < 2; ++mt) af[mt] = *(const bf16x8*)(S0 + (32 * mt + c31) * 64 + 16 * ks + 8 * hi);
#pragma unroll
            for (int nt = 0; nt < 2; ++nt) bfr[nt] = *(const bf16x8*)(YT + (32 * nt + c31) * 64 + 16 * ks + 8 * hi);
#pragma unroll
            for (int mt = 0; mt < 2; ++mt)
#pragma unroll
                for (int nt = 0; nt < 2; ++nt) acc[mt][nt] = MFMA32(af[mt], bfr[nt], acc[mt][nt]);
        }
    }
#pragma unroll
    for (int ks = 0; ks < 8; ++ks) {
        bf16x8 af[2], bfr[2];
#pragma unroll
        for (int mt = 0; mt < 2; ++mt) af[mt] = *(const bf16x8*)(gut + (32 * mt + c31) * 128 + 16 * ks + 8 * hi);
#pragma unroll
        for (int nt = 0; nt < 2; ++nt) {
            const int t = 64 * c + 32 * nt + c31, j0 = 16 * ks + 8 * hi; const size_t row = (size_t)b * SEQ + t;
            const u32x4 cu = *(const u32x4*)(rf + row * RW + 1280 + j0);
            u32x4 pv = (u32x4){0u, 0u, 0u, 0u}; if (t > 0) pv = *(const u32x4*)(rf + (row - 1) * RW + 1280 + j0);
            const f32x4 m0 = *(const f32x4*)(mu + 1280 + j0), m1 = *(const f32x4*)(mu + 1280 + j0 + 4);
            float cv[8], pw[8];
            cv[0] = __uint_as_float(cu.x << 16); cv[1] = __uint_as_float(cu.x & 0xffff0000u); cv[2] = __uint_as_float(cu.y << 16); cv[3] = __uint_as_float(cu.y & 0xffff0000u);
            cv[4] = __uint_as_float(cu.z << 16); cv[5] = __uint_as_float(cu.z & 0xffff0000u); cv[6] = __uint_as_float(cu.w << 16); cv[7] = __uint_as_float(cu.w & 0xffff0000u);
            pw[0] = __uint_as_float(pv.x << 16); pw[1] = __uint_as_float(pv.x & 0xffff0000u); pw[2] = __uint_as_float(pv.y << 16); pw[3] = __uint_as_float(pv.y & 0xffff0000u);
            pw[4] = __uint_as_float(pv.z << 16); pw[5] = __uint_as_float(pv.z & 0xffff0000u); pw[6] = __uint_as_float(pv.w << 16); pw[7] = __uint_as_float(pv.w & 0xffff0000u);
            const float mm[8] = {m0.x, m0.y, m0.z, m0.w, m1.x, m1.y, m1.z, m1.w};
            float sg[8];
#pragma unroll
            for (int k = 0; k < 8; ++k) sg[k] = sigm(cv[k] + (pw[k] - cv[k]) * mm[k]);
            u32x4 u; u.x = pk2(sg[0], sg[1]); u.y = pk2(sg[2], sg[3]); u.z = pk2(sg[4], sg[5]); u.w = pk2(sg[6], sg[7]);
            bfr[nt] = __builtin_bit_cast(bf16x8, u);
        }
#pragma unroll
        for (int mt = 0; mt < 2; ++mt)
#pragma unroll
            for (int nt = 0; nt < 2; ++nt) gacc[mt][nt] = MFMA32(af[mt], bfr[nt], gacc[mt][nt]);
    }
    const float* lnw = INF(F, I_LNW) + layer * 384 + h * 64; const float* lnb = INF(F, I_LNB) + layer * 384 + h * 64;
    const float* bonus = (const float*)(F.ws + WS_BONUS);
    bf16_t* mix = (bf16_t*)(F.ws + WS_HM);
#pragma unroll
    for (int nt = 0; nt < 2; ++nt) {
        const int tl = 32 * nt + c31, t = 64 * c + tl; const size_t row = (size_t)b * SEQ + t;
        float s = 0.f;
#pragma unroll
        for (int mt = 0; mt < 2; ++mt)
#pragma unroll
            for (int rq = 0; rq < 4; ++rq) {
                const u32x2 y = *(const u32x2*)(Y0 + tl * 64 + 32 * mt + 8 * rq + 4 * hi);
                acc[mt][nt][4 * rq + 0] += __uint_as_float(y.x << 16); acc[mt][nt][4 * rq + 1] += __uint_as_float(y.x & 0xffff0000u);
                acc[mt][nt][4 * rq + 2] += __uint_as_float(y.y << 16); acc[mt][nt][4 * rq + 3] += __uint_as_float(y.y & 0xffff0000u);
                s += (acc[mt][nt][4 * rq] + acc[mt][nt][4 * rq + 1]) + (acc[mt][nt][4 * rq + 2] + acc[mt][nt][4 * rq + 3]);
            }
        s += shx(s, 32, lane);
        const float mean = s * (1.f / 64.f);
        float vs = 0.f;
#pragma unroll
        for (int mt = 0; mt < 2; ++mt)
#pragma unroll
            for (int r = 0; r < 16; ++r) { const float d = acc[mt][nt][r] - mean; vs += d * d; }
        vs += shx(vs, 32, lane);
        const float rstd = rsqrtf(vs * (1.f / 64.f) + 64e-5f);
        const float bn = bonus[row * 8 + h];
#pragma unroll
        for (int mt = 0; mt < 2; ++mt)
#pragma unroll
            for (int rq = 0; rq < 4; ++rq) {
                const int v0 = 32 * mt + 8 * rq + 4 * hi;
                const u32x2 vc = *(const u32x2*)(rf + row * RW + 768 + h * 64 + v0);
                u32x2 vp = (u32x2){0u, 0u}; if (t > 0) vp = *(const u32x2*)(rf + (row - 1) * RW + 768 + h * 64 + v0);
                const f32x4 mv = *(const f32x4*)(mu + 768 + h * 64 + v0), lw = *(const f32x4*)(lnw + v0), lb = *(const f32x4*)(lnb + v0);
                const float vcur[4] = {__uint_as_float(vc.x << 16), __uint_as_float(vc.x & 0xffff0000u), __uint_as_float(vc.y << 16), __uint_as_float(vc.y & 0xffff0000u)};
                const float vprv[4] = {__uint_as_float(vp.x << 16), __uint_as_float(vp.x & 0xffff0000u), __uint_as_float(vp.y << 16), __uint_as_float(vp.y & 0xffff0000u)};
                const float mvv[4] = {mv.x, mv.y, mv.z, mv.w}, lwv[4] = {lw.x, lw.y, lw.z, lw.w}, lbv[4] = {lb.x, lb.y, lb.z, lb.w};
                float o[4];
#pragma unroll
                for (int k = 0; k < 4; ++k) {
                    const float vsh = vcur[k] + (vprv[k] - vcur[k]) * mvv[k];
                    const float y = (acc[mt][nt][4 * rq + k] - mean) * rstd * lwv[k] + lbv[k];
                    o[k] = (y + bn * vsh) * gacc[mt][nt][4 * rq + k];
                }
                u32x2 ov; ov.x = pk2(o[0], o[1]); ov.y = pk2(o[2], o[3]);
                *(u32x2*)(mix + row * D + 640 + h * 64 + v0) = ov;
            }
    }
}
__device__ __forceinline__ void mixnorm_rows(Frame& F, int layer) {
    bf16_t* mix = (bf16_t*)(F.ws + WS_HM);
    const float* gn = INF(F, I_NNSA) + layer * 384; const float* gm = INF(F, I_NMOBA) + layer * 256;
    const int gw = F.bid * NWAVES + F.wave, NGW = F.G * NWAVES, lane = F.lane;
    for (int m = gw; m < T; m += NGW) {
        unsigned* rowp = (unsigned*)(mix + (size_t)m * D);
        unsigned a[3], c[2]; float sa = 0.f, sc = 0.f;
#pragma unroll
        for (int j = 0; j < 3; ++j) { a[j] = rowp[lane + 64 * j]; const float x = __uint_as_float(a[j] << 16), y = __uint_as_float(a[j] & 0xffff0000u); sa += x * x + y * y; }
#pragma unroll
        for (int j = 0; j < 2; ++j) { c[j] = rowp[192 + lane + 64 * j]; const float x = __uint_as_float(c[j] << 16), y = __uint_as_float(c[j] & 0xffff0000u); sc += x * x + y * y; }
        const float ra = rsqrtf(wave_sum(sa, lane) * (1.f / 384.f) + NORM_EPS), rc = rsqrtf(wave_sum(sc, lane) * (1.f / 256.f) + NORM_EPS);
#pragma unroll
        for (int j = 0; j < 3; ++j) { const int col = 2 * (lane + 64 * j); rowp[lane + 64 * j] = pk2(__uint_as_float(a[j] << 16) * ra * gn[col], __uint_as_float(a[j] & 0xffff0000u) * ra * gn[col + 1]); }
#pragma unroll
        for (int j = 0; j < 2; ++j) { const int col = 2 * (lane + 64 * j); rowp[192 + lane + 64 * j] = pk2(__uint_as_float(c[j] << 16) * rc * gm[col], __uint_as_float(c[j] & 0xffff0000u) * rc * gm[col + 1]); }
    }
}
__device__ __forceinline__ void phase_e(Frame& F, int layer) {
    const int gw = F.bid * NWAVES + F.wave, NGW = F.G * NWAVES;
    for (int task = gw; task < 1536; task += NGW) r3_task(F, layer, task);
    LAUNDER(F);
    mixnorm_rows(F, layer);
}

__device__ __forceinline__ void phase_g1(Frame& F, int layer) {
    LAS float* wr = (LAS float*)F.lds;
    { const float* W = INF(F, I_WROUTER); for (int i = F.tid; i < 4096; i += NTHR) *(LAS f32x4*)(wr + 4 * i) = *(const f32x4*)(W + 4 * i); }
    __syncthreads();
    const float* mod = (const float*)(F.ws + WS_MOD);
    bf16_t* H = (bf16_t*)(F.ws + WS_HM);
    int* route = (int*)(F.ws + WS_ROUTE);
    unsigned* cnt = F.ctl + CW_CNT + 64 * layer;
    const float* rb = INF(F, I_RBIAS);
    const float* gn = INF(F, I_NFFN) + layer * D;
    const int gw = F.bid * NWAVES + F.wave, NGW = F.G * NWAVES;
    for (int m = gw; m < T; m += NGW) {
        int lane = F.lane; asm volatile("" : "+v"(lane));
        const int b = m >> 13;
        const float* sh = mod + ((size_t)layer * BATCH + b) * 6144 + 3072; const float* sc = sh + 1024;
        f32x4 v[4]; float ss = 0.f;
#pragma unroll
        for (int j = 0; j < 4; ++j) { v[j] = *(const f32x4*)(F.out + (size_t)m * D + 4 * lane + 256 * j); ss += (v[j].x * v[j].x + v[j].y * v[j].y) + (v[j].z * v[j].z + v[j].w * v[j].w); }
        const float rstd = rsqrtf(wave_sum(ss, lane) * (1.f / D) + NORM_EPS);
        float lg[16];
#pragma unroll
        for (int e = 0; e < 16; ++e) lg[e] = 0.f;
#pragma unroll
        for (int j = 0; j < 4; ++j) { const int col = 4 * lane + 256 * j;
            const f32x4 g = *(const f32x4*)(gn + col), s1 = *(const f32x4*)(sc + col), s0 = *(const f32x4*)(sh + col);
            const float hx = v[j].x * rstd * g.x * (1.f + s1.x) + s0.x, hy = v[j].y * rstd * g.y * (1.f + s1.y) + s0.y, hz = v[j].z * rstd * g.z * (1.f + s1.z) + s0.z, hw = v[j].w * rstd * g.w * (1.f + s1.w) + s0.w;
            u32x2 o; o.x = pk2(hx, hy); o.y = pk2(hz, hw); *(u32x2*)(H + (size_t)m * D + col) = o;
            const float hh[4] = {hx, hy, hz, hw};
#pragma unroll
            for (int k = 0; k < 4; ++k) {
                const LAS f32x4* wp = (const LAS f32x4*)(wr + (col + k) * 16);
                const f32x4 w0 = wp[0], w1 = wp[1], w2 = wp[2], w3 = wp[3];
                lg[0] += hh[k] * w0.x; lg[1] += hh[k] * w0.y; lg[2] += hh[k] * w0.z; lg[3] += hh[k] * w0.w; lg[4] += hh[k] * w1.x; lg[5] += hh[k] * w1.y; lg[6] += hh[k] * w1.z; lg[7] += hh[k] * w1.w;
                lg[8] += hh[k] * w2.x; lg[9] += hh[k] * w2.y; lg[10] += hh[k] * w2.z; lg[11] += hh[k] * w2.w; lg[12] += hh[k] * w3.x; lg[13] += hh[k] * w3.y; lg[14] += hh[k] * w3.z; lg[15] += hh[k] * w3.w;
            } }
        float aff[16], bia[16];
#pragma unroll
        for (int e = 0; e < 16; ++e) { aff[e] = sigm(wave_sum(lg[e], lane)); bia[e] = aff[e] + rb[e]; }
        int best = 0; float bscore = -INFINITY;
#pragma unroll
        for (int g = 0; g < 4; ++g) {
            float t1 = -INFINITY, t2 = -INFINITY;
#pragma unroll
            for (int k = 0; k < 4; ++k) { const float x = bia[4 * g + k]; if (x > t1) { t2 = t1; t1 = x; } else if (x > t2) t2 = x; }
            const float gs = t1 + t2; if (gs > bscore) { bscore = gs; best = g; }
        }
        float x4[4], a4[4];
#pragma unroll
        for (int k = 0; k < 4; ++k) { x4[k] = (best == 0) ? bia[k] : (best == 1) ? bia[4 + k] : (best == 2) ? bia[8 + k] : bia[12 + k]; a4[k] = (best == 0) ? aff[k] : (best == 1) ? aff[4 + k] : (best == 2) ? aff[8 + k] : aff[12 + k]; }
        int i1 = 0; float v1 = x4[0];
#pragma unroll
        for (int k = 1; k < 4; ++k) if (x4[k] > v1) { v1 = x4[k]; i1 = k; }
        int i2 = -1; float v2 = -INFINITY;
#pragma unroll
        for (int k = 0; k < 4; ++k) if (k != i1 && x4[k] > v2) { v2 = x4[k]; i2 = k; }
        float w1 = 0.f, w2 = 0.f;
#pragma unroll
        for (int k = 0; k < 4; ++k) { if (k == i1) w1 = a4[k]; if (k == i2) w2 = a4[k]; }
        const float ws = w1 + w2; w1 /= ws; w2 /= ws;
        if (lane == 0) {
            const int e1 = 4 * best + i1, e2 = 4 * best + i2;
            const int p1 = (int)__hip_atomic_fetch_add(cnt + e1, 1u, RLX_AGENT), p2 = (int)__hip_atomic_fetch_add(cnt + e2, 1u, RLX_AGENT);
            int* rp = route + (size_t)m * 8; rp[0] = e1; rp[1] = e2; rp[2] = p1; rp[3] = p2; rp[4] = __float_as_int(w1); rp[5] = __float_as_int(w2);
        }
    }
}
__device__ __forceinline__ void phase_g2(Frame& F, int layer) {
    volatile LAS int* off = (volatile LAS int*)F.lds;
    unsigned* cnt = F.ctl + CW_CNT + 64 * layer;
    int* rowinfo = (int*)(F.ws + WS_ROWINFO + layer * ROWINFO_LSTRIDE); float* roww = (float*)(rowinfo + MAXROWS); int* tile_e = rowinfo + 2 * MAXROWS; int* ntl = tile_e + 256;
    if (F.tid == 0) { int o = 0; for (int e = 0; e < 16; ++e) { off[e] = o; const int c = (int)__hip_atomic_load(cnt + e, RLX_AGENT); o += ((c + 255) >> 8) << 8; } off[16] = o; }
    __syncthreads();
    if (F.bid == 0) {
        if (F.tid == 0) ntl[0] = off[16] >> 8;
        for (int e = 0; e < 16; ++e) {
            const int c = (int)__hip_atomic_load(cnt + e, RLX_AGENT), o0 = off[e], o1 = off[e + 1];
            for (int r = o0 + c + F.tid; r < o1; r += NTHR) { rowinfo[r] = -1; roww[r] = 0.f; }
            for (int tl = (o0 >> 8) + F.tid; tl < (o1 >> 8); tl += NTHR) tile_e[tl] = e;
        }
    }
    const int* route = (const int*)(F.ws + WS_ROUTE);
    const bf16_t* H = (const bf16_t*)(F.ws + WS_HM);
    bf16_t* SA = (bf16_t*)(F.ws + WS_SORTA);
    const int gw = F.bid * NWAVES + F.wave, NGW = F.G * NWAVES, lane = F.lane;
    for (int m = gw; m < T; m += NGW) {
        const int* rp = route + (size_t)m * 8;
        const int e1 = ld_ctl(rp), e2 = ld_ctl(rp + 1), p1 = ld_ctl(rp + 2), p2 = ld_ctl(rp + 3);
        const int r1 = off[e1] + p1, r2 = off[e2] + p2;
        const u32x4 a = *(const u32x4*)(H + (size_t)m * D + 8 * lane), c = *(const u32x4*)(H + (size_t)m * D + 512 + 8 * lane);
        *(u32x4*)(SA + (size_t)r1 * D + 8 * lane) = a; *(u32x4*)(SA + (size_t)r1 * D + 512 + 8 * lane) = c;
        *(u32x4*)(SA + (size_t)r2 * D + 8 * lane) = a; *(u32x4*)(SA + (size_t)r2 * D + 512 + 8 * lane) = c;
        if (lane == 0) { rowinfo[r1] = 2 * m; rowinfo[r2] = 2 * m + 1; roww[r1] = __int_as_float(ld_ctl(rp + 4)); roww[r2] = __int_as_float(ld_ctl(rp + 5)); }
    }
}

#if DBG_MODE == 2
__device__ __forceinline__ void dbg_flag(Frame& F, bool bad, unsigned code) { if (__any(bad) && F.lane == 0) atomicCAS(F.ctl + CW_DBG, 0u, code); }
__device__ __forceinline__ void scan_bf16(Frame& F, size_t off, size_t n, unsigned code) {
    const unsigned* p = (const unsigned*)(F.ws + off); bool bad = false;
    for (size_t i = (size_t)F.bid * NTHR + F.tid; i < n / 2; i += (size_t)F.G * NTHR) { const unsigned u = p[i]; bad = bad || ((u & 0x7f80u) == 0x7f80u) || ((u & 0x7f800000u) == 0x7f800000u); }
    dbg_flag(F, bad, code); }
__device__ __forceinline__ void scan_f32p(Frame& F, const float* p, size_t n, unsigned code) {
    bool bad = false;
    for (size_t i = (size_t)F.bid * NTHR + F.tid; i < n; i += (size_t)F.G * NTHR) { const unsigned u = __float_as_uint(p[i]); bad = bad || ((u & 0x7f800000u) == 0x7f800000u); }
    dbg_flag(F, bad, code); }
__device__ __forceinline__ void dbg_check(Frame& F, int p) {
    const unsigned code = (unsigned)(p + 1);
    if (DBG_SUB >= 4) {
        if (p != DBG_P) return;
        const size_t off = (DBG_SUB == 4) ? WS_ZS : (DBG_SUB == 5) ? WS_PT : (DBG_SUB == 6) ? WS_YT : WS_Y0;
        const unsigned* q = (const unsigned*)(F.ws + off); unsigned mx = 0;
        for (size_t i = (size_t)F.bid * NTHR + F.tid; i < (size_t)1536 * 2048; i += (size_t)F.G * NTHR) { const unsigned u = q[i]; const unsigned e0 = (u >> 7) & 0xffu, e1 = (u >> 23) & 0xffu; mx = mx > e0 ? mx : e0; mx = mx > e1 ? mx : e1; }
#if DBG_CNT
        { unsigned cnt = 0; for (size_t i = (size_t)F.bid * NTHR + F.tid; i < (size_t)1536 * 2048; i += (size_t)F.G * NTHR) { const unsigned u = q[i]; cnt += (((u >> 7) & 0xffu) == 0xffu) + (((u >> 23) & 0xffu) == 0xffu); }
          if (cnt) atomicAdd(F.ctl + CW_DBG, cnt); return; }
#endif
        atomicMax(F.ctl + CW_DBG, mx); return; }
    if (DBG_SUB == 3 && p != 4) return;
    if (p == 0) { scan_f32p(F, (const float*)(F.ws + WS_COS), (size_t)T * 64, code); scan_f32p(F, (const float*)(F.ws + WS_MOD), 2 * 2 * 6144, code); return; }
    if (p > 10 * NL) return;
    const int sub = (p - 1) % 10;
    switch (sub) {
    case 0: scan_bf16(F, WS_HM, (size_t)T * D, code); scan_bf16(F, WS_WIN, (size_t)NPAD * D, code); scan_bf16(F, WS_WOUT, (size_t)D * D, code); scan_bf16(F, WS_WUP, (size_t)16 * 512 * D, code);
            scan_bf16(F, WS_WDN, (size_t)16 * D * 256, code); scan_bf16(F, WS_PHIW, (size_t)2 * 64 * 2048, code); scan_bf16(F, WS_GUPT, 384 * 128, code); scan_f32p(F, (const float*)(F.ws + WS_PHIB), 256, code); break;
    case 1: scan_bf16(F, WS_NQ, (size_t)T * 384, code); scan_bf16(F, WS_KV6, (size_t)6 * T * 128, code); scan_bf16(F, WS_MQKV, (size_t)3 * T * 256, code); scan_bf16(F, WS_RFEAT, (size_t)T * RW, code);
            scan_f32p(F, (const float*)(F.ws + WS_GATE), (size_t)T * 32, code); break;
    case 2: scan_bf16(F, WS_KCMP, 2 * 2 * 512 * 64, code); scan_bf16(F, WS_VCMP, 2 * 2 * 512 * 64, code); scan_bf16(F, WS_KMEAN, 2 * 4 * 32 * 64, code);
            scan_bf16(F, WS_PT, (size_t)1536 * 4096, code); scan_bf16(F, WS_ZS, (size_t)1536 * 4096, code); scan_bf16(F, WS_YT, (size_t)1536 * 4096, code); scan_bf16(F, WS_Y0, (size_t)1536 * 4096, code);
            scan_f32p(F, (const float*)(F.ws + WS_BONUS), (size_t)T * 8, code); break;
    case 3: {
#if DBG_SUB == 3
        if (p == 4) { const unsigned* hm = (const unsigned*)(F.ws + WS_HM); bool b1 = false, b2 = false, b4 = false;
            for (size_t i = (size_t)F.bid * NTHR + F.tid; i < (size_t)T * 512; i += (size_t)F.G * NTHR) { const unsigned u = hm[i]; const int col = (int)(i & 511) * 2; const bool bad = ((u & 0x7f80u) == 0x7f80u) || ((u & 0x7f800000u) == 0x7f800000u);
                if (col < 384) b1 = b1 || bad; else if (col < 640) b2 = b2 || bad; }
            const unsigned* zs = (const unsigned*)(F.ws + WS_ZS);
            for (size_t i = (size_t)F.bid * NTHR + F.tid; i < (size_t)1536 * 2048; i += (size_t)F.G * NTHR) { const unsigned u = zs[i]; b4 = b4 || ((u & 0x7f80u) == 0x7f80u) || ((u & 0x7f800000u) == 0x7f800000u); }
            const unsigned bits = (__any(b1) ? 1u : 0u) | (__any(b2) ? 2u : 0u) | (__any(b4) ? 4u : 0u);
            if (bits && F.lane == 0) atomicOr(F.ctl + CW_DBG, bits); }
#else
        scan_bf16(F, WS_HM, (size_t)T * D, code); scan_bf16(F, WS_ZS, (size_t)1536 * 4096, code);
#endif
        } break;
    case 4: scan_bf16(F, WS_HM, (size_t)T * D, code); break;
    case 5: scan_f32p(F, F.out, (size_t)T * D, code); break;
    case 6: scan_bf16(F, WS_HM, (size_t)T * D, code); break;
    case 7: scan_bf16(F, WS_SORTA, (size_t)MAXROWS * D, code); break;
    case 8: scan_bf16(F, WS_HID, (size_t)MAXROWS * 256, code); break;
    case 9: scan_bf16(F, WS_YS, (size_t)2 * T * D, code); break;
    }
}
#endif
struct Args { const void* in[31]; float* out; unsigned char* ws; int ph_lo, ph_hi; };
constexpr int N_PHASES = 2 + 10 * NL + (DBG_MODE ? 1 : 0);

__global__ void __launch_bounds__(NTHR, 2) hybrid_fwd(Args args) {
    extern __shared__ __attribute__((aligned(16))) unsigned char lds_raw[];
    Frame F;
    F.lds = (LAS unsigned char*)lds_raw;
    F.MISC = (volatile LAS unsigned*)(F.lds + MISC_OFF);
    F.tid = threadIdx.x; F.lane = F.tid & 63; F.wave = __builtin_amdgcn_readfirstlane(F.tid >> 6);
    F.G = gridDim.x; F.bid = blockIdx.x;
    F.ws = args.ws; F.out = args.out; F.ctl = (unsigned*)(args.ws + WS_CTL);
    for (int u = F.tid; u < (LDS_BYTES - RING_BYTES) / 4; u += NTHR) ((LAS unsigned*)(F.lds + RING_BYTES))[u] = 0u;
    __syncthreads();
    if (F.tid < 31) *(LAS unsigned long long*)(F.lds + IN_OFF + 8 * F.tid) = (unsigned long long)args.in[F.tid];
    __syncthreads();
#if MK_PER_PHASE
#define GRID_BAR() do { } while (0)
#else
    XcdBarrier bar = xcd_barrier_post(F.ctl + CW_BAR, F.MISC + 8);
#define GRID_BAR() do { LAUNDER(F); xcd_barrier(bar, F.tid); } while (0)
#endif
    const int lo = args.ph_lo, hi = args.ph_hi;
    for (int ph_ = lo; ph_ < hi; ++ph_) {
        int ph = ph_; asm volatile("" : "+s"(ph));
#if DBG_MODE == 2
        if (ph > 0) { LAUNDER(F); dbg_check(F, ph - 1); }
#endif
        if (ph == 0) { if (PH_EN(10)) { LAUNDER(F); phase_pro(F); } }
#if DBG_MODE
        else if (ph == N_PHASES - 1) { LAUNDER(F); const float dv = sqrtf((float)ld_ctl((const int*)(F.ctl + CW_DBG)));
            for (int i = F.bid * NTHR + F.tid; i < T * D; i += F.G * NTHR) F.out[i] = dv; }
        else if (ph == N_PHASES - 2) { if (PH_EN(11)) { LAUNDER(F); norm_rows(F, 0, true); } }
#else
        else if (ph == N_PHASES - 1) { if (PH_EN(11)) { LAUNDER(F); norm_rows(F, 0, true); } }
#endif
        else {
            const int layer = (ph - 1) / 10, sub = (ph - 1) % 10;
            switch (sub) {
            case 0: if (PH_EN(0)) { LAUNDER(F); phase_a(F, layer); } break;
            case 1: if (PH_EN(1)) { LAUNDER(F); pg8::Gemm g{(const bf16_t*)(F.ws + WS_HM), (const bf16_t*)(F.ws + WS_WIN), T, NPAD, D}; pg8::StaticOrder S; S.init(T, NPAD, F.G, F.bid);
                      EpiInProj E{(bf16_t*)(F.ws + WS_NQ), (bf16_t*)(F.ws + WS_KV6), (bf16_t*)(F.ws + WS_MQKV), (bf16_t*)(F.ws + WS_RFEAT), (float*)(F.ws + WS_GATE), (const float*)(F.ws + WS_COS), (const float*)(F.ws + WS_SIN)};
                      pg8::gemm_phase<EpiInProj, pg8::StaticOrder, true, true>(F.lds, g, S, E, F.tid); } break;
            case 2: if (PH_EN(2)) { LAUNDER(F); phase_c(F, layer); } break;
            case 3: if (PH_EN(3)) { LAUNDER(F); phase_d(F, layer); } break;
            case 4: if (PH_EN(4)) { LAUNDER(F); phase_e(F, layer); } break;
            case 5: if (PH_EN(5)) { LAUNDER(F); pg8::Gemm g{(const bf16_t*)(F.ws + WS_HM), (const bf16_t*)(F.ws + WS_WOUT), T, D, D}; pg8::StaticOrder S; S.init(T, D, F.G, F.bid);
                      EpiOutProj E{layer == 0 ? INF(F, I_X) : F.out, F.out, (const float*)(F.ws + WS_MOD) + (size_t)layer * BATCH * 6144 + 2048};
                      pg8::gemm_phase<EpiOutProj, pg8::StaticOrder, true, true>(F.lds, g, S, E, F.tid); } break;
            case 6: if (PH_EN(6)) { LAUNDER(F); phase_g1(F, layer); } break;
            case 7: if (PH_EN(7)) { LAUNDER(F); phase_g2(F, layer); } break;
            case 8: if (PH_EN(8)) { LAUNDER(F); const int* rowinfo = (const int*)(F.ws + WS_ROWINFO + layer * ROWINFO_LSTRIDE); const int* tile_e = rowinfo + 2 * MAXROWS;
                      const int ntl = __builtin_amdgcn_readfirstlane(ld_ctl(tile_e + 256));
                      pg8::Gemm g{(const bf16_t*)(F.ws + WS_SORTA), (const bf16_t*)(F.ws + WS_WUP), MAXROWS, 512, D};
                      MoeOrder S{ntl, 2, F.G, F.bid, tile_e, (size_t)512 * D * 2};
                      EpiMoeUp E{(bf16_t*)(F.ws + WS_HID)};
                      pg8::gemm_phase<EpiMoeUp, MoeOrder, true, true>(F.lds, g, S, E, F.tid); } break;
            case 9: if (PH_EN(9)) { LAUNDER(F); const int* rowinfo = (const int*)(F.ws + WS_ROWINFO + layer * ROWINFO_LSTRIDE); const int* tile_e = rowinfo + 2 * MAXROWS;
                      const int ntl = __builtin_amdgcn_readfirstlane(ld_ctl(tile_e + 256));
                      pg8::Gemm g{(const bf16_t*)(F.ws + WS_HID), (const bf16_t*)(F.ws + WS_WDN), MAXROWS, D, 256};
                      MoeOrder S{ntl, 4, F.G, F.bid, tile_e, (size_t)D * 256 * 2};
                      EpiMoeDown E{(bf16_t*)(F.ws + WS_YS), rowinfo, (const float*)(rowinfo + MAXROWS)};
                      pg8::gemm_phase<EpiMoeDown, MoeOrder, true, true>(F.lds, g, S, E, F.tid); } break;
            }
        }
        if (ph_ + 1 < hi) GRID_BAR();
    }
}

extern "C" void kernel_launch(void* const* d_in, const int* in_sizes, int n_in, void* d_out, int out_size, void* d_ws, size_t ws_size, hipStream_t stream) {
    static int grid = 0;
    if (grid == 0) {
        if (n_in != 31 || out_size != T * D || ws_size < WS_END) { fprintf(stderr, "kernel_launch: unexpected shapes: n_in %d out %d ws %zu (need %zu)\n", n_in, out_size, ws_size, (size_t)WS_END); grid = -1; return; }
        int dev = 0, cus = 0, per_cu = 0;
        if (hipGetDevice(&dev) != hipSuccess || hipDeviceGetAttribute(&cus, hipDeviceAttributeMultiprocessorCount, dev) != hipSuccess) { grid = -1; return; }
        if (hipFuncSetAttribute((const void*)hybrid_fwd, hipFuncAttributeMaxDynamicSharedMemorySize, LDS_BYTES) != hipSuccess) { fprintf(stderr, "kernel_launch: hipFuncSetAttribute failed\n"); grid = -1; return; }
        if (hipOccupancyMaxActiveBlocksPerMultiprocessor(&per_cu, (const void*)hybrid_fwd, NTHR, LDS_BYTES) != hipSuccess || per_cu < 1) fprintf(stderr, "kernel_launch: occupancy query says %d\n", per_cu);
        (void)hipGetLastError();
        grid = cus;
    }
    if (grid < 0) return;
    (void)hipMemsetAsync((char*)d_ws + WS_CTL, 0, CTL_ZERO_BYTES, stream);
    Args a{};
    for (int i = 0; i < 31; ++i) a.in[i] = d_in[i];
    a.out = (float*)d_out; a.ws = (unsigned char*)d_ws;
#if MK_PER_PHASE
    for (int ph = 0; ph < N_PHASES; ++ph) { a.ph_lo = ph; a.ph_hi = ph + 1; hipLaunchKernelGGL(hybrid_fwd, dim3(grid), dim3(NTHR), LDS_BYTES, stream, a); }
#else
    a.ph_lo = 0; a.ph_hi = N_PHASES;
    hipLaunchKernelGGL(hybrid_fwd, dim3(grid), dim3(NTHR), LDS_BYTES, stream, a);
#endif
}
```

```cpp
#include <hip/hip_runtime.h>
#include <cstdio>
#include <cstdint>
#include <cmath>
#ifndef PH_MASK
#define PH_MASK 0xfff
#endif
#define PH_EN(k) ((PH_MASK >> (k)) & 1)
#ifndef MK_PER_PHASE
#define MK_PER_PHASE 0
#endif
namespace pg8 {
#define PG8_LAS __attribute__((address_space(3)))
typedef unsigned short bf16_t;
typedef short bf16x8 __attribute__((ext_vector_type(8)));
typedef float f32x4 __attribute__((ext_vector_type(4)));
typedef unsigned u32x4 __attribute__((ext_vector_type(4)));
constexpr int BM = 256, BK = 64, HALF = 128, HTB = HALF * BK * 2  , STAGE_BYTES = 8 * HTB, NXCD = 8, WGM = 8;

__host__ __device__ __forceinline__ int lds_byte(int r, int c) { const int st = (r >> 4) * 2 + (c >> 5), rr = r & 15, cc = c & 31, ob = rr * 64 + cc * 2; return st * 1024 + (ob ^ (((ob >> 9) & 1) << 5)); }
__host__ __device__ __forceinline__ void stage_rc(int b, int& R, int& C) { const int st = b / 1024, sb = b % 1024, swz = sb ^ (((sb >> 9) & 1) << 5); R = (st >> 1) * 16 + swz / 64; C = (st & 1) * 32 + (swz % 64) / 2; }
__host__ __device__ __forceinline__ int perm32(int rho) { const int n = rho >> 4, i = rho & 15; return 8 * (i >> 2) + 4 * n + (i & 3); }

struct Unit { int pm, pn, mask; };
struct Gemm { const bf16_t* A; const bf16_t* Bt; int M, N, K; };

__host__ __device__ __forceinline__ bool tail_split(int i, int G, int c, int total, int& L, int& f, int& sub) {
    const int rounds = total / G, nfull = rounds * G, ntail = total - nfull; f = 1; sub = 0;
    if (i < rounds) { L = i * G + c; return true; }
    if (i > rounds || ntail == 0) return false;
    f = (4 * ntail <= G) ? 4 : (2 * ntail <= G) ? 2 : 1;
    if (c >= ntail * f) return false;
    L = nfull + c / f; sub = c % f; return true;
}
struct StaticOrder {
    int nM, nN, nwg, G, c, padpn;
    __host__ __device__ void init(int M, int N, int G_, int c_, int padpn_ = -1) { nM = M / BM; nN = N / BM; nwg = nM * nN; G = G_; c = c_; padpn = padpn_; }
    __host__ __device__ bool next(int i, Unit& u) const {
        int L, f, sub; if (!tail_split(i, G, c, nwg, L, f, sub)) return false;
        int wgid = L; { const int q = nwg / NXCD, r = nwg % NXCD, xcd = wgid % NXCD, off = wgid / NXCD; wgid = (xcd < r ? xcd * (q + 1) : r * (q + 1) + (xcd - r) * q) + off; }
        const int nig = WGM * nN, gid = wgid / nig, fm = gid * WGM, gsz = (nM - fm) < WGM ? (nM - fm) : WGM;
        u.pm = fm + ((wgid % nig) % gsz); u.pn = (wgid % nig) / gsz;
        const bool pad = (u.pn == padpn);
        u.mask = (f == 1) ? (pad ? 0x5 : 0xF) : (f == 2) ? (pad ? (sub ? 0x4 : 0x1) : (sub ? 0xA : 0x5)) : ((1 << sub) & (pad ? 0x5 : 0xF));
        return true;
    }
    static constexpr bool GATHER = false;
    __device__ __forceinline__ void arows(const Unit&, const int (&)[2], int (&o)[2][2]) const { o[0][0] = o[0][1] = o[1][0] = o[1][1] = 0; }
    __device__ __forceinline__ void a_ready(const Unit&) const {}
    __device__ __forceinline__ size_t boff(const Unit&) const { return 0; }
    __device__ __forceinline__ void done(const Unit&) const {}
};

template <class Epi, class Sched, bool ALIGN_EPI = false, bool SP2 = false>
__device__ __forceinline__ void gemm_phase(PG8_LAS unsigned char* lds, const Gemm g, const Sched& S, const Epi& E, const int tid_in) {
    const int tid = tid_in, wid = __builtin_amdgcn_readfirstlane(tid >> 6), lane = tid & 63, wr = wid >> 2, wc = wid & 3, fr = lane & 15, fq = lane >> 4;
    const int K = g.K, nt = K / BK;
    unsigned voffA[2], voffB[2];
    int RA[2], CA[2];
    unsigned gA_cur[2][2], gA_nxt[2][2];
    static_assert(!Sched::GATHER || SP2, "row-gathered A is wired into the SP2 loop only");
#pragma unroll
    for (int i = 0; i < 2; ++i) { int R, C; stage_rc(tid * 16 + i * 8192, R, C); const int Rb = Epi::PERM ? ((R & ~31) + perm32(R & 31)) : R;
        voffA[i] = (unsigned)(R * K + C) * 2u; voffB[i] = (unsigned)(Rb * K + C) * 2u; RA[i] = R; CA[i] = C; }
#define PG8_GROWS(u, o) do { int ar_[2][2]; S.arows(u, RA, ar_); _Pragma("unroll") for (int h_ = 0; h_ < 2; ++h_) _Pragma("unroll") for (int i_ = 0; i_ < 2; ++i_) o[h_][i_] = (unsigned)(ar_[h_][i_] * K + CA[i_]) * 2u; } while (0)
    const size_t kstep = (size_t)(BK * 2);
    const size_t hstep = (size_t)HALF * K * 2;
    const size_t tstep = 2 * hstep;
    const unsigned ldsw = (unsigned)wid * 1024u;
    const int aoff = lds_byte(wr * 64 + fr, fq * 8), boff = lds_byte(wc * 32 + fr, fq * 8);
#define PG8_SA(b, h) (((b) * 2 + (h)) * HTB)
#define PG8_SB(b, h) ((4 + (b) * 2 + (h)) * HTB)
#define PG8_STAGE(bufoff, gbase, voff) do { _Pragma("unroll") for (int _i = 0; _i < 2; ++_i) \
        __builtin_amdgcn_global_load_lds((const unsigned*)((const char*)(gbase) + (voff)[_i]), (PG8_LAS unsigned*)(lds + (bufoff) + ldsw + _i * 8192), 16, 0, 0); } while (0)
#define PG8_STAGE_A(bufoff, gbase, half, nx) do { if constexpr (Sched::GATHER) { _Pragma("unroll") for (int _i = 0; _i < 2; ++_i) { const unsigned vo_ = (nx) ? gA_nxt[half][_i] : gA_cur[half][_i]; \
        __builtin_amdgcn_global_load_lds((const unsigned*)((const char*)(gbase) + vo_), (PG8_LAS unsigned*)(lds + (bufoff) + ldsw + _i * 8192), 16, 0, 0); } } else { PG8_STAGE(bufoff, (gbase) + (half) * hstep, voffA); } } while (0)
#define PG8_LDA(dst, b, h) do { _Pragma("unroll") for (int m = 0; m < 4; ++m) _Pragma("unroll") for (int k = 0; k < 2; ++k) dst[m][k] = *(const PG8_LAS bf16x8*)(lds + PG8_SA(b, h) + aoff + m * 2048 + k * 1024); } while (0)
#define PG8_LDB(dst, b, h) do { _Pragma("unroll") for (int n = 0; n < 2; ++n) _Pragma("unroll") for (int k = 0; k < 2; ++k) dst[n][k] = *(const PG8_LAS bf16x8*)(lds + PG8_SB(b, h) + boff + n * 2048 + k * 1024); } while (0)
#define PG8_MMA(ai, bj, At, Bt) do { if (cmask & (1 << ((ai) * 2 + (bj)))) PG8_MMA_(ai, bj, At, Bt); } while (0)
#define PG8_MMA_(ai, bj, At, Bt) do { __builtin_amdgcn_s_setprio(1); _Pragma("unroll") for (int m = 0; m < 4; ++m) _Pragma("unroll") for (int n = 0; n < 2; ++n) _Pragma("unroll") for (int k = 0; k < 2; ++k) \
        acc[ai][bj][m][n] = __builtin_amdgcn_mfma_f32_16x16x32_bf16(Bt[n][k], At[m][k], acc[ai][bj][m][n], 0, 0, 0); __builtin_amdgcn_s_setprio(0); } while (0)
#define PG8_WAIT_V(n) asm volatile("s_waitcnt vmcnt(" #n ")" ::: "memory")
#define PG8_WAIT_L(n) asm volatile("s_waitcnt lgkmcnt(" #n ")" ::: "memory")
#define PG8_BAR __builtin_amdgcn_s_barrier()
#define PG8_SCHED __builtin_amdgcn_sched_barrier(0)
    Unit cur, nxt; int ui = 0;
    if (!S.next(0, cur)) return;
    f32x4 acc[2][2][4][2];
#pragma unroll
    for (int a = 0; a < 2; ++a)
#pragma unroll
        for (int b = 0; b < 2; ++b)
#pragma unroll
            for (int m = 0; m < 4; ++m)
#pragma unroll
                for (int n = 0; n < 2; ++n) acc[a][b][m][n] = (f32x4){0.f, 0.f, 0.f, 0.f};
    bf16x8 At[4][2], B0[2][2], B1[2][2];
    const char* cA = (const char*)g.A + (Sched::GATHER ? (size_t)0 : (size_t)cur.pm * tstep); const char* cB = (const char*)g.Bt + S.boff(cur) + (size_t)cur.pn * tstep;
    S.a_ready(cur);
    if constexpr (Sched::GATHER) { PG8_GROWS(cur, gA_cur); }
    if constexpr (SP2) {
        PG8_STAGE(PG8_SB(0, 0), cB, voffB); PG8_STAGE(PG8_SB(0, 1), cB + hstep, voffB); PG8_STAGE_A(PG8_SA(0, 0), cA, 0, false); PG8_STAGE_A(PG8_SA(0, 1), cA, 1, false);
        if (wr == 1) PG8_BAR;
        PG8_WAIT_V(2); PG8_BAR;
        PG8_STAGE(PG8_SB(1, 0), cB + kstep, voffB); PG8_STAGE_A(PG8_SA(1, 0), cA + kstep, 0, false); PG8_STAGE(PG8_SB(1, 1), cB + hstep + kstep, voffB);
        PG8_WAIT_V(6); PG8_BAR;
    } else {
        PG8_STAGE(PG8_SB(0, 0), cB, voffB); PG8_STAGE(PG8_SA(0, 0), cA, voffA); PG8_STAGE(PG8_SB(0, 1), cB + hstep, voffB); PG8_STAGE(PG8_SA(0, 1), cA + hstep, voffA);
        if (wr == 1) PG8_BAR;
        PG8_WAIT_V(4); PG8_BAR;
        PG8_STAGE(PG8_SB(1, 0), cB + kstep, voffB); PG8_STAGE(PG8_SA(1, 0), cA + kstep, voffA); PG8_STAGE(PG8_SB(1, 1), cB + hstep + kstep, voffB);
        PG8_WAIT_V(6); PG8_BAR;
    }
    for (;;) {
        const int cmask = __builtin_amdgcn_readfirstlane(cur.mask);
        const bool has_next = S.next(ui + 1, nxt);
        const char* nA = has_next ? (const char*)g.A + (Sched::GATHER ? (size_t)0 : (size_t)nxt.pm * tstep) : cA; const char* nB = has_next ? (const char*)g.Bt + S.boff(nxt) + (size_t)nxt.pn * tstep : cB;
        if constexpr (Sched::GATHER) { if (has_next) { PG8_GROWS(nxt, gA_nxt); } }
        for (int t = 0; t < nt; t += 2) {
            const bool last = (t == nt - 2);
            const char* a1 = cA + (size_t)(t + 1) * kstep;
            const char* a2 = last ? nA : cA + (size_t)(t + 2) * kstep; const char* b2 = last ? nB : cB + (size_t)(t + 2) * kstep;
            const char* a3 = a2 + kstep; const char* b3 = b2 + kstep;
            if (last && has_next) S.a_ready(nxt);
            const bool usen = last && has_next;
            if constexpr (SP2) {
            PG8_LDB(B0, 0, 0); PG8_LDB(B1, 0, 1); PG8_SCHED; PG8_LDA(At, 0, 0); PG8_STAGE_A(PG8_SA(1, 1), a1, 1, false);
            PG8_WAIT_V(8); PG8_WAIT_L(0); PG8_BAR; PG8_MMA(0, 0, At, B0); PG8_MMA(0, 1, At, B1); PG8_BAR; PG8_SCHED;
            PG8_LDA(At, 0, 1); PG8_STAGE(PG8_SB(0, 0), b2, voffB); PG8_STAGE(PG8_SB(0, 1), b2 + hstep, voffB); PG8_STAGE_A(PG8_SA(0, 0), a2, 0, usen);
            PG8_WAIT_V(8); PG8_WAIT_L(0); PG8_BAR; PG8_MMA(1, 0, At, B0); PG8_MMA(1, 1, At, B1); PG8_BAR; PG8_SCHED;
            PG8_LDB(B0, 1, 0); PG8_LDB(B1, 1, 1); PG8_SCHED; PG8_LDA(At, 1, 0); PG8_STAGE_A(PG8_SA(0, 1), a2, 1, usen);
            PG8_WAIT_V(8); PG8_WAIT_L(0); PG8_BAR; PG8_MMA(0, 0, At, B0); PG8_MMA(0, 1, At, B1); PG8_BAR; PG8_SCHED;
            PG8_LDA(At, 1, 1); PG8_STAGE(PG8_SB(1, 0), b3, voffB); PG8_STAGE(PG8_SB(1, 1), b3 + hstep, voffB); PG8_STAGE_A(PG8_SA(1, 0), a3, 0, usen);
            PG8_WAIT_V(8); PG8_WAIT_L(0); PG8_BAR; PG8_MMA(1, 0, At, B0); PG8_MMA(1, 1, At, B1); PG8_BAR; PG8_SCHED;
            } else {
            PG8_LDB(B0, 0, 0); PG8_SCHED; PG8_LDA(At, 0, 0); PG8_STAGE(PG8_SA(1, 1), a1 + hstep, voffA);
            PG8_WAIT_L(8); PG8_BAR; PG8_WAIT_L(0); PG8_MMA(0, 0, At, B0); PG8_BAR; PG8_SCHED;
            PG8_LDB(B1, 0, 1); PG8_STAGE(PG8_SB(0, 0), b2, voffB);
            PG8_BAR; PG8_WAIT_L(0); PG8_MMA(0, 1, At, B1); PG8_BAR;
            PG8_LDA(At, 0, 1); PG8_STAGE(PG8_SA(0, 0), a2, voffA);
            PG8_BAR; PG8_WAIT_L(0); PG8_MMA(1, 0, At, B0); PG8_BAR; PG8_SCHED;
            PG8_STAGE(PG8_SB(0, 1), b2 + hstep, voffB);
            PG8_WAIT_V(6); PG8_BAR; PG8_MMA(1, 1, At, B1); PG8_BAR;
            PG8_LDB(B0, 1, 0); PG8_SCHED; PG8_LDA(At, 1, 0); PG8_STAGE(PG8_SA(0, 1), a2 + hstep, voffA);
            PG8_WAIT_L(8); PG8_BAR; PG8_WAIT_L(0); PG8_MMA(0, 0, At, B0); PG8_BAR; PG8_SCHED;
            PG8_LDB(B1, 1, 1); PG8_STAGE(PG8_SB(1, 0), b3, voffB);
            PG8_BAR; PG8_WAIT_L(0); PG8_MMA(0, 1, At, B1); PG8_BAR;
            PG8_LDA(At, 1, 1); PG8_STAGE(PG8_SA(1, 0), a3, voffA);
            PG8_BAR; PG8_WAIT_L(0); PG8_MMA(1, 0, At, B0); PG8_BAR; PG8_SCHED;
            PG8_STAGE(PG8_SB(1, 1), b3 + hstep, voffB);
            PG8_WAIT_V(6); PG8_BAR; PG8_MMA(1, 1, At, B1); PG8_BAR;
            }
        }
        if constexpr (ALIGN_EPI) { if (wr == 0) PG8_BAR; }
        if constexpr (!Epi::AFTER_DRAIN) { E(acc, cur, wr, wc, 0, 0); S.done(cur); }
        if (!has_next) break;
#pragma unroll
        for (int a = 0; a < 2; ++a)
#pragma unroll
            for (int b = 0; b < 2; ++b)
#pragma unroll
                for (int m = 0; m < 4; ++m)
#pragma unroll
                    for (int n = 0; n < 2; ++n) acc[a][b][m][n] = (f32x4){0.f, 0.f, 0.f, 0.f};
        cur = nxt; cA = nA; cB = nB; ++ui;
        if constexpr (Sched::GATHER) {
#pragma unroll
            for (int h_ = 0; h_ < 2; ++h_)
#pragma unroll
                for (int i_ = 0; i_ < 2; ++i_) gA_cur[h_][i_] = gA_nxt[h_][i_]; }
        if constexpr (ALIGN_EPI) { if (wr == 1) PG8_BAR; }
    }
    PG8_WAIT_V(0);
    if constexpr (!ALIGN_EPI) { if (wr == 0) PG8_BAR; }
    PG8_BAR;
    if constexpr (Epi::AFTER_DRAIN) { E.fused(acc, cur, wr, wc, fr, fq, lds, wid, lane); S.done(cur); }
#undef PG8_SA
#undef PG8_SB
#undef PG8_STAGE
#undef PG8_STAGE_A
#undef PG8_GROWS
#undef PG8_LDA
#undef PG8_LDB
#undef PG8_MMA
#undef PG8_MMA_
#undef PG8_WAIT_V
#undef PG8_WAIT_L
#undef PG8_BAR
#undef PG8_SCHED
}
}

constexpr int BATCH = 2, SEQ = 8192, T = BATCH * SEQ, D = 1024, NL = 2;
constexpr int NPAD = 3584, RW = 1408, INCOLS = 3346;
constexpr int NWAVES = 8, NTHR = 512;
constexpr float LOG2E = 1.4426950408889634f;
constexpr float NORM_EPS = 1e-6f;

#define GAS __attribute__((address_space(1)))
#define LAS __attribute__((address_space(3)))
typedef unsigned short bf16_t;
typedef short bf16x8 __attribute__((ext_vector_type(8)));
typedef short s16x4 __attribute__((ext_vector_type(4)));
typedef short v4i16_t __attribute__((ext_vector_type(4)));
typedef float f32x4 __attribute__((ext_vector_type(4)));
typedef float f32x16 __attribute__((ext_vector_type(16)));
typedef unsigned u32x4 __attribute__((ext_vector_type(4)));
typedef unsigned u32x2 __attribute__((ext_vector_type(2)));
typedef GAS unsigned gu32;

constexpr size_t MiB = 1u << 20, KiB = 1u << 10;
constexpr size_t WS_CTL = 0, CTL_ZERO_BYTES = 64 * KiB;
constexpr size_t WS_COS = 1 * MiB, WS_SIN = 3 * MiB;
constexpr size_t WS_MOD = 5 * MiB;
constexpr size_t WS_PHIB = WS_MOD + 128 * KiB;
constexpr size_t WS_KMEAN = WS_MOD + 192 * KiB;
constexpr size_t WS_KCMP = WS_MOD + 256 * KiB;
constexpr size_t WS_VCMP = WS_KCMP + 256 * KiB;
constexpr size_t WS_BONUS = 6 * MiB;
constexpr size_t WS_GATE = 7 * MiB;
constexpr size_t WS_ROUTE = 9 * MiB;
constexpr size_t WS_ROWINFO = 10 * MiB;
constexpr size_t ROWINFO_LSTRIDE = 512 * KiB;
constexpr int MAXROWS = 36864;
constexpr size_t WS_ELIST = 9 * MiB;
constexpr size_t WS_EWW = 11 * MiB;
constexpr int TE_OFF = 272, TE_CNT = 304;
constexpr size_t WS_WIN = 12 * MiB;
constexpr size_t WS_WOUT = 19 * MiB;
constexpr size_t WS_WUP = 21 * MiB;
constexpr size_t WS_WDN = 37 * MiB;
constexpr size_t WS_PHIW = 45 * MiB;
constexpr size_t WS_GUPT = 45 * MiB + 512 * KiB;
constexpr size_t WS_WUPT = 45 * MiB + 640 * KiB;
constexpr size_t WS_AUPT = 45 * MiB + 704 * KiB;
constexpr size_t WS_LORA = 46 * MiB;
constexpr size_t WS_HM = 46 * MiB;
constexpr size_t WS_NQ = 78 * MiB;
constexpr size_t WS_KV6 = 90 * MiB;
constexpr size_t KV6_STRIDE = (size_t)BATCH * 2 * SEQ * 64;
constexpr size_t WS_MQKV = 114 * MiB;
constexpr size_t MQKV_STRIDE = (size_t)BATCH * 4 * SEQ * 64;
constexpr size_t WS_RFEAT = 138 * MiB;
constexpr size_t WS_SORTA = 78 * MiB;
constexpr size_t WS_HID = 150 * MiB;
constexpr size_t WS_PT = 182 * MiB;
constexpr size_t WS_ZS = 194 * MiB;
constexpr size_t WS_YT = 206 * MiB;
constexpr size_t WS_Y0 = 218 * MiB;
constexpr size_t WS_YS = 182 * MiB;
constexpr size_t WS_SS = 230 * MiB;
constexpr size_t WS_END = 256 * MiB;
constexpr int CW_Q = 64;
constexpr int CW_CNT = 1024;
constexpr int CW_BAR = 4096;
constexpr int CW_DBG = 3072;
#ifndef DBG_MODE
#define DBG_MODE 0
#endif
#ifndef EXTRA_BAR
#define EXTRA_BAR 0
#endif
#ifndef REPEAT_PH
#define REPEAT_PH -1
#endif
#ifndef DBG_TPH0
#define DBG_TPH0 0
#endif
#ifndef DBG_TPH1
#define DBG_TPH1 1
#endif
#ifndef DBG_QOFF
#define DBG_QOFF 0.0f
#endif
#ifndef DBG_TPH2
#define DBG_TPH2 0
#endif
#ifndef DBG_TPH3
#define DBG_TPH3 1
#endif
#ifndef DBG_SUB
#define DBG_SUB 4
#endif
#ifndef DBG_P
#define DBG_P 4
#endif
#ifndef DBG_CNT
#define DBG_CNT 1
#endif

#define RLX_AGENT __ATOMIC_RELAXED, __HIP_MEMORY_SCOPE_AGENT
#define LDS_WAIT() asm volatile("s_waitcnt lgkmcnt(0)" ::: "memory")
#define VM_WAIT() asm volatile("s_waitcnt vmcnt(0)" ::: "memory")
__device__ __forceinline__ float bf2f(bf16_t h) { return __uint_as_float(((unsigned)h) << 16); }
typedef float f32x2_t __attribute__((ext_vector_type(2)));
typedef __bf16 bf16x2_t __attribute__((ext_vector_type(2)));
__device__ __forceinline__ unsigned pk2(float lo, float hi) { const f32x2_t v = {lo, hi}; return __builtin_bit_cast(unsigned, __builtin_convertvector(v, bf16x2_t)); }
__device__ __forceinline__ bf16_t f2bf(float f) { return (bf16_t)(pk2(f, 0.f) & 0xffffu); }
__device__ __forceinline__ float shx(float v, int mask, int lane) { return __uint_as_float(__builtin_amdgcn_ds_bpermute((lane ^ mask) << 2, __float_as_uint(v))); }
__device__ __forceinline__ int shxi(int v, int mask, int lane) { return __builtin_amdgcn_ds_bpermute((lane ^ mask) << 2, v); }
template <int CTRL> __device__ __forceinline__ float dpp_mov(float v) { return __uint_as_float(__builtin_amdgcn_update_dpp(0u, __float_as_uint(v), CTRL, 0xf, 0xf, true)); }
__device__ __forceinline__ float half_sum32(float v) { const unsigned u = __float_as_uint(v); auto r = __builtin_amdgcn_permlane32_swap(u, u, false, false); return __uint_as_float(r[0]) + __uint_as_float(r[1]); }
__device__ __forceinline__ float row_sum16(float v) { const unsigned u = __float_as_uint(v); auto r = __builtin_amdgcn_permlane16_swap(u, u, false, false); return __uint_as_float(r[0]) + __uint_as_float(r[1]); }
__device__ __forceinline__ float wave_sum(float v, int lane) {
    (void)lane;
    v += dpp_mov<0xB1>(v); v += dpp_mov<0x4E>(v); v += dpp_mov<0x141>(v); v += dpp_mov<0x140>(v);
    return half_sum32(row_sum16(v));
}
__device__ __forceinline__ float tanh_fast(float x) { const float xc = fminf(fmaxf(x, -15.f), 15.f); return 1.f - 2.f * __builtin_amdgcn_rcpf(__builtin_amdgcn_exp2f(xc * (2.f * LOG2E)) + 1.f); }
__device__ __forceinline__ float sigm(float x) { return __builtin_amdgcn_rcpf(1.f + __expf(-x)); }
__device__ __forceinline__ int ld_ctl(const int* p) { return __hip_atomic_load(p, RLX_AGENT); }
__device__ __forceinline__ float ld_ctlf(const float* p) { return __uint_as_float(__hip_atomic_load((const unsigned*)p, RLX_AGENT)); }
#define MFMA16(a, b, c) __builtin_amdgcn_mfma_f32_16x16x32_bf16(a, b, c, 0, 0, 0)
#define MFMA32(a, b, c) __builtin_amdgcn_mfma_f32_32x32x16_bf16(a, b, c, 0, 0, 0)

#define XB_TMO      128
#define XB_XCNT(j)  (256  + 64 * (j))
#define XB_XSUB(j)  (1280 + 64 * (j))
#define XB_XGEN(j)  (2304 + 64 * (j))
#define XB_TOP      3328
#define XB_TOPGEN   3392
#define XCD_BAR_WORDS 3456
#define XB_SPIN_CAP (1u << 22)
__device__ __forceinline__ unsigned xb_ld(unsigned* p)              { return __hip_atomic_load(p, __ATOMIC_RELAXED, __HIP_MEMORY_SCOPE_AGENT); }
__device__ __forceinline__ unsigned xb_add(unsigned* p, unsigned v) { return __hip_atomic_fetch_add(p, v, __ATOMIC_RELAXED, __HIP_MEMORY_SCOPE_AGENT); }
__device__ __forceinline__ unsigned xb_xcc_id() { return (unsigned)__builtin_amdgcn_s_getreg((3 << 11) | 20) & 0xFu; }
#define XB_SPIN(cond, bar) do { unsigned _sp = 0; while (cond) { __builtin_amdgcn_s_sleep(1); \
    if ((++_sp & 255u) == 0u) { if (xb_ld(&(bar)[XB_TMO])) break; if (_sp > XB_SPIN_CAP) { atomicAdd(&(bar)[XB_TMO], 1u); break; } } } } while (0)
struct XcdBarrier { unsigned* bar; unsigned x; volatile LAS unsigned* st; };
__device__ __forceinline__ XcdBarrier xcd_barrier_post(unsigned* bar, volatile LAS unsigned* st) {
    XcdBarrier b; b.bar = bar; b.x = xb_xcc_id(); b.st = st;
    if (threadIdx.x == 0) (void)xb_add(&bar[XB_XCNT(b.x)], 1u);
    return b;
}
__device__ __forceinline__ void xcd_barrier_complete(unsigned* bar, unsigned x, unsigned& nloc, unsigned& nx) {
    const unsigned G = gridDim.x * gridDim.y * gridDim.z;
    unsigned sum, cnt, mine, sp = 0u;
    for (;;) {
        sum = 0u; cnt = 0u; mine = 0u;
#pragma unroll
        for (unsigned j = 0; j < 16; ++j) { const unsigned c = xb_ld(&bar[XB_XCNT(j)]); sum += c; cnt += (c > 0u) ? 1u : 0u; mine = (j == x) ? c : mine; }
        if (sum == G) break;
        __builtin_amdgcn_s_sleep(1);
        if ((++sp & 255u) == 0u) { if (xb_ld(&bar[XB_TMO])) break; if (sp > XB_SPIN_CAP) { atomicAdd(&bar[XB_TMO], 1u); break; } }
    }
    nloc = mine > 0u ? mine : 1u; nx = cnt > 0u ? cnt : 1u;
}
__device__ __forceinline__ void xcd_barrier(const XcdBarrier& b, const int tid) {
    asm volatile("s_waitcnt vmcnt(0)" ::: "memory");
    __syncthreads();
    if (tid == 0) {
        unsigned* bar = b.bar;
        __builtin_amdgcn_s_waitcnt(0);
        unsigned nloc = b.st[0], nx = b.st[1];
        if (nloc == 0u) { xcd_barrier_complete(bar, b.x, nloc, nx); b.st[0] = nloc; b.st[1] = nx; }
        const unsigned old = xb_add(&bar[XB_XSUB(b.x)], 1u);
        const unsigned gen = old / nloc;
        if (old + 1u == (gen + 1u) * nloc) {
            __builtin_amdgcn_fence(__ATOMIC_RELEASE, "agent");
            asm volatile("s_waitcnt vmcnt(0)" ::: "memory");
            const unsigned og = xb_add(&bar[XB_TOP], 1u);
            const unsigned tg = og / nx;
            if (og + 1u == (tg + 1u) * nx) xb_add(&bar[XB_TOPGEN], 1u);
            else XB_SPIN(xb_ld(&bar[XB_TOPGEN]) == tg, bar);
            __builtin_amdgcn_fence(__ATOMIC_ACQUIRE, "agent");
            xb_add(&bar[XB_XGEN(b.x)], 1u);
            asm volatile("s_waitcnt vmcnt(0)" ::: "memory");
        } else {
            XB_SPIN(xb_ld(&bar[XB_XGEN(b.x)]) == gen, bar);
            __builtin_amdgcn_fence(__ATOMIC_ACQUIRE, "agent");
            asm volatile("s_waitcnt vmcnt(0)" ::: "memory");
        }
    }
    __syncthreads();
}

constexpr int RING_BYTES = 131072, MISC_OFF = RING_BYTES + 320, LDS_BYTES = 147456;
struct Frame {
    LAS unsigned char* lds;
    volatile LAS unsigned* MISC;
    unsigned* ctl;
    int tid, lane, wave, G, bid;
    unsigned char* ws;
    float* out;
};
constexpr int IN_OFF = RING_BYTES + 1024;
__device__ __forceinline__ const float* inptr(const LAS unsigned char* lds, int k) {
    int z = 0; asm volatile("" : "+v"(z));
    const LAS unsigned* p = (const LAS unsigned*)(lds + IN_OFF + z) + 2 * k;
    const unsigned lo = __builtin_amdgcn_readfirstlane(p[0]), hi = __builtin_amdgcn_readfirstlane(p[1]);
    return (const float*)(const GAS float*)(((unsigned long long)hi << 32) | lo); }
#define INF(F, k) inptr((F).lds, k)
#define LAUNDER(F) do { GAS unsigned char* w_ = (GAS unsigned char*)(F).ws; GAS float* o_ = (GAS float*)(F).out; int g_ = (F).G, b_ = (F).bid, wv_ = (F).wave, z_ = 0; asm volatile("" : "+s"(w_), "+s"(o_), "+s"(g_), "+s"(b_), "+s"(wv_), "+s"(z_)); \
    int l_ = (int)__builtin_amdgcn_mbcnt_hi(~0u, __builtin_amdgcn_mbcnt_lo(~0u, (unsigned)z_)); asm volatile("" : "+v"(l_)); \
    (F).ws = (unsigned char*)w_; (F).out = (float*)o_; (F).ctl = (unsigned*)(GAS unsigned*)w_; (F).G = g_; (F).bid = b_; (F).wave = wv_; (F).lane = l_; (F).tid = wv_ * 64 + l_; } while (0)
enum { I_X = 0, I_C, I_POS, I_WMOD, I_BMOD, I_NMIX, I_NFFN, I_WIN, I_PHIW1, I_PHIW2, I_PHIPOS, I_MU, I_WUP, I_W0, I_AUP, I_A0, I_GUP, I_KK, I_KA, I_RK, I_LNW, I_LNB,
       I_NNSA, I_NMOBA, I_WOUT, I_WROUTER, I_RBIAS, I_MGATE, I_MUP, I_MDOWN, I_NFINAL };

__device__ const float g_invf[32] = {1.000000000e+00f, 7.498942018e-01f, 5.623413324e-01f, 4.216965139e-01f, 3.162277639e-01f, 2.371373773e-01f, 1.778279394e-01f, 1.333521456e-01f,
    1.000000015e-01f, 7.498942316e-02f, 5.623413250e-02f, 4.216964915e-02f, 3.162277490e-02f, 2.371373773e-02f, 1.778279431e-02f, 1.333521400e-02f, 9.999999776e-03f, 7.498942316e-03f,
    5.623413250e-03f, 4.216964822e-03f, 3.162277630e-03f, 2.371373819e-03f, 1.778279431e-03f, 1.333521446e-03f, 1.000000047e-03f, 7.498941850e-04f, 5.623413017e-04f, 4.216965172e-04f,
    3.162277571e-04f, 2.371373703e-04f, 1.778279402e-04f, 1.333521504e-04f};
__device__ __forceinline__ void phase_pro(Frame& F) {
    const int* pos = (const int*)INF(F, I_POS);
    float* cosT = (float*)(F.ws + WS_COS); float* sinT = (float*)(F.ws + WS_SIN);
    for (int idx = F.bid * NTHR + F.tid; idx < T * 32; idx += F.G * NTHR) {
        const int row = idx >> 5, i = idx & 31;
        const float ang = (float)pos[row] * g_invf[i];
        float sv, cv; sincosf(ang, &sv, &cv);
        cosT[idx] = cv; sinT[idx] = sv;
    }
    LAS float* red = (LAS float*)F.lds;
    for (int chunk = F.bid; chunk < NL * 96; chunk += F.G) {
        const int l = chunk / 96, j0 = (chunk % 96) * 64;
        const float* W = INF(F, I_WMOD) + (size_t)l * D * 6144 + j0 + F.lane;
        const float* c = INF(F, I_C);
        float a0 = 0.f, a1 = 0.f;
        const int k0 = F.wave * 128;
#pragma unroll 32
        for (int k = 0; k < 128; ++k) {
            const float w = W[(size_t)(k0 + k) * 6144];
            const float c0 = c[k0 + k], c1 = c[D + k0 + k];
            a0 += w * (c0 * sigm(c0)); a1 += w * (c1 * sigm(c1));
        }
        red[(F.wave * 2 + 0) * 64 + F.lane] = a0; red[(F.wave * 2 + 1) * 64 + F.lane] = a1;
        __syncthreads();
        if (F.wave < 2) {
            float s = INF(F, I_BMOD)[l * 6144 + j0 + F.lane];
#pragma unroll
            for (int w = 0; w < 8; ++w) s += red[(w * 2 + F.wave) * 64 + F.lane];
            ((float*)(F.ws + WS_MOD))[((size_t)l * BATCH + F.wave) * 6144 + j0 + F.lane] = s;
        }
        __syncthreads();
    }
}

__device__ __forceinline__ void transpose_item(int ldw, int K, bf16_t* WT, int n0, int k0, LAS float* scr, int lane, const float* src) {
    const int n4 = lane & 7, kr = lane >> 3;
#pragma unroll
    for (int i = 0; i < 8; ++i) { const int kk = 8 * i + kr; f32x4 v = (f32x4){0.f, 0.f, 0.f, 0.f};
        if (src) { const float* p = src + (size_t)(k0 + kk) * ldw; v.x = p[0]; v.y = p[1]; v.z = p[2]; v.w = p[3]; }
        scr[kk * 33 + 4 * n4] = v.x; scr[kk * 33 + 4 * n4 + 1] = v.y; scr[kk * 33 + 4 * n4 + 2] = v.z; scr[kk * 33 + 4 * n4 + 3] = v.w; }
    LDS_WAIT(); asm volatile("" ::: "memory");
    const int c = lane & 7;
#pragma unroll
    for (int j = 0; j < 4; ++j) { const int n = (lane >> 3) + 8 * j; const LAS float* sp = scr + (8 * c) * 33 + n;
        u32x4 o; o.x = pk2(sp[0 * 33], sp[1 * 33]); o.y = pk2(sp[2 * 33], sp[3 * 33]); o.z = pk2(sp[4 * 33], sp[5 * 33]); o.w = pk2(sp[6 * 33], sp[7 * 33]);
        *(u32x4*)(WT + (size_t)(n0 + n) * K + k0 + 8 * c) = o; }
    LDS_WAIT(); asm volatile("" ::: "memory");
}
__device__ __forceinline__ const float* cm_in(const float* W, int pos) {
        const int G = pos >> 6, p = pos & 63, w = p >> 5, n = (p >> 4) & 1, q = p & 15, d = 16 * w + q + 32 * n;
        int sc;
        if (G < 6) sc = G * 64 + d; else if (G < 18) sc = 384 + (G - 6) * 64 + d; else if (G < 30) sc = 1170 + (G - 18) * 64 + d;
        else if (G < 52) sc = 1938 + (G - 30) * 64 + d; else if (G == 52 && d < 18) sc = 1152 + d; else return nullptr;
        return W + sc; }
__device__ __forceinline__ const float* cm_up(const float* Wg, const float* Wu, int pos) { const int Wd = pos >> 5, n = (pos >> 4) & 1, q = pos & 15, f = 16 * Wd + q; return (n ? Wu : Wg) + f; }

__device__ __forceinline__ void norm_rows(Frame& F, int layer, bool final_) {
    const float* xin = INF(F, I_X);
    const bf16_t* ys = (const bf16_t*)(F.ws + WS_YS);
    const float* mod = (const float*)(F.ws + WS_MOD);
    bf16_t* H = (bf16_t*)(F.ws + WS_HM);
    const int gw = F.bid * NWAVES + F.wave, NGW = F.G * NWAVES;
    for (int m = gw; m < T; m += NGW) {
        const int b = m >> 13;
        f32x4 v[4]; float ss = 0.f;
        if (layer == 0 && !final_) {
#pragma unroll
            for (int j = 0; j < 4; ++j) v[j] = *(const f32x4*)(xin + (size_t)m * D + 4 * F.lane + 256 * j);
        } else {
            const int pl = final_ ? NL - 1 : layer - 1;
            const float* g2 = mod + ((size_t)pl * BATCH + b) * 6144 + 5120;
#pragma unroll
            for (int j = 0; j < 4; ++j) {
                const int col = 4 * F.lane + 256 * j;
                f32x4 x = *(const f32x4*)(F.out + (size_t)m * D + col);
                const u32x2 a = *(const u32x2*)(ys + (size_t)m * D + col), c = *(const u32x2*)(ys + (size_t)(T + m) * D + col);
                const f32x4 g = *(const f32x4*)(g2 + col);
                x.x += g.x * (__uint_as_float(a.x << 16) + __uint_as_float(c.x << 16));
                x.y += g.y * (__uint_as_float(a.x & 0xffff0000u) + __uint_as_float(c.x & 0xffff0000u));
                x.z += g.z * (__uint_as_float(a.y << 16) + __uint_as_float(c.y << 16));
                x.w += g.w * (__uint_as_float(a.y & 0xffff0000u) + __uint_as_float(c.y & 0xffff0000u));
                v[j] = x;
                if (!final_) *(f32x4*)(F.out + (size_t)m * D + col) = x;
            }
        }
#pragma unroll
        for (int j = 0; j < 4; ++j) ss += (v[j].x * v[j].x + v[j].y * v[j].y) + (v[j].z * v[j].z + v[j].w * v[j].w);
        const float rstd = rsqrtf(wave_sum(ss, F.lane) * (1.f / D) + NORM_EPS);
#if DBG_MODE == 1
        if (final_) { float bad = 0.f;
#pragma unroll
            for (int j = 0; j < 4; ++j) { bad += (fabsf(v[j].x) <= 3e38f) ? 0.f : 1.f; bad += (fabsf(v[j].y) <= 3e38f) ? 0.f : 1.f; bad += (fabsf(v[j].z) <= 3e38f) ? 0.f : 1.f; bad += (fabsf(v[j].w) <= 3e38f) ? 0.f : 1.f; }
            bad = wave_sum(bad, F.lane); if (F.lane == 0 && bad > 0.f) atomicAdd(F.ctl + CW_DBG, (unsigned)bad); }
#endif
        if (final_) {
            const float* gn = INF(F, I_NFINAL);
#pragma unroll
            for (int j = 0; j < 4; ++j) { const int col = 4 * F.lane + 256 * j; const f32x4 g = *(const f32x4*)(gn + col);
                f32x4 o; o.x = v[j].x * rstd * g.x; o.y = v[j].y * rstd * g.y; o.z = v[j].z * rstd * g.z; o.w = v[j].w * rstd * g.w;
                *(f32x4*)(F.out + (size_t)m * D + col) = o; }
        } else {
            const float* gn = INF(F, I_NMIX) + layer * D;
            const float* sh = mod + ((size_t)layer * BATCH + b) * 6144; const float* sc = sh + 1024;
#pragma unroll
            for (int j = 0; j < 4; ++j) { const int col = 4 * F.lane + 256 * j;
                const f32x4 g = *(const f32x4*)(gn + col), s1 = *(const f32x4*)(sc + col), s0 = *(const f32x4*)(sh + col);
                u32x2 o; o.x = pk2(v[j].x * rstd * g.x * (1.f + s1.x) + s0.x, v[j].y * rstd * g.y * (1.f + s1.y) + s0.y);
                o.y = pk2(v[j].z * rstd * g.z * (1.f + s1.z) + s0.z, v[j].w * rstd * g.w * (1.f + s1.w) + s0.w);
                *(u32x2*)(H + (size_t)m * D + col) = o; }
        }
    }
}
__device__ __forceinline__ void phase_a(Frame& F, int layer, bool do_norm, bool do_conv) {
    if (do_norm) { norm_rows(F, layer, false); LAUNDER(F); }
    if (!do_conv) return;
    LAS float* scr = (LAS float*)(F.lds + F.wave * 16384);
    const int gw = F.bid * NWAVES + F.wave, NGW = F.G * NWAVES;
    constexpr int I_IN = 16 * 112, I_OUT = 16 * 32, I_UPI = 16 * 16 * 16, I_DN = 16 * 4 * 32, I_PHI = 2 * 32 * 2, I_GU = 2 * 12, I_LR = 2 * 12;
    constexpr int NIT = I_IN + I_OUT + I_UPI + I_DN + I_PHI + I_GU + I_LR;
    for (int it = gw; it < NIT; it += NGW) {
        int r = it;
        const int l31 = 4 * (F.lane & 7);
        if (r < I_IN) { const int kb = r / 112, nb = r % 112;
            transpose_item(INCOLS, D, (bf16_t*)(F.ws + WS_WIN), nb * 32, kb * 64, scr, F.lane, cm_in(INF(F, I_WIN) + (size_t)layer * D * INCOLS, nb * 32 + l31)); continue; } r -= I_IN;
        if (r < I_OUT) { const int kb = r / 32, nb = r % 32;
            transpose_item(D, D, (bf16_t*)(F.ws + WS_WOUT), nb * 32, kb * 64, scr, F.lane, INF(F, I_WOUT) + (size_t)layer * D * D + nb * 32 + l31); continue; } r -= I_OUT;
        if (r < I_UPI) { const int e = r / 256, q = r % 256, kb = q / 16, nb = q % 16;
            transpose_item(256, D, (bf16_t*)(F.ws + WS_WUP) + (size_t)e * 512 * D, nb * 32, kb * 64, scr, F.lane,
                           cm_up(INF(F, I_MGATE) + ((size_t)layer * 16 + e) * D * 256, INF(F, I_MUP) + ((size_t)layer * 16 + e) * D * 256, nb * 32 + l31)); continue; } r -= I_UPI;
        if (r < I_DN) { const int e = r / 128, q = r % 128, kb = q / 32, nb = q % 32;
            transpose_item(D, 256, (bf16_t*)(F.ws + WS_WDN) + (size_t)e * D * 256, nb * 32, kb * 64, scr, F.lane, INF(F, I_MDOWN) + ((size_t)layer * 16 + e) * 256 * D + nb * 32 + l31); continue; } r -= I_DN;
        if (r < I_PHI) { const int kv = r / 64, q = r % 64, kb = q / 2, nb = q % 2;
            transpose_item(64, 2048, (bf16_t*)(F.ws + WS_PHIW) + (size_t)kv * 64 * 2048, nb * 32, kb * 64, scr, F.lane, INF(F, I_PHIW1) + ((size_t)layer * 2 + kv) * 2048 * 64 + nb * 32 + l31); continue; } r -= I_PHI;
        if (r < I_GU) { const int kb = r / 12, nb = r % 12;
            transpose_item(384, 128, (bf16_t*)(F.ws + WS_GUPT), nb * 32, kb * 64, scr, F.lane, INF(F, I_GUP) + (size_t)layer * 128 * 384 + nb * 32 + l31); continue; } r -= I_GU;
        { const int which = r / 12, nb = r % 12;
            transpose_item(384, 64, (bf16_t*)(F.ws + (which ? WS_AUPT : WS_WUPT)), nb * 32, 0, scr, F.lane, INF(F, which ? I_AUP : I_WUP) + (size_t)layer * 64 * 384 + nb * 32 + l31); }
    }
    LAUNDER(F);
    if (F.bid == F.G - 1) {
        __syncthreads();
        LAS float* part = (LAS float*)F.lds;
#pragma unroll 1
        for (int kv = 0; kv < 2; ++kv) {
            const float* w1 = INF(F, I_PHIW1) + ((size_t)layer * 2 + kv) * 2048 * 64 + (size_t)F.wave * 256 * 64; const float* pp = INF(F, I_PHIPOS) + ((size_t)layer * 2 + kv) * 2048 + F.wave * 256;
            float a[4] = {0.f, 0.f, 0.f, 0.f};
#pragma unroll 1
            for (int k = 0; k < 256; k += 16) {
                float wv[16];
#pragma unroll
                for (int u = 0; u < 16; ++u) wv[u] = w1[(size_t)(k + u) * 64 + F.lane];
#pragma unroll
                for (int u = 0; u < 16; ++u) a[u & 3] += pp[k + u] * wv[u];
            }
            part[(F.wave * 2 + kv) * 64 + F.lane] = (a[0] + a[1]) + (a[2] + a[3]);
        }
        __syncthreads();
        if (F.wave < 2) { float sacc = 0.f;
#pragma unroll
            for (int w = 0; w < 8; ++w) sacc += part[(w * 2 + F.wave) * 64 + F.lane];
            ((float*)(F.ws + WS_PHIB))[(layer * 2 + F.wave) * 64 + F.lane] = sacc; }
    }
}

struct EpiInProj {
    static constexpr bool PERM = false, AFTER_DRAIN = false;
    bf16_t* nq; bf16_t* kv6; bf16_t* mqkv; bf16_t* rfeat; float* gate; const float* cosT; const float* sinT;
    __device__ __forceinline__ void operator()(const f32x4 (&acc)[2][2][4][2], const pg8::Unit& u, int wr, int wc, int fr_, int fq_) const {
        int z_ = 0; asm volatile("" : "+s"(z_)); int l_ = (int)__builtin_amdgcn_mbcnt_hi(~0u, __builtin_amdgcn_mbcnt_lo(~0u, (unsigned)z_)); asm volatile("" : "+v"(l_)); const int fr = l_ & 15, fq = l_ >> 4; (void)fr_; (void)fq_;
#pragma unroll
        for (int bj = 0; bj < 2; ++bj) {
            const int G = 4 * u.pn + 2 * bj + (wc >> 1), w = wc & 1;
            if (G >= 53) continue;
            const int qm = u.mask >> bj;
            const int d0 = 16 * w + 4 * fq;
            const bool rope = (G < 6) || (G == 10) || (G == 11) || (G == 14) || (G == 15) || (G >= 18 && G < 26);
            const float scl = (G < 6 || (G >= 18 && G < 22)) ? 0.125f * LOG2E : 1.0f;
#pragma unroll
            for (int ai = 0; ai < 2; ++ai) {
                if (!((qm >> (2 * ai)) & 1)) continue;
#pragma unroll
                for (int m = 0; m < 4; ++m) {
                    const int row = 256 * u.pm + 128 * ai + 64 * wr + 16 * m + fr, b = row >> 13, t = row & (SEQ - 1);
                    f32x4 x1 = acc[ai][bj][m][0], x2 = acc[ai][bj][m][1];
                    if (rope) {
                        const f32x4 c = *(const f32x4*)(cosT + (size_t)row * 32 + d0), s = *(const f32x4*)(sinT + (size_t)row * 32 + d0);
                        const f32x4 y1 = (x1 * c - x2 * s) * scl, y2 = (x2 * c + x1 * s) * scl; x1 = y1; x2 = y2;
                    }
                    if (G == 52) {
                        float* gp = gate + (size_t)row * 32;
                        *(f32x4*)(gp + d0) = x1;
                        continue;
                    }
                    bf16_t* dst;
                    if (G < 6) dst = nq + ((size_t)(b * 6 + G) * SEQ + t) * 64;
                    else if (G < 18) dst = kv6 + (size_t)((G - 6) >> 1) * KV6_STRIDE + ((size_t)(b * 2 + ((G - 6) & 1)) * SEQ + t) * 64;
                    else if (G < 30) dst = mqkv + (size_t)((G - 18) >> 2) * MQKV_STRIDE + ((size_t)(b * 4 + ((G - 18) & 3)) * SEQ + t) * 64;
                    else dst = rfeat + (size_t)row * RW + (G - 30) * 64;
                    u32x2 o1, o2; o1.x = pk2(x1.x, x1.y); o1.y = pk2(x1.z, x1.w); o2.x = pk2(x2.x, x2.y); o2.y = pk2(x2.z, x2.w);
                    *(u32x2*)(dst + d0) = o1; *(u32x2*)(dst + d0 + 32) = o2;
                }
            }
        }
    }
};
struct EpiNull {
    static constexpr bool PERM = false, AFTER_DRAIN = false;
    float* sink;
    __device__ __forceinline__ void operator()(const f32x4 (&acc)[2][2][4][2], const pg8::Unit& u, int wr, int wc, int fr_, int fq_) const {
        f32x4 s = (f32x4){0.f, 0.f, 0.f, 0.f};
#pragma unroll
        for (int ai = 0; ai < 2; ++ai)
#pragma unroll
            for (int bj = 0; bj < 2; ++bj)
#pragma unroll
                for (int m = 0; m < 4; ++m)
#pragma unroll
                    for (int n = 0; n < 2; ++n) s += acc[ai][bj][m][n];
        if (s.x + s.y + s.z + s.w == 123456.789f) sink[0] = s.x;
    }
};
struct EpiOutProj {
    static constexpr bool PERM = false, AFTER_DRAIN = false;
    const float* xold; float* xnew; const float* g1;
    __device__ __forceinline__ void operator()(const f32x4 (&acc)[2][2][4][2], const pg8::Unit& u, int wr, int wc, int fr_, int fq_) const {
        int z_ = 0; asm volatile("" : "+s"(z_)); int l_ = (int)__builtin_amdgcn_mbcnt_hi(~0u, __builtin_amdgcn_mbcnt_lo(~0u, (unsigned)z_)); asm volatile("" : "+v"(l_)); const int fr = l_ & 15, fq = l_ >> 4; (void)fr_; (void)fq_;
#pragma unroll
        for (int ai = 0; ai < 2; ++ai)
#pragma unroll
            for (int m = 0; m < 4; ++m) {
                const int row = 256 * u.pm + 128 * ai + 64 * wr + 16 * m + fr, b = row >> 13;
#pragma unroll
                for (int bj = 0; bj < 2; ++bj)
#pragma unroll
                    for (int n = 0; n < 2; ++n) {
                        if (!((u.mask >> (2 * ai + bj)) & 1)) continue;
                        const int col = 256 * u.pn + 128 * bj + 32 * wc + 16 * n + 4 * fq;
                        const f32x4 g = *(const f32x4*)(g1 + (size_t)b * 6144 + col);
                        const f32x4 xo = *(const f32x4*)(xold + (size_t)row * D + col);
                        *(f32x4*)(xnew + (size_t)row * D + col) = xo + g * acc[ai][bj][m][n];
                    }
            }
    }
};
struct EpiMoeUp {
    static constexpr bool PERM = false, AFTER_DRAIN = false;
    bf16_t* hid;
    __device__ __forceinline__ void operator()(const f32x4 (&acc)[2][2][4][2], const pg8::Unit& u, int wr, int wc, int fr_, int fq_) const {
        int z_ = 0; asm volatile("" : "+s"(z_)); int l_ = (int)__builtin_amdgcn_mbcnt_hi(~0u, __builtin_amdgcn_mbcnt_lo(~0u, (unsigned)z_)); asm volatile("" : "+v"(l_)); const int fr = l_ & 15, fq = l_ >> 4; (void)fr_; (void)fq_;
#pragma unroll
        for (int ai = 0; ai < 2; ++ai)
#pragma unroll
            for (int m = 0; m < 4; ++m) {
                const int row = 256 * u.pm + 128 * ai + 64 * wr + 16 * m + fr;
#pragma unroll
                for (int bj = 0; bj < 2; ++bj) {
                    if (!((u.mask >> (2 * ai + bj)) & 1)) continue;
                    const int f0 = 16 * (8 * u.pn + 4 * bj + wc) + 4 * fq;
                    const f32x4 g = acc[ai][bj][m][0], up = acc[ai][bj][m][1];
                    u32x2 o; o.x = pk2(g.x * sigm(g.x) * up.x, g.y * sigm(g.y) * up.y); o.y = pk2(g.z * sigm(g.z) * up.z, g.w * sigm(g.w) * up.w);
                    *(u32x2*)(hid + (size_t)row * 256 + f0) = o;
                }
            }
    }
};
struct EpiMoeDown {
    static constexpr bool PERM = false, AFTER_DRAIN = false;
    bf16_t* ys; const int* tile_e; const int* elist; const float* eww;
    __device__ __forceinline__ void operator()(const f32x4 (&acc)[2][2][4][2], const pg8::Unit& u, int wr, int wc, int fr_, int fq_) const {
        int z_ = 0; asm volatile("" : "+s"(z_)); int l_ = (int)__builtin_amdgcn_mbcnt_hi(~0u, __builtin_amdgcn_mbcnt_lo(~0u, (unsigned)z_)); asm volatile("" : "+v"(l_)); const int fr = l_ & 15, fq = l_ >> 4; (void)fr_; (void)fq_;
        const int e = __builtin_amdgcn_readfirstlane(ld_ctl(tile_e + u.pm)), off = __builtin_amdgcn_readfirstlane(ld_ctl(tile_e + TE_OFF + e)), cnt = __builtin_amdgcn_readfirstlane(ld_ctl(tile_e + TE_CNT + e));
        int ri[2][4]; float wv[2][4];
#pragma unroll
        for (int ai = 0; ai < 2; ++ai)
#pragma unroll
            for (int m = 0; m < 4; ++m) { const int local = 256 * u.pm + 128 * ai + 64 * wr + 16 * m + fr - off, idx = e * 16384 + (local < cnt ? local : 0); ri[ai][m] = elist[idx]; wv[ai][m] = eww[idx]; }
#pragma unroll
        for (int ai = 0; ai < 2; ++ai)
#pragma unroll
            for (int m = 0; m < 4; ++m) {
                const int local = 256 * u.pm + 128 * ai + 64 * wr + 16 * m + fr - off;
                if (local >= cnt) continue;
                const float w = wv[ai][m];
                bf16_t* dst = ys + ((size_t)(ri[ai][m] & 1) * T + (ri[ai][m] >> 1)) * D;
#pragma unroll
                for (int bj = 0; bj < 2; ++bj)
#pragma unroll
                    for (int n = 0; n < 2; ++n) {
                        if (!((u.mask >> (2 * ai + bj)) & 1)) continue;
                        const int col = 256 * u.pn + 128 * bj + 32 * wc + 16 * n + 4 * fq;
                        const f32x4 v = acc[ai][bj][m][n] * w;
                        u32x2 o; o.x = pk2(v.x, v.y); o.y = pk2(v.z, v.w);
                        *(u32x2*)(dst + col) = o;
                    }
            }
    }
};
template <bool GATHER_>
struct MoeOrderT {
    static constexpr bool GATHER = GATHER_;
    int ntiles, nN, G, c; const int* tile_e; size_t estride; const int* elist;
    __device__ __forceinline__ void arows(const pg8::Unit& u, const int (&RA)[2], int (&o)[2][2]) const {
        const int e = __builtin_amdgcn_readfirstlane(ld_ctl(tile_e + u.pm)), off = __builtin_amdgcn_readfirstlane(ld_ctl(tile_e + TE_OFF + e)), c = __builtin_amdgcn_readfirstlane(ld_ctl(tile_e + TE_CNT + e));
        int ri[2][2];
#pragma unroll
        for (int h = 0; h < 2; ++h)
#pragma unroll
            for (int i = 0; i < 2; ++i) { const int local = 256 * u.pm + 128 * h + RA[i] - off; ri[h][i] = elist[e * 16384 + (local < c ? local : 0)]; }
#pragma unroll
        for (int h = 0; h < 2; ++h)
#pragma unroll
            for (int i = 0; i < 2; ++i) { const int local = 256 * u.pm + 128 * h + RA[i] - off; o[h][i] = (local < c) ? (ri[h][i] >> 1) : 0; }
    }
    __device__ __forceinline__ bool next(int i, pg8::Unit& u) const { int L, f, sub; if (!pg8::tail_split(i, G, c, ntiles * nN, L, f, sub)) return false;
        u.pm = L / nN; u.pn = L % nN; u.mask = (f == 1) ? 0xF : (f == 2) ? (sub ? 0xA : 0x5) : (1 << sub); return true; }
    __device__ __forceinline__ void a_ready(const pg8::Unit&) const {}
    __device__ __forceinline__ size_t boff(const pg8::Unit& u) const { return (size_t)__builtin_amdgcn_readfirstlane(ld_ctl(tile_e + u.pm)) * estride; }
    __device__ __forceinline__ void done(const pg8::Unit&) const {}
};
typedef MoeOrderT<false> MoeOrder;
typedef MoeOrderT<true> MoeGatherOrder;

__device__ __forceinline__ float gelu_tanh(float x) { const float u = 0.7978845608028654f * (x + 0.044715f * x * x * x); return 0.5f * x * (1.f + tanhf(u)); }

__device__ __forceinline__ void compress_unit(Frame& F, int layer, int u) {
    const int kvsel = u >> 5, b = (u >> 4) & 1, kvh = (u >> 3) & 1, rt = u & 7, i0 = 64 * rt;
    const bf16_t* src = (const bf16_t*)(F.ws + WS_KV6) + (size_t)kvsel * KV6_STRIDE + (size_t)(b * 2 + kvh) * SEQ * 64;
    const bf16_t* w1t = (const bf16_t*)(F.ws + WS_PHIW) + (size_t)kvsel * 64 * 2048;
    const int lane = F.lane, r = lane & 15, kg = lane >> 4;
    f32x4 acc[4][4];
#pragma unroll
    for (int a = 0; a < 4; ++a)
#pragma unroll
        for (int c = 0; c < 4; ++c) acc[a][c] = (f32x4){0.f, 0.f, 0.f, 0.f};
#pragma unroll 2
    for (int lq = 0; lq < 4; ++lq) {
        const int l = 4 * F.wave + lq;
#pragma unroll
        for (int ks = 0; ks < 2; ++ks) {
            bf16x8 af[4], bfr[4];
#pragma unroll
            for (int mt = 0; mt < 4; ++mt) af[mt] = *(const bf16x8*)(src + ((size_t)(16 * (i0 + 16 * mt + r) + l)) * 64 + 32 * ks + 8 * kg);
#pragma unroll
            for (int nt = 0; nt < 4; ++nt) bfr[nt] = *(const bf16x8*)(w1t + (size_t)(16 * nt + r) * 2048 + l * 64 + 32 * ks + 8 * kg);
#pragma unroll
            for (int mt = 0; mt < 4; ++mt)
#pragma unroll
                for (int nt = 0; nt < 4; ++nt) acc[mt][nt] = MFMA16(af[mt], bfr[nt], acc[mt][nt]);
        }
    }
    LAS float* part = (LAS float*)F.lds;
#pragma unroll
    for (int mt = 0; mt < 4; ++mt)
#pragma unroll
        for (int nt = 0; nt < 4; ++nt)
#pragma unroll
            for (int q = 0; q < 4; ++q) part[(F.wave * 64 + 16 * mt + 4 * kg + q) * 64 + 16 * nt + r] = acc[mt][nt][q];
    __syncthreads();
    const float* phib = (const float*)(F.ws + WS_PHIB) + (layer * 2 + kvsel) * 64;
    float hv[8];
    const int row = F.tid >> 3, e0 = (F.tid & 7) * 8;
#pragma unroll
    for (int k = 0; k < 8; ++k) { float s = phib[e0 + k];
#pragma unroll
        for (int w = 0; w < 8; ++w) s += part[(w * 64 + row) * 64 + e0 + k];
        hv[k] = gelu_tanh(s); }
    __syncthreads();
    LAS float* hb = (LAS float*)F.lds;
    LAS float* ob = (LAS float*)(F.lds + 32768);
#pragma unroll
    for (int k = 0; k < 8; ++k) hb[row * 65 + e0 + k] = hv[k];
    __syncthreads();
    const float* w2 = INF(F, I_PHIW2) + ((size_t)layer * 2 + kvsel) * 64 * 64;
    float o[8];
#pragma unroll
    for (int k = 0; k < 8; ++k) o[k] = 0.f;
#pragma unroll 8
    for (int e = 0; e < 64; ++e) { const float h = hb[row * 65 + e]; const f32x4 wa = *(const f32x4*)(w2 + e * 64 + e0), wb = *(const f32x4*)(w2 + e * 64 + e0 + 4);
        o[0] += h * wa.x; o[1] += h * wa.y; o[2] += h * wa.z; o[3] += h * wa.w; o[4] += h * wb.x; o[5] += h * wb.y; o[6] += h * wb.z; o[7] += h * wb.w; }
#pragma unroll
    for (int k = 0; k < 8; ++k) ob[row * 65 + e0 + k] = o[k];
    __syncthreads();
    const int i = i0 + row;
    bf16_t* dst = (bf16_t*)(F.ws + (kvsel ? WS_VCMP : WS_KCMP)) + ((size_t)(b * 2 + kvh) * 512 + i) * 64 + e0;
    float y[8];
    if (i >= 511) {
#pragma unroll
        for (int k = 0; k < 8; ++k) y[k] = 0.f;
    } else if (kvsel == 0) {
        const size_t pr = (size_t)b * SEQ + 16 * i + 31;
        const float* cs = (const float*)(F.ws + WS_COS) + pr * 32; const float* sn = (const float*)(F.ws + WS_SIN) + pr * 32;
#pragma unroll
        for (int k = 0; k < 8; ++k) { const int d = e0 + k, f = d & 31; const float x1 = ob[row * 65 + f], x2 = ob[row * 65 + f + 32];
            y[k] = (d < 32) ? (x1 * cs[f] - x2 * sn[f]) : (x2 * cs[f] + x1 * sn[f]); }
    } else {
#pragma unroll
        for (int k = 0; k < 8; ++k) y[k] = o[k];
    }
    u32x4 pk; pk.x = pk2(y[0], y[1]); pk.y = pk2(y[2], y[3]); pk.z = pk2(y[4], y[5]); pk.w = pk2(y[6], y[7]);
    *(u32x4*)dst = pk;
    __syncthreads();
}
__device__ __forceinline__ void kmean_task(Frame& F, int wt) {
    const int b = wt >> 7, h = (wt >> 5) & 3, blk = wt & 31, sub = F.lane >> 3, ch = F.lane & 7;
    const bf16_t* mk = (const bf16_t*)(F.ws + WS_MQKV) + MQKV_STRIDE + ((size_t)(b * 4 + h) * SEQ + 256 * blk) * 64;
    float a[8];
#pragma unroll
    for (int k = 0; k < 8; ++k) a[k] = 0.f;
#pragma unroll 8
    for (int it = 0; it < 32; ++it) {
        const u32x4 v = *(const u32x4*)(mk + (size_t)(8 * it + sub) * 64 + 8 * ch);
        a[0] += __uint_as_float(v.x << 16); a[1] += __uint_as_float(v.x & 0xffff0000u); a[2] += __uint_as_float(v.y << 16); a[3] += __uint_as_float(v.y & 0xffff0000u);
        a[4] += __uint_as_float(v.z << 16); a[5] += __uint_as_float(v.z & 0xffff0000u); a[6] += __uint_as_float(v.w << 16); a[7] += __uint_as_float(v.w & 0xffff0000u);
    }
#pragma unroll
    for (int k = 0; k < 8; ++k) { a[k] += shx(a[k], 8, F.lane); a[k] += shx(a[k], 16, F.lane); a[k] += shx(a[k], 32, F.lane); a[k] *= (1.f / 256.f); }
    if (sub == 0) { u32x4 o; o.x = pk2(a[0], a[1]); o.y = pk2(a[2], a[3]); o.z = pk2(a[4], a[5]); o.w = pk2(a[6], a[7]);
        *(u32x4*)((bf16_t*)(F.ws + WS_KMEAN) + ((size_t)(b * 4 + h) * 32 + blk) * 64 + 8 * ch) = o; }
}

constexpr int R1_TASK_OFF = 32768, R1_TASK_BYTES = 12288;
__device__ __forceinline__ unsigned bf_hi(float x) { return __float_as_uint(x) >> 16; }
__device__ __forceinline__ void r1_block(Frame& F, int layer, int bt) {
    const int chain = bt >> 4, b = chain / 6, h = chain % 6, lane0 = F.lane;
    const int chunk = 8 * (bt & 15) + F.wave, task = chain * 128 + chunk;
    LAS float* tb = (LAS float*)(F.lds + R1_TASK_OFF + F.wave * R1_TASK_BYTES);
    LAS float* Lr = tb; LAS float* Lw = tb + 512; LAS float* Lk = tb + 1024; LAS float* Lkk = tb + 1536; LAS float* Lbb = tb + 2048; LAS float* Lv = tb + 2560;
    const bf16_t* rf = (const bf16_t*)(F.ws + WS_RFEAT);
    const float* mu = INF(F, I_MU) + layer * RW;
    float* bonus = (float*)(F.ws + WS_BONUS);
    bf16_t* ytil = (bf16_t*)(F.ws + WS_YT) + (size_t)task * 4096; bf16_t* y0o = (bf16_t*)(F.ws + WS_Y0) + (size_t)task * 4096;
    bf16_t* lora = (bf16_t*)(F.ws + (task < 896 ? (size_t)242 * MiB + (size_t)task * 16384 : task < 1344 ? WS_WIN + (size_t)(task - 896) * 16384 : WS_ROUTE + (size_t)(task - 1344) * 16384));
    {
        const int c31 = lane0 & 31, hi = lane0 >> 5;
        f32x16 aw[2][2], aa[2][2];
#pragma unroll
        for (int mt = 0; mt < 2; ++mt)
#pragma unroll
            for (int nt = 0; nt < 2; ++nt)
#pragma unroll
                for (int r = 0; r < 16; ++r) { aw[mt][nt][r] = 0.f; aa[mt][nt][r] = 0.f; }
        const bf16_t* wt = (const bf16_t*)(F.ws + WS_WUPT) + (size_t)(h * 64) * 64; const bf16_t* at = (const bf16_t*)(F.ws + WS_AUPT) + (size_t)(h * 64) * 64;
#pragma unroll
        for (int ks = 0; ks < 4; ++ks) {
            const int j0 = 16 * ks + 8 * hi;
            bf16x8 fw[2], fa[2], bw[2], ba[2];
#pragma unroll
            for (int nt = 0; nt < 2; ++nt) { bw[nt] = *(const bf16x8*)(wt + (32 * nt + c31) * 64 + j0); ba[nt] = *(const bf16x8*)(at + (32 * nt + c31) * 64 + j0); }
#pragma unroll
            for (int mt = 0; mt < 2; ++mt) {
                const int t = 64 * chunk + 32 * mt + c31; const int rowi = b * SEQ + t;
                const u32x4 cw = *(const u32x4*)(rf + (size_t)rowi * RW + 1152 + j0), ca = *(const u32x4*)(rf + (size_t)rowi * RW + 1216 + j0);
                u32x4 pw = (u32x4){0u, 0u, 0u, 0u}, pa = (u32x4){0u, 0u, 0u, 0u};
                if (t > 0) { pw = *(const u32x4*)(rf + (size_t)(rowi - 1) * RW + 1152 + j0); pa = *(const u32x4*)(rf + (size_t)(rowi - 1) * RW + 1216 + j0); }
                const f32x4 mw0 = *(const f32x4*)(mu + 1152 + j0), mw1 = *(const f32x4*)(mu + 1152 + j0 + 4), ma0 = *(const f32x4*)(mu + 1216 + j0), ma1 = *(const f32x4*)(mu + 1216 + j0 + 4);
                const float mwv[8] = {mw0.x, mw0.y, mw0.z, mw0.w, mw1.x, mw1.y, mw1.z, mw1.w}, mav[8] = {ma0.x, ma0.y, ma0.z, ma0.w, ma1.x, ma1.y, ma1.z, ma1.w};
                const unsigned cwv[4] = {cw.x, cw.y, cw.z, cw.w}, pwv[4] = {pw.x, pw.y, pw.z, pw.w}, cav[4] = {ca.x, ca.y, ca.z, ca.w}, pav[4] = {pa.x, pa.y, pa.z, pa.w};
                float xw[8], xa[8];
#pragma unroll
                for (int k = 0; k < 4; ++k) {
                    const float c0 = __uint_as_float(cwv[k] << 16), c1 = __uint_as_float(cwv[k] & 0xffff0000u), p0 = __uint_as_float(pwv[k] << 16), p1 = __uint_as_float(pwv[k] & 0xffff0000u);
                    xw[2 * k] = tanh_fast(c0 + (p0 - c0) * mwv[2 * k]); xw[2 * k + 1] = tanh_fast(c1 + (p1 - c1) * mwv[2 * k + 1]);
                    const float d0 = __uint_as_float(cav[k] << 16), d1 = __uint_as_float(cav[k] & 0xffff0000u), q0 = __uint_as_float(pav[k] << 16), q1 = __uint_as_float(pav[k] & 0xffff0000u);
                    xa[2 * k] = d0 + (q0 - d0) * mav[2 * k]; xa[2 * k + 1] = d1 + (q1 - d1) * mav[2 * k + 1];
                }
                u32x4 uw, ua; uw.x = pk2(xw[0], xw[1]); uw.y = pk2(xw[2], xw[3]); uw.z = pk2(xw[4], xw[5]); uw.w = pk2(xw[6], xw[7]);
                ua.x = pk2(xa[0], xa[1]); ua.y = pk2(xa[2], xa[3]); ua.z = pk2(xa[4], xa[5]); ua.w = pk2(xa[6], xa[7]);
                fw[mt] = __builtin_bit_cast(bf16x8, uw); fa[mt] = __builtin_bit_cast(bf16x8, ua);
            }
#pragma unroll
            for (int mt = 0; mt < 2; ++mt)
#pragma unroll
                for (int nt = 0; nt < 2; ++nt) { aw[mt][nt] = MFMA32(fw[mt], bw[nt], aw[mt][nt]); aa[mt][nt] = MFMA32(fa[mt], ba[nt], aa[mt][nt]); }
        }
#pragma unroll
        for (int mt = 0; mt < 2; ++mt)
#pragma unroll
            for (int nt = 0; nt < 2; ++nt)
#pragma unroll
                for (int r = 0; r < 16; ++r) { const int tl = 32 * mt + (r & 3) + 8 * (r >> 2) + 4 * hi;
                    lora[tl * 64 + 32 * nt + c31] = f2bf(aw[mt][nt][r]); lora[4096 + tl * 64 + 32 * nt + c31] = f2bf(aa[mt][nt][r]); }
        asm volatile("s_waitcnt vmcnt(0)" ::: "memory");
    }
    float Wrun = 1.f;
    f32x16 XP[2][2], XZ[2][2];
    { const int c31 = lane0 & 31, hi = lane0 >> 5;
#pragma unroll
      for (int mt = 0; mt < 2; ++mt)
#pragma unroll
          for (int nt = 0; nt < 2; ++nt)
#pragma unroll
              for (int r = 0; r < 16; ++r) { XP[mt][nt][r] = (32 * mt + (r & 3) + 8 * (r >> 2) + 4 * hi == 32 * nt + c31) ? 1.f : 0.f; XZ[mt][nt][r] = 0.f; } }
#pragma unroll 1
    for (int sub = 0; sub < 8; ++sub) {
        int lane = lane0, hc = h * 64 + lane0; asm volatile("" : "+v"(lane), "+v"(hc));
#pragma unroll 1
        for (int half = 0; half < 2; ++half) {
            float rs4[4], ks4[4], vs4[4], aw4[4], aa4[4];
            const float mu_r = mu[hc], mu_k = mu[384 + hc], mu_v = mu[768 + hc];
            const float w0 = INF(F, I_W0)[layer * 384 + hc], a0 = INF(F, I_A0)[layer * 384 + hc];
#pragma unroll
            for (int q = 0; q < 4; ++q) {
                const int tl = 8 * sub + 4 * half + q, t = 64 * chunk + tl; const int rowi = b * SEQ + t;
                const bf16_t* cur = rf + (size_t)rowi * RW; const bf16_t* prv = cur - RW; const bool hp = t > 0;
                const float rc = bf2f(cur[hc]), kc = bf2f(cur[384 + hc]), vc = bf2f(cur[768 + hc]);
                const float rp = hp ? bf2f(prv[hc]) : 0.f, kp = hp ? bf2f(prv[384 + hc]) : 0.f, vp = hp ? bf2f(prv[768 + hc]) : 0.f;
                rs4[q] = rc + (rp - rc) * mu_r; ks4[q] = kc + (kp - kc) * mu_k; vs4[q] = vc + (vp - vc) * mu_v;
                aw4[q] = w0 + bf2f(lora[tl * 64 + lane]); aa4[q] = a0 + bf2f(lora[4096 + tl * 64 + lane]);
            }
            const float k_k = INF(F, I_KK)[layer * 384 + hc], k_a = INF(F, I_KA)[layer * 384 + hc], r_k = INF(F, I_RK)[layer * 384 + hc];
#pragma unroll
            for (int q = 0; q < 4; ++q) {
                const int tt = 4 * half + q; const int rowi = b * SEQ + 64 * chunk + 8 * sub + tt;
                const float dec = __expf(-0.606531f * sigm(aw4[q])), a = sigm(aa4[q]);
                float kk = ks4[q] * k_k; const float n2 = wave_sum(kk * kk, lane); kk = kk * __builtin_amdgcn_rsqf(fmaxf(n2, 1e-24f));
                const float km = ks4[q] * (1.f + (a - 1.f) * k_a);
                const float bn = wave_sum(rs4[q] * km * r_k, lane);
                const float Wprev = Wrun; Wrun *= dec; const float iW = __builtin_amdgcn_rcpf(Wrun);
                Lr[tt * 64 + lane] = rs4[q] * Wrun; Lk[tt * 64 + lane] = km * iW; Lkk[tt * 64 + lane] = -(kk * Wprev); Lbb[tt * 64 + lane] = kk * a * iW; Lv[tt * 64 + lane] = vs4[q];
                if (lane == 0) bonus[(size_t)rowi * 8 + h] = bn;
            }
        }
        LDS_WAIT(); asm volatile("" ::: "memory");
        const int c31 = lane & 31, hi = lane >> 5;
#pragma unroll 1
        for (int tt = 0; tt < 8; ++tt) {
            f32x4 k4[2][4], r4[2][4];
#pragma unroll
            for (int mt = 0; mt < 2; ++mt)
#pragma unroll
                for (int rq = 0; rq < 4; ++rq) { const int c0 = tt * 64 + 32 * mt + 8 * rq + 4 * hi;
                    k4[mt][rq] = *(const LAS f32x4*)(Lkk + c0); r4[mt][rq] = *(const LAS f32x4*)(Lr + c0); }
            float saP[2], saZ[2];
            { f32x2_t p2[2] = {{0.f, 0.f}, {0.f, 0.f}}, z2[2] = {{0.f, 0.f}, {0.f, 0.f}};
#pragma unroll
              for (int mt = 0; mt < 2; ++mt)
#pragma unroll
                  for (int r = 0; r < 16; r += 2) { const f32x2_t kk2 = {k4[mt][r >> 2][r & 3], k4[mt][r >> 2][(r & 3) + 1]};
#pragma unroll
                      for (int nt = 0; nt < 2; ++nt) { const f32x2_t xp2 = {XP[mt][nt][r], XP[mt][nt][r + 1]}, xz2 = {XZ[mt][nt][r], XZ[mt][nt][r + 1]};
                          p2[nt] = __builtin_elementwise_fma(xp2, kk2, p2[nt]); z2[nt] = __builtin_elementwise_fma(xz2, kk2, z2[nt]); } }
#pragma unroll
              for (int nt = 0; nt < 2; ++nt) { saP[nt] = half_sum32(p2[nt].x + p2[nt].y); saZ[nt] = half_sum32(z2[nt].x + z2[nt].y); } }
            bf16x8 af[2], bP[2], bZ[2];
#pragma unroll
            for (int mt = 0; mt < 2; ++mt) { const float bbv = Lbb[tt * 64 + 32 * mt + c31], kv = Lk[tt * 64 + 32 * mt + c31];
                const unsigned bh = bf_hi(bbv), kh = bf_hi(kv); const unsigned bl = bf_hi(bbv - __uint_as_float(bh << 16)), kl = bf_hi(kv - __uint_as_float(kh << 16));
                u32x4 u; u.x = bh | (bl << 16); u.y = bh | (kh << 16); u.z = kl | (kh << 16); u.w = 0u;
                if (hi) u = (u32x4){0u, 0u, 0u, 0u};
                af[mt] = __builtin_bit_cast(bf16x8, u); }
#pragma unroll
            for (int nt = 0; nt < 2; ++nt) { const float vv = Lv[tt * 64 + 32 * nt + c31];
                const unsigned ph = bf_hi(saP[nt]), zh = bf_hi(saZ[nt]), vh = bf_hi(vv);
                const unsigned pl = bf_hi(saP[nt] - __uint_as_float(ph << 16)), zl = bf_hi(saZ[nt] - __uint_as_float(zh << 16)), vl = bf_hi(vv - __uint_as_float(vh << 16));
                u32x4 up, uz; up.x = ph | (ph << 16); up.y = pl; up.z = 0u; up.w = 0u;
                uz.x = zh | (zh << 16); uz.y = zl | (vh << 16); uz.z = vh | (vl << 16); uz.w = 0u;
                if (hi) { up = (u32x4){0u, 0u, 0u, 0u}; uz = (u32x4){0u, 0u, 0u, 0u}; }
                bP[nt] = __builtin_bit_cast(bf16x8, up); bZ[nt] = __builtin_bit_cast(bf16x8, uz); }
#pragma unroll
            for (int mt = 0; mt < 2; ++mt)
#pragma unroll
                for (int nt = 0; nt < 2; ++nt) { XP[mt][nt] = MFMA32(af[mt], bP[nt], XP[mt][nt]); XZ[mt][nt] = MFMA32(af[mt], bZ[nt], XZ[mt][nt]); }
            { f32x2_t p2[2] = {{0.f, 0.f}, {0.f, 0.f}}, z2[2] = {{0.f, 0.f}, {0.f, 0.f}};
#pragma unroll
              for (int mt = 0; mt < 2; ++mt)
#pragma unroll
                  for (int r = 0; r < 16; r += 2) { const f32x2_t rr2 = {r4[mt][r >> 2][r & 3], r4[mt][r >> 2][(r & 3) + 1]};
#pragma unroll
                      for (int nt = 0; nt < 2; ++nt) { const f32x2_t xp2 = {XP[mt][nt][r], XP[mt][nt][r + 1]}, xz2 = {XZ[mt][nt][r], XZ[mt][nt][r + 1]};
                          p2[nt] = __builtin_elementwise_fma(xp2, rr2, p2[nt]); z2[nt] = __builtin_elementwise_fma(xz2, rr2, z2[nt]); } }
#pragma unroll
              for (int nt = 0; nt < 2; ++nt) { const float p = half_sum32(p2[nt].x + p2[nt].y), z = half_sum32(z2[nt].x + z2[nt].y);
                  if (hi == 0) { ytil[(8 * sub + tt) * 64 + 32 * nt + c31] = f2bf(p); y0o[(8 * sub + tt) * 64 + 32 * nt + c31] = f2bf(z); } } }
        }
    }
    int lane_e = lane0; asm volatile("" : "+v"(lane_e));
    Lw[lane_e] = Wrun; LDS_WAIT(); asm volatile("" ::: "memory");
    { const int hi_ = lane_e >> 5;
#pragma unroll
      for (int mt = 0; mt < 2; ++mt)
#pragma unroll
          for (int rq = 0; rq < 4; ++rq) { const f32x4 wl = *(const LAS f32x4*)(Lw + 32 * mt + 8 * rq + 4 * hi_);
#pragma unroll
              for (int nt = 0; nt < 2; ++nt)
#pragma unroll
                  for (int k = 0; k < 4; ++k) { XP[mt][nt][4 * rq + k] *= wl[k]; XZ[mt][nt][4 * rq + k] *= wl[k]; } } }
    { const int c31 = lane_e & 31, hi = lane_e >> 5;
      bf16_t* PT = (bf16_t*)(F.ws + WS_PT) + (size_t)task * 4096;
      bf16_t* ZP = (bf16_t*)(F.ws + WS_ZS) + (size_t)task * 4096;
#pragma unroll
      for (int mt = 0; mt < 2; ++mt)
#pragma unroll
          for (int nt = 0; nt < 2; ++nt) {
#pragma unroll
              for (int r = 0; r < 16; ++r) PT[(32 * mt + (r & 3) + 8 * (r >> 2) + 4 * hi) * 64 + 32 * nt + c31] = f2bf(XP[mt][nt][r]);
              u32x4 a, c2; a.x = pk2(XZ[mt][nt][0], XZ[mt][nt][1]); a.y = pk2(XZ[mt][nt][2], XZ[mt][nt][3]); a.z = pk2(XZ[mt][nt][4], XZ[mt][nt][5]); a.w = pk2(XZ[mt][nt][6], XZ[mt][nt][7]);
              c2.x = pk2(XZ[mt][nt][8], XZ[mt][nt][9]); c2.y = pk2(XZ[mt][nt][10], XZ[mt][nt][11]); c2.z = pk2(XZ[mt][nt][12], XZ[mt][nt][13]); c2.w = pk2(XZ[mt][nt][14], XZ[mt][nt][15]);
              *(u32x4*)(ZP + ((mt * 2 + nt) * 64 + lane_e) * 16) = a; *(u32x4*)(ZP + ((mt * 2 + nt) * 64 + lane_e) * 16 + 8) = c2; } }
    __syncthreads();
}
constexpr int CW_PREP = 768;
constexpr int CW_R1DONE = 896;
__device__ __forceinline__ void publish_count(Frame& F, unsigned* word) {
    asm volatile("s_waitcnt vmcnt(0)" ::: "memory"); __syncthreads();
    if (F.tid == 0) { __builtin_amdgcn_fence(__ATOMIC_RELEASE, "agent"); asm volatile("s_waitcnt vmcnt(0)" ::: "memory"); (void)__hip_atomic_fetch_add(word, 1u, RLX_AGENT); }
}
__device__ __forceinline__ void await_count(Frame& F, unsigned* word, unsigned want) {
    if (F.tid == 0) { unsigned sp = 0; while ((unsigned)__builtin_amdgcn_readfirstlane(__hip_atomic_load(word, RLX_AGENT)) < want) { __builtin_amdgcn_s_sleep(4); if (++sp > (1u << 24)) break; }
        __builtin_amdgcn_fence(__ATOMIC_ACQUIRE, "agent"); asm volatile("s_waitcnt vmcnt(0)" ::: "memory"); }
    __syncthreads();
}
__device__ __forceinline__ void phase_c(Frame& F, int layer) {
    if (F.bid < 192) r1_block(F, layer, F.bid);
    else { compress_unit(F, layer, F.bid - 192); LAUNDER(F); if (F.bid < 224) kmean_task(F, (F.bid - 192) * 8 + F.wave); }
    LAUNDER(F);
    publish_count(F, F.ctl + ((F.bid < 192) ? CW_R1DONE + 64 * layer + (F.bid >> 4) : CW_PREP + 64 * layer));
}

constexpr int KP = 72;
constexpr int TILE_B = 64 * KP * 2;
constexpr int AT_K0 = 0, AT_V0 = 2 * TILE_B;
constexpr int AT_IMP = 4 * TILE_B;
constexpr int AT_MISC = AT_IMP + 8 * 8192;
constexpr int AT_KMEAN = AT_MISC + 256;
constexpr int R2_SBUF = 0;

__device__ __forceinline__ bf16x8 lds_frag(const LAS bf16_t* tile, int row, int col) { return *(const LAS bf16x8*)(tile + row * KP + col); }
__device__ __forceinline__ s16x4 lds_tr(const LAS bf16_t* p) { return __builtin_bit_cast(s16x4, __builtin_amdgcn_ds_read_tr16_b64_v4i16((LAS v4i16_t*)p)); }
__device__ __forceinline__ bf16x8 cat8(s16x4 a, s16x4 b) { bf16x8 r; r[0] = a[0]; r[1] = a[1]; r[2] = a[2]; r[3] = a[3]; r[4] = b[0]; r[5] = b[1]; r[6] = b[2]; r[7] = b[3]; return r; }
__device__ __forceinline__ bf16x8 pack8(const f32x4& a, const f32x4& b) { u32x4 u; u.x = pk2(a.x, a.y); u.y = pk2(a.z, a.w); u.z = pk2(b.x, b.y); u.w = pk2(b.z, b.w); return __builtin_bit_cast(bf16x8, u); }

template <int NH>
__device__ __forceinline__ void qk_tile(const LAS bf16_t* Kt, const bf16x8 (&qf)[NH][2], f32x4 (&st)[NH][4], const float (&cm)[NH], int lane, const bool (&keep)[NH]) {
    const int r = lane & 15, kg = lane >> 4;
    f32x4 ci[NH];
#pragma unroll
    for (int g = 0; g < NH; ++g) { const float c = keep[g] ? cm[g] : -INFINITY; ci[g] = (f32x4){c, c, c, c}; }
#pragma unroll
    for (int kt = 0; kt < 4; ++kt) {
        const bf16x8 k0 = lds_frag(Kt, 16 * kt + r, 8 * kg), k1 = lds_frag(Kt, 16 * kt + r, 32 + 8 * kg);
#pragma unroll
        for (int g = 0; g < NH; ++g) { f32x4 z = MFMA16(k0, qf[g][0], ci[g]); st[g][kt] = MFMA16(k1, qf[g][1], z); }
    }
}
template <int NH, bool DO_V>
__device__ __forceinline__ void pv_tile(const LAS bf16_t* Vt, const f32x4 (&p)[NH][4], f32x4 (&o)[NH][4], f32x4 (&lacc)[NH], int lane) {
    const int kg = lane >> 4, rr = (lane & 15) >> 2, cc = 4 * (lane & 3);
    const u32x4 one4 = (u32x4){0x3f803f80u, 0x3f803f80u, 0x3f803f80u, 0x3f803f80u};
    const bf16x8 ones = __builtin_bit_cast(bf16x8, one4);
#pragma unroll
    for (int i = 0; i < 2; ++i) {
        bf16x8 pf[NH];
#pragma unroll
        for (int g = 0; g < NH; ++g) { pf[g] = pack8(p[g][2 * i], p[g][2 * i + 1]); lacc[g] = MFMA16(ones, pf[g], lacc[g]); }
        if (DO_V) {
#pragma unroll
            for (int dt = 0; dt < 4; ++dt) {
                const s16x4 lo = lds_tr(Vt + (32 * i + 4 * kg + rr) * KP + 16 * dt + cc), hi = lds_tr(Vt + (32 * i + 16 + 4 * kg + rr) * KP + 16 * dt + cc);
                const bf16x8 vf = cat8(lo, hi);
#pragma unroll
                for (int g = 0; g < NH; ++g) o[g][dt] = MFMA16(vf, pf[g], o[g][dt]);
            }
        }
    }
}
__device__ __forceinline__ void softmax_tile(f32x4 (&st)[4], f32x4 (&o)[4], f32x4& lacc, float& mref, int lane) {
    float mx = -INFINITY;
#pragma unroll
    for (int kt = 0; kt < 4; ++kt) mx = fmaxf(fmaxf(mx, fmaxf(st[kt].x, st[kt].y)), fmaxf(st[kt].z, st[kt].w));
    mx = fmaxf(mx, shx(mx, 16, lane)); mx = fmaxf(mx, shx(mx, 32, lane));
    const bool fresh = (mref == -INFINITY);
    if (__any((fresh && mx > -INFINITY) || mx > 8.0f)) {
        const float d = fresh ? ((mx == -INFINITY) ? 0.f : mx) : fmaxf(mx, 0.f);
        const float alpha = fresh ? 1.f : __builtin_amdgcn_exp2f(-d);
        mref = fresh ? mx : mref + d;
        lacc = lacc * alpha;
#pragma unroll
        for (int dt = 0; dt < 4; ++dt) o[dt] = o[dt] * alpha;
#pragma unroll
        for (int kt = 0; kt < 4; ++kt) st[kt] = st[kt] - d;
    }
#pragma unroll
    for (int kt = 0; kt < 4; ++kt) {
        st[kt].x = __builtin_amdgcn_exp2f(st[kt].x); st[kt].y = __builtin_amdgcn_exp2f(st[kt].y);
        st[kt].z = __builtin_amdgcn_exp2f(st[kt].z); st[kt].w = __builtin_amdgcn_exp2f(st[kt].w);
    }
}
#define MX2(a, b) __builtin_elementwise_maximum((float)(a), (float)(b))
#define MX3(a, b, c) MX2(MX2(a, b), c)
template <int NH>
__device__ __forceinline__ void softmax_tiles(f32x4 (&st)[NH][4], f32x4 (&o)[NH][4], f32x4 (&lacc)[NH], float (&mref)[NH], float (&cm)[NH], int lane) {
    float mx[NH];
#pragma unroll
    for (int g = 0; g < NH; ++g) {
        float a = MX3(st[g][0].x, st[g][0].y, st[g][0].z), c = MX3(st[g][2].x, st[g][2].y, st[g][2].z);
        a = MX3(a, st[g][0].w, st[g][1].x); c = MX3(c, st[g][2].w, st[g][3].x);
        a = MX3(a, st[g][1].y, st[g][1].z); c = MX3(c, st[g][3].y, st[g][3].z);
        mx[g] = MX3(MX3(a, st[g][1].w, st[g][3].w), c, c); }
#pragma unroll
    for (int g = 0; g < NH; ++g)
#pragma unroll
        for (int kt = 0; kt < 4; ++kt) {
            st[g][kt].x = __builtin_amdgcn_exp2f(st[g][kt].x); st[g][kt].y = __builtin_amdgcn_exp2f(st[g][kt].y);
            st[g][kt].z = __builtin_amdgcn_exp2f(st[g][kt].z); st[g][kt].w = __builtin_amdgcn_exp2f(st[g][kt].w);
        }
#pragma unroll
    for (int g = 0; g < NH; ++g) { const unsigned u = __float_as_uint(mx[g]); auto a = __builtin_amdgcn_permlane16_swap(u, u, false, false); mx[g] = MX2(__uint_as_float(a[0]), __uint_as_float(a[1])); }
#pragma unroll
    for (int g = 0; g < NH; ++g) { const unsigned u = __float_as_uint(mx[g]); auto a = __builtin_amdgcn_permlane32_swap(u, u, false, false); mx[g] = MX2(__uint_as_float(a[0]), __uint_as_float(a[1])); }
    bool need = false;
#pragma unroll
    for (int g = 0; g < NH; ++g) need = need | (((mref[g] == -INFINITY) & (mx[g] > -INFINITY)) | (mx[g] > 8.0f));
    if (__any(need)) {
#pragma unroll
        for (int g = 0; g < NH; ++g) {
            const bool fresh = (mref[g] == -INFINITY);
            const float d = fresh ? ((mx[g] == -INFINITY) ? 0.f : fmaxf(mx[g], -100.f)) : fmaxf(mx[g], 0.f);
            const float pf = __builtin_amdgcn_exp2f(-d);
            const float alpha = fresh ? 1.f : pf;
            mref[g] = fresh ? ((mx[g] == -INFINITY) ? -INFINITY : d) : mref[g] + d;
            cm[g] = (mref[g] == -INFINITY) ? 0.f : -mref[g];
            lacc[g] = lacc[g] * alpha;
#pragma unroll
            for (int dt = 0; dt < 4; ++dt) o[g][dt] = o[g][dt] * alpha;
#pragma unroll
            for (int kt = 0; kt < 4; ++kt) st[g][kt] = st[g][kt] * pf;
        }
    }
}
__device__ __forceinline__ void acc_pk(u32x2& d, const f32x4& v) {
    const float a = __uint_as_float(d.x << 16) + v.x, b = __uint_as_float(d.x & 0xffff0000u) + v.y, c = __uint_as_float(d.y << 16) + v.z, e = __uint_as_float(d.y & 0xffff0000u) + v.w;
    d.x = pk2(a, b); d.y = pk2(c, e); }
__device__ __forceinline__ u32x4 tile_load(const bf16_t* g, int tid) { const int off = (tid >> 3) * 64 + (tid & 7) * 8; return *(const u32x4*)(g + off); }
__device__ __forceinline__ void tile_store(LAS bf16_t* t, int tid, u32x4 v) { *(LAS u32x4*)(t + (tid >> 3) * KP + (tid & 7) * 8) = v; }

__device__ __forceinline__ void nsa_task(Frame& F, int b, int kvh, int J) {
    const int lane = F.lane, tid = F.tid, wv = F.wave, q = lane & 15, kg = lane >> 4;
    const int t0 = 128 * J, tw0 = t0 + 16 * wv, tq_abs = tw0 + q, cur = tw0 >> 6, tq = tq_abs & 63;
    LAS bf16_t* Kb = (LAS bf16_t*)(F.lds + AT_K0); LAS bf16_t* Vb = (LAS bf16_t*)(F.lds + AT_V0);
    LAS float* imp = (LAS float*)(F.lds + AT_IMP + wv * 8192);
    const bf16_t* kvbase = (const bf16_t*)(F.ws + WS_KV6);
    const size_t slab = (size_t)(b * 2 + kvh) * SEQ * 64;
    const bf16_t* Kcmp = (const bf16_t*)(F.ws + WS_KCMP) + (size_t)(b * 2 + kvh) * 512 * 64;
    const bf16_t* Vcmp = (const bf16_t*)(F.ws + WS_VCMP) + (size_t)(b * 2 + kvh) * 512 * 64;
    const bf16_t* Ks = kvbase + 2 * KV6_STRIDE + slab; const bf16_t* Vs = kvbase + 3 * KV6_STRIDE + slab;
    const bf16_t* Kw = kvbase + 4 * KV6_STRIDE + slab; const bf16_t* Vw = kvbase + 5 * KV6_STRIDE + slab;
    bf16x8 qf[3][2];
#pragma unroll
    for (int g = 0; g < 3; ++g) { const bf16_t* qp = (const bf16_t*)(F.ws + WS_NQ) + (((b * 6 + 3 * kvh + g) * SEQ + tq_abs) * 64 + 8 * kg);
        qf[g][0] = *(const bf16x8*)qp; qf[g][1] = *(const bf16x8*)(qp + 32); }
#define NSA_GATEP ((const float*)(F.ws + WS_GATE) + ((b * SEQ + tq_abs) * 32 + 9 * kvh))
    for (int i = lane; i < 2048; i += 64) imp[i] = 0.f;
    const int imax_blk = (t0 + 127 - 31) >> 4;
    const int ntc = (imax_blk >> 6) + 1;
    const int imax_w = (tw0 + 15 >= 31) ? ((tw0 + 15 - 31) >> 4) : -1;
    const int ivis = (tq_abs >= 31) ? ((tq_abs - 31) >> 4) : -1;
    float m[3] = {-INFINITY, -INFINITY, -INFINITY}; float cm[3] = {0.f, 0.f, 0.f};
    f32x4 lacc[3] = {(f32x4){0.f, 0.f, 0.f, 0.f}, (f32x4){0.f, 0.f, 0.f, 0.f}, (f32x4){0.f, 0.f, 0.f, 0.f}};
    f32x4 st[3][4];
    f32x4 ob[3][4];
    const bool keep3[3] = {true, true, true};
#pragma unroll
    for (int g = 0; g < 3; ++g)
#pragma unroll
        for (int dt = 0; dt < 4; ++dt) ob[g][dt] = (f32x4){0.f, 0.f, 0.f, 0.f};
    {
        u32x4 kr = tile_load(Kcmp, tid);
        tile_store(Kb, tid, kr); __syncthreads();
        for (int ct = 0; ct < ntc; ++ct) {
            if (ct + 1 < ntc) kr = tile_load(Kcmp + (ct + 1) * 4096, tid);
            const LAS bf16_t* Kt = Kb + (ct & 1) * (TILE_B / 2);
            if (64 * ct <= imax_w) {
                qk_tile<3>(Kt, qf, st, cm, lane, keep3);
#pragma unroll
                for (int g = 0; g < 3; ++g) {
#pragma unroll
                    for (int kt = 0; kt < 4; ++kt)
#pragma unroll
                        for (int r = 0; r < 4; ++r) { const int i = 64 * ct + 16 * kt + 4 * kg + r; st[g][kt][r] = (i <= ivis) ? st[g][kt][r] : -INFINITY; }
                }
                softmax_tiles<3>(st, ob, lacc, m, cm, lane);
                pv_tile<3, false>(Kt, st, ob, lacc, lane);
            }
            if (ct + 1 < ntc) tile_store(Kb + ((ct + 1) & 1) * (TILE_B / 2), tid, kr);
            __syncthreads();
        }
    }
    float invl[3]; float msafe[3];
#pragma unroll
    for (int g = 0; g < 3; ++g) { msafe[g] = (m[g] == -INFINITY) ? 0.f : m[g]; invl[g] = 1.f / fmaxf(lacc[g].x, 1e-30f); }
    {
        u32x4 kr = tile_load(Kcmp, tid), vr = tile_load(Vcmp, tid);
        tile_store(Kb, tid, kr); tile_store(Vb, tid, vr); __syncthreads();
        for (int ct = 0; ct < ntc; ++ct) {
            if (ct + 1 < ntc) { kr = tile_load(Kcmp + (ct + 1) * 4096, tid); vr = tile_load(Vcmp + (ct + 1) * 4096, tid); }
            const LAS bf16_t* Kt = Kb + (ct & 1) * (TILE_B / 2); const LAS bf16_t* Vt = Vb + (ct & 1) * (TILE_B / 2);
            if (64 * ct <= imax_w) {
                qk_tile<3>(Kt, qf, st, cm, lane, keep3);
#pragma unroll
                for (int g = 0; g < 3; ++g)
#pragma unroll
                    for (int kt = 0; kt < 4; ++kt)
#pragma unroll
                        for (int r = 0; r < 4; ++r) { const int i = 64 * ct + 16 * kt + 4 * kg + r;
                            st[g][kt][r] = (i <= ivis) ? __builtin_amdgcn_exp2f(st[g][kt][r]) * invl[g] : 0.f; }
#pragma unroll
                for (int kt = 0; kt < 4; ++kt) {
                    float a = 0.f, c = 0.f;
#pragma unroll
                    for (int g = 0; g < 3; ++g) { a += (st[g][kt].x + st[g][kt].y) + st[g][kt].z; c += st[g][kt].w; }
                    c *= 0.5f; a += c;
                    const float recv = __uint_as_float(__builtin_amdgcn_ds_bpermute(((lane + 48) & 63) << 2, __float_as_uint(c)));
                    const int ktp = 4 * ct + kt;
                    imp[ktp * 64 + lane] += a + (kg != 0 ? recv : 0.f);
                    if (kg == 0 && ktp + 1 < 32) imp[(ktp + 1) * 64 + lane] += recv;
                }
                pv_tile<3, true>(Vt, st, ob, lacc, lane);
            }
            if (ct + 1 < ntc) { tile_store(Kb + ((ct + 1) & 1) * (TILE_B / 2), tid, kr); tile_store(Vb + ((ct + 1) & 1) * (TILE_B / 2), tid, vr); }
            __syncthreads();
        }
    }
#pragma unroll
    for (int g = 0; g < 3; ++g) { const float sc = sigm(NSA_GATEP[3 * g + 0]);
#pragma unroll
        for (int dt = 0; dt < 4; ++dt) ob[g][dt] = ob[g][dt] * sc; }
    unsigned msk[4] = {0u, 0u, 0u, 0u};
    if (cur <= 15) {
        msk[0] = (cur == 31) ? 0xffffffffu : ((1u << (cur + 1)) - 1u);
    } else {
        float iv[32];
#pragma unroll
        for (int k = 0; k < 32; ++k) { const int s = 4 * k + kg; const float v = imp[k * 64 + lane]; iv[k] = (s >= 1 && s <= cur - 2) ? v : -1.f; }
        msk[0] = 1u; msk[cur >> 5] |= 1u << (cur & 31); msk[(cur - 1) >> 5] |= 1u << ((cur - 1) & 31);
        for (int it = 0; it < 13; ++it) {
            float bv = -2.f; int bs = 1 << 20;
#pragma unroll
            for (int k = 0; k < 32; ++k) { if (iv[k] > bv) { bv = iv[k]; bs = 4 * k + kg; } }
#pragma unroll
            for (int sh = 16; sh <= 32; sh <<= 1) { const float ov = shx(bv, sh, lane); const int os = shxi(bs, sh, lane); if (ov > bv || (ov == bv && os < bs)) { bv = ov; bs = os; } }
#pragma unroll
            for (int k = 0; k < 32; ++k) if (4 * k + kg == bs) iv[k] = -1.f;
#pragma unroll
            for (int wd = 0; wd < 4; ++wd) if ((bs >> 5) == wd) msk[wd] |= 1u << (bs & 31);
        }
    }
    LAS u32x2* otp = (LAS u32x2*)imp;
#pragma unroll
    for (int g = 0; g < 3; ++g)
#pragma unroll
        for (int dt = 0; dt < 4; ++dt) { u32x2 o; o.x = pk2(ob[g][dt].x, ob[g][dt].y); o.y = pk2(ob[g][dt].z, ob[g][dt].w); otp[(g * 4 + dt) * 64 + lane] = o; }
    {
#pragma unroll
        for (int g = 0; g < 3; ++g) { m[g] = -INFINITY; cm[g] = 0.f; lacc[g] = (f32x4){0.f, 0.f, 0.f, 0.f};
#pragma unroll
            for (int dt = 0; dt < 4; ++dt) ob[g][dt] = (f32x4){0.f, 0.f, 0.f, 0.f}; }
        const int nb = 2 * J + 2;
        u32x4 kr[2], vr[2]; unsigned mw = 0u;
        kr[0] = tile_load(Ks, tid); vr[0] = tile_load(Vs, tid);
        kr[1] = tile_load(Ks + ((nb > 1) ? 4096 : 0), tid); vr[1] = tile_load(Vs + ((nb > 1) ? 4096 : 0), tid);
        tile_store(Kb, tid, kr[0]); tile_store(Vb, tid, vr[0]); __syncthreads();
        for (int s0 = 0; s0 < nb; s0 += 2) {
#pragma unroll
            for (int u = 0; u < 2; ++u) {
                const int s = s0 + u;
                if (s < nb) {
                    if (s + 2 < nb) { kr[u] = tile_load(Ks + (s + 2) * 4096, tid); vr[u] = tile_load(Vs + (s + 2) * 4096, tid); }
                    const LAS bf16_t* Kt = Kb + (s & 1) * (TILE_B / 2); const LAS bf16_t* Vt = Vb + (s & 1) * (TILE_B / 2);
                    if ((s & 31) == 0) mw = (s == 0) ? msk[0] : (s == 32) ? msk[1] : (s == 64) ? msk[2] : msk[3];
                    const bool sel = ((mw >> (s & 31)) & 1u) != 0u;
                    if (__any(sel)) {
                        const bool selk[3] = {sel, sel, sel};
                        qk_tile<3>(Kt, qf, st, cm, lane, selk);
                        if (s == cur) {
#pragma unroll
                            for (int g = 0; g < 3; ++g)
#pragma unroll
                                for (int kt = 0; kt < 4; ++kt)
#pragma unroll
                                    for (int r = 0; r < 4; ++r) { const int kk = 16 * kt + 4 * kg + r; st[g][kt][r] = (kk <= tq) ? st[g][kt][r] : -INFINITY; }
                        }
                        softmax_tiles<3>(st, ob, lacc, m, cm, lane);
                        pv_tile<3, true>(Vt, st, ob, lacc, lane);
                    }
                    if (s + 1 < nb) { tile_store(Kb + ((s + 1) & 1) * (TILE_B / 2), tid, kr[u ^ 1]); tile_store(Vb + ((s + 1) & 1) * (TILE_B / 2), tid, vr[u ^ 1]); }
                }
                __syncthreads();
            }
        }
#pragma unroll
        for (int g = 0; g < 3; ++g) { const float sc = sigm(NSA_GATEP[3 * g + 1]) / fmaxf(lacc[g].x, 1e-30f);
#pragma unroll
            for (int dt = 0; dt < 4; ++dt) { u32x2 o = otp[(g * 4 + dt) * 64 + lane]; acc_pk(o, ob[g][dt] * sc); otp[(g * 4 + dt) * 64 + lane] = o; } }
    }
    {
#pragma unroll
        for (int g = 0; g < 3; ++g) { m[g] = -INFINITY; cm[g] = 0.f; lacc[g] = (f32x4){0.f, 0.f, 0.f, 0.f};
#pragma unroll
            for (int dt = 0; dt < 4; ++dt) ob[g][dt] = (f32x4){0.f, 0.f, 0.f, 0.f}; }
        const int s_lo = (2 * J - 8 > 0) ? 2 * J - 8 : 0, s_hi = 2 * J + 1, nb = s_hi - s_lo + 1;
        u32x4 kr[2], vr[2];
        kr[0] = tile_load(Kw + s_lo * 4096, tid); vr[0] = tile_load(Vw + s_lo * 4096, tid);
        kr[1] = tile_load(Kw + (s_lo + ((nb > 1) ? 1 : 0)) * 4096, tid); vr[1] = tile_load(Vw + (s_lo + ((nb > 1) ? 1 : 0)) * 4096, tid);
        tile_store(Kb, tid, kr[0]); tile_store(Vb, tid, vr[0]); __syncthreads();
        for (int it0 = 0; it0 < nb; it0 += 2) {
#pragma unroll
            for (int u = 0; u < 2; ++u) {
                const int it = it0 + u;
                if (it < nb) {
                    const int s = s_lo + it;
                    if (it + 2 < nb) { kr[u] = tile_load(Kw + (s + 2) * 4096, tid); vr[u] = tile_load(Vw + (s + 2) * 4096, tid); }
                    const LAS bf16_t* Kt = Kb + (it & 1) * (TILE_B / 2); const LAS bf16_t* Vt = Vb + (it & 1) * (TILE_B / 2);
                    if (s <= cur && s >= cur - 8) {
                        qk_tile<3>(Kt, qf, st, cm, lane, keep3);
                        if (s == cur || s == cur - 8) {
#pragma unroll
                            for (int g = 0; g < 3; ++g)
#pragma unroll
                                for (int kt = 0; kt < 4; ++kt)
#pragma unroll
                                    for (int r = 0; r < 4; ++r) { const int kk = 16 * kt + 4 * kg + r; const bool ok = (s == cur) ? (kk <= tq) : (kk > tq); st[g][kt][r] = ok ? st[g][kt][r] : -INFINITY; }
                        }
                        softmax_tiles<3>(st, ob, lacc, m, cm, lane);
                        pv_tile<3, true>(Vt, st, ob, lacc, lane);
                    }
                    if (it + 1 < nb) { tile_store(Kb + ((it + 1) & 1) * (TILE_B / 2), tid, kr[u ^ 1]); tile_store(Vb + ((it + 1) & 1) * (TILE_B / 2), tid, vr[u ^ 1]); }
                }
                __syncthreads();
            }
        }
        bf16_t* mixp = (bf16_t*)(F.ws + WS_HM) + ((b * SEQ + tq_abs) * D + 3 * kvh * 64 + 4 * kg);
#pragma unroll
        for (int g = 0; g < 3; ++g) { const float sc = sigm(NSA_GATEP[3 * g + 2]) / fmaxf(lacc[g].x, 1e-30f);
#pragma unroll
            for (int dt = 0; dt < 4; ++dt) { u32x2 o = otp[(g * 4 + dt) * 64 + lane]; acc_pk(o, ob[g][dt] * sc); *(u32x2*)(mixp + g * 64 + 16 * dt) = o; } }
    }
}

__device__ __forceinline__ void moba_task(Frame& F, int b, int h, int own) {
    const int lane = F.lane, tid = F.tid, wv = F.wave, q = lane & 15, kg = lane >> 4;
    LAS bf16_t* Kb = (LAS bf16_t*)(F.lds + AT_K0); LAS bf16_t* Vb = (LAS bf16_t*)(F.lds + AT_V0); LAS bf16_t* Km = (LAS bf16_t*)(F.lds + AT_KMEAN);
    const size_t slab = (size_t)(b * 4 + h) * SEQ * 64;
    const bf16_t* Qg = (const bf16_t*)(F.ws + WS_MQKV) + slab; const bf16_t* Kg = Qg + MQKV_STRIDE; const bf16_t* Vg = Kg + MQKV_STRIDE;
    const int tw0 = 256 * own + 32 * wv;
    bf16x8 qf[2][2];
#pragma unroll
    for (int rt = 0; rt < 2; ++rt) { const bf16_t* qp = Qg + ((tw0 + 16 * rt + q) * 64 + 8 * kg); qf[rt][0] = *(const bf16x8*)qp; qf[rt][1] = *(const bf16x8*)(qp + 32); }
    if (tid < 256) { const u32x4 v = *(const u32x4*)((const bf16_t*)(F.ws + WS_KMEAN) + (size_t)(b * 4 + h) * 2048 + (tid >> 3) * 64 + (tid & 7) * 8); *(LAS u32x4*)(Km + (tid >> 3) * KP + (tid & 7) * 8) = v; }
    __syncthreads();
    unsigned msk[2] = {0u, 0u};
    {
        f32x4 gs[2][2];
#pragma unroll
        for (int kt = 0; kt < 2; ++kt) { const bf16x8 k0 = lds_frag(Km, 16 * kt + q, 8 * kg), k1 = lds_frag(Km, 16 * kt + q, 32 + 8 * kg);
#pragma unroll
            for (int rt = 0; rt < 2; ++rt) { f32x4 z = (f32x4){0.f, 0.f, 0.f, 0.f}; z = MFMA16(k0, qf[rt][0], z); gs[rt][kt] = MFMA16(k1, qf[rt][1], z); } }
#pragma unroll
        for (int rt = 0; rt < 2; ++rt) {
            float gv[8];
#pragma unroll
            for (int kt = 0; kt < 2; ++kt)
#pragma unroll
                for (int r = 0; r < 4; ++r) { const int blk = 16 * kt + 4 * kg + r; gv[4 * kt + r] = (blk < own) ? gs[rt][kt][r] : -INFINITY; }
            for (int it = 0; it < 3; ++it) {
                float bv = -INFINITY; int bs = 1 << 20;
#pragma unroll
                for (int k = 0; k < 8; ++k) { const int blk = 16 * (k >> 2) + 4 * kg + (k & 3); if (gv[k] > bv) { bv = gv[k]; bs = blk; } }
#pragma unroll
                for (int sh = 16; sh <= 32; sh <<= 1) { const float ov = shx(bv, sh, lane); const int os = shxi(bs, sh, lane); if (ov > bv || (ov == bv && os < bs)) { bv = ov; bs = os; } }
                if (bs < 32) { msk[rt] |= 1u << bs;
#pragma unroll
                    for (int k = 0; k < 8; ++k) if (16 * (k >> 2) + 4 * kg + (k & 3) == bs) gv[k] = -INFINITY; }
            }
        }
    }
    float m[2] = {-INFINITY, -INFINITY}; float cm[2] = {0.f, 0.f}; f32x4 lacc[2] = {(f32x4){0.f, 0.f, 0.f, 0.f}, (f32x4){0.f, 0.f, 0.f, 0.f}};
    f32x4 ob[2][4], st[2][4];
#pragma unroll
    for (int rt = 0; rt < 2; ++rt)
#pragma unroll
        for (int dt = 0; dt < 4; ++dt) ob[rt][dt] = (f32x4){0.f, 0.f, 0.f, 0.f};
    const int ntile = 4 * own + 4;
    u32x4 kr[2], vr[2];
    kr[0] = tile_load(Kg, tid); vr[0] = tile_load(Vg, tid); kr[1] = tile_load(Kg + 4096, tid); vr[1] = tile_load(Vg + 4096, tid);
    tile_store(Kb, tid, kr[0]); tile_store(Vb, tid, vr[0]); __syncthreads();
    for (int tau0 = 0; tau0 < ntile; tau0 += 2) {
#pragma unroll
        for (int u = 0; u < 2; ++u) {
            const int tau = tau0 + u;
            if (tau + 2 < ntile) { kr[u] = tile_load(Kg + (tau + 2) * 4096, tid); vr[u] = tile_load(Vg + (tau + 2) * 4096, tid); }
            const LAS bf16_t* Kt = Kb + (tau & 1) * (TILE_B / 2); const LAS bf16_t* Vt = Vb + (tau & 1) * (TILE_B / 2);
            const int blk = tau >> 2;
            bool sel[2]; bool anyv = false;
#pragma unroll
            for (int rt = 0; rt < 2; ++rt) { sel[rt] = (blk < own) ? ((msk[rt] >> blk) & 1u) : (64 * (tau & 3) <= 32 * wv + 16 * rt + q); anyv = anyv || sel[rt]; }
            if (__any(anyv)) {
                const bool selk[2] = {(blk < own) ? sel[0] : true, (blk < own) ? sel[1] : true};
                qk_tile<2>(Kt, qf, st, cm, lane, selk);
                if (blk >= own) {
#pragma unroll
                    for (int rt = 0; rt < 2; ++rt) {
                        const int trel = 32 * wv + 16 * rt + q;
#pragma unroll
                        for (int kt = 0; kt < 4; ++kt)
#pragma unroll
                            for (int r = 0; r < 4; ++r) { const int kk = 64 * (tau & 3) + 16 * kt + 4 * kg + r; st[rt][kt][r] = (kk <= trel) ? st[rt][kt][r] : -INFINITY; }
                    }
                }
                softmax_tiles<2>(st, ob, lacc, m, cm, lane);
                pv_tile<2, true>(Vt, st, ob, lacc, lane);
            }
            if (tau + 1 < ntile) { tile_store(Kb + ((tau + 1) & 1) * (TILE_B / 2), tid, kr[u ^ 1]); tile_store(Vb + ((tau + 1) & 1) * (TILE_B / 2), tid, vr[u ^ 1]); }
            __syncthreads();
        }
    }
#pragma unroll
    for (int rt = 0; rt < 2; ++rt) {
        const float sc = 1.f / fmaxf(lacc[rt].x, 1e-30f);
        bf16_t* mix = (bf16_t*)(F.ws + WS_HM) + ((b * SEQ + tw0 + 16 * rt + q) * D + 384 + h * 64 + 4 * kg);
#pragma unroll
        for (int dt = 0; dt < 4; ++dt) { const f32x4 v = ob[rt][dt] * sc; u32x2 o; o.x = pk2(v.x, v.y); o.y = pk2(v.z, v.w); *(u32x2*)(mix + 16 * dt) = o; }
    }
}

constexpr int R2_RING = 16384, R2_SLOT = 12288;
__device__ __forceinline__ void r2_issue(const bf16_t* pt, const bf16_t* zp, LAS unsigned char* slot) {
#pragma unroll
    for (int mt = 0; mt < 2; ++mt)
#pragma unroll
        for (int ks = 0; ks < 4; ++ks) __builtin_amdgcn_global_load_lds((const unsigned*)(pt + mt * 2048 + ks * 16), (LAS unsigned*)(slot + (mt * 4 + ks) * 1024), 16, 0, 0);
#pragma unroll
    for (int mt = 0; mt < 2; ++mt)
#pragma unroll
        for (int q = 0; q < 2; ++q) __builtin_amdgcn_global_load_lds((const unsigned*)(zp + mt * 2048 + q * 8), (LAS unsigned*)(slot + 8192 + (mt * 2 + q) * 1024), 16, 0, 0);
}
__device__ __forceinline__ void r2_wave(Frame& F, int widx) {
    const int chain = widx >> 1, hf = widx & 1, lane = F.lane, c31 = lane & 31, hi = lane >> 5;
    LAS bf16_t* sb = (LAS bf16_t*)(F.lds + R2_SBUF + F.wave * (32 * KP * 2));
    LAS unsigned char* ring = F.lds + R2_RING + F.wave * (4 * R2_SLOT);
    for (int i = lane; i < 32 * KP / 2; i += 64) ((LAS unsigned*)sb)[i] = 0u;
    const bf16_t* PTl = (const bf16_t*)(F.ws + WS_PT) + (size_t)chain * 128 * 4096 + c31 * 64 + 8 * hi;
    const bf16_t* ZPl = (const bf16_t*)(F.ws + WS_ZS) + (size_t)chain * 128 * 4096 + (hf * 64 + lane) * 16;
    bf16_t* SS = (bf16_t*)(F.ws + WS_SS) + (size_t)chain * 128 * 4096 + (32 * hf) * 64;
    r2_issue(PTl, ZPl, ring); r2_issue(PTl + 4096, ZPl + 4096, ring + R2_SLOT); r2_issue(PTl + 2 * 4096, ZPl + 2 * 4096, ring + 2 * R2_SLOT);
#pragma unroll 1
    for (int c = 0; c < 128; ++c) {
        const int cn = (c + 3 < 128) ? c + 3 : 127;
        r2_issue(PTl + cn * 4096, ZPl + cn * 4096, ring + ((c + 3) & 3) * R2_SLOT);
        asm volatile("s_waitcnt vmcnt(36)" ::: "memory");
        const LAS unsigned char* sl = ring + (c & 3) * R2_SLOT + lane * 16;
        f32x16 acc[2];
#pragma unroll
        for (int mt = 0; mt < 2; ++mt)
#pragma unroll
            for (int q = 0; q < 2; ++q) { const u32x4 z = *(const LAS u32x4*)(sl + 8192 + (mt * 2 + q) * 1024);
                acc[mt][8 * q + 0] = __uint_as_float(z.x << 16); acc[mt][8 * q + 1] = __uint_as_float(z.x & 0xffff0000u); acc[mt][8 * q + 2] = __uint_as_float(z.y << 16); acc[mt][8 * q + 3] = __uint_as_float(z.y & 0xffff0000u);
                acc[mt][8 * q + 4] = __uint_as_float(z.z << 16); acc[mt][8 * q + 5] = __uint_as_float(z.z & 0xffff0000u); acc[mt][8 * q + 6] = __uint_as_float(z.w << 16); acc[mt][8 * q + 7] = __uint_as_float(z.w & 0xffff0000u); }
#pragma unroll
        for (int ks = 0; ks < 4; ++ks) {
            const bf16x8 bx = *(const LAS bf16x8*)(sb + c31 * KP + 16 * ks + 8 * hi);
#pragma unroll
            for (int mt = 0; mt < 2; ++mt) { const bf16x8 pa = *(const LAS bf16x8*)(sl + (mt * 4 + ks) * 1024); acc[mt] = MFMA32(pa, bx, acc[mt]); }
        }
#pragma unroll
        for (int mt = 0; mt < 2; ++mt)
#pragma unroll
            for (int r = 0; r < 16; ++r) sb[c31 * KP + 32 * mt + (r & 3) + 8 * (r >> 2) + 4 * hi] = f2bf(acc[mt][r]);
        bf16_t* ss = SS + c * 4096;
#pragma unroll
        for (int j = 0; j < 4; ++j) { const int qd = lane + 64 * j, row = qd >> 3, ch = qd & 7; *(u32x4*)(ss + row * 64 + ch * 8) = *(const LAS u32x4*)(sb + row * KP + ch * 8); }
    }
    asm volatile("s_waitcnt vmcnt(0)" ::: "memory");
}

struct TaskTable { unsigned short v[512]; };
constexpr TaskTable make_tasks() {
    TaskTable t{}; int n = 0, a = 63, am = 0, c = 31, cm = 0;
    while (a >= 0 || c >= 0) {
        const int ca = (a >= 0) ? 96 * a + 1344 : -1, cc = (c >= 0) ? 128 * c + 128 : -1;
        if (ca >= cc) { t.v[n++] = (unsigned short)(0 * 512 + am * 64 + a); if (++am == 4) { am = 0; --a; } }
        else { t.v[n++] = (unsigned short)(1 * 512 + cm * 64 + c); if (++cm == 8) { cm = 0; --c; } }
    }
    return t;
}
__device__ const TaskTable g_tasks = make_tasks();

__device__ __forceinline__ void r3_task(Frame& F, int layer, int task) {
    const int chain = task >> 7, c = task & 127, b = chain / 6, h = chain % 6, lane = F.lane, c31 = lane & 31, hi = lane >> 5;
    const bf16_t* S0 = (const bf16_t*)(F.ws + WS_SS) + (size_t)(task - 1) * 4096;
    const bf16_t* YT = (const bf16_t*)(F.ws + WS_YT) + (size_t)task * 4096;
    const bf16_t* Y0 = (const bf16_t*)(F.ws + WS_Y0) + (size_t)task * 4096;
    const bf16_t* rf = (const bf16_t*)(F.ws + WS_RFEAT);
    const bf16_t* gut = (const bf16_t*)(F.ws + WS_GUPT) + (size_t)(h * 64) * 128;
    const float* mu = INF(F, I_MU) + layer * RW;
    f32x16 acc[2][2], gacc[2][2];
#pragma unroll
    for (int a = 0; a < 2; ++a)
#pragma unroll
        for (int n = 0; n < 2; ++n)
#pragma unroll
            for (int r = 0; r < 16; ++r) { acc[a][n][r] = 0.f; gacc[a][n][r] = 0.f; }
    if (c > 0) {
#pragma unroll
        for (int ks = 0; ks < 4; ++ks) {
            bf16x8 af[2], bfr[2];
#pragma unroll
            for (int mt = 0; mt < 2; ++mt) af[mt] = *(const bf16x8*)(S0 + (32 * mt + c31) * 64 + 16 * ks + 8 * hi);
#pragma unroll
            for (int nt = 0; nt < 2; ++nt) bfr[nt] = *(const bf16x8*)(YT + (32 * nt + c31) * 64 + 16 * ks + 8 * hi);
#pragma unroll
            for (int mt = 0; mt < 2; ++mt)
#pragma unroll
                for (int nt = 0; nt < 2; ++nt) acc[mt][nt] = MFMA32(af[mt], bfr[nt], acc[mt][nt]);
        }
    }
#pragma unroll
    for (int ks = 0; ks < 8; ++ks) {
        bf16x8 af[2], bfr[2];
#pragma unroll
        for (int mt = 0; mt < 2; ++mt) af[mt] = *(const bf16x8*)(gut + (32 * mt + c31) * 128 + 16 * ks + 8 * hi);
#pragma unroll
        for (int nt = 0; nt < 2; ++nt) {
            const int t = 64 * c + 32 * nt + c31, j0 = 16 * ks + 8 * hi; const size_t row = (size_t)b * SEQ + t;
            const u32x4 cu = *(const u32x4*)(rf + row * RW + 1280 + j0);
            u32x4 pv = (u32x4){0u, 0u, 0u, 0u}; if (t > 0) pv = *(const u32x4*)(rf + (row - 1) * RW + 1280 + j0);
            const f32x4 m0 = *(const f32x4*)(mu + 1280 + j0), m1 = *(const f32x4*)(mu + 1280 + j0 + 4);
            float cv[8], pw[8];
            cv[0] = __uint_as_float(cu.x << 16); cv[1] = __uint_as_float(cu.x & 0xffff0000u); cv[2] = __uint_as_float(cu.y << 16); cv[3] = __uint_as_float(cu.y & 0xffff0000u);
            cv[4] = __uint_as_float(cu.z << 16); cv[5] = __uint_as_float(cu.z & 0xffff0000u); cv[6] = __uint_as_float(cu.w << 16); cv[7] = __uint_as_float(cu.w & 0xffff0000u);
            pw[0] = __uint_as_float(pv.x << 16); pw[1] = __uint_as_float(pv.x & 0xffff0000u); pw[2] = __uint_as_float(pv.y << 16); pw[3] = __uint_as_float(pv.y & 0xffff0000u);
            pw[4] = __uint_as_float(pv.z << 16); pw[5] = __uint_as_float(pv.z & 0xffff0000u); pw[6] = __uint_as_float(pv.w << 16); pw[7] = __uint_as_float(pv.w & 0xffff0000u);
            const float mm[8] = {m0.x, m0.y, m0.z, m0.w, m1.x, m1.y, m1.z, m1.w};
            float sg[8];
#pragma unroll
            for (int k = 0; k < 8; ++k) sg[k] = sigm(cv[k] + (pw[k] - cv[k]) * mm[k]);
            u32x4 u; u.x = pk2(sg[0], sg[1]); u.y = pk2(sg[2], sg[3]); u.z = pk2(sg[4], sg[5]); u.w = pk2(sg[6], sg[7]);
            bfr[nt] = __builtin_bit_cast(bf16x8, u);
        }
#pragma unroll
        for (int mt = 0; mt < 2; ++mt)
#pragma unroll
            for (int nt = 0; nt < 2; ++nt) gacc[mt][nt] = MFMA32(af[mt], bfr[nt], gacc[mt][nt]);
    }
    const float* lnw = INF(F, I_LNW) + layer * 384 + h * 64; const float* lnb = INF(F, I_LNB) + layer * 384 + h * 64;
    const float* bonus = (const float*)(F.ws + WS_BONUS);
    bf16_t* mix = (bf16_t*)(F.ws + WS_HM);
#pragma unroll
    for (int nt = 0; nt < 2; ++nt) {
        const int tl = 32 * nt + c31, t = 64 * c + tl; const size_t row = (size_t)b * SEQ + t;
        float s = 0.f;
#pragma unroll
        for (int mt = 0; mt < 2; ++mt)
#pragma unroll
            for (int rq = 0; rq < 4; ++rq) {
                const u32x2 y = *(const u32x2*)(Y0 + tl * 64 + 32 * mt + 8 * rq + 4 * hi);
                acc[mt][nt][4 * rq + 0] += __uint_as_float(y.x << 16); acc[mt][nt][4 * rq + 1] += __uint_as_float(y.x & 0xffff0000u);
                acc[mt][nt][4 * rq + 2] += __uint_as_float(y.y << 16); acc[mt][nt][4 * rq + 3] += __uint_as_float(y.y & 0xffff0000u);
                s += (acc[mt][nt][4 * rq] + acc[mt][nt][4 * rq + 1]) + (acc[mt][nt][4 * rq + 2] + acc[mt][nt][4 * rq + 3]);
            }
        s += shx(s, 32, lane);
        const float mean = s * (1.f / 64.f);
        float vs = 0.f;
#pragma unroll
        for (int mt = 0; mt < 2; ++mt)
#pragma unroll
            for (int r = 0; r < 16; ++r) { const float d = acc[mt][nt][r] - mean; vs += d * d; }
        vs += shx(vs, 32, lane);
        const float rstd = rsqrtf(vs * (1.f / 64.f) + 64e-5f);
        const float bn = bonus[row * 8 + h];
#pragma unroll
        for (int mt = 0; mt < 2; ++mt)
#pragma unroll
            for (int rq = 0; rq < 4; ++rq) {
                const int v0 = 32 * mt + 8 * rq + 4 * hi;
                const u32x2 vc = *(const u32x2*)(rf + row * RW + 768 + h * 64 + v0);
                u32x2 vp = (u32x2){0u, 0u}; if (t > 0) vp = *(const u32x2*)(rf + (row - 1) * RW + 768 + h * 64 + v0);
                const f32x4 mv = *(const f32x4*)(mu + 768 + h * 64 + v0), lw = *(const f32x4*)(lnw + v0), lb = *(const f32x4*)(lnb + v0);
                const float vcur[4] = {__uint_as_float(vc.x << 16), __uint_as_float(vc.x & 0xffff0000u), __uint_as_float(vc.y << 16), __uint_as_float(vc.y & 0xffff0000u)};
                const float vprv[4] = {__uint_as_float(vp.x << 16), __uint_as_float(vp.x & 0xffff0000u), __uint_as_float(vp.y << 16), __uint_as_float(vp.y & 0xffff0000u)};
                const float mvv[4] = {mv.x, mv.y, mv.z, mv.w}, lwv[4] = {lw.x, lw.y, lw.z, lw.w}, lbv[4] = {lb.x, lb.y, lb.z, lb.w};
                float o[4];
#pragma unroll
                for (int k = 0; k < 4; ++k) {
                    const float vsh = vcur[k] + (vprv[k] - vcur[k]) * mvv[k];
                    const float y = (acc[mt][nt][4 * rq + k] - mean) * rstd * lwv[k] + lbv[k];
                    o[k] = (y + bn * vsh) * gacc[mt][nt][4 * rq + k];
                }
                u32x2 ov; ov.x = pk2(o[0], o[1]); ov.y = pk2(o[2], o[3]);
                *(u32x2*)(mix + row * D + 640 + h * 64 + v0) = ov;
            }
    }
}
__device__ __forceinline__ void mixnorm_rows(Frame& F, int layer, int m0, int nrows) {
    bf16_t* mix = (bf16_t*)(F.ws + WS_HM);
    const float* gn = INF(F, I_NNSA) + layer * 384; const float* gm = INF(F, I_NMOBA) + layer * 256;
    const int lane = F.lane;
    for (int m = m0 + F.wave; m < m0 + nrows; m += NWAVES) {
        unsigned* rowp = (unsigned*)(mix + (size_t)m * D);
        unsigned a[3], c[2]; float sa = 0.f, sc = 0.f;
#pragma unroll
        for (int j = 0; j < 3; ++j) { a[j] = rowp[lane + 64 * j]; const float x = __uint_as_float(a[j] << 16), y = __uint_as_float(a[j] & 0xffff0000u); sa += x * x + y * y; }
#pragma unroll
        for (int j = 0; j < 2; ++j) { c[j] = rowp[192 + lane + 64 * j]; const float x = __uint_as_float(c[j] << 16), y = __uint_as_float(c[j] & 0xffff0000u); sc += x * x + y * y; }
        const float ra = rsqrtf(wave_sum(sa, lane) * (1.f / 384.f) + NORM_EPS), rc = rsqrtf(wave_sum(sc, lane) * (1.f / 256.f) + NORM_EPS);
#pragma unroll
        for (int j = 0; j < 3; ++j) { const int col = 2 * (lane + 64 * j); rowp[lane + 64 * j] = pk2(__uint_as_float(a[j] << 16) * ra * gn[col], __uint_as_float(a[j] & 0xffff0000u) * ra * gn[col + 1]); }
#pragma unroll
        for (int j = 0; j < 2; ++j) { const int col = 2 * (lane + 64 * j); rowp[192 + lane + 64 * j] = pk2(__uint_as_float(c[j] << 16) * rc * gm[col], __uint_as_float(c[j] & 0xffff0000u) * rc * gm[col + 1]); }
    }
}
__device__ __forceinline__ void phase_e(Frame& F, int layer) {
    const int gw = F.bid * NWAVES + F.wave, NGW = F.G * NWAVES;
    (void)gw; (void)NGW; (void)layer;
}

constexpr int CW_TILE = 1536;
constexpr int CW_R2DONE = 512;
__device__ __forceinline__ void phase_d(Frame& F, int layer, int rep = 0) {
    if (F.bid < 12 && rep == 0) {
        await_count(F, F.ctl + CW_R1DONE + 64 * layer + F.bid, 16u);
        if (F.wave < 2) { r2_wave(F, F.bid * 2 + F.wave);
            __builtin_amdgcn_fence(__ATOMIC_RELEASE, "agent"); asm volatile("s_waitcnt vmcnt(0)" ::: "memory");
            if (F.lane == 0) (void)__hip_atomic_fetch_add(F.ctl + CW_R2DONE + 64 * layer, 1u, RLX_AGENT); }
        __syncthreads();
#if DBG_MODE == 4
        if (F.bid == 0 && layer == 0) __hip_atomic_store(F.ctl + 3200 + 30, (unsigned)__builtin_amdgcn_s_memrealtime(), RLX_AGENT);
#endif
    }
    LAUNDER(F);
    await_count(F, F.ctl + CW_PREP + 64 * layer, 64u);
    LAUNDER(F);
    volatile LAS int* tw = (volatile LAS int*)(F.lds + AT_MISC);
    unsigned* qh = F.ctl + CW_Q + 64 * layer + 16 * rep;
    const int ntask = (rep == 0) ? 512 + 192 + 128 : 512;
    for (;;) {
        if (F.tid == 0) tw[0] = (int)__hip_atomic_fetch_add(qh, 1u, RLX_AGENT);
        __syncthreads();
        const int k = __builtin_amdgcn_readfirstlane(tw[0]);
        __syncthreads();
        if (k >= ntask) break;
        LAUNDER(F);
        if (k >= 512 + 192) {
            const int tile = k - (512 + 192);
            await_count(F, F.ctl + CW_TILE + 128 * layer + tile, 6u);
            mixnorm_rows(F, layer, tile * 128, 128);
            continue;
        }
        if (k >= 512) {
            if (F.tid == 0) { unsigned sp = 0; while ((unsigned)__builtin_amdgcn_readfirstlane(__hip_atomic_load(F.ctl + CW_R2DONE + 64 * layer, RLX_AGENT)) < 24u) { __builtin_amdgcn_s_sleep(4); if (++sp > (1u << 24)) break; }
                __builtin_amdgcn_fence(__ATOMIC_ACQUIRE, "agent"); asm volatile("s_waitcnt vmcnt(0)" ::: "memory"); }
            __syncthreads();
            r3_task(F, layer, (k - 512) * 8 + F.wave);
            continue;
        }
        const int code = g_tasks.v[k], ty = code >> 9, mm = (code >> 6) & 7, jj = code & 63;
        if (ty == 0) nsa_task(F, mm >> 1, mm & 1, jj); else moba_task(F, mm >> 2, mm & 3, jj);
        if (rep == 0) {
            asm volatile("s_waitcnt vmcnt(0)" ::: "memory"); __syncthreads();
            if (F.tid == 0) { __builtin_amdgcn_fence(__ATOMIC_RELEASE, "agent"); asm volatile("s_waitcnt vmcnt(0)" ::: "memory");
                unsigned* tc = F.ctl + CW_TILE + 128 * layer;
                if (ty == 0) (void)__hip_atomic_fetch_add(tc + (mm >> 1) * 64 + jj, 1u, RLX_AGENT);
                else { (void)__hip_atomic_fetch_add(tc + (mm >> 2) * 64 + 2 * jj, 1u, RLX_AGENT); (void)__hip_atomic_fetch_add(tc + (mm >> 2) * 64 + 2 * jj + 1, 1u, RLX_AGENT); } }
        }
    }
}

__device__ __forceinline__ void phase_g1(Frame& F, int layer) {
    LAS float* wr = (LAS float*)F.lds;
    { const float* W = INF(F, I_WROUTER);
#pragma unroll 1
      for (int i0 = 0; i0 < 4096; i0 += 2048) { f32x4 t4[4];
#pragma unroll
          for (int u = 0; u < 4; ++u) t4[u] = *(const f32x4*)(W + 4 * (i0 + u * NTHR + F.tid));
#pragma unroll
          for (int u = 0; u < 4; ++u) { const int i = 4 * (i0 + u * NTHR + F.tid), k = i >> 4, e = i & 15;
              wr[e * 1028 + k] = t4[u].x; wr[(e + 1) * 1028 + k] = t4[u].y; wr[(e + 2) * 1028 + k] = t4[u].z; wr[(e + 3) * 1028 + k] = t4[u].w; } } }
    __syncthreads();
    const float* mod = (const float*)(F.ws + WS_MOD);
    bf16_t* H = (bf16_t*)(F.ws + WS_HM);
    unsigned* cnt = F.ctl + CW_CNT + 64 * layer;
    const float* rb = INF(F, I_RBIAS);
    const float* gn = INF(F, I_NFFN) + layer * D;
    const int gw = F.bid * NWAVES + F.wave, NGW = F.G * NWAVES;
    f32x4 vnext[4];
#pragma unroll
    for (int j = 0; j < 4; ++j) vnext[j] = *(const f32x4*)(F.out + (size_t)gw * D + 4 * F.lane + 256 * j);
    int px = 0, pm = 0; float pw = 0.f; int ridx = 0;
    for (int m = gw; m < T; m += NGW, ++ridx) {
        int lane = F.lane; asm volatile("" : "+v"(lane));
        const int b = m >> 13;
        const float* sh = mod + ((size_t)layer * BATCH + b) * 6144 + 3072; const float* sc = sh + 1024;
        f32x4 v[4]; float ss = 0.f;
#pragma unroll
        for (int j = 0; j < 4; ++j) { v[j] = vnext[j]; ss += (v[j].x * v[j].x + v[j].y * v[j].y) + (v[j].z * v[j].z + v[j].w * v[j].w); }
        { const int mn = (m + NGW < T) ? m + NGW : m;
#pragma unroll
          for (int j = 0; j < 4; ++j) vnext[j] = *(const f32x4*)(F.out + (size_t)mn * D + 4 * lane + 256 * j); }
        const float rstd = rsqrtf(wave_sum(ss, lane) * (1.f / D) + NORM_EPS);
        float lg[16]; f32x2_t lgp[16];
#pragma unroll
        for (int e = 0; e < 16; ++e) lgp[e] = (f32x2_t){0.f, 0.f};
#pragma unroll
        for (int j = 0; j < 4; ++j) { const int col = 4 * lane + 256 * j;
            const f32x4 g = *(const f32x4*)(gn + col), s1 = *(const f32x4*)(sc + col), s0 = *(const f32x4*)(sh + col);
            const float hx = v[j].x * rstd * g.x * (1.f + s1.x) + s0.x, hy = v[j].y * rstd * g.y * (1.f + s1.y) + s0.y, hz = v[j].z * rstd * g.z * (1.f + s1.z) + s0.z, hw = v[j].w * rstd * g.w * (1.f + s1.w) + s0.w;
            u32x2 o; o.x = pk2(hx, hy); o.y = pk2(hz, hw); *(u32x2*)(H + (size_t)m * D + col) = o;
            const f32x2_t h01 = {hx, hy}, h23 = {hz, hw};
#pragma unroll
            for (int e = 0; e < 16; ++e) { const f32x4 w4 = *(const LAS f32x4*)(wr + e * 1028 + col);
                lgp[e] = __builtin_elementwise_fma(h01, (f32x2_t){w4.x, w4.y}, lgp[e]); lgp[e] = __builtin_elementwise_fma(h23, (f32x2_t){w4.z, w4.w}, lgp[e]); }
        }
#pragma unroll
        for (int e = 0; e < 16; ++e) lg[e] = lgp[e].x + lgp[e].y;
        float r8[8], r4[4], r2[2], r1;
#pragma unroll
        for (int e = 0; e < 8; ++e) { auto sw = __builtin_amdgcn_permlane32_swap(__float_as_uint(lg[e]), __float_as_uint(lg[e + 8]), false, false); r8[e] = __uint_as_float(sw[0]) + __uint_as_float(sw[1]); }
#pragma unroll
        for (int e = 0; e < 4; ++e) { auto sw = __builtin_amdgcn_permlane16_swap(__float_as_uint(r8[e]), __float_as_uint(r8[e + 4]), false, false); r4[e] = __uint_as_float(sw[0]) + __uint_as_float(sw[1]); }
        { const bool up = (lane & 8) != 0;
#pragma unroll
          for (int e = 0; e < 2; ++e) { const float keep = up ? r4[e + 2] : r4[e], send = up ? r4[e] : r4[e + 2]; r2[e] = keep + dpp_mov<0x140>(send); } }
        { const bool up = (lane & 4) != 0; const float keep = up ? r2[1] : r2[0], send = up ? r2[0] : r2[1]; r1 = keep + dpp_mov<0x141>(send); }
        r1 += dpp_mov<0x4E>(r1); r1 += dpp_mov<0xB1>(r1);
        const int el = (((lane >> 5) & 1) << 3) | (((lane >> 4) & 1) << 2) | (((lane >> 3) & 1) << 1) | ((lane >> 2) & 1);
        const float affl = sigm(r1), bial = affl + rb[el];
        float aff[16], bia[16];
#pragma unroll
        for (int e = 0; e < 16; ++e) { const int src = ((e & 8) ? 32 : 0) | ((e & 4) ? 16 : 0) | ((e & 2) ? 8 : 0) | ((e & 1) ? 4 : 0);
            aff[e] = __uint_as_float(__builtin_amdgcn_readlane(__float_as_uint(affl), src)); bia[e] = __uint_as_float(__builtin_amdgcn_readlane(__float_as_uint(bial), src)); }
        int best = 0; float bscore = -INFINITY;
#pragma unroll
        for (int g = 0; g < 4; ++g) {
            float t1 = -INFINITY, t2 = -INFINITY;
#pragma unroll
            for (int k = 0; k < 4; ++k) { const float x = bia[4 * g + k]; if (x > t1) { t2 = t1; t1 = x; } else if (x > t2) t2 = x; }
            const float gs = t1 + t2; if (gs > bscore) { bscore = gs; best = g; }
        }
        float x4[4], a4[4];
#pragma unroll
        for (int k = 0; k < 4; ++k) { x4[k] = (best == 0) ? bia[k] : (best == 1) ? bia[4 + k] : (best == 2) ? bia[8 + k] : bia[12 + k]; a4[k] = (best == 0) ? aff[k] : (best == 1) ? aff[4 + k] : (best == 2) ? aff[8 + k] : aff[12 + k]; }
        int i1 = 0; float v1 = x4[0];
#pragma unroll
        for (int k = 1; k < 4; ++k) if (x4[k] > v1) { v1 = x4[k]; i1 = k; }
        int i2 = -1; float v2 = -INFINITY;
#pragma unroll
        for (int k = 0; k < 4; ++k) if (k != i1 && x4[k] > v2) { v2 = x4[k]; i2 = k; }
        float w1 = 0.f, w2 = 0.f;
#pragma unroll
        for (int k = 0; k < 4; ++k) { if (k == i1) w1 = a4[k]; if (k == i2) w2 = a4[k]; }
        const float ws = w1 + w2; w1 /= ws; w2 /= ws;
        if (lane == 2 * ridx) { px = 4 * best + i1; pm = m; pw = w1; }
        if (lane == 2 * ridx + 1) { px = 4 * best + i2; pm = m; pw = w2; }
    }
    {
        const int lane = F.lane; const int np = 2 * ridx;
        int rank = 0, total = 0, leader = 64;
        for (int j = 0; j < np; ++j) { const int xj = __builtin_amdgcn_readlane(px, j); const bool same = (xj == px); rank += (same && j < lane) ? 1 : 0; total += same ? 1 : 0; leader = (same && j < leader) ? j : leader; }
        int base = 0;
        if (lane < np && rank == 0) base = (int)__hip_atomic_fetch_add(cnt + px, (unsigned)total, RLX_AGENT);
        base = __builtin_amdgcn_ds_bpermute((leader & 63) << 2, base);
        if (lane < np) { const int idx = px * 16384 + base + rank; ((int*)(F.ws + WS_ELIST))[idx] = 2 * pm + (lane & 1); ((float*)(F.ws + WS_EWW))[idx] = pw; }
    }
    asm volatile("s_waitcnt vmcnt(0)" ::: "memory"); __syncthreads();
    if (F.wave == 0) {
        unsigned tk = 0;
        if (F.lane == 0) { __builtin_amdgcn_fence(__ATOMIC_RELEASE, "agent"); asm volatile("s_waitcnt vmcnt(0)" ::: "memory"); tk = __hip_atomic_fetch_add(cnt + 32, 1u, RLX_AGENT); }
        tk = (unsigned)__builtin_amdgcn_readfirstlane((int)tk);
        if (tk == (unsigned)F.G - 1u) {
            __builtin_amdgcn_fence(__ATOMIC_ACQUIRE, "agent");
            const int lane = F.lane;
            int* tile_e = (int*)(F.ws + WS_ROWINFO + layer * ROWINFO_LSTRIDE) + 2 * MAXROWS;
            const int c = (lane < 16) ? (int)__hip_atomic_load(cnt + (lane & 15), RLX_AGENT) : 0, nt = (c + 255) >> 8;
            int ofs = 0, tot = 0;
            for (int e = 0; e < 16; ++e) { const int ne = __builtin_amdgcn_readlane(nt, e) << 8; ofs += (e < lane) ? ne : 0; tot += ne; }
            if (lane < 16) { tile_e[TE_OFF + lane] = ofs; tile_e[TE_CNT + lane] = c; for (int j = 0; j < nt; ++j) tile_e[(ofs >> 8) + j] = lane; }
            if (lane == 0) tile_e[256] = tot >> 8;
        }
    }
}
__device__ __forceinline__ void phase_g2(Frame& F, int layer) {
    volatile LAS int* off = (volatile LAS int*)F.lds;
    unsigned* cnt = F.ctl + CW_CNT + 64 * layer;
    int* rowinfo = (int*)(F.ws + WS_ROWINFO + layer * ROWINFO_LSTRIDE); float* roww = (float*)(rowinfo + MAXROWS); int* tile_e = rowinfo + 2 * MAXROWS; int* ntl = tile_e + 256;
    if (F.tid == 0) { int o = 0; for (int e = 0; e < 16; ++e) { off[e] = o; const int c = (int)__hip_atomic_load(cnt + e, RLX_AGENT); o += ((c + 255) >> 8) << 8; } off[16] = o; }
    __syncthreads();
    if (F.bid == 0) {
        if (F.tid == 0) ntl[0] = off[16] >> 8;
        for (int e = 0; e < 16; ++e) {
            const int c = (int)__hip_atomic_load(cnt + e, RLX_AGENT), o0 = off[e], o1 = off[e + 1];
            for (int r = o0 + c + F.tid; r < o1; r += NTHR) { rowinfo[r] = -1; roww[r] = 0.f; }
            for (int tl = (o0 >> 8) + F.tid; tl < (o1 >> 8); tl += NTHR) tile_e[tl] = e;
        }
    }
    const int* route = (const int*)(F.ws + WS_ROUTE);
    const int gw = F.bid * NWAVES + F.wave, NGW = F.G * NWAVES, lane = F.lane;
    for (int m = gw; m < T; m += NGW) {
        const int* rp = route + (size_t)m * 8;
        const int e1 = ld_ctl(rp), e2 = ld_ctl(rp + 1), p1 = ld_ctl(rp + 2), p2 = ld_ctl(rp + 3);
        const int r1 = off[e1] + p1, r2 = off[e2] + p2;
        if (lane == 0) { rowinfo[r1] = 2 * m; rowinfo[r2] = 2 * m + 1; roww[r1] = __int_as_float(ld_ctl(rp + 4)); roww[r2] = __int_as_float(ld_ctl(rp + 5)); }
    }
}

#if DBG_MODE == 2
__device__ __forceinline__ void dbg_flag(Frame& F, bool bad, unsigned code) { if (__any(bad) && F.lane == 0) atomicCAS(F.ctl + CW_DBG, 0u, code); }
__device__ __forceinline__ void scan_bf16(Frame& F, size_t off, size_t n, unsigned code) {
    const unsigned* p = (const unsigned*)(F.ws + off); bool bad = false;
    for (size_t i = (size_t)F.bid * NTHR + F.tid; i < n / 2; i += (size_t)F.G * NTHR) { const unsigned u = p[i]; bad = bad || ((u & 0x7f80u) == 0x7f80u) || ((u & 0x7f800000u) == 0x7f800000u); }
    dbg_flag(F, bad, code); }
__device__ __forceinline__ void scan_f32p(Frame& F, const float* p, size_t n, unsigned code) {
    bool bad = false;
    for (size_t i = (size_t)F.bid * NTHR + F.tid; i < n; i += (size_t)F.G * NTHR) { const unsigned u = __float_as_uint(p[i]); bad = bad || ((u & 0x7f800000u) == 0x7f800000u); }
    dbg_flag(F, bad, code); }
__device__ __forceinline__ void dbg_check(Frame& F, int p) {
    const unsigned code = (unsigned)(p + 1);
    if (DBG_SUB >= 4) {
        if (p != DBG_P) return;
        const size_t off = (DBG_SUB == 4) ? WS_ZS : (DBG_SUB == 5) ? WS_PT : (DBG_SUB == 6) ? WS_YT : WS_Y0;
        const unsigned* q = (const unsigned*)(F.ws + off); unsigned mx = 0;
        for (size_t i = (size_t)F.bid * NTHR + F.tid; i < (size_t)1536 * 2048; i += (size_t)F.G * NTHR) { const unsigned u = q[i]; const unsigned e0 = (u >> 7) & 0xffu, e1 = (u >> 23) & 0xffu; mx = mx > e0 ? mx : e0; mx = mx > e1 ? mx : e1; }
#if DBG_CNT
        { unsigned cnt = 0; for (size_t i = (size_t)F.bid * NTHR + F.tid; i < (size_t)1536 * 2048; i += (size_t)F.G * NTHR) { const unsigned u = q[i]; cnt += (((u >> 7) & 0xffu) == 0xffu) + (((u >> 23) & 0xffu) == 0xffu); }
          if (cnt) atomicAdd(F.ctl + CW_DBG, cnt); return; }
#endif
        atomicMax(F.ctl + CW_DBG, mx); return; }
    if (DBG_SUB == 3 && p != 4) return;
    if (p == 0) { scan_f32p(F, (const float*)(F.ws + WS_COS), (size_t)T * 64, code); scan_f32p(F, (const float*)(F.ws + WS_MOD), 2 * 2 * 6144, code); return; }
    if (p > 10 * NL) return;
    const int sub = (p - 1) % 10;
    switch (sub) {
    case 0: scan_bf16(F, WS_HM, (size_t)T * D, code); scan_bf16(F, WS_WIN, (size_t)NPAD * D, code); scan_bf16(F, WS_WOUT, (size_t)D * D, code); scan_bf16(F, WS_WUP, (size_t)16 * 512 * D, code);
            scan_bf16(F, WS_WDN, (size_t)16 * D * 256, code); scan_bf16(F, WS_PHIW, (size_t)2 * 64 * 2048, code); scan_bf16(F, WS_GUPT, 384 * 128, code); scan_f32p(F, (const float*)(F.ws + WS_PHIB), 256, code); break;
    case 1: scan_bf16(F, WS_NQ, (size_t)T * 384, code); scan_bf16(F, WS_KV6, (size_t)6 * T * 128, code); scan_bf16(F, WS_MQKV, (size_t)3 * T * 256, code); scan_bf16(F, WS_RFEAT, (size_t)T * RW, code);
            scan_f32p(F, (const float*)(F.ws + WS_GATE), (size_t)T * 32, code); break;
    case 2: scan_bf16(F, WS_KCMP, 2 * 2 * 512 * 64, code); scan_bf16(F, WS_VCMP, 2 * 2 * 512 * 64, code); scan_bf16(F, WS_KMEAN, 2 * 4 * 32 * 64, code);
            scan_bf16(F, WS_PT, (size_t)1536 * 4096, code); scan_bf16(F, WS_ZS, (size_t)1536 * 4096, code); scan_bf16(F, WS_YT, (size_t)1536 * 4096, code); scan_bf16(F, WS_Y0, (size_t)1536 * 4096, code);
            scan_f32p(F, (const float*)(F.ws + WS_BONUS), (size_t)T * 8, code); break;
    case 3: {
#if DBG_SUB == 3
        if (p == 4) { const unsigned* hm = (const unsigned*)(F.ws + WS_HM); bool b1 = false, b2 = false, b4 = false;
            for (size_t i = (size_t)F.bid * NTHR + F.tid; i < (size_t)T * 512; i += (size_t)F.G * NTHR) { const unsigned u = hm[i]; const int col = (int)(i & 511) * 2; const bool bad = ((u & 0x7f80u) == 0x7f80u) || ((u & 0x7f800000u) == 0x7f800000u);
                if (col < 384) b1 = b1 || bad; else if (col < 640) b2 = b2 || bad; }
            const unsigned* zs = (const unsigned*)(F.ws + WS_ZS);
            for (size_t i = (size_t)F.bid * NTHR + F.tid; i < (size_t)1536 * 2048; i += (size_t)F.G * NTHR) { const unsigned u = zs[i]; b4 = b4 || ((u & 0x7f80u) == 0x7f80u) || ((u & 0x7f800000u) == 0x7f800000u); }
            const unsigned bits = (__any(b1) ? 1u : 0u) | (__any(b2) ? 2u : 0u) | (__any(b4) ? 4u : 0u);
            if (bits && F.lane == 0) atomicOr(F.ctl + CW_DBG, bits); }
#else
        scan_bf16(F, WS_HM, (size_t)T * D, code); scan_bf16(F, WS_ZS, (size_t)1536 * 4096, code);
#endif
        } break;
    case 4: scan_bf16(F, WS_HM, (size_t)T * D, code); break;
    case 5: scan_f32p(F, F.out, (size_t)T * D, code); break;
    case 6: scan_bf16(F, WS_HM, (size_t)T * D, code); break;
    case 7: scan_bf16(F, WS_SORTA, (size_t)MAXROWS * D, code); break;
    case 8: scan_bf16(F, WS_HID, (size_t)MAXROWS * 256, code); break;
    case 9: scan_bf16(F, WS_YS, (size_t)2 * T * D, code); break;
    }
}
#endif
struct Args { const void* in[31]; float* out; unsigned char* ws; int ph_lo, ph_hi; };
constexpr int N_PHASES = 2 + 10 * NL + (DBG_MODE ? 1 : 0);

__global__ void __launch_bounds__(NTHR, 2) hybrid_fwd(Args args) {
    extern __shared__ __attribute__((aligned(16))) unsigned char lds_raw[];
    Frame F;
    F.lds = (LAS unsigned char*)lds_raw;
    F.MISC = (volatile LAS unsigned*)(F.lds + MISC_OFF);
    F.tid = threadIdx.x; F.lane = F.tid & 63; F.wave = __builtin_amdgcn_readfirstlane(F.tid >> 6);
    F.G = gridDim.x; F.bid = blockIdx.x;
    F.ws = (unsigned char*)(GAS unsigned char*)args.ws; F.out = (float*)(GAS float*)args.out; F.ctl = (unsigned*)(GAS unsigned*)(args.ws + WS_CTL);
    for (int u = F.tid; u < (LDS_BYTES - RING_BYTES) / 4; u += NTHR) ((LAS unsigned*)(F.lds + RING_BYTES))[u] = 0u;
    __syncthreads();
    if (F.tid < 31) *(LAS unsigned long long*)(F.lds + IN_OFF + 8 * F.tid) = (unsigned long long)args.in[F.tid];
    __syncthreads();
#if MK_PER_PHASE
#define GRID_BAR() do { } while (0)
#else
    XcdBarrier bar = xcd_barrier_post(F.ctl + CW_BAR, F.MISC + 8);
#define GRID_BAR() do { LAUNDER(F); xcd_barrier(bar, F.tid); } while (0)
#endif
    const int lo = args.ph_lo, hi = args.ph_hi;
    for (int ph_ = lo; ph_ < hi; ++ph_) {
        int ph = ph_; asm volatile("" : "+s"(ph));
#if DBG_MODE == 2
        if (ph > 0) { LAUNDER(F); dbg_check(F, ph - 1); }
#endif
#if DBG_MODE == 4
        if (blockIdx.x == 0) { const unsigned tnow = (unsigned)__builtin_amdgcn_s_memrealtime(); __hip_atomic_store((unsigned*)(args.ws + WS_CTL) + 3200 + ph_, tnow, RLX_AGENT); }
#endif
        for (int rep = 0; rep < ((REPEAT_PH >= 0 && ph_ == REPEAT_PH) ? 2 : 1); ++rep) {
        if (rep) GRID_BAR();
        if (ph == 0) { if (PH_EN(10)) { LAUNDER(F); phase_pro(F); LAUNDER(F); phase_a(F, 0, false, true); } }
#if DBG_MODE
        else if (ph == N_PHASES - 1) { LAUNDER(F);
#if DBG_MODE == 4
            const float dv = 100.f * floorf(4.f * log2f((float)(unsigned)(ld_ctl((const int*)(F.ctl + 3200 + DBG_TPH1)) - ld_ctl((const int*)(F.ctl + 3200 + DBG_TPH0)))) + DBG_QOFF);
            const float dv2 = 10000.f * floorf(4.f * log2f((float)(unsigned)(ld_ctl((const int*)(F.ctl + 3200 + DBG_TPH3)) - ld_ctl((const int*)(F.ctl + 3200 + DBG_TPH2)))) + DBG_QOFF);
            for (int i = F.bid * NTHR + F.tid; i < T * D; i += F.G * NTHR) F.out[i] = (i == 0) ? dv2 : dv;
            if (0)
#else
            const float dv = sqrtf((float)ld_ctl((const int*)(F.ctl + CW_DBG)));
#endif
            for (int i = F.bid * NTHR + F.tid; i < T * D; i += F.G * NTHR) F.out[i] = dv; }
        else if (ph == N_PHASES - 2) { if (PH_EN(11)) { LAUNDER(F); norm_rows(F, 0, true); } }
#else
        else if (ph == N_PHASES - 1) { if (PH_EN(11)) { LAUNDER(F); norm_rows(F, 0, true); } }
#endif
        else {
            const int layer = (ph - 1) / 10, sub = (ph - 1) % 10;
            switch (sub) {
            case 0: if (PH_EN(0)) { LAUNDER(F); phase_a(F, layer, true, layer > 0); } break;
            case 1: if (PH_EN(1)) { LAUNDER(F); pg8::Gemm g{(const bf16_t*)(F.ws + WS_HM), (const bf16_t*)(F.ws + WS_WIN), T, NPAD, D}; pg8::StaticOrder S; S.init(T, NPAD, F.G, F.bid, NPAD / 256 - 1);
                      EpiInProj E{(bf16_t*)(F.ws + WS_NQ), (bf16_t*)(F.ws + WS_KV6), (bf16_t*)(F.ws + WS_MQKV), (bf16_t*)(F.ws + WS_RFEAT), (float*)(F.ws + WS_GATE), (const float*)(F.ws + WS_COS), (const float*)(F.ws + WS_SIN)};
                      if (rep == 0) pg8::gemm_phase<EpiInProj, pg8::StaticOrder, true, true>(F.lds, g, S, E, F.tid);
                      else { EpiNull EN{(float*)(F.ws + WS_GATE)}; pg8::gemm_phase<EpiNull, pg8::StaticOrder, true, true>(F.lds, g, S, EN, F.tid); } } break;
            case 2: if (PH_EN(2)) { LAUNDER(F); phase_c(F, layer); LAUNDER(F); phase_d(F, layer, rep); } break;
            case 3: break;
            case 4: if (PH_EN(4)) { LAUNDER(F); phase_e(F, layer); } break;
            case 5: if (PH_EN(5)) { LAUNDER(F); pg8::Gemm g{(const bf16_t*)(F.ws + WS_HM), (const bf16_t*)(F.ws + WS_WOUT), T, D, D}; pg8::StaticOrder S; S.init(T, D, F.G, F.bid);
                      EpiOutProj E{layer == 0 ? INF(F, I_X) : F.out, F.out, (const float*)(F.ws + WS_MOD) + (size_t)layer * BATCH * 6144 + 2048};
                      if (rep == 0) pg8::gemm_phase<EpiOutProj, pg8::StaticOrder, true, true>(F.lds, g, S, E, F.tid);
                      else { EpiNull EN{(float*)(F.ws + WS_GATE)}; pg8::gemm_phase<EpiNull, pg8::StaticOrder, true, true>(F.lds, g, S, EN, F.tid); } } break;
            case 6: if (PH_EN(6)) { LAUNDER(F); phase_g1(F, layer); } break;
            case 7: break;
            case 8: if (PH_EN(8)) { LAUNDER(F); const int* rowinfo = (const int*)(F.ws + WS_ROWINFO + layer * ROWINFO_LSTRIDE); const int* tile_e = rowinfo + 2 * MAXROWS;
                      const int ntl = __builtin_amdgcn_readfirstlane(ld_ctl(tile_e + 256));
                      pg8::Gemm g{(const bf16_t*)(F.ws + WS_HM), (const bf16_t*)(F.ws + WS_WUP), MAXROWS, 512, D};
                      MoeGatherOrder S{ntl, 2, F.G, F.bid, tile_e, (size_t)512 * D * 2, (const int*)(F.ws + WS_ELIST)};
                      EpiMoeUp E{(bf16_t*)(F.ws + WS_HID)};
                      pg8::gemm_phase<EpiMoeUp, MoeGatherOrder, true, true>(F.lds, g, S, E, F.tid); } break;
            case 9: if (PH_EN(9)) { LAUNDER(F); const int* rowinfo = (const int*)(F.ws + WS_ROWINFO + layer * ROWINFO_LSTRIDE); const int* tile_e = rowinfo + 2 * MAXROWS;
                      const int ntl = __builtin_amdgcn_readfirstlane(ld_ctl(tile_e + 256));
                      pg8::Gemm g{(const bf16_t*)(F.ws + WS_HID), (const bf16_t*)(F.ws + WS_WDN), MAXROWS, D, 256};
                      MoeOrder S{ntl, 4, F.G, F.bid, tile_e, (size_t)D * 256 * 2, (const int*)(F.ws + WS_ELIST)};
                      EpiMoeDown E{(bf16_t*)(F.ws + WS_YS), tile_e, (const int*)(F.ws + WS_ELIST), (const float*)(F.ws + WS_EWW)};
                      pg8::gemm_phase<EpiMoeDown, MoeOrder, true, true>(F.lds, g, S, E, F.tid); } break;
            }
        }
        }
#if EXTRA_BAR
        if (ph_ == 0) { for (int eb = 0; eb < EXTRA_BAR; ++eb) GRID_BAR(); }
#endif
        if (ph_ + 1 < hi && !(ph_ >= 1 && ph_ <= 10 * NL && (((ph_ - 1) % 10) == 2 || ((ph_ - 1) % 10) == 3 || ((ph_ - 1) % 10) == 7))) GRID_BAR();
    }
}

extern "C" void kernel_launch(void* const* d_in, const int* in_sizes, int n_in, void* d_out, int out_size, void* d_ws, size_t ws_size, hipStream_t stream) {
    static int grid = 0;
    if (grid == 0) {
        if (n_in != 31 || out_size != T * D || ws_size < WS_END) { fprintf(stderr, "kernel_launch: unexpected shapes: n_in %d out %d ws %zu (need %zu)\n", n_in, out_size, ws_size, (size_t)WS_END); grid = -1; return; }
        int dev = 0, cus = 0, per_cu = 0;
        if (hipGetDevice(&dev) != hipSuccess || hipDeviceGetAttribute(&cus, hipDeviceAttributeMultiprocessorCount, dev) != hipSuccess) { grid = -1; return; }
        if (hipFuncSetAttribute((const void*)hybrid_fwd, hipFuncAttributeMaxDynamicSharedMemorySize, LDS_BYTES) != hipSuccess) { fprintf(stderr, "kernel_launch: hipFuncSetAttribute failed\n"); grid = -1; return; }
        if (hipOccupancyMaxActiveBlocksPerMultiprocessor(&per_cu, (const void*)hybrid_fwd, NTHR, LDS_BYTES) != hipSuccess || per_cu < 1) fprintf(stderr, "kernel_launch: occupancy query says %d\n", per_cu);
        (void)hipGetLastError();
        grid = cus;
    }
    if (grid < 0) return;
    (void)hipMemsetAsync((char*)d_ws + WS_CTL, 0, CTL_ZERO_BYTES, stream);
    Args a{};
    for (int i = 0; i < 31; ++i) a.in[i] = d_in[i];
    a.out = (float*)d_out; a.ws = (unsigned char*)d_ws;
#if MK_PER_PHASE
    for (int ph = 0; ph < N_PHASES; ++ph) { a.ph_lo = ph; a.ph_hi = ph + 1; hipLaunchKernelGGL(hybrid_fwd, dim3(grid), dim3(NTHR), LDS_BYTES, stream, a); }
#else
    a.ph_lo = 0; a.ph_hi = N_PHASES;
    hipLaunchKernelGGL(hybrid_fwd, dim3(grid), dim3(NTHR), LDS_BYTES, stream, a);
#endif
}
```

```cpp
#include <hip/hip_runtime.h>
#include <cstdio>
#include <cstdint>
#include <cmath>
#ifndef PH_MASK
#define PH_MASK 0xfff
#endif
#define PH_EN(k) ((PH_MASK >> (k)) & 1)
#ifndef MK_PER_PHASE
#define MK_PER_PHASE 0
#endif
namespace pg8 {
#define PG8_LAS __attribute__((address_space(3)))
typedef unsigned short bf16_t;
typedef short bf16x8 __attribute__((ext_vector_type(8)));
typedef float f32x4 __attribute__((ext_vector_type(4)));
typedef unsigned u32x4 __attribute__((ext_vector_type(4)));
constexpr int BM = 256, BK = 64, HALF = 128, HTB = HALF * BK * 2  , STAGE_BYTES = 8 * HTB, NXCD = 8, WGM = 8;

__host__ __device__ __forceinline__ int lds_byte(int r, int c) { const int st = (r >> 4) * 2 + (c >> 5), rr = r & 15, cc = c & 31, ob = rr * 64 + cc * 2; return st * 1024 + (ob ^ (((ob >> 9) & 1) << 5)); }
__host__ __device__ __forceinline__ void stage_rc(int b, int& R, int& C) { const int st = b / 1024, sb = b % 1024, swz = sb ^ (((sb >> 9) & 1) << 5); R = (st >> 1) * 16 + swz / 64; C = (st & 1) * 32 + (swz % 64) / 2; }
__host__ __device__ __forceinline__ int perm32(int rho) { const int n = rho >> 4, i = rho & 15; return 8 * (i >> 2) + 4 * n + (i & 3); }

struct Unit { int pm, pn, mask; };
struct Gemm { const bf16_t* A; const bf16_t* Bt; int M, N, K; };

__host__ __device__ __forceinline__ bool tail_split(int i, int G, int c, int total, int& L, int& f, int& sub) {
    const int rounds = total / G, nfull = rounds * G, ntail = total - nfull; f = 1; sub = 0;
    if (i < rounds) { L = i * G + c; return true; }
    if (i > rounds || ntail == 0) return false;
    f = (4 * ntail <= G) ? 4 : (2 * ntail <= G) ? 2 : 1;
    if (c >= ntail * f) return false;
    L = nfull + c / f; sub = c % f; return true;
}
struct StaticOrder {
    int nM, nN, nwg, G, c, padpn;
    __host__ __device__ void init(int M, int N, int G_, int c_, int padpn_ = -1) { nM = M / BM; nN = N / BM; nwg = nM * nN; G = G_; c = c_; padpn = padpn_; }
    __host__ __device__ bool next(int i, Unit& u) const {
        int L, f, sub; if (!tail_split(i, G, c, nwg, L, f, sub)) return false;
        int wgid = L; { const int q = nwg / NXCD, r = nwg % NXCD, xcd = wgid % NXCD, off = wgid / NXCD; wgid = (xcd < r ? xcd * (q + 1) : r * (q + 1) + (xcd - r) * q) + off; }
        const int nig = WGM * nN, gid = wgid / nig, fm = gid * WGM, gsz = (nM - fm) < WGM ? (nM - fm) : WGM;
        u.pm = fm + ((wgid % nig) % gsz); u.pn = (wgid % nig) / gsz;
        const bool pad = (u.pn == padpn);
        u.mask = (f == 1) ? (pad ? 0x5 : 0xF) : (f == 2) ? (pad ? (sub ? 0x4 : 0x1) : (sub ? 0xA : 0x5)) : ((1 << sub) & (pad ? 0x5 : 0xF));
        return true;
    }
    static constexpr bool GATHER = false;
    __device__ __forceinline__ void arows(const Unit&, const int (&)[2], int (&o)[2][2]) const { o[0][0] = o[0][1] = o[1][0] = o[1][1] = 0; }
    __device__ __forceinline__ void a_ready(const Unit&) const {}
    __device__ __forceinline__ size_t boff(const Unit&) const { return 0; }
    __device__ __forceinline__ void done(const Unit&) const {}
};

template <class Epi, class Sched, bool ALIGN_EPI = false, bool SP2 = false>
__device__ __forceinline__ void gemm_phase(PG8_LAS unsigned char* lds, const Gemm g, const Sched& S, const Epi& E, const int tid_in) {
    const int tid = tid_in, wid = __builtin_amdgcn_readfirstlane(tid >> 6), lane = tid & 63, wr = wid >> 2, wc = wid & 3, fr = lane & 15, fq = lane >> 4;
    const int K = g.K, nt = K / BK;
    unsigned voffA[2], voffB[2];
    int RA[2], CA[2];
    unsigned gA_cur[2][2], gA_nxt[2][2];
    static_assert(!Sched::GATHER || SP2, "row-gathered A is wired into the SP2 loop only");
#pragma unroll
    for (int i = 0; i < 2; ++i) { int R, C; stage_rc(tid * 16 + i * 8192, R, C); const int Rb = Epi::PERM ? ((R & ~31) + perm32(R & 31)) : R;
        voffA[i] = (unsigned)(R * K + C) * 2u; voffB[i] = (unsigned)(Rb * K + C) * 2u; RA[i] = R; CA[i] = C; }
#define PG8_GROWS(u, o) do { int ar_[2][2]; S.arows(u, RA, ar_); _Pragma("unroll") for (int h_ = 0; h_ < 2; ++h_) _Pragma("unroll") for (int i_ = 0; i_ < 2; ++i_) o[h_][i_] = (unsigned)(ar_[h_][i_] * K + CA[i_]) * 2u; } while (0)
    const size_t kstep = (size_t)(BK * 2);
    const size_t hstep = (size_t)HALF * K * 2;
    const size_t tstep = 2 * hstep;
    const unsigned ldsw = (unsigned)wid * 1024u;
    const int aoff = lds_byte(wr * 64 + fr, fq * 8), boff = lds_byte(wc * 32 + fr, fq * 8);
#define PG8_SA(b, h) (((b) * 2 + (h)) * HTB)
#define PG8_SB(b, h) ((4 + (b) * 2 + (h)) * HTB)
#define PG8_STAGE(bufoff, gbase, voff) do { _Pragma("unroll") for (int _i = 0; _i < 2; ++_i) \
        __builtin_amdgcn_global_load_lds((const unsigned*)((const char*)(gbase) + (voff)[_i]), (PG8_LAS unsigned*)(lds + (bufoff) + ldsw + _i * 8192), 16, 0, 0); } while (0)
#define PG8_STAGE_A(bufoff, gbase, half, nx) do { if constexpr (Sched::GATHER) { _Pragma("unroll") for (int _i = 0; _i < 2; ++_i) { const unsigned vo_ = (nx) ? gA_nxt[half][_i] : gA_cur[half][_i]; \
        __builtin_amdgcn_global_load_lds((const unsigned*)((const char*)(gbase) + vo_), (PG8_LAS unsigned*)(lds + (bufoff) + ldsw + _i * 8192), 16, 0, 0); } } else { PG8_STAGE(bufoff, (gbase) + (half) * hstep, voffA); } } while (0)
#define PG8_LDA(dst, b, h) do { _Pragma("unroll") for (int m = 0; m < 4; ++m) _Pragma("unroll") for (int k = 0; k < 2; ++k) dst[m][k] = *(const PG8_LAS bf16x8*)(lds + PG8_SA(b, h) + aoff + m * 2048 + k * 1024); } while (0)
#define PG8_LDB(dst, b, h) do { _Pragma("unroll") for (int n = 0; n < 2; ++n) _Pragma("unroll") for (int k = 0; k < 2; ++k) dst[n][k] = *(const PG8_LAS bf16x8*)(lds + PG8_SB(b, h) + boff + n * 2048 + k * 1024); } while (0)
#define PG8_MMA(ai, bj, At, Bt) do { if (cmask & (1 << ((ai) * 2 + (bj)))) PG8_MMA_(ai, bj, At, Bt); } while (0)
#define PG8_MMA_(ai, bj, At, Bt) do { __builtin_amdgcn_s_setprio(1); _Pragma("unroll") for (int m = 0; m < 4; ++m) _Pragma("unroll") for (int n = 0; n < 2; ++n) _Pragma("unroll") for (int k = 0; k < 2; ++k) \
        acc[ai][bj][m][n] = __builtin_amdgcn_mfma_f32_16x16x32_bf16(Bt[n][k], At[m][k], acc[ai][bj][m][n], 0, 0, 0); __builtin_amdgcn_s_setprio(0); } while (0)
#define PG8_WAIT_V(n) asm volatile("s_waitcnt vmcnt(" #n ")" ::: "memory")
#define PG8_WAIT_L(n) asm volatile("s_waitcnt lgkmcnt(" #n ")" ::: "memory")
#define PG8_BAR __builtin_amdgcn_s_barrier()
#define PG8_SCHED __builtin_amdgcn_sched_barrier(0)
    Unit cur, nxt; int ui = 0;
    if (!S.next(0, cur)) return;
    f32x4 acc[2][2][4][2];
#pragma unroll
    for (int a = 0; a < 2; ++a)
#pragma unroll
        for (int b = 0; b < 2; ++b)
#pragma unroll
            for (int m = 0; m < 4; ++m)
#pragma unroll
                for (int n = 0; n < 2; ++n) acc[a][b][m][n] = (f32x4){0.f, 0.f, 0.f, 0.f};
    bf16x8 At[4][2], B0[2][2], B1[2][2];
    const char* cA = (const char*)g.A + (Sched::GATHER ? (size_t)0 : (size_t)cur.pm * tstep); const char* cB = (const char*)g.Bt + S.boff(cur) + (size_t)cur.pn * tstep;
    S.a_ready(cur);
    if constexpr (Sched::GATHER) { PG8_GROWS(cur, gA_cur); }
    if constexpr (SP2) {
        PG8_STAGE(PG8_SB(0, 0), cB, voffB); PG8_STAGE(PG8_SB(0, 1), cB + hstep, voffB); PG8_STAGE_A(PG8_SA(0, 0), cA, 0, false); PG8_STAGE_A(PG8_SA(0, 1), cA, 1, false);
        if (wr == 1) PG8_BAR;
        PG8_WAIT_V(2); PG8_BAR;
        PG8_STAGE(PG8_SB(1, 0), cB + kstep, voffB); PG8_STAGE_A(PG8_SA(1, 0), cA + kstep, 0, false); PG8_STAGE(PG8_SB(1, 1), cB + hstep + kstep, voffB);
        PG8_WAIT_V(6); PG8_BAR;
    } else {
        PG8_STAGE(PG8_SB(0, 0), cB, voffB); PG8_STAGE(PG8_SA(0, 0), cA, voffA); PG8_STAGE(PG8_SB(0, 1), cB + hstep, voffB); PG8_STAGE(PG8_SA(0, 1), cA + hstep, voffA);
        if (wr == 1) PG8_BAR;
        PG8_WAIT_V(4); PG8_BAR;
        PG8_STAGE(PG8_SB(1, 0), cB + kstep, voffB); PG8_STAGE(PG8_SA(1, 0), cA + kstep, voffA); PG8_STAGE(PG8_SB(1, 1), cB + hstep + kstep, voffB);
        PG8_WAIT_V(6); PG8_BAR;
    }
    for (;;) {
        const int cmask = __builtin_amdgcn_readfirstlane(cur.mask);
        const bool has_next = S.next(ui + 1, nxt);
        const char* nA = has_next ? (const char*)g.A + (Sched::GATHER ? (size_t)0 : (size_t)nxt.pm * tstep) : cA; const char* nB = has_next ? (const char*)g.Bt + S.boff(nxt) + (size_t)nxt.pn * tstep : cB;
        if constexpr (Sched::GATHER) { if (has_next) { PG8_GROWS(nxt, gA_nxt); } }
        for (int t = 0; t < nt; t += 2) {
            const bool last = (t == nt - 2);
            const char* a1 = cA + (size_t)(t + 1) * kstep;
            const char* a2 = last ? nA : cA + (size_t)(t + 2) * kstep; const char* b2 = last ? nB : cB + (size_t)(t + 2) * kstep;
            const char* a3 = a2 + kstep; const char* b3 = b2 + kstep;
            if (last && has_next) S.a_ready(nxt);
            const bool usen = last && has_next;
            if constexpr (SP2) {
            PG8_LDB(B0, 0, 0); PG8_LDB(B1, 0, 1); PG8_SCHED; PG8_LDA(At, 0, 0); PG8_STAGE_A(PG8_SA(1, 1), a1, 1, false);
            PG8_WAIT_V(8); PG8_WAIT_L(0); PG8_BAR; PG8_MMA(0, 0, At, B0); PG8_MMA(0, 1, At, B1); PG8_BAR; PG8_SCHED;
            PG8_LDA(At, 0, 1); PG8_STAGE(PG8_SB(0, 0), b2, voffB); PG8_STAGE(PG8_SB(0, 1), b2 + hstep, voffB); PG8_STAGE_A(PG8_SA(0, 0), a2, 0, usen);
            PG8_WAIT_V(8); PG8_WAIT_L(0); PG8_BAR; PG8_MMA(1, 0, At, B0); PG8_MMA(1, 1, At, B1); PG8_BAR; PG8_SCHED;
            PG8_LDB(B0, 1, 0); PG8_LDB(B1, 1, 1); PG8_SCHED; PG8_LDA(At, 1, 0); PG8_STAGE_A(PG8_SA(0, 1), a2, 1, usen);
            PG8_WAIT_V(8); PG8_WAIT_L(0); PG8_BAR; PG8_MMA(0, 0, At, B0); PG8_MMA(0, 1, At, B1); PG8_BAR; PG8_SCHED;
            PG8_LDA(At, 1, 1); PG8_STAGE(PG8_SB(1, 0), b3, voffB); PG8_STAGE(PG8_SB(1, 1), b3 + hstep, voffB); PG8_STAGE_A(PG8_SA(1, 0), a3, 0, usen);
            PG8_WAIT_V(8); PG8_WAIT_L(0); PG8_BAR; PG8_MMA(1, 0, At, B0); PG8_MMA(1, 1, At, B1); PG8_BAR; PG8_SCHED;
            } else {
            PG8_LDB(B0, 0, 0); PG8_SCHED; PG8_LDA(At, 0, 0); PG8_STAGE(PG8_SA(1, 1), a1 + hstep, voffA);
            PG8_WAIT_L(8); PG8_BAR; PG8_WAIT_L(0); PG8_MMA(0, 0, At, B0); PG8_BAR; PG8_SCHED;
            PG8_LDB(B1, 0, 1); PG8_STAGE(PG8_SB(0, 0), b2, voffB);
            PG8_BAR; PG8_WAIT_L(0); PG8_MMA(0, 1, At, B1); PG8_BAR;
            PG8_LDA(At, 0, 1); PG8_STAGE(PG8_SA(0, 0), a2, voffA);
            PG8_BAR; PG8_WAIT_L(0); PG8_MMA(1, 0, At, B0); PG8_BAR; PG8_SCHED;
            PG8_STAGE(PG8_SB(0, 1), b2 + hstep, voffB);
            PG8_WAIT_V(6); PG8_BAR; PG8_MMA(1, 1, At, B1); PG8_BAR;
            PG8_LDB(B0, 1, 0); PG8_SCHED; PG8_LDA(At, 1, 0); PG8_STAGE(PG8_SA(0, 1), a2 + hstep, voffA);
            PG8_WAIT_L(8); PG8_BAR; PG8_WAIT_L(0); PG8_MMA(0, 0, At, B0); PG8_BAR; PG8_SCHED;
            PG8_LDB(B1, 1, 1); PG8_STAGE(PG8_SB(1, 0), b3, voffB);
            PG8_BAR; PG8_WAIT_L(0); PG8_MMA(0, 1, At, B1); PG8_BAR;
            PG8_LDA(At, 1, 1); PG8_STAGE(PG8_SA(1, 0), a3, voffA);
            PG8_BAR; PG8_WAIT_L(0); PG8_MMA(1, 0, At, B0); PG8_BAR; PG8_SCHED;
            PG8_STAGE(PG8_SB(1, 1), b3 + hstep, voffB);
            PG8_WAIT_V(6); PG8_BAR; PG8_MMA(1, 1, At, B1); PG8_BAR;
            }
        }
        if constexpr (ALIGN_EPI) { if (wr == 0) PG8_BAR; }
        if constexpr (!Epi::AFTER_DRAIN) { E(acc, cur, wr, wc, 0, 0); S.done(cur); }
        if (!has_next) break;
#pragma unroll
        for (int a = 0; a < 2; ++a)
#pragma unroll
            for (int b = 0; b < 2; ++b)
#pragma unroll
                for (int m = 0; m < 4; ++m)
#pragma unroll
                    for (int n = 0; n < 2; ++n) acc[a][b][m][n] = (f32x4){0.f, 0.f, 0.f, 0.f};
        cur = nxt; cA = nA; cB = nB; ++ui;
        if constexpr (Sched::GATHER) {
#pragma unroll
            for (int h_ = 0; h_ < 2; ++h_)
#pragma unroll
                for (int i_ = 0; i_ < 2; ++i_) gA_cur[h_][i_] = gA_nxt[h_][i_]; }
        if constexpr (ALIGN_EPI) { if (wr == 1) PG8_BAR; }
    }
    PG8_WAIT_V(0);
    if constexpr (!ALIGN_EPI) { if (wr == 0) PG8_BAR; }
    PG8_BAR;
    if constexpr (Epi::AFTER_DRAIN) { E.fused(acc, cur, wr, wc, fr, fq, lds, wid, lane); S.done(cur); }
#undef PG8_SA
#undef PG8_SB
#undef PG8_STAGE
#undef PG8_STAGE_A
#undef PG8_GROWS
#undef PG8_LDA
#undef PG8_LDB
#undef PG8_MMA
#undef PG8_MMA_
#undef PG8_WAIT_V
#undef PG8_WAIT_L
#undef PG8_BAR
#undef PG8_SCHED
}
}

constexpr int BATCH = 2, SEQ = 8192, T = BATCH * SEQ, D = 1024, NL = 2;
constexpr int NPAD = 3584, RW = 1408, INCOLS = 3346;
constexpr int NWAVES = 8, NTHR = 512;
constexpr float LOG2E = 1.4426950408889634f;
constexpr float NORM_EPS = 1e-6f;

#define GAS __attribute__((address_space(1)))
#define LAS __attribute__((address_space(3)))
typedef unsigned short bf16_t;
typedef short bf16x8 __attribute__((ext_vector_type(8)));
typedef short s16x4 __attribute__((ext_vector_type(4)));
typedef short v4i16_t __attribute__((ext_vector_type(4)));
typedef float f32x4 __attribute__((ext_vector_type(4)));
typedef float f32x16 __attribute__((ext_vector_type(16)));
typedef unsigned u32x4 __attribute__((ext_vector_type(4)));
typedef unsigned u32x2 __attribute__((ext_vector_type(2)));
typedef GAS unsigned gu32;

constexpr size_t MiB = 1u << 20, KiB = 1u << 10;
constexpr size_t WS_CTL = 0, CTL_ZERO_BYTES = 64 * KiB;
constexpr size_t WS_COS = 1 * MiB, WS_SIN = 3 * MiB;
constexpr size_t WS_MOD = 5 * MiB;
constexpr size_t WS_PHIB = WS_MOD + 128 * KiB;
constexpr size_t WS_KMEAN = WS_MOD + 192 * KiB;
constexpr size_t WS_KCMP = WS_MOD + 256 * KiB;
constexpr size_t WS_VCMP = WS_KCMP + 256 * KiB;
constexpr size_t WS_BONUS = 6 * MiB;
constexpr size_t WS_GATE = 7 * MiB;
constexpr size_t WS_ROUTE = 9 * MiB;
constexpr size_t WS_ROWINFO = 10 * MiB;
constexpr size_t ROWINFO_LSTRIDE = 512 * KiB;
constexpr int MAXROWS = 36864;
constexpr size_t WS_ELIST = 9 * MiB;
constexpr size_t WS_EWW = 11 * MiB;
constexpr int TE_OFF = 272, TE_CNT = 304;
constexpr size_t WS_WIN = 12 * MiB;
constexpr size_t WS_WOUT = 19 * MiB;
constexpr size_t WS_WUP = 21 * MiB;
constexpr size_t WS_WDN = 37 * MiB;
constexpr size_t WS_PHIW = 45 * MiB;
constexpr size_t WS_GUPT = 45 * MiB + 512 * KiB;
constexpr size_t WS_WUPT = 45 * MiB + 640 * KiB;
constexpr size_t WS_AUPT = 45 * MiB + 704 * KiB;
constexpr size_t WS_LORA = 46 * MiB;
constexpr size_t WS_HM = 46 * MiB;
constexpr size_t WS_NQ = 78 * MiB;
constexpr size_t WS_KV6 = 90 * MiB;
constexpr size_t KV6_STRIDE = (size_t)BATCH * 2 * SEQ * 64;
constexpr size_t WS_MQKV = 114 * MiB;
constexpr size_t MQKV_STRIDE = (size_t)BATCH * 4 * SEQ * 64;
constexpr size_t WS_RFEAT = 138 * MiB;
constexpr size_t WS_SORTA = 78 * MiB;
constexpr size_t WS_HID = 150 * MiB;
constexpr size_t WS_PT = 182 * MiB;
constexpr size_t WS_ZS = 194 * MiB;
constexpr size_t WS_YT = 206 * MiB;
constexpr size_t WS_Y0 = 218 * MiB;
constexpr size_t WS_YS = 182 * MiB;
constexpr size_t WS_SS = 230 * MiB;
constexpr size_t WS_END = 256 * MiB;
constexpr int CW_Q = 64;
constexpr int CW_CNT = 1024;
constexpr int CW_BAR = 4096;
constexpr int CW_DBG = 3072;
#ifndef DBG_MODE
#define DBG_MODE 0
#endif
#ifndef EXTRA_BAR
#define EXTRA_BAR 0
#endif
#ifndef REPEAT_PH
#define REPEAT_PH -1
#endif
#ifndef DBG_TPH0
#define DBG_TPH0 0
#endif
#ifndef DBG_TPH1
#define DBG_TPH1 1
#endif
#ifndef DBG_QOFF
#define DBG_QOFF 0.0f
#endif
#ifndef DBG_TPH2
#define DBG_TPH2 0
#endif
#ifndef DBG_TPH3
#define DBG_TPH3 1
#endif
#ifndef DBG_SUB
#define DBG_SUB 4
#endif
#ifndef DBG_P
#define DBG_P 4
#endif
#ifndef DBG_CNT
#define DBG_CNT 1
#endif

#define RLX_AGENT __ATOMIC_RELAXED, __HIP_MEMORY_SCOPE_AGENT
#define LDS_WAIT() asm volatile("s_waitcnt lgkmcnt(0)" ::: "memory")
#define VM_WAIT() asm volatile("s_waitcnt vmcnt(0)" ::: "memory")
__device__ __forceinline__ float bf2f(bf16_t h) { return __uint_as_float(((unsigned)h) << 16); }
typedef float f32x2_t __attribute__((ext_vector_type(2)));
typedef __bf16 bf16x2_t __attribute__((ext_vector_type(2)));
__device__ __forceinline__ unsigned pk2(float lo, float hi) { const f32x2_t v = {lo, hi}; return __builtin_bit_cast(unsigned, __builtin_convertvector(v, bf16x2_t)); }
__device__ __forceinline__ bf16_t f2bf(float f) { return (bf16_t)(pk2(f, 0.f) & 0xffffu); }
__device__ __forceinline__ float shx(float v, int mask, int lane) { return __uint_as_float(__builtin_amdgcn_ds_bpermute((lane ^ mask) << 2, __float_as_uint(v))); }
__device__ __forceinline__ int shxi(int v, int mask, int lane) { return __builtin_amdgcn_ds_bpermute((lane ^ mask) << 2, v); }
template <int CTRL> __device__ __forceinline__ float dpp_mov(float v) { return __uint_as_float(__builtin_amdgcn_update_dpp(0u, __float_as_uint(v), CTRL, 0xf, 0xf, true)); }
__device__ __forceinline__ float half_sum32(float v) { const unsigned u = __float_as_uint(v); auto r = __builtin_amdgcn_permlane32_swap(u, u, false, false); return __uint_as_float(r[0]) + __uint_as_float(r[1]); }
__device__ __forceinline__ float row_sum16(float v) { const unsigned u = __float_as_uint(v); auto r = __builtin_amdgcn_permlane16_swap(u, u, false, false); return __uint_as_float(r[0]) + __uint_as_float(r[1]); }
__device__ __forceinline__ float wave_sum(float v, int lane) {
    (void)lane;
    v += dpp_mov<0xB1>(v); v += dpp_mov<0x4E>(v); v += dpp_mov<0x141>(v); v += dpp_mov<0x140>(v);
    return half_sum32(row_sum16(v));
}
__device__ __forceinline__ float tanh_fast(float x) { const float xc = fminf(fmaxf(x, -15.f), 15.f); return 1.f - 2.f * __builtin_amdgcn_rcpf(__builtin_amdgcn_exp2f(xc * (2.f * LOG2E)) + 1.f); }
__device__ __forceinline__ float sigm(float x) { return __builtin_amdgcn_rcpf(1.f + __expf(-x)); }
__device__ __forceinline__ int ld_ctl(const int* p) { return __hip_atomic_load(p, RLX_AGENT); }
__device__ __forceinline__ float ld_ctlf(const float* p) { return __uint_as_float(__hip_atomic_load((const unsigned*)p, RLX_AGENT)); }
#define MFMA16(a, b, c) __builtin_amdgcn_mfma_f32_16x16x32_bf16(a, b, c, 0, 0, 0)
#define MFMA32(a, b, c) __builtin_amdgcn_mfma_f32_32x32x16_bf16(a, b, c, 0, 0, 0)

#define XB_TMO      128
#define XB_XCNT(j)  (256  + 64 * (j))
#define XB_XSUB(j)  (1280 + 64 * (j))
#define XB_XGEN(j)  (2304 + 64 * (j))
#define XB_TOP      3328
#define XB_TOPGEN   3392
#define XCD_BAR_WORDS 3456
#define XB_SPIN_CAP (1u << 22)
__device__ __forceinline__ unsigned xb_ld(unsigned* p)              { return __hip_atomic_load(p, __ATOMIC_RELAXED, __HIP_MEMORY_SCOPE_AGENT); }
__device__ __forceinline__ unsigned xb_add(unsigned* p, unsigned v) { return __hip_atomic_fetch_add(p, v, __ATOMIC_RELAXED, __HIP_MEMORY_SCOPE_AGENT); }
__device__ __forceinline__ unsigned xb_xcc_id() { return (unsigned)__builtin_amdgcn_s_getreg((3 << 11) | 20) & 0xFu; }
#define XB_SPIN(cond, bar) do { unsigned _sp = 0; while (cond) { __builtin_amdgcn_s_sleep(1); \
    if ((++_sp & 255u) == 0u) { if (xb_ld(&(bar)[XB_TMO])) break; if (_sp > XB_SPIN_CAP) { atomicAdd(&(bar)[XB_TMO], 1u); break; } } } } while (0)
struct XcdBarrier { unsigned* bar; unsigned x; volatile LAS unsigned* st; };
__device__ __forceinline__ XcdBarrier xcd_barrier_post(unsigned* bar, volatile LAS unsigned* st) {
    XcdBarrier b; b.bar = bar; b.x = xb_xcc_id(); b.st = st;
    if (threadIdx.x == 0) (void)xb_add(&bar[XB_XCNT(b.x)], 1u);
    return b;
}
__device__ __forceinline__ void xcd_barrier_complete(unsigned* bar, unsigned x, unsigned& nloc, unsigned& nx) {
    const unsigned G = gridDim.x * gridDim.y * gridDim.z;
    unsigned sum, cnt, mine, sp = 0u;
    for (;;) {
        sum = 0u; cnt = 0u; mine = 0u;
#pragma unroll
        for (unsigned j = 0; j < 16; ++j) { const unsigned c = xb_ld(&bar[XB_XCNT(j)]); sum += c; cnt += (c > 0u) ? 1u : 0u; mine = (j == x) ? c : mine; }
        if (sum == G) break;
        __builtin_amdgcn_s_sleep(1);
        if ((++sp & 255u) == 0u) { if (xb_ld(&bar[XB_TMO])) break; if (sp > XB_SPIN_CAP) { atomicAdd(&bar[XB_TMO], 1u); break; } }
    }
    nloc = mine > 0u ? mine : 1u; nx = cnt > 0u ? cnt : 1u;
}
__device__ __forceinline__ void xcd_barrier(const XcdBarrier& b, const int tid) {
    asm volatile("s_waitcnt vmcnt(0)" ::: "memory");
    __syncthreads();
    if (tid == 0) {
        unsigned* bar = b.bar;
        __builtin_amdgcn_s_waitcnt(0);
        unsigned nloc = b.st[0], nx = b.st[1];
        if (nloc == 0u) { xcd_barrier_complete(bar, b.x, nloc, nx); b.st[0] = nloc; b.st[1] = nx; }
        const unsigned old = xb_add(&bar[XB_XSUB(b.x)], 1u);
        const unsigned gen = old / nloc;
        if (old + 1u == (gen + 1u) * nloc) {
            __builtin_amdgcn_fence(__ATOMIC_RELEASE, "agent");
            asm volatile("s_waitcnt vmcnt(0)" ::: "memory");
            const unsigned og = xb_add(&bar[XB_TOP], 1u);
            const unsigned tg = og / nx;
            if (og + 1u == (tg + 1u) * nx) xb_add(&bar[XB_TOPGEN], 1u);
            else XB_SPIN(xb_ld(&bar[XB_TOPGEN]) == tg, bar);
            __builtin_amdgcn_fence(__ATOMIC_ACQUIRE, "agent");
            xb_add(&bar[XB_XGEN(b.x)], 1u);
            asm volatile("s_waitcnt vmcnt(0)" ::: "memory");
        } else {
            XB_SPIN(xb_ld(&bar[XB_XGEN(b.x)]) == gen, bar);
            __builtin_amdgcn_fence(__ATOMIC_ACQUIRE, "agent");
            asm volatile("s_waitcnt vmcnt(0)" ::: "memory");
        }
    }
    __syncthreads();
}

constexpr int RING_BYTES = 131072, MISC_OFF = RING_BYTES + 320, LDS_BYTES = 147456;
struct Frame {
    LAS unsigned char* lds;
    volatile LAS unsigned* MISC;
    unsigned* ctl;
    int tid, lane, wave, G, bid;
    unsigned char* ws;
    float* out;
};
constexpr int IN_OFF = RING_BYTES + 1024;
__device__ __forceinline__ const float* inptr(const LAS unsigned char* lds, int k) {
    int z = 0; asm volatile("" : "+v"(z));
    const LAS unsigned* p = (const LAS unsigned*)(lds + IN_OFF + z) + 2 * k;
    const unsigned lo = __builtin_amdgcn_readfirstlane(p[0]), hi = __builtin_amdgcn_readfirstlane(p[1]);
    return (const float*)(const GAS float*)(((unsigned long long)hi << 32) | lo); }
#define INF(F, k) inptr((F).lds, k)
#define LAUNDER(F) do { GAS unsigned char* w_ = (GAS unsigned char*)(F).ws; GAS float* o_ = (GAS float*)(F).out; int g_ = (F).G, b_ = (F).bid, wv_ = (F).wave, z_ = 0; asm volatile("" : "+s"(w_), "+s"(o_), "+s"(g_), "+s"(b_), "+s"(wv_), "+s"(z_)); \
    int l_ = (int)__builtin_amdgcn_mbcnt_hi(~0u, __builtin_amdgcn_mbcnt_lo(~0u, (unsigned)z_)); asm volatile("" : "+v"(l_)); \
    (F).ws = (unsigned char*)w_; (F).out = (float*)o_; (F).ctl = (unsigned*)(GAS unsigned*)w_; (F).G = g_; (F).bid = b_; (F).wave = wv_; (F).lane = l_; (F).tid = wv_ * 64 + l_; } while (0)
enum { I_X = 0, I_C, I_POS, I_WMOD, I_BMOD, I_NMIX, I_NFFN, I_WIN, I_PHIW1, I_PHIW2, I_PHIPOS, I_MU, I_WUP, I_W0, I_AUP, I_A0, I_GUP, I_KK, I_KA, I_RK, I_LNW, I_LNB,
       I_NNSA, I_NMOBA, I_WOUT, I_WROUTER, I_RBIAS, I_MGATE, I_MUP, I_MDOWN, I_NFINAL };

__device__ const float g_invf[32] = {1.000000000e+00f, 7.498942018e-01f, 5.623413324e-01f, 4.216965139e-01f, 3.162277639e-01f, 2.371373773e-01f, 1.778279394e-01f, 1.333521456e-01f,
    1.000000015e-01f, 7.498942316e-02f, 5.623413250e-02f, 4.216964915e-02f, 3.162277490e-02f, 2.371373773e-02f, 1.778279431e-02f, 1.333521400e-02f, 9.999999776e-03f, 7.498942316e-03f,
    5.623413250e-03f, 4.216964822e-03f, 3.162277630e-03f, 2.371373819e-03f, 1.778279431e-03f, 1.333521446e-03f, 1.000000047e-03f, 7.498941850e-04f, 5.623413017e-04f, 4.216965172e-04f,
    3.162277571e-04f, 2.371373703e-04f, 1.778279402e-04f, 1.333521504e-04f};
__device__ __forceinline__ void phase_pro(Frame& F) {
    const int* pos = (const int*)INF(F, I_POS);
    float* cosT = (float*)(F.ws + WS_COS); float* sinT = (float*)(F.ws + WS_SIN);
    for (int idx = F.bid * NTHR + F.tid; idx < T * 32; idx += F.G * NTHR) {
        const int row = idx >> 5, i = idx & 31;
        const float ang = (float)pos[row] * g_invf[i];
        float sv, cv; sincosf(ang, &sv, &cv);
        cosT[idx] = cv; sinT[idx] = sv;
    }
    LAS float* red = (LAS float*)F.lds;
    for (int chunk = F.bid; chunk < NL * 96; chunk += F.G) {
        const int l = chunk / 96, j0 = (chunk % 96) * 64;
        const float* W = INF(F, I_WMOD) + (size_t)l * D * 6144 + j0 + F.lane;
        const float* c = INF(F, I_C);
        float a0 = 0.f, a1 = 0.f;
        const int k0 = F.wave * 128;
#pragma unroll 32
        for (int k = 0; k < 128; ++k) {
            const float w = W[(size_t)(k0 + k) * 6144];
            const float c0 = c[k0 + k], c1 = c[D + k0 + k];
            a0 += w * (c0 * sigm(c0)); a1 += w * (c1 * sigm(c1));
        }
        red[(F.wave * 2 + 0) * 64 + F.lane] = a0; red[(F.wave * 2 + 1) * 64 + F.lane] = a1;
        __syncthreads();
        if (F.wave < 2) {
            float s = INF(F, I_BMOD)[l * 6144 + j0 + F.lane];
#pragma unroll
            for (int w = 0; w < 8; ++w) s += red[(w * 2 + F.wave) * 64 + F.lane];
            ((float*)(F.ws + WS_MOD))[((size_t)l * BATCH + F.wave) * 6144 + j0 + F.lane] = s;
        }
        __syncthreads();
    }
}

__device__ __forceinline__ void transpose_item(int ldw, int K, bf16_t* WT, int n0, int k0, LAS float* scr, int lane, const float* src) {
    const int n4 = lane & 7, kr = lane >> 3;
#pragma unroll
    for (int i = 0; i < 8; ++i) { const int kk = 8 * i + kr; f32x4 v = (f32x4){0.f, 0.f, 0.f, 0.f};
        if (src) { const float* p = src + (size_t)(k0 + kk) * ldw; v.x = p[0]; v.y = p[1]; v.z = p[2]; v.w = p[3]; }
        scr[kk * 33 + 4 * n4] = v.x; scr[kk * 33 + 4 * n4 + 1] = v.y; scr[kk * 33 + 4 * n4 + 2] = v.z; scr[kk * 33 + 4 * n4 + 3] = v.w; }
    LDS_WAIT(); asm volatile("" ::: "memory");
    const int c = lane & 7;
#pragma unroll
    for (int j = 0; j < 4; ++j) { const int n = (lane >> 3) + 8 * j; const LAS float* sp = scr + (8 * c) * 33 + n;
        u32x4 o; o.x = pk2(sp[0 * 33], sp[1 * 33]); o.y = pk2(sp[2 * 33], sp[3 * 33]); o.z = pk2(sp[4 * 33], sp[5 * 33]); o.w = pk2(sp[6 * 33], sp[7 * 33]);
        *(u32x4*)(WT + (size_t)(n0 + n) * K + k0 + 8 * c) = o; }
    LDS_WAIT(); asm volatile("" ::: "memory");
}
__device__ __forceinline__ const float* cm_in(const float* W, int pos) {
        const int G = pos >> 6, p = pos & 63, w = p >> 5, n = (p >> 4) & 1, q = p & 15, d = 16 * w + q + 32 * n;
        int sc;
        if (G < 6) sc = G * 64 + d; else if (G < 18) sc = 384 + (G - 6) * 64 + d; else if (G < 30) sc = 1170 + (G - 18) * 64 + d;
        else if (G < 52) sc = 1938 + (G - 30) * 64 + d; else if (G == 52 && d < 18) sc = 1152 + d; else return nullptr;
        return W + sc; }
__device__ __forceinline__ const float* cm_up(const float* Wg, const float* Wu, int pos) { const int Wd = pos >> 5, n = (pos >> 4) & 1, q = pos & 15, f = 16 * Wd + q; return (n ? Wu : Wg) + f; }

__device__ __forceinline__ void norm_rows(Frame& F, int layer, bool final_) {
    const float* xin = INF(F, I_X);
    const bf16_t* ys = (const bf16_t*)(F.ws + WS_YS);
    const float* mod = (const float*)(F.ws + WS_MOD);
    bf16_t* H = (bf16_t*)(F.ws + WS_HM);
    const int gw = F.bid * NWAVES + F.wave, NGW = F.G * NWAVES;
    for (int m = gw; m < T; m += NGW) {
        const int b = m >> 13;
        f32x4 v[4]; float ss = 0.f;
        if (layer == 0 && !final_) {
#pragma unroll
            for (int j = 0; j < 4; ++j) v[j] = *(const f32x4*)(xin + (size_t)m * D + 4 * F.lane + 256 * j);
        } else {
            const int pl = final_ ? NL - 1 : layer - 1;
            const float* g2 = mod + ((size_t)pl * BATCH + b) * 6144 + 5120;
#pragma unroll
            for (int j = 0; j < 4; ++j) {
                const int col = 4 * F.lane + 256 * j;
                f32x4 x = *(const f32x4*)(F.out + (size_t)m * D + col);
                const u32x2 a = *(const u32x2*)(ys + (size_t)m * D + col), c = *(const u32x2*)(ys + (size_t)(T + m) * D + col);
                const f32x4 g = *(const f32x4*)(g2 + col);
                x.x += g.x * (__uint_as_float(a.x << 16) + __uint_as_float(c.x << 16));
                x.y += g.y * (__uint_as_float(a.x & 0xffff0000u) + __uint_as_float(c.x & 0xffff0000u));
                x.z += g.z * (__uint_as_float(a.y << 16) + __uint_as_float(c.y << 16));
                x.w += g.w * (__uint_as_float(a.y & 0xffff0000u) + __uint_as_float(c.y & 0xffff0000u));
                v[j] = x;
                if (!final_) *(f32x4*)(F.out + (size_t)m * D + col) = x;
            }
        }
#pragma unroll
        for (int j = 0; j < 4; ++j) ss += (v[j].x * v[j].x + v[j].y * v[j].y) + (v[j].z * v[j].z + v[j].w * v[j].w);
        const float rstd = rsqrtf(wave_sum(ss, F.lane) * (1.f / D) + NORM_EPS);
#if DBG_MODE == 1
        if (final_) { float bad = 0.f;
#pragma unroll
            for (int j = 0; j < 4; ++j) { bad += (fabsf(v[j].x) <= 3e38f) ? 0.f : 1.f; bad += (fabsf(v[j].y) <= 3e38f) ? 0.f : 1.f; bad += (fabsf(v[j].z) <= 3e38f) ? 0.f : 1.f; bad += (fabsf(v[j].w) <= 3e38f) ? 0.f : 1.f; }
            bad = wave_sum(bad, F.lane); if (F.lane == 0 && bad > 0.f) atomicAdd(F.ctl + CW_DBG, (unsigned)bad); }
#endif
        if (final_) {
            const float* gn = INF(F, I_NFINAL);
#pragma unroll
            for (int j = 0; j < 4; ++j) { const int col = 4 * F.lane + 256 * j; const f32x4 g = *(const f32x4*)(gn + col);
                f32x4 o; o.x = v[j].x * rstd * g.x; o.y = v[j].y * rstd * g.y; o.z = v[j].z * rstd * g.z; o.w = v[j].w * rstd * g.w;
                *(f32x4*)(F.out + (size_t)m * D + col) = o; }
        } else {
            const float* gn = INF(F, I_NMIX) + layer * D;
            const float* sh = mod + ((size_t)layer * BATCH + b) * 6144; const float* sc = sh + 1024;
#pragma unroll
            for (int j = 0; j < 4; ++j) { const int col = 4 * F.lane + 256 * j;
                const f32x4 g = *(const f32x4*)(gn + col), s1 = *(const f32x4*)(sc + col), s0 = *(const f32x4*)(sh + col);
                u32x2 o; o.x = pk2(v[j].x * rstd * g.x * (1.f + s1.x) + s0.x, v[j].y * rstd * g.y * (1.f + s1.y) + s0.y);
                o.y = pk2(v[j].z * rstd * g.z * (1.f + s1.z) + s0.z, v[j].w * rstd * g.w * (1.f + s1.w) + s0.w);
                *(u32x2*)(H + (size_t)m * D + col) = o; }
        }
    }
}
__device__ __forceinline__ void phase_a(Frame& F, int layer, bool do_norm, bool do_conv) {
    if (do_norm) { norm_rows(F, layer, false); LAUNDER(F); }
    if (!do_conv) return;
    LAS float* scr = (LAS float*)(F.lds + F.wave * 16384);
    const int gw = F.bid * NWAVES + F.wave, NGW = F.G * NWAVES;
    constexpr int I_IN = 16 * 112, I_OUT = 16 * 32, I_UPI = 16 * 16 * 16, I_DN = 16 * 4 * 32, I_PHI = 2 * 32 * 2, I_GU = 2 * 12, I_LR = 2 * 12;
    constexpr int NIT = I_IN + I_OUT + I_UPI + I_DN + I_PHI + I_GU + I_LR;
    for (int it = gw; it < NIT; it += NGW) {
        int r = it;
        const int l31 = 4 * (F.lane & 7);
        if (r < I_IN) { const int kb = r / 112, nb = r % 112;
            transpose_item(INCOLS, D, (bf16_t*)(F.ws + WS_WIN), nb * 32, kb * 64, scr, F.lane, cm_in(INF(F, I_WIN) + (size_t)layer * D * INCOLS, nb * 32 + l31)); continue; } r -= I_IN;
        if (r < I_OUT) { const int kb = r / 32, nb = r % 32;
            transpose_item(D, D, (bf16_t*)(F.ws + WS_WOUT), nb * 32, kb * 64, scr, F.lane, INF(F, I_WOUT) + (size_t)layer * D * D + nb * 32 + l31); continue; } r -= I_OUT;
        if (r < I_UPI) { const int e = r / 256, q = r % 256, kb = q / 16, nb = q % 16;
            transpose_item(256, D, (bf16_t*)(F.ws + WS_WUP) + (size_t)e * 512 * D, nb * 32, kb * 64, scr, F.lane,
                           cm_up(INF(F, I_MGATE) + ((size_t)layer * 16 + e) * D * 256, INF(F, I_MUP) + ((size_t)layer * 16 + e) * D * 256, nb * 32 + l31)); continue; } r -= I_UPI;
        if (r < I_DN) { const int e = r / 128, q = r % 128, kb = q / 32, nb = q % 32;
            transpose_item(D, 256, (bf16_t*)(F.ws + WS_WDN) + (size_t)e * D * 256, nb * 32, kb * 64, scr, F.lane, INF(F, I_MDOWN) + ((size_t)layer * 16 + e) * 256 * D + nb * 32 + l31); continue; } r -= I_DN;
        if (r < I_PHI) { const int kv = r / 64, q = r % 64, kb = q / 2, nb = q % 2;
            transpose_item(64, 2048, (bf16_t*)(F.ws + WS_PHIW) + (size_t)kv * 64 * 2048, nb * 32, kb * 64, scr, F.lane, INF(F, I_PHIW1) + ((size_t)layer * 2 + kv) * 2048 * 64 + nb * 32 + l31); continue; } r -= I_PHI;
        if (r < I_GU) { const int kb = r / 12, nb = r % 12;
            transpose_item(384, 128, (bf16_t*)(F.ws + WS_GUPT), nb * 32, kb * 64, scr, F.lane, INF(F, I_GUP) + (size_t)layer * 128 * 384 + nb * 32 + l31); continue; } r -= I_GU;
        { const int which = r / 12, nb = r % 12;
            transpose_item(384, 64, (bf16_t*)(F.ws + (which ? WS_AUPT : WS_WUPT)), nb * 32, 0, scr, F.lane, INF(F, which ? I_AUP : I_WUP) + (size_t)layer * 64 * 384 + nb * 32 + l31); }
    }
    LAUNDER(F);
    if (F.bid == F.G - 1) {
        __syncthreads();
        LAS float* part = (LAS float*)F.lds;
#pragma unroll 1
        for (int kv = 0; kv < 2; ++kv) {
            const float* w1 = INF(F, I_PHIW1) + ((size_t)layer * 2 + kv) * 2048 * 64 + (size_t)F.wave * 256 * 64; const float* pp = INF(F, I_PHIPOS) + ((size_t)layer * 2 + kv) * 2048 + F.wave * 256;
            float a[4] = {0.f, 0.f, 0.f, 0.f};
#pragma unroll 1
            for (int k = 0; k < 256; k += 16) {
                float wv[16];
#pragma unroll
                for (int u = 0; u < 16; ++u) wv[u] = w1[(size_t)(k + u) * 64 + F.lane];
#pragma unroll
                for (int u = 0; u < 16; ++u) a[u & 3] += pp[k + u] * wv[u];
            }
            part[(F.wave * 2 + kv) * 64 + F.lane] = (a[0] + a[1]) + (a[2] + a[3]);
        }
        __syncthreads();
        if (F.wave < 2) { float sacc = 0.f;
#pragma unroll
            for (int w = 0; w < 8; ++w) sacc += part[(w * 2 + F.wave) * 64 + F.lane];
            ((float*)(F.ws + WS_PHIB))[(layer * 2 + F.wave) * 64 + F.lane] = sacc; }
    }
}

struct EpiInProj {
    static constexpr bool PERM = false, AFTER_DRAIN = false;
    bf16_t* nq; bf16_t* kv6; bf16_t* mqkv; bf16_t* rfeat; float* gate; const float* cosT; const float* sinT;
    __device__ __forceinline__ void operator()(const f32x4 (&acc)[2][2][4][2], const pg8::Unit& u, int wr, int wc, int fr_, int fq_) const {
        int z_ = 0; asm volatile("" : "+s"(z_)); int l_ = (int)__builtin_amdgcn_mbcnt_hi(~0u, __builtin_amdgcn_mbcnt_lo(~0u, (unsigned)z_)); asm volatile("" : "+v"(l_)); const int fr = l_ & 15, fq = l_ >> 4; (void)fr_; (void)fq_;
#pragma unroll
        for (int bj = 0; bj < 2; ++bj) {
            const int G = 4 * u.pn + 2 * bj + (wc >> 1), w = wc & 1;
            if (G >= 53) continue;
            const int qm = u.mask >> bj;
            const int d0 = 16 * w + 4 * fq;
            const bool rope = (G < 6) || (G == 10) || (G == 11) || (G == 14) || (G == 15) || (G >= 18 && G < 26);
            const float scl = (G < 6 || (G >= 18 && G < 22)) ? 0.125f * LOG2E : 1.0f;
#pragma unroll
            for (int ai = 0; ai < 2; ++ai) {
                if (!((qm >> (2 * ai)) & 1)) continue;
#pragma unroll
                for (int m = 0; m < 4; ++m) {
                    const int row = 256 * u.pm + 128 * ai + 64 * wr + 16 * m + fr, b = row >> 13, t = row & (SEQ - 1);
                    f32x4 x1 = acc[ai][bj][m][0], x2 = acc[ai][bj][m][1];
                    if (rope) {
                        const f32x4 c = *(const f32x4*)(cosT + (size_t)row * 32 + d0), s = *(const f32x4*)(sinT + (size_t)row * 32 + d0);
                        const f32x4 y1 = (x1 * c - x2 * s) * scl, y2 = (x2 * c + x1 * s) * scl; x1 = y1; x2 = y2;
                    }
                    if (G == 52) {
                        float* gp = gate + (size_t)row * 32;
                        *(f32x4*)(gp + d0) = x1;
                        continue;
                    }
                    bf16_t* dst;
                    if (G < 6) dst = nq + ((size_t)(b * 6 + G) * SEQ + t) * 64;
                    else if (G < 18) dst = kv6 + (size_t)((G - 6) >> 1) * KV6_STRIDE + ((size_t)(b * 2 + ((G - 6) & 1)) * SEQ + t) * 64;
                    else if (G < 30) dst = mqkv + (size_t)((G - 18) >> 2) * MQKV_STRIDE + ((size_t)(b * 4 + ((G - 18) & 3)) * SEQ + t) * 64;
                    else dst = rfeat + (size_t)row * RW + (G - 30) * 64;
                    u32x2 o1, o2; o1.x = pk2(x1.x, x1.y); o1.y = pk2(x1.z, x1.w); o2.x = pk2(x2.x, x2.y); o2.y = pk2(x2.z, x2.w);
                    *(u32x2*)(dst + d0) = o1; *(u32x2*)(dst + d0 + 32) = o2;
                }
            }
        }
    }
};
struct EpiNull {
    static constexpr bool PERM = false, AFTER_DRAIN = false;
    float* sink;
    __device__ __forceinline__ void operator()(const f32x4 (&acc)[2][2][4][2], const pg8::Unit& u, int wr, int wc, int fr_, int fq_) const {
        f32x4 s = (f32x4){0.f, 0.f, 0.f, 0.f};
#pragma unroll
        for (int ai = 0; ai < 2; ++ai)
#pragma unroll
            for (int bj = 0; bj < 2; ++bj)
#pragma unroll
                for (int m = 0; m < 4; ++m)
#pragma unroll
                    for (int n = 0; n < 2; ++n) s += acc[ai][bj][m][n];
        if (s.x + s.y + s.z + s.w == 123456.789f) sink[0] = s.x;
    }
};
struct EpiOutProj {
    static constexpr bool PERM = false, AFTER_DRAIN = false;
    const float* xold; float* xnew; const float* g1;
    __device__ __forceinline__ void operator()(const f32x4 (&acc)[2][2][4][2], const pg8::Unit& u, int wr, int wc, int fr_, int fq_) const {
        int z_ = 0; asm volatile("" : "+s"(z_)); int l_ = (int)__builtin_amdgcn_mbcnt_hi(~0u, __builtin_amdgcn_mbcnt_lo(~0u, (unsigned)z_)); asm volatile("" : "+v"(l_)); const int fr = l_ & 15, fq = l_ >> 4; (void)fr_; (void)fq_;
#pragma unroll
        for (int ai = 0; ai < 2; ++ai)
#pragma unroll
            for (int m = 0; m < 4; ++m) {
                const int row = 256 * u.pm + 128 * ai + 64 * wr + 16 * m + fr, b = row >> 13;
#pragma unroll
                for (int bj = 0; bj < 2; ++bj)
#pragma unroll
                    for (int n = 0; n < 2; ++n) {
                        if (!((u.mask >> (2 * ai + bj)) & 1)) continue;
                        const int col = 256 * u.pn + 128 * bj + 32 * wc + 16 * n + 4 * fq;
                        const f32x4 g = *(const f32x4*)(g1 + (size_t)b * 6144 + col);
                        const f32x4 xo = *(const f32x4*)(xold + (size_t)row * D + col);
                        *(f32x4*)(xnew + (size_t)row * D + col) = xo + g * acc[ai][bj][m][n];
                    }
            }
    }
};
struct EpiMoeUp {
    static constexpr bool PERM = false, AFTER_DRAIN = false;
    bf16_t* hid;
    __device__ __forceinline__ void operator()(const f32x4 (&acc)[2][2][4][2], const pg8::Unit& u, int wr, int wc, int fr_, int fq_) const {
        int z_ = 0; asm volatile("" : "+s"(z_)); int l_ = (int)__builtin_amdgcn_mbcnt_hi(~0u, __builtin_amdgcn_mbcnt_lo(~0u, (unsigned)z_)); asm volatile("" : "+v"(l_)); const int fr = l_ & 15, fq = l_ >> 4; (void)fr_; (void)fq_;
#pragma unroll
        for (int ai = 0; ai < 2; ++ai)
#pragma unroll
            for (int m = 0; m < 4; ++m) {
                const int row = 256 * u.pm + 128 * ai + 64 * wr + 16 * m + fr;
#pragma unroll
                for (int bj = 0; bj < 2; ++bj) {
                    if (!((u.mask >> (2 * ai + bj)) & 1)) continue;
                    const int f0 = 16 * (8 * u.pn + 4 * bj + wc) + 4 * fq;
                    const f32x4 g = acc[ai][bj][m][0], up = acc[ai][bj][m][1];
                    u32x2 o; o.x = pk2(g.x * sigm(g.x) * up.x, g.y * sigm(g.y) * up.y); o.y = pk2(g.z * sigm(g.z) * up.z, g.w * sigm(g.w) * up.w);
                    *(u32x2*)(hid + (size_t)row * 256 + f0) = o;
                }
            }
    }
};
struct EpiMoeDown {
    static constexpr bool PERM = false, AFTER_DRAIN = false;
    bf16_t* ys; const int* tile_e; const int* elist; const float* eww;
    __device__ __forceinline__ void operator()(const f32x4 (&acc)[2][2][4][2], const pg8::Unit& u, int wr, int wc, int fr_, int fq_) const {
        int z_ = 0; asm volatile("" : "+s"(z_)); int l_ = (int)__builtin_amdgcn_mbcnt_hi(~0u, __builtin_amdgcn_mbcnt_lo(~0u, (unsigned)z_)); asm volatile("" : "+v"(l_)); const int fr = l_ & 15, fq = l_ >> 4; (void)fr_; (void)fq_;
        const int e = __builtin_amdgcn_readfirstlane(ld_ctl(tile_e + u.pm)), off = __builtin_amdgcn_readfirstlane(ld_ctl(tile_e + TE_OFF + e)), cnt = __builtin_amdgcn_readfirstlane(ld_ctl(tile_e + TE_CNT + e));
        int ri[2][4]; float wv[2][4];
#pragma unroll
        for (int ai = 0; ai < 2; ++ai)
#pragma unroll
            for (int m = 0; m < 4; ++m) { const int local = 256 * u.pm + 128 * ai + 64 * wr + 16 * m + fr - off, idx = e * 16384 + (local < cnt ? local : 0); ri[ai][m] = elist[idx]; wv[ai][m] = eww[idx]; }
#pragma unroll
        for (int ai = 0; ai < 2; ++ai)
#pragma unroll
            for (int m = 0; m < 4; ++m) {
                const int local = 256 * u.pm + 128 * ai + 64 * wr + 16 * m + fr - off;
                if (local >= cnt) continue;
                const float w = wv[ai][m];
                bf16_t* dst = ys + ((size_t)(ri[ai][m] & 1) * T + (ri[ai][m] >> 1)) * D;
#pragma unroll
                for (int bj = 0; bj < 2; ++bj)
#pragma unroll
                    for (int n = 0; n < 2; ++n) {
                        if (!((u.mask >> (2 * ai + bj)) & 1)) continue;
                        const int col = 256 * u.pn + 128 * bj + 32 * wc + 16 * n + 4 * fq;
                        const f32x4 v = acc[ai][bj][m][n] * w;
                        u32x2 o; o.x = pk2(v.x, v.y); o.y = pk2(v.z, v.w);
                        *(u32x2*)(dst + col) = o;
                    }
            }
    }
};
template <bool GATHER_>
struct MoeOrderT {
    static constexpr bool GATHER = GATHER_;
    int ntiles, nN, G, c; const int* tile_e; size_t estride; const int* elist;
    __device__ __forceinline__ void arows(const pg8::Unit& u, const int (&RA)[2], int (&o)[2][2]) const {
        const int e = __builtin_amdgcn_readfirstlane(ld_ctl(tile_e + u.pm)), off = __builtin_amdgcn_readfirstlane(ld_ctl(tile_e + TE_OFF + e)), c = __builtin_amdgcn_readfirstlane(ld_ctl(tile_e + TE_CNT + e));
        int ri[2][2];
#pragma unroll
        for (int h = 0; h < 2; ++h)
#pragma unroll
            for (int i = 0; i < 2; ++i) { const int local = 256 * u.pm + 128 * h + RA[i] - off; ri[h][i] = elist[e * 16384 + (local < c ? local : 0)]; }
#pragma unroll
        for (int h = 0; h < 2; ++h)
#pragma unroll
            for (int i = 0; i < 2; ++i) { const int local = 256 * u.pm + 128 * h + RA[i] - off; o[h][i] = (local < c) ? (ri[h][i] >> 1) : 0; }
    }
    __device__ __forceinline__ bool next(int i, pg8::Unit& u) const { int L, f, sub; const int U = ntiles * nN;
        if ((G & 7) == 0) { const int x = c & 7, j = c >> 3, nb = G >> 3, U8 = (U + 7) >> 3, lo = x * U8, n = (lo + U8 <= U) ? U8 : (U > lo ? U - lo : 0);
            if (!pg8::tail_split(i, nb, j, n, L, f, sub)) return false; L += lo; }
        else if (!pg8::tail_split(i, G, c, U, L, f, sub)) return false;
        u.pm = L / nN; u.pn = L % nN; u.mask = (f == 1) ? 0xF : (f == 2) ? (sub ? 0xA : 0x5) : (1 << sub); return true; }
    __device__ __forceinline__ void a_ready(const pg8::Unit&) const {}
    __device__ __forceinline__ size_t boff(const pg8::Unit& u) const { return (size_t)__builtin_amdgcn_readfirstlane(ld_ctl(tile_e + u.pm)) * estride; }
    __device__ __forceinline__ void done(const pg8::Unit&) const {}
};
typedef MoeOrderT<false> MoeOrder;
typedef MoeOrderT<true> MoeGatherOrder;

__device__ __forceinline__ float gelu_tanh(float x) { const float u = 0.7978845608028654f * (x + 0.044715f * x * x * x); return 0.5f * x * (1.f + tanhf(u)); }

__device__ __forceinline__ void compress_unit(Frame& F, int layer, int u) {
    const int kvsel = u >> 5, b = (u >> 4) & 1, kvh = (u >> 3) & 1, rt = u & 7, i0 = 64 * rt;
    const bf16_t* src = (const bf16_t*)(F.ws + WS_KV6) + (size_t)kvsel * KV6_STRIDE + (size_t)(b * 2 + kvh) * SEQ * 64;
    const bf16_t* w1t = (const bf16_t*)(F.ws + WS_PHIW) + (size_t)kvsel * 64 * 2048;
    const int lane = F.lane, r = lane & 15, kg = lane >> 4;
    f32x4 acc[4][4];
#pragma unroll
    for (int a = 0; a < 4; ++a)
#pragma unroll
        for (int c = 0; c < 4; ++c) acc[a][c] = (f32x4){0.f, 0.f, 0.f, 0.f};
#pragma unroll 2
    for (int lq = 0; lq < 4; ++lq) {
        const int l = 4 * F.wave + lq;
#pragma unroll
        for (int ks = 0; ks < 2; ++ks) {
            bf16x8 af[4], bfr[4];
#pragma unroll
            for (int mt = 0; mt < 4; ++mt) af[mt] = *(const bf16x8*)(src + ((size_t)(16 * (i0 + 16 * mt + r) + l)) * 64 + 32 * ks + 8 * kg);
#pragma unroll
            for (int nt = 0; nt < 4; ++nt) bfr[nt] = *(const bf16x8*)(w1t + (size_t)(16 * nt + r) * 2048 + l * 64 + 32 * ks + 8 * kg);
#pragma unroll
            for (int mt = 0; mt < 4; ++mt)
#pragma unroll
                for (int nt = 0; nt < 4; ++nt) acc[mt][nt] = MFMA16(af[mt], bfr[nt], acc[mt][nt]);
        }
    }
    LAS float* part = (LAS float*)F.lds;
#pragma unroll
    for (int mt = 0; mt < 4; ++mt)
#pragma unroll
        for (int nt = 0; nt < 4; ++nt)
#pragma unroll
            for (int q = 0; q < 4; ++q) part[(F.wave * 64 + 16 * mt + 4 * kg + q) * 64 + 16 * nt + r] = acc[mt][nt][q];
    __syncthreads();
    const float* phib = (const float*)(F.ws + WS_PHIB) + (layer * 2 + kvsel) * 64;
    float hv[8];
    const int row = F.tid >> 3, e0 = (F.tid & 7) * 8;
#pragma unroll
    for (int k = 0; k < 8; ++k) { float s = phib[e0 + k];
#pragma unroll
        for (int w = 0; w < 8; ++w) s += part[(w * 64 + row) * 64 + e0 + k];
        hv[k] = gelu_tanh(s); }
    __syncthreads();
    LAS float* hb = (LAS float*)F.lds;
    LAS float* ob = (LAS float*)(F.lds + 32768);
#pragma unroll
    for (int k = 0; k < 8; ++k) hb[row * 65 + e0 + k] = hv[k];
    __syncthreads();
    const float* w2 = INF(F, I_PHIW2) + ((size_t)layer * 2 + kvsel) * 64 * 64;
    float o[8];
#pragma unroll
    for (int k = 0; k < 8; ++k) o[k] = 0.f;
#pragma unroll 8
    for (int e = 0; e < 64; ++e) { const float h = hb[row * 65 + e]; const f32x4 wa = *(const f32x4*)(w2 + e * 64 + e0), wb = *(const f32x4*)(w2 + e * 64 + e0 + 4);
        o[0] += h * wa.x; o[1] += h * wa.y; o[2] += h * wa.z; o[3] += h * wa.w; o[4] += h * wb.x; o[5] += h * wb.y; o[6] += h * wb.z; o[7] += h * wb.w; }
#pragma unroll
    for (int k = 0; k < 8; ++k) ob[row * 65 + e0 + k] = o[k];
    __syncthreads();
    const int i = i0 + row;
    bf16_t* dst = (bf16_t*)(F.ws + (kvsel ? WS_VCMP : WS_KCMP)) + ((size_t)(b * 2 + kvh) * 512 + i) * 64 + e0;
    float y[8];
    if (i >= 511) {
#pragma unroll
        for (int k = 0; k < 8; ++k) y[k] = 0.f;
    } else if (kvsel == 0) {
        const size_t pr = (size_t)b * SEQ + 16 * i + 31;
        const float* cs = (const float*)(F.ws + WS_COS) + pr * 32; const float* sn = (const float*)(F.ws + WS_SIN) + pr * 32;
#pragma unroll
        for (int k = 0; k < 8; ++k) { const int d = e0 + k, f = d & 31; const float x1 = ob[row * 65 + f], x2 = ob[row * 65 + f + 32];
            y[k] = (d < 32) ? (x1 * cs[f] - x2 * sn[f]) : (x2 * cs[f] + x1 * sn[f]); }
    } else {
#pragma unroll
        for (int k = 0; k < 8; ++k) y[k] = o[k];
    }
    u32x4 pk; pk.x = pk2(y[0], y[1]); pk.y = pk2(y[2], y[3]); pk.z = pk2(y[4], y[5]); pk.w = pk2(y[6], y[7]);
    *(u32x4*)dst = pk;
    __syncthreads();
}
__device__ __forceinline__ void kmean_task(Frame& F, int wt) {
    const int b = wt >> 7, h = (wt >> 5) & 3, blk = wt & 31, sub = F.lane >> 3, ch = F.lane & 7;
    const bf16_t* mk = (const bf16_t*)(F.ws + WS_MQKV) + MQKV_STRIDE + ((size_t)(b * 4 + h) * SEQ + 256 * blk) * 64;
    float a[8];
#pragma unroll
    for (int k = 0; k < 8; ++k) a[k] = 0.f;
#pragma unroll 8
    for (int it = 0; it < 32; ++it) {
        const u32x4 v = *(const u32x4*)(mk + (size_t)(8 * it + sub) * 64 + 8 * ch);
        a[0] += __uint_as_float(v.x << 16); a[1] += __uint_as_float(v.x & 0xffff0000u); a[2] += __uint_as_float(v.y << 16); a[3] += __uint_as_float(v.y & 0xffff0000u);
        a[4] += __uint_as_float(v.z << 16); a[5] += __uint_as_float(v.z & 0xffff0000u); a[6] += __uint_as_float(v.w << 16); a[7] += __uint_as_float(v.w & 0xffff0000u);
    }
#pragma unroll
    for (int k = 0; k < 8; ++k) { a[k] += shx(a[k], 8, F.lane); a[k] += shx(a[k], 16, F.lane); a[k] += shx(a[k], 32, F.lane); a[k] *= (1.f / 256.f); }
    if (sub == 0) { u32x4 o; o.x = pk2(a[0], a[1]); o.y = pk2(a[2], a[3]); o.z = pk2(a[4], a[5]); o.w = pk2(a[6], a[7]);
        *(u32x4*)((bf16_t*)(F.ws + WS_KMEAN) + ((size_t)(b * 4 + h) * 32 + blk) * 64 + 8 * ch) = o; }
}

constexpr int R1_TASK_OFF = 32768, R1_TASK_BYTES = 12288;
__device__ __forceinline__ unsigned bf_hi(float x) { return __float_as_uint(x) >> 16; }
__device__ __forceinline__ void r1_block(Frame& F, int layer, int bt) {
    const int chain = bt >> 4, b = chain / 6, h = chain % 6, lane0 = F.lane;
    const int chunk = 8 * (bt & 15) + F.wave, task = chain * 128 + chunk;
    LAS float* tb = (LAS float*)(F.lds + R1_TASK_OFF + F.wave * R1_TASK_BYTES);
    LAS float* Lr = tb; LAS float* Lw = tb + 512; LAS float* Lk = tb + 1024; LAS float* Lkk = tb + 1536; LAS float* Lbb = tb + 2048; LAS float* Lv = tb + 2560;
    const bf16_t* rf = (const bf16_t*)(F.ws + WS_RFEAT);
    const float* mu = INF(F, I_MU) + layer * RW;
    float* bonus = (float*)(F.ws + WS_BONUS);
    bf16_t* ytil = (bf16_t*)(F.ws + WS_YT) + (size_t)task * 4096; bf16_t* y0o = (bf16_t*)(F.ws + WS_Y0) + (size_t)task * 4096;
    bf16_t* lora = (bf16_t*)(F.ws + (task < 896 ? (size_t)242 * MiB + (size_t)task * 16384 : task < 1344 ? WS_WIN + (size_t)(task - 896) * 16384 : WS_ROUTE + (size_t)(task - 1344) * 16384));
    {
        const int c31 = lane0 & 31, hi = lane0 >> 5;
        f32x16 aw[2][2], aa[2][2];
#pragma unroll
        for (int mt = 0; mt < 2; ++mt)
#pragma unroll
            for (int nt = 0; nt < 2; ++nt)
#pragma unroll
                for (int r = 0; r < 16; ++r) { aw[mt][nt][r] = 0.f; aa[mt][nt][r] = 0.f; }
        const bf16_t* wt = (const bf16_t*)(F.ws + WS_WUPT) + (size_t)(h * 64) * 64; const bf16_t* at = (const bf16_t*)(F.ws + WS_AUPT) + (size_t)(h * 64) * 64;
#pragma unroll
        for (int ks = 0; ks < 4; ++ks) {
            const int j0 = 16 * ks + 8 * hi;
            bf16x8 fw[2], fa[2], bw[2], ba[2];
#pragma unroll
            for (int nt = 0; nt < 2; ++nt) { bw[nt] = *(const bf16x8*)(wt + (32 * nt + c31) * 64 + j0); ba[nt] = *(const bf16x8*)(at + (32 * nt + c31) * 64 + j0); }
#pragma unroll
            for (int mt = 0; mt < 2; ++mt) {
                const int t = 64 * chunk + 32 * mt + c31; const int rowi = b * SEQ + t;
                const u32x4 cw = *(const u32x4*)(rf + (size_t)rowi * RW + 1152 + j0), ca = *(const u32x4*)(rf + (size_t)rowi * RW + 1216 + j0);
                u32x4 pw = (u32x4){0u, 0u, 0u, 0u}, pa = (u32x4){0u, 0u, 0u, 0u};
                if (t > 0) { pw = *(const u32x4*)(rf + (size_t)(rowi - 1) * RW + 1152 + j0); pa = *(const u32x4*)(rf + (size_t)(rowi - 1) * RW + 1216 + j0); }
                const f32x4 mw0 = *(const f32x4*)(mu + 1152 + j0), mw1 = *(const f32x4*)(mu + 1152 + j0 + 4), ma0 = *(const f32x4*)(mu + 1216 + j0), ma1 = *(const f32x4*)(mu + 1216 + j0 + 4);
                const float mwv[8] = {mw0.x, mw0.y, mw0.z, mw0.w, mw1.x, mw1.y, mw1.z, mw1.w}, mav[8] = {ma0.x, ma0.y, ma0.z, ma0.w, ma1.x, ma1.y, ma1.z, ma1.w};
                const unsigned cwv[4] = {cw.x, cw.y, cw.z, cw.w}, pwv[4] = {pw.x, pw.y, pw.z, pw.w}, cav[4] = {ca.x, ca.y, ca.z, ca.w}, pav[4] = {pa.x, pa.y, pa.z, pa.w};
                float xw[8], xa[8];
#pragma unroll
                for (int k = 0; k < 4; ++k) {
                    const float c0 = __uint_as_float(cwv[k] << 16), c1 = __uint_as_float(cwv[k] & 0xffff0000u), p0 = __uint_as_float(pwv[k] << 16), p1 = __uint_as_float(pwv[k] & 0xffff0000u);
                    xw[2 * k] = tanh_fast(c0 + (p0 - c0) * mwv[2 * k]); xw[2 * k + 1] = tanh_fast(c1 + (p1 - c1) * mwv[2 * k + 1]);
                    const float d0 = __uint_as_float(cav[k] << 16), d1 = __uint_as_float(cav[k] & 0xffff0000u), q0 = __uint_as_float(pav[k] << 16), q1 = __uint_as_float(pav[k] & 0xffff0000u);
                    xa[2 * k] = d0 + (q0 - d0) * mav[2 * k]; xa[2 * k + 1] = d1 + (q1 - d1) * mav[2 * k + 1];
                }
                u32x4 uw, ua; uw.x = pk2(xw[0], xw[1]); uw.y = pk2(xw[2], xw[3]); uw.z = pk2(xw[4], xw[5]); uw.w = pk2(xw[6], xw[7]);
                ua.x = pk2(xa[0], xa[1]); ua.y = pk2(xa[2], xa[3]); ua.z = pk2(xa[4], xa[5]); ua.w = pk2(xa[6], xa[7]);
                fw[mt] = __builtin_bit_cast(bf16x8, uw); fa[mt] = __builtin_bit_cast(bf16x8, ua);
            }
#pragma unroll
            for (int mt = 0; mt < 2; ++mt)
#pragma unroll
                for (int nt = 0; nt < 2; ++nt) { aw[mt][nt] = MFMA32(fw[mt], bw[nt], aw[mt][nt]); aa[mt][nt] = MFMA32(fa[mt], ba[nt], aa[mt][nt]); }
        }
#pragma unroll
        for (int mt = 0; mt < 2; ++mt)
#pragma unroll
            for (int nt = 0; nt < 2; ++nt)
#pragma unroll
                for (int r = 0; r < 16; ++r) { const int tl = 32 * mt + (r & 3) + 8 * (r >> 2) + 4 * hi;
                    lora[tl * 64 + 32 * nt + c31] = f2bf(aw[mt][nt][r]); lora[4096 + tl * 64 + 32 * nt + c31] = f2bf(aa[mt][nt][r]); }
        asm volatile("s_waitcnt vmcnt(0)" ::: "memory");
    }
    float Wrun = 1.f;
    f32x16 XP[2][2], XZ[2][2];
    { const int c31 = lane0 & 31, hi = lane0 >> 5;
#pragma unroll
      for (int mt = 0; mt < 2; ++mt)
#pragma unroll
          for (int nt = 0; nt < 2; ++nt)
#pragma unroll
              for (int r = 0; r < 16; ++r) { XP[mt][nt][r] = (32 * mt + (r & 3) + 8 * (r >> 2) + 4 * hi == 32 * nt + c31) ? 1.f : 0.f; XZ[mt][nt][r] = 0.f; } }
#pragma unroll 1
    for (int sub = 0; sub < 8; ++sub) {
        int lane = lane0, hc = h * 64 + lane0; asm volatile("" : "+v"(lane), "+v"(hc));
#pragma unroll 1
        for (int half = 0; half < 2; ++half) {
            float rs4[4], ks4[4], vs4[4], aw4[4], aa4[4];
            const float mu_r = mu[hc], mu_k = mu[384 + hc], mu_v = mu[768 + hc];
            const float w0 = INF(F, I_W0)[layer * 384 + hc], a0 = INF(F, I_A0)[layer * 384 + hc];
#pragma unroll
            for (int q = 0; q < 4; ++q) {
                const int tl = 8 * sub + 4 * half + q, t = 64 * chunk + tl; const int rowi = b * SEQ + t;
                const bf16_t* cur = rf + (size_t)rowi * RW; const bf16_t* prv = cur - RW; const bool hp = t > 0;
                const float rc = bf2f(cur[hc]), kc = bf2f(cur[384 + hc]), vc = bf2f(cur[768 + hc]);
                const float rp = hp ? bf2f(prv[hc]) : 0.f, kp = hp ? bf2f(prv[384 + hc]) : 0.f, vp = hp ? bf2f(prv[768 + hc]) : 0.f;
                rs4[q] = rc + (rp - rc) * mu_r; ks4[q] = kc + (kp - kc) * mu_k; vs4[q] = vc + (vp - vc) * mu_v;
                aw4[q] = w0 + bf2f(lora[tl * 64 + lane]); aa4[q] = a0 + bf2f(lora[4096 + tl * 64 + lane]);
            }
            const float k_k = INF(F, I_KK)[layer * 384 + hc], k_a = INF(F, I_KA)[layer * 384 + hc], r_k = INF(F, I_RK)[layer * 384 + hc];
#pragma unroll
            for (int q = 0; q < 4; ++q) {
                const int tt = 4 * half + q; const int rowi = b * SEQ + 64 * chunk + 8 * sub + tt;
                const float dec = __expf(-0.606531f * sigm(aw4[q])), a = sigm(aa4[q]);
                float kk = ks4[q] * k_k; const float n2 = wave_sum(kk * kk, lane); kk = kk * __builtin_amdgcn_rsqf(fmaxf(n2, 1e-24f));
                const float km = ks4[q] * (1.f + (a - 1.f) * k_a);
                const float bn = wave_sum(rs4[q] * km * r_k, lane);
                const float Wprev = Wrun; Wrun *= dec; const float iW = __builtin_amdgcn_rcpf(Wrun);
                Lr[tt * 64 + lane] = rs4[q] * Wrun; Lk[tt * 64 + lane] = km * iW; Lkk[tt * 64 + lane] = -(kk * Wprev); Lbb[tt * 64 + lane] = kk * a * iW; Lv[tt * 64 + lane] = vs4[q];
                if (lane == 0) bonus[(size_t)rowi * 8 + h] = bn;
            }
        }
        LDS_WAIT(); asm volatile("" ::: "memory");
        const int c31 = lane & 31, hi = lane >> 5;
#pragma unroll 1
        for (int tt = 0; tt < 8; ++tt) {
            f32x4 k4[2][4], r4[2][4];
#pragma unroll
            for (int mt = 0; mt < 2; ++mt)
#pragma unroll
                for (int rq = 0; rq < 4; ++rq) { const int c0 = tt * 64 + 32 * mt + 8 * rq + 4 * hi;
                    k4[mt][rq] = *(const LAS f32x4*)(Lkk + c0); r4[mt][rq] = *(const LAS f32x4*)(Lr + c0); }
            float saP[2], saZ[2];
#pragma unroll
            for (int nt = 0; nt < 2; ++nt) { f32x2_t p2 = {0.f, 0.f}, z2 = {0.f, 0.f};
#pragma unroll
                for (int mt = 0; mt < 2; ++mt)
#pragma unroll
                    for (int r = 0; r < 16; r += 2) { const f32x2_t kk2 = {k4[mt][r >> 2][r & 3], k4[mt][r >> 2][(r & 3) + 1]};
                        const f32x2_t xp2 = {XP[mt][nt][r], XP[mt][nt][r + 1]}, xz2 = {XZ[mt][nt][r], XZ[mt][nt][r + 1]};
                        p2 = __builtin_elementwise_fma(xp2, kk2, p2); z2 = __builtin_elementwise_fma(xz2, kk2, z2); }
                float p = p2.x + p2.y, z = z2.x + z2.y;
                p = half_sum32(p); z = half_sum32(z); saP[nt] = p; saZ[nt] = z; }
            bf16x8 af[2], bP[2], bZ[2];
#pragma unroll
            for (int mt = 0; mt < 2; ++mt) { const float bbv = Lbb[tt * 64 + 32 * mt + c31], kv = Lk[tt * 64 + 32 * mt + c31];
                const unsigned bh = bf_hi(bbv), kh = bf_hi(kv); const unsigned bl = bf_hi(bbv - __uint_as_float(bh << 16)), kl = bf_hi(kv - __uint_as_float(kh << 16));
                u32x4 u; u.x = bh | (bl << 16); u.y = bh | (kh << 16); u.z = kl | (kh << 16); u.w = 0u;
                if (hi) u = (u32x4){0u, 0u, 0u, 0u};
                af[mt] = __builtin_bit_cast(bf16x8, u); }
#pragma unroll
            for (int nt = 0; nt < 2; ++nt) { const float vv = Lv[tt * 64 + 32 * nt + c31];
                const unsigned ph = bf_hi(saP[nt]), zh = bf_hi(saZ[nt]), vh = bf_hi(vv);
                const unsigned pl = bf_hi(saP[nt] - __uint_as_float(ph << 16)), zl = bf_hi(saZ[nt] - __uint_as_float(zh << 16)), vl = bf_hi(vv - __uint_as_float(vh << 16));
                u32x4 up, uz; up.x = ph | (ph << 16); up.y = pl; up.z = 0u; up.w = 0u;
                uz.x = zh | (zh << 16); uz.y = zl | (vh << 16); uz.z = vh | (vl << 16); uz.w = 0u;
                if (hi) { up = (u32x4){0u, 0u, 0u, 0u}; uz = (u32x4){0u, 0u, 0u, 0u}; }
                bP[nt] = __builtin_bit_cast(bf16x8, up); bZ[nt] = __builtin_bit_cast(bf16x8, uz); }
#pragma unroll
            for (int mt = 0; mt < 2; ++mt)
#pragma unroll
                for (int nt = 0; nt < 2; ++nt) { XP[mt][nt] = MFMA32(af[mt], bP[nt], XP[mt][nt]); XZ[mt][nt] = MFMA32(af[mt], bZ[nt], XZ[mt][nt]); }
#pragma unroll
            for (int nt = 0; nt < 2; ++nt) { f32x2_t p2 = {0.f, 0.f}, z2 = {0.f, 0.f};
#pragma unroll
                for (int mt = 0; mt < 2; ++mt)
#pragma unroll
                    for (int r = 0; r < 16; r += 2) { const f32x2_t rr2 = {r4[mt][r >> 2][r & 3], r4[mt][r >> 2][(r & 3) + 1]};
                        const f32x2_t xp2 = {XP[mt][nt][r], XP[mt][nt][r + 1]}, xz2 = {XZ[mt][nt][r], XZ[mt][nt][r + 1]};
                        p2 = __builtin_elementwise_fma(xp2, rr2, p2); z2 = __builtin_elementwise_fma(xz2, rr2, z2); }
                float p = p2.x + p2.y, z = z2.x + z2.y;
                p = half_sum32(p); z = half_sum32(z);
                if (hi == 0) { ytil[(8 * sub + tt) * 64 + 32 * nt + c31] = f2bf(p); y0o[(8 * sub + tt) * 64 + 32 * nt + c31] = f2bf(z); } }
        }
    }
    int lane_e = lane0; asm volatile("" : "+v"(lane_e));
    Lw[lane_e] = Wrun; LDS_WAIT(); asm volatile("" ::: "memory");
    { const int hi_ = lane_e >> 5;
#pragma unroll
      for (int mt = 0; mt < 2; ++mt)
#pragma unroll
          for (int rq = 0; rq < 4; ++rq) { const f32x4 wl = *(const LAS f32x4*)(Lw + 32 * mt + 8 * rq + 4 * hi_);
#pragma unroll
              for (int nt = 0; nt < 2; ++nt)
#pragma unroll
                  for (int k = 0; k < 4; ++k) { XP[mt][nt][4 * rq + k] *= wl[k]; XZ[mt][nt][4 * rq + k] *= wl[k]; } } }
    { const int c31 = lane_e & 31, hi = lane_e >> 5;
      bf16_t* PT = (bf16_t*)(F.ws + WS_PT) + (size_t)task * 4096;
      bf16_t* ZP = (bf16_t*)(F.ws + WS_ZS) + (size_t)task * 4096;
#pragma unroll
      for (int mt = 0; mt < 2; ++mt)
#pragma unroll
          for (int nt = 0; nt < 2; ++nt) {
#pragma unroll
              for (int r = 0; r < 16; ++r) PT[(32 * mt + (r & 3) + 8 * (r >> 2) + 4 * hi) * 64 + 32 * nt + c31] = f2bf(XP[mt][nt][r]);
              u32x4 a, c2; a.x = pk2(XZ[mt][nt][0], XZ[mt][nt][1]); a.y = pk2(XZ[mt][nt][2], XZ[mt][nt][3]); a.z = pk2(XZ[mt][nt][4], XZ[mt][nt][5]); a.w = pk2(XZ[mt][nt][6], XZ[mt][nt][7]);
              c2.x = pk2(XZ[mt][nt][8], XZ[mt][nt][9]); c2.y = pk2(XZ[mt][nt][10], XZ[mt][nt][11]); c2.z = pk2(XZ[mt][nt][12], XZ[mt][nt][13]); c2.w = pk2(XZ[mt][nt][14], XZ[mt][nt][15]);
              *(u32x4*)(ZP + ((mt * 2 + nt) * 64 + lane_e) * 16) = a; *(u32x4*)(ZP + ((mt * 2 + nt) * 64 + lane_e) * 16 + 8) = c2; } }
    __syncthreads();
}
constexpr int CW_PREP = 768;
constexpr int CW_R1DONE = 896;
__device__ __forceinline__ void publish_count(Frame& F, unsigned* word) {
    asm volatile("s_waitcnt vmcnt(0)" ::: "memory"); __syncthreads();
    if (F.tid == 0) { __builtin_amdgcn_fence(__ATOMIC_RELEASE, "agent"); asm volatile("s_waitcnt vmcnt(0)" ::: "memory"); (void)__hip_atomic_fetch_add(word, 1u, RLX_AGENT); }
}
__device__ __forceinline__ void await_count(Frame& F, unsigned* word, unsigned want) {
    if (F.tid == 0) { unsigned sp = 0; while ((unsigned)__builtin_amdgcn_readfirstlane(__hip_atomic_load(word, RLX_AGENT)) < want) { __builtin_amdgcn_s_sleep(4); if (++sp > (1u << 24)) break; }
        __builtin_amdgcn_fence(__ATOMIC_ACQUIRE, "agent"); asm volatile("s_waitcnt vmcnt(0)" ::: "memory"); }
    __syncthreads();
}
__device__ __forceinline__ void phase_c(Frame& F, int layer) {
    if (F.bid < 192) r1_block(F, layer, F.bid);
    else { compress_unit(F, layer, F.bid - 192); LAUNDER(F); if (F.bid < 224) kmean_task(F, (F.bid - 192) * 8 + F.wave); }
    LAUNDER(F);
    publish_count(F, F.ctl + ((F.bid < 192) ? CW_R1DONE + 64 * layer + (F.bid >> 4) : CW_PREP + 64 * layer));
}

constexpr int KP = 72;
constexpr int TILE_B = 64 * KP * 2;
constexpr int AT_K0 = 0, AT_V0 = 2 * TILE_B;
constexpr int AT_IMP = 4 * TILE_B;
constexpr int AT_MISC = AT_IMP + 8 * 8192;
constexpr int AT_KMEAN = AT_MISC + 256;
constexpr int R2_SBUF = 0;

__device__ __forceinline__ bf16x8 lds_frag(const LAS bf16_t* tile, int row, int col) { return *(const LAS bf16x8*)(tile + row * KP + col); }
__device__ __forceinline__ s16x4 lds_tr(const LAS bf16_t* p) { return __builtin_bit_cast(s16x4, __builtin_amdgcn_ds_read_tr16_b64_v4i16((LAS v4i16_t*)p)); }
__device__ __forceinline__ bf16x8 cat8(s16x4 a, s16x4 b) { bf16x8 r; r[0] = a[0]; r[1] = a[1]; r[2] = a[2]; r[3] = a[3]; r[4] = b[0]; r[5] = b[1]; r[6] = b[2]; r[7] = b[3]; return r; }
__device__ __forceinline__ bf16x8 pack8(const f32x4& a, const f32x4& b) { u32x4 u; u.x = pk2(a.x, a.y); u.y = pk2(a.z, a.w); u.z = pk2(b.x, b.y); u.w = pk2(b.z, b.w); return __builtin_bit_cast(bf16x8, u); }

template <int NH>
__device__ __forceinline__ void qk_tile(const LAS bf16_t* Kt, const bf16x8 (&qf)[NH][2], f32x4 (&st)[NH][4], const float (&cm)[NH], int lane, const bool (&keep)[NH]) {
    const int r = lane & 15, kg = lane >> 4;
    f32x4 ci[NH];
#pragma unroll
    for (int g = 0; g < NH; ++g) { const float c = keep[g] ? cm[g] : -INFINITY; ci[g] = (f32x4){c, c, c, c}; }
#pragma unroll
    for (int kt = 0; kt < 4; ++kt) {
        const bf16x8 k0 = lds_frag(Kt, 16 * kt + r, 8 * kg), k1 = lds_frag(Kt, 16 * kt + r, 32 + 8 * kg);
#pragma unroll
        for (int g = 0; g < NH; ++g) { f32x4 z = MFMA16(k0, qf[g][0], ci[g]); st[g][kt] = MFMA16(k1, qf[g][1], z); }
    }
}
template <int NH, bool DO_V>
__device__ __forceinline__ void pv_tile(const LAS bf16_t* Vt, const f32x4 (&p)[NH][4], f32x4 (&o)[NH][4], f32x4 (&lacc)[NH], int lane) {
    const int kg = lane >> 4, rr = (lane & 15) >> 2, cc = 4 * (lane & 3);
    const u32x4 one4 = (u32x4){0x3f803f80u, 0x3f803f80u, 0x3f803f80u, 0x3f803f80u};
    const bf16x8 ones = __builtin_bit_cast(bf16x8, one4);
#pragma unroll
    for (int i = 0; i < 2; ++i) {
        bf16x8 pf[NH];
#pragma unroll
        for (int g = 0; g < NH; ++g) { pf[g] = pack8(p[g][2 * i], p[g][2 * i + 1]); lacc[g] = MFMA16(ones, pf[g], lacc[g]); }
        if (DO_V) {
#pragma unroll
            for (int dt = 0; dt < 4; ++dt) {
                const s16x4 lo = lds_tr(Vt + (32 * i + 4 * kg + rr) * KP + 16 * dt + cc), hi = lds_tr(Vt + (32 * i + 16 + 4 * kg + rr) * KP + 16 * dt + cc);
                const bf16x8 vf = cat8(lo, hi);
#pragma unroll
                for (int g = 0; g < NH; ++g) o[g][dt] = MFMA16(vf, pf[g], o[g][dt]);
            }
        }
    }
}
__device__ __forceinline__ void softmax_tile(f32x4 (&st)[4], f32x4 (&o)[4], f32x4& lacc, float& mref, int lane) {
    float mx = -INFINITY;
#pragma unroll
    for (int kt = 0; kt < 4; ++kt) mx = fmaxf(fmaxf(mx, fmaxf(st[kt].x, st[kt].y)), fmaxf(st[kt].z, st[kt].w));
    mx = fmaxf(mx, shx(mx, 16, lane)); mx = fmaxf(mx, shx(mx, 32, lane));
    const bool fresh = (mref == -INFINITY);
    if (__any((fresh && mx > -INFINITY) || mx > 8.0f)) {
        const float d = fresh ? ((mx == -INFINITY) ? 0.f : mx) : fmaxf(mx, 0.f);
        const float alpha = fresh ? 1.f : __builtin_amdgcn_exp2f(-d);
        mref = fresh ? mx : mref + d;
        lacc = lacc * alpha;
#pragma unroll
        for (int dt = 0; dt < 4; ++dt) o[dt] = o[dt] * alpha;
#pragma unroll
        for (int kt = 0; kt < 4; ++kt) st[kt] = st[kt] - d;
    }
#pragma unroll
    for (int kt = 0; kt < 4; ++kt) {
        st[kt].x = __builtin_amdgcn_exp2f(st[kt].x); st[kt].y = __builtin_amdgcn_exp2f(st[kt].y);
        st[kt].z = __builtin_amdgcn_exp2f(st[kt].z); st[kt].w = __builtin_amdgcn_exp2f(st[kt].w);
    }
}
#define MX2(a, b) __builtin_elementwise_maximum((float)(a), (float)(b))
#define MX3(a, b, c) MX2(MX2(a, b), c)
template <int NH>
__device__ __forceinline__ void softmax_tiles(f32x4 (&st)[NH][4], f32x4 (&o)[NH][4], f32x4 (&lacc)[NH], float (&mref)[NH], float (&cm)[NH], int lane) {
    float mx[NH];
#pragma unroll
    for (int g = 0; g < NH; ++g) {
        float a = MX3(st[g][0].x, st[g][0].y, st[g][0].z), c = MX3(st[g][2].x, st[g][2].y, st[g][2].z);
        a = MX3(a, st[g][0].w, st[g][1].x); c = MX3(c, st[g][2].w, st[g][3].x);
        a = MX3(a, st[g][1].y, st[g][1].z); c = MX3(c, st[g][3].y, st[g][3].z);
        mx[g] = MX3(MX3(a, st[g][1].w, st[g][3].w), c, c); }
#pragma unroll
    for (int g = 0; g < NH; ++g)
#pragma unroll
        for (int kt = 0; kt < 4; ++kt) {
            st[g][kt].x = __builtin_amdgcn_exp2f(st[g][kt].x); st[g][kt].y = __builtin_amdgcn_exp2f(st[g][kt].y);
            st[g][kt].z = __builtin_amdgcn_exp2f(st[g][kt].z); st[g][kt].w = __builtin_amdgcn_exp2f(st[g][kt].w);
        }
#pragma unroll
    for (int g = 0; g < NH; ++g) { const unsigned u = __float_as_uint(mx[g]); auto a = __builtin_amdgcn_permlane16_swap(u, u, false, false); mx[g] = MX2(__uint_as_float(a[0]), __uint_as_float(a[1])); }
#pragma unroll
    for (int g = 0; g < NH; ++g) { const unsigned u = __float_as_uint(mx[g]); auto a = __builtin_amdgcn_permlane32_swap(u, u, false, false); mx[g] = MX2(__uint_as_float(a[0]), __uint_as_float(a[1])); }
    bool need = false;
#pragma unroll
    for (int g = 0; g < NH; ++g) need = need | (((mref[g] == -INFINITY) & (mx[g] > -INFINITY)) | (mx[g] > 8.0f));
    if (__any(need)) {
#pragma unroll
        for (int g = 0; g < NH; ++g) {
            const bool fresh = (mref[g] == -INFINITY);
            const float d = fresh ? ((mx[g] == -INFINITY) ? 0.f : fmaxf(mx[g], -100.f)) : fmaxf(mx[g], 0.f);
            const float pf = __builtin_amdgcn_exp2f(-d);
            const float alpha = fresh ? 1.f : pf;
            mref[g] = fresh ? ((mx[g] == -INFINITY) ? -INFINITY : d) : mref[g] + d;
            cm[g] = (mref[g] == -INFINITY) ? 0.f : -mref[g];
            lacc[g] = lacc[g] * alpha;
#pragma unroll
            for (int dt = 0; dt < 4; ++dt) o[g][dt] = o[g][dt] * alpha;
#pragma unroll
            for (int kt = 0; kt < 4; ++kt) st[g][kt] = st[g][kt] * pf;
        }
    }
}
__device__ __forceinline__ void acc_pk(u32x2& d, const f32x4& v) {
    const float a = __uint_as_float(d.x << 16) + v.x, b = __uint_as_float(d.x & 0xffff0000u) + v.y, c = __uint_as_float(d.y << 16) + v.z, e = __uint_as_float(d.y & 0xffff0000u) + v.w;
    d.x = pk2(a, b); d.y = pk2(c, e); }
__device__ __forceinline__ u32x4 tile_load(const bf16_t* g, int tid) { const int off = (tid >> 3) * 64 + (tid & 7) * 8; return *(const u32x4*)(g + off); }
__device__ __forceinline__ void tile_store(LAS bf16_t* t, int tid, u32x4 v) { *(LAS u32x4*)(t + (tid >> 3) * KP + (tid & 7) * 8) = v; }

__device__ __forceinline__ void nsa_task(Frame& F, int b, int kvh, int J) {
    const int lane = F.lane, tid = F.tid, wv = F.wave, q = lane & 15, kg = lane >> 4;
    const int t0 = 128 * J, tw0 = t0 + 16 * wv, tq_abs = tw0 + q, cur = tw0 >> 6, tq = tq_abs & 63;
    LAS bf16_t* Kb = (LAS bf16_t*)(F.lds + AT_K0); LAS bf16_t* Vb = (LAS bf16_t*)(F.lds + AT_V0);
    LAS float* imp = (LAS float*)(F.lds + AT_IMP + wv * 8192);
    const bf16_t* kvbase = (const bf16_t*)(F.ws + WS_KV6);
    const size_t slab = (size_t)(b * 2 + kvh) * SEQ * 64;
    const bf16_t* Kcmp = (const bf16_t*)(F.ws + WS_KCMP) + (size_t)(b * 2 + kvh) * 512 * 64;
    const bf16_t* Vcmp = (const bf16_t*)(F.ws + WS_VCMP) + (size_t)(b * 2 + kvh) * 512 * 64;
    const bf16_t* Ks = kvbase + 2 * KV6_STRIDE + slab; const bf16_t* Vs = kvbase + 3 * KV6_STRIDE + slab;
    const bf16_t* Kw = kvbase + 4 * KV6_STRIDE + slab; const bf16_t* Vw = kvbase + 5 * KV6_STRIDE + slab;
    bf16x8 qf[3][2];
#pragma unroll
    for (int g = 0; g < 3; ++g) { const bf16_t* qp = (const bf16_t*)(F.ws + WS_NQ) + (((b * 6 + 3 * kvh + g) * SEQ + tq_abs) * 64 + 8 * kg);
        qf[g][0] = *(const bf16x8*)qp; qf[g][1] = *(const bf16x8*)(qp + 32); }
#define NSA_GATEP ((const float*)(F.ws + WS_GATE) + ((b * SEQ + tq_abs) * 32 + 9 * kvh))
    for (int i = lane; i < 2048; i += 64) imp[i] = 0.f;
    const int imax_blk = (t0 + 127 - 31) >> 4;
    const int ntc = (imax_blk >> 6) + 1;
    const int imax_w = (tw0 + 15 >= 31) ? ((tw0 + 15 - 31) >> 4) : -1;
    const int ivis = (tq_abs >= 31) ? ((tq_abs - 31) >> 4) : -1;
    float m[3] = {-INFINITY, -INFINITY, -INFINITY}; float cm[3] = {0.f, 0.f, 0.f};
    f32x4 lacc[3] = {(f32x4){0.f, 0.f, 0.f, 0.f}, (f32x4){0.f, 0.f, 0.f, 0.f}, (f32x4){0.f, 0.f, 0.f, 0.f}};
    f32x4 st[3][4];
    f32x4 ob[3][4];
    const bool keep3[3] = {true, true, true};
#pragma unroll
    for (int g = 0; g < 3; ++g)
#pragma unroll
        for (int dt = 0; dt < 4; ++dt) ob[g][dt] = (f32x4){0.f, 0.f, 0.f, 0.f};
    {
        u32x4 kr = tile_load(Kcmp, tid);
        tile_store(Kb, tid, kr); __syncthreads();
        for (int ct = 0; ct < ntc; ++ct) {
            if (ct + 1 < ntc) kr = tile_load(Kcmp + (ct + 1) * 4096, tid);
            const LAS bf16_t* Kt = Kb + (ct & 1) * (TILE_B / 2);
            if (64 * ct <= imax_w) {
                qk_tile<3>(Kt, qf, st, cm, lane, keep3);
#pragma unroll
                for (int g = 0; g < 3; ++g) {
#pragma unroll
                    for (int kt = 0; kt < 4; ++kt)
#pragma unroll
                        for (int r = 0; r < 4; ++r) { const int i = 64 * ct + 16 * kt + 4 * kg + r; st[g][kt][r] = (i <= ivis) ? st[g][kt][r] : -INFINITY; }
                }
                softmax_tiles<3>(st, ob, lacc, m, cm, lane);
                pv_tile<3, false>(Kt, st, ob, lacc, lane);
            }
            if (ct + 1 < ntc) tile_store(Kb + ((ct + 1) & 1) * (TILE_B / 2), tid, kr);
            __syncthreads();
        }
    }
    float invl[3]; float msafe[3];
#pragma unroll
    for (int g = 0; g < 3; ++g) { msafe[g] = (m[g] == -INFINITY) ? 0.f : m[g]; invl[g] = 1.f / fmaxf(lacc[g].x, 1e-30f); }
    {
        u32x4 kr = tile_load(Kcmp, tid), vr = tile_load(Vcmp, tid);
        tile_store(Kb, tid, kr); tile_store(Vb, tid, vr); __syncthreads();
        for (int ct = 0; ct < ntc; ++ct) {
            if (ct + 1 < ntc) { kr = tile_load(Kcmp + (ct + 1) * 4096, tid); vr = tile_load(Vcmp + (ct + 1) * 4096, tid); }
            const LAS bf16_t* Kt = Kb + (ct & 1) * (TILE_B / 2); const LAS bf16_t* Vt = Vb + (ct & 1) * (TILE_B / 2);
            if (64 * ct <= imax_w) {
                qk_tile<3>(Kt, qf, st, cm, lane, keep3);
#pragma unroll
                for (int g = 0; g < 3; ++g)
#pragma unroll
                    for (int kt = 0; kt < 4; ++kt)
#pragma unroll
                        for (int r = 0; r < 4; ++r) { const int i = 64 * ct + 16 * kt + 4 * kg + r;
                            st[g][kt][r] = (i <= ivis) ? __builtin_amdgcn_exp2f(st[g][kt][r]) * invl[g] : 0.f; }
#pragma unroll
                for (int kt = 0; kt < 4; ++kt) {
                    float a = 0.f, c = 0.f;
#pragma unroll
                    for (int g = 0; g < 3; ++g) { a += (st[g][kt].x + st[g][kt].y) + st[g][kt].z; c += st[g][kt].w; }
                    c *= 0.5f; a += c;
                    const float recv = __uint_as_float(__builtin_amdgcn_ds_bpermute(((lane + 48) & 63) << 2, __float_as_uint(c)));
                    const int ktp = 4 * ct + kt;
                    imp[ktp * 64 + lane] += a + (kg != 0 ? recv : 0.f);
                    if (kg == 0 && ktp + 1 < 32) imp[(ktp + 1) * 64 + lane] += recv;
                }
                pv_tile<3, true>(Vt, st, ob, lacc, lane);
            }
            if (ct + 1 < ntc) { tile_store(Kb + ((ct + 1) & 1) * (TILE_B / 2), tid, kr); tile_store(Vb + ((ct + 1) & 1) * (TILE_B / 2), tid, vr); }
            __syncthreads();
        }
    }
#pragma unroll
    for (int g = 0; g < 3; ++g) { const float sc = sigm(NSA_GATEP[3 * g + 0]);
#pragma unroll
        for (int dt = 0; dt < 4; ++dt) ob[g][dt] = ob[g][dt] * sc; }
    unsigned msk[4] = {0u, 0u, 0u, 0u};
    if (cur <= 15) {
        msk[0] = (cur == 31) ? 0xffffffffu : ((1u << (cur + 1)) - 1u);
    } else {
        float iv[32];
#pragma unroll
        for (int k = 0; k < 32; ++k) { const int s = 4 * k + kg; const float v = imp[k * 64 + lane]; iv[k] = (s >= 1 && s <= cur - 2) ? v : -1.f; }
        msk[0] = 1u; msk[cur >> 5] |= 1u << (cur & 31); msk[(cur - 1) >> 5] |= 1u << ((cur - 1) & 31);
        for (int it = 0; it < 13; ++it) {
            float bv = -2.f; int bs = 1 << 20;
#pragma unroll
            for (int k = 0; k < 32; ++k) { if (iv[k] > bv) { bv = iv[k]; bs = 4 * k + kg; } }
#pragma unroll
            for (int sh = 16; sh <= 32; sh <<= 1) { const float ov = shx(bv, sh, lane); const int os = shxi(bs, sh, lane); if (ov > bv || (ov == bv && os < bs)) { bv = ov; bs = os; } }
#pragma unroll
            for (int k = 0; k < 32; ++k) if (4 * k + kg == bs) iv[k] = -1.f;
#pragma unroll
            for (int wd = 0; wd < 4; ++wd) if ((bs >> 5) == wd) msk[wd] |= 1u << (bs & 31);
        }
    }
    LAS u32x2* otp = (LAS u32x2*)imp;
#pragma unroll
    for (int g = 0; g < 3; ++g)
#pragma unroll
        for (int dt = 0; dt < 4; ++dt) { u32x2 o; o.x = pk2(ob[g][dt].x, ob[g][dt].y); o.y = pk2(ob[g][dt].z, ob[g][dt].w); otp[(g * 4 + dt) * 64 + lane] = o; }
    {
#pragma unroll
        for (int g = 0; g < 3; ++g) { m[g] = -INFINITY; cm[g] = 0.f; lacc[g] = (f32x4){0.f, 0.f, 0.f, 0.f};
#pragma unroll
            for (int dt = 0; dt < 4; ++dt) ob[g][dt] = (f32x4){0.f, 0.f, 0.f, 0.f}; }
        const int nb = 2 * J + 2;
        u32x4 kr[2], vr[2]; unsigned mw = 0u;
        kr[0] = tile_load(Ks, tid); vr[0] = tile_load(Vs, tid);
        kr[1] = tile_load(Ks + ((nb > 1) ? 4096 : 0), tid); vr[1] = tile_load(Vs + ((nb > 1) ? 4096 : 0), tid);
        tile_store(Kb, tid, kr[0]); tile_store(Vb, tid, vr[0]); __syncthreads();
        for (int s0 = 0; s0 < nb; s0 += 2) {
#pragma unroll
            for (int u = 0; u < 2; ++u) {
                const int s = s0 + u;
                if (s < nb) {
                    if (s + 2 < nb) { kr[u] = tile_load(Ks + (s + 2) * 4096, tid); vr[u] = tile_load(Vs + (s + 2) * 4096, tid); }
                    const LAS bf16_t* Kt = Kb + (s & 1) * (TILE_B / 2); const LAS bf16_t* Vt = Vb + (s & 1) * (TILE_B / 2);
                    if ((s & 31) == 0) mw = (s == 0) ? msk[0] : (s == 32) ? msk[1] : (s == 64) ? msk[2] : msk[3];
                    const bool sel = ((mw >> (s & 31)) & 1u) != 0u;
                    if (__any(sel)) {
                        const bool selk[3] = {sel, sel, sel};
                        qk_tile<3>(Kt, qf, st, cm, lane, selk);
                        if (s == cur) {
#pragma unroll
                            for (int g = 0; g < 3; ++g)
#pragma unroll
                                for (int kt = 0; kt < 4; ++kt)
#pragma unroll
                                    for (int r = 0; r < 4; ++r) { const int kk = 16 * kt + 4 * kg + r; st[g][kt][r] = (kk <= tq) ? st[g][kt][r] : -INFINITY; }
                        }
                        softmax_tiles<3>(st, ob, lacc, m, cm, lane);
                        pv_tile<3, true>(Vt, st, ob, lacc, lane);
                    }
                    if (s + 1 < nb) { tile_store(Kb + ((s + 1) & 1) * (TILE_B / 2), tid, kr[u ^ 1]); tile_store(Vb + ((s + 1) & 1) * (TILE_B / 2), tid, vr[u ^ 1]); }
                }
                __syncthreads();
            }
        }
#pragma unroll
        for (int g = 0; g < 3; ++g) { const float sc = sigm(NSA_GATEP[3 * g + 1]) / fmaxf(lacc[g].x, 1e-30f);
#pragma unroll
            for (int dt = 0; dt < 4; ++dt) { u32x2 o = otp[(g * 4 + dt) * 64 + lane]; acc_pk(o, ob[g][dt] * sc); otp[(g * 4 + dt) * 64 + lane] = o; } }
    }
    {
#pragma unroll
        for (int g = 0; g < 3; ++g) { m[g] = -INFINITY; cm[g] = 0.f; lacc[g] = (f32x4){0.f, 0.f, 0.f, 0.f};
#pragma unroll
            for (int dt = 0; dt < 4; ++dt) ob[g][dt] = (f32x4){0.f, 0.f, 0.f, 0.f}; }
        const int s_lo = (2 * J - 8 > 0) ? 2 * J - 8 : 0, s_hi = 2 * J + 1, nb = s_hi - s_lo + 1;
        u32x4 kr[2], vr[2];
        kr[0] = tile_load(Kw + s_lo * 4096, tid); vr[0] = tile_load(Vw + s_lo * 4096, tid);
        kr[1] = tile_load(Kw + (s_lo + ((nb > 1) ? 1 : 0)) * 4096, tid); vr[1] = tile_load(Vw + (s_lo + ((nb > 1) ? 1 : 0)) * 4096, tid);
        tile_store(Kb, tid, kr[0]); tile_store(Vb, tid, vr[0]); __syncthreads();
        for (int it0 = 0; it0 < nb; it0 += 2) {
#pragma unroll
            for (int u = 0; u < 2; ++u) {
                const int it = it0 + u;
                if (it < nb) {
                    const int s = s_lo + it;
                    if (it + 2 < nb) { kr[u] = tile_load(Kw + (s + 2) * 4096, tid); vr[u] = tile_load(Vw + (s + 2) * 4096, tid); }
                    const LAS bf16_t* Kt = Kb + (it & 1) * (TILE_B / 2); const LAS bf16_t* Vt = Vb + (it & 1) * (TILE_B / 2);
                    if (s <= cur && s >= cur - 8) {
                        qk_tile<3>(Kt, qf, st, cm, lane, keep3);
                        if (s == cur || s == cur - 8) {
#pragma unroll
                            for (int g = 0; g < 3; ++g)
#pragma unroll
                                for (int kt = 0; kt < 4; ++kt)
#pragma unroll
                                    for (int r = 0; r < 4; ++r) { const int kk = 16 * kt + 4 * kg + r; const bool ok = (s == cur) ? (kk <= tq) : (kk > tq); st[g][kt][r] = ok ? st[g][kt][r] : -INFINITY; }
                        }
                        softmax_tiles<3>(st, ob, lacc, m, cm, lane);
                        pv_tile<3, true>(Vt, st, ob, lacc, lane);
                    }
                    if (it + 1 < nb) { tile_store(Kb + ((it + 1) & 1) * (TILE_B / 2), tid, kr[u ^ 1]); tile_store(Vb + ((it + 1) & 1) * (TILE_B / 2), tid, vr[u ^ 1]); }
                }
                __syncthreads();
            }
        }
        bf16_t* mixp = (bf16_t*)(F.ws + WS_HM) + ((b * SEQ + tq_abs) * D + 3 * kvh * 64 + 4 * kg);
#pragma unroll
        for (int g = 0; g < 3; ++g) { const float sc = sigm(NSA_GATEP[3 * g + 2]) / fmaxf(lacc[g].x, 1e-30f);
#pragma unroll
            for (int dt = 0; dt < 4; ++dt) { u32x2 o = otp[(g * 4 + dt) * 64 + lane]; acc_pk(o, ob[g][dt] * sc); *(u32x2*)(mixp + g * 64 + 16 * dt) = o; } }
    }
}

__device__ __forceinline__ void moba_task(Frame& F, int b, int h, int own) {
    const int lane = F.lane, tid = F.tid, wv = F.wave, q = lane & 15, kg = lane >> 4;
    LAS bf16_t* Kb = (LAS bf16_t*)(F.lds + AT_K0); LAS bf16_t* Vb = (LAS bf16_t*)(F.lds + AT_V0); LAS bf16_t* Km = (LAS bf16_t*)(F.lds + AT_KMEAN);
    const size_t slab = (size_t)(b * 4 + h) * SEQ * 64;
    const bf16_t* Qg = (const bf16_t*)(F.ws + WS_MQKV) + slab; const bf16_t* Kg = Qg + MQKV_STRIDE; const bf16_t* Vg = Kg + MQKV_STRIDE;
    const int tw0 = 256 * own + 32 * wv;
    bf16x8 qf[2][2];
#pragma unroll
    for (int rt = 0; rt < 2; ++rt) { const bf16_t* qp = Qg + ((tw0 + 16 * rt + q) * 64 + 8 * kg); qf[rt][0] = *(const bf16x8*)qp; qf[rt][1] = *(const bf16x8*)(qp + 32); }
    if (tid < 256) { const u32x4 v = *(const u32x4*)((const bf16_t*)(F.ws + WS_KMEAN) + (size_t)(b * 4 + h) * 2048 + (tid >> 3) * 64 + (tid & 7) * 8); *(LAS u32x4*)(Km + (tid >> 3) * KP + (tid & 7) * 8) = v; }
    __syncthreads();
    unsigned msk[2] = {0u, 0u};
    {
        f32x4 gs[2][2];
#pragma unroll
        for (int kt = 0; kt < 2; ++kt) { const bf16x8 k0 = lds_frag(Km, 16 * kt + q, 8 * kg), k1 = lds_frag(Km, 16 * kt + q, 32 + 8 * kg);
#pragma unroll
            for (int rt = 0; rt < 2; ++rt) { f32x4 z = (f32x4){0.f, 0.f, 0.f, 0.f}; z = MFMA16(k0, qf[rt][0], z); gs[rt][kt] = MFMA16(k1, qf[rt][1], z); } }
#pragma unroll
        for (int rt = 0; rt < 2; ++rt) {
            float gv[8];
#pragma unroll
            for (int kt = 0; kt < 2; ++kt)
#pragma unroll
                for (int r = 0; r < 4; ++r) { const int blk = 16 * kt + 4 * kg + r; gv[4 * kt + r] = (blk < own) ? gs[rt][kt][r] : -INFINITY; }
            for (int it = 0; it < 3; ++it) {
                float bv = -INFINITY; int bs = 1 << 20;
#pragma unroll
                for (int k = 0; k < 8; ++k) { const int blk = 16 * (k >> 2) + 4 * kg + (k & 3); if (gv[k] > bv) { bv = gv[k]; bs = blk; } }
#pragma unroll
                for (int sh = 16; sh <= 32; sh <<= 1) { const float ov = shx(bv, sh, lane); const int os = shxi(bs, sh, lane); if (ov > bv || (ov == bv && os < bs)) { bv = ov; bs = os; } }
                if (bs < 32) { msk[rt] |= 1u << bs;
#pragma unroll
                    for (int k = 0; k < 8; ++k) if (16 * (k >> 2) + 4 * kg + (k & 3) == bs) gv[k] = -INFINITY; }
            }
        }
    }
    float m[2] = {-INFINITY, -INFINITY}; float cm[2] = {0.f, 0.f}; f32x4 lacc[2] = {(f32x4){0.f, 0.f, 0.f, 0.f}, (f32x4){0.f, 0.f, 0.f, 0.f}};
    f32x4 ob[2][4], st[2][4];
#pragma unroll
    for (int rt = 0; rt < 2; ++rt)
#pragma unroll
        for (int dt = 0; dt < 4; ++dt) ob[rt][dt] = (f32x4){0.f, 0.f, 0.f, 0.f};
    const int ntile = 4 * own + 4;
    u32x4 kr[2], vr[2];
    kr[0] = tile_load(Kg, tid); vr[0] = tile_load(Vg, tid); kr[1] = tile_load(Kg + 4096, tid); vr[1] = tile_load(Vg + 4096, tid);
    tile_store(Kb, tid, kr[0]); tile_store(Vb, tid, vr[0]); __syncthreads();
    for (int tau0 = 0; tau0 < ntile; tau0 += 2) {
#pragma unroll
        for (int u = 0; u < 2; ++u) {
            const int tau = tau0 + u;
            if (tau + 2 < ntile) { kr[u] = tile_load(Kg + (tau + 2) * 4096, tid); vr[u] = tile_load(Vg + (tau + 2) * 4096, tid); }
            const LAS bf16_t* Kt = Kb + (tau & 1) * (TILE_B / 2); const LAS bf16_t* Vt = Vb + (tau & 1) * (TILE_B / 2);
            const int blk = tau >> 2;
            bool sel[2]; bool anyv = false;
#pragma unroll
            for (int rt = 0; rt < 2; ++rt) { sel[rt] = (blk < own) ? ((msk[rt] >> blk) & 1u) : (64 * (tau & 3) <= 32 * wv + 16 * rt + q); anyv = anyv || sel[rt]; }
            if (__any(anyv)) {
                const bool selk[2] = {(blk < own) ? sel[0] : true, (blk < own) ? sel[1] : true};
                qk_tile<2>(Kt, qf, st, cm, lane, selk);
                if (blk >= own) {
#pragma unroll
                    for (int rt = 0; rt < 2; ++rt) {
                        const int trel = 32 * wv + 16 * rt + q;
#pragma unroll
                        for (int kt = 0; kt < 4; ++kt)
#pragma unroll
                            for (int r = 0; r < 4; ++r) { const int kk = 64 * (tau & 3) + 16 * kt + 4 * kg + r; st[rt][kt][r] = (kk <= trel) ? st[rt][kt][r] : -INFINITY; }
                    }
                }
                softmax_tiles<2>(st, ob, lacc, m, cm, lane);
                pv_tile<2, true>(Vt, st, ob, lacc, lane);
            }
            if (tau + 1 < ntile) { tile_store(Kb + ((tau + 1) & 1) * (TILE_B / 2), tid, kr[u ^ 1]); tile_store(Vb + ((tau + 1) & 1) * (TILE_B / 2), tid, vr[u ^ 1]); }
            __syncthreads();
        }
    }
#pragma unroll
    for (int rt = 0; rt < 2; ++rt) {
        const float sc = 1.f / fmaxf(lacc[rt].x, 1e-30f);
        bf16_t* mix = (bf16_t*)(F.ws + WS_HM) + ((b * SEQ + tw0 + 16 * rt + q) * D + 384 + h * 64 + 4 * kg);
#pragma unroll
        for (int dt = 0; dt < 4; ++dt) { const f32x4 v = ob[rt][dt] * sc; u32x2 o; o.x = pk2(v.x, v.y); o.y = pk2(v.z, v.w); *(u32x2*)(mix + 16 * dt) = o; }
    }
}

constexpr int R2_RING = 16384, R2_SLOT = 12288;
__device__ __forceinline__ void r2_issue(const bf16_t* pt, const bf16_t* zp, LAS unsigned char* slot) {
#pragma unroll
    for (int mt = 0; mt < 2; ++mt)
#pragma unroll
        for (int ks = 0; ks < 4; ++ks) __builtin_amdgcn_global_load_lds((const unsigned*)(pt + mt * 2048 + ks * 16), (LAS unsigned*)(slot + (mt * 4 + ks) * 1024), 16, 0, 0);
#pragma unroll
    for (int mt = 0; mt < 2; ++mt)
#pragma unroll
        for (int q = 0; q < 2; ++q) __builtin_amdgcn_global_load_lds((const unsigned*)(zp + mt * 2048 + q * 8), (LAS unsigned*)(slot + 8192 + (mt * 2 + q) * 1024), 16, 0, 0);
}
__device__ __forceinline__ void r2_wave(Frame& F, int widx) {
    const int chain = widx >> 1, hf = widx & 1, lane = F.lane, c31 = lane & 31, hi = lane >> 5;
    LAS bf16_t* sb = (LAS bf16_t*)(F.lds + R2_SBUF + F.wave * (32 * KP * 2));
    LAS unsigned char* ring = F.lds + R2_RING + F.wave * (4 * R2_SLOT);
    for (int i = lane; i < 32 * KP / 2; i += 64) ((LAS unsigned*)sb)[i] = 0u;
    const bf16_t* PTl = (const bf16_t*)(F.ws + WS_PT) + (size_t)chain * 128 * 4096 + c31 * 64 + 8 * hi;
    const bf16_t* ZPl = (const bf16_t*)(F.ws + WS_ZS) + (size_t)chain * 128 * 4096 + (hf * 64 + lane) * 16;
    bf16_t* SS = (bf16_t*)(F.ws + WS_SS) + (size_t)chain * 128 * 4096 + (32 * hf) * 64;
    r2_issue(PTl, ZPl, ring); r2_issue(PTl + 4096, ZPl + 4096, ring + R2_SLOT); r2_issue(PTl + 2 * 4096, ZPl + 2 * 4096, ring + 2 * R2_SLOT);
#pragma unroll 1
    for (int c = 0; c < 128; ++c) {
        const int cn = (c + 3 < 128) ? c + 3 : 127;
        r2_issue(PTl + cn * 4096, ZPl + cn * 4096, ring + ((c + 3) & 3) * R2_SLOT);
        asm volatile("s_waitcnt vmcnt(36)" ::: "memory");
        const LAS unsigned char* sl = ring + (c & 3) * R2_SLOT + lane * 16;
        f32x16 acc[2];
#pragma unroll
        for (int mt = 0; mt < 2; ++mt)
#pragma unroll
            for (int q = 0; q < 2; ++q) { const u32x4 z = *(const LAS u32x4*)(sl + 8192 + (mt * 2 + q) * 1024);
                acc[mt][8 * q + 0] = __uint_as_float(z.x << 16); acc[mt][8 * q + 1] = __uint_as_float(z.x & 0xffff0000u); acc[mt][8 * q + 2] = __uint_as_float(z.y << 16); acc[mt][8 * q + 3] = __uint_as_float(z.y & 0xffff0000u);
                acc[mt][8 * q + 4] = __uint_as_float(z.z << 16); acc[mt][8 * q + 5] = __uint_as_float(z.z & 0xffff0000u); acc[mt][8 * q + 6] = __uint_as_float(z.w << 16); acc[mt][8 * q + 7] = __uint_as_float(z.w & 0xffff0000u); }
#pragma unroll
        for (int ks = 0; ks < 4; ++ks) {
            const bf16x8 bx = *(const LAS bf16x8*)(sb + c31 * KP + 16 * ks + 8 * hi);
#pragma unroll
            for (int mt = 0; mt < 2; ++mt) { const bf16x8 pa = *(const LAS bf16x8*)(sl + (mt * 4 + ks) * 1024); acc[mt] = MFMA32(pa, bx, acc[mt]); }
        }
#pragma unroll
        for (int mt = 0; mt < 2; ++mt)
#pragma unroll
            for (int r = 0; r < 16; ++r) sb[c31 * KP + 32 * mt + (r & 3) + 8 * (r >> 2) + 4 * hi] = f2bf(acc[mt][r]);
        bf16_t* ss = SS + c * 4096;
#pragma unroll
        for (int j = 0; j < 4; ++j) { const int qd = lane + 64 * j, row = qd >> 3, ch = qd & 7; *(u32x4*)(ss + row * 64 + ch * 8) = *(const LAS u32x4*)(sb + row * KP + ch * 8); }
    }
    asm volatile("s_waitcnt vmcnt(0)" ::: "memory");
}

struct TaskTable { unsigned short v[512]; };
constexpr TaskTable make_tasks() {
    TaskTable t{}; int n = 0, a = 63, am = 0, c = 31, cm = 0;
    while (a >= 0 || c >= 0) {
        const int ca = (a >= 0) ? 96 * a + 1344 : -1, cc = (c >= 0) ? 128 * c + 128 : -1;
        if (ca >= cc) { t.v[n++] = (unsigned short)(0 * 512 + am * 64 + a); if (++am == 4) { am = 0; --a; } }
        else { t.v[n++] = (unsigned short)(1 * 512 + cm * 64 + c); if (++cm == 8) { cm = 0; --c; } }
    }
    return t;
}
__device__ const TaskTable g_tasks = make_tasks();

__device__ __forceinline__ void r3_task(Frame& F, int layer, int task) {
    const int chain = task >> 7, c = task & 127, b = chain / 6, h = chain % 6, lane = F.lane, c31 = lane & 31, hi = lane >> 5;
    const bf16_t* S0 = (const bf16_t*)(F.ws + WS_SS) + (size_t)(task - 1) * 4096;
    const bf16_t* YT = (const bf16_t*)(F.ws + WS_YT) + (size_t)task * 4096;
    const bf16_t* Y0 = (const bf16_t*)(F.ws + WS_Y0) + (size_t)task * 4096;
    const bf16_t* rf = (const bf16_t*)(F.ws + WS_RFEAT);
    const bf16_t* gut = (const bf16_t*)(F.ws + WS_GUPT) + (size_t)(h * 64) * 128;
    const float* mu = INF(F, I_MU) + layer * RW;
    f32x16 acc[2][2], gacc[2][2];
#pragma unroll
    for (int a = 0; a < 2; ++a)
#pragma unroll
        for (int n = 0; n < 2; ++n)
#pragma unroll
            for (int r = 0; r < 16; ++r) { acc[a][n][r] = 0.f; gacc[a][n][r] = 0.f; }
    if (c > 0) {
#pragma unroll
        for (int ks = 0; ks < 4; ++ks) {
            bf16x8 af[2], bfr[2];
#pragma unroll
            for (int mt = 0; mt < 2; ++mt) af[mt] = *(const bf16x8*)(S0 + (32 * mt + c31) * 64 + 16 * ks + 8 * hi);
#pragma unroll
            for (int nt = 0; nt < 2; ++nt) bfr[nt] = *(const bf16x8*)(YT + (32 * nt + c31) * 64 + 16 * ks + 8 * hi);
#pragma unroll
            for (int mt = 0; mt < 2; ++mt)
#pragma unroll
                for (int nt = 0; nt < 2; ++nt) acc[mt][nt] = MFMA32(af[mt], bfr[nt], acc[mt][nt]);
        }
    }
#pragma unroll
    for (int ks = 0; ks < 8; ++ks) {
        bf16x8 af[2], bfr[2];
#pragma unroll
        for (int mt = 0; mt < 2; ++mt) af[mt] = *(const bf16x8*)(gut + (32 * mt + c31) * 128 + 16 * ks + 8 * hi);
#pragma unroll
        for (int nt = 0; nt < 2; ++nt) {
            const int t = 64 * c + 32 * nt + c31, j0 = 16 * ks + 8 * hi; const size_t row = (size_t)b * SEQ + t;
            const u32x4 cu = *(const u32x4*)(rf + row * RW + 1280 + j0);
            u32x4 pv = (u32x4){0u, 0u, 0u, 0u}; if (t > 0) pv = *(const u32x4*)(rf + (row - 1) * RW + 1280 + j0);
            const f32x4 m0 = *(const f32x4*)(mu + 1280 + j0), m1 = *(const f32x4*)(mu + 1280 + j0 + 4);
            float cv[8], pw[8];
            cv[0] = __uint_as_float(cu.x << 16); cv[1] = __uint_as_float(cu.x & 0xffff0000u); cv[2] = __uint_as_float(cu.y << 16); cv[3] = __uint_as_float(cu.y & 0xffff0000u);
            cv[4] = __uint_as_float(cu.z << 16); cv[5] = __uint_as_float(cu.z & 0xffff0000u); cv[6] = __uint_as_float(cu.w << 16); cv[7] = __uint_as_float(cu.w & 0xffff0000u);
            pw[0] = __uint_as_float(pv.x << 16); pw[1] = __uint_as_float(pv.x & 0xffff0000u); pw[2] = __uint_as_float(pv.y << 16); pw[3] = __uint_as_float(pv.y & 0xffff0000u);
            pw[4] = __uint_as_float(pv.z << 16); pw[5] = __uint_as_float(pv.z & 0xffff0000u); pw[6] = __uint_as_float(pv.w << 16); pw[7] = __uint_as_float(pv.w & 0xffff0000u);
            const float mm[8] = {m0.x, m0.y, m0.z, m0.w, m1.x, m1.y, m1.z, m1.w};
            float sg[8];
#pragma unroll
            for (int k = 0; k < 8; ++k) sg[k] = sigm(cv[k] + (pw[k] - cv[k]) * mm[k]);
            u32x4 u; u.x = pk2(sg[0], sg[1]); u.y = pk2(sg[2], sg[3]); u.z = pk2(sg[4], sg[5]); u.w = pk2(sg[6], sg[7]);
            bfr[nt] = __builtin_bit_cast(bf16x8, u);
        }
#pragma unroll
        for (int mt = 0; mt < 2; ++mt)
#pragma unroll
            for (int nt = 0; nt < 2; ++nt) gacc[mt][nt] = MFMA32(af[mt], bfr[nt], gacc[mt][nt]);
    }
    const float* lnw = INF(F, I_LNW) + layer * 384 + h * 64; const float* lnb = INF(F, I_LNB) + layer * 384 + h * 64;
    const float* bonus = (const float*)(F.ws + WS_BONUS);
    bf16_t* mix = (bf16_t*)(F.ws + WS_HM);
#pragma unroll
    for (int nt = 0; nt < 2; ++nt) {
        const int tl = 32 * nt + c31, t = 64 * c + tl; const size_t row = (size_t)b * SEQ + t;
        float s = 0.f;
#pragma unroll
        for (int mt = 0; mt < 2; ++mt)
#pragma unroll
            for (int rq = 0; rq < 4; ++rq) {
                const u32x2 y = *(const u32x2*)(Y0 + tl * 64 + 32 * mt + 8 * rq + 4 * hi);
                acc[mt][nt][4 * rq + 0] += __uint_as_float(y.x << 16); acc[mt][nt][4 * rq + 1] += __uint_as_float(y.x & 0xffff0000u);
                acc[mt][nt][4 * rq + 2] += __uint_as_float(y.y << 16); acc[mt][nt][4 * rq + 3] += __uint_as_float(y.y & 0xffff0000u);
                s += (acc[mt][nt][4 * rq] + acc[mt][nt][4 * rq + 1]) + (acc[mt][nt][4 * rq + 2] + acc[mt][nt][4 * rq + 3]);
            }
        s += shx(s, 32, lane);
        const float mean = s * (1.f / 64.f);
        float vs = 0.f;
#pragma unroll
        for (int mt = 0; mt < 2; ++mt)
#pragma unroll
            for (int r = 0; r < 16; ++r) { const float d = acc[mt][nt][r] - mean; vs += d * d; }
        vs += shx(vs, 32, lane);
        const float rstd = rsqrtf(vs * (1.f / 64.f) + 64e-5f);
        const float bn = bonus[row * 8 + h];
#pragma unroll
        for (int mt = 0; mt < 2; ++mt)
#pragma unroll
            for (int rq = 0; rq < 4; ++rq) {
                const int v0 = 32 * mt + 8 * rq + 4 * hi;
                const u32x2 vc = *(const u32x2*)(rf + row * RW + 768 + h * 64 + v0);
                u32x2 vp = (u32x2){0u, 0u}; if (t > 0) vp = *(const u32x2*)(rf + (row - 1) * RW + 768 + h * 64 + v0);
                const f32x4 mv = *(const f32x4*)(mu + 768 + h * 64 + v0), lw = *(const f32x4*)(lnw + v0), lb = *(const f32x4*)(lnb + v0);
                const float vcur[4] = {__uint_as_float(vc.x << 16), __uint_as_float(vc.x & 0xffff0000u), __uint_as_float(vc.y << 16), __uint_as_float(vc.y & 0xffff0000u)};
                const float vprv[4] = {__uint_as_float(vp.x << 16), __uint_as_float(vp.x & 0xffff0000u), __uint_as_float(vp.y << 16), __uint_as_float(vp.y & 0xffff0000u)};
                const float mvv[4] = {mv.x, mv.y, mv.z, mv.w}, lwv[4] = {lw.x, lw.y, lw.z, lw.w}, lbv[4] = {lb.x, lb.y, lb.z, lb.w};
                float o[4];
#pragma unroll
                for (int k = 0; k < 4; ++k) {
                    const float vsh = vcur[k] + (vprv[k] - vcur[k]) * mvv[k];
                    const float y = (acc[mt][nt][4 * rq + k] - mean) * rstd * lwv[k] + lbv[k];
                    o[k] = (y + bn * vsh) * gacc[mt][nt][4 * rq + k];
                }
                u32x2 ov; ov.x = pk2(o[0], o[1]); ov.y = pk2(o[2], o[3]);
                *(u32x2*)(mix + row * D + 640 + h * 64 + v0) = ov;
            }
    }
}
__device__ __forceinline__ void mixnorm_rows(Frame& F, int layer, int m0, int nrows) {
    bf16_t* mix = (bf16_t*)(F.ws + WS_HM);
    const float* gn = INF(F, I_NNSA) + layer * 384; const float* gm = INF(F, I_NMOBA) + layer * 256;
    const int lane = F.lane;
    for (int m = m0 + F.wave; m < m0 + nrows; m += NWAVES) {
        unsigned* rowp = (unsigned*)(mix + (size_t)m * D);
        unsigned a[3], c[2]; float sa = 0.f, sc = 0.f;
#pragma unroll
        for (int j = 0; j < 3; ++j) { a[j] = rowp[lane + 64 * j]; const float x = __uint_as_float(a[j] << 16), y = __uint_as_float(a[j] & 0xffff0000u); sa += x * x + y * y; }
#pragma unroll
        for (int j = 0; j < 2; ++j) { c[j] = rowp[192 + lane + 64 * j]; const float x = __uint_as_float(c[j] << 16), y = __uint_as_float(c[j] & 0xffff0000u); sc += x * x + y * y; }
        const float ra = rsqrtf(wave_sum(sa, lane) * (1.f / 384.f) + NORM_EPS), rc = rsqrtf(wave_sum(sc, lane) * (1.f / 256.f) + NORM_EPS);
#pragma unroll
        for (int j = 0; j < 3; ++j) { const int col = 2 * (lane + 64 * j); rowp[lane + 64 * j] = pk2(__uint_as_float(a[j] << 16) * ra * gn[col], __uint_as_float(a[j] & 0xffff0000u) * ra * gn[col + 1]); }
#pragma unroll
        for (int j = 0; j < 2; ++j) { const int col = 2 * (lane + 64 * j); rowp[192 + lane + 64 * j] = pk2(__uint_as_float(c[j] << 16) * rc * gm[col], __uint_as_float(c[j] & 0xffff0000u) * rc * gm[col + 1]); }
    }
}
__device__ __forceinline__ void phase_e(Frame& F, int layer) {
    const int gw = F.bid * NWAVES + F.wave, NGW = F.G * NWAVES;
    (void)gw; (void)NGW; (void)layer;
}

constexpr int CW_TILE = 1536;
constexpr int CW_R2DONE = 512;
__device__ __forceinline__ void phase_d(Frame& F, int layer, int rep = 0) {
    if (F.bid < 12 && rep == 0) {
        await_count(F, F.ctl + CW_R1DONE + 64 * layer + F.bid, 16u);
        if (F.wave < 2) { r2_wave(F, F.bid * 2 + F.wave);
            __builtin_amdgcn_fence(__ATOMIC_RELEASE, "agent"); asm volatile("s_waitcnt vmcnt(0)" ::: "memory");
            if (F.lane == 0) (void)__hip_atomic_fetch_add(F.ctl + CW_R2DONE + 64 * layer, 1u, RLX_AGENT); }
        __syncthreads();
#if DBG_MODE == 4
        if (F.bid == 0 && layer == 0) __hip_atomic_store(F.ctl + 3200 + 30, (unsigned)__builtin_amdgcn_s_memrealtime(), RLX_AGENT);
#endif
    }
    LAUNDER(F);
    await_count(F, F.ctl + CW_PREP + 64 * layer, 64u);
    LAUNDER(F);
    volatile LAS int* tw = (volatile LAS int*)(F.lds + AT_MISC);
    unsigned* qh = F.ctl + CW_Q + 64 * layer + 16 * rep;
    const int ntask = (rep == 0) ? 512 + 192 + 128 : 512;
    for (;;) {
        if (F.tid == 0) tw[0] = (int)__hip_atomic_fetch_add(qh, 1u, RLX_AGENT);
        __syncthreads();
        const int k = __builtin_amdgcn_readfirstlane(tw[0]);
        __syncthreads();
        if (k >= ntask) break;
        LAUNDER(F);
        if (k >= 512 + 192) {
            const int tile = k - (512 + 192);
            await_count(F, F.ctl + CW_TILE + 128 * layer + tile, 6u);
            mixnorm_rows(F, layer, tile * 128, 128);
            continue;
        }
        if (k >= 512) {
            if (F.tid == 0) { unsigned sp = 0; while ((unsigned)__builtin_amdgcn_readfirstlane(__hip_atomic_load(F.ctl + CW_R2DONE + 64 * layer, RLX_AGENT)) < 24u) { __builtin_amdgcn_s_sleep(4); if (++sp > (1u << 24)) break; }
                __builtin_amdgcn_fence(__ATOMIC_ACQUIRE, "agent"); asm volatile("s_waitcnt vmcnt(0)" ::: "memory"); }
            __syncthreads();
            r3_task(F, layer, (k - 512) * 8 + F.wave);
            continue;
        }
        const int code = g_tasks.v[k], ty = code >> 9, mm = (code >> 6) & 7, jj = code & 63;
        if (ty == 0) nsa_task(F, mm >> 1, mm & 1, jj); else moba_task(F, mm >> 2, mm & 3, jj);
        if (rep == 0) {
            asm volatile("s_waitcnt vmcnt(0)" ::: "memory"); __syncthreads();
            if (F.tid == 0) { __builtin_amdgcn_fence(__ATOMIC_RELEASE, "agent"); asm volatile("s_waitcnt vmcnt(0)" ::: "memory");
                unsigned* tc = F.ctl + CW_TILE + 128 * layer;
                if (ty == 0) (void)__hip_atomic_fetch_add(tc + (mm >> 1) * 64 + jj, 1u, RLX_AGENT);
                else { (void)__hip_atomic_fetch_add(tc + (mm >> 2) * 64 + 2 * jj, 1u, RLX_AGENT); (void)__hip_atomic_fetch_add(tc + (mm >> 2) * 64 + 2 * jj + 1, 1u, RLX_AGENT); } }
        }
    }
}

__device__ __forceinline__ void phase_g1(Frame& F, int layer) {
    LAS float* wr = (LAS float*)F.lds;
    { const float* W = INF(F, I_WROUTER);
#pragma unroll 1
      for (int i0 = 0; i0 < 4096; i0 += 2048) { f32x4 t4[4];
#pragma unroll
          for (int u = 0; u < 4; ++u) t4[u] = *(const f32x4*)(W + 4 * (i0 + u * NTHR + F.tid));
#pragma unroll
          for (int u = 0; u < 4; ++u) { const int i = 4 * (i0 + u * NTHR + F.tid), k = i >> 4, e = i & 15;
              wr[e * 1028 + k] = t4[u].x; wr[(e + 1) * 1028 + k] = t4[u].y; wr[(e + 2) * 1028 + k] = t4[u].z; wr[(e + 3) * 1028 + k] = t4[u].w; } } }
    __syncthreads();
    const float* mod = (const float*)(F.ws + WS_MOD);
    bf16_t* H = (bf16_t*)(F.ws + WS_HM);
    unsigned* cnt = F.ctl + CW_CNT + 64 * layer;
    const float* rb = INF(F, I_RBIAS);
    const float* gn = INF(F, I_NFFN) + layer * D;
    const int gw = F.bid * NWAVES + F.wave, NGW = F.G * NWAVES;
    f32x4 vnext[4];
#pragma unroll
    for (int j = 0; j < 4; ++j) vnext[j] = *(const f32x4*)(F.out + (size_t)gw * D + 4 * F.lane + 256 * j);
    int px = 0, pm = 0; float pw = 0.f; int ridx = 0;
    for (int m = gw; m < T; m += NGW, ++ridx) {
        int lane = F.lane; asm volatile("" : "+v"(lane));
        const int b = m >> 13;
        const float* sh = mod + ((size_t)layer * BATCH + b) * 6144 + 3072; const float* sc = sh + 1024;
        f32x4 v[4]; float ss = 0.f;
#pragma unroll
        for (int j = 0; j < 4; ++j) { v[j] = vnext[j]; ss += (v[j].x * v[j].x + v[j].y * v[j].y) + (v[j].z * v[j].z + v[j].w * v[j].w); }
        { const int mn = (m + NGW < T) ? m + NGW : m;
#pragma unroll
          for (int j = 0; j < 4; ++j) vnext[j] = *(const f32x4*)(F.out + (size_t)mn * D + 4 * lane + 256 * j); }
        const float rstd = rsqrtf(wave_sum(ss, lane) * (1.f / D) + NORM_EPS);
        float lg[16]; f32x2_t lgp[16];
#pragma unroll
        for (int e = 0; e < 16; ++e) lgp[e] = (f32x2_t){0.f, 0.f};
#pragma unroll
        for (int j = 0; j < 4; ++j) { const int col = 4 * lane + 256 * j;
            const f32x4 g = *(const f32x4*)(gn + col), s1 = *(const f32x4*)(sc + col), s0 = *(const f32x4*)(sh + col);
            const float hx = v[j].x * rstd * g.x * (1.f + s1.x) + s0.x, hy = v[j].y * rstd * g.y * (1.f + s1.y) + s0.y, hz = v[j].z * rstd * g.z * (1.f + s1.z) + s0.z, hw = v[j].w * rstd * g.w * (1.f + s1.w) + s0.w;
            u32x2 o; o.x = pk2(hx, hy); o.y = pk2(hz, hw); *(u32x2*)(H + (size_t)m * D + col) = o;
            const f32x2_t h01 = {hx, hy}, h23 = {hz, hw};
#pragma unroll
            for (int e = 0; e < 16; ++e) { const f32x4 w4 = *(const LAS f32x4*)(wr + e * 1028 + col);
                lgp[e] = __builtin_elementwise_fma(h01, (f32x2_t){w4.x, w4.y}, lgp[e]); lgp[e] = __builtin_elementwise_fma(h23, (f32x2_t){w4.z, w4.w}, lgp[e]); }
        }
#pragma unroll
        for (int e = 0; e < 16; ++e) lg[e] = lgp[e].x + lgp[e].y;
        float r8[8], r4[4], r2[2], r1;
#pragma unroll
        for (int e = 0; e < 8; ++e) { auto sw = __builtin_amdgcn_permlane32_swap(__float_as_uint(lg[e]), __float_as_uint(lg[e + 8]), false, false); r8[e] = __uint_as_float(sw[0]) + __uint_as_float(sw[1]); }
#pragma unroll
        for (int e = 0; e < 4; ++e) { auto sw = __builtin_amdgcn_permlane16_swap(__float_as_uint(r8[e]), __float_as_uint(r8[e + 4]), false, false); r4[e] = __uint_as_float(sw[0]) + __uint_as_float(sw[1]); }
        { const bool up = (lane & 8) != 0;
#pragma unroll
          for (int e = 0; e < 2; ++e) { const float keep = up ? r4[e + 2] : r4[e], send = up ? r4[e] : r4[e + 2]; r2[e] = keep + dpp_mov<0x140>(send); } }
        { const bool up = (lane & 4) != 0; const float keep = up ? r2[1] : r2[0], send = up ? r2[0] : r2[1]; r1 = keep + dpp_mov<0x141>(send); }
        r1 += dpp_mov<0x4E>(r1); r1 += dpp_mov<0xB1>(r1);
        const int el = (((lane >> 5) & 1) << 3) | (((lane >> 4) & 1) << 2) | (((lane >> 3) & 1) << 1) | ((lane >> 2) & 1);
        const float affl = sigm(r1), bial = affl + rb[el];
        float aff[16], bia[16];
#pragma unroll
        for (int e = 0; e < 16; ++e) { const int src = ((e & 8) ? 32 : 0) | ((e & 4) ? 16 : 0) | ((e & 2) ? 8 : 0) | ((e & 1) ? 4 : 0);
            aff[e] = __uint_as_float(__builtin_amdgcn_readlane(__float_as_uint(affl), src)); bia[e] = __uint_as_float(__builtin_amdgcn_readlane(__float_as_uint(bial), src)); }
        int best = 0; float bscore = -INFINITY;
#pragma unroll
        for (int g = 0; g < 4; ++g) {
            float t1 = -INFINITY, t2 = -INFINITY;
#pragma unroll
            for (int k = 0; k < 4; ++k) { const float x = bia[4 * g + k]; if (x > t1) { t2 = t1; t1 = x; } else if (x > t2) t2 = x; }
            const float gs = t1 + t2; if (gs > bscore) { bscore = gs; best = g; }
        }
        float x4[4], a4[4];
#pragma unroll
        for (int k = 0; k < 4; ++k) { x4[k] = (best == 0) ? bia[k] : (best == 1) ? bia[4 + k] : (best == 2) ? bia[8 + k] : bia[12 + k]; a4[k] = (best == 0) ? aff[k] : (best == 1) ? aff[4 + k] : (best == 2) ? aff[8 + k] : aff[12 + k]; }
        int i1 = 0; float v1 = x4[0];
#pragma unroll
        for (int k = 1; k < 4; ++k) if (x4[k] > v1) { v1 = x4[k]; i1 = k; }
        int i2 = -1; float v2 = -INFINITY;
#pragma unroll
        for (int k = 0; k < 4; ++k) if (k != i1 && x4[k] > v2) { v2 = x4[k]; i2 = k; }
        float w1 = 0.f, w2 = 0.f;
#pragma unroll
        for (int k = 0; k < 4; ++k) { if (k == i1) w1 = a4[k]; if (k == i2) w2 = a4[k]; }
        const float ws = w1 + w2; w1 /= ws; w2 /= ws;
        if (lane == 2 * ridx) { px = 4 * best + i1; pm = m; pw = w1; }
        if (lane == 2 * ridx + 1) { px = 4 * best + i2; pm = m; pw = w2; }
    }
    {
        const int lane = F.lane; const int np = 2 * ridx;
        int rank = 0, total = 0, leader = 64;
        for (int j = 0; j < np; ++j) { const int xj = __builtin_amdgcn_readlane(px, j); const bool same = (xj == px); rank += (same && j < lane) ? 1 : 0; total += same ? 1 : 0; leader = (same && j < leader) ? j : leader; }
        int base = 0;
        if (lane < np && rank == 0) base = (int)__hip_atomic_fetch_add(cnt + px, (unsigned)total, RLX_AGENT);
        base = __builtin_amdgcn_ds_bpermute((leader & 63) << 2, base);
        if (lane < np) { const int idx = px * 16384 + base + rank; ((int*)(F.ws + WS_ELIST))[idx] = 2 * pm + (lane & 1); ((float*)(F.ws + WS_EWW))[idx] = pw; }
    }
    asm volatile("s_waitcnt vmcnt(0)" ::: "memory"); __syncthreads();
    if (F.wave == 0) {
        unsigned tk = 0;
        if (F.lane == 0) { __builtin_amdgcn_fence(__ATOMIC_RELEASE, "agent"); asm volatile("s_waitcnt vmcnt(0)" ::: "memory"); tk = __hip_atomic_fetch_add(cnt + 32, 1u, RLX_AGENT); }
        tk = (unsigned)__builtin_amdgcn_readfirstlane((int)tk);
        if (tk == (unsigned)F.G - 1u) {
            __builtin_amdgcn_fence(__ATOMIC_ACQUIRE, "agent");
            const int lane = F.lane;
            int* tile_e = (int*)(F.ws + WS_ROWINFO + layer * ROWINFO_LSTRIDE) + 2 * MAXROWS;
            const int c = (lane < 16) ? (int)__hip_atomic_load(cnt + (lane & 15), RLX_AGENT) : 0, nt = (c + 255) >> 8;
            int ofs = 0, tot = 0;
            for (int e = 0; e < 16; ++e) { const int ne = __builtin_amdgcn_readlane(nt, e) << 8; ofs += (e < lane) ? ne : 0; tot += ne; }
            if (lane < 16) { tile_e[TE_OFF + lane] = ofs; tile_e[TE_CNT + lane] = c; for (int j = 0; j < nt; ++j) tile_e[(ofs >> 8) + j] = lane; }
            if (lane == 0) tile_e[256] = tot >> 8;
        }
    }
}
__device__ __forceinline__ void phase_g2(Frame& F, int layer) {
    volatile LAS int* off = (volatile LAS int*)F.lds;
    unsigned* cnt = F.ctl + CW_CNT + 64 * layer;
    int* rowinfo = (int*)(F.ws + WS_ROWINFO + layer * ROWINFO_LSTRIDE); float* roww = (float*)(rowinfo + MAXROWS); int* tile_e = rowinfo + 2 * MAXROWS; int* ntl = tile_e + 256;
    if (F.tid == 0) { int o = 0; for (int e = 0; e < 16; ++e) { off[e] = o; const int c = (int)__hip_atomic_load(cnt + e, RLX_AGENT); o += ((c + 255) >> 8) << 8; } off[16] = o; }
    __syncthreads();
    if (F.bid == 0) {
        if (F.tid == 0) ntl[0] = off[16] >> 8;
        for (int e = 0; e < 16; ++e) {
            const int c = (int)__hip_atomic_load(cnt + e, RLX_AGENT), o0 = off[e], o1 = off[e + 1];
            for (int r = o0 + c + F.tid; r < o1; r += NTHR) { rowinfo[r] = -1; roww[r] = 0.f; }
            for (int tl = (o0 >> 8) + F.tid; tl < (o1 >> 8); tl += NTHR) tile_e[tl] = e;
        }
    }
    const int* route = (const int*)(F.ws + WS_ROUTE);
    const int gw = F.bid * NWAVES + F.wave, NGW = F.G * NWAVES, lane = F.lane;
    for (int m = gw; m < T; m += NGW) {
        const int* rp = route + (size_t)m * 8;
        const int e1 = ld_ctl(rp), e2 = ld_ctl(rp + 1), p1 = ld_ctl(rp + 2), p2 = ld_ctl(rp + 3);
        const int r1 = off[e1] + p1, r2 = off[e2] + p2;
        if (lane == 0) { rowinfo[r1] = 2 * m; rowinfo[r2] = 2 * m + 1; roww[r1] = __int_as_float(ld_ctl(rp + 4)); roww[r2] = __int_as_float(ld_ctl(rp + 5)); }
    }
}

#if DBG_MODE == 2
__device__ __forceinline__ void dbg_flag(Frame& F, bool bad, unsigned code) { if (__any(bad) && F.lane == 0) atomicCAS(F.ctl + CW_DBG, 0u, code); }
__device__ __forceinline__ void scan_bf16(Frame& F, size_t off, size_t n, unsigned code) {
    const unsigned* p = (const unsigned*)(F.ws + off); bool bad = false;
    for (size_t i = (size_t)F.bid * NTHR + F.tid; i < n / 2; i += (size_t)F.G * NTHR) { const unsigned u = p[i]; bad = bad || ((u & 0x7f80u) == 0x7f80u) || ((u & 0x7f800000u) == 0x7f800000u); }
    dbg_flag(F, bad, code); }
__device__ __forceinline__ void scan_f32p(Frame& F, const float* p, size_t n, unsigned code) {
    bool bad = false;
    for (size_t i = (size_t)F.bid * NTHR + F.tid; i < n; i += (size_t)F.G * NTHR) { const unsigned u = __float_as_uint(p[i]); bad = bad || ((u & 0x7f800000u) == 0x7f800000u); }
    dbg_flag(F, bad, code); }
__device__ __forceinline__ void dbg_check(Frame& F, int p) {
    const unsigned code = (unsigned)(p + 1);
    if (DBG_SUB >= 4) {
        if (p != DBG_P) return;
        const size_t off = (DBG_SUB == 4) ? WS_ZS : (DBG_SUB == 5) ? WS_PT : (DBG_SUB == 6) ? WS_YT : WS_Y0;
        const unsigned* q = (const unsigned*)(F.ws + off); unsigned mx = 0;
        for (size_t i = (size_t)F.bid * NTHR + F.tid; i < (size_t)1536 * 2048; i += (size_t)F.G * NTHR) { const unsigned u = q[i]; const unsigned e0 = (u >> 7) & 0xffu, e1 = (u >> 23) & 0xffu; mx = mx > e0 ? mx : e0; mx = mx > e1 ? mx : e1; }
#if DBG_CNT
        { unsigned cnt = 0; for (size_t i = (size_t)F.bid * NTHR + F.tid; i < (size_t)1536 * 2048; i += (size_t)F.G * NTHR) { const unsigned u = q[i]; cnt += (((u >> 7) & 0xffu) == 0xffu) + (((u >> 23) & 0xffu) == 0xffu); }
          if (cnt) atomicAdd(F.ctl + CW_DBG, cnt); return; }
#endif
        atomicMax(F.ctl + CW_DBG, mx); return; }
    if (DBG_SUB == 3 && p != 4) return;
    if (p == 0) { scan_f32p(F, (const float*)(F.ws + WS_COS), (size_t)T * 64, code); scan_f32p(F, (const float*)(F.ws + WS_MOD), 2 * 2 * 6144, code); return; }
    if (p > 10 * NL) return;
    const int sub = (p - 1) % 10;
    switch (sub) {
    case 0: scan_bf16(F, WS_HM, (size_t)T * D, code); scan_bf16(F, WS_WIN, (size_t)NPAD * D, code); scan_bf16(F, WS_WOUT, (size_t)D * D, code); scan_bf16(F, WS_WUP, (size_t)16 * 512 * D, code);
            scan_bf16(F, WS_WDN, (size_t)16 * D * 256, code); scan_bf16(F, WS_PHIW, (size_t)2 * 64 * 2048, code); scan_bf16(F, WS_GUPT, 384 * 128, code); scan_f32p(F, (const float*)(F.ws + WS_PHIB), 256, code); break;
    case 1: scan_bf16(F, WS_NQ, (size_t)T * 384, code); scan_bf16(F, WS_KV6, (size_t)6 * T * 128, code); scan_bf16(F, WS_MQKV, (size_t)3 * T * 256, code); scan_bf16(F, WS_RFEAT, (size_t)T * RW, code);
            scan_f32p(F, (const float*)(F.ws + WS_GATE), (size_t)T * 32, code); break;
    case 2: scan_bf16(F, WS_KCMP, 2 * 2 * 512 * 64, code); scan_bf16(F, WS_VCMP, 2 * 2 * 512 * 64, code); scan_bf16(F, WS_KMEAN, 2 * 4 * 32 * 64, code);
            scan_bf16(F, WS_PT, (size_t)1536 * 4096, code); scan_bf16(F, WS_ZS, (size_t)1536 * 4096, code); scan_bf16(F, WS_YT, (size_t)1536 * 4096, code); scan_bf16(F, WS_Y0, (size_t)1536 * 4096, code);
            scan_f32p(F, (const float*)(F.ws + WS_BONUS), (size_t)T * 8, code); break;
    case 3: {
#if DBG_SUB == 3
        if (p == 4) { const unsigned* hm = (const unsigned*)(F.ws + WS_HM); bool b1 = false, b2 = false, b4 = false;
            for (size_t i = (size_t)F.bid * NTHR + F.tid; i < (size_t)T * 512; i += (size_t)F.G * NTHR) { const unsigned u = hm[i]; const int col = (int)(i & 511) * 2; const bool bad = ((u & 0x7f80u) == 0x7f80u) || ((u & 0x7f800000u) == 0x7f800000u);
                if (col < 384) b1 = b1 || bad; else if (col < 640) b2 = b2 || bad; }
            const unsigned* zs = (const unsigned*)(F.ws + WS_ZS);
            for (size_t i = (size_t)F.bid * NTHR + F.tid; i < (size_t)1536 * 2048; i += (size_t)F.G * NTHR) { const unsigned u = zs[i]; b4 = b4 || ((u & 0x7f80u) == 0x7f80u) || ((u & 0x7f800000u) == 0x7f800000u); }
            const unsigned bits = (__any(b1) ? 1u : 0u) | (__any(b2) ? 2u : 0u) | (__any(b4) ? 4u : 0u);
            if (bits && F.lane == 0) atomicOr(F.ctl + CW_DBG, bits); }
#else
        scan_bf16(F, WS_HM, (size_t)T * D, code); scan_bf16(F, WS_ZS, (size_t)1536 * 4096, code);
#endif
        } break;
    case 4: scan_bf16(F, WS_HM, (size_t)T * D, code); break;
    case 5: scan_f32p(F, F.out, (size_t)T * D, code); break;
    case 6: scan_bf16(F, WS_HM, (size_t)T * D, code); break;
    case 7: scan_bf16(F, WS_SORTA, (size_t)MAXROWS * D, code); break;
    case 8: scan_bf16(F, WS_HID, (size_t)MAXROWS * 256, code); break;
    case 9: scan_bf16(F, WS_YS, (size_t)2 * T * D, code); break;
    }
}
#endif
struct Args { const void* in[31]; float* out; unsigned char* ws; int ph_lo, ph_hi; };
constexpr int N_PHASES = 2 + 10 * NL + (DBG_MODE ? 1 : 0);

__global__ void __launch_bounds__(NTHR, 2) hybrid_fwd(Args args) {
    extern __shared__ __attribute__((aligned(16))) unsigned char lds_raw[];
    Frame F;
    F.lds = (LAS unsigned char*)lds_raw;
    F.MISC = (volatile LAS unsigned*)(F.lds + MISC_OFF);
    F.tid = threadIdx.x; F.lane = F.tid & 63; F.wave = __builtin_amdgcn_readfirstlane(F.tid >> 6);
    F.G = gridDim.x; F.bid = blockIdx.x;
    F.ws = (unsigned char*)(GAS unsigned char*)args.ws; F.out = (float*)(GAS float*)args.out; F.ctl = (unsigned*)(GAS unsigned*)(args.ws + WS_CTL);
    for (int u = F.tid; u < (LDS_BYTES - RING_BYTES) / 4; u += NTHR) ((LAS unsigned*)(F.lds + RING_BYTES))[u] = 0u;
    __syncthreads();
    if (F.tid < 31) *(LAS unsigned long long*)(F.lds + IN_OFF + 8 * F.tid) = (unsigned long long)args.in[F.tid];
    __syncthreads();
#if MK_PER_PHASE
#define GRID_BAR() do { } while (0)
#else
    XcdBarrier bar = xcd_barrier_post(F.ctl + CW_BAR, F.MISC + 8);
#define GRID_BAR() do { LAUNDER(F); xcd_barrier(bar, F.tid); } while (0)
#endif
    const int lo = args.ph_lo, hi = args.ph_hi;
    for (int ph_ = lo; ph_ < hi; ++ph_) {
        int ph = ph_; asm volatile("" : "+s"(ph));
#if DBG_MODE == 2
        if (ph > 0) { LAUNDER(F); dbg_check(F, ph - 1); }
#endif
#if DBG_MODE == 4
        if (blockIdx.x == 0) { const unsigned tnow = (unsigned)__builtin_amdgcn_s_memrealtime(); __hip_atomic_store((unsigned*)(args.ws + WS_CTL) + 3200 + ph_, tnow, RLX_AGENT); }
#endif
        for (int rep = 0; rep < ((REPEAT_PH >= 0 && ph_ == REPEAT_PH) ? 2 : 1); ++rep) {
        if (rep) GRID_BAR();
        if (ph == 0) { if (PH_EN(10)) { LAUNDER(F); phase_pro(F); LAUNDER(F); phase_a(F, 0, false, true); } }
#if DBG_MODE
        else if (ph == N_PHASES - 1) { LAUNDER(F);
#if DBG_MODE == 4
            const float dv = 100.f * floorf(4.f * log2f((float)(unsigned)(ld_ctl((const int*)(F.ctl + 3200 + DBG_TPH1)) - ld_ctl((const int*)(F.ctl + 3200 + DBG_TPH0)))) + DBG_QOFF);
            const float dv2 = 10000.f * floorf(4.f * log2f((float)(unsigned)(ld_ctl((const int*)(F.ctl + 3200 + DBG_TPH3)) - ld_ctl((const int*)(F.ctl + 3200 + DBG_TPH2)))) + DBG_QOFF);
            for (int i = F.bid * NTHR + F.tid; i < T * D; i += F.G * NTHR) F.out[i] = (i == 0) ? dv2 : dv;
            if (0)
#else
            const float dv = sqrtf((float)ld_ctl((const int*)(F.ctl + CW_DBG)));
#endif
            for (int i = F.bid * NTHR + F.tid; i < T * D; i += F.G * NTHR) F.out[i] = dv; }
        else if (ph == N_PHASES - 2) { if (PH_EN(11)) { LAUNDER(F); norm_rows(F, 0, true); } }
#else
        else if (ph == N_PHASES - 1) { if (PH_EN(11)) { LAUNDER(F); norm_rows(F, 0, true); } }
#endif
        else {
            const int layer = (ph - 1) / 10, sub = (ph - 1) % 10;
            switch (sub) {
            case 0: if (PH_EN(0)) { LAUNDER(F); phase_a(F, layer, true, layer > 0); } break;
            case 1: if (PH_EN(1)) { LAUNDER(F); pg8::Gemm g{(const bf16_t*)(F.ws + WS_HM), (const bf16_t*)(F.ws + WS_WIN), T, NPAD, D}; pg8::StaticOrder S; S.init(T, NPAD, F.G, F.bid, NPAD / 256 - 1);
                      EpiInProj E{(bf16_t*)(F.ws + WS_NQ), (bf16_t*)(F.ws + WS_KV6), (bf16_t*)(F.ws + WS_MQKV), (bf16_t*)(F.ws + WS_RFEAT), (float*)(F.ws + WS_GATE), (const float*)(F.ws + WS_COS), (const float*)(F.ws + WS_SIN)};
                      if (rep == 0) pg8::gemm_phase<EpiInProj, pg8::StaticOrder, true, true>(F.lds, g, S, E, F.tid);
                      else { EpiNull EN{(float*)(F.ws + WS_GATE)}; pg8::gemm_phase<EpiNull, pg8::StaticOrder, true, true>(F.lds, g, S, EN, F.tid); } } break;
            case 2: if (PH_EN(2)) { LAUNDER(F); phase_c(F, layer); LAUNDER(F); phase_d(F, layer, rep); } break;
            case 3: break;
            case 4: if (PH_EN(4)) { LAUNDER(F); phase_e(F, layer); } break;
            case 5: if (PH_EN(5)) { LAUNDER(F); pg8::Gemm g{(const bf16_t*)(F.ws + WS_HM), (const bf16_t*)(F.ws + WS_WOUT), T, D, D}; pg8::StaticOrder S; S.init(T, D, F.G, F.bid);
                      EpiOutProj E{layer == 0 ? INF(F, I_X) : F.out, F.out, (const float*)(F.ws + WS_MOD) + (size_t)layer * BATCH * 6144 + 2048};
                      if (rep == 0) pg8::gemm_phase<EpiOutProj, pg8::StaticOrder, true, true>(F.lds, g, S, E, F.tid);
                      else { EpiNull EN{(float*)(F.ws + WS_GATE)}; pg8::gemm_phase<EpiNull, pg8::StaticOrder, true, true>(F.lds, g, S, EN, F.tid); } } break;
            case 6: if (PH_EN(6)) { LAUNDER(F); phase_g1(F, layer); } break;
            case 7: break;
            case 8: if (PH_EN(8)) { LAUNDER(F); const int* rowinfo = (const int*)(F.ws + WS_ROWINFO + layer * ROWINFO_LSTRIDE); const int* tile_e = rowinfo + 2 * MAXROWS;
                      const int ntl = __builtin_amdgcn_readfirstlane(ld_ctl(tile_e + 256));
                      pg8::Gemm g{(const bf16_t*)(F.ws + WS_HM), (const bf16_t*)(F.ws + WS_WUP), MAXROWS, 512, D};
                      MoeGatherOrder S{ntl, 2, F.G, F.bid, tile_e, (size_t)512 * D * 2, (const int*)(F.ws + WS_ELIST)};
                      EpiMoeUp E{(bf16_t*)(F.ws + WS_HID)};
                      pg8::gemm_phase<EpiMoeUp, MoeGatherOrder, true, true>(F.lds, g, S, E, F.tid); } break;
            case 9: if (PH_EN(9)) { LAUNDER(F); const int* rowinfo = (const int*)(F.ws + WS_ROWINFO + layer * ROWINFO_LSTRIDE); const int* tile_e = rowinfo + 2 * MAXROWS;
                      const int ntl = __builtin_amdgcn_readfirstlane(ld_ctl(tile_e + 256));
                      pg8::Gemm g{(const bf16_t*)(F.ws + WS_HID), (const bf16_t*)(F.ws + WS_WDN), MAXROWS, D, 256};
                      MoeOrder S{ntl, 4, F.G, F.bid, tile_e, (size_t)D * 256 * 2, (const int*)(F.ws + WS_ELIST)};
                      EpiMoeDown E{(bf16_t*)(F.ws + WS_YS), tile_e, (const int*)(F.ws + WS_ELIST), (const float*)(F.ws + WS_EWW)};
                      pg8::gemm_phase<EpiMoeDown, MoeOrder, true, true>(F.lds, g, S, E, F.tid); } break;
            }
        }
        }
#if EXTRA_BAR
        if (ph_ == 0) { for (int eb = 0; eb < EXTRA_BAR; ++eb) GRID_BAR(); }
#endif
        if (ph_ + 1 < hi && !(ph_ >= 1 && ph_ <= 10 * NL && (((ph_ - 1) % 10) == 2 || ((ph_ - 1) % 10) == 3 || ((ph_ - 1) % 10) == 7))) GRID_BAR();
    }
}

extern "C" void kernel_launch(void* const* d_in, const int* in_sizes, int n_in, void* d_out, int out_size, void* d_ws, size_t ws_size, hipStream_t stream) {
    static int grid = 0;
    if (grid == 0) {
        if (n_in != 31 || out_size != T * D || ws_size < WS_END) { fprintf(stderr, "kernel_launch: unexpected shapes: n_in %d out %d ws %zu (need %zu)\n", n_in, out_size, ws_size, (size_t)WS_END); grid = -1; return; }
        int dev = 0, cus = 0, per_cu = 0;
        if (hipGetDevice(&dev) != hipSuccess || hipDeviceGetAttribute(&cus, hipDeviceAttributeMultiprocessorCount, dev) != hipSuccess) { grid = -1; return; }
        if (hipFuncSetAttribute((const void*)hybrid_fwd, hipFuncAttributeMaxDynamicSharedMemorySize, LDS_BYTES) != hipSuccess) { fprintf(stderr, "kernel_launch: hipFuncSetAttribute failed\n"); grid = -1; return; }
        if (hipOccupancyMaxActiveBlocksPerMultiprocessor(&per_cu, (const void*)hybrid_fwd, NTHR, LDS_BYTES) != hipSuccess || per_cu < 1) fprintf(stderr, "kernel_launch: occupancy query says %d\n", per_cu);
        (void)hipGetLastError();
        grid = cus;
    }
    if (grid < 0) return;
    (void)hipMemsetAsync((char*)d_ws + WS_CTL, 0, CTL_ZERO_BYTES, stream);
    Args a{};
    for (int i = 0; i < 31; ++i) a.in[i] = d_in[i];
    a.out = (float*)d_out; a.ws = (unsigned char*)d_ws;
#if MK_PER_PHASE
    for (int ph = 0; ph < N_PHASES; ++ph) { a.ph_lo = ph; a.ph_hi = ph + 1; hipLaunchKernelGGL(hybrid_fwd, dim3(grid), dim3(NTHR), LDS_BYTES, stream, a); }
#else
    a.ph_lo = 0; a.ph_hi = N_PHASES;
    hipLaunchKernelGGL(hybrid_fwd, dim3(grid), dim3(NTHR), LDS_BYTES, stream, a);
#endif
}
```

```cpp
#include <hip/hip_runtime.h>
#include <cstdio>
#include <cstdint>
#include <cmath>
#ifndef PH_MASK
#define PH_MASK 0xfff
#endif
#define PH_EN(k) ((PH_MASK >> (k)) & 1)
#ifndef MK_PER_PHASE
#define MK_PER_PHASE 0
#endif
namespace pg8 {
#define PG8_LAS __attribute__((address_space(3)))
typedef unsigned short bf16_t;
typedef short bf16x8 __attribute__((ext_vector_type(8)));
typedef float f32x4 __attribute__((ext_vector_type(4)));
typedef unsigned u32x4 __attribute__((ext_vector_type(4)));
constexpr int BM = 256, BK = 64, HALF = 128, HTB = HALF * BK * 2  , STAGE_BYTES = 8 * HTB, NXCD = 8, WGM = 8;

__host__ __device__ __forceinline__ int lds_byte(int r, int c) { const int st = (r >> 4) * 2 + (c >> 5), rr = r & 15, cc = c & 31, ob = rr * 64 + cc * 2; return st * 1024 + (ob ^ (((ob >> 9) & 1) << 5)); }
__host__ __device__ __forceinline__ void stage_rc(int b, int& R, int& C) { const int st = b / 1024, sb = b % 1024, swz = sb ^ (((sb >> 9) & 1) << 5); R = (st >> 1) * 16 + swz / 64; C = (st & 1) * 32 + (swz % 64) / 2; }
__host__ __device__ __forceinline__ int perm32(int rho) { const int n = rho >> 4, i = rho & 15; return 8 * (i >> 2) + 4 * n + (i & 3); }

struct Unit { int pm, pn, mask; };
struct Gemm { const bf16_t* A; const bf16_t* Bt; int M, N, K; };

__host__ __device__ __forceinline__ bool tail_split(int i, int G, int c, int total, int& L, int& f, int& sub) {
    const int rounds = total / G, nfull = rounds * G, ntail = total - nfull; f = 1; sub = 0;
    if (i < rounds) { L = i * G + c; return true; }
    if (i > rounds || ntail == 0) return false;
    f = (4 * ntail <= G) ? 4 : (2 * ntail <= G) ? 2 : 1;
    if (c >= ntail * f) return false;
    L = nfull + c / f; sub = c % f; return true;
}
struct StaticOrder {
    int nM, nN, nwg, G, c, padpn;
    __host__ __device__ void init(int M, int N, int G_, int c_, int padpn_ = -1) { nM = M / BM; nN = N / BM; nwg = nM * nN; G = G_; c = c_; padpn = padpn_; }
    __host__ __device__ bool next(int i, Unit& u) const {
        int L, f, sub; if (!tail_split(i, G, c, nwg, L, f, sub)) return false;
        int wgid = L; { const int q = nwg / NXCD, r = nwg % NXCD, xcd = wgid % NXCD, off = wgid / NXCD; wgid = (xcd < r ? xcd * (q + 1) : r * (q + 1) + (xcd - r) * q) + off; }
        const int nig = WGM * nN, gid = wgid / nig, fm = gid * WGM, gsz = (nM - fm) < WGM ? (nM - fm) : WGM;
        u.pm = fm + ((wgid % nig) % gsz); u.pn = (wgid % nig) / gsz;
        const bool pad = (u.pn == padpn);
        u.mask = (f == 1) ? (pad ? 0x5 : 0xF) : (f == 2) ? (pad ? (sub ? 0x4 : 0x1) : (sub ? 0xA : 0x5)) : ((1 << sub) & (pad ? 0x5 : 0xF));
        return true;
    }
    static constexpr bool GATHER = false;
    __device__ __forceinline__ void arows(const Unit&, const int (&)[2], int (&o)[2][2]) const { o[0][0] = o[0][1] = o[1][0] = o[1][1] = 0; }
    __device__ __forceinline__ void a_ready(const Unit&) const {}
    __device__ __forceinline__ size_t boff(const Unit&) const { return 0; }
    __device__ __forceinline__ void done(const Unit&) const {}
};

template <class Epi, class Sched, bool ALIGN_EPI = false, bool SP2 = false>
__device__ __forceinline__ void gemm_phase(PG8_LAS unsigned char* lds, const Gemm g, const Sched& S, const Epi& E, const int tid_in) {
    const int tid = tid_in, wid = __builtin_amdgcn_readfirstlane(tid >> 6), lane = tid & 63, wr = wid >> 2, wc = wid & 3, fr = lane & 15, fq = lane >> 4;
    const int K = g.K, nt = K / BK;
    unsigned voffA[2], voffB[2];
    int RA[2], CA[2];
    unsigned gA_cur[2][2], gA_nxt[2][2];
    static_assert(!Sched::GATHER || SP2, "row-gathered A is wired into the SP2 loop only");
#pragma unroll
    for (int i = 0; i < 2; ++i) { int R, C; stage_rc(tid * 16 + i * 8192, R, C); const int Rb = Epi::PERM ? ((R & ~31) + perm32(R & 31)) : R;
        voffA[i] = (unsigned)(R * K + C) * 2u; voffB[i] = (unsigned)(Rb * K + C) * 2u; RA[i] = R; CA[i] = C; }
#define PG8_GROWS(u, o) do { int ar_[2][2]; S.arows(u, RA, ar_); _Pragma("unroll") for (int h_ = 0; h_ < 2; ++h_) _Pragma("unroll") for (int i_ = 0; i_ < 2; ++i_) o[h_][i_] = (unsigned)(ar_[h_][i_] * K + CA[i_]) * 2u; } while (0)
    const size_t kstep = (size_t)(BK * 2);
    const size_t hstep = (size_t)HALF * K * 2;
    const size_t tstep = 2 * hstep;
    const unsigned ldsw = (unsigned)wid * 1024u;
    const int aoff = lds_byte(wr * 64 + fr, fq * 8), boff = lds_byte(wc * 32 + fr, fq * 8);
#define PG8_SA(b, h) (((b) * 2 + (h)) * HTB)
#define PG8_SB(b, h) ((4 + (b) * 2 + (h)) * HTB)
#define PG8_STAGE(bufoff, gbase, voff) do { _Pragma("unroll") for (int _i = 0; _i < 2; ++_i) \
        __builtin_amdgcn_global_load_lds((const unsigned*)((const char*)(gbase) + (voff)[_i]), (PG8_LAS unsigned*)(lds + (bufoff) + ldsw + _i * 8192), 16, 0, 0); } while (0)
#define PG8_STAGE_A(bufoff, gbase, half, nx) do { if constexpr (Sched::GATHER) { _Pragma("unroll") for (int _i = 0; _i < 2; ++_i) { const unsigned vo_ = (nx) ? gA_nxt[half][_i] : gA_cur[half][_i]; \
        __builtin_amdgcn_global_load_lds((const unsigned*)((const char*)(gbase) + vo_), (PG8_LAS unsigned*)(lds + (bufoff) + ldsw + _i * 8192), 16, 0, 0); } } else { PG8_STAGE(bufoff, (gbase) + (half) * hstep, voffA); } } while (0)
#define PG8_LDA(dst, b, h) do { _Pragma("unroll") for (int m = 0; m < 4; ++m) _Pragma("unroll") for (int k = 0; k < 2; ++k) dst[m][k] = *(const PG8_LAS bf16x8*)(lds + PG8_SA(b, h) + aoff + m * 2048 + k * 1024); } while (0)
#define PG8_LDB(dst, b, h) do { _Pragma("unroll") for (int n = 0; n < 2; ++n) _Pragma("unroll") for (int k = 0; k < 2; ++k) dst[n][k] = *(const PG8_LAS bf16x8*)(lds + PG8_SB(b, h) + boff + n * 2048 + k * 1024); } while (0)
#define PG8_MMA(ai, bj, At, Bt) do { if (cmask & (1 << ((ai) * 2 + (bj)))) PG8_MMA_(ai, bj, At, Bt); } while (0)
#define PG8_MMA_(ai, bj, At, Bt) do { __builtin_amdgcn_s_setprio(1); _Pragma("unroll") for (int m = 0; m < 4; ++m) _Pragma("unroll") for (int n = 0; n < 2; ++n) _Pragma("unroll") for (int k = 0; k < 2; ++k) \
        acc[ai][bj][m][n] = __builtin_amdgcn_mfma_f32_16x16x32_bf16(Bt[n][k], At[m][k], acc[ai][bj][m][n], 0, 0, 0); __builtin_amdgcn_s_setprio(0); } while (0)
#define PG8_WAIT_V(n) asm volatile("s_waitcnt vmcnt(" #n ")" ::: "memory")
#define PG8_WAIT_L(n) asm volatile("s_waitcnt lgkmcnt(" #n ")" ::: "memory")
#define PG8_BAR __builtin_amdgcn_s_barrier()
#define PG8_SCHED __builtin_amdgcn_sched_barrier(0)
    Unit cur, nxt; int ui = 0;
    if (!S.next(0, cur)) return;
    f32x4 acc[2][2][4][2];
#pragma unroll
    for (int a = 0; a < 2; ++a)
#pragma unroll
        for (int b = 0; b < 2; ++b)
#pragma unroll
            for (int m = 0; m < 4; ++m)
#pragma unroll
                for (int n = 0; n < 2; ++n) acc[a][b][m][n] = (f32x4){0.f, 0.f, 0.f, 0.f};
    bf16x8 At[4][2], B0[2][2], B1[2][2];
    const char* cA = (const char*)g.A + (Sched::GATHER ? (size_t)0 : (size_t)cur.pm * tstep); const char* cB = (const char*)g.Bt + S.boff(cur) + (size_t)cur.pn * tstep;
    S.a_ready(cur);
    if constexpr (Sched::GATHER) { PG8_GROWS(cur, gA_cur); }
    if constexpr (SP2) {
        PG8_STAGE(PG8_SB(0, 0), cB, voffB); PG8_STAGE(PG8_SB(0, 1), cB + hstep, voffB); PG8_STAGE_A(PG8_SA(0, 0), cA, 0, false); PG8_STAGE_A(PG8_SA(0, 1), cA, 1, false);
        if (wr == 1) PG8_BAR;
        PG8_WAIT_V(2); PG8_BAR;
        PG8_STAGE(PG8_SB(1, 0), cB + kstep, voffB); PG8_STAGE_A(PG8_SA(1, 0), cA + kstep, 0, false); PG8_STAGE(PG8_SB(1, 1), cB + hstep + kstep, voffB);
        PG8_WAIT_V(6); PG8_BAR;
    } else {
        PG8_STAGE(PG8_SB(0, 0), cB, voffB); PG8_STAGE(PG8_SA(0, 0), cA, voffA); PG8_STAGE(PG8_SB(0, 1), cB + hstep, voffB); PG8_STAGE(PG8_SA(0, 1), cA + hstep, voffA);
        if (wr == 1) PG8_BAR;
        PG8_WAIT_V(4); PG8_BAR;
        PG8_STAGE(PG8_SB(1, 0), cB + kstep, voffB); PG8_STAGE(PG8_SA(1, 0), cA + kstep, voffA); PG8_STAGE(PG8_SB(1, 1), cB + hstep + kstep, voffB);
        PG8_WAIT_V(6); PG8_BAR;
    }
    for (;;) {
        const int cmask = __builtin_amdgcn_readfirstlane(cur.mask);
        const bool has_next = S.next(ui + 1, nxt);
        const char* nA = has_next ? (const char*)g.A + (Sched::GATHER ? (size_t)0 : (size_t)nxt.pm * tstep) : cA; const char* nB = has_next ? (const char*)g.Bt + S.boff(nxt) + (size_t)nxt.pn * tstep : cB;
        if constexpr (Sched::GATHER) { if (has_next) { PG8_GROWS(nxt, gA_nxt); } }
        for (int t = 0; t < nt; t += 2) {
            const bool last = (t == nt - 2);
            const char* a1 = cA + (size_t)(t + 1) * kstep;
            const char* a2 = last ? nA : cA + (size_t)(t + 2) * kstep; const char* b2 = last ? nB : cB + (size_t)(t + 2) * kstep;
            const char* a3 = a2 + kstep; const char* b3 = b2 + kstep;
            if (last && has_next) S.a_ready(nxt);
            const bool usen = last && has_next;
            if constexpr (SP2) {
            PG8_LDB(B0, 0, 0); PG8_LDB(B1, 0, 1); PG8_SCHED; PG8_LDA(At, 0, 0); PG8_STAGE_A(PG8_SA(1, 1), a1, 1, false);
            PG8_WAIT_V(8); PG8_WAIT_L(0); PG8_BAR; PG8_MMA(0, 0, At, B0); PG8_MMA(0, 1, At, B1); PG8_BAR; PG8_SCHED;
            PG8_LDA(At, 0, 1); PG8_STAGE(PG8_SB(0, 0), b2, voffB); PG8_STAGE(PG8_SB(0, 1), b2 + hstep, voffB); PG8_STAGE_A(PG8_SA(0, 0), a2, 0, usen);
            PG8_WAIT_V(8); PG8_WAIT_L(0); PG8_BAR; PG8_MMA(1, 0, At, B0); PG8_MMA(1, 1, At, B1); PG8_BAR; PG8_SCHED;
            PG8_LDB(B0, 1, 0); PG8_LDB(B1, 1, 1); PG8_SCHED; PG8_LDA(At, 1, 0); PG8_STAGE_A(PG8_SA(0, 1), a2, 1, usen);
            PG8_WAIT_V(8); PG8_WAIT_L(0); PG8_BAR; PG8_MMA(0, 0, At, B0); PG8_MMA(0, 1, At, B1); PG8_BAR; PG8_SCHED;
            PG8_LDA(At, 1, 1); PG8_STAGE(PG8_SB(1, 0), b3, voffB); PG8_STAGE(PG8_SB(1, 1), b3 + hstep, voffB); PG8_STAGE_A(PG8_SA(1, 0), a3, 0, usen);
            PG8_WAIT_V(8); PG8_WAIT_L(0); PG8_BAR; PG8_MMA(1, 0, At, B0); PG8_MMA(1, 1, At, B1); PG8_BAR; PG8_SCHED;
            } else {
            PG8_LDB(B0, 0, 0); PG8_SCHED; PG8_LDA(At, 0, 0); PG8_STAGE(PG8_SA(1, 1), a1 + hstep, voffA);
            PG8_WAIT_L(8); PG8_BAR; PG8_WAIT_L(0); PG8_MMA(0, 0, At, B0); PG8_BAR; PG8_SCHED;
            PG8_LDB(B1, 0, 1); PG8_STAGE(PG8_SB(0, 0), b2, voffB);
            PG8_BAR; PG8_WAIT_L(0); PG8_MMA(0, 1, At, B1); PG8_BAR;
            PG8_LDA(At, 0, 1); PG8_STAGE(PG8_SA(0, 0), a2, voffA);
            PG8_BAR; PG8_WAIT_L(0); PG8_MMA(1, 0, At, B0); PG8_BAR; PG8_SCHED;
            PG8_STAGE(PG8_SB(0, 1), b2 + hstep, voffB);
            PG8_WAIT_V(6); PG8_BAR; PG8_MMA(1, 1, At, B1); PG8_BAR;
            PG8_LDB(B0, 1, 0); PG8_SCHED; PG8_LDA(At, 1, 0); PG8_STAGE(PG8_SA(0, 1), a2 + hstep, voffA);
            PG8_WAIT_L(8); PG8_BAR; PG8_WAIT_L(0); PG8_MMA(0, 0, At, B0); PG8_BAR; PG8_SCHED;
            PG8_LDB(B1, 1, 1); PG8_STAGE(PG8_SB(1, 0), b3, voffB);
            PG8_BAR; PG8_WAIT_L(0); PG8_MMA(0, 1, At, B1); PG8_BAR;
            PG8_LDA(At, 1, 1); PG8_STAGE(PG8_SA(1, 0), a3, voffA);
            PG8_BAR; PG8_WAIT_L(0); PG8_MMA(1, 0, At, B0); PG8_BAR; PG8_SCHED;
            PG8_STAGE(PG8_SB(1, 1), b3 + hstep, voffB);
            PG8_WAIT_V(6); PG8_BAR; PG8_MMA(1, 1, At, B1); PG8_BAR;
            }
        }
        if constexpr (ALIGN_EPI) { if (wr == 0) PG8_BAR; }
        if constexpr (!Epi::AFTER_DRAIN) { E(acc, cur, wr, wc, 0, 0); S.done(cur); }
        if (!has_next) break;
#pragma unroll
        for (int a = 0; a < 2; ++a)
#pragma unroll
            for (int b = 0; b < 2; ++b)
#pragma unroll
                for (int m = 0; m < 4; ++m)
#pragma unroll
                    for (int n = 0; n < 2; ++n) acc[a][b][m][n] = (f32x4){0.f, 0.f, 0.f, 0.f};
        cur = nxt; cA = nA; cB = nB; ++ui;
        if constexpr (Sched::GATHER) {
#pragma unroll
            for (int h_ = 0; h_ < 2; ++h_)
#pragma unroll
                for (int i_ = 0; i_ < 2; ++i_) gA_cur[h_][i_] = gA_nxt[h_][i_]; }
        if constexpr (ALIGN_EPI) { if (wr == 1) PG8_BAR; }
    }
    PG8_WAIT_V(0);
    if constexpr (!ALIGN_EPI) { if (wr == 0) PG8_BAR; }
    PG8_BAR;
    if constexpr (Epi::AFTER_DRAIN) { E.fused(acc, cur, wr, wc, fr, fq, lds, wid, lane); S.done(cur); }
#undef PG8_SA
#undef PG8_SB
#undef PG8_STAGE
#undef PG8_STAGE_A
#undef PG8_GROWS
#undef PG8_LDA
#undef PG8_LDB
#undef PG8_MMA
#undef PG8_MMA_
#undef PG8_WAIT_V
#undef PG8_WAIT_L
#undef PG8_BAR
#undef PG8_SCHED
}
}

constexpr int BATCH = 2, SEQ = 8192, T = BATCH * SEQ, D = 1024, NL = 2;
constexpr int NPAD = 3584, RW = 1408, INCOLS = 3346;
constexpr int NWAVES = 8, NTHR = 512;
constexpr float LOG2E = 1.4426950408889634f;
constexpr float NORM_EPS = 1e-6f;

#define GAS __attribute__((address_space(1)))
#define LAS __attribute__((address_space(3)))
typedef unsigned short bf16_t;
typedef short bf16x8 __attribute__((ext_vector_type(8)));
typedef short s16x4 __attribute__((ext_vector_type(4)));
typedef short v4i16_t __attribute__((ext_vector_type(4)));
typedef float f32x4 __attribute__((ext_vector_type(4)));
typedef float f32x16 __attribute__((ext_vector_type(16)));
typedef unsigned u32x4 __attribute__((ext_vector_type(4)));
typedef unsigned u32x2 __attribute__((ext_vector_type(2)));
typedef GAS unsigned gu32;

constexpr size_t MiB = 1u << 20, KiB = 1u << 10;
constexpr size_t WS_CTL = 0, CTL_ZERO_BYTES = 64 * KiB;
constexpr size_t WS_COS = 1 * MiB, WS_SIN = 3 * MiB;
constexpr size_t WS_MOD = 5 * MiB;
constexpr size_t WS_PHIB = WS_MOD + 128 * KiB;
constexpr size_t WS_KMEAN = WS_MOD + 192 * KiB;
constexpr size_t WS_KCMP = WS_MOD + 256 * KiB;
constexpr size_t WS_VCMP = WS_KCMP + 256 * KiB;
constexpr size_t WS_BONUS = 6 * MiB;
constexpr size_t WS_GATE = 7 * MiB;
constexpr size_t WS_ROUTE = 9 * MiB;
constexpr size_t WS_ROWINFO = 10 * MiB;
constexpr size_t ROWINFO_LSTRIDE = 512 * KiB;
constexpr int MAXROWS = 36864;
constexpr size_t WS_ELIST = 9 * MiB;
constexpr size_t WS_EWW = 11 * MiB;
constexpr int TE_OFF = 272, TE_CNT = 304;
constexpr size_t WS_WIN = 12 * MiB;
constexpr size_t WS_WOUT = 19 * MiB;
constexpr size_t WS_WUP = 21 * MiB;
constexpr size_t WS_WDN = 37 * MiB;
constexpr size_t WS_PHIW = 45 * MiB;
constexpr size_t WS_GUPT = 45 * MiB + 512 * KiB;
constexpr size_t WS_WUPT = 45 * MiB + 640 * KiB;
constexpr size_t WS_AUPT = 45 * MiB + 704 * KiB;
constexpr size_t WS_LORA = 46 * MiB;
constexpr size_t WS_HM = 46 * MiB;
constexpr size_t WS_NQ = 78 * MiB;
constexpr size_t WS_KV6 = 90 * MiB;
constexpr size_t KV6_STRIDE = (size_t)BATCH * 2 * SEQ * 64;
constexpr size_t WS_MQKV = 114 * MiB;
constexpr size_t MQKV_STRIDE = (size_t)BATCH * 4 * SEQ * 64;
constexpr size_t WS_RFEAT = 138 * MiB;
constexpr size_t WS_SORTA = 78 * MiB;
constexpr size_t WS_HID = 150 * MiB;
constexpr size_t WS_PT = 182 * MiB;
constexpr size_t WS_ZS = 194 * MiB;
constexpr size_t WS_YT = 206 * MiB;
constexpr size_t WS_Y0 = 218 * MiB;
constexpr size_t WS_YS = 182 * MiB;
constexpr size_t WS_SS = 230 * MiB;
constexpr size_t WS_END = 256 * MiB;
constexpr int CW_Q = 64;
constexpr int CW_CNT = 1024;
constexpr int CW_BAR = 4096;
constexpr int CW_DBG = 3072;
#ifndef DBG_MODE
#define DBG_MODE 0
#endif
#ifndef EXTRA_BAR
#define EXTRA_BAR 0
#endif
#ifndef REPEAT_PH
#define REPEAT_PH -1
#endif
#ifndef DBG_TPH0
#define DBG_TPH0 0
#endif
#ifndef DBG_TPH1
#define DBG_TPH1 1
#endif
#ifndef DBG_QOFF
#define DBG_QOFF 0.0f
#endif
#ifndef DBG_TPH2
#define DBG_TPH2 0
#endif
#ifndef DBG_TPH3
#define DBG_TPH3 1
#endif
#ifndef DBG_SUB
#define DBG_SUB 4
#endif
#ifndef DBG_P
#define DBG_P 4
#endif
#ifndef DBG_CNT
#define DBG_CNT 1
#endif

#define RLX_AGENT __ATOMIC_RELAXED, __HIP_MEMORY_SCOPE_AGENT
#define LDS_WAIT() asm volatile("s_waitcnt lgkmcnt(0)" ::: "memory")
#define VM_WAIT() asm volatile("s_waitcnt vmcnt(0)" ::: "memory")
__device__ __forceinline__ float bf2f(bf16_t h) { return __uint_as_float(((unsigned)h) << 16); }
typedef float f32x2_t __attribute__((ext_vector_type(2)));
typedef __bf16 bf16x2_t __attribute__((ext_vector_type(2)));
__device__ __forceinline__ unsigned pk2(float lo, float hi) { const f32x2_t v = {lo, hi}; return __builtin_bit_cast(unsigned, __builtin_convertvector(v, bf16x2_t)); }
__device__ __forceinline__ bf16_t f2bf(float f) { return (bf16_t)(pk2(f, 0.f) & 0xffffu); }
__device__ __forceinline__ float shx(float v, int mask, int lane) { return __uint_as_float(__builtin_amdgcn_ds_bpermute((lane ^ mask) << 2, __float_as_uint(v))); }
__device__ __forceinline__ int shxi(int v, int mask, int lane) { return __builtin_amdgcn_ds_bpermute((lane ^ mask) << 2, v); }
template <int CTRL> __device__ __forceinline__ float dpp_mov(float v) { return __uint_as_float(__builtin_amdgcn_update_dpp(0u, __float_as_uint(v), CTRL, 0xf, 0xf, true)); }
__device__ __forceinline__ float half_sum32(float v) { const unsigned u = __float_as_uint(v); auto r = __builtin_amdgcn_permlane32_swap(u, u, false, false); return __uint_as_float(r[0]) + __uint_as_float(r[1]); }
__device__ __forceinline__ float row_sum16(float v) { const unsigned u = __float_as_uint(v); auto r = __builtin_amdgcn_permlane16_swap(u, u, false, false); return __uint_as_float(r[0]) + __uint_as_float(r[1]); }
__device__ __forceinline__ float wave_sum(float v, int lane) {
    (void)lane;
    v += dpp_mov<0xB1>(v); v += dpp_mov<0x4E>(v); v += dpp_mov<0x141>(v); v += dpp_mov<0x140>(v);
    return half_sum32(row_sum16(v));
}
__device__ __forceinline__ float tanh_fast(float x) { const float xc = fminf(fmaxf(x, -15.f), 15.f); return 1.f - 2.f * __builtin_amdgcn_rcpf(__builtin_amdgcn_exp2f(xc * (2.f * LOG2E)) + 1.f); }
__device__ __forceinline__ float sigm(float x) { return __builtin_amdgcn_rcpf(1.f + __expf(-x)); }
__device__ __forceinline__ int ld_ctl(const int* p) { return __hip_atomic_load(p, RLX_AGENT); }
__device__ __forceinline__ float ld_ctlf(const float* p) { return __uint_as_float(__hip_atomic_load((const unsigned*)p, RLX_AGENT)); }
#define MFMA16(a, b, c) __builtin_amdgcn_mfma_f32_16x16x32_bf16(a, b, c, 0, 0, 0)
#define MFMA32(a, b, c) __builtin_amdgcn_mfma_f32_32x32x16_bf16(a, b, c, 0, 0, 0)

#define XB_TMO      128
#define XB_XCNT(j)  (256  + 64 * (j))
#define XB_XSUB(j)  (1280 + 64 * (j))
#define XB_XGEN(j)  (2304 + 64 * (j))
#define XB_TOP      3328
#define XB_TOPGEN   3392
#define XCD_BAR_WORDS 3456
#define XB_SPIN_CAP (1u << 22)
__device__ __forceinline__ unsigned xb_ld(unsigned* p)              { return __hip_atomic_load(p, __ATOMIC_RELAXED, __HIP_MEMORY_SCOPE_AGENT); }
__device__ __forceinline__ unsigned xb_add(unsigned* p, unsigned v) { return __hip_atomic_fetch_add(p, v, __ATOMIC_RELAXED, __HIP_MEMORY_SCOPE_AGENT); }
__device__ __forceinline__ unsigned xb_xcc_id() { return (unsigned)__builtin_amdgcn_s_getreg((3 << 11) | 20) & 0xFu; }
#define XB_SPIN(cond, bar) do { unsigned _sp = 0; while (cond) { __builtin_amdgcn_s_sleep(1); \
    if ((++_sp & 255u) == 0u) { if (xb_ld(&(bar)[XB_TMO])) break; if (_sp > XB_SPIN_CAP) { atomicAdd(&(bar)[XB_TMO], 1u); break; } } } } while (0)
struct XcdBarrier { unsigned* bar; unsigned x; volatile LAS unsigned* st; };
__device__ __forceinline__ XcdBarrier xcd_barrier_post(unsigned* bar, volatile LAS unsigned* st) {
    XcdBarrier b; b.bar = bar; b.x = xb_xcc_id(); b.st = st;
    if (threadIdx.x == 0) (void)xb_add(&bar[XB_XCNT(b.x)], 1u);
    return b;
}
__device__ __forceinline__ void xcd_barrier_complete(unsigned* bar, unsigned x, unsigned& nloc, unsigned& nx) {
    const unsigned G = gridDim.x * gridDim.y * gridDim.z;
    unsigned sum, cnt, mine, sp = 0u;
    for (;;) {
        sum = 0u; cnt = 0u; mine = 0u;
#pragma unroll
        for (unsigned j = 0; j < 16; ++j) { const unsigned c = xb_ld(&bar[XB_XCNT(j)]); sum += c; cnt += (c > 0u) ? 1u : 0u; mine = (j == x) ? c : mine; }
        if (sum == G) break;
        __builtin_amdgcn_s_sleep(1);
        if ((++sp & 255u) == 0u) { if (xb_ld(&bar[XB_TMO])) break; if (sp > XB_SPIN_CAP) { atomicAdd(&bar[XB_TMO], 1u); break; } }
    }
    nloc = mine > 0u ? mine : 1u; nx = cnt > 0u ? cnt : 1u;
}
__device__ __forceinline__ void xcd_barrier(const XcdBarrier& b, const int tid) {
    asm volatile("s_waitcnt vmcnt(0)" ::: "memory");
    __syncthreads();
    if (tid == 0) {
        unsigned* bar = b.bar;
        __builtin_amdgcn_s_waitcnt(0);
        unsigned nloc = b.st[0], nx = b.st[1];
        if (nloc == 0u) { xcd_barrier_complete(bar, b.x, nloc, nx); b.st[0] = nloc; b.st[1] = nx; }
        const unsigned old = xb_add(&bar[XB_XSUB(b.x)], 1u);
        const unsigned gen = old / nloc;
        if (old + 1u == (gen + 1u) * nloc) {
            __builtin_amdgcn_fence(__ATOMIC_RELEASE, "agent");
            asm volatile("s_waitcnt vmcnt(0)" ::: "memory");
            const unsigned og = xb_add(&bar[XB_TOP], 1u);
            const unsigned tg = og / nx;
            if (og + 1u == (tg + 1u) * nx) xb_add(&bar[XB_TOPGEN], 1u);
            else XB_SPIN(xb_ld(&bar[XB_TOPGEN]) == tg, bar);
            __builtin_amdgcn_fence(__ATOMIC_ACQUIRE, "agent");
            xb_add(&bar[XB_XGEN(b.x)], 1u);
            asm volatile("s_waitcnt vmcnt(0)" ::: "memory");
        } else {
            XB_SPIN(xb_ld(&bar[XB_XGEN(b.x)]) == gen, bar);
            __builtin_amdgcn_fence(__ATOMIC_ACQUIRE, "agent");
            asm volatile("s_waitcnt vmcnt(0)" ::: "memory");
        }
    }
    __syncthreads();
}

constexpr int RING_BYTES = 131072, MISC_OFF = RING_BYTES + 320, LDS_BYTES = 147456;
struct Frame {
    LAS unsigned char* lds;
    volatile LAS unsigned* MISC;
    unsigned* ctl;
    int tid, lane, wave, G, bid;
    unsigned char* ws;
    float* out;
};
constexpr int IN_OFF = RING_BYTES + 1024;
__device__ __forceinline__ const float* inptr(const LAS unsigned char* lds, int k) {
    int z = 0; asm volatile("" : "+v"(z));
    const LAS unsigned* p = (const LAS unsigned*)(lds + IN_OFF + z) + 2 * k;
    const unsigned lo = __builtin_amdgcn_readfirstlane(p[0]), hi = __builtin_amdgcn_readfirstlane(p[1]);
    return (const float*)(const GAS float*)(((unsigned long long)hi << 32) | lo); }
#define INF(F, k) inptr((F).lds, k)
#define LAUNDER(F) do { GAS unsigned char* w_ = (GAS unsigned char*)(F).ws; GAS float* o_ = (GAS float*)(F).out; int g_ = (F).G, b_ = (F).bid, wv_ = (F).wave, z_ = 0; asm volatile("" : "+s"(w_), "+s"(o_), "+s"(g_), "+s"(b_), "+s"(wv_), "+s"(z_)); \
    int l_ = (int)__builtin_amdgcn_mbcnt_hi(~0u, __builtin_amdgcn_mbcnt_lo(~0u, (unsigned)z_)); asm volatile("" : "+v"(l_)); \
    (F).ws = (unsigned char*)w_; (F).out = (float*)o_; (F).ctl = (unsigned*)(GAS unsigned*)w_; (F).G = g_; (F).bid = b_; (F).wave = wv_; (F).lane = l_; (F).tid = wv_ * 64 + l_; } while (0)
enum { I_X = 0, I_C, I_POS, I_WMOD, I_BMOD, I_NMIX, I_NFFN, I_WIN, I_PHIW1, I_PHIW2, I_PHIPOS, I_MU, I_WUP, I_W0, I_AUP, I_A0, I_GUP, I_KK, I_KA, I_RK, I_LNW, I_LNB,
       I_NNSA, I_NMOBA, I_WOUT, I_WROUTER, I_RBIAS, I_MGATE, I_MUP, I_MDOWN, I_NFINAL };

__device__ const float g_invf[32] = {1.000000000e+00f, 7.498942018e-01f, 5.623413324e-01f, 4.216965139e-01f, 3.162277639e-01f, 2.371373773e-01f, 1.778279394e-01f, 1.333521456e-01f,
    1.000000015e-01f, 7.498942316e-02f, 5.623413250e-02f, 4.216964915e-02f, 3.162277490e-02f, 2.371373773e-02f, 1.778279431e-02f, 1.333521400e-02f, 9.999999776e-03f, 7.498942316e-03f,
    5.623413250e-03f, 4.216964822e-03f, 3.162277630e-03f, 2.371373819e-03f, 1.778279431e-03f, 1.333521446e-03f, 1.000000047e-03f, 7.498941850e-04f, 5.623413017e-04f, 4.216965172e-04f,
    3.162277571e-04f, 2.371373703e-04f, 1.778279402e-04f, 1.333521504e-04f};
__device__ __forceinline__ void phase_pro(Frame& F) {
    const int* pos = (const int*)INF(F, I_POS);
    float* cosT = (float*)(F.ws + WS_COS); float* sinT = (float*)(F.ws + WS_SIN);
    for (int idx = F.bid * NTHR + F.tid; idx < T * 32; idx += F.G * NTHR) {
        const int row = idx >> 5, i = idx & 31;
        const float ang = (float)pos[row] * g_invf[i];
        float sv, cv; sincosf(ang, &sv, &cv);
        cosT[idx] = cv; sinT[idx] = sv;
    }
    LAS float* red = (LAS float*)F.lds;
    for (int chunk = F.bid; chunk < NL * 96; chunk += F.G) {
        const int l = chunk / 96, j0 = (chunk % 96) * 64;
        const float* W = INF(F, I_WMOD) + (size_t)l * D * 6144 + j0 + F.lane;
        const float* c = INF(F, I_C);
        float a0 = 0.f, a1 = 0.f;
        const int k0 = F.wave * 128;
#pragma unroll 32
        for (int k = 0; k < 128; ++k) {
            const float w = W[(size_t)(k0 + k) * 6144];
            const float c0 = c[k0 + k], c1 = c[D + k0 + k];
            a0 += w * (c0 * sigm(c0)); a1 += w * (c1 * sigm(c1));
        }
        red[(F.wave * 2 + 0) * 64 + F.lane] = a0; red[(F.wave * 2 + 1) * 64 + F.lane] = a1;
        __syncthreads();
        if (F.wave < 2) {
            float s = INF(F, I_BMOD)[l * 6144 + j0 + F.lane];
#pragma unroll
            for (int w = 0; w < 8; ++w) s += red[(w * 2 + F.wave) * 64 + F.lane];
            ((float*)(F.ws + WS_MOD))[((size_t)l * BATCH + F.wave) * 6144 + j0 + F.lane] = s;
        }
        __syncthreads();
    }
}

__device__ __forceinline__ void transpose_item(int ldw, int K, bf16_t* WT, int n0, int k0, LAS float* scr, int lane, const float* src) {
    const int n4 = lane & 7, kr = lane >> 3;
#pragma unroll
    for (int i = 0; i < 8; ++i) { const int kk = 8 * i + kr; f32x4 v = (f32x4){0.f, 0.f, 0.f, 0.f};
        if (src) { const float* p = src + (size_t)(k0 + kk) * ldw; v.x = p[0]; v.y = p[1]; v.z = p[2]; v.w = p[3]; }
        scr[kk * 33 + 4 * n4] = v.x; scr[kk * 33 + 4 * n4 + 1] = v.y; scr[kk * 33 + 4 * n4 + 2] = v.z; scr[kk * 33 + 4 * n4 + 3] = v.w; }
    LDS_WAIT(); asm volatile("" ::: "memory");
    const int c = lane & 7;
#pragma unroll
    for (int j = 0; j < 4; ++j) { const int n = (lane >> 3) + 8 * j; const LAS float* sp = scr + (8 * c) * 33 + n;
        u32x4 o; o.x = pk2(sp[0 * 33], sp[1 * 33]); o.y = pk2(sp[2 * 33], sp[3 * 33]); o.z = pk2(sp[4 * 33], sp[5 * 33]); o.w = pk2(sp[6 * 33], sp[7 * 33]);
        *(u32x4*)(WT + (size_t)(n0 + n) * K + k0 + 8 * c) = o; }
    LDS_WAIT(); asm volatile("" ::: "memory");
}
__device__ __forceinline__ const float* cm_in(const float* W, int pos) {
        const int G = pos >> 6, p = pos & 63, w = p >> 5, n = (p >> 4) & 1, q = p & 15, d = 16 * w + q + 32 * n;
        int sc;
        if (G < 6) sc = G * 64 + d; else if (G < 18) sc = 384 + (G - 6) * 64 + d; else if (G < 30) sc = 1170 + (G - 18) * 64 + d;
        else if (G < 52) sc = 1938 + (G - 30) * 64 + d; else if (G == 52 && d < 18) sc = 1152 + d; else return nullptr;
        return W + sc; }
__device__ __forceinline__ const float* cm_up(const float* Wg, const float* Wu, int pos) { const int Wd = pos >> 5, n = (pos >> 4) & 1, q = pos & 15, f = 16 * Wd + q; return (n ? Wu : Wg) + f; }

__device__ __forceinline__ void norm_rows(Frame& F, int layer, bool final_) {
    const float* xin = INF(F, I_X);
    const bf16_t* ys = (const bf16_t*)(F.ws + WS_YS);
    const float* mod = (const float*)(F.ws + WS_MOD);
    bf16_t* H = (bf16_t*)(F.ws + WS_HM);
    const int gw = F.bid * NWAVES + F.wave, NGW = F.G * NWAVES;
    for (int m = gw; m < T; m += NGW) {
        const int b = m >> 13;
        f32x4 v[4]; float ss = 0.f;
        if (layer == 0 && !final_) {
#pragma unroll
            for (int j = 0; j < 4; ++j) v[j] = *(const f32x4*)(xin + (size_t)m * D + 4 * F.lane + 256 * j);
        } else {
            const int pl = final_ ? NL - 1 : layer - 1;
            const float* g2 = mod + ((size_t)pl * BATCH + b) * 6144 + 5120;
#pragma unroll
            for (int j = 0; j < 4; ++j) {
                const int col = 4 * F.lane + 256 * j;
                f32x4 x = *(const f32x4*)(F.out + (size_t)m * D + col);
                const u32x2 a = *(const u32x2*)(ys + (size_t)m * D + col), c = *(const u32x2*)(ys + (size_t)(T + m) * D + col);
                const f32x4 g = *(const f32x4*)(g2 + col);
                x.x += g.x * (__uint_as_float(a.x << 16) + __uint_as_float(c.x << 16));
                x.y += g.y * (__uint_as_float(a.x & 0xffff0000u) + __uint_as_float(c.x & 0xffff0000u));
                x.z += g.z * (__uint_as_float(a.y << 16) + __uint_as_float(c.y << 16));
                x.w += g.w * (__uint_as_float(a.y & 0xffff0000u) + __uint_as_float(c.y & 0xffff0000u));
                v[j] = x;
                if (!final_) *(f32x4*)(F.out + (size_t)m * D + col) = x;
            }
        }
#pragma unroll
        for (int j = 0; j < 4; ++j) ss += (v[j].x * v[j].x + v[j].y * v[j].y) + (v[j].z * v[j].z + v[j].w * v[j].w);
        const float rstd = rsqrtf(wave_sum(ss, F.lane) * (1.f / D) + NORM_EPS);
#if DBG_MODE == 1
        if (final_) { float bad = 0.f;
#pragma unroll
            for (int j = 0; j < 4; ++j) { bad += (fabsf(v[j].x) <= 3e38f) ? 0.f : 1.f; bad += (fabsf(v[j].y) <= 3e38f) ? 0.f : 1.f; bad += (fabsf(v[j].z) <= 3e38f) ? 0.f : 1.f; bad += (fabsf(v[j].w) <= 3e38f) ? 0.f : 1.f; }
            bad = wave_sum(bad, F.lane); if (F.lane == 0 && bad > 0.f) atomicAdd(F.ctl + CW_DBG, (unsigned)bad); }
#endif
        if (final_) {
            const float* gn = INF(F, I_NFINAL);
#pragma unroll
            for (int j = 0; j < 4; ++j) { const int col = 4 * F.lane + 256 * j; const f32x4 g = *(const f32x4*)(gn + col);
                f32x4 o; o.x = v[j].x * rstd * g.x; o.y = v[j].y * rstd * g.y; o.z = v[j].z * rstd * g.z; o.w = v[j].w * rstd * g.w;
                *(f32x4*)(F.out + (size_t)m * D + col) = o; }
        } else {
            const float* gn = INF(F, I_NMIX) + layer * D;
            const float* sh = mod + ((size_t)layer * BATCH + b) * 6144; const float* sc = sh + 1024;
#pragma unroll
            for (int j = 0; j < 4; ++j) { const int col = 4 * F.lane + 256 * j;
                const f32x4 g = *(const f32x4*)(gn + col), s1 = *(const f32x4*)(sc + col), s0 = *(const f32x4*)(sh + col);
                u32x2 o; o.x = pk2(v[j].x * rstd * g.x * (1.f + s1.x) + s0.x, v[j].y * rstd * g.y * (1.f + s1.y) + s0.y);
                o.y = pk2(v[j].z * rstd * g.z * (1.f + s1.z) + s0.z, v[j].w * rstd * g.w * (1.f + s1.w) + s0.w);
                *(u32x2*)(H + (size_t)m * D + col) = o; }
        }
    }
}
__device__ __forceinline__ void phase_a(Frame& F, int layer, bool do_norm, bool do_conv) {
    if (do_norm) { norm_rows(F, layer, false); LAUNDER(F); }
    if (!do_conv) return;
    LAS float* scr = (LAS float*)(F.lds + F.wave * 16384);
    const int gw = F.bid * NWAVES + F.wave, NGW = F.G * NWAVES;
    constexpr int I_IN = 16 * 112, I_OUT = 16 * 32, I_UPI = 16 * 16 * 16, I_DN = 16 * 4 * 32, I_PHI = 2 * 32 * 2, I_GU = 2 * 12, I_LR = 2 * 12;
    constexpr int NIT = I_IN + I_OUT + I_UPI + I_DN + I_PHI + I_GU + I_LR;
    for (int it = gw; it < NIT; it += NGW) {
        int r = it;
        const int l31 = 4 * (F.lane & 7);
        if (r < I_IN) { const int kb = r / 112, nb = r % 112;
            transpose_item(INCOLS, D, (bf16_t*)(F.ws + WS_WIN), nb * 32, kb * 64, scr, F.lane, cm_in(INF(F, I_WIN) + (size_t)layer * D * INCOLS, nb * 32 + l31)); continue; } r -= I_IN;
        if (r < I_OUT) { const int kb = r / 32, nb = r % 32;
            transpose_item(D, D, (bf16_t*)(F.ws + WS_WOUT), nb * 32, kb * 64, scr, F.lane, INF(F, I_WOUT) + (size_t)layer * D * D + nb * 32 + l31); continue; } r -= I_OUT;
        if (r < I_UPI) { const int e = r / 256, q = r % 256, kb = q / 16, nb = q % 16;
            transpose_item(256, D, (bf16_t*)(F.ws + WS_WUP) + (size_t)e * 512 * D, nb * 32, kb * 64, scr, F.lane,
                           cm_up(INF(F, I_MGATE) + ((size_t)layer * 16 + e) * D * 256, INF(F, I_MUP) + ((size_t)layer * 16 + e) * D * 256, nb * 32 + l31)); continue; } r -= I_UPI;
        if (r < I_DN) { const int e = r / 128, q = r % 128, kb = q / 32, nb = q % 32;
            transpose_item(D, 256, (bf16_t*)(F.ws + WS_WDN) + (size_t)e * D * 256, nb * 32, kb * 64, scr, F.lane, INF(F, I_MDOWN) + ((size_t)layer * 16 + e) * 256 * D + nb * 32 + l31); continue; } r -= I_DN;
        if (r < I_PHI) { const int kv = r / 64, q = r % 64, kb = q / 2, nb = q % 2;
            transpose_item(64, 2048, (bf16_t*)(F.ws + WS_PHIW) + (size_t)kv * 64 * 2048, nb * 32, kb * 64, scr, F.lane, INF(F, I_PHIW1) + ((size_t)layer * 2 + kv) * 2048 * 64 + nb * 32 + l31); continue; } r -= I_PHI;
        if (r < I_GU) { const int kb = r / 12, nb = r % 12;
            transpose_item(384, 128, (bf16_t*)(F.ws + WS_GUPT), nb * 32, kb * 64, scr, F.lane, INF(F, I_GUP) + (size_t)layer * 128 * 384 + nb * 32 + l31); continue; } r -= I_GU;
        { const int which = r / 12, nb = r % 12;
            transpose_item(384, 64, (bf16_t*)(F.ws + (which ? WS_AUPT : WS_WUPT)), nb * 32, 0, scr, F.lane, INF(F, which ? I_AUP : I_WUP) + (size_t)layer * 64 * 384 + nb * 32 + l31); }
    }
    LAUNDER(F);
    if (F.bid == F.G - 1) {
        __syncthreads();
        LAS float* part = (LAS float*)F.lds;
#pragma unroll 1
        for (int kv = 0; kv < 2; ++kv) {
            const float* w1 = INF(F, I_PHIW1) + ((size_t)layer * 2 + kv) * 2048 * 64 + (size_t)F.wave * 256 * 64; const float* pp = INF(F, I_PHIPOS) + ((size_t)layer * 2 + kv) * 2048 + F.wave * 256;
            float a[4] = {0.f, 0.f, 0.f, 0.f};
#pragma unroll 1
            for (int k = 0; k < 256; k += 16) {
                float wv[16];
#pragma unroll
                for (int u = 0; u < 16; ++u) wv[u] = w1[(size_t)(k + u) * 64 + F.lane];
#pragma unroll
                for (int u = 0; u < 16; ++u) a[u & 3] += pp[k + u] * wv[u];
            }
            part[(F.wave * 2 + kv) * 64 + F.lane] = (a[0] + a[1]) + (a[2] + a[3]);
        }
        __syncthreads();
        if (F.wave < 2) { float sacc = 0.f;
#pragma unroll
            for (int w = 0; w < 8; ++w) sacc += part[(w * 2 + F.wave) * 64 + F.lane];
            ((float*)(F.ws + WS_PHIB))[(layer * 2 + F.wave) * 64 + F.lane] = sacc; }
    }
}

struct EpiInProj {
    static constexpr bool PERM = false, AFTER_DRAIN = false;
    bf16_t* nq; bf16_t* kv6; bf16_t* mqkv; bf16_t* rfeat; float* gate; const float* cosT; const float* sinT;
    __device__ __forceinline__ void operator()(const f32x4 (&acc)[2][2][4][2], const pg8::Unit& u, int wr, int wc, int fr_, int fq_) const {
        int z_ = 0; asm volatile("" : "+s"(z_)); int l_ = (int)__builtin_amdgcn_mbcnt_hi(~0u, __builtin_amdgcn_mbcnt_lo(~0u, (unsigned)z_)); asm volatile("" : "+v"(l_)); const int fr = l_ & 15, fq = l_ >> 4; (void)fr_; (void)fq_;
#pragma unroll
        for (int bj = 0; bj < 2; ++bj) {
            const int G = 4 * u.pn + 2 * bj + (wc >> 1), w = wc & 1;
            if (G >= 53) continue;
            const int qm = u.mask >> bj;
            const int d0 = 16 * w + 4 * fq;
            const bool rope = (G < 6) || (G == 10) || (G == 11) || (G == 14) || (G == 15) || (G >= 18 && G < 26);
            const float scl = (G < 6 || (G >= 18 && G < 22)) ? 0.125f * LOG2E : 1.0f;
#pragma unroll
            for (int ai = 0; ai < 2; ++ai) {
                if (!((qm >> (2 * ai)) & 1)) continue;
#pragma unroll
                for (int m = 0; m < 4; ++m) {
                    const int row = 256 * u.pm + 128 * ai + 64 * wr + 16 * m + fr, b = row >> 13, t = row & (SEQ - 1);
                    f32x4 x1 = acc[ai][bj][m][0], x2 = acc[ai][bj][m][1];
                    if (rope) {
                        const f32x4 c = *(const f32x4*)(cosT + (size_t)row * 32 + d0), s = *(const f32x4*)(sinT + (size_t)row * 32 + d0);
                        const f32x4 y1 = (x1 * c - x2 * s) * scl, y2 = (x2 * c + x1 * s) * scl; x1 = y1; x2 = y2;
                    }
                    if (G == 52) {
                        float* gp = gate + (size_t)row * 32;
                        *(f32x4*)(gp + d0) = x1;
                        continue;
                    }
                    bf16_t* dst;
                    if (G < 6) dst = nq + ((size_t)(b * 6 + G) * SEQ + t) * 64;
                    else if (G < 18) dst = kv6 + (size_t)((G - 6) >> 1) * KV6_STRIDE + ((size_t)(b * 2 + ((G - 6) & 1)) * SEQ + t) * 64;
                    else if (G < 30) dst = mqkv + (size_t)((G - 18) >> 2) * MQKV_STRIDE + ((size_t)(b * 4 + ((G - 18) & 3)) * SEQ + t) * 64;
                    else dst = rfeat + (size_t)row * RW + (G - 30) * 64;
                    auto sx = __builtin_amdgcn_permlane16_swap(pk2(x1.x, x1.y), pk2(x2.x, x2.y), false, false);
                    auto sy = __builtin_amdgcn_permlane16_swap(pk2(x1.z, x1.w), pk2(x2.z, x2.w), false, false);
                    u32x4 o; o.x = sx[0]; o.y = sy[0]; o.z = sx[1]; o.w = sy[1];
                    *(u32x4*)(dst + ((fq & 1) ? d0 - 4 + 32 : d0)) = o;
                }
            }
        }
    }
};
struct EpiNull {
    static constexpr bool PERM = false, AFTER_DRAIN = false;
    float* sink;
    __device__ __forceinline__ void operator()(const f32x4 (&acc)[2][2][4][2], const pg8::Unit& u, int wr, int wc, int fr_, int fq_) const {
        f32x4 s = (f32x4){0.f, 0.f, 0.f, 0.f};
#pragma unroll
        for (int ai = 0; ai < 2; ++ai)
#pragma unroll
            for (int bj = 0; bj < 2; ++bj)
#pragma unroll
                for (int m = 0; m < 4; ++m)
#pragma unroll
                    for (int n = 0; n < 2; ++n) s += acc[ai][bj][m][n];
        if (s.x + s.y + s.z + s.w == 123456.789f) sink[0] = s.x;
    }
};
struct EpiOutProj {
    static constexpr bool PERM = false, AFTER_DRAIN = false;
    const float* xold; float* xnew; const float* g1;
    __device__ __forceinline__ void operator()(const f32x4 (&acc)[2][2][4][2], const pg8::Unit& u, int wr, int wc, int fr_, int fq_) const {
        int z_ = 0; asm volatile("" : "+s"(z_)); int l_ = (int)__builtin_amdgcn_mbcnt_hi(~0u, __builtin_amdgcn_mbcnt_lo(~0u, (unsigned)z_)); asm volatile("" : "+v"(l_)); const int fr = l_ & 15, fq = l_ >> 4; (void)fr_; (void)fq_;
#pragma unroll
        for (int ai = 0; ai < 2; ++ai)
#pragma unroll
            for (int m = 0; m < 4; ++m) {
                const int row = 256 * u.pm + 128 * ai + 64 * wr + 16 * m + fr, b = row >> 13;
#pragma unroll
                for (int bj = 0; bj < 2; ++bj)
#pragma unroll
                    for (int n = 0; n < 2; ++n) {
                        if (!((u.mask >> (2 * ai + bj)) & 1)) continue;
                        const int col = 256 * u.pn + 128 * bj + 32 * wc + 16 * n + 4 * fq;
                        const f32x4 g = *(const f32x4*)(g1 + (size_t)b * 6144 + col);
                        const f32x4 xo = *(const f32x4*)(xold + (size_t)row * D + col);
                        *(f32x4*)(xnew + (size_t)row * D + col) = xo + g * acc[ai][bj][m][n];
                    }
            }
    }
};
struct EpiMoeUp {
    static constexpr bool PERM = false, AFTER_DRAIN = false;
    bf16_t* hid;
    __device__ __forceinline__ void operator()(const f32x4 (&acc)[2][2][4][2], const pg8::Unit& u, int wr, int wc, int fr_, int fq_) const {
        int z_ = 0; asm volatile("" : "+s"(z_)); int l_ = (int)__builtin_amdgcn_mbcnt_hi(~0u, __builtin_amdgcn_mbcnt_lo(~0u, (unsigned)z_)); asm volatile("" : "+v"(l_)); const int fr = l_ & 15, fq = l_ >> 4; (void)fr_; (void)fq_;
#pragma unroll
        for (int ai = 0; ai < 2; ++ai)
#pragma unroll
            for (int m = 0; m < 4; ++m) {
                const int row = 256 * u.pm + 128 * ai + 64 * wr + 16 * m + fr;
                u32x2 ob[2];
#pragma unroll
                for (int bj = 0; bj < 2; ++bj) { const f32x4 g = acc[ai][bj][m][0], up = acc[ai][bj][m][1];
                    ob[bj].x = pk2(g.x * sigm(g.x) * up.x, g.y * sigm(g.y) * up.y); ob[bj].y = pk2(g.z * sigm(g.z) * up.z, g.w * sigm(g.w) * up.w); }
                if (((u.mask >> (2 * ai)) & 3) == 3) {
                    auto sx = __builtin_amdgcn_permlane16_swap(ob[0].x, ob[1].x, false, false);
                    auto sy = __builtin_amdgcn_permlane16_swap(ob[0].y, ob[1].y, false, false);
                    u32x4 o; o.x = sx[0]; o.y = sy[0]; o.z = sx[1]; o.w = sy[1];
                    const int f0 = (fq & 1) ? 16 * (8 * u.pn + 4 + wc) + 4 * (fq - 1) : 16 * (8 * u.pn + wc) + 4 * fq;
                    *(u32x4*)(hid + (size_t)row * 256 + f0) = o;
                } else {
#pragma unroll
                    for (int bj = 0; bj < 2; ++bj) {
                        if (!((u.mask >> (2 * ai + bj)) & 1)) continue;
                        *(u32x2*)(hid + (size_t)row * 256 + 16 * (8 * u.pn + 4 * bj + wc) + 4 * fq) = ob[bj];
                    }
                }
            }
    }
};
struct EpiMoeDown {
    static constexpr bool PERM = false, AFTER_DRAIN = false;
    bf16_t* ys; const int* tile_e; const int* elist; const float* eww;
    __device__ __forceinline__ void operator()(const f32x4 (&acc)[2][2][4][2], const pg8::Unit& u, int wr, int wc, int fr_, int fq_) const {
        int z_ = 0; asm volatile("" : "+s"(z_)); int l_ = (int)__builtin_amdgcn_mbcnt_hi(~0u, __builtin_amdgcn_mbcnt_lo(~0u, (unsigned)z_)); asm volatile("" : "+v"(l_)); const int fr = l_ & 15, fq = l_ >> 4; (void)fr_; (void)fq_;
        const int e = __builtin_amdgcn_readfirstlane(ld_ctl(tile_e + u.pm)), off = __builtin_amdgcn_readfirstlane(ld_ctl(tile_e + TE_OFF + e)), cnt = __builtin_amdgcn_readfirstlane(ld_ctl(tile_e + TE_CNT + e));
        int ri[2][4]; float wv[2][4];
#pragma unroll
        for (int ai = 0; ai < 2; ++ai)
#pragma unroll
            for (int m = 0; m < 4; ++m) { const int local = 256 * u.pm + 128 * ai + 64 * wr + 16 * m + fr - off, idx = e * 16384 + (local < cnt ? local : 0); ri[ai][m] = elist[idx]; wv[ai][m] = eww[idx]; }
#pragma unroll
        for (int ai = 0; ai < 2; ++ai)
#pragma unroll
            for (int m = 0; m < 4; ++m) {
                const int local = 256 * u.pm + 128 * ai + 64 * wr + 16 * m + fr - off;
                if (local >= cnt) continue;
                const float w = wv[ai][m];
                bf16_t* dst = ys + ((size_t)(ri[ai][m] & 1) * T + (ri[ai][m] >> 1)) * D;
#pragma unroll
                for (int bj = 0; bj < 2; ++bj) {
                    if (!((u.mask >> (2 * ai + bj)) & 1)) continue;
                    const f32x4 v0 = acc[ai][bj][m][0] * w, v1 = acc[ai][bj][m][1] * w;
                    auto sx = __builtin_amdgcn_permlane16_swap(pk2(v0.x, v0.y), pk2(v1.x, v1.y), false, false);
                    auto sy = __builtin_amdgcn_permlane16_swap(pk2(v0.z, v0.w), pk2(v1.z, v1.w), false, false);
                    u32x4 o; o.x = sx[0]; o.y = sy[0]; o.z = sx[1]; o.w = sy[1];
                    const int col = 256 * u.pn + 128 * bj + 32 * wc + ((fq & 1) ? 16 + 4 * (fq - 1) : 4 * fq);
                    *(u32x4*)(dst + col) = o;
                }
            }
    }
};
template <bool GATHER_>
struct MoeOrderT {
    static constexpr bool GATHER = GATHER_;
    int ntiles, nN, G, c; const int* tile_e; size_t estride; const int* elist;
    __device__ __forceinline__ void arows(const pg8::Unit& u, const int (&RA)[2], int (&o)[2][2]) const {
        const int e = __builtin_amdgcn_readfirstlane(ld_ctl(tile_e + u.pm)), off = __builtin_amdgcn_readfirstlane(ld_ctl(tile_e + TE_OFF + e)), c = __builtin_amdgcn_readfirstlane(ld_ctl(tile_e + TE_CNT + e));
        int ri[2][2];
#pragma unroll
        for (int h = 0; h < 2; ++h)
#pragma unroll
            for (int i = 0; i < 2; ++i) { const int local = 256 * u.pm + 128 * h + RA[i] - off; ri[h][i] = elist[e * 16384 + (local < c ? local : 0)]; }
#pragma unroll
        for (int h = 0; h < 2; ++h)
#pragma unroll
            for (int i = 0; i < 2; ++i) { const int local = 256 * u.pm + 128 * h + RA[i] - off; o[h][i] = (local < c) ? (ri[h][i] >> 1) : 0; }
    }
    __device__ __forceinline__ bool next(int i, pg8::Unit& u) const { int L, f, sub; const int U = ntiles * nN;
        if ((G & 7) == 0) { const int x = c & 7, j = c >> 3, nb = G >> 3, U8 = (U + 7) >> 3, lo = x * U8, n = (lo + U8 <= U) ? U8 : (U > lo ? U - lo : 0);
            if (!pg8::tail_split(i, nb, j, n, L, f, sub)) return false; L += lo; }
        else if (!pg8::tail_split(i, G, c, U, L, f, sub)) return false;
        u.pm = L / nN; u.pn = L % nN; u.mask = (f == 1) ? 0xF : (f == 2) ? (sub ? 0xA : 0x5) : (1 << sub); return true; }
    __device__ __forceinline__ void a_ready(const pg8::Unit&) const {}
    __device__ __forceinline__ size_t boff(const pg8::Unit& u) const { return (size_t)__builtin_amdgcn_readfirstlane(ld_ctl(tile_e + u.pm)) * estride; }
    __device__ __forceinline__ void done(const pg8::Unit&) const {}
};
typedef MoeOrderT<false> MoeOrder;
typedef MoeOrderT<true> MoeGatherOrder;

__device__ __forceinline__ float gelu_tanh(float x) { const float u = 0.7978845608028654f * (x + 0.044715f * x * x * x); return 0.5f * x * (1.f + tanhf(u)); }

__device__ __forceinline__ void compress_unit(Frame& F, int layer, int u) {
    const int kvsel = u >> 5, b = (u >> 4) & 1, kvh = (u >> 3) & 1, rt = u & 7, i0 = 64 * rt;
    const bf16_t* src = (const bf16_t*)(F.ws + WS_KV6) + (size_t)kvsel * KV6_STRIDE + (size_t)(b * 2 + kvh) * SEQ * 64;
    const bf16_t* w1t = (const bf16_t*)(F.ws + WS_PHIW) + (size_t)kvsel * 64 * 2048;
    const int lane = F.lane, r = lane & 15, kg = lane >> 4;
    f32x4 acc[4][4];
#pragma unroll
    for (int a = 0; a < 4; ++a)
#pragma unroll
        for (int c = 0; c < 4; ++c) acc[a][c] = (f32x4){0.f, 0.f, 0.f, 0.f};
#pragma unroll 2
    for (int lq = 0; lq < 4; ++lq) {
        const int l = 4 * F.wave + lq;
#pragma unroll
        for (int ks = 0; ks < 2; ++ks) {
            bf16x8 af[4], bfr[4];
#pragma unroll
            for (int mt = 0; mt < 4; ++mt) af[mt] = *(const bf16x8*)(src + ((size_t)(16 * (i0 + 16 * mt + r) + l)) * 64 + 32 * ks + 8 * kg);
#pragma unroll
            for (int nt = 0; nt < 4; ++nt) bfr[nt] = *(const bf16x8*)(w1t + (size_t)(16 * nt + r) * 2048 + l * 64 + 32 * ks + 8 * kg);
#pragma unroll
            for (int mt = 0; mt < 4; ++mt)
#pragma unroll
                for (int nt = 0; nt < 4; ++nt) acc[mt][nt] = MFMA16(af[mt], bfr[nt], acc[mt][nt]);
        }
    }
    LAS float* part = (LAS float*)F.lds;
#pragma unroll
    for (int mt = 0; mt < 4; ++mt)
#pragma unroll
        for (int nt = 0; nt < 4; ++nt)
#pragma unroll
            for (int q = 0; q < 4; ++q) part[(F.wave * 64 + 16 * mt + 4 * kg + q) * 64 + 16 * nt + r] = acc[mt][nt][q];
    __syncthreads();
    const float* phib = (const float*)(F.ws + WS_PHIB) + (layer * 2 + kvsel) * 64;
    float hv[8];
    const int row = F.tid >> 3, e0 = (F.tid & 7) * 8;
#pragma unroll
    for (int k = 0; k < 8; ++k) { float s = phib[e0 + k];
#pragma unroll
        for (int w = 0; w < 8; ++w) s += part[(w * 64 + row) * 64 + e0 + k];
        hv[k] = gelu_tanh(s); }
    __syncthreads();
    LAS float* hb = (LAS float*)F.lds;
    LAS float* ob = (LAS float*)(F.lds + 32768);
#pragma unroll
    for (int k = 0; k < 8; ++k) hb[row * 65 + e0 + k] = hv[k];
    __syncthreads();
    const float* w2 = INF(F, I_PHIW2) + ((size_t)layer * 2 + kvsel) * 64 * 64;
    float o[8];
#pragma unroll
    for (int k = 0; k < 8; ++k) o[k] = 0.f;
#pragma unroll 8
    for (int e = 0; e < 64; ++e) { const float h = hb[row * 65 + e]; const f32x4 wa = *(const f32x4*)(w2 + e * 64 + e0), wb = *(const f32x4*)(w2 + e * 64 + e0 + 4);
        o[0] += h * wa.x; o[1] += h * wa.y; o[2] += h * wa.z; o[3] += h * wa.w; o[4] += h * wb.x; o[5] += h * wb.y; o[6] += h * wb.z; o[7] += h * wb.w; }
#pragma unroll
    for (int k = 0; k < 8; ++k) ob[row * 65 + e0 + k] = o[k];
    __syncthreads();
    const int i = i0 + row;
    bf16_t* dst = (bf16_t*)(F.ws + (kvsel ? WS_VCMP : WS_KCMP)) + ((size_t)(b * 2 + kvh) * 512 + i) * 64 + e0;
    float y[8];
    if (i >= 511) {
#pragma unroll
        for (int k = 0; k < 8; ++k) y[k] = 0.f;
    } else if (kvsel == 0) {
        const size_t pr = (size_t)b * SEQ + 16 * i + 31;
        const float* cs = (const float*)(F.ws + WS_COS) + pr * 32; const float* sn = (const float*)(F.ws + WS_SIN) + pr * 32;
#pragma unroll
        for (int k = 0; k < 8; ++k) { const int d = e0 + k, f = d & 31; const float x1 = ob[row * 65 + f], x2 = ob[row * 65 + f + 32];
            y[k] = (d < 32) ? (x1 * cs[f] - x2 * sn[f]) : (x2 * cs[f] + x1 * sn[f]); }
    } else {
#pragma unroll
        for (int k = 0; k < 8; ++k) y[k] = o[k];
    }
    u32x4 pk; pk.x = pk2(y[0], y[1]); pk.y = pk2(y[2], y[3]); pk.z = pk2(y[4], y[5]); pk.w = pk2(y[6], y[7]);
    *(u32x4*)dst = pk;
    __syncthreads();
}
__device__ __forceinline__ void kmean_task(Frame& F, int wt) {
    const int b = wt >> 7, h = (wt >> 5) & 3, blk = wt & 31, sub = F.lane >> 3, ch = F.lane & 7;
    const bf16_t* mk = (const bf16_t*)(F.ws + WS_MQKV) + MQKV_STRIDE + ((size_t)(b * 4 + h) * SEQ + 256 * blk) * 64;
    float a[8];
#pragma unroll
    for (int k = 0; k < 8; ++k) a[k] = 0.f;
#pragma unroll 8
    for (int it = 0; it < 32; ++it) {
        const u32x4 v = *(const u32x4*)(mk + (size_t)(8 * it + sub) * 64 + 8 * ch);
        a[0] += __uint_as_float(v.x << 16); a[1] += __uint_as_float(v.x & 0xffff0000u); a[2] += __uint_as_float(v.y << 16); a[3] += __uint_as_float(v.y & 0xffff0000u);
        a[4] += __uint_as_float(v.z << 16); a[5] += __uint_as_float(v.z & 0xffff0000u); a[6] += __uint_as_float(v.w << 16); a[7] += __uint_as_float(v.w & 0xffff0000u);
    }
#pragma unroll
    for (int k = 0; k < 8; ++k) { a[k] += shx(a[k], 8, F.lane); a[k] += shx(a[k], 16, F.lane); a[k] += shx(a[k], 32, F.lane); a[k] *= (1.f / 256.f); }
    if (sub == 0) { u32x4 o; o.x = pk2(a[0], a[1]); o.y = pk2(a[2], a[3]); o.z = pk2(a[4], a[5]); o.w = pk2(a[6], a[7]);
        *(u32x4*)((bf16_t*)(F.ws + WS_KMEAN) + ((size_t)(b * 4 + h) * 32 + blk) * 64 + 8 * ch) = o; }
}

constexpr int R1_TASK_OFF = 32768, R1_TASK_BYTES = 12288;
__device__ __forceinline__ unsigned bf_hi(float x) { return __float_as_uint(x) >> 16; }
__device__ __forceinline__ void r1_block(Frame& F, int layer, int bt) {
    const int chain = bt >> 4, b = chain / 6, h = chain % 6, lane0 = F.lane;
    const int chunk = 8 * (bt & 15) + F.wave, task = chain * 128 + chunk;
    LAS float* tb = (LAS float*)(F.lds + R1_TASK_OFF + F.wave * R1_TASK_BYTES);
    LAS float* Lr = tb; LAS float* Lw = tb + 512; LAS float* Lk = tb + 1024; LAS float* Lkk = tb + 1536; LAS float* Lbb = tb + 2048; LAS float* Lv = tb + 2560;
    const bf16_t* rf = (const bf16_t*)(F.ws + WS_RFEAT);
    const float* mu = INF(F, I_MU) + layer * RW;
    float* bonus = (float*)(F.ws + WS_BONUS);
    bf16_t* ytil = (bf16_t*)(F.ws + WS_YT) + (size_t)task * 4096; bf16_t* y0o = (bf16_t*)(F.ws + WS_Y0) + (size_t)task * 4096;
    bf16_t* lora = (bf16_t*)(F.ws + (task < 896 ? (size_t)242 * MiB + (size_t)task * 16384 : task < 1344 ? WS_WIN + (size_t)(task - 896) * 16384 : WS_ROUTE + (size_t)(task - 1344) * 16384));
    {
        const int c31 = lane0 & 31, hi = lane0 >> 5;
        f32x16 aw[2][2], aa[2][2];
#pragma unroll
        for (int mt = 0; mt < 2; ++mt)
#pragma unroll
            for (int nt = 0; nt < 2; ++nt)
#pragma unroll
                for (int r = 0; r < 16; ++r) { aw[mt][nt][r] = 0.f; aa[mt][nt][r] = 0.f; }
        const bf16_t* wt = (const bf16_t*)(F.ws + WS_WUPT) + (size_t)(h * 64) * 64; const bf16_t* at = (const bf16_t*)(F.ws + WS_AUPT) + (size_t)(h * 64) * 64;
#pragma unroll
        for (int ks = 0; ks < 4; ++ks) {
            const int j0 = 16 * ks + 8 * hi;
            bf16x8 fw[2], fa[2], bw[2], ba[2];
#pragma unroll
            for (int nt = 0; nt < 2; ++nt) { bw[nt] = *(const bf16x8*)(wt + (32 * nt + c31) * 64 + j0); ba[nt] = *(const bf16x8*)(at + (32 * nt + c31) * 64 + j0); }
#pragma unroll
            for (int mt = 0; mt < 2; ++mt) {
                const int t = 64 * chunk + 32 * mt + c31; const int rowi = b * SEQ + t;
                const u32x4 cw = *(const u32x4*)(rf + (size_t)rowi * RW + 1152 + j0), ca = *(const u32x4*)(rf + (size_t)rowi * RW + 1216 + j0);
                u32x4 pw = (u32x4){0u, 0u, 0u, 0u}, pa = (u32x4){0u, 0u, 0u, 0u};
                if (t > 0) { pw = *(const u32x4*)(rf + (size_t)(rowi - 1) * RW + 1152 + j0); pa = *(const u32x4*)(rf + (size_t)(rowi - 1) * RW + 1216 + j0); }
                const f32x4 mw0 = *(const f32x4*)(mu + 1152 + j0), mw1 = *(const f32x4*)(mu + 1152 + j0 + 4), ma0 = *(const f32x4*)(mu + 1216 + j0), ma1 = *(const f32x4*)(mu + 1216 + j0 + 4);
                const float mwv[8] = {mw0.x, mw0.y, mw0.z, mw0.w, mw1.x, mw1.y, mw1.z, mw1.w}, mav[8] = {ma0.x, ma0.y, ma0.z, ma0.w, ma1.x, ma1.y, ma1.z, ma1.w};
                const unsigned cwv[4] = {cw.x, cw.y, cw.z, cw.w}, pwv[4] = {pw.x, pw.y, pw.z, pw.w}, cav[4] = {ca.x, ca.y, ca.z, ca.w}, pav[4] = {pa.x, pa.y, pa.z, pa.w};
                float xw[8], xa[8];
#pragma unroll
                for (int k = 0; k < 4; ++k) {
                    const float c0 = __uint_as_float(cwv[k] << 16), c1 = __uint_as_float(cwv[k] & 0xffff0000u), p0 = __uint_as_float(pwv[k] << 16), p1 = __uint_as_float(pwv[k] & 0xffff0000u);
                    xw[2 * k] = tanh_fast(c0 + (p0 - c0) * mwv[2 * k]); xw[2 * k + 1] = tanh_fast(c1 + (p1 - c1) * mwv[2 * k + 1]);
                    const float d0 = __uint_as_float(cav[k] << 16), d1 = __uint_as_float(cav[k] & 0xffff0000u), q0 = __uint_as_float(pav[k] << 16), q1 = __uint_as_float(pav[k] & 0xffff0000u);
                    xa[2 * k] = d0 + (q0 - d0) * mav[2 * k]; xa[2 * k + 1] = d1 + (q1 - d1) * mav[2 * k + 1];
                }
                u32x4 uw, ua; uw.x = pk2(xw[0], xw[1]); uw.y = pk2(xw[2], xw[3]); uw.z = pk2(xw[4], xw[5]); uw.w = pk2(xw[6], xw[7]);
                ua.x = pk2(xa[0], xa[1]); ua.y = pk2(xa[2], xa[3]); ua.z = pk2(xa[4], xa[5]); ua.w = pk2(xa[6], xa[7]);
                fw[mt] = __builtin_bit_cast(bf16x8, uw); fa[mt] = __builtin_bit_cast(bf16x8, ua);
            }
#pragma unroll
            for (int mt = 0; mt < 2; ++mt)
#pragma unroll
                for (int nt = 0; nt < 2; ++nt) { aw[mt][nt] = MFMA32(fw[mt], bw[nt], aw[mt][nt]); aa[mt][nt] = MFMA32(fa[mt], ba[nt], aa[mt][nt]); }
        }
#pragma unroll
        for (int mt = 0; mt < 2; ++mt)
#pragma unroll
            for (int nt = 0; nt < 2; ++nt)
#pragma unroll
                for (int r = 0; r < 16; ++r) { const int tl = 32 * mt + (r & 3) + 8 * (r >> 2) + 4 * hi;
                    lora[tl * 64 + 32 * nt + c31] = f2bf(aw[mt][nt][r]); lora[4096 + tl * 64 + 32 * nt + c31] = f2bf(aa[mt][nt][r]); }
        asm volatile("s_waitcnt vmcnt(0)" ::: "memory");
    }
    float Wrun = 1.f;
    f32x16 XP[2][2], XZ[2][2];
    { const int c31 = lane0 & 31, hi = lane0 >> 5;
#pragma unroll
      for (int mt = 0; mt < 2; ++mt)
#pragma unroll
          for (int nt = 0; nt < 2; ++nt)
#pragma unroll
              for (int r = 0; r < 16; ++r) { XP[mt][nt][r] = (32 * mt + (r & 3) + 8 * (r >> 2) + 4 * hi == 32 * nt + c31) ? 1.f : 0.f; XZ[mt][nt][r] = 0.f; } }
#pragma unroll 1
    for (int sub = 0; sub < 8; ++sub) {
        int lane = lane0, hc = h * 64 + lane0; asm volatile("" : "+v"(lane), "+v"(hc));
#pragma unroll 1
        for (int half = 0; half < 2; ++half) {
            float rs4[4], ks4[4], vs4[4], aw4[4], aa4[4];
            const float mu_r = mu[hc], mu_k = mu[384 + hc], mu_v = mu[768 + hc];
            const float w0 = INF(F, I_W0)[layer * 384 + hc], a0 = INF(F, I_A0)[layer * 384 + hc];
#pragma unroll
            for (int q = 0; q < 4; ++q) {
                const int tl = 8 * sub + 4 * half + q, t = 64 * chunk + tl; const int rowi = b * SEQ + t;
                const bf16_t* cur = rf + (size_t)rowi * RW; const bf16_t* prv = cur - RW; const bool hp = t > 0;
                const float rc = bf2f(cur[hc]), kc = bf2f(cur[384 + hc]), vc = bf2f(cur[768 + hc]);
                const float rp = hp ? bf2f(prv[hc]) : 0.f, kp = hp ? bf2f(prv[384 + hc]) : 0.f, vp = hp ? bf2f(prv[768 + hc]) : 0.f;
                rs4[q] = rc + (rp - rc) * mu_r; ks4[q] = kc + (kp - kc) * mu_k; vs4[q] = vc + (vp - vc) * mu_v;
                aw4[q] = w0 + bf2f(lora[tl * 64 + lane]); aa4[q] = a0 + bf2f(lora[4096 + tl * 64 + lane]);
            }
            const float k_k = INF(F, I_KK)[layer * 384 + hc], k_a = INF(F, I_KA)[layer * 384 + hc], r_k = INF(F, I_RK)[layer * 384 + hc];
#pragma unroll
            for (int q = 0; q < 4; ++q) {
                const int tt = 4 * half + q; const int rowi = b * SEQ + 64 * chunk + 8 * sub + tt;
                const float dec = __expf(-0.606531f * sigm(aw4[q])), a = sigm(aa4[q]);
                float kk = ks4[q] * k_k; const float n2 = wave_sum(kk * kk, lane); kk = kk * __builtin_amdgcn_rsqf(fmaxf(n2, 1e-24f));
                const float km = ks4[q] * (1.f + (a - 1.f) * k_a);
                const float bn = wave_sum(rs4[q] * km * r_k, lane);
                const float Wprev = Wrun; Wrun *= dec; const float iW = __builtin_amdgcn_rcpf(Wrun);
                Lr[tt * 64 + lane] = rs4[q] * Wrun; Lk[tt * 64 + lane] = km * iW; Lkk[tt * 64 + lane] = -(kk * Wprev); Lbb[tt * 64 + lane] = kk * a * iW; Lv[tt * 64 + lane] = vs4[q];
                if (lane == 0) bonus[(size_t)rowi * 8 + h] = bn;
            }
        }
        LDS_WAIT(); asm volatile("" ::: "memory");
        const int c31 = lane & 31, hi = lane >> 5;
#pragma unroll 1
        for (int tt = 0; tt < 8; ++tt) {
            f32x4 k4[2][4], r4[2][4];
#pragma unroll
            for (int mt = 0; mt < 2; ++mt)
#pragma unroll
                for (int rq = 0; rq < 4; ++rq) { const int c0 = tt * 64 + 32 * mt + 8 * rq + 4 * hi;
                    k4[mt][rq] = *(const LAS f32x4*)(Lkk + c0); r4[mt][rq] = *(const LAS f32x4*)(Lr + c0); }
            float saP[2], saZ[2];
#pragma unroll
            for (int nt = 0; nt < 2; ++nt) { f32x2_t p2 = {0.f, 0.f}, z2 = {0.f, 0.f};
#pragma unroll
                for (int mt = 0; mt < 2; ++mt)
#pragma unroll
                    for (int r = 0; r < 16; r += 2) { const f32x2_t kk2 = {k4[mt][r >> 2][r & 3], k4[mt][r >> 2][(r & 3) + 1]};
                        const f32x2_t xp2 = {XP[mt][nt][r], XP[mt][nt][r + 1]}, xz2 = {XZ[mt][nt][r], XZ[mt][nt][r + 1]};
                        p2 = __builtin_elementwise_fma(xp2, kk2, p2); z2 = __builtin_elementwise_fma(xz2, kk2, z2); }
                float p = p2.x + p2.y, z = z2.x + z2.y;
                p = half_sum32(p); z = half_sum32(z); saP[nt] = p; saZ[nt] = z; }
            bf16x8 af[2], bP[2], bZ[2];
#pragma unroll
            for (int mt = 0; mt < 2; ++mt) { const float bbv = Lbb[tt * 64 + 32 * mt + c31], kv = Lk[tt * 64 + 32 * mt + c31];
                const unsigned bh = bf_hi(bbv), kh = bf_hi(kv); const unsigned bl = bf_hi(bbv - __uint_as_float(bh << 16)), kl = bf_hi(kv - __uint_as_float(kh << 16));
                u32x4 u; u.x = bh | (bl << 16); u.y = bh | (kh << 16); u.z = kl | (kh << 16); u.w = 0u;
                if (hi) u = (u32x4){0u, 0u, 0u, 0u};
                af[mt] = __builtin_bit_cast(bf16x8, u); }
#pragma unroll
            for (int nt = 0; nt < 2; ++nt) { const float vv = Lv[tt * 64 + 32 * nt + c31];
                const unsigned ph = bf_hi(saP[nt]), zh = bf_hi(saZ[nt]), vh = bf_hi(vv);
                const unsigned pl = bf_hi(saP[nt] - __uint_as_float(ph << 16)), zl = bf_hi(saZ[nt] - __uint_as_float(zh << 16)), vl = bf_hi(vv - __uint_as_float(vh << 16));
                u32x4 up, uz; up.x = ph | (ph << 16); up.y = pl; up.z = 0u; up.w = 0u;
                uz.x = zh | (zh << 16); uz.y = zl | (vh << 16); uz.z = vh | (vl << 16); uz.w = 0u;
                if (hi) { up = (u32x4){0u, 0u, 0u, 0u}; uz = (u32x4){0u, 0u, 0u, 0u}; }
                bP[nt] = __builtin_bit_cast(bf16x8, up); bZ[nt] = __builtin_bit_cast(bf16x8, uz); }
#pragma unroll
            for (int mt = 0; mt < 2; ++mt)
#pragma unroll
                for (int nt = 0; nt < 2; ++nt) { XP[mt][nt] = MFMA32(af[mt], bP[nt], XP[mt][nt]); XZ[mt][nt] = MFMA32(af[mt], bZ[nt], XZ[mt][nt]); }
#pragma unroll
            for (int nt = 0; nt < 2; ++nt) { f32x2_t p2 = {0.f, 0.f}, z2 = {0.f, 0.f};
#pragma unroll
                for (int mt = 0; mt < 2; ++mt)
#pragma unroll
                    for (int r = 0; r < 16; r += 2) { const f32x2_t rr2 = {r4[mt][r >> 2][r & 3], r4[mt][r >> 2][(r & 3) + 1]};
                        const f32x2_t xp2 = {XP[mt][nt][r], XP[mt][nt][r + 1]}, xz2 = {XZ[mt][nt][r], XZ[mt][nt][r + 1]};
                        p2 = __builtin_elementwise_fma(xp2, rr2, p2); z2 = __builtin_elementwise_fma(xz2, rr2, z2); }
                float p = p2.x + p2.y, z = z2.x + z2.y;
                p = half_sum32(p); z = half_sum32(z);
                if (hi == 0) { ytil[(8 * sub + tt) * 64 + 32 * nt + c31] = f2bf(p); y0o[(8 * sub + tt) * 64 + 32 * nt + c31] = f2bf(z); } }
        }
    }
    int lane_e = lane0; asm volatile("" : "+v"(lane_e));
    Lw[lane_e] = Wrun; LDS_WAIT(); asm volatile("" ::: "memory");
    { const int hi_ = lane_e >> 5;
#pragma unroll
      for (int mt = 0; mt < 2; ++mt)
#pragma unroll
          for (int rq = 0; rq < 4; ++rq) { const f32x4 wl = *(const LAS f32x4*)(Lw + 32 * mt + 8 * rq + 4 * hi_);
#pragma unroll
              for (int nt = 0; nt < 2; ++nt)
#pragma unroll
                  for (int k = 0; k < 4; ++k) { XP[mt][nt][4 * rq + k] *= wl[k]; XZ[mt][nt][4 * rq + k] *= wl[k]; } } }
    { const int c31 = lane_e & 31, hi = lane_e >> 5;
      bf16_t* PT = (bf16_t*)(F.ws + WS_PT) + (size_t)task * 4096;
      bf16_t* ZP = (bf16_t*)(F.ws + WS_ZS) + (size_t)task * 4096;
#pragma unroll
      for (int mt = 0; mt < 2; ++mt)
#pragma unroll
          for (int nt = 0; nt < 2; ++nt) {
#pragma unroll
              for (int r = 0; r < 16; ++r) PT[(32 * mt + (r & 3) + 8 * (r >> 2) + 4 * hi) * 64 + 32 * nt + c31] = f2bf(XP[mt][nt][r]);
              u32x4 a, c2; a.x = pk2(XZ[mt][nt][0], XZ[mt][nt][1]); a.y = pk2(XZ[mt][nt][2], XZ[mt][nt][3]); a.z = pk2(XZ[mt][nt][4], XZ[mt][nt][5]); a.w = pk2(XZ[mt][nt][6], XZ[mt][nt][7]);
              c2.x = pk2(XZ[mt][nt][8], XZ[mt][nt][9]); c2.y = pk2(XZ[mt][nt][10], XZ[mt][nt][11]); c2.z = pk2(XZ[mt][nt][12], XZ[mt][nt][13]); c2.w = pk2(XZ[mt][nt][14], XZ[mt][nt][15]);
              *(u32x4*)(ZP + ((mt * 2 + nt) * 64 + lane_e) * 16) = a; *(u32x4*)(ZP + ((mt * 2 + nt) * 64 + lane_e) * 16 + 8) = c2; } }
    __syncthreads();
}
constexpr int CW_PREP = 768;
constexpr int CW_R1DONE = 896;
__device__ __forceinline__ void publish_count(Frame& F, unsigned* word) {
    asm volatile("s_waitcnt vmcnt(0)" ::: "memory"); __syncthreads();
    if (F.tid == 0) { __builtin_amdgcn_fence(__ATOMIC_RELEASE, "agent"); asm volatile("s_waitcnt vmcnt(0)" ::: "memory"); (void)__hip_atomic_fetch_add(word, 1u, RLX_AGENT); }
}
__device__ __forceinline__ void await_count(Frame& F, unsigned* word, unsigned want) {
    if (F.tid == 0) { unsigned sp = 0; while ((unsigned)__builtin_amdgcn_readfirstlane(__hip_atomic_load(word, RLX_AGENT)) < want) { __builtin_amdgcn_s_sleep(4); if (++sp > (1u << 24)) break; }
        __builtin_amdgcn_fence(__ATOMIC_ACQUIRE, "agent"); asm volatile("s_waitcnt vmcnt(0)" ::: "memory"); }
    __syncthreads();
}
__device__ __forceinline__ void phase_c(Frame& F, int layer) {
    if (F.bid < 192) r1_block(F, layer, F.bid);
    else { compress_unit(F, layer, F.bid - 192); LAUNDER(F); if (F.bid < 224) kmean_task(F, (F.bid - 192) * 8 + F.wave); }
    LAUNDER(F);
    publish_count(F, F.ctl + ((F.bid < 192) ? CW_R1DONE + 64 * layer + (F.bid >> 4) : CW_PREP + 64 * layer));
}

constexpr int KP = 72;
constexpr int TILE_B = 64 * KP * 2;
constexpr int AT_K0 = 0, AT_V0 = 2 * TILE_B;
constexpr int AT_IMP = 4 * TILE_B;
constexpr int AT_MISC = AT_IMP + 8 * 8192;
constexpr int AT_KMEAN = AT_MISC + 256;
constexpr int R2_SBUF = 0;

__device__ __forceinline__ bf16x8 lds_frag(const LAS bf16_t* tile, int row, int col) { return *(const LAS bf16x8*)(tile + row * KP + col); }
__device__ __forceinline__ s16x4 lds_tr(const LAS bf16_t* p) { return __builtin_bit_cast(s16x4, __builtin_amdgcn_ds_read_tr16_b64_v4i16((LAS v4i16_t*)p)); }
__device__ __forceinline__ bf16x8 cat8(s16x4 a, s16x4 b) { bf16x8 r; r[0] = a[0]; r[1] = a[1]; r[2] = a[2]; r[3] = a[3]; r[4] = b[0]; r[5] = b[1]; r[6] = b[2]; r[7] = b[3]; return r; }
__device__ __forceinline__ bf16x8 pack8(const f32x4& a, const f32x4& b) { u32x4 u; u.x = pk2(a.x, a.y); u.y = pk2(a.z, a.w); u.z = pk2(b.x, b.y); u.w = pk2(b.z, b.w); return __builtin_bit_cast(bf16x8, u); }

template <int NH>
__device__ __forceinline__ void qk_tile(const LAS bf16_t* Kt, const bf16x8 (&qf)[NH][2], f32x4 (&st)[NH][4], const float (&cm)[NH], int lane, const bool (&keep)[NH]) {
    const int r = lane & 15, kg = lane >> 4;
    f32x4 ci[NH];
#pragma unroll
    for (int g = 0; g < NH; ++g) { const float c = keep[g] ? cm[g] : -INFINITY; ci[g] = (f32x4){c, c, c, c}; }
#pragma unroll
    for (int kt = 0; kt < 4; ++kt) {
        const bf16x8 k0 = lds_frag(Kt, 16 * kt + r, 8 * kg), k1 = lds_frag(Kt, 16 * kt + r, 32 + 8 * kg);
#pragma unroll
        for (int g = 0; g < NH; ++g) { f32x4 z = MFMA16(k0, qf[g][0], ci[g]); st[g][kt] = MFMA16(k1, qf[g][1], z); }
    }
}
template <int NH, bool DO_V>
__device__ __forceinline__ void pv_tile(const LAS bf16_t* Vt, const f32x4 (&p)[NH][4], f32x4 (&o)[NH][4], f32x4 (&lacc)[NH], int lane) {
    const int kg = lane >> 4, rr = (lane & 15) >> 2, cc = 4 * (lane & 3);
    const u32x4 one4 = (u32x4){0x3f803f80u, 0x3f803f80u, 0x3f803f80u, 0x3f803f80u};
    const bf16x8 ones = __builtin_bit_cast(bf16x8, one4);
#pragma unroll
    for (int i = 0; i < 2; ++i) {
        bf16x8 pf[NH];
#pragma unroll
        for (int g = 0; g < NH; ++g) { pf[g] = pack8(p[g][2 * i], p[g][2 * i + 1]); lacc[g] = MFMA16(ones, pf[g], lacc[g]); }
        if (DO_V) {
#pragma unroll
            for (int dt = 0; dt < 4; ++dt) {
                const s16x4 lo = lds_tr(Vt + (32 * i + 4 * kg + rr) * KP + 16 * dt + cc), hi = lds_tr(Vt + (32 * i + 16 + 4 * kg + rr) * KP + 16 * dt + cc);
                const bf16x8 vf = cat8(lo, hi);
#pragma unroll
                for (int g = 0; g < NH; ++g) o[g][dt] = MFMA16(vf, pf[g], o[g][dt]);
            }
        }
    }
}
__device__ __forceinline__ void softmax_tile(f32x4 (&st)[4], f32x4 (&o)[4], f32x4& lacc, float& mref, int lane) {
    float mx = -INFINITY;
#pragma unroll
    for (int kt = 0; kt < 4; ++kt) mx = fmaxf(fmaxf(mx, fmaxf(st[kt].x, st[kt].y)), fmaxf(st[kt].z, st[kt].w));
    mx = fmaxf(mx, shx(mx, 16, lane)); mx = fmaxf(mx, shx(mx, 32, lane));
    const bool fresh = (mref == -INFINITY);
    if (__any((fresh && mx > -INFINITY) || mx > 8.0f)) {
        const float d = fresh ? ((mx == -INFINITY) ? 0.f : mx) : fmaxf(mx, 0.f);
        const float alpha = fresh ? 1.f : __builtin_amdgcn_exp2f(-d);
        mref = fresh ? mx : mref + d;
        lacc = lacc * alpha;
#pragma unroll
        for (int dt = 0; dt < 4; ++dt) o[dt] = o[dt] * alpha;
#pragma unroll
        for (int kt = 0; kt < 4; ++kt) st[kt] = st[kt] - d;
    }
#pragma unroll
    for (int kt = 0; kt < 4; ++kt) {
        st[kt].x = __builtin_amdgcn_exp2f(st[kt].x); st[kt].y = __builtin_amdgcn_exp2f(st[kt].y);
        st[kt].z = __builtin_amdgcn_exp2f(st[kt].z); st[kt].w = __builtin_amdgcn_exp2f(st[kt].w);
    }
}
#define MX2(a, b) __builtin_elementwise_maximum((float)(a), (float)(b))
#define MX3(a, b, c) MX2(MX2(a, b), c)
template <int NH>
__device__ __forceinline__ void softmax_tiles(f32x4 (&st)[NH][4], f32x4 (&o)[NH][4], f32x4 (&lacc)[NH], float (&mref)[NH], float (&cm)[NH], int lane) {
    float mx[NH];
#pragma unroll
    for (int g = 0; g < NH; ++g) {
        float a = MX3(st[g][0].x, st[g][0].y, st[g][0].z), c = MX3(st[g][2].x, st[g][2].y, st[g][2].z);
        a = MX3(a, st[g][0].w, st[g][1].x); c = MX3(c, st[g][2].w, st[g][3].x);
        a = MX3(a, st[g][1].y, st[g][1].z); c = MX3(c, st[g][3].y, st[g][3].z);
        mx[g] = MX3(MX3(a, st[g][1].w, st[g][3].w), c, c); }
#pragma unroll
    for (int g = 0; g < NH; ++g)
#pragma unroll
        for (int kt = 0; kt < 4; ++kt) {
            st[g][kt].x = __builtin_amdgcn_exp2f(st[g][kt].x); st[g][kt].y = __builtin_amdgcn_exp2f(st[g][kt].y);
            st[g][kt].z = __builtin_amdgcn_exp2f(st[g][kt].z); st[g][kt].w = __builtin_amdgcn_exp2f(st[g][kt].w);
        }
#pragma unroll
    for (int g = 0; g < NH; ++g) { const unsigned u = __float_as_uint(mx[g]); auto a = __builtin_amdgcn_permlane16_swap(u, u, false, false); mx[g] = MX2(__uint_as_float(a[0]), __uint_as_float(a[1])); }
#pragma unroll
    for (int g = 0; g < NH; ++g) { const unsigned u = __float_as_uint(mx[g]); auto a = __builtin_amdgcn_permlane32_swap(u, u, false, false); mx[g] = MX2(__uint_as_float(a[0]), __uint_as_float(a[1])); }
    bool need = false;
#pragma unroll
    for (int g = 0; g < NH; ++g) need = need | (((mref[g] == -INFINITY) & (mx[g] > -INFINITY)) | (mx[g] > 8.0f));
    if (__any(need)) {
#pragma unroll
        for (int g = 0; g < NH; ++g) {
            const bool fresh = (mref[g] == -INFINITY);
            const float d = fresh ? ((mx[g] == -INFINITY) ? 0.f : fmaxf(mx[g], -100.f)) : fmaxf(mx[g], 0.f);
            const float pf = __builtin_amdgcn_exp2f(-d);
            const float alpha = fresh ? 1.f : pf;
            mref[g] = fresh ? ((mx[g] == -INFINITY) ? -INFINITY : d) : mref[g] + d;
            cm[g] = (mref[g] == -INFINITY) ? 0.f : -mref[g];
            lacc[g] = lacc[g] * alpha;
#pragma unroll
            for (int dt = 0; dt < 4; ++dt) o[g][dt] = o[g][dt] * alpha;
#pragma unroll
            for (int kt = 0; kt < 4; ++kt) st[g][kt] = st[g][kt] * pf;
        }
    }
}
__device__ __forceinline__ void acc_pk(u32x2& d, const f32x4& v) {
    const float a = __uint_as_float(d.x << 16) + v.x, b = __uint_as_float(d.x & 0xffff0000u) + v.y, c = __uint_as_float(d.y << 16) + v.z, e = __uint_as_float(d.y & 0xffff0000u) + v.w;
    d.x = pk2(a, b); d.y = pk2(c, e); }
__device__ __forceinline__ u32x4 tile_load(const bf16_t* g, int tid) { const int off = (tid >> 3) * 64 + (tid & 7) * 8; return *(const u32x4*)(g + off); }
__device__ __forceinline__ void tile_store(LAS bf16_t* t, int tid, u32x4 v) { *(LAS u32x4*)(t + (tid >> 3) * KP + (tid & 7) * 8) = v; }

__device__ __forceinline__ void nsa_task(Frame& F, int b, int kvh, int J) {
    const int lane = F.lane, tid = F.tid, wv = F.wave, q = lane & 15, kg = lane >> 4;
    const int t0 = 128 * J, tw0 = t0 + 16 * wv, tq_abs = tw0 + q, cur = tw0 >> 6, tq = tq_abs & 63;
    LAS bf16_t* Kb = (LAS bf16_t*)(F.lds + AT_K0); LAS bf16_t* Vb = (LAS bf16_t*)(F.lds + AT_V0);
    LAS float* imp = (LAS float*)(F.lds + AT_IMP + wv * 8192);
    const bf16_t* kvbase = (const bf16_t*)(F.ws + WS_KV6);
    const size_t slab = (size_t)(b * 2 + kvh) * SEQ * 64;
    const bf16_t* Kcmp = (const bf16_t*)(F.ws + WS_KCMP) + (size_t)(b * 2 + kvh) * 512 * 64;
    const bf16_t* Vcmp = (const bf16_t*)(F.ws + WS_VCMP) + (size_t)(b * 2 + kvh) * 512 * 64;
    const bf16_t* Ks = kvbase + 2 * KV6_STRIDE + slab; const bf16_t* Vs = kvbase + 3 * KV6_STRIDE + slab;
    const bf16_t* Kw = kvbase + 4 * KV6_STRIDE + slab; const bf16_t* Vw = kvbase + 5 * KV6_STRIDE + slab;
    bf16x8 qf[3][2];
#pragma unroll
    for (int g = 0; g < 3; ++g) { const bf16_t* qp = (const bf16_t*)(F.ws + WS_NQ) + (((b * 6 + 3 * kvh + g) * SEQ + tq_abs) * 64 + 8 * kg);
        qf[g][0] = *(const bf16x8*)qp; qf[g][1] = *(const bf16x8*)(qp + 32); }
#define NSA_GATEP ((const float*)(F.ws + WS_GATE) + ((b * SEQ + tq_abs) * 32 + 9 * kvh))
    for (int i = lane; i < 2048; i += 64) imp[i] = 0.f;
    const int imax_blk = (t0 + 127 - 31) >> 4;
    const int ntc = (imax_blk >> 6) + 1;
    const int imax_w = (tw0 + 15 >= 31) ? ((tw0 + 15 - 31) >> 4) : -1;
    const int ivis = (tq_abs >= 31) ? ((tq_abs - 31) >> 4) : -1;
    float m[3] = {-INFINITY, -INFINITY, -INFINITY}; float cm[3] = {0.f, 0.f, 0.f};
    f32x4 lacc[3] = {(f32x4){0.f, 0.f, 0.f, 0.f}, (f32x4){0.f, 0.f, 0.f, 0.f}, (f32x4){0.f, 0.f, 0.f, 0.f}};
    f32x4 st[3][4];
    f32x4 ob[3][4];
    const bool keep3[3] = {true, true, true};
#pragma unroll
    for (int g = 0; g < 3; ++g)
#pragma unroll
        for (int dt = 0; dt < 4; ++dt) ob[g][dt] = (f32x4){0.f, 0.f, 0.f, 0.f};
    {
        u32x4 kr = tile_load(Kcmp, tid);
        tile_store(Kb, tid, kr); __syncthreads();
        for (int ct = 0; ct < ntc; ++ct) {
            if (ct + 1 < ntc) kr = tile_load(Kcmp + (ct + 1) * 4096, tid);
            const LAS bf16_t* Kt = Kb + (ct & 1) * (TILE_B / 2);
            if (64 * ct <= imax_w) {
                qk_tile<3>(Kt, qf, st, cm, lane, keep3);
#pragma unroll
                for (int g = 0; g < 3; ++g) {
#pragma unroll
                    for (int kt = 0; kt < 4; ++kt)
#pragma unroll
                        for (int r = 0; r < 4; ++r) { const int i = 64 * ct + 16 * kt + 4 * kg + r; st[g][kt][r] = (i <= ivis) ? st[g][kt][r] : -INFINITY; }
                }
                softmax_tiles<3>(st, ob, lacc, m, cm, lane);
                pv_tile<3, false>(Kt, st, ob, lacc, lane);
            }
            if (ct + 1 < ntc) tile_store(Kb + ((ct + 1) & 1) * (TILE_B / 2), tid, kr);
            __syncthreads();
        }
    }
    float invl[3]; float msafe[3];
#pragma unroll
    for (int g = 0; g < 3; ++g) { msafe[g] = (m[g] == -INFINITY) ? 0.f : m[g]; invl[g] = 1.f / fmaxf(lacc[g].x, 1e-30f); }
    {
        u32x4 kr = tile_load(Kcmp, tid), vr = tile_load(Vcmp, tid);
        tile_store(Kb, tid, kr); tile_store(Vb, tid, vr); __syncthreads();
        for (int ct = 0; ct < ntc; ++ct) {
            if (ct + 1 < ntc) { kr = tile_load(Kcmp + (ct + 1) * 4096, tid); vr = tile_load(Vcmp + (ct + 1) * 4096, tid); }
            const LAS bf16_t* Kt = Kb + (ct & 1) * (TILE_B / 2); const LAS bf16_t* Vt = Vb + (ct & 1) * (TILE_B / 2);
            if (64 * ct <= imax_w) {
                qk_tile<3>(Kt, qf, st, cm, lane, keep3);
#pragma unroll
                for (int g = 0; g < 3; ++g)
#pragma unroll
                    for (int kt = 0; kt < 4; ++kt)
#pragma unroll
                        for (int r = 0; r < 4; ++r) { const int i = 64 * ct + 16 * kt + 4 * kg + r;
                            st[g][kt][r] = (i <= ivis) ? __builtin_amdgcn_exp2f(st[g][kt][r]) * invl[g] : 0.f; }
#pragma unroll
                for (int kt = 0; kt < 4; ++kt) {
                    float a = 0.f, c = 0.f;
#pragma unroll
                    for (int g = 0; g < 3; ++g) { a += (st[g][kt].x + st[g][kt].y) + st[g][kt].z; c += st[g][kt].w; }
                    c *= 0.5f; a += c;
                    const float recv = __uint_as_float(__builtin_amdgcn_ds_bpermute(((lane + 48) & 63) << 2, __float_as_uint(c)));
                    const int ktp = 4 * ct + kt;
                    imp[ktp * 64 + lane] += a + (kg != 0 ? recv : 0.f);
                    if (kg == 0 && ktp + 1 < 32) imp[(ktp + 1) * 64 + lane] += recv;
                }
                pv_tile<3, true>(Vt, st, ob, lacc, lane);
            }
            if (ct + 1 < ntc) { tile_store(Kb + ((ct + 1) & 1) * (TILE_B / 2), tid, kr); tile_store(Vb + ((ct + 1) & 1) * (TILE_B / 2), tid, vr); }
            __syncthreads();
        }
    }
#pragma unroll
    for (int g = 0; g < 3; ++g) { const float sc = sigm(NSA_GATEP[3 * g + 0]);
#pragma unroll
        for (int dt = 0; dt < 4; ++dt) ob[g][dt] = ob[g][dt] * sc; }
    unsigned msk[4] = {0u, 0u, 0u, 0u};
    if (cur <= 15) {
        msk[0] = (cur == 31) ? 0xffffffffu : ((1u << (cur + 1)) - 1u);
    } else {
        float iv[32];
#pragma unroll
        for (int k = 0; k < 32; ++k) { const int s = 4 * k + kg; const float v = imp[k * 64 + lane]; iv[k] = (s >= 1 && s <= cur - 2) ? v : -1.f; }
        msk[0] = 1u; msk[cur >> 5] |= 1u << (cur & 31); msk[(cur - 1) >> 5] |= 1u << ((cur - 1) & 31);
        for (int it = 0; it < 13; ++it) {
            float bv = -2.f; int bs = 1 << 20;
#pragma unroll
            for (int k = 0; k < 32; ++k) { if (iv[k] > bv) { bv = iv[k]; bs = 4 * k + kg; } }
#pragma unroll
            for (int sh = 16; sh <= 32; sh <<= 1) { const float ov = shx(bv, sh, lane); const int os = shxi(bs, sh, lane); if (ov > bv || (ov == bv && os < bs)) { bv = ov; bs = os; } }
#pragma unroll
            for (int k = 0; k < 32; ++k) if (4 * k + kg == bs) iv[k] = -1.f;
#pragma unroll
            for (int wd = 0; wd < 4; ++wd) if ((bs >> 5) == wd) msk[wd] |= 1u << (bs & 31);
        }
    }
    LAS u32x2* otp = (LAS u32x2*)imp;
#pragma unroll
    for (int g = 0; g < 3; ++g)
#pragma unroll
        for (int dt = 0; dt < 4; ++dt) { u32x2 o; o.x = pk2(ob[g][dt].x, ob[g][dt].y); o.y = pk2(ob[g][dt].z, ob[g][dt].w); otp[(g * 4 + dt) * 64 + lane] = o; }
    {
#pragma unroll
        for (int g = 0; g < 3; ++g) { m[g] = -INFINITY; cm[g] = 0.f; lacc[g] = (f32x4){0.f, 0.f, 0.f, 0.f};
#pragma unroll
            for (int dt = 0; dt < 4; ++dt) ob[g][dt] = (f32x4){0.f, 0.f, 0.f, 0.f}; }
        const int nb = 2 * J + 2;
        u32x4 kr[2], vr[2]; unsigned mw = 0u;
        kr[0] = tile_load(Ks, tid); vr[0] = tile_load(Vs, tid);
        kr[1] = tile_load(Ks + ((nb > 1) ? 4096 : 0), tid); vr[1] = tile_load(Vs + ((nb > 1) ? 4096 : 0), tid);
        tile_store(Kb, tid, kr[0]); tile_store(Vb, tid, vr[0]); __syncthreads();
        for (int s0 = 0; s0 < nb; s0 += 2) {
#pragma unroll
            for (int u = 0; u < 2; ++u) {
                const int s = s0 + u;
                if (s < nb) {
                    if (s + 2 < nb) { kr[u] = tile_load(Ks + (s + 2) * 4096, tid); vr[u] = tile_load(Vs + (s + 2) * 4096, tid); }
                    const LAS bf16_t* Kt = Kb + (s & 1) * (TILE_B / 2); const LAS bf16_t* Vt = Vb + (s & 1) * (TILE_B / 2);
                    if ((s & 31) == 0) mw = (s == 0) ? msk[0] : (s == 32) ? msk[1] : (s == 64) ? msk[2] : msk[3];
                    const bool sel = ((mw >> (s & 31)) & 1u) != 0u;
                    if (__any(sel)) {
                        const bool selk[3] = {sel, sel, sel};
                        qk_tile<3>(Kt, qf, st, cm, lane, selk);
                        if (s == cur) {
#pragma unroll
                            for (int g = 0; g < 3; ++g)
#pragma unroll
                                for (int kt = 0; kt < 4; ++kt)
#pragma unroll
                                    for (int r = 0; r < 4; ++r) { const int kk = 16 * kt + 4 * kg + r; st[g][kt][r] = (kk <= tq) ? st[g][kt][r] : -INFINITY; }
                        }
                        softmax_tiles<3>(st, ob, lacc, m, cm, lane);
                        pv_tile<3, true>(Vt, st, ob, lacc, lane);
                    }
                    if (s + 1 < nb) { tile_store(Kb + ((s + 1) & 1) * (TILE_B / 2), tid, kr[u ^ 1]); tile_store(Vb + ((s + 1) & 1) * (TILE_B / 2), tid, vr[u ^ 1]); }
                }
                __syncthreads();
            }
        }
#pragma unroll
        for (int g = 0; g < 3; ++g) { const float sc = sigm(NSA_GATEP[3 * g + 1]) / fmaxf(lacc[g].x, 1e-30f);
#pragma unroll
            for (int dt = 0; dt < 4; ++dt) { u32x2 o = otp[(g * 4 + dt) * 64 + lane]; acc_pk(o, ob[g][dt] * sc); otp[(g * 4 + dt) * 64 + lane] = o; } }
    }
    {
#pragma unroll
        for (int g = 0; g < 3; ++g) { m[g] = -INFINITY; cm[g] = 0.f; lacc[g] = (f32x4){0.f, 0.f, 0.f, 0.f};
#pragma unroll
            for (int dt = 0; dt < 4; ++dt) ob[g][dt] = (f32x4){0.f, 0.f, 0.f, 0.f}; }
        const int s_lo = (2 * J - 8 > 0) ? 2 * J - 8 : 0, s_hi = 2 * J + 1, nb = s_hi - s_lo + 1;
        u32x4 kr[2], vr[2];
        kr[0] = tile_load(Kw + s_lo * 4096, tid); vr[0] = tile_load(Vw + s_lo * 4096, tid);
        kr[1] = tile_load(Kw + (s_lo + ((nb > 1) ? 1 : 0)) * 4096, tid); vr[1] = tile_load(Vw + (s_lo + ((nb > 1) ? 1 : 0)) * 4096, tid);
        tile_store(Kb, tid, kr[0]); tile_store(Vb, tid, vr[0]); __syncthreads();
        for (int it0 = 0; it0 < nb; it0 += 2) {
#pragma unroll
            for (int u = 0; u < 2; ++u) {
                const int it = it0 + u;
                if (it < nb) {
                    const int s = s_lo + it;
                    if (it + 2 < nb) { kr[u] = tile_load(Kw + (s + 2) * 4096, tid); vr[u] = tile_load(Vw + (s + 2) * 4096, tid); }
                    const LAS bf16_t* Kt = Kb + (it & 1) * (TILE_B / 2); const LAS bf16_t* Vt = Vb + (it & 1) * (TILE_B / 2);
                    if (s <= cur && s >= cur - 8) {
                        qk_tile<3>(Kt, qf, st, cm, lane, keep3);
                        if (s == cur || s == cur - 8) {
#pragma unroll
                            for (int g = 0; g < 3; ++g)
#pragma unroll
                                for (int kt = 0; kt < 4; ++kt)
#pragma unroll
                                    for (int r = 0; r < 4; ++r) { const int kk = 16 * kt + 4 * kg + r; const bool ok = (s == cur) ? (kk <= tq) : (kk > tq); st[g][kt][r] = ok ? st[g][kt][r] : -INFINITY; }
                        }
                        softmax_tiles<3>(st, ob, lacc, m, cm, lane);
                        pv_tile<3, true>(Vt, st, ob, lacc, lane);
                    }
                    if (it + 1 < nb) { tile_store(Kb + ((it + 1) & 1) * (TILE_B / 2), tid, kr[u ^ 1]); tile_store(Vb + ((it + 1) & 1) * (TILE_B / 2), tid, vr[u ^ 1]); }
                }
                __syncthreads();
            }
        }
        bf16_t* mixp = (bf16_t*)(F.ws + WS_HM) + ((b * SEQ + tq_abs) * D + 3 * kvh * 64 + 4 * kg);
#pragma unroll
        for (int g = 0; g < 3; ++g) { const float sc = sigm(NSA_GATEP[3 * g + 2]) / fmaxf(lacc[g].x, 1e-30f);
#pragma unroll
            for (int dt = 0; dt < 4; ++dt) { u32x2 o = otp[(g * 4 + dt) * 64 + lane]; acc_pk(o, ob[g][dt] * sc); *(u32x2*)(mixp + g * 64 + 16 * dt) = o; } }
    }
}

__device__ __forceinline__ void moba_task(Frame& F, int b, int h, int own) {
    const int lane = F.lane, tid = F.tid, wv = F.wave, q = lane & 15, kg = lane >> 4;
    LAS bf16_t* Kb = (LAS bf16_t*)(F.lds + AT_K0); LAS bf16_t* Vb = (LAS bf16_t*)(F.lds + AT_V0); LAS bf16_t* Km = (LAS bf16_t*)(F.lds + AT_KMEAN);
    const size_t slab = (size_t)(b * 4 + h) * SEQ * 64;
    const bf16_t* Qg = (const bf16_t*)(F.ws + WS_MQKV) + slab; const bf16_t* Kg = Qg + MQKV_STRIDE; const bf16_t* Vg = Kg + MQKV_STRIDE;
    const int tw0 = 256 * own + 32 * wv;
    bf16x8 qf[2][2];
#pragma unroll
    for (int rt = 0; rt < 2; ++rt) { const bf16_t* qp = Qg + ((tw0 + 16 * rt + q) * 64 + 8 * kg); qf[rt][0] = *(const bf16x8*)qp; qf[rt][1] = *(const bf16x8*)(qp + 32); }
    if (tid < 256) { const u32x4 v = *(const u32x4*)((const bf16_t*)(F.ws + WS_KMEAN) + (size_t)(b * 4 + h) * 2048 + (tid >> 3) * 64 + (tid & 7) * 8); *(LAS u32x4*)(Km + (tid >> 3) * KP + (tid & 7) * 8) = v; }
    __syncthreads();
    unsigned msk[2] = {0u, 0u};
    {
        f32x4 gs[2][2];
#pragma unroll
        for (int kt = 0; kt < 2; ++kt) { const bf16x8 k0 = lds_frag(Km, 16 * kt + q, 8 * kg), k1 = lds_frag(Km, 16 * kt + q, 32 + 8 * kg);
#pragma unroll
            for (int rt = 0; rt < 2; ++rt) { f32x4 z = (f32x4){0.f, 0.f, 0.f, 0.f}; z = MFMA16(k0, qf[rt][0], z); gs[rt][kt] = MFMA16(k1, qf[rt][1], z); } }
#pragma unroll
        for (int rt = 0; rt < 2; ++rt) {
            float gv[8];
#pragma unroll
            for (int kt = 0; kt < 2; ++kt)
#pragma unroll
                for (int r = 0; r < 4; ++r) { const int blk = 16 * kt + 4 * kg + r; gv[4 * kt + r] = (blk < own) ? gs[rt][kt][r] : -INFINITY; }
            for (int it = 0; it < 3; ++it) {
                float bv = -INFINITY; int bs = 1 << 20;
#pragma unroll
                for (int k = 0; k < 8; ++k) { const int blk = 16 * (k >> 2) + 4 * kg + (k & 3); if (gv[k] > bv) { bv = gv[k]; bs = blk; } }
#pragma unroll
                for (int sh = 16; sh <= 32; sh <<= 1) { const float ov = shx(bv, sh, lane); const int os = shxi(bs, sh, lane); if (ov > bv || (ov == bv && os < bs)) { bv = ov; bs = os; } }
                if (bs < 32) { msk[rt] |= 1u << bs;
#pragma unroll
                    for (int k = 0; k < 8; ++k) if (16 * (k >> 2) + 4 * kg + (k & 3) == bs) gv[k] = -INFINITY; }
            }
        }
    }
    float m[2] = {-INFINITY, -INFINITY}; float cm[2] = {0.f, 0.f}; f32x4 lacc[2] = {(f32x4){0.f, 0.f, 0.f, 0.f}, (f32x4){0.f, 0.f, 0.f, 0.f}};
    f32x4 ob[2][4], st[2][4];
#pragma unroll
    for (int rt = 0; rt < 2; ++rt)
#pragma unroll
        for (int dt = 0; dt < 4; ++dt) ob[rt][dt] = (f32x4){0.f, 0.f, 0.f, 0.f};
    const int ntile = 4 * own + 4;
    u32x4 kr[2], vr[2];
    kr[0] = tile_load(Kg, tid); vr[0] = tile_load(Vg, tid); kr[1] = tile_load(Kg + 4096, tid); vr[1] = tile_load(Vg + 4096, tid);
    tile_store(Kb, tid, kr[0]); tile_store(Vb, tid, vr[0]); __syncthreads();
    for (int tau0 = 0; tau0 < ntile; tau0 += 2) {
#pragma unroll
        for (int u = 0; u < 2; ++u) {
            const int tau = tau0 + u;
            if (tau + 2 < ntile) { kr[u] = tile_load(Kg + (tau + 2) * 4096, tid); vr[u] = tile_load(Vg + (tau + 2) * 4096, tid); }
            const LAS bf16_t* Kt = Kb + (tau & 1) * (TILE_B / 2); const LAS bf16_t* Vt = Vb + (tau & 1) * (TILE_B / 2);
            const int blk = tau >> 2;
            bool sel[2]; bool anyv = false;
#pragma unroll
            for (int rt = 0; rt < 2; ++rt) { sel[rt] = (blk < own) ? ((msk[rt] >> blk) & 1u) : (64 * (tau & 3) <= 32 * wv + 16 * rt + q); anyv = anyv || sel[rt]; }
            if (__any(anyv)) {
                const bool selk[2] = {(blk < own) ? sel[0] : true, (blk < own) ? sel[1] : true};
                qk_tile<2>(Kt, qf, st, cm, lane, selk);
                if (blk >= own) {
#pragma unroll
                    for (int rt = 0; rt < 2; ++rt) {
                        const int trel = 32 * wv + 16 * rt + q;
#pragma unroll
                        for (int kt = 0; kt < 4; ++kt)
#pragma unroll
                            for (int r = 0; r < 4; ++r) { const int kk = 64 * (tau & 3) + 16 * kt + 4 * kg + r; st[rt][kt][r] = (kk <= trel) ? st[rt][kt][r] : -INFINITY; }
                    }
                }
                softmax_tiles<2>(st, ob, lacc, m, cm, lane);
                pv_tile<2, true>(Vt, st, ob, lacc, lane);
            }
            if (tau + 1 < ntile) { tile_store(Kb + ((tau + 1) & 1) * (TILE_B / 2), tid, kr[u ^ 1]); tile_store(Vb + ((tau + 1) & 1) * (TILE_B / 2), tid, vr[u ^ 1]); }
            __syncthreads();
        }
    }
#pragma unroll
    for (int rt = 0; rt < 2; ++rt) {
        const float sc = 1.f / fmaxf(lacc[rt].x, 1e-30f);
        bf16_t* mix = (bf16_t*)(F.ws + WS_HM) + ((b * SEQ + tw0 + 16 * rt + q) * D + 384 + h * 64 + 4 * kg);
#pragma unroll
        for (int dt = 0; dt < 4; ++dt) { const f32x4 v = ob[rt][dt] * sc; u32x2 o; o.x = pk2(v.x, v.y); o.y = pk2(v.z, v.w); *(u32x2*)(mix + 16 * dt) = o; }
    }
}

constexpr int R2_RING = 16384, R2_SLOT = 12288;
__device__ __forceinline__ void r2_issue(const bf16_t* pt, const bf16_t* zp, LAS unsigned char* slot) {
#pragma unroll
    for (int mt = 0; mt < 2; ++mt)
#pragma unroll
        for (int ks = 0; ks < 4; ++ks) __builtin_amdgcn_global_load_lds((const unsigned*)(pt + mt * 2048 + ks * 16), (LAS unsigned*)(slot + (mt * 4 + ks) * 1024), 16, 0, 0);
#pragma unroll
    for (int mt = 0; mt < 2; ++mt)
#pragma unroll
        for (int q = 0; q < 2; ++q) __builtin_amdgcn_global_load_lds((const unsigned*)(zp + mt * 2048 + q * 8), (LAS unsigned*)(slot + 8192 + (mt * 2 + q) * 1024), 16, 0, 0);
}
__device__ __forceinline__ void r2_wave(Frame& F, int widx) {
    const int chain = widx >> 1, hf = widx & 1, lane = F.lane, c31 = lane & 31, hi = lane >> 5;
    LAS bf16_t* sb = (LAS bf16_t*)(F.lds + R2_SBUF + F.wave * (32 * KP * 2));
    LAS unsigned char* ring = F.lds + R2_RING + F.wave * (4 * R2_SLOT);
    for (int i = lane; i < 32 * KP / 2; i += 64) ((LAS unsigned*)sb)[i] = 0u;
    const bf16_t* PTl = (const bf16_t*)(F.ws + WS_PT) + (size_t)chain * 128 * 4096 + c31 * 64 + 8 * hi;
    const bf16_t* ZPl = (const bf16_t*)(F.ws + WS_ZS) + (size_t)chain * 128 * 4096 + (hf * 64 + lane) * 16;
    bf16_t* SS = (bf16_t*)(F.ws + WS_SS) + (size_t)chain * 128 * 4096 + (32 * hf) * 64;
    r2_issue(PTl, ZPl, ring); r2_issue(PTl + 4096, ZPl + 4096, ring + R2_SLOT); r2_issue(PTl + 2 * 4096, ZPl + 2 * 4096, ring + 2 * R2_SLOT);
#pragma unroll 1
    for (int c = 0; c < 128; ++c) {
        const int cn = (c + 3 < 128) ? c + 3 : 127;
        r2_issue(PTl + cn * 4096, ZPl + cn * 4096, ring + ((c + 3) & 3) * R2_SLOT);
        asm volatile("s_waitcnt vmcnt(36)" ::: "memory");
        const LAS unsigned char* sl = ring + (c & 3) * R2_SLOT + lane * 16;
        f32x16 acc[2];
#pragma unroll
        for (int mt = 0; mt < 2; ++mt)
#pragma unroll
            for (int q = 0; q < 2; ++q) { const u32x4 z = *(const LAS u32x4*)(sl + 8192 + (mt * 2 + q) * 1024);
                acc[mt][8 * q + 0] = __uint_as_float(z.x << 16); acc[mt][8 * q + 1] = __uint_as_float(z.x & 0xffff0000u); acc[mt][8 * q + 2] = __uint_as_float(z.y << 16); acc[mt][8 * q + 3] = __uint_as_float(z.y & 0xffff0000u);
                acc[mt][8 * q + 4] = __uint_as_float(z.z << 16); acc[mt][8 * q + 5] = __uint_as_float(z.z & 0xffff0000u); acc[mt][8 * q + 6] = __uint_as_float(z.w << 16); acc[mt][8 * q + 7] = __uint_as_float(z.w & 0xffff0000u); }
#pragma unroll
        for (int ks = 0; ks < 4; ++ks) {
            const bf16x8 bx = *(const LAS bf16x8*)(sb + c31 * KP + 16 * ks + 8 * hi);
#pragma unroll
            for (int mt = 0; mt < 2; ++mt) { const bf16x8 pa = *(const LAS bf16x8*)(sl + (mt * 4 + ks) * 1024); acc[mt] = MFMA32(pa, bx, acc[mt]); }
        }
#pragma unroll
        for (int mt = 0; mt < 2; ++mt)
#pragma unroll
            for (int r = 0; r < 16; ++r) sb[c31 * KP + 32 * mt + (r & 3) + 8 * (r >> 2) + 4 * hi] = f2bf(acc[mt][r]);
        bf16_t* ss = SS + c * 4096;
#pragma unroll
        for (int j = 0; j < 4; ++j) { const int qd = lane + 64 * j, row = qd >> 3, ch = qd & 7; *(u32x4*)(ss + row * 64 + ch * 8) = *(const LAS u32x4*)(sb + row * KP + ch * 8); }
    }
    asm volatile("s_waitcnt vmcnt(0)" ::: "memory");
}

struct TaskTable { unsigned short v[512]; };
constexpr TaskTable make_tasks() {
    TaskTable t{}; int n = 0, a = 63, am = 0, c = 31, cm = 0;
    while (a >= 0 || c >= 0) {
        const int ca = (a >= 0) ? 96 * a + 1344 : -1, cc = (c >= 0) ? 128 * c + 128 : -1;
        if (ca >= cc) { t.v[n++] = (unsigned short)(0 * 512 + am * 64 + a); if (++am == 4) { am = 0; --a; } }
        else { t.v[n++] = (unsigned short)(1 * 512 + cm * 64 + c); if (++cm == 8) { cm = 0; --c; } }
    }
    return t;
}
__device__ const TaskTable g_tasks = make_tasks();

__device__ __forceinline__ void r3_task(Frame& F, int layer, int task) {
    const int chain = task >> 7, c = task & 127, b = chain / 6, h = chain % 6, lane = F.lane, c31 = lane & 31, hi = lane >> 5;
    const bf16_t* S0 = (const bf16_t*)(F.ws + WS_SS) + (size_t)(task - 1) * 4096;
    const bf16_t* YT = (const bf16_t*)(F.ws + WS_YT) + (size_t)task * 4096;
    const bf16_t* Y0 = (const bf16_t*)(F.ws + WS_Y0) + (size_t)task * 4096;
    const bf16_t* rf = (const bf16_t*)(F.ws + WS_RFEAT);
    const bf16_t* gut = (const bf16_t*)(F.ws + WS_GUPT) + (size_t)(h * 64) * 128;
    const float* mu = INF(F, I_MU) + layer * RW;
    f32x16 acc[2][2], gacc[2][2];
#pragma unroll
    for (int a = 0; a < 2; ++a)
#pragma unroll
        for (int n = 0; n < 2; ++n)
#pragma unroll
            for (int r = 0; r < 16; ++r) { acc[a][n][r] = 0.f; gacc[a][n][r] = 0.f; }
    if (c > 0) {
#pragma unroll
        for (int ks = 0; ks < 4; ++ks) {
            bf16x8 af[2], bfr[2];
#pragma unroll
            for (int mt = 0; mt < 2; ++mt) af[mt] = *(const bf16x8*)(S0 + (32 * mt + c31) * 64 + 16 * ks + 8 * hi);
#pragma unroll
            for (int nt = 0; nt < 2; ++nt) bfr[nt] = *(const bf16x8*)(YT + (32 * nt + c31) * 64 + 16 * ks + 8 * hi);
#pragma unroll
            for (int mt = 0; mt < 2; ++mt)
#pragma unroll
                for (int nt = 0; nt < 2; ++nt) acc[mt][nt] = MFMA32(af[mt], bfr[nt], acc[mt][nt]);
        }
    }
#pragma unroll
    for (int ks = 0; ks < 8; ++ks) {
        bf16x8 af[2], bfr[2];
#pragma unroll
        for (int mt = 0; mt < 2; ++mt) af[mt] = *(const bf16x8*)(gut + (32 * mt + c31) * 128 + 16 * ks + 8 * hi);
#pragma unroll
        for (int nt = 0; nt < 2; ++nt) {
            const int t = 64 * c + 32 * nt + c31, j0 = 16 * ks + 8 * hi; const size_t row = (size_t)b * SEQ + t;
            const u32x4 cu = *(const u32x4*)(rf + row * RW + 1280 + j0);
            u32x4 pv = (u32x4){0u, 0u, 0u, 0u}; if (t > 0) pv = *(const u32x4*)(rf + (row - 1) * RW + 1280 + j0);
            const f32x4 m0 = *(const f32x4*)(mu + 1280 + j0), m1 = *(const f32x4*)(mu + 1280 + j0 + 4);
            float cv[8], pw[8];
            cv[0] = __uint_as_float(cu.x << 16); cv[1] = __uint_as_float(cu.x & 0xffff0000u); cv[2] = __uint_as_float(cu.y << 16); cv[3] = __uint_as_float(cu.y & 0xffff0000u);
            cv[4] = __uint_as_float(cu.z << 16); cv[5] = __uint_as_float(cu.z & 0xffff0000u); cv[6] = __uint_as_float(cu.w << 16); cv[7] = __uint_as_float(cu.w & 0xffff0000u);
            pw[0] = __uint_as_float(pv.x << 16); pw[1] = __uint_as_float(pv.x & 0xffff0000u); pw[2] = __uint_as_float(pv.y << 16); pw[3] = __uint_as_float(pv.y & 0xffff0000u);
            pw[4] = __uint_as_float(pv.z << 16); pw[5] = __uint_as_float(pv.z & 0xffff0000u); pw[6] = __uint_as_float(pv.w << 16); pw[7] = __uint_as_float(pv.w & 0xffff0000u);
            const float mm[8] = {m0.x, m0.y, m0.z, m0.w, m1.x, m1.y, m1.z, m1.w};
            float sg[8];
#pragma unroll
            for (int k = 0; k < 8; ++k) sg[k] = sigm(cv[k] + (pw[k] - cv[k]) * mm[k]);
            u32x4 u; u.x = pk2(sg[0], sg[1]); u.y = pk2(sg[2], sg[3]); u.z = pk2(sg[4], sg[5]); u.w = pk2(sg[6], sg[7]);
            bfr[nt] = __builtin_bit_cast(bf16x8, u);
        }
#pragma unroll
        for (int mt = 0; mt < 2; ++mt)
#pragma unroll
            for (int nt = 0; nt < 2; ++nt) gacc[mt][nt] = MFMA32(af[mt], bfr[nt], gacc[mt][nt]);
    }
    const float* lnw = INF(F, I_LNW) + layer * 384 + h * 64; const float* lnb = INF(F, I_LNB) + layer * 384 + h * 64;
    const float* bonus = (const float*)(F.ws + WS_BONUS);
    bf16_t* mix = (bf16_t*)(F.ws + WS_HM);
#pragma unroll
    for (int nt = 0; nt < 2; ++nt) {
        const int tl = 32 * nt + c31, t = 64 * c + tl; const size_t row = (size_t)b * SEQ + t;
        float s = 0.f;
#pragma unroll
        for (int mt = 0; mt < 2; ++mt)
#pragma unroll
            for (int rq = 0; rq < 4; ++rq) {
                const u32x2 y = *(const u32x2*)(Y0 + tl * 64 + 32 * mt + 8 * rq + 4 * hi);
                acc[mt][nt][4 * rq + 0] += __uint_as_float(y.x << 16); acc[mt][nt][4 * rq + 1] += __uint_as_float(y.x & 0xffff0000u);
                acc[mt][nt][4 * rq + 2] += __uint_as_float(y.y << 16); acc[mt][nt][4 * rq + 3] += __uint_as_float(y.y & 0xffff0000u);
                s += (acc[mt][nt][4 * rq] + acc[mt][nt][4 * rq + 1]) + (acc[mt][nt][4 * rq + 2] + acc[mt][nt][4 * rq + 3]);
            }
        s += shx(s, 32, lane);
        const float mean = s * (1.f / 64.f);
        float vs = 0.f;
#pragma unroll
        for (int mt = 0; mt < 2; ++mt)
#pragma unroll
            for (int r = 0; r < 16; ++r) { const float d = acc[mt][nt][r] - mean; vs += d * d; }
        vs += shx(vs, 32, lane);
        const float rstd = rsqrtf(vs * (1.f / 64.f) + 64e-5f);
        const float bn = bonus[row * 8 + h];
#pragma unroll
        for (int mt = 0; mt < 2; ++mt)
#pragma unroll
            for (int rq = 0; rq < 4; ++rq) {
                const int v0 = 32 * mt + 8 * rq + 4 * hi;
                const u32x2 vc = *(const u32x2*)(rf + row * RW + 768 + h * 64 + v0);
                u32x2 vp = (u32x2){0u, 0u}; if (t > 0) vp = *(const u32x2*)(rf + (row - 1) * RW + 768 + h * 64 + v0);
                const f32x4 mv = *(const f32x4*)(mu + 768 + h * 64 + v0), lw = *(const f32x4*)(lnw + v0), lb = *(const f32x4*)(lnb + v0);
                const float vcur[4] = {__uint_as_float(vc.x << 16), __uint_as_float(vc.x & 0xffff0000u), __uint_as_float(vc.y << 16), __uint_as_float(vc.y & 0xffff0000u)};
                const float vprv[4] = {__uint_as_float(vp.x << 16), __uint_as_float(vp.x & 0xffff0000u), __uint_as_float(vp.y << 16), __uint_as_float(vp.y & 0xffff0000u)};
                const float mvv[4] = {mv.x, mv.y, mv.z, mv.w}, lwv[4] = {lw.x, lw.y, lw.z, lw.w}, lbv[4] = {lb.x, lb.y, lb.z, lb.w};
                float o[4];
#pragma unroll
                for (int k = 0; k < 4; ++k) {
                    const float vsh = vcur[k] + (vprv[k] - vcur[k]) * mvv[k];
                    const float y = (acc[mt][nt][4 * rq + k] - mean) * rstd * lwv[k] + lbv[k];
                    o[k] = (y + bn * vsh) * gacc[mt][nt][4 * rq + k];
                }
                u32x2 ov; ov.x = pk2(o[0], o[1]); ov.y = pk2(o[2], o[3]);
                *(u32x2*)(mix + row * D + 640 + h * 64 + v0) = ov;
            }
    }
}
__device__ __forceinline__ void mixnorm_rows(Frame& F, int layer, int m0, int nrows) {
    bf16_t* mix = (bf16_t*)(F.ws + WS_HM);
    const float* gn = INF(F, I_NNSA) + layer * 384; const float* gm = INF(F, I_NMOBA) + layer * 256;
    const int lane = F.lane;
    for (int m = m0 + F.wave; m < m0 + nrows; m += NWAVES) {
        unsigned* rowp = (unsigned*)(mix + (size_t)m * D);
        unsigned a[3], c[2]; float sa = 0.f, sc = 0.f;
#pragma unroll
        for (int j = 0; j < 3; ++j) { a[j] = rowp[lane + 64 * j]; const float x = __uint_as_float(a[j] << 16), y = __uint_as_float(a[j] & 0xffff0000u); sa += x * x + y * y; }
#pragma unroll
        for (int j = 0; j < 2; ++j) { c[j] = rowp[192 + lane + 64 * j]; const float x = __uint_as_float(c[j] << 16), y = __uint_as_float(c[j] & 0xffff0000u); sc += x * x + y * y; }
        const float ra = rsqrtf(wave_sum(sa, lane) * (1.f / 384.f) + NORM_EPS), rc = rsqrtf(wave_sum(sc, lane) * (1.f / 256.f) + NORM_EPS);
#pragma unroll
        for (int j = 0; j < 3; ++j) { const int col = 2 * (lane + 64 * j); rowp[lane + 64 * j] = pk2(__uint_as_float(a[j] << 16) * ra * gn[col], __uint_as_float(a[j] & 0xffff0000u) * ra * gn[col + 1]); }
#pragma unroll
        for (int j = 0; j < 2; ++j) { const int col = 2 * (lane + 64 * j); rowp[192 + lane + 64 * j] = pk2(__uint_as_float(c[j] << 16) * rc * gm[col], __uint_as_float(c[j] & 0xffff0000u) * rc * gm[col + 1]); }
    }
}
__device__ __forceinline__ void phase_e(Frame& F, int layer) {
    const int gw = F.bid * NWAVES + F.wave, NGW = F.G * NWAVES;
    (void)gw; (void)NGW; (void)layer;
}

constexpr int CW_TILE = 1536;
constexpr int CW_R2DONE = 512;
__device__ __forceinline__ void phase_d(Frame& F, int layer, int rep = 0) {
    if (F.bid < 12 && rep == 0) {
        await_count(F, F.ctl + CW_R1DONE + 64 * layer + F.bid, 16u);
        if (F.wave < 2) { r2_wave(F, F.bid * 2 + F.wave);
            __builtin_amdgcn_fence(__ATOMIC_RELEASE, "agent"); asm volatile("s_waitcnt vmcnt(0)" ::: "memory");
            if (F.lane == 0) (void)__hip_atomic_fetch_add(F.ctl + CW_R2DONE + 64 * layer, 1u, RLX_AGENT); }
        __syncthreads();
#if DBG_MODE == 4
        if (F.bid == 0 && layer == 0) __hip_atomic_store(F.ctl + 3200 + 30, (unsigned)__builtin_amdgcn_s_memrealtime(), RLX_AGENT);
#endif
    }
    LAUNDER(F);
    await_count(F, F.ctl + CW_PREP + 64 * layer, 64u);
    LAUNDER(F);
    volatile LAS int* tw = (volatile LAS int*)(F.lds + AT_MISC);
    unsigned* qh = F.ctl + CW_Q + 64 * layer + 16 * rep;
    const int ntask = (rep == 0) ? 512 + 192 + 128 : 512;
    for (;;) {
        if (F.tid == 0) tw[0] = (int)__hip_atomic_fetch_add(qh, 1u, RLX_AGENT);
        __syncthreads();
        const int k = __builtin_amdgcn_readfirstlane(tw[0]);
        __syncthreads();
        if (k >= ntask) break;
        LAUNDER(F);
        if (k >= 512 + 192) {
            const int tile = k - (512 + 192);
            await_count(F, F.ctl + CW_TILE + 128 * layer + tile, 6u);
            mixnorm_rows(F, layer, tile * 128, 128);
            continue;
        }
        if (k >= 512) {
            if (F.tid == 0) { unsigned sp = 0; while ((unsigned)__builtin_amdgcn_readfirstlane(__hip_atomic_load(F.ctl + CW_R2DONE + 64 * layer, RLX_AGENT)) < 24u) { __builtin_amdgcn_s_sleep(4); if (++sp > (1u << 24)) break; }
                __builtin_amdgcn_fence(__ATOMIC_ACQUIRE, "agent"); asm volatile("s_waitcnt vmcnt(0)" ::: "memory"); }
            __syncthreads();
            r3_task(F, layer, (k - 512) * 8 + F.wave);
            continue;
        }
        const int code = g_tasks.v[k], ty = code >> 9, mm = (code >> 6) & 7, jj = code & 63;
        if (ty == 0) nsa_task(F, mm >> 1, mm & 1, jj); else moba_task(F, mm >> 2, mm & 3, jj);
        if (rep == 0) {
            asm volatile("s_waitcnt vmcnt(0)" ::: "memory"); __syncthreads();
            if (F.tid == 0) { __builtin_amdgcn_fence(__ATOMIC_RELEASE, "agent"); asm volatile("s_waitcnt vmcnt(0)" ::: "memory");
                unsigned* tc = F.ctl + CW_TILE + 128 * layer;
                if (ty == 0) (void)__hip_atomic_fetch_add(tc + (mm >> 1) * 64 + jj, 1u, RLX_AGENT);
                else { (void)__hip_atomic_fetch_add(tc + (mm >> 2) * 64 + 2 * jj, 1u, RLX_AGENT); (void)__hip_atomic_fetch_add(tc + (mm >> 2) * 64 + 2 * jj + 1, 1u, RLX_AGENT); } }
        }
    }
}

__device__ __forceinline__ void phase_g1(Frame& F, int layer) {
    LAS float* wr = (LAS float*)F.lds;
    { const float* W = INF(F, I_WROUTER);
#pragma unroll 1
      for (int i0 = 0; i0 < 4096; i0 += 2048) { f32x4 t4[4];
#pragma unroll
          for (int u = 0; u < 4; ++u) t4[u] = *(const f32x4*)(W + 4 * (i0 + u * NTHR + F.tid));
#pragma unroll
          for (int u = 0; u < 4; ++u) { const int i = 4 * (i0 + u * NTHR + F.tid), k = i >> 4, e = i & 15;
              wr[e * 1028 + k] = t4[u].x; wr[(e + 1) * 1028 + k] = t4[u].y; wr[(e + 2) * 1028 + k] = t4[u].z; wr[(e + 3) * 1028 + k] = t4[u].w; } } }
    __syncthreads();
    const float* mod = (const float*)(F.ws + WS_MOD);
    bf16_t* H = (bf16_t*)(F.ws + WS_HM);
    unsigned* cnt = F.ctl + CW_CNT + 64 * layer;
    const float* rb = INF(F, I_RBIAS);
    const float* gn = INF(F, I_NFFN) + layer * D;
    const int gw = F.bid * NWAVES + F.wave, NGW = F.G * NWAVES;
    f32x4 vnext[4];
#pragma unroll
    for (int j = 0; j < 4; ++j) vnext[j] = *(const f32x4*)(F.out + (size_t)gw * D + 4 * F.lane + 256 * j);
    int px = 0, pm = 0; float pw = 0.f; int ridx = 0;
    for (int m = gw; m < T; m += NGW, ++ridx) {
        int lane = F.lane; asm volatile("" : "+v"(lane));
        const int b = m >> 13;
        const float* sh = mod + ((size_t)layer * BATCH + b) * 6144 + 3072; const float* sc = sh + 1024;
        f32x4 v[4]; float ss = 0.f;
#pragma unroll
        for (int j = 0; j < 4; ++j) { v[j] = vnext[j]; ss += (v[j].x * v[j].x + v[j].y * v[j].y) + (v[j].z * v[j].z + v[j].w * v[j].w); }
        { const int mn = (m + NGW < T) ? m + NGW : m;
#pragma unroll
          for (int j = 0; j < 4; ++j) vnext[j] = *(const f32x4*)(F.out + (size_t)mn * D + 4 * lane + 256 * j); }
        const float rstd = rsqrtf(wave_sum(ss, lane) * (1.f / D) + NORM_EPS);
        float lg[16]; f32x2_t lgp[16];
#pragma unroll
        for (int e = 0; e < 16; ++e) lgp[e] = (f32x2_t){0.f, 0.f};
#pragma unroll
        for (int j = 0; j < 4; ++j) { const int col = 4 * lane + 256 * j;
            const f32x4 g = *(const f32x4*)(gn + col), s1 = *(const f32x4*)(sc + col), s0 = *(const f32x4*)(sh + col);
            const float hx = v[j].x * rstd * g.x * (1.f + s1.x) + s0.x, hy = v[j].y * rstd * g.y * (1.f + s1.y) + s0.y, hz = v[j].z * rstd * g.z * (1.f + s1.z) + s0.z, hw = v[j].w * rstd * g.w * (1.f + s1.w) + s0.w;
            u32x2 o; o.x = pk2(hx, hy); o.y = pk2(hz, hw); *(u32x2*)(H + (size_t)m * D + col) = o;
            const f32x2_t h01 = {hx, hy}, h23 = {hz, hw};
#pragma unroll
            for (int e = 0; e < 16; ++e) { const f32x4 w4 = *(const LAS f32x4*)(wr + e * 1028 + col);
                lgp[e] = __builtin_elementwise_fma(h01, (f32x2_t){w4.x, w4.y}, lgp[e]); lgp[e] = __builtin_elementwise_fma(h23, (f32x2_t){w4.z, w4.w}, lgp[e]); }
        }
#pragma unroll
        for (int e = 0; e < 16; ++e) lg[e] = lgp[e].x + lgp[e].y;
        float r8[8], r4[4], r2[2], r1;
#pragma unroll
        for (int e = 0; e < 8; ++e) { auto sw = __builtin_amdgcn_permlane32_swap(__float_as_uint(lg[e]), __float_as_uint(lg[e + 8]), false, false); r8[e] = __uint_as_float(sw[0]) + __uint_as_float(sw[1]); }
#pragma unroll
        for (int e = 0; e < 4; ++e) { auto sw = __builtin_amdgcn_permlane16_swap(__float_as_uint(r8[e]), __float_as_uint(r8[e + 4]), false, false); r4[e] = __uint_as_float(sw[0]) + __uint_as_float(sw[1]); }
        { const bool up = (lane & 8) != 0;
#pragma unroll
          for (int e = 0; e < 2; ++e) { const float keep = up ? r4[e + 2] : r4[e], send = up ? r4[e] : r4[e + 2]; r2[e] = keep + dpp_mov<0x140>(send); } }
        { const bool up = (lane & 4) != 0; const float keep = up ? r2[1] : r2[0], send = up ? r2[0] : r2[1]; r1 = keep + dpp_mov<0x141>(send); }
        r1 += dpp_mov<0x4E>(r1); r1 += dpp_mov<0xB1>(r1);
        const int el = (((lane >> 5) & 1) << 3) | (((lane >> 4) & 1) << 2) | (((lane >> 3) & 1) << 1) | ((lane >> 2) & 1);
        const float affl = sigm(r1), bial = affl + rb[el];
        float aff[16], bia[16];
#pragma unroll
        for (int e = 0; e < 16; ++e) { const int src = ((e & 8) ? 32 : 0) | ((e & 4) ? 16 : 0) | ((e & 2) ? 8 : 0) | ((e & 1) ? 4 : 0);
            aff[e] = __uint_as_float(__builtin_amdgcn_readlane(__float_as_uint(affl), src)); bia[e] = __uint_as_float(__builtin_amdgcn_readlane(__float_as_uint(bial), src)); }
        int best = 0; float bscore = -INFINITY;
#pragma unroll
        for (int g = 0; g < 4; ++g) {
            float t1 = -INFINITY, t2 = -INFINITY;
#pragma unroll
            for (int k = 0; k < 4; ++k) { const float x = bia[4 * g + k]; if (x > t1) { t2 = t1; t1 = x; } else if (x > t2) t2 = x; }
            const float gs = t1 + t2; if (gs > bscore) { bscore = gs; best = g; }
        }
        float x4[4], a4[4];
#pragma unroll
        for (int k = 0; k < 4; ++k) { x4[k] = (best == 0) ? bia[k] : (best == 1) ? bia[4 + k] : (best == 2) ? bia[8 + k] : bia[12 + k]; a4[k] = (best == 0) ? aff[k] : (best == 1) ? aff[4 + k] : (best == 2) ? aff[8 + k] : aff[12 + k]; }
        int i1 = 0; float v1 = x4[0];
#pragma unroll
        for (int k = 1; k < 4; ++k) if (x4[k] > v1) { v1 = x4[k]; i1 = k; }
        int i2 = -1; float v2 = -INFINITY;
#pragma unroll
        for (int k = 0; k < 4; ++k) if (k != i1 && x4[k] > v2) { v2 = x4[k]; i2 = k; }
        float w1 = 0.f, w2 = 0.f;
#pragma unroll
        for (int k = 0; k < 4; ++k) { if (k == i1) w1 = a4[k]; if (k == i2) w2 = a4[k]; }
        const float ws = w1 + w2; w1 /= ws; w2 /= ws;
        if (lane == 2 * ridx) { px = 4 * best + i1; pm = m; pw = w1; }
        if (lane == 2 * ridx + 1) { px = 4 * best + i2; pm = m; pw = w2; }
    }
    {
        const int lane = F.lane; const int np = 2 * ridx;
        int rank = 0, total = 0, leader = 64;
        for (int j = 0; j < np; ++j) { const int xj = __builtin_amdgcn_readlane(px, j); const bool same = (xj == px); rank += (same && j < lane) ? 1 : 0; total += same ? 1 : 0; leader = (same && j < leader) ? j : leader; }
        int base = 0;
        if (lane < np && rank == 0) base = (int)__hip_atomic_fetch_add(cnt + px, (unsigned)total, RLX_AGENT);
        base = __builtin_amdgcn_ds_bpermute((leader & 63) << 2, base);
        if (lane < np) { const int idx = px * 16384 + base + rank; ((int*)(F.ws + WS_ELIST))[idx] = 2 * pm + (lane & 1); ((float*)(F.ws + WS_EWW))[idx] = pw; }
    }
    asm volatile("s_waitcnt vmcnt(0)" ::: "memory"); __syncthreads();
    if (F.wave == 0) {
        unsigned tk = 0;
        if (F.lane == 0) { __builtin_amdgcn_fence(__ATOMIC_RELEASE, "agent"); asm volatile("s_waitcnt vmcnt(0)" ::: "memory"); tk = __hip_atomic_fetch_add(cnt + 32, 1u, RLX_AGENT); }
        tk = (unsigned)__builtin_amdgcn_readfirstlane((int)tk);
        if (tk == (unsigned)F.G - 1u) {
            __builtin_amdgcn_fence(__ATOMIC_ACQUIRE, "agent");
            const int lane = F.lane;
            int* tile_e = (int*)(F.ws + WS_ROWINFO + layer * ROWINFO_LSTRIDE) + 2 * MAXROWS;
            const int c = (lane < 16) ? (int)__hip_atomic_load(cnt + (lane & 15), RLX_AGENT) : 0, nt = (c + 255) >> 8;
            int ofs = 0, tot = 0;
            for (int e = 0; e < 16; ++e) { const int ne = __builtin_amdgcn_readlane(nt, e) << 8; ofs += (e < lane) ? ne : 0; tot += ne; }
            if (lane < 16) { tile_e[TE_OFF + lane] = ofs; tile_e[TE_CNT + lane] = c; for (int j = 0; j < nt; ++j) tile_e[(ofs >> 8) + j] = lane; }
            if (lane == 0) tile_e[256] = tot >> 8;
        }
    }
}
__device__ __forceinline__ void phase_g2(Frame& F, int layer) {
    volatile LAS int* off = (volatile LAS int*)F.lds;
    unsigned* cnt = F.ctl + CW_CNT + 64 * layer;
    int* rowinfo = (int*)(F.ws + WS_ROWINFO + layer * ROWINFO_LSTRIDE); float* roww = (float*)(rowinfo + MAXROWS); int* tile_e = rowinfo + 2 * MAXROWS; int* ntl = tile_e + 256;
    if (F.tid == 0) { int o = 0; for (int e = 0; e < 16; ++e) { off[e] = o; const int c = (int)__hip_atomic_load(cnt + e, RLX_AGENT); o += ((c + 255) >> 8) << 8; } off[16] = o; }
    __syncthreads();
    if (F.bid == 0) {
        if (F.tid == 0) ntl[0] = off[16] >> 8;
        for (int e = 0; e < 16; ++e) {
            const int c = (int)__hip_atomic_load(cnt + e, RLX_AGENT), o0 = off[e], o1 = off[e + 1];
            for (int r = o0 + c + F.tid; r < o1; r += NTHR) { rowinfo[r] = -1; roww[r] = 0.f; }
            for (int tl = (o0 >> 8) + F.tid; tl < (o1 >> 8); tl += NTHR) tile_e[tl] = e;
        }
    }
    const int* route = (const int*)(F.ws + WS_ROUTE);
    const int gw = F.bid * NWAVES + F.wave, NGW = F.G * NWAVES, lane = F.lane;
    for (int m = gw; m < T; m += NGW) {
        const int* rp = route + (size_t)m * 8;
        const int e1 = ld_ctl(rp), e2 = ld_ctl(rp + 1), p1 = ld_ctl(rp + 2), p2 = ld_ctl(rp + 3);
        const int r1 = off[e1] + p1, r2 = off[e2] + p2;
        if (lane == 0) { rowinfo[r1] = 2 * m; rowinfo[r2] = 2 * m + 1; roww[r1] = __int_as_float(ld_ctl(rp + 4)); roww[r2] = __int_as_float(ld_ctl(rp + 5)); }
    }
}

#if DBG_MODE == 2
__device__ __forceinline__ void dbg_flag(Frame& F, bool bad, unsigned code) { if (__any(bad) && F.lane == 0) atomicCAS(F.ctl + CW_DBG, 0u, code); }
__device__ __forceinline__ void scan_bf16(Frame& F, size_t off, size_t n, unsigned code) {
    const unsigned* p = (const unsigned*)(F.ws + off); bool bad = false;
    for (size_t i = (size_t)F.bid * NTHR + F.tid; i < n / 2; i += (size_t)F.G * NTHR) { const unsigned u = p[i]; bad = bad || ((u & 0x7f80u) == 0x7f80u) || ((u & 0x7f800000u) == 0x7f800000u); }
    dbg_flag(F, bad, code); }
__device__ __forceinline__ void scan_f32p(Frame& F, const float* p, size_t n, unsigned code) {
    bool bad = false;
    for (size_t i = (size_t)F.bid * NTHR + F.tid; i < n; i += (size_t)F.G * NTHR) { const unsigned u = __float_as_uint(p[i]); bad = bad || ((u & 0x7f800000u) == 0x7f800000u); }
    dbg_flag(F, bad, code); }
__device__ __forceinline__ void dbg_check(Frame& F, int p) {
    const unsigned code = (unsigned)(p + 1);
    if (DBG_SUB >= 4) {
        if (p != DBG_P) return;
        const size_t off = (DBG_SUB == 4) ? WS_ZS : (DBG_SUB == 5) ? WS_PT : (DBG_SUB == 6) ? WS_YT : WS_Y0;
        const unsigned* q = (const unsigned*)(F.ws + off); unsigned mx = 0;
        for (size_t i = (size_t)F.bid * NTHR + F.tid; i < (size_t)1536 * 2048; i += (size_t)F.G * NTHR) { const unsigned u = q[i]; const unsigned e0 = (u >> 7) & 0xffu, e1 = (u >> 23) & 0xffu; mx = mx > e0 ? mx : e0; mx = mx > e1 ? mx : e1; }
#if DBG_CNT
        { unsigned cnt = 0; for (size_t i = (size_t)F.bid * NTHR + F.tid; i < (size_t)1536 * 2048; i += (size_t)F.G * NTHR) { const unsigned u = q[i]; cnt += (((u >> 7) & 0xffu) == 0xffu) + (((u >> 23) & 0xffu) == 0xffu); }
          if (cnt) atomicAdd(F.ctl + CW_DBG, cnt); return; }
#endif
        atomicMax(F.ctl + CW_DBG, mx); return; }
    if (DBG_SUB == 3 && p != 4) return;
    if (p == 0) { scan_f32p(F, (const float*)(F.ws + WS_COS), (size_t)T * 64, code); scan_f32p(F, (const float*)(F.ws + WS_MOD), 2 * 2 * 6144, code); return; }
    if (p > 10 * NL) return;
    const int sub = (p - 1) % 10;
    switch (sub) {
    case 0: scan_bf16(F, WS_HM, (size_t)T * D, code); scan_bf16(F, WS_WIN, (size_t)NPAD * D, code); scan_bf16(F, WS_WOUT, (size_t)D * D, code); scan_bf16(F, WS_WUP, (size_t)16 * 512 * D, code);
            scan_bf16(F, WS_WDN, (size_t)16 * D * 256, code); scan_bf16(F, WS_PHIW, (size_t)2 * 64 * 2048, code); scan_bf16(F, WS_GUPT, 384 * 128, code); scan_f32p(F, (const float*)(F.ws + WS_PHIB), 256, code); break;
    case 1: scan_bf16(F, WS_NQ, (size_t)T * 384, code); scan_bf16(F, WS_KV6, (size_t)6 * T * 128, code); scan_bf16(F, WS_MQKV, (size_t)3 * T * 256, code); scan_bf16(F, WS_RFEAT, (size_t)T * RW, code);
            scan_f32p(F, (const float*)(F.ws + WS_GATE), (size_t)T * 32, code); break;
    case 2: scan_bf16(F, WS_KCMP, 2 * 2 * 512 * 64, code); scan_bf16(F, WS_VCMP, 2 * 2 * 512 * 64, code); scan_bf16(F, WS_KMEAN, 2 * 4 * 32 * 64, code);
            scan_bf16(F, WS_PT, (size_t)1536 * 4096, code); scan_bf16(F, WS_ZS, (size_t)1536 * 4096, code); scan_bf16(F, WS_YT, (size_t)1536 * 4096, code); scan_bf16(F, WS_Y0, (size_t)1536 * 4096, code);
            scan_f32p(F, (const float*)(F.ws + WS_BONUS), (size_t)T * 8, code); break;
    case 3: {
#if DBG_SUB == 3
        if (p == 4) { const unsigned* hm = (const unsigned*)(F.ws + WS_HM); bool b1 = false, b2 = false, b4 = false;
            for (size_t i = (size_t)F.bid * NTHR + F.tid; i < (size_t)T * 512; i += (size_t)F.G * NTHR) { const unsigned u = hm[i]; const int col = (int)(i & 511) * 2; const bool bad = ((u & 0x7f80u) == 0x7f80u) || ((u & 0x7f800000u) == 0x7f800000u);
                if (col < 384) b1 = b1 || bad; else if (col < 640) b2 = b2 || bad; }
            const unsigned* zs = (const unsigned*)(F.ws + WS_ZS);
            for (size_t i = (size_t)F.bid * NTHR + F.tid; i < (size_t)1536 * 2048; i += (size_t)F.G * NTHR) { const unsigned u = zs[i]; b4 = b4 || ((u & 0x7f80u) == 0x7f80u) || ((u & 0x7f800000u) == 0x7f800000u); }
            const unsigned bits = (__any(b1) ? 1u : 0u) | (__any(b2) ? 2u : 0u) | (__any(b4) ? 4u : 0u);
            if (bits && F.lane == 0) atomicOr(F.ctl + CW_DBG, bits); }
#else
        scan_bf16(F, WS_HM, (size_t)T * D, code); scan_bf16(F, WS_ZS, (size_t)1536 * 4096, code);
#endif
        } break;
    case 4: scan_bf16(F, WS_HM, (size_t)T * D, code); break;
    case 5: scan_f32p(F, F.out, (size_t)T * D, code); break;
    case 6: scan_bf16(F, WS_HM, (size_t)T * D, code); break;
    case 7: scan_bf16(F, WS_SORTA, (size_t)MAXROWS * D, code); break;
    case 8: scan_bf16(F, WS_HID, (size_t)MAXROWS * 256, code); break;
    case 9: scan_bf16(F, WS_YS, (size_t)2 * T * D, code); break;
    }
}
#endif
struct Args { const void* in[31]; float* out; unsigned char* ws; int ph_lo, ph_hi; };
constexpr int N_PHASES = 2 + 10 * NL + (DBG_MODE ? 1 : 0);

__global__ void __launch_bounds__(NTHR, 2) hybrid_fwd(Args args) {
    extern __shared__ __attribute__((aligned(16))) unsigned char lds_raw[];
    Frame F;
    F.lds = (LAS unsigned char*)lds_raw;
    F.MISC = (volatile LAS unsigned*)(F.lds + MISC_OFF);
    F.tid = threadIdx.x; F.lane = F.tid & 63; F.wave = __builtin_amdgcn_readfirstlane(F.tid >> 6);
    F.G = gridDim.x; F.bid = blockIdx.x;
    F.ws = (unsigned char*)(GAS unsigned char*)args.ws; F.out = (float*)(GAS float*)args.out; F.ctl = (unsigned*)(GAS unsigned*)(args.ws + WS_CTL);
    for (int u = F.tid; u < (LDS_BYTES - RING_BYTES) / 4; u += NTHR) ((LAS unsigned*)(F.lds + RING_BYTES))[u] = 0u;
    __syncthreads();
    if (F.tid < 31) *(LAS unsigned long long*)(F.lds + IN_OFF + 8 * F.tid) = (unsigned long long)args.in[F.tid];
    __syncthreads();
#if MK_PER_PHASE
#define GRID_BAR() do { } while (0)
#else
    XcdBarrier bar = xcd_barrier_post(F.ctl + CW_BAR, F.MISC + 8);
#define GRID_BAR() do { LAUNDER(F); xcd_barrier(bar, F.tid); } while (0)
#endif
    const int lo = args.ph_lo, hi = args.ph_hi;
    for (int ph_ = lo; ph_ < hi; ++ph_) {
        int ph = ph_; asm volatile("" : "+s"(ph));
#if DBG_MODE == 2
        if (ph > 0) { LAUNDER(F); dbg_check(F, ph - 1); }
#endif
#if DBG_MODE == 4
        if (blockIdx.x == 0) { const unsigned tnow = (unsigned)__builtin_amdgcn_s_memrealtime(); __hip_atomic_store((unsigned*)(args.ws + WS_CTL) + 3200 + ph_, tnow, RLX_AGENT); }
#endif
        for (int rep = 0; rep < ((REPEAT_PH >= 0 && ph_ == REPEAT_PH) ? 2 : 1); ++rep) {
        if (rep) GRID_BAR();
        if (ph == 0) { if (PH_EN(10)) { LAUNDER(F); phase_pro(F); LAUNDER(F); phase_a(F, 0, false, true); } }
#if DBG_MODE
        else if (ph == N_PHASES - 1) { LAUNDER(F);
#if DBG_MODE == 4
            const float dv = 100.f * floorf(4.f * log2f((float)(unsigned)(ld_ctl((const int*)(F.ctl + 3200 + DBG_TPH1)) - ld_ctl((const int*)(F.ctl + 3200 + DBG_TPH0)))) + DBG_QOFF);
            const float dv2 = 10000.f * floorf(4.f * log2f((float)(unsigned)(ld_ctl((const int*)(F.ctl + 3200 + DBG_TPH3)) - ld_ctl((const int*)(F.ctl + 3200 + DBG_TPH2)))) + DBG_QOFF);
            for (int i = F.bid * NTHR + F.tid; i < T * D; i += F.G * NTHR) F.out[i] = (i == 0) ? dv2 : dv;
            if (0)
#else
            const float dv = sqrtf((float)ld_ctl((const int*)(F.ctl + CW_DBG)));
#endif
            for (int i = F.bid * NTHR + F.tid; i < T * D; i += F.G * NTHR) F.out[i] = dv; }
        else if (ph == N_PHASES - 2) { if (PH_EN(11)) { LAUNDER(F); norm_rows(F, 0, true); } }
#else
        else if (ph == N_PHASES - 1) { if (PH_EN(11)) { LAUNDER(F); norm_rows(F, 0, true); } }
#endif
        else {
            const int layer = (ph - 1) / 10, sub = (ph - 1) % 10;
            switch (sub) {
            case 0: if (PH_EN(0)) { LAUNDER(F); phase_a(F, layer, true, layer > 0); } break;
            case 1: if (PH_EN(1)) { LAUNDER(F); pg8::Gemm g{(const bf16_t*)(F.ws + WS_HM), (const bf16_t*)(F.ws + WS_WIN), T, NPAD, D}; pg8::StaticOrder S; S.init(T, NPAD, F.G, F.bid, NPAD / 256 - 1);
                      EpiInProj E{(bf16_t*)(F.ws + WS_NQ), (bf16_t*)(F.ws + WS_KV6), (bf16_t*)(F.ws + WS_MQKV), (bf16_t*)(F.ws + WS_RFEAT), (float*)(F.ws + WS_GATE), (const float*)(F.ws + WS_COS), (const float*)(F.ws + WS_SIN)};
                      if (rep == 0) pg8::gemm_phase<EpiInProj, pg8::StaticOrder, true, true>(F.lds, g, S, E, F.tid);
                      else { EpiNull EN{(float*)(F.ws + WS_GATE)}; pg8::gemm_phase<EpiNull, pg8::StaticOrder, true, true>(F.lds, g, S, EN, F.tid); } } break;
            case 2: if (PH_EN(2)) { LAUNDER(F); phase_c(F, layer); LAUNDER(F); phase_d(F, layer, rep); } break;
            case 3: break;
            case 4: if (PH_EN(4)) { LAUNDER(F); phase_e(F, layer); } break;
            case 5: if (PH_EN(5)) { LAUNDER(F); pg8::Gemm g{(const bf16_t*)(F.ws + WS_HM), (const bf16_t*)(F.ws + WS_WOUT), T, D, D}; pg8::StaticOrder S; S.init(T, D, F.G, F.bid);
                      EpiOutProj E{layer == 0 ? INF(F, I_X) : F.out, F.out, (const float*)(F.ws + WS_MOD) + (size_t)layer * BATCH * 6144 + 2048};
                      if (rep == 0) pg8::gemm_phase<EpiOutProj, pg8::StaticOrder, true, true>(F.lds, g, S, E, F.tid);
                      else { EpiNull EN{(float*)(F.ws + WS_GATE)}; pg8::gemm_phase<EpiNull, pg8::StaticOrder, true, true>(F.lds, g, S, EN, F.tid); } } break;
            case 6: if (PH_EN(6)) { LAUNDER(F); phase_g1(F, layer); } break;
            case 7: break;
            case 8: if (PH_EN(8)) { LAUNDER(F); const int* rowinfo = (const int*)(F.ws + WS_ROWINFO + layer * ROWINFO_LSTRIDE); const int* tile_e = rowinfo + 2 * MAXROWS;
                      const int ntl = __builtin_amdgcn_readfirstlane(ld_ctl(tile_e + 256));
                      pg8::Gemm g{(const bf16_t*)(F.ws + WS_HM), (const bf16_t*)(F.ws + WS_WUP), MAXROWS, 512, D};
                      MoeGatherOrder S{ntl, 2, F.G, F.bid, tile_e, (size_t)512 * D * 2, (const int*)(F.ws + WS_ELIST)};
                      EpiMoeUp E{(bf16_t*)(F.ws + WS_HID)};
                      pg8::gemm_phase<EpiMoeUp, MoeGatherOrder, true, true>(F.lds, g, S, E, F.tid); } break;
            case 9: if (PH_EN(9)) { LAUNDER(F); const int* rowinfo = (const int*)(F.ws + WS_ROWINFO + layer * ROWINFO_LSTRIDE); const int* tile_e = rowinfo + 2 * MAXROWS;
                      const int ntl = __builtin_amdgcn_readfirstlane(ld_ctl(tile_e + 256));
                      pg8::Gemm g{(const bf16_t*)(F.ws + WS_HID), (const bf16_t*)(F.ws + WS_WDN), MAXROWS, D, 256};
                      MoeOrder S{ntl, 4, F.G, F.bid, tile_e, (size_t)D * 256 * 2, (const int*)(F.ws + WS_ELIST)};
                      EpiMoeDown E{(bf16_t*)(F.ws + WS_YS), tile_e, (const int*)(F.ws + WS_ELIST), (const float*)(F.ws + WS_EWW)};
                      pg8::gemm_phase<EpiMoeDown, MoeOrder, true, true>(F.lds, g, S, E, F.tid); } break;
            }
        }
        }
#if EXTRA_BAR
        if (ph_ == 0) { for (int eb = 0; eb < EXTRA_BAR; ++eb) GRID_BAR(); }
#endif
        if (ph_ + 1 < hi && !(ph_ >= 1 && ph_ <= 10 * NL && (((ph_ - 1) % 10) == 2 || ((ph_ - 1) % 10) == 3 || ((ph_ - 1) % 10) == 7))) GRID_BAR();
    }
}

extern "C" void kernel_launch(void* const* d_in, const int* in_sizes, int n_in, void* d_out, int out_size, void* d_ws, size_t ws_size, hipStream_t stream) {
    static int grid = 0;
    if (grid == 0) {
        if (n_in != 31 || out_size != T * D || ws_size < WS_END) { fprintf(stderr, "kernel_launch: unexpected shapes: n_in %d out %d ws %zu (need %zu)\n", n_in, out_size, ws_size, (size_t)WS_END); grid = -1; return; }
        int dev = 0, cus = 0, per_cu = 0;
        if (hipGetDevice(&dev) != hipSuccess || hipDeviceGetAttribute(&cus, hipDeviceAttributeMultiprocessorCount, dev) != hipSuccess) { grid = -1; return; }
        if (hipFuncSetAttribute((const void*)hybrid_fwd, hipFuncAttributeMaxDynamicSharedMemorySize, LDS_BYTES) != hipSuccess) { fprintf(stderr, "kernel_launch: hipFuncSetAttribute failed\n"); grid = -1; return; }
        if (hipOccupancyMaxActiveBlocksPerMultiprocessor(&per_cu, (const void*)hybrid_fwd, NTHR, LDS_BYTES) != hipSuccess || per_cu < 1) fprintf(stderr, "kernel_launch: occupancy query says %d\n", per_cu);
        (void)hipGetLastError();
        grid = cus;
    }
    if (grid < 0) return;
    (void)hipMemsetAsync((char*)d_ws + WS_CTL, 0, CTL_ZERO_BYTES, stream);
    Args a{};
    for (int i = 0; i < 31; ++i) a.in[i] = d_in[i];
    a.out = (float*)d_out; a.ws = (unsigned char*)d_ws;
#if MK_PER_PHASE
    for (int ph = 0; ph < N_PHASES; ++ph) { a.ph_lo = ph; a.ph_hi = ph + 1; hipLaunchKernelGGL(hybrid_fwd, dim3(grid), dim3(NTHR), LDS_BYTES, stream, a); }
#else
    a.ph_lo = 0; a.ph_hi = N_PHASES;
    hipLaunchKernelGGL(hybrid_fwd, dim3(grid), dim3(NTHR), LDS_BYTES, stream, a);
#endif
}
```

```cpp
#include <hip/hip_runtime.h>
#include <cstdio>
#include <cstdint>
#include <cmath>
#ifndef PH_MASK
#define PH_MASK 0xfff
#endif
#define PH_EN(k) ((PH_MASK >> (k)) & 1)
#ifndef MK_PER_PHASE
#define MK_PER_PHASE 0
#endif
namespace pg8 {
#define PG8_LAS __attribute__((address_space(3)))
typedef unsigned short bf16_t;
typedef short bf16x8 __attribute__((ext_vector_type(8)));
typedef float f32x4 __attribute__((ext_vector_type(4)));
typedef unsigned u32x4 __attribute__((ext_vector_type(4)));
constexpr int BM = 256, BK = 64, HALF = 128, HTB = HALF * BK * 2  , STAGE_BYTES = 8 * HTB, NXCD = 8, WGM = 8;

__host__ __device__ __forceinline__ int lds_byte(int r, int c) { const int st = (r >> 4) * 2 + (c >> 5), rr = r & 15, cc = c & 31, ob = rr * 64 + cc * 2; return st * 1024 + (ob ^ (((ob >> 9) & 1) << 5)); }
__host__ __device__ __forceinline__ void stage_rc(int b, int& R, int& C) { const int st = b / 1024, sb = b % 1024, swz = sb ^ (((sb >> 9) & 1) << 5); R = (st >> 1) * 16 + swz / 64; C = (st & 1) * 32 + (swz % 64) / 2; }
__host__ __device__ __forceinline__ int perm32(int rho) { const int n = rho >> 4, i = rho & 15; return 8 * (i >> 2) + 4 * n + (i & 3); }

struct Unit { int pm, pn, mask; };
struct Gemm { const bf16_t* A; const bf16_t* Bt; int M, N, K; };

__host__ __device__ __forceinline__ bool tail_split(int i, int G, int c, int total, int& L, int& f, int& sub) {
    const int rounds = total / G, nfull = rounds * G, ntail = total - nfull; f = 1; sub = 0;
    if (i < rounds) { L = i * G + c; return true; }
    if (i > rounds || ntail == 0) return false;
    f = (4 * ntail <= G) ? 4 : (2 * ntail <= G) ? 2 : 1;
    if (c >= ntail * f) return false;
    L = nfull + c / f; sub = c % f; return true;
}
struct StaticOrder {
    int nM, nN, nwg, G, c, padpn;
    __host__ __device__ void init(int M, int N, int G_, int c_, int padpn_ = -1) { nM = M / BM; nN = N / BM; nwg = nM * nN; G = G_; c = c_; padpn = padpn_; }
    __host__ __device__ bool next(int i, Unit& u) const {
        int L, f, sub; if (!tail_split(i, G, c, nwg, L, f, sub)) return false;
        int wgid = L; { const int q = nwg / NXCD, r = nwg % NXCD, xcd = wgid % NXCD, off = wgid / NXCD; wgid = (xcd < r ? xcd * (q + 1) : r * (q + 1) + (xcd - r) * q) + off; }
        const int nig = WGM * nN, gid = wgid / nig, fm = gid * WGM, gsz = (nM - fm) < WGM ? (nM - fm) : WGM;
        u.pm = fm + ((wgid % nig) % gsz); u.pn = (wgid % nig) / gsz;
        const bool pad = (u.pn == padpn);
        u.mask = (f == 1) ? (pad ? 0x5 : 0xF) : (f == 2) ? (pad ? (sub ? 0x4 : 0x1) : (sub ? 0xA : 0x5)) : ((1 << sub) & (pad ? 0x5 : 0xF));
        return true;
    }
    static constexpr bool GATHER = false;
    __device__ __forceinline__ void arows(const Unit&, const int (&)[2], int (&o)[2][2]) const { o[0][0] = o[0][1] = o[1][0] = o[1][1] = 0; }
    __device__ __forceinline__ void a_ready(const Unit&) const {}
    __device__ __forceinline__ size_t boff(const Unit&) const { return 0; }
    __device__ __forceinline__ void done(const Unit&) const {}
};

template <class Epi, class Sched, bool ALIGN_EPI = false, bool SP2 = false>
__device__ __forceinline__ void gemm_phase(PG8_LAS unsigned char* lds, const Gemm g, const Sched& S, const Epi& E, const int tid_in) {
    const int tid = tid_in, wid = __builtin_amdgcn_readfirstlane(tid >> 6), lane = tid & 63, wr = wid >> 2, wc = wid & 3, fr = lane & 15, fq = lane >> 4;
    const int K = g.K, nt = K / BK;
    unsigned voffA[2], voffB[2];
    int RA[2], CA[2];
    unsigned gA_cur[2][2], gA_nxt[2][2];
    static_assert(!Sched::GATHER || SP2, "row-gathered A is wired into the SP2 loop only");
#pragma unroll
    for (int i = 0; i < 2; ++i) { int R, C; stage_rc(tid * 16 + i * 8192, R, C); const int Rb = Epi::PERM ? ((R & ~31) + perm32(R & 31)) : R;
        voffA[i] = (unsigned)(R * K + C) * 2u; voffB[i] = (unsigned)(Rb * K + C) * 2u; RA[i] = R; CA[i] = C; }
#define PG8_GROWS(u, o) do { int ar_[2][2]; S.arows(u, RA, ar_); _Pragma("unroll") for (int h_ = 0; h_ < 2; ++h_) _Pragma("unroll") for (int i_ = 0; i_ < 2; ++i_) o[h_][i_] = (unsigned)(ar_[h_][i_] * K + CA[i_]) * 2u; } while (0)
    const size_t kstep = (size_t)(BK * 2);
    const size_t hstep = (size_t)HALF * K * 2;
    const size_t tstep = 2 * hstep;
    const unsigned ldsw = (unsigned)wid * 1024u;
    const int aoff = lds_byte(wr * 64 + fr, fq * 8), boff = lds_byte(wc * 32 + fr, fq * 8);
#define PG8_SA(b, h) (((b) * 2 + (h)) * HTB)
#define PG8_SB(b, h) ((4 + (b) * 2 + (h)) * HTB)
#define PG8_STAGE(bufoff, gbase, voff) do { _Pragma("unroll") for (int _i = 0; _i < 2; ++_i) \
        __builtin_amdgcn_global_load_lds((const unsigned*)((const char*)(gbase) + (voff)[_i]), (PG8_LAS unsigned*)(lds + (bufoff) + ldsw + _i * 8192), 16, 0, 0); } while (0)
#define PG8_STAGE_A(bufoff, gbase, half, nx) do { if constexpr (Sched::GATHER) { _Pragma("unroll") for (int _i = 0; _i < 2; ++_i) { const unsigned vo_ = (nx) ? gA_nxt[half][_i] : gA_cur[half][_i]; \
        __builtin_amdgcn_global_load_lds((const unsigned*)((const char*)(gbase) + vo_), (PG8_LAS unsigned*)(lds + (bufoff) + ldsw + _i * 8192), 16, 0, 0); } } else { PG8_STAGE(bufoff, (gbase) + (half) * hstep, voffA); } } while (0)
#define PG8_LDA(dst, b, h) do { _Pragma("unroll") for (int m = 0; m < 4; ++m) _Pragma("unroll") for (int k = 0; k < 2; ++k) dst[m][k] = *(const PG8_LAS bf16x8*)(lds + PG8_SA(b, h) + aoff + m * 2048 + k * 1024); } while (0)
#define PG8_LDB(dst, b, h) do { _Pragma("unroll") for (int n = 0; n < 2; ++n) _Pragma("unroll") for (int k = 0; k < 2; ++k) dst[n][k] = *(const PG8_LAS bf16x8*)(lds + PG8_SB(b, h) + boff + n * 2048 + k * 1024); } while (0)
#define PG8_MMA(ai, bj, At, Bt) do { if (cmask & (1 << ((ai) * 2 + (bj)))) PG8_MMA_(ai, bj, At, Bt); } while (0)
#define PG8_MMA_(ai, bj, At, Bt) do { __builtin_amdgcn_s_setprio(1); _Pragma("unroll") for (int m = 0; m < 4; ++m) _Pragma("unroll") for (int n = 0; n < 2; ++n) _Pragma("unroll") for (int k = 0; k < 2; ++k) \
        acc[ai][bj][m][n] = __builtin_amdgcn_mfma_f32_16x16x32_bf16(Bt[n][k], At[m][k], acc[ai][bj][m][n], 0, 0, 0); __builtin_amdgcn_s_setprio(0); } while (0)
#define PG8_WAIT_V(n) asm volatile("s_waitcnt vmcnt(" #n ")" ::: "memory")
#define PG8_WAIT_L(n) asm volatile("s_waitcnt lgkmcnt(" #n ")" ::: "memory")
#define PG8_BAR __builtin_amdgcn_s_barrier()
#define PG8_SCHED __builtin_amdgcn_sched_barrier(0)
    Unit cur, nxt; int ui = 0;
    if (!S.next(0, cur)) return;
    f32x4 acc[2][2][4][2];
#pragma unroll
    for (int a = 0; a < 2; ++a)
#pragma unroll
        for (int b = 0; b < 2; ++b)
#pragma unroll
            for (int m = 0; m < 4; ++m)
#pragma unroll
                for (int n = 0; n < 2; ++n) acc[a][b][m][n] = (f32x4){0.f, 0.f, 0.f, 0.f};
    bf16x8 At[4][2], B0[2][2], B1[2][2];
    const char* cA = (const char*)g.A + (Sched::GATHER ? (size_t)0 : (size_t)cur.pm * tstep); const char* cB = (const char*)g.Bt + S.boff(cur) + (size_t)cur.pn * tstep;
    S.a_ready(cur);
    if constexpr (Sched::GATHER) { PG8_GROWS(cur, gA_cur); }
    if constexpr (SP2) {
        PG8_STAGE(PG8_SB(0, 0), cB, voffB); PG8_STAGE(PG8_SB(0, 1), cB + hstep, voffB); PG8_STAGE_A(PG8_SA(0, 0), cA, 0, false); PG8_STAGE_A(PG8_SA(0, 1), cA, 1, false);
        if (wr == 1) PG8_BAR;
        PG8_WAIT_V(2); PG8_BAR;
        PG8_STAGE(PG8_SB(1, 0), cB + kstep, voffB); PG8_STAGE_A(PG8_SA(1, 0), cA + kstep, 0, false); PG8_STAGE(PG8_SB(1, 1), cB + hstep + kstep, voffB);
        PG8_WAIT_V(6); PG8_BAR;
    } else {
        PG8_STAGE(PG8_SB(0, 0), cB, voffB); PG8_STAGE(PG8_SA(0, 0), cA, voffA); PG8_STAGE(PG8_SB(0, 1), cB + hstep, voffB); PG8_STAGE(PG8_SA(0, 1), cA + hstep, voffA);
        if (wr == 1) PG8_BAR;
        PG8_WAIT_V(4); PG8_BAR;
        PG8_STAGE(PG8_SB(1, 0), cB + kstep, voffB); PG8_STAGE(PG8_SA(1, 0), cA + kstep, voffA); PG8_STAGE(PG8_SB(1, 1), cB + hstep + kstep, voffB);
        PG8_WAIT_V(6); PG8_BAR;
    }
    for (;;) {
        const int cmask = __builtin_amdgcn_readfirstlane(cur.mask);
        const bool has_next = S.next(ui + 1, nxt);
        const char* nA = has_next ? (const char*)g.A + (Sched::GATHER ? (size_t)0 : (size_t)nxt.pm * tstep) : cA; const char* nB = has_next ? (const char*)g.Bt + S.boff(nxt) + (size_t)nxt.pn * tstep : cB;
        if constexpr (Sched::GATHER) { if (has_next) { PG8_GROWS(nxt, gA_nxt); } }
        for (int t = 0; t < nt; t += 2) {
            const bool last = (t == nt - 2);
            const char* a1 = cA + (size_t)(t + 1) * kstep;
            const char* a2 = last ? nA : cA + (size_t)(t + 2) * kstep; const char* b2 = last ? nB : cB + (size_t)(t + 2) * kstep;
            const char* a3 = a2 + kstep; const char* b3 = b2 + kstep;
            if (last && has_next) S.a_ready(nxt);
            const bool usen = last && has_next;
            if constexpr (SP2) {
            PG8_LDB(B0, 0, 0); PG8_LDB(B1, 0, 1); PG8_SCHED; PG8_LDA(At, 0, 0); PG8_STAGE_A(PG8_SA(1, 1), a1, 1, false);
            PG8_WAIT_V(8); PG8_WAIT_L(0); PG8_BAR; PG8_MMA(0, 0, At, B0); PG8_MMA(0, 1, At, B1); PG8_BAR; PG8_SCHED;
            PG8_LDA(At, 0, 1); PG8_STAGE(PG8_SB(0, 0), b2, voffB); PG8_STAGE(PG8_SB(0, 1), b2 + hstep, voffB); PG8_STAGE_A(PG8_SA(0, 0), a2, 0, usen);
            PG8_WAIT_V(8); PG8_WAIT_L(0); PG8_BAR; PG8_MMA(1, 0, At, B0); PG8_MMA(1, 1, At, B1); PG8_BAR; PG8_SCHED;
            PG8_LDB(B0, 1, 0); PG8_LDB(B1, 1, 1); PG8_SCHED; PG8_LDA(At, 1, 0); PG8_STAGE_A(PG8_SA(0, 1), a2, 1, usen);
            PG8_WAIT_V(8); PG8_WAIT_L(0); PG8_BAR; PG8_MMA(0, 0, At, B0); PG8_MMA(0, 1, At, B1); PG8_BAR; PG8_SCHED;
            PG8_LDA(At, 1, 1); PG8_STAGE(PG8_SB(1, 0), b3, voffB); PG8_STAGE(PG8_SB(1, 1), b3 + hstep, voffB); PG8_STAGE_A(PG8_SA(1, 0), a3, 0, usen);
            PG8_WAIT_V(8); PG8_WAIT_L(0); PG8_BAR; PG8_MMA(1, 0, At, B0); PG8_MMA(1, 1, At, B1); PG8_BAR; PG8_SCHED;
            } else {
            PG8_LDB(B0, 0, 0); PG8_SCHED; PG8_LDA(At, 0, 0); PG8_STAGE(PG8_SA(1, 1), a1 + hstep, voffA);
            PG8_WAIT_L(8); PG8_BAR; PG8_WAIT_L(0); PG8_MMA(0, 0, At, B0); PG8_BAR; PG8_SCHED;
            PG8_LDB(B1, 0, 1); PG8_STAGE(PG8_SB(0, 0), b2, voffB);
            PG8_BAR; PG8_WAIT_L(0); PG8_MMA(0, 1, At, B1); PG8_BAR;
            PG8_LDA(At, 0, 1); PG8_STAGE(PG8_SA(0, 0), a2, voffA);
            PG8_BAR; PG8_WAIT_L(0); PG8_MMA(1, 0, At, B0); PG8_BAR; PG8_SCHED;
            PG8_STAGE(PG8_SB(0, 1), b2 + hstep, voffB);
            PG8_WAIT_V(6); PG8_BAR; PG8_MMA(1, 1, At, B1); PG8_BAR;
            PG8_LDB(B0, 1, 0); PG8_SCHED; PG8_LDA(At, 1, 0); PG8_STAGE(PG8_SA(0, 1), a2 + hstep, voffA);
            PG8_WAIT_L(8); PG8_BAR; PG8_WAIT_L(0); PG8_MMA(0, 0, At, B0); PG8_BAR; PG8_SCHED;
            PG8_LDB(B1, 1, 1); PG8_STAGE(PG8_SB(1, 0), b3, voffB);
            PG8_BAR; PG8_WAIT_L(0); PG8_MMA(0, 1, At, B1); PG8_BAR;
            PG8_LDA(At, 1, 1); PG8_STAGE(PG8_SA(1, 0), a3, voffA);
            PG8_BAR; PG8_WAIT_L(0); PG8_MMA(1, 0, At, B0); PG8_BAR; PG8_SCHED;
            PG8_STAGE(PG8_SB(1, 1), b3 + hstep, voffB);
            PG8_WAIT_V(6); PG8_BAR; PG8_MMA(1, 1, At, B1); PG8_BAR;
            }
        }
        if constexpr (ALIGN_EPI) { if (wr == 0) PG8_BAR; }
        if constexpr (!Epi::AFTER_DRAIN) { E(acc, cur, wr, wc, 0, 0); S.done(cur); }
        if (!has_next) break;
#pragma unroll
        for (int a = 0; a < 2; ++a)
#pragma unroll
            for (int b = 0; b < 2; ++b)
#pragma unroll
                for (int m = 0; m < 4; ++m)
#pragma unroll
                    for (int n = 0; n < 2; ++n) acc[a][b][m][n] = (f32x4){0.f, 0.f, 0.f, 0.f};
        cur = nxt; cA = nA; cB = nB; ++ui;
        if constexpr (Sched::GATHER) {
#pragma unroll
            for (int h_ = 0; h_ < 2; ++h_)
#pragma unroll
                for (int i_ = 0; i_ < 2; ++i_) gA_cur[h_][i_] = gA_nxt[h_][i_]; }
        if constexpr (ALIGN_EPI) { if (wr == 1) PG8_BAR; }
    }
    PG8_WAIT_V(0);
    if constexpr (!ALIGN_EPI) { if (wr == 0) PG8_BAR; }
    PG8_BAR;
    if constexpr (Epi::AFTER_DRAIN) { E.fused(acc, cur, wr, wc, fr, fq, lds, wid, lane); S.done(cur); }
#undef PG8_SA
#undef PG8_SB
#undef PG8_STAGE
#undef PG8_STAGE_A
#undef PG8_GROWS
#undef PG8_LDA
#undef PG8_LDB
#undef PG8_MMA
#undef PG8_MMA_
#undef PG8_WAIT_V
#undef PG8_WAIT_L
#undef PG8_BAR
#undef PG8_SCHED
}
}

constexpr int BATCH = 2, SEQ = 8192, T = BATCH * SEQ, D = 1024, NL = 2;
constexpr int NPAD = 3584, RW = 1408, INCOLS = 3346;
constexpr int NWAVES = 8, NTHR = 512;
constexpr float LOG2E = 1.4426950408889634f;
constexpr float NORM_EPS = 1e-6f;

#define GAS __attribute__((address_space(1)))
#define LAS __attribute__((address_space(3)))
typedef unsigned short bf16_t;
typedef short bf16x8 __attribute__((ext_vector_type(8)));
typedef short s16x4 __attribute__((ext_vector_type(4)));
typedef short v4i16_t __attribute__((ext_vector_type(4)));
typedef float f32x4 __attribute__((ext_vector_type(4)));
typedef float f32x16 __attribute__((ext_vector_type(16)));
typedef unsigned u32x4 __attribute__((ext_vector_type(4)));
typedef unsigned u32x2 __attribute__((ext_vector_type(2)));
typedef GAS unsigned gu32;

constexpr size_t MiB = 1u << 20, KiB = 1u << 10;
constexpr size_t WS_CTL = 0, CTL_ZERO_BYTES = 64 * KiB;
constexpr size_t WS_COS = 1 * MiB, WS_SIN = 3 * MiB;
constexpr size_t WS_MOD = 5 * MiB;
constexpr size_t WS_PHIB = WS_MOD + 128 * KiB;
constexpr size_t WS_KMEAN = WS_MOD + 192 * KiB;
constexpr size_t WS_KCMP = WS_MOD + 256 * KiB;
constexpr size_t WS_VCMP = WS_KCMP + 256 * KiB;
constexpr size_t WS_BONUS = 6 * MiB;
constexpr size_t WS_GATE = 7 * MiB;
constexpr size_t WS_ROUTE = 9 * MiB;
constexpr size_t WS_ROWINFO = 10 * MiB;
constexpr size_t ROWINFO_LSTRIDE = 512 * KiB;
constexpr int MAXROWS = 36864;
constexpr size_t WS_ELIST = 9 * MiB;
constexpr size_t WS_EWW = 11 * MiB;
constexpr int TE_OFF = 272, TE_CNT = 304;
constexpr size_t WS_WIN = 12 * MiB;
constexpr size_t WS_WOUT = 19 * MiB;
constexpr size_t WS_WUP = 21 * MiB;
constexpr size_t WS_WDN = 37 * MiB;
constexpr size_t WS_PHIW = 45 * MiB;
constexpr size_t WS_GUPT = 45 * MiB + 512 * KiB;
constexpr size_t WS_WUPT = 45 * MiB + 640 * KiB;
constexpr size_t WS_AUPT = 45 * MiB + 704 * KiB;
constexpr size_t WS_LORA = 46 * MiB;
constexpr size_t WS_HM = 46 * MiB;
constexpr size_t WS_NQ = 78 * MiB;
constexpr size_t WS_KV6 = 90 * MiB;
constexpr size_t KV6_STRIDE = (size_t)BATCH * 2 * SEQ * 64;
constexpr size_t WS_MQKV = 114 * MiB;
constexpr size_t MQKV_STRIDE = (size_t)BATCH * 4 * SEQ * 64;
constexpr size_t WS_RFEAT = 138 * MiB;
constexpr size_t WS_SORTA = 78 * MiB;
constexpr size_t WS_HID = 150 * MiB;
constexpr size_t WS_PT = 182 * MiB;
constexpr size_t WS_ZS = 194 * MiB;
constexpr size_t WS_YT = 206 * MiB;
constexpr size_t WS_Y0 = 218 * MiB;
constexpr size_t WS_YS = 182 * MiB;
constexpr size_t WS_SS = 230 * MiB;
constexpr size_t WS_END = 256 * MiB;
constexpr int CW_Q = 64;
constexpr int CW_CNT = 1024;
constexpr int CW_BAR = 4096;
constexpr int CW_DBG = 3072;
#ifndef DBG_MODE
#define DBG_MODE 0
#endif
#ifndef EXTRA_BAR
#define EXTRA_BAR 0
#endif
#ifndef REPEAT_PH
#define REPEAT_PH -1
#endif
#ifndef DBG_TPH0
#define DBG_TPH0 0
#endif
#ifndef DBG_TPH1
#define DBG_TPH1 1
#endif
#ifndef DBG_QOFF
#define DBG_QOFF 0.0f
#endif
#ifndef DBG_TPH2
#define DBG_TPH2 0
#endif
#ifndef DBG_TPH3
#define DBG_TPH3 1
#endif
#ifndef DBG_SUB
#define DBG_SUB 4
#endif
#ifndef DBG_P
#define DBG_P 4
#endif
#ifndef DBG_CNT
#define DBG_CNT 1
#endif

#define RLX_AGENT __ATOMIC_RELAXED, __HIP_MEMORY_SCOPE_AGENT
#define LDS_WAIT() asm volatile("s_waitcnt lgkmcnt(0)" ::: "memory")
#define VM_WAIT() asm volatile("s_waitcnt vmcnt(0)" ::: "memory")
__device__ __forceinline__ float bf2f(bf16_t h) { return __uint_as_float(((unsigned)h) << 16); }
typedef float f32x2_t __attribute__((ext_vector_type(2)));
typedef __bf16 bf16x2_t __attribute__((ext_vector_type(2)));
__device__ __forceinline__ unsigned pk2(float lo, float hi) { const f32x2_t v = {lo, hi}; return __builtin_bit_cast(unsigned, __builtin_convertvector(v, bf16x2_t)); }
__device__ __forceinline__ bf16_t f2bf(float f) { return (bf16_t)(pk2(f, 0.f) & 0xffffu); }
__device__ __forceinline__ float shx(float v, int mask, int lane) { return __uint_as_float(__builtin_amdgcn_ds_bpermute((lane ^ mask) << 2, __float_as_uint(v))); }
__device__ __forceinline__ int shxi(int v, int mask, int lane) { return __builtin_amdgcn_ds_bpermute((lane ^ mask) << 2, v); }
template <int CTRL> __device__ __forceinline__ float dpp_mov(float v) { return __uint_as_float(__builtin_amdgcn_update_dpp(0u, __float_as_uint(v), CTRL, 0xf, 0xf, true)); }
__device__ __forceinline__ float half_sum32(float v) { const unsigned u = __float_as_uint(v); auto r = __builtin_amdgcn_permlane32_swap(u, u, false, false); return __uint_as_float(r[0]) + __uint_as_float(r[1]); }
__device__ __forceinline__ float row_sum16(float v) { const unsigned u = __float_as_uint(v); auto r = __builtin_amdgcn_permlane16_swap(u, u, false, false); return __uint_as_float(r[0]) + __uint_as_float(r[1]); }
__device__ __forceinline__ float wave_sum(float v, int lane) {
    (void)lane;
    v += dpp_mov<0xB1>(v); v += dpp_mov<0x4E>(v); v += dpp_mov<0x141>(v); v += dpp_mov<0x140>(v);
    return half_sum32(row_sum16(v));
}
__device__ __forceinline__ float tanh_fast(float x) { const float xc = fminf(fmaxf(x, -15.f), 15.f); return 1.f - 2.f * __builtin_amdgcn_rcpf(__builtin_amdgcn_exp2f(xc * (2.f * LOG2E)) + 1.f); }
__device__ __forceinline__ float sigm(float x) { return __builtin_amdgcn_rcpf(1.f + __expf(-x)); }
__device__ __forceinline__ int ld_ctl(const int* p) { return __hip_atomic_load(p, RLX_AGENT); }
__device__ __forceinline__ float ld_ctlf(const float* p) { return __uint_as_float(__hip_atomic_load((const unsigned*)p, RLX_AGENT)); }
#define MFMA16(a, b, c) __builtin_amdgcn_mfma_f32_16x16x32_bf16(a, b, c, 0, 0, 0)
#define MFMA32(a, b, c) __builtin_amdgcn_mfma_f32_32x32x16_bf16(a, b, c, 0, 0, 0)

#define XB_TMO      128
#define XB_XCNT(j)  (256  + 64 * (j))
#define XB_XSUB(j)  (1280 + 64 * (j))
#define XB_XGEN(j)  (2304 + 64 * (j))
#define XB_TOP      3328
#define XB_TOPGEN   3392
#define XCD_BAR_WORDS 3456
#define XB_SPIN_CAP (1u << 22)
__device__ __forceinline__ unsigned xb_ld(unsigned* p)              { return __hip_atomic_load(p, __ATOMIC_RELAXED, __HIP_MEMORY_SCOPE_AGENT); }
__device__ __forceinline__ unsigned xb_add(unsigned* p, unsigned v) { return __hip_atomic_fetch_add(p, v, __ATOMIC_RELAXED, __HIP_MEMORY_SCOPE_AGENT); }
__device__ __forceinline__ unsigned xb_xcc_id() { return (unsigned)__builtin_amdgcn_s_getreg((3 << 11) | 20) & 0xFu; }
#define XB_SPIN(cond, bar) do { unsigned _sp = 0; while (cond) { __builtin_amdgcn_s_sleep(1); \
    if ((++_sp & 255u) == 0u) { if (xb_ld(&(bar)[XB_TMO])) break; if (_sp > XB_SPIN_CAP) { atomicAdd(&(bar)[XB_TMO], 1u); break; } } } } while (0)
struct XcdBarrier { unsigned* bar; unsigned x; volatile LAS unsigned* st; };
__device__ __forceinline__ XcdBarrier xcd_barrier_post(unsigned* bar, volatile LAS unsigned* st) {
    XcdBarrier b; b.bar = bar; b.x = xb_xcc_id(); b.st = st;
    if (threadIdx.x == 0) (void)xb_add(&bar[XB_XCNT(b.x)], 1u);
    return b;
}
__device__ __forceinline__ void xcd_barrier_complete(unsigned* bar, unsigned x, unsigned& nloc, unsigned& nx) {
    const unsigned G = gridDim.x * gridDim.y * gridDim.z;
    unsigned sum, cnt, mine, sp = 0u;
    for (;;) {
        sum = 0u; cnt = 0u; mine = 0u;
#pragma unroll
        for (unsigned j = 0; j < 16; ++j) { const unsigned c = xb_ld(&bar[XB_XCNT(j)]); sum += c; cnt += (c > 0u) ? 1u : 0u; mine = (j == x) ? c : mine; }
        if (sum == G) break;
        __builtin_amdgcn_s_sleep(1);
        if ((++sp & 255u) == 0u) { if (xb_ld(&bar[XB_TMO])) break; if (sp > XB_SPIN_CAP) { atomicAdd(&bar[XB_TMO], 1u); break; } }
    }
    nloc = mine > 0u ? mine : 1u; nx = cnt > 0u ? cnt : 1u;
}
__device__ __forceinline__ void xcd_barrier(const XcdBarrier& b, const int tid) {
    asm volatile("s_waitcnt vmcnt(0)" ::: "memory");
    __syncthreads();
    if (tid == 0) {
        unsigned* bar = b.bar;
        __builtin_amdgcn_s_waitcnt(0);
        unsigned nloc = b.st[0], nx = b.st[1];
        if (nloc == 0u) { xcd_barrier_complete(bar, b.x, nloc, nx); b.st[0] = nloc; b.st[1] = nx; }
        const unsigned old = xb_add(&bar[XB_XSUB(b.x)], 1u);
        const unsigned gen = old / nloc;
        if (old + 1u == (gen + 1u) * nloc) {
            __builtin_amdgcn_fence(__ATOMIC_RELEASE, "agent");
            asm volatile("s_waitcnt vmcnt(0)" ::: "memory");
            const unsigned og = xb_add(&bar[XB_TOP], 1u);
            const unsigned tg = og / nx;
            if (og + 1u == (tg + 1u) * nx) xb_add(&bar[XB_TOPGEN], 1u);
            else XB_SPIN(xb_ld(&bar[XB_TOPGEN]) == tg, bar);
            __builtin_amdgcn_fence(__ATOMIC_ACQUIRE, "agent");
            xb_add(&bar[XB_XGEN(b.x)], 1u);
            asm volatile("s_waitcnt vmcnt(0)" ::: "memory");
        } else {
            XB_SPIN(xb_ld(&bar[XB_XGEN(b.x)]) == gen, bar);
            __builtin_amdgcn_fence(__ATOMIC_ACQUIRE, "agent");
            asm volatile("s_waitcnt vmcnt(0)" ::: "memory");
        }
    }
    __syncthreads();
}

constexpr int RING_BYTES = 131072, MISC_OFF = RING_BYTES + 320, LDS_BYTES = 147456;
struct Frame {
    LAS unsigned char* lds;
    volatile LAS unsigned* MISC;
    unsigned* ctl;
    int tid, lane, wave, G, bid;
    unsigned char* ws;
    float* out;
};
constexpr int IN_OFF = RING_BYTES + 1024;
__device__ __forceinline__ const float* inptr(const LAS unsigned char* lds, int k) {
    int z = 0; asm volatile("" : "+v"(z));
    const LAS unsigned* p = (const LAS unsigned*)(lds + IN_OFF + z) + 2 * k;
    const unsigned lo = __builtin_amdgcn_readfirstlane(p[0]), hi = __builtin_amdgcn_readfirstlane(p[1]);
    return (const float*)(const GAS float*)(((unsigned long long)hi << 32) | lo); }
#define INF(F, k) inptr((F).lds, k)
#define LAUNDER(F) do { GAS unsigned char* w_ = (GAS unsigned char*)(F).ws; GAS float* o_ = (GAS float*)(F).out; int g_ = (F).G, b_ = (F).bid, wv_ = (F).wave, z_ = 0; asm volatile("" : "+s"(w_), "+s"(o_), "+s"(g_), "+s"(b_), "+s"(wv_), "+s"(z_)); \
    int l_ = (int)__builtin_amdgcn_mbcnt_hi(~0u, __builtin_amdgcn_mbcnt_lo(~0u, (unsigned)z_)); asm volatile("" : "+v"(l_)); \
    (F).ws = (unsigned char*)w_; (F).out = (float*)o_; (F).ctl = (unsigned*)(GAS unsigned*)w_; (F).G = g_; (F).bid = b_; (F).wave = wv_; (F).lane = l_; (F).tid = wv_ * 64 + l_; } while (0)
enum { I_X = 0, I_C, I_POS, I_WMOD, I_BMOD, I_NMIX, I_NFFN, I_WIN, I_PHIW1, I_PHIW2, I_PHIPOS, I_MU, I_WUP, I_W0, I_AUP, I_A0, I_GUP, I_KK, I_KA, I_RK, I_LNW, I_LNB,
       I_NNSA, I_NMOBA, I_WOUT, I_WROUTER, I_RBIAS, I_MGATE, I_MUP, I_MDOWN, I_NFINAL };

__device__ const float g_invf[32] = {1.000000000e+00f, 7.498942018e-01f, 5.623413324e-01f, 4.216965139e-01f, 3.162277639e-01f, 2.371373773e-01f, 1.778279394e-01f, 1.333521456e-01f,
    1.000000015e-01f, 7.498942316e-02f, 5.623413250e-02f, 4.216964915e-02f, 3.162277490e-02f, 2.371373773e-02f, 1.778279431e-02f, 1.333521400e-02f, 9.999999776e-03f, 7.498942316e-03f,
    5.623413250e-03f, 4.216964822e-03f, 3.162277630e-03f, 2.371373819e-03f, 1.778279431e-03f, 1.333521446e-03f, 1.000000047e-03f, 7.498941850e-04f, 5.623413017e-04f, 4.216965172e-04f,
    3.162277571e-04f, 2.371373703e-04f, 1.778279402e-04f, 1.333521504e-04f};
__device__ __forceinline__ void phase_pro(Frame& F) {
    const int* pos = (const int*)INF(F, I_POS);
    float* cosT = (float*)(F.ws + WS_COS); float* sinT = (float*)(F.ws + WS_SIN);
    for (int idx = F.bid * NTHR + F.tid; idx < T * 32; idx += F.G * NTHR) {
        const int row = idx >> 5, i = idx & 31;
        const float ang = (float)pos[row] * g_invf[i];
        float sv, cv; sincosf(ang, &sv, &cv);
        cosT[idx] = cv; sinT[idx] = sv;
    }
    LAS float* red = (LAS float*)F.lds;
    for (int chunk = F.bid; chunk < NL * 96; chunk += F.G) {
        const int l = chunk / 96, j0 = (chunk % 96) * 64;
        const float* W = INF(F, I_WMOD) + (size_t)l * D * 6144 + j0 + F.lane;
        const float* c = INF(F, I_C);
        float a0 = 0.f, a1 = 0.f;
        const int k0 = F.wave * 128;
#pragma unroll 32
        for (int k = 0; k < 128; ++k) {
            const float w = W[(size_t)(k0 + k) * 6144];
            const float c0 = c[k0 + k], c1 = c[D + k0 + k];
            a0 += w * (c0 * sigm(c0)); a1 += w * (c1 * sigm(c1));
        }
        red[(F.wave * 2 + 0) * 64 + F.lane] = a0; red[(F.wave * 2 + 1) * 64 + F.lane] = a1;
        __syncthreads();
        if (F.wave < 2) {
            float s = INF(F, I_BMOD)[l * 6144 + j0 + F.lane];
#pragma unroll
            for (int w = 0; w < 8; ++w) s += red[(w * 2 + F.wave) * 64 + F.lane];
            ((float*)(F.ws + WS_MOD))[((size_t)l * BATCH + F.wave) * 6144 + j0 + F.lane] = s;
        }
        __syncthreads();
    }
}

__device__ __forceinline__ void transpose_item(int ldw, int K, bf16_t* WT, int n0, int k0, LAS float* scr, int lane, const float* src) {
    const int n4 = lane & 7, kr = lane >> 3;
#pragma unroll
    for (int i = 0; i < 8; ++i) { const int kk = 8 * i + kr; f32x4 v = (f32x4){0.f, 0.f, 0.f, 0.f};
        if (src) { const float* p = src + (size_t)(k0 + kk) * ldw; v.x = p[0]; v.y = p[1]; v.z = p[2]; v.w = p[3]; }
        scr[kk * 33 + 4 * n4] = v.x; scr[kk * 33 + 4 * n4 + 1] = v.y; scr[kk * 33 + 4 * n4 + 2] = v.z; scr[kk * 33 + 4 * n4 + 3] = v.w; }
    LDS_WAIT(); asm volatile("" ::: "memory");
    const int c = lane & 7;
#pragma unroll
    for (int j = 0; j < 4; ++j) { const int n = (lane >> 3) + 8 * j; const LAS float* sp = scr + (8 * c) * 33 + n;
        u32x4 o; o.x = pk2(sp[0 * 33], sp[1 * 33]); o.y = pk2(sp[2 * 33], sp[3 * 33]); o.z = pk2(sp[4 * 33], sp[5 * 33]); o.w = pk2(sp[6 * 33], sp[7 * 33]);
        *(u32x4*)(WT + (size_t)(n0 + n) * K + k0 + 8 * c) = o; }
    LDS_WAIT(); asm volatile("" ::: "memory");
}
__device__ __forceinline__ const float* cm_in(const float* W, int pos) {
        const int G = pos >> 6, p = pos & 63, w = p >> 5, n = (p >> 4) & 1, q = p & 15, d = 16 * w + q + 32 * n;
        int sc;
        if (G < 6) sc = G * 64 + d; else if (G < 18) sc = 384 + (G - 6) * 64 + d; else if (G < 30) sc = 1170 + (G - 18) * 64 + d;
        else if (G < 52) sc = 1938 + (G - 30) * 64 + d; else if (G == 52 && d < 18) sc = 1152 + d; else return nullptr;
        return W + sc; }
__device__ __forceinline__ const float* cm_up(const float* Wg, const float* Wu, int pos) { const int Wd = pos >> 5, n = (pos >> 4) & 1, q = pos & 15, f = 16 * Wd + q; return (n ? Wu : Wg) + f; }

__device__ __forceinline__ void norm_rows(Frame& F, int layer, bool final_) {
    const float* xin = INF(F, I_X);
    const bf16_t* ys = (const bf16_t*)(F.ws + WS_YS);
    const float* mod = (const float*)(F.ws + WS_MOD);
    bf16_t* H = (bf16_t*)(F.ws + WS_HM);
    const int gw = F.bid * NWAVES + F.wave, NGW = F.G * NWAVES;
    for (int m = gw; m < T; m += NGW) {
        const int b = m >> 13;
        f32x4 v[4]; float ss = 0.f;
        if (layer == 0 && !final_) {
#pragma unroll
            for (int j = 0; j < 4; ++j) v[j] = *(const f32x4*)(xin + (size_t)m * D + 4 * F.lane + 256 * j);
        } else {
            const int pl = final_ ? NL - 1 : layer - 1;
            const float* g2 = mod + ((size_t)pl * BATCH + b) * 6144 + 5120;
#pragma unroll
            for (int j = 0; j < 4; ++j) {
                const int col = 4 * F.lane + 256 * j;
                f32x4 x = *(const f32x4*)(F.out + (size_t)m * D + col);
                const u32x2 a = *(const u32x2*)(ys + (size_t)m * D + col), c = *(const u32x2*)(ys + (size_t)(T + m) * D + col);
                const f32x4 g = *(const f32x4*)(g2 + col);
                x.x += g.x * (__uint_as_float(a.x << 16) + __uint_as_float(c.x << 16));
                x.y += g.y * (__uint_as_float(a.x & 0xffff0000u) + __uint_as_float(c.x & 0xffff0000u));
                x.z += g.z * (__uint_as_float(a.y << 16) + __uint_as_float(c.y << 16));
                x.w += g.w * (__uint_as_float(a.y & 0xffff0000u) + __uint_as_float(c.y & 0xffff0000u));
                v[j] = x;
                if (!final_) *(f32x4*)(F.out + (size_t)m * D + col) = x;
            }
        }
#pragma unroll
        for (int j = 0; j < 4; ++j) ss += (v[j].x * v[j].x + v[j].y * v[j].y) + (v[j].z * v[j].z + v[j].w * v[j].w);
        const float rstd = rsqrtf(wave_sum(ss, F.lane) * (1.f / D) + NORM_EPS);
#if DBG_MODE == 1
        if (final_) { float bad = 0.f;
#pragma unroll
            for (int j = 0; j < 4; ++j) { bad += (fabsf(v[j].x) <= 3e38f) ? 0.f : 1.f; bad += (fabsf(v[j].y) <= 3e38f) ? 0.f : 1.f; bad += (fabsf(v[j].z) <= 3e38f) ? 0.f : 1.f; bad += (fabsf(v[j].w) <= 3e38f) ? 0.f : 1.f; }
            bad = wave_sum(bad, F.lane); if (F.lane == 0 && bad > 0.f) atomicAdd(F.ctl + CW_DBG, (unsigned)bad); }
#endif
        if (final_) {
            const float* gn = INF(F, I_NFINAL);
#pragma unroll
            for (int j = 0; j < 4; ++j) { const int col = 4 * F.lane + 256 * j; const f32x4 g = *(const f32x4*)(gn + col);
                f32x4 o; o.x = v[j].x * rstd * g.x; o.y = v[j].y * rstd * g.y; o.z = v[j].z * rstd * g.z; o.w = v[j].w * rstd * g.w;
                *(f32x4*)(F.out + (size_t)m * D + col) = o; }
        } else {
            const float* gn = INF(F, I_NMIX) + layer * D;
            const float* sh = mod + ((size_t)layer * BATCH + b) * 6144; const float* sc = sh + 1024;
#pragma unroll
            for (int j = 0; j < 4; ++j) { const int col = 4 * F.lane + 256 * j;
                const f32x4 g = *(const f32x4*)(gn + col), s1 = *(const f32x4*)(sc + col), s0 = *(const f32x4*)(sh + col);
                u32x2 o; o.x = pk2(v[j].x * rstd * g.x * (1.f + s1.x) + s0.x, v[j].y * rstd * g.y * (1.f + s1.y) + s0.y);
                o.y = pk2(v[j].z * rstd * g.z * (1.f + s1.z) + s0.z, v[j].w * rstd * g.w * (1.f + s1.w) + s0.w);
                *(u32x2*)(H + (size_t)m * D + col) = o; }
        }
    }
}
__device__ __forceinline__ void phase_a(Frame& F, int layer, bool do_norm, bool do_conv) {
    if (do_norm) { norm_rows(F, layer, false); LAUNDER(F); }
    if (!do_conv) return;
    LAS float* scr = (LAS float*)(F.lds + F.wave * 16384);
    const int gw = F.bid * NWAVES + F.wave, NGW = F.G * NWAVES;
    constexpr int I_IN = 16 * 112, I_OUT = 16 * 32, I_UPI = 16 * 16 * 16, I_DN = 16 * 4 * 32, I_PHI = 2 * 32 * 2, I_GU = 2 * 12, I_LR = 2 * 12;
    constexpr int NIT = I_IN + I_OUT + I_UPI + I_DN + I_PHI + I_GU + I_LR;
    for (int it = gw; it < NIT; it += NGW) {
        int r = it;
        const int l31 = 4 * (F.lane & 7);
        if (r < I_IN) { const int kb = r / 112, nb = r % 112;
            transpose_item(INCOLS, D, (bf16_t*)(F.ws + WS_WIN), nb * 32, kb * 64, scr, F.lane, cm_in(INF(F, I_WIN) + (size_t)layer * D * INCOLS, nb * 32 + l31)); continue; } r -= I_IN;
        if (r < I_OUT) { const int kb = r / 32, nb = r % 32;
            transpose_item(D, D, (bf16_t*)(F.ws + WS_WOUT), nb * 32, kb * 64, scr, F.lane, INF(F, I_WOUT) + (size_t)layer * D * D + nb * 32 + l31); continue; } r -= I_OUT;
        if (r < I_UPI) { const int e = r / 256, q = r % 256, kb = q / 16, nb = q % 16;
            transpose_item(256, D, (bf16_t*)(F.ws + WS_WUP) + (size_t)e * 512 * D, nb * 32, kb * 64, scr, F.lane,
                           cm_up(INF(F, I_MGATE) + ((size_t)layer * 16 + e) * D * 256, INF(F, I_MUP) + ((size_t)layer * 16 + e) * D * 256, nb * 32 + l31)); continue; } r -= I_UPI;
        if (r < I_DN) { const int e = r / 128, q = r % 128, kb = q / 32, nb = q % 32;
            transpose_item(D, 256, (bf16_t*)(F.ws + WS_WDN) + (size_t)e * D * 256, nb * 32, kb * 64, scr, F.lane, INF(F, I_MDOWN) + ((size_t)layer * 16 + e) * 256 * D + nb * 32 + l31); continue; } r -= I_DN;
        if (r < I_PHI) { const int kv = r / 64, q = r % 64, kb = q / 2, nb = q % 2;
            transpose_item(64, 2048, (bf16_t*)(F.ws + WS_PHIW) + (size_t)kv * 64 * 2048, nb * 32, kb * 64, scr, F.lane, INF(F, I_PHIW1) + ((size_t)layer * 2 + kv) * 2048 * 64 + nb * 32 + l31); continue; } r -= I_PHI;
        if (r < I_GU) { const int kb = r / 12, nb = r % 12;
            transpose_item(384, 128, (bf16_t*)(F.ws + WS_GUPT), nb * 32, kb * 64, scr, F.lane, INF(F, I_GUP) + (size_t)layer * 128 * 384 + nb * 32 + l31); continue; } r -= I_GU;
        { const int which = r / 12, nb = r % 12;
            transpose_item(384, 64, (bf16_t*)(F.ws + (which ? WS_AUPT : WS_WUPT)), nb * 32, 0, scr, F.lane, INF(F, which ? I_AUP : I_WUP) + (size_t)layer * 64 * 384 + nb * 32 + l31); }
    }
    LAUNDER(F);
    if (F.bid == F.G - 1) {
        __syncthreads();
        LAS float* part = (LAS float*)F.lds;
#pragma unroll 1
        for (int kv = 0; kv < 2; ++kv) {
            const float* w1 = INF(F, I_PHIW1) + ((size_t)layer * 2 + kv) * 2048 * 64 + (size_t)F.wave * 256 * 64; const float* pp = INF(F, I_PHIPOS) + ((size_t)layer * 2 + kv) * 2048 + F.wave * 256;
            float a[4] = {0.f, 0.f, 0.f, 0.f};
#pragma unroll 1
            for (int k = 0; k < 256; k += 16) {
                float wv[16];
#pragma unroll
                for (int u = 0; u < 16; ++u) wv[u] = w1[(size_t)(k + u) * 64 + F.lane];
#pragma unroll
                for (int u = 0; u < 16; ++u) a[u & 3] += pp[k + u] * wv[u];
            }
            part[(F.wave * 2 + kv) * 64 + F.lane] = (a[0] + a[1]) + (a[2] + a[3]);
        }
        __syncthreads();
        if (F.wave < 2) { float sacc = 0.f;
#pragma unroll
            for (int w = 0; w < 8; ++w) sacc += part[(w * 2 + F.wave) * 64 + F.lane];
            ((float*)(F.ws + WS_PHIB))[(layer * 2 + F.wave) * 64 + F.lane] = sacc; }
    }
}

struct EpiInProj {
    static constexpr bool PERM = false, AFTER_DRAIN = false;
    bf16_t* nq; bf16_t* kv6; bf16_t* mqkv; bf16_t* rfeat; float* gate; const float* cosT; const float* sinT;
    __device__ __forceinline__ void operator()(const f32x4 (&acc)[2][2][4][2], const pg8::Unit& u, int wr, int wc, int fr_, int fq_) const {
        int z_ = 0; asm volatile("" : "+s"(z_)); int l_ = (int)__builtin_amdgcn_mbcnt_hi(~0u, __builtin_amdgcn_mbcnt_lo(~0u, (unsigned)z_)); asm volatile("" : "+v"(l_)); const int fr = l_ & 15, fq = l_ >> 4; (void)fr_; (void)fq_;
#pragma unroll
        for (int bj = 0; bj < 2; ++bj) {
            const int G = 4 * u.pn + 2 * bj + (wc >> 1), w = wc & 1;
            if (G >= 53) continue;
            const int qm = u.mask >> bj;
            const int d0 = 16 * w + 4 * fq;
            const bool rope = (G < 6) || (G == 10) || (G == 11) || (G == 14) || (G == 15) || (G >= 18 && G < 26);
            const float scl = (G < 6 || (G >= 18 && G < 22)) ? 0.125f * LOG2E : 1.0f;
#pragma unroll
            for (int ai = 0; ai < 2; ++ai) {
                if (!((qm >> (2 * ai)) & 1)) continue;
#pragma unroll
                for (int m = 0; m < 4; ++m) {
                    const int row = 256 * u.pm + 128 * ai + 64 * wr + 16 * m + fr, b = row >> 13, t = row & (SEQ - 1);
                    f32x4 x1 = acc[ai][bj][m][0], x2 = acc[ai][bj][m][1];
                    if (rope) {
                        const f32x4 c = *(const f32x4*)(cosT + (size_t)row * 32 + d0), s = *(const f32x4*)(sinT + (size_t)row * 32 + d0);
                        const f32x4 y1 = (x1 * c - x2 * s) * scl, y2 = (x2 * c + x1 * s) * scl; x1 = y1; x2 = y2;
                    }
                    if (G == 52) {
                        float* gp = gate + (size_t)row * 32;
                        *(f32x4*)(gp + d0) = x1;
                        continue;
                    }
                    bf16_t* dst;
                    if (G < 6) dst = nq + ((size_t)(b * 6 + G) * SEQ + t) * 64;
                    else if (G < 18) dst = kv6 + (size_t)((G - 6) >> 1) * KV6_STRIDE + ((size_t)(b * 2 + ((G - 6) & 1)) * SEQ + t) * 64;
                    else if (G < 30) dst = mqkv + (size_t)((G - 18) >> 2) * MQKV_STRIDE + ((size_t)(b * 4 + ((G - 18) & 3)) * SEQ + t) * 64;
                    else dst = rfeat + (size_t)row * RW + (G - 30) * 64;
                    auto sx = __builtin_amdgcn_permlane16_swap(pk2(x1.x, x1.y), pk2(x2.x, x2.y), false, false);
                    auto sy = __builtin_amdgcn_permlane16_swap(pk2(x1.z, x1.w), pk2(x2.z, x2.w), false, false);
                    u32x4 o; o.x = sx[0]; o.y = sy[0]; o.z = sx[1]; o.w = sy[1];
                    *(u32x4*)(dst + ((fq & 1) ? d0 - 4 + 32 : d0)) = o;
                }
            }
        }
    }
};
struct EpiNull {
    static constexpr bool PERM = false, AFTER_DRAIN = false;
    float* sink;
    __device__ __forceinline__ void operator()(const f32x4 (&acc)[2][2][4][2], const pg8::Unit& u, int wr, int wc, int fr_, int fq_) const {
        f32x4 s = (f32x4){0.f, 0.f, 0.f, 0.f};
#pragma unroll
        for (int ai = 0; ai < 2; ++ai)
#pragma unroll
            for (int bj = 0; bj < 2; ++bj)
#pragma unroll
                for (int m = 0; m < 4; ++m)
#pragma unroll
                    for (int n = 0; n < 2; ++n) s += acc[ai][bj][m][n];
        if (s.x + s.y + s.z + s.w == 123456.789f) sink[0] = s.x;
    }
};
struct EpiOutProj {
    static constexpr bool PERM = false, AFTER_DRAIN = false;
    const float* xold; float* xnew; const float* g1;
    __device__ __forceinline__ void operator()(const f32x4 (&acc)[2][2][4][2], const pg8::Unit& u, int wr, int wc, int fr_, int fq_) const {
        int z_ = 0; asm volatile("" : "+s"(z_)); int l_ = (int)__builtin_amdgcn_mbcnt_hi(~0u, __builtin_amdgcn_mbcnt_lo(~0u, (unsigned)z_)); asm volatile("" : "+v"(l_)); const int fr = l_ & 15, fq = l_ >> 4; (void)fr_; (void)fq_;
#pragma unroll
        for (int ai = 0; ai < 2; ++ai)
#pragma unroll
            for (int m = 0; m < 4; ++m) {
                const int row = 256 * u.pm + 128 * ai + 64 * wr + 16 * m + fr, b = row >> 13;
#pragma unroll
                for (int bj = 0; bj < 2; ++bj)
#pragma unroll
                    for (int n = 0; n < 2; ++n) {
                        if (!((u.mask >> (2 * ai + bj)) & 1)) continue;
                        const int col = 256 * u.pn + 128 * bj + 32 * wc + 16 * n + 4 * fq;
                        const f32x4 g = *(const f32x4*)(g1 + (size_t)b * 6144 + col);
                        const f32x4 xo = *(const f32x4*)(xold + (size_t)row * D + col);
                        *(f32x4*)(xnew + (size_t)row * D + col) = xo + g * acc[ai][bj][m][n];
                    }
            }
    }
};
struct EpiMoeUp {
    static constexpr bool PERM = false, AFTER_DRAIN = false;
    bf16_t* hid;
    __device__ __forceinline__ void operator()(const f32x4 (&acc)[2][2][4][2], const pg8::Unit& u, int wr, int wc, int fr_, int fq_) const {
        int z_ = 0; asm volatile("" : "+s"(z_)); int l_ = (int)__builtin_amdgcn_mbcnt_hi(~0u, __builtin_amdgcn_mbcnt_lo(~0u, (unsigned)z_)); asm volatile("" : "+v"(l_)); const int fr = l_ & 15, fq = l_ >> 4; (void)fr_; (void)fq_;
#pragma unroll
        for (int ai = 0; ai < 2; ++ai)
#pragma unroll
            for (int m = 0; m < 4; ++m) {
                const int row = 256 * u.pm + 128 * ai + 64 * wr + 16 * m + fr;
                u32x2 ob[2];
#pragma unroll
                for (int bj = 0; bj < 2; ++bj) { const f32x4 g = acc[ai][bj][m][0], up = acc[ai][bj][m][1];
                    ob[bj].x = pk2(g.x * sigm(g.x) * up.x, g.y * sigm(g.y) * up.y); ob[bj].y = pk2(g.z * sigm(g.z) * up.z, g.w * sigm(g.w) * up.w); }
                if (((u.mask >> (2 * ai)) & 3) == 3) {
                    auto sx = __builtin_amdgcn_permlane16_swap(ob[0].x, ob[1].x, false, false);
                    auto sy = __builtin_amdgcn_permlane16_swap(ob[0].y, ob[1].y, false, false);
                    u32x4 o; o.x = sx[0]; o.y = sy[0]; o.z = sx[1]; o.w = sy[1];
                    const int f0 = (fq & 1) ? 16 * (8 * u.pn + 4 + wc) + 4 * (fq - 1) : 16 * (8 * u.pn + wc) + 4 * fq;
                    *(u32x4*)(hid + (size_t)row * 256 + f0) = o;
                } else {
#pragma unroll
                    for (int bj = 0; bj < 2; ++bj) {
                        if (!((u.mask >> (2 * ai + bj)) & 1)) continue;
                        *(u32x2*)(hid + (size_t)row * 256 + 16 * (8 * u.pn + 4 * bj + wc) + 4 * fq) = ob[bj];
                    }
                }
            }
    }
};
struct EpiMoeDown {
    static constexpr bool PERM = false, AFTER_DRAIN = false;
    bf16_t* ys; const int* tile_e; const int* elist; const float* eww;
    __device__ __forceinline__ void operator()(const f32x4 (&acc)[2][2][4][2], const pg8::Unit& u, int wr, int wc, int fr_, int fq_) const {
        int z_ = 0; asm volatile("" : "+s"(z_)); int l_ = (int)__builtin_amdgcn_mbcnt_hi(~0u, __builtin_amdgcn_mbcnt_lo(~0u, (unsigned)z_)); asm volatile("" : "+v"(l_)); const int fr = l_ & 15, fq = l_ >> 4; (void)fr_; (void)fq_;
        const int e = __builtin_amdgcn_readfirstlane(ld_ctl(tile_e + u.pm)), off = __builtin_amdgcn_readfirstlane(ld_ctl(tile_e + TE_OFF + e)), cnt = __builtin_amdgcn_readfirstlane(ld_ctl(tile_e + TE_CNT + e));
        int ri[2][4]; float wv[2][4];
#pragma unroll
        for (int ai = 0; ai < 2; ++ai)
#pragma unroll
            for (int m = 0; m < 4; ++m) { const int local = 256 * u.pm + 128 * ai + 64 * wr + 16 * m + fr - off, idx = e * 16384 + (local < cnt ? local : 0); ri[ai][m] = elist[idx]; wv[ai][m] = eww[idx]; }
#pragma unroll
        for (int ai = 0; ai < 2; ++ai)
#pragma unroll
            for (int m = 0; m < 4; ++m) {
                const int local = 256 * u.pm + 128 * ai + 64 * wr + 16 * m + fr - off;
                if (local >= cnt) continue;
                const float w = wv[ai][m];
                bf16_t* dst = ys + ((size_t)(ri[ai][m] & 1) * T + (ri[ai][m] >> 1)) * D;
#pragma unroll
                for (int bj = 0; bj < 2; ++bj) {
                    if (!((u.mask >> (2 * ai + bj)) & 1)) continue;
                    const f32x4 v0 = acc[ai][bj][m][0] * w, v1 = acc[ai][bj][m][1] * w;
                    auto sx = __builtin_amdgcn_permlane16_swap(pk2(v0.x, v0.y), pk2(v1.x, v1.y), false, false);
                    auto sy = __builtin_amdgcn_permlane16_swap(pk2(v0.z, v0.w), pk2(v1.z, v1.w), false, false);
                    u32x4 o; o.x = sx[0]; o.y = sy[0]; o.z = sx[1]; o.w = sy[1];
                    const int col = 256 * u.pn + 128 * bj + 32 * wc + ((fq & 1) ? 16 + 4 * (fq - 1) : 4 * fq);
                    *(u32x4*)(dst + col) = o;
                }
            }
    }
};
template <bool GATHER_>
struct MoeOrderT {
    static constexpr bool GATHER = GATHER_;
    int ntiles, nN, G, c; const int* tile_e; size_t estride; const int* elist;
    __device__ __forceinline__ void arows(const pg8::Unit& u, const int (&RA)[2], int (&o)[2][2]) const {
        const int e = __builtin_amdgcn_readfirstlane(ld_ctl(tile_e + u.pm)), off = __builtin_amdgcn_readfirstlane(ld_ctl(tile_e + TE_OFF + e)), c = __builtin_amdgcn_readfirstlane(ld_ctl(tile_e + TE_CNT + e));
        int ri[2][2];
#pragma unroll
        for (int h = 0; h < 2; ++h)
#pragma unroll
            for (int i = 0; i < 2; ++i) { const int local = 256 * u.pm + 128 * h + RA[i] - off; ri[h][i] = elist[e * 16384 + (local < c ? local : 0)]; }
#pragma unroll
        for (int h = 0; h < 2; ++h)
#pragma unroll
            for (int i = 0; i < 2; ++i) { const int local = 256 * u.pm + 128 * h + RA[i] - off; o[h][i] = (local < c) ? (ri[h][i] >> 1) : 0; }
    }
    __device__ __forceinline__ bool next(int i, pg8::Unit& u) const { int L, f, sub; const int U = ntiles * nN;
        if ((G & 7) == 0) { const int x = c & 7, j = c >> 3, nb = G >> 3, U8 = (U + 7) >> 3, lo = x * U8, n = (lo + U8 <= U) ? U8 : (U > lo ? U - lo : 0);
            if (!pg8::tail_split(i, nb, j, n, L, f, sub)) return false; L += lo; }
        else if (!pg8::tail_split(i, G, c, U, L, f, sub)) return false;
        u.pm = L / nN; u.pn = L % nN; u.mask = (f == 1) ? 0xF : (f == 2) ? (sub ? 0xA : 0x5) : (1 << sub); return true; }
    __device__ __forceinline__ void a_ready(const pg8::Unit&) const {}
    __device__ __forceinline__ size_t boff(const pg8::Unit& u) const { return (size_t)__builtin_amdgcn_readfirstlane(ld_ctl(tile_e + u.pm)) * estride; }
    __device__ __forceinline__ void done(const pg8::Unit&) const {}
};
typedef MoeOrderT<false> MoeOrder;
typedef MoeOrderT<true> MoeGatherOrder;

__device__ __forceinline__ float gelu_tanh(float x) { const float u = 0.7978845608028654f * (x + 0.044715f * x * x * x); return 0.5f * x * (1.f + tanhf(u)); }

__device__ __forceinline__ void compress_unit(Frame& F, int layer, int u) {
    const int kvsel = u >> 5, b = (u >> 4) & 1, kvh = (u >> 3) & 1, rt = u & 7, i0 = 64 * rt;
    const bf16_t* src = (const bf16_t*)(F.ws + WS_KV6) + (size_t)kvsel * KV6_STRIDE + (size_t)(b * 2 + kvh) * SEQ * 64;
    const bf16_t* w1t = (const bf16_t*)(F.ws + WS_PHIW) + (size_t)kvsel * 64 * 2048;
    const int lane = F.lane, r = lane & 15, kg = lane >> 4;
    f32x4 acc[4][4];
#pragma unroll
    for (int a = 0; a < 4; ++a)
#pragma unroll
        for (int c = 0; c < 4; ++c) acc[a][c] = (f32x4){0.f, 0.f, 0.f, 0.f};
#pragma unroll 2
    for (int lq = 0; lq < 4; ++lq) {
        const int l = 4 * F.wave + lq;
#pragma unroll
        for (int ks = 0; ks < 2; ++ks) {
            bf16x8 af[4], bfr[4];
#pragma unroll
            for (int mt = 0; mt < 4; ++mt) af[mt] = *(const bf16x8*)(src + ((size_t)(16 * (i0 + 16 * mt + r) + l)) * 64 + 32 * ks + 8 * kg);
#pragma unroll
            for (int nt = 0; nt < 4; ++nt) bfr[nt] = *(const bf16x8*)(w1t + (size_t)(16 * nt + r) * 2048 + l * 64 + 32 * ks + 8 * kg);
#pragma unroll
            for (int mt = 0; mt < 4; ++mt)
#pragma unroll
                for (int nt = 0; nt < 4; ++nt) acc[mt][nt] = MFMA16(af[mt], bfr[nt], acc[mt][nt]);
        }
    }
    LAS float* part = (LAS float*)F.lds;
#pragma unroll
    for (int mt = 0; mt < 4; ++mt)
#pragma unroll
        for (int nt = 0; nt < 4; ++nt)
#pragma unroll
            for (int q = 0; q < 4; ++q) part[(F.wave * 64 + 16 * mt + 4 * kg + q) * 64 + 16 * nt + r] = acc[mt][nt][q];
    __syncthreads();
    const float* phib = (const float*)(F.ws + WS_PHIB) + (layer * 2 + kvsel) * 64;
    float hv[8];
    const int row = F.tid >> 3, e0 = (F.tid & 7) * 8;
#pragma unroll
    for (int k = 0; k < 8; ++k) { float s = phib[e0 + k];
#pragma unroll
        for (int w = 0; w < 8; ++w) s += part[(w * 64 + row) * 64 + e0 + k];
        hv[k] = gelu_tanh(s); }
    __syncthreads();
    LAS float* hb = (LAS float*)F.lds;
    LAS float* ob = (LAS float*)(F.lds + 32768);
#pragma unroll
    for (int k = 0; k < 8; ++k) hb[row * 65 + e0 + k] = hv[k];
    __syncthreads();
    const float* w2 = INF(F, I_PHIW2) + ((size_t)layer * 2 + kvsel) * 64 * 64;
    float o[8];
#pragma unroll
    for (int k = 0; k < 8; ++k) o[k] = 0.f;
#pragma unroll 8
    for (int e = 0; e < 64; ++e) { const float h = hb[row * 65 + e]; const f32x4 wa = *(const f32x4*)(w2 + e * 64 + e0), wb = *(const f32x4*)(w2 + e * 64 + e0 + 4);
        o[0] += h * wa.x; o[1] += h * wa.y; o[2] += h * wa.z; o[3] += h * wa.w; o[4] += h * wb.x; o[5] += h * wb.y; o[6] += h * wb.z; o[7] += h * wb.w; }
#pragma unroll
    for (int k = 0; k < 8; ++k) ob[row * 65 + e0 + k] = o[k];
    __syncthreads();
    const int i = i0 + row;
    bf16_t* dst = (bf16_t*)(F.ws + (kvsel ? WS_VCMP : WS_KCMP)) + ((size_t)(b * 2 + kvh) * 512 + i) * 64 + e0;
    float y[8];
    if (i >= 511) {
#pragma unroll
        for (int k = 0; k < 8; ++k) y[k] = 0.f;
    } else if (kvsel == 0) {
        const size_t pr = (size_t)b * SEQ + 16 * i + 31;
        const float* cs = (const float*)(F.ws + WS_COS) + pr * 32; const float* sn = (const float*)(F.ws + WS_SIN) + pr * 32;
#pragma unroll
        for (int k = 0; k < 8; ++k) { const int d = e0 + k, f = d & 31; const float x1 = ob[row * 65 + f], x2 = ob[row * 65 + f + 32];
            y[k] = (d < 32) ? (x1 * cs[f] - x2 * sn[f]) : (x2 * cs[f] + x1 * sn[f]); }
    } else {
#pragma unroll
        for (int k = 0; k < 8; ++k) y[k] = o[k];
    }
    u32x4 pk; pk.x = pk2(y[0], y[1]); pk.y = pk2(y[2], y[3]); pk.z = pk2(y[4], y[5]); pk.w = pk2(y[6], y[7]);
    *(u32x4*)dst = pk;
    __syncthreads();
}
__device__ __forceinline__ void kmean_task(Frame& F, int wt) {
    const int b = wt >> 7, h = (wt >> 5) & 3, blk = wt & 31, sub = F.lane >> 3, ch = F.lane & 7;
    const bf16_t* mk = (const bf16_t*)(F.ws + WS_MQKV) + MQKV_STRIDE + ((size_t)(b * 4 + h) * SEQ + 256 * blk) * 64;
    float a[8];
#pragma unroll
    for (int k = 0; k < 8; ++k) a[k] = 0.f;
#pragma unroll 8
    for (int it = 0; it < 32; ++it) {
        const u32x4 v = *(const u32x4*)(mk + (size_t)(8 * it + sub) * 64 + 8 * ch);
        a[0] += __uint_as_float(v.x << 16); a[1] += __uint_as_float(v.x & 0xffff0000u); a[2] += __uint_as_float(v.y << 16); a[3] += __uint_as_float(v.y & 0xffff0000u);
        a[4] += __uint_as_float(v.z << 16); a[5] += __uint_as_float(v.z & 0xffff0000u); a[6] += __uint_as_float(v.w << 16); a[7] += __uint_as_float(v.w & 0xffff0000u);
    }
#pragma unroll
    for (int k = 0; k < 8; ++k) { a[k] += shx(a[k], 8, F.lane); a[k] += shx(a[k], 16, F.lane); a[k] += shx(a[k], 32, F.lane); a[k] *= (1.f / 256.f); }
    if (sub == 0) { u32x4 o; o.x = pk2(a[0], a[1]); o.y = pk2(a[2], a[3]); o.z = pk2(a[4], a[5]); o.w = pk2(a[6], a[7]);
        *(u32x4*)((bf16_t*)(F.ws + WS_KMEAN) + ((size_t)(b * 4 + h) * 32 + blk) * 64 + 8 * ch) = o; }
}

constexpr int R1_TASK_OFF = 32768, R1_TASK_BYTES = 12288;
__device__ __forceinline__ unsigned bf_hi(float x) { return __float_as_uint(x) >> 16; }
__device__ __forceinline__ void r1_block(Frame& F, int layer, int bt) {
    const int chain = bt >> 4, b = chain / 6, h = chain % 6, lane0 = F.lane;
    const int chunk = 8 * (bt & 15) + F.wave, task = chain * 128 + chunk;
    LAS float* tb = (LAS float*)(F.lds + R1_TASK_OFF + F.wave * R1_TASK_BYTES);
    LAS float* Lr = tb; LAS float* Lw = tb + 512; LAS float* Lk = tb + 1024; LAS float* Lkk = tb + 1536; LAS float* Lbb = tb + 2048; LAS float* Lv = tb + 2560;
    const bf16_t* rf = (const bf16_t*)(F.ws + WS_RFEAT);
    const float* mu = INF(F, I_MU) + layer * RW;
    float* bonus = (float*)(F.ws + WS_BONUS);
    bf16_t* ytil = (bf16_t*)(F.ws + WS_YT) + (size_t)task * 4096; bf16_t* y0o = (bf16_t*)(F.ws + WS_Y0) + (size_t)task * 4096;
    bf16_t* lora = (bf16_t*)(F.ws + (task < 896 ? (size_t)242 * MiB + (size_t)task * 16384 : task < 1344 ? WS_WIN + (size_t)(task - 896) * 16384 : WS_ROUTE + (size_t)(task - 1344) * 16384));
    {
        const int c31 = lane0 & 31, hi = lane0 >> 5;
        f32x16 aw[2][2], aa[2][2];
#pragma unroll
        for (int mt = 0; mt < 2; ++mt)
#pragma unroll
            for (int nt = 0; nt < 2; ++nt)
#pragma unroll
                for (int r = 0; r < 16; ++r) { aw[mt][nt][r] = 0.f; aa[mt][nt][r] = 0.f; }
        const bf16_t* wt = (const bf16_t*)(F.ws + WS_WUPT) + (size_t)(h * 64) * 64; const bf16_t* at = (const bf16_t*)(F.ws + WS_AUPT) + (size_t)(h * 64) * 64;
#pragma unroll
        for (int ks = 0; ks < 4; ++ks) {
            const int j0 = 16 * ks + 8 * hi;
            bf16x8 fw[2], fa[2], bw[2], ba[2];
#pragma unroll
            for (int nt = 0; nt < 2; ++nt) { bw[nt] = *(const bf16x8*)(wt + (32 * nt + c31) * 64 + j0); ba[nt] = *(const bf16x8*)(at + (32 * nt + c31) * 64 + j0); }
#pragma unroll
            for (int mt = 0; mt < 2; ++mt) {
                const int t = 64 * chunk + 32 * mt + c31; const int rowi = b * SEQ + t;
                const u32x4 cw = *(const u32x4*)(rf + (size_t)rowi * RW + 1152 + j0), ca = *(const u32x4*)(rf + (size_t)rowi * RW + 1216 + j0);
                u32x4 pw = (u32x4){0u, 0u, 0u, 0u}, pa = (u32x4){0u, 0u, 0u, 0u};
                if (t > 0) { pw = *(const u32x4*)(rf + (size_t)(rowi - 1) * RW + 1152 + j0); pa = *(const u32x4*)(rf + (size_t)(rowi - 1) * RW + 1216 + j0); }
                const f32x4 mw0 = *(const f32x4*)(mu + 1152 + j0), mw1 = *(const f32x4*)(mu + 1152 + j0 + 4), ma0 = *(const f32x4*)(mu + 1216 + j0), ma1 = *(const f32x4*)(mu + 1216 + j0 + 4);
                const float mwv[8] = {mw0.x, mw0.y, mw0.z, mw0.w, mw1.x, mw1.y, mw1.z, mw1.w}, mav[8] = {ma0.x, ma0.y, ma0.z, ma0.w, ma1.x, ma1.y, ma1.z, ma1.w};
                const unsigned cwv[4] = {cw.x, cw.y, cw.z, cw.w}, pwv[4] = {pw.x, pw.y, pw.z, pw.w}, cav[4] = {ca.x, ca.y, ca.z, ca.w}, pav[4] = {pa.x, pa.y, pa.z, pa.w};
                float xw[8], xa[8];
#pragma unroll
                for (int k = 0; k < 4; ++k) {
                    const float c0 = __uint_as_float(cwv[k] << 16), c1 = __uint_as_float(cwv[k] & 0xffff0000u), p0 = __uint_as_float(pwv[k] << 16), p1 = __uint_as_float(pwv[k] & 0xffff0000u);
                    xw[2 * k] = tanh_fast(c0 + (p0 - c0) * mwv[2 * k]); xw[2 * k + 1] = tanh_fast(c1 + (p1 - c1) * mwv[2 * k + 1]);
                    const float d0 = __uint_as_float(cav[k] << 16), d1 = __uint_as_float(cav[k] & 0xffff0000u), q0 = __uint_as_float(pav[k] << 16), q1 = __uint_as_float(pav[k] & 0xffff0000u);
                    xa[2 * k] = d0 + (q0 - d0) * mav[2 * k]; xa[2 * k + 1] = d1 + (q1 - d1) * mav[2 * k + 1];
                }
                u32x4 uw, ua; uw.x = pk2(xw[0], xw[1]); uw.y = pk2(xw[2], xw[3]); uw.z = pk2(xw[4], xw[5]); uw.w = pk2(xw[6], xw[7]);
                ua.x = pk2(xa[0], xa[1]); ua.y = pk2(xa[2], xa[3]); ua.z = pk2(xa[4], xa[5]); ua.w = pk2(xa[6], xa[7]);
                fw[mt] = __builtin_bit_cast(bf16x8, uw); fa[mt] = __builtin_bit_cast(bf16x8, ua);
            }
#pragma unroll
            for (int mt = 0; mt < 2; ++mt)
#pragma unroll
                for (int nt = 0; nt < 2; ++nt) { aw[mt][nt] = MFMA32(fw[mt], bw[nt], aw[mt][nt]); aa[mt][nt] = MFMA32(fa[mt], ba[nt], aa[mt][nt]); }
        }
#pragma unroll
        for (int mt = 0; mt < 2; ++mt)
#pragma unroll
            for (int nt = 0; nt < 2; ++nt)
#pragma unroll
                for (int r = 0; r < 16; ++r) { const int tl = 32 * mt + (r & 3) + 8 * (r >> 2) + 4 * hi;
                    lora[tl * 64 + 32 * nt + c31] = f2bf(aw[mt][nt][r]); lora[4096 + tl * 64 + 32 * nt + c31] = f2bf(aa[mt][nt][r]); }
        asm volatile("s_waitcnt vmcnt(0)" ::: "memory");
    }
    float Wrun = 1.f;
    f32x16 XP[2][2], XZ[2][2];
    { const int c31 = lane0 & 31, hi = lane0 >> 5;
#pragma unroll
      for (int mt = 0; mt < 2; ++mt)
#pragma unroll
          for (int nt = 0; nt < 2; ++nt)
#pragma unroll
              for (int r = 0; r < 16; ++r) { XP[mt][nt][r] = (32 * mt + (r & 3) + 8 * (r >> 2) + 4 * hi == 32 * nt + c31) ? 1.f : 0.f; XZ[mt][nt][r] = 0.f; } }
#pragma unroll 1
    for (int sub = 0; sub < 8; ++sub) {
        int lane = lane0, hc = h * 64 + lane0; asm volatile("" : "+v"(lane), "+v"(hc));
#pragma unroll 1
        for (int half = 0; half < 2; ++half) {
            float rs4[4], ks4[4], vs4[4], aw4[4], aa4[4];
            const float mu_r = mu[hc], mu_k = mu[384 + hc], mu_v = mu[768 + hc];
            const float w0 = INF(F, I_W0)[layer * 384 + hc], a0 = INF(F, I_A0)[layer * 384 + hc];
#pragma unroll
            for (int q = 0; q < 4; ++q) {
                const int tl = 8 * sub + 4 * half + q, t = 64 * chunk + tl; const int rowi = b * SEQ + t;
                const bf16_t* cur = rf + (size_t)rowi * RW; const bf16_t* prv = cur - RW; const bool hp = t > 0;
                const float rc = bf2f(cur[hc]), kc = bf2f(cur[384 + hc]), vc = bf2f(cur[768 + hc]);
                const float rp = hp ? bf2f(prv[hc]) : 0.f, kp = hp ? bf2f(prv[384 + hc]) : 0.f, vp = hp ? bf2f(prv[768 + hc]) : 0.f;
                rs4[q] = rc + (rp - rc) * mu_r; ks4[q] = kc + (kp - kc) * mu_k; vs4[q] = vc + (vp - vc) * mu_v;
                aw4[q] = w0 + bf2f(lora[tl * 64 + lane]); aa4[q] = a0 + bf2f(lora[4096 + tl * 64 + lane]);
            }
            const float k_k = INF(F, I_KK)[layer * 384 + hc], k_a = INF(F, I_KA)[layer * 384 + hc], r_k = INF(F, I_RK)[layer * 384 + hc];
#pragma unroll
            for (int q = 0; q < 4; ++q) {
                const int tt = 4 * half + q; const int rowi = b * SEQ + 64 * chunk + 8 * sub + tt;
                const float dec = __expf(-0.606531f * sigm(aw4[q])), a = sigm(aa4[q]);
                float kk = ks4[q] * k_k; const float n2 = wave_sum(kk * kk, lane); kk = kk * __builtin_amdgcn_rsqf(fmaxf(n2, 1e-24f));
                const float km = ks4[q] * (1.f + (a - 1.f) * k_a);
                const float bn = wave_sum(rs4[q] * km * r_k, lane);
                const float Wprev = Wrun; Wrun *= dec; const float iW = __builtin_amdgcn_rcpf(Wrun);
                Lr[tt * 64 + lane] = rs4[q] * Wrun; Lk[tt * 64 + lane] = km * iW; Lkk[tt * 64 + lane] = -(kk * Wprev); Lbb[tt * 64 + lane] = kk * a * iW; Lv[tt * 64 + lane] = vs4[q];
                if (lane == 0) bonus[(size_t)rowi * 8 + h] = bn;
            }
        }
        LDS_WAIT(); asm volatile("" ::: "memory");
        const int c31 = lane & 31, hi = lane >> 5;
#pragma unroll 1
        for (int tt = 0; tt < 8; ++tt) {
            f32x4 k4[2][4], r4[2][4];
#pragma unroll
            for (int mt = 0; mt < 2; ++mt)
#pragma unroll
                for (int rq = 0; rq < 4; ++rq) { const int c0 = tt * 64 + 32 * mt + 8 * rq + 4 * hi;
                    k4[mt][rq] = *(const LAS f32x4*)(Lkk + c0); r4[mt][rq] = *(const LAS f32x4*)(Lr + c0); }
            float saP[2], saZ[2];
#pragma unroll
            for (int nt = 0; nt < 2; ++nt) { f32x2_t p2 = {0.f, 0.f}, z2 = {0.f, 0.f};
#pragma unroll
                for (int mt = 0; mt < 2; ++mt)
#pragma unroll
                    for (int r = 0; r < 16; r += 2) { const f32x2_t kk2 = {k4[mt][r >> 2][r & 3], k4[mt][r >> 2][(r & 3) + 1]};
                        const f32x2_t xp2 = {XP[mt][nt][r], XP[mt][nt][r + 1]}, xz2 = {XZ[mt][nt][r], XZ[mt][nt][r + 1]};
                        p2 = __builtin_elementwise_fma(xp2, kk2, p2); z2 = __builtin_elementwise_fma(xz2, kk2, z2); }
                float p = p2.x + p2.y, z = z2.x + z2.y;
                p = half_sum32(p); z = half_sum32(z); saP[nt] = p; saZ[nt] = z; }
            bf16x8 af[2], bP[2], bZ[2];
#pragma unroll
            for (int mt = 0; mt < 2; ++mt) { const float bbv = Lbb[tt * 64 + 32 * mt + c31], kv = Lk[tt * 64 + 32 * mt + c31];
                const unsigned bh = bf_hi(bbv), kh = bf_hi(kv); const unsigned bl = bf_hi(bbv - __uint_as_float(bh << 16)), kl = bf_hi(kv - __uint_as_float(kh << 16));
                u32x4 u; u.x = bh | (bl << 16); u.y = bh | (kh << 16); u.z = kl | (kh << 16); u.w = 0u;
                if (hi) u = (u32x4){0u, 0u, 0u, 0u};
                af[mt] = __builtin_bit_cast(bf16x8, u); }
#pragma unroll
            for (int nt = 0; nt < 2; ++nt) { const float vv = Lv[tt * 64 + 32 * nt + c31];
                const unsigned ph = bf_hi(saP[nt]), zh = bf_hi(saZ[nt]), vh = bf_hi(vv);
                const unsigned pl = bf_hi(saP[nt] - __uint_as_float(ph << 16)), zl = bf_hi(saZ[nt] - __uint_as_float(zh << 16)), vl = bf_hi(vv - __uint_as_float(vh << 16));
                u32x4 up, uz; up.x = ph | (ph << 16); up.y = pl; up.z = 0u; up.w = 0u;
                uz.x = zh | (zh << 16); uz.y = zl | (vh << 16); uz.z = vh | (vl << 16); uz.w = 0u;
                if (hi) { up = (u32x4){0u, 0u, 0u, 0u}; uz = (u32x4){0u, 0u, 0u, 0u}; }
                bP[nt] = __builtin_bit_cast(bf16x8, up); bZ[nt] = __builtin_bit_cast(bf16x8, uz); }
#pragma unroll
            for (int mt = 0; mt < 2; ++mt)
#pragma unroll
                for (int nt = 0; nt < 2; ++nt) { XP[mt][nt] = MFMA32(af[mt], bP[nt], XP[mt][nt]); XZ[mt][nt] = MFMA32(af[mt], bZ[nt], XZ[mt][nt]); }
#pragma unroll
            for (int nt = 0; nt < 2; ++nt) { f32x2_t p2 = {0.f, 0.f}, z2 = {0.f, 0.f};
#pragma unroll
                for (int mt = 0; mt < 2; ++mt)
#pragma unroll
                    for (int r = 0; r < 16; r += 2) { const f32x2_t rr2 = {r4[mt][r >> 2][r & 3], r4[mt][r >> 2][(r & 3) + 1]};
                        const f32x2_t xp2 = {XP[mt][nt][r], XP[mt][nt][r + 1]}, xz2 = {XZ[mt][nt][r], XZ[mt][nt][r + 1]};
                        p2 = __builtin_elementwise_fma(xp2, rr2, p2); z2 = __builtin_elementwise_fma(xz2, rr2, z2); }
                float p = p2.x + p2.y, z = z2.x + z2.y;
                p = half_sum32(p); z = half_sum32(z);
                if (hi == 0) { ytil[(8 * sub + tt) * 64 + 32 * nt + c31] = f2bf(p); y0o[(8 * sub + tt) * 64 + 32 * nt + c31] = f2bf(z); } }
        }
    }
    int lane_e = lane0; asm volatile("" : "+v"(lane_e));
    Lw[lane_e] = Wrun; LDS_WAIT(); asm volatile("" ::: "memory");
    { const int hi_ = lane_e >> 5;
#pragma unroll
      for (int mt = 0; mt < 2; ++mt)
#pragma unroll
          for (int rq = 0; rq < 4; ++rq) { const f32x4 wl = *(const LAS f32x4*)(Lw + 32 * mt + 8 * rq + 4 * hi_);
#pragma unroll
              for (int nt = 0; nt < 2; ++nt)
#pragma unroll
                  for (int k = 0; k < 4; ++k) { XP[mt][nt][4 * rq + k] *= wl[k]; XZ[mt][nt][4 * rq + k] *= wl[k]; } } }
    { const int c31 = lane_e & 31, hi = lane_e >> 5;
      bf16_t* PT = (bf16_t*)(F.ws + WS_PT) + (size_t)task * 4096;
      bf16_t* ZP = (bf16_t*)(F.ws + WS_ZS) + (size_t)task * 4096;
#pragma unroll
      for (int mt = 0; mt < 2; ++mt)
#pragma unroll
          for (int nt = 0; nt < 2; ++nt) {
#pragma unroll
              for (int r = 0; r < 16; ++r) PT[(32 * mt + (r & 3) + 8 * (r >> 2) + 4 * hi) * 64 + 32 * nt + c31] = f2bf(XP[mt][nt][r]);
              u32x4 a, c2; a.x = pk2(XZ[mt][nt][0], XZ[mt][nt][1]); a.y = pk2(XZ[mt][nt][2], XZ[mt][nt][3]); a.z = pk2(XZ[mt][nt][4], XZ[mt][nt][5]); a.w = pk2(XZ[mt][nt][6], XZ[mt][nt][7]);
              c2.x = pk2(XZ[mt][nt][8], XZ[mt][nt][9]); c2.y = pk2(XZ[mt][nt][10], XZ[mt][nt][11]); c2.z = pk2(XZ[mt][nt][12], XZ[mt][nt][13]); c2.w = pk2(XZ[mt][nt][14], XZ[mt][nt][15]);
              *(u32x4*)(ZP + ((mt * 2 + nt) * 64 + lane_e) * 16) = a; *(u32x4*)(ZP + ((mt * 2 + nt) * 64 + lane_e) * 16 + 8) = c2; } }
    __syncthreads();
}
constexpr int CW_PREP = 768;
constexpr int CW_R1DONE = 896;
__device__ __forceinline__ void publish_count(Frame& F, unsigned* word) {
    asm volatile("s_waitcnt vmcnt(0)" ::: "memory"); __syncthreads();
    if (F.tid == 0) { __builtin_amdgcn_fence(__ATOMIC_RELEASE, "agent"); asm volatile("s_waitcnt vmcnt(0)" ::: "memory"); (void)__hip_atomic_fetch_add(word, 1u, RLX_AGENT); }
}
__device__ __forceinline__ void await_count(Frame& F, unsigned* word, unsigned want) {
    if (F.tid == 0) { unsigned sp = 0; while ((unsigned)__builtin_amdgcn_readfirstlane(__hip_atomic_load(word, RLX_AGENT)) < want) { __builtin_amdgcn_s_sleep(4); if (++sp > (1u << 24)) break; }
        __builtin_amdgcn_fence(__ATOMIC_ACQUIRE, "agent"); asm volatile("s_waitcnt vmcnt(0)" ::: "memory"); }
    __syncthreads();
}
__device__ __forceinline__ void phase_c(Frame& F, int layer) {
    if (F.bid < 192) r1_block(F, layer, F.bid);
    else { compress_unit(F, layer, F.bid - 192); LAUNDER(F); if (F.bid < 224) kmean_task(F, (F.bid - 192) * 8 + F.wave); }
    LAUNDER(F);
    publish_count(F, F.ctl + ((F.bid < 192) ? CW_R1DONE + 64 * layer + (F.bid >> 4) : CW_PREP + 64 * layer));
}

constexpr int KP = 72;
constexpr int TILE_B = 64 * KP * 2;
constexpr int AT_K0 = 0, AT_V0 = 2 * TILE_B;
constexpr int AT_IMP = 4 * TILE_B;
constexpr int AT_MISC = AT_IMP + 8 * 8192;
constexpr int AT_KMEAN = AT_MISC + 256;
constexpr int R2_SBUF = 0;

__device__ __forceinline__ bf16x8 lds_frag(const LAS bf16_t* tile, int row, int col) { return *(const LAS bf16x8*)(tile + row * KP + col); }
__device__ __forceinline__ s16x4 lds_tr(const LAS bf16_t* p) { return __builtin_bit_cast(s16x4, __builtin_amdgcn_ds_read_tr16_b64_v4i16((LAS v4i16_t*)p)); }
__device__ __forceinline__ bf16x8 cat8(s16x4 a, s16x4 b) { bf16x8 r; r[0] = a[0]; r[1] = a[1]; r[2] = a[2]; r[3] = a[3]; r[4] = b[0]; r[5] = b[1]; r[6] = b[2]; r[7] = b[3]; return r; }
__device__ __forceinline__ bf16x8 pack8(const f32x4& a, const f32x4& b) { u32x4 u; u.x = pk2(a.x, a.y); u.y = pk2(a.z, a.w); u.z = pk2(b.x, b.y); u.w = pk2(b.z, b.w); return __builtin_bit_cast(bf16x8, u); }

template <int NH>
__device__ __forceinline__ void qk_tile(const LAS bf16_t* Kt, const bf16x8 (&qf)[NH][2], f32x4 (&st)[NH][4], const float (&cm)[NH], int lane, const bool (&keep)[NH]) {
    const int r = lane & 15, kg = lane >> 4;
    f32x4 ci[NH];
#pragma unroll
    for (int g = 0; g < NH; ++g) { const float c = keep[g] ? cm[g] : -INFINITY; ci[g] = (f32x4){c, c, c, c}; }
#pragma unroll
    for (int kt = 0; kt < 4; ++kt) {
        const bf16x8 k0 = lds_frag(Kt, 16 * kt + r, 8 * kg), k1 = lds_frag(Kt, 16 * kt + r, 32 + 8 * kg);
#pragma unroll
        for (int g = 0; g < NH; ++g) { f32x4 z = MFMA16(k0, qf[g][0], ci[g]); st[g][kt] = MFMA16(k1, qf[g][1], z); }
    }
}
template <int NH, bool DO_V>
__device__ __forceinline__ void pv_tile(const LAS bf16_t* Vt, const f32x4 (&p)[NH][4], f32x4 (&o)[NH][4], f32x4 (&lacc)[NH], int lane) {
    const int kg = lane >> 4, rr = (lane & 15) >> 2, cc = 4 * (lane & 3);
    const u32x4 one4 = (u32x4){0x3f803f80u, 0x3f803f80u, 0x3f803f80u, 0x3f803f80u};
    const bf16x8 ones = __builtin_bit_cast(bf16x8, one4);
#pragma unroll
    for (int i = 0; i < 2; ++i) {
        bf16x8 pf[NH];
#pragma unroll
        for (int g = 0; g < NH; ++g) { pf[g] = pack8(p[g][2 * i], p[g][2 * i + 1]); lacc[g] = MFMA16(ones, pf[g], lacc[g]); }
        if (DO_V) {
#pragma unroll
            for (int dt = 0; dt < 4; ++dt) {
                const s16x4 lo = lds_tr(Vt + (32 * i + 4 * kg + rr) * KP + 16 * dt + cc), hi = lds_tr(Vt + (32 * i + 16 + 4 * kg + rr) * KP + 16 * dt + cc);
                const bf16x8 vf = cat8(lo, hi);
#pragma unroll
                for (int g = 0; g < NH; ++g) o[g][dt] = MFMA16(vf, pf[g], o[g][dt]);
            }
        }
    }
}
__device__ __forceinline__ void softmax_tile(f32x4 (&st)[4], f32x4 (&o)[4], f32x4& lacc, float& mref, int lane) {
    float mx = -INFINITY;
#pragma unroll
    for (int kt = 0; kt < 4; ++kt) mx = fmaxf(fmaxf(mx, fmaxf(st[kt].x, st[kt].y)), fmaxf(st[kt].z, st[kt].w));
    mx = fmaxf(mx, shx(mx, 16, lane)); mx = fmaxf(mx, shx(mx, 32, lane));
    const bool fresh = (mref == -INFINITY);
    if (__any((fresh && mx > -INFINITY) || mx > 8.0f)) {
        const float d = fresh ? ((mx == -INFINITY) ? 0.f : mx) : fmaxf(mx, 0.f);
        const float alpha = fresh ? 1.f : __builtin_amdgcn_exp2f(-d);
        mref = fresh ? mx : mref + d;
        lacc = lacc * alpha;
#pragma unroll
        for (int dt = 0; dt < 4; ++dt) o[dt] = o[dt] * alpha;
#pragma unroll
        for (int kt = 0; kt < 4; ++kt) st[kt] = st[kt] - d;
    }
#pragma unroll
    for (int kt = 0; kt < 4; ++kt) {
        st[kt].x = __builtin_amdgcn_exp2f(st[kt].x); st[kt].y = __builtin_amdgcn_exp2f(st[kt].y);
        st[kt].z = __builtin_amdgcn_exp2f(st[kt].z); st[kt].w = __builtin_amdgcn_exp2f(st[kt].w);
    }
}
#define MX2(a, b) __builtin_elementwise_maximum((float)(a), (float)(b))
#define MX3(a, b, c) MX2(MX2(a, b), c)
template <int NH>
__device__ __forceinline__ void softmax_tiles(f32x4 (&st)[NH][4], f32x4 (&o)[NH][4], f32x4 (&lacc)[NH], float (&mref)[NH], float (&cm)[NH], int lane) {
    float mx[NH];
#pragma unroll
    for (int g = 0; g < NH; ++g) {
        float a = MX3(st[g][0].x, st[g][0].y, st[g][0].z), c = MX3(st[g][2].x, st[g][2].y, st[g][2].z);
        a = MX3(a, st[g][0].w, st[g][1].x); c = MX3(c, st[g][2].w, st[g][3].x);
        a = MX3(a, st[g][1].y, st[g][1].z); c = MX3(c, st[g][3].y, st[g][3].z);
        mx[g] = MX3(MX3(a, st[g][1].w, st[g][3].w), c, c); }
#pragma unroll
    for (int g = 0; g < NH; ++g)
#pragma unroll
        for (int kt = 0; kt < 4; ++kt) {
            st[g][kt].x = __builtin_amdgcn_exp2f(st[g][kt].x); st[g][kt].y = __builtin_amdgcn_exp2f(st[g][kt].y);
            st[g][kt].z = __builtin_amdgcn_exp2f(st[g][kt].z); st[g][kt].w = __builtin_amdgcn_exp2f(st[g][kt].w);
        }
#pragma unroll
    for (int g = 0; g < NH; ++g) { const unsigned u = __float_as_uint(mx[g]); auto a = __builtin_amdgcn_permlane16_swap(u, u, false, false); mx[g] = MX2(__uint_as_float(a[0]), __uint_as_float(a[1])); }
#pragma unroll
    for (int g = 0; g < NH; ++g) { const unsigned u = __float_as_uint(mx[g]); auto a = __builtin_amdgcn_permlane32_swap(u, u, false, false); mx[g] = MX2(__uint_as_float(a[0]), __uint_as_float(a[1])); }
    bool need = false;
#pragma unroll
    for (int g = 0; g < NH; ++g) need = need | (((mref[g] == -INFINITY) & (mx[g] > -INFINITY)) | (mx[g] > 8.0f));
    if (__any(need)) {
#pragma unroll
        for (int g = 0; g < NH; ++g) {
            const bool fresh = (mref[g] == -INFINITY);
            const float d = fresh ? ((mx[g] == -INFINITY) ? 0.f : fmaxf(mx[g], -100.f)) : fmaxf(mx[g], 0.f);
            const float pf = __builtin_amdgcn_exp2f(-d);
            const float alpha = fresh ? 1.f : pf;
            mref[g] = fresh ? ((mx[g] == -INFINITY) ? -INFINITY : d) : mref[g] + d;
            cm[g] = (mref[g] == -INFINITY) ? 0.f : -mref[g];
            lacc[g] = lacc[g] * alpha;
#pragma unroll
            for (int dt = 0; dt < 4; ++dt) o[g][dt] = o[g][dt] * alpha;
#pragma unroll
            for (int kt = 0; kt < 4; ++kt) st[g][kt] = st[g][kt] * pf;
        }
    }
}
__device__ __forceinline__ void acc_pk(u32x2& d, const f32x4& v) {
    const float a = __uint_as_float(d.x << 16) + v.x, b = __uint_as_float(d.x & 0xffff0000u) + v.y, c = __uint_as_float(d.y << 16) + v.z, e = __uint_as_float(d.y & 0xffff0000u) + v.w;
    d.x = pk2(a, b); d.y = pk2(c, e); }
__device__ __forceinline__ u32x4 tile_load(const bf16_t* g, int tid) { const int off = (tid >> 3) * 64 + (tid & 7) * 8; return *(const u32x4*)(g + off); }
__device__ __forceinline__ void tile_store(LAS bf16_t* t, int tid, u32x4 v) { *(LAS u32x4*)(t + (tid >> 3) * KP + (tid & 7) * 8) = v; }

#define LDS_BAR() do { asm volatile("s_waitcnt lgkmcnt(0)" ::: "memory"); __builtin_amdgcn_s_barrier(); asm volatile("" ::: "memory"); } while (0)
__device__ __forceinline__ void nsa_task(Frame& F, int b, int kvh, int J) {
    const int lane = F.lane, tid = F.tid, wv = F.wave, q = lane & 15, kg = lane >> 4;
    const int t0 = 128 * J, tw0 = t0 + 16 * wv, tq_abs = tw0 + q, cur = tw0 >> 6, tq = tq_abs & 63;
    LAS bf16_t* Kb = (LAS bf16_t*)(F.lds + AT_K0); LAS bf16_t* Vb = (LAS bf16_t*)(F.lds + AT_V0);
    LAS float* imp = (LAS float*)(F.lds + AT_IMP + wv * 8192);
    const bf16_t* kvbase = (const bf16_t*)(F.ws + WS_KV6);
    const size_t slab = (size_t)(b * 2 + kvh) * SEQ * 64;
    const bf16_t* Kcmp = (const bf16_t*)(F.ws + WS_KCMP) + (size_t)(b * 2 + kvh) * 512 * 64;
    const bf16_t* Vcmp = (const bf16_t*)(F.ws + WS_VCMP) + (size_t)(b * 2 + kvh) * 512 * 64;
    const bf16_t* Ks = kvbase + 2 * KV6_STRIDE + slab; const bf16_t* Vs = kvbase + 3 * KV6_STRIDE + slab;
    const bf16_t* Kw = kvbase + 4 * KV6_STRIDE + slab; const bf16_t* Vw = kvbase + 5 * KV6_STRIDE + slab;
    bf16x8 qf[3][2];
#pragma unroll
    for (int g = 0; g < 3; ++g) { const bf16_t* qp = (const bf16_t*)(F.ws + WS_NQ) + (((b * 6 + 3 * kvh + g) * SEQ + tq_abs) * 64 + 8 * kg);
        qf[g][0] = *(const bf16x8*)qp; qf[g][1] = *(const bf16x8*)(qp + 32); }
#define NSA_GATEP ((const float*)(F.ws + WS_GATE) + ((b * SEQ + tq_abs) * 32 + 9 * kvh))
    for (int i = lane; i < 2048; i += 64) imp[i] = 0.f;
    const int imax_blk = (t0 + 127 - 31) >> 4;
    const int ntc = (imax_blk >> 6) + 1;
    const int imax_w = (tw0 + 15 >= 31) ? ((tw0 + 15 - 31) >> 4) : -1;
    const int ivis = (tq_abs >= 31) ? ((tq_abs - 31) >> 4) : -1;
    float m[3] = {-INFINITY, -INFINITY, -INFINITY}; float cm[3] = {0.f, 0.f, 0.f};
    f32x4 lacc[3] = {(f32x4){0.f, 0.f, 0.f, 0.f}, (f32x4){0.f, 0.f, 0.f, 0.f}, (f32x4){0.f, 0.f, 0.f, 0.f}};
    f32x4 st[3][4];
    f32x4 ob[3][4];
    const bool keep3[3] = {true, true, true};
#pragma unroll
    for (int g = 0; g < 3; ++g)
#pragma unroll
        for (int dt = 0; dt < 4; ++dt) ob[g][dt] = (f32x4){0.f, 0.f, 0.f, 0.f};
    {
        u32x4 kr = tile_load(Kcmp, tid);
        tile_store(Kb, tid, kr); __syncthreads();
        for (int ct = 0; ct < ntc; ++ct) {
            if (ct + 1 < ntc) kr = tile_load(Kcmp + (ct + 1) * 4096, tid);
            const LAS bf16_t* Kt = Kb + (ct & 1) * (TILE_B / 2);
            if (64 * ct <= imax_w) {
                qk_tile<3>(Kt, qf, st, cm, lane, keep3);
#pragma unroll
                for (int g = 0; g < 3; ++g) {
#pragma unroll
                    for (int kt = 0; kt < 4; ++kt)
#pragma unroll
                        for (int r = 0; r < 4; ++r) { const int i = 64 * ct + 16 * kt + 4 * kg + r; st[g][kt][r] = (i <= ivis) ? st[g][kt][r] : -INFINITY; }
                }
                softmax_tiles<3>(st, ob, lacc, m, cm, lane);
                pv_tile<3, false>(Kt, st, ob, lacc, lane);
            }
            if (ct + 1 < ntc) tile_store(Kb + ((ct + 1) & 1) * (TILE_B / 2), tid, kr);
            LDS_BAR();
        }
    }
    float invl[3]; float msafe[3];
#pragma unroll
    for (int g = 0; g < 3; ++g) { msafe[g] = (m[g] == -INFINITY) ? 0.f : m[g]; invl[g] = 1.f / fmaxf(lacc[g].x, 1e-30f); }
    {
        u32x4 kr = tile_load(Kcmp, tid), vr = tile_load(Vcmp, tid);
        tile_store(Kb, tid, kr); tile_store(Vb, tid, vr); __syncthreads();
        for (int ct = 0; ct < ntc; ++ct) {
            if (ct + 1 < ntc) { kr = tile_load(Kcmp + (ct + 1) * 4096, tid); vr = tile_load(Vcmp + (ct + 1) * 4096, tid); }
            const LAS bf16_t* Kt = Kb + (ct & 1) * (TILE_B / 2); const LAS bf16_t* Vt = Vb + (ct & 1) * (TILE_B / 2);
            if (64 * ct <= imax_w) {
                qk_tile<3>(Kt, qf, st, cm, lane, keep3);
#pragma unroll
                for (int g = 0; g < 3; ++g)
#pragma unroll
                    for (int kt = 0; kt < 4; ++kt)
#pragma unroll
                        for (int r = 0; r < 4; ++r) { const int i = 64 * ct + 16 * kt + 4 * kg + r;
                            st[g][kt][r] = (i <= ivis) ? __builtin_amdgcn_exp2f(st[g][kt][r]) * invl[g] : 0.f; }
#pragma unroll
                for (int kt = 0; kt < 4; ++kt) {
                    float a = 0.f, c = 0.f;
#pragma unroll
                    for (int g = 0; g < 3; ++g) { a += (st[g][kt].x + st[g][kt].y) + st[g][kt].z; c += st[g][kt].w; }
                    c *= 0.5f; a += c;
                    const float recv = __uint_as_float(__builtin_amdgcn_ds_bpermute(((lane + 48) & 63) << 2, __float_as_uint(c)));
                    const int ktp = 4 * ct + kt;
                    imp[ktp * 64 + lane] += a + (kg != 0 ? recv : 0.f);
                    if (kg == 0 && ktp + 1 < 32) imp[(ktp + 1) * 64 + lane] += recv;
                }
                pv_tile<3, true>(Vt, st, ob, lacc, lane);
            }
            if (ct + 1 < ntc) { tile_store(Kb + ((ct + 1) & 1) * (TILE_B / 2), tid, kr); tile_store(Vb + ((ct + 1) & 1) * (TILE_B / 2), tid, vr); }
            LDS_BAR();
        }
    }
#pragma unroll
    for (int g = 0; g < 3; ++g) { const float sc = sigm(NSA_GATEP[3 * g + 0]);
#pragma unroll
        for (int dt = 0; dt < 4; ++dt) ob[g][dt] = ob[g][dt] * sc; }
    unsigned msk[4] = {0u, 0u, 0u, 0u};
    if (cur <= 15) {
        msk[0] = (cur == 31) ? 0xffffffffu : ((1u << (cur + 1)) - 1u);
    } else {
        float iv[32];
#pragma unroll
        for (int k = 0; k < 32; ++k) { const int s = 4 * k + kg; const float v = imp[k * 64 + lane]; iv[k] = (s >= 1 && s <= cur - 2) ? v : -1.f; }
        msk[0] = 1u; msk[cur >> 5] |= 1u << (cur & 31); msk[(cur - 1) >> 5] |= 1u << ((cur - 1) & 31);
        for (int it = 0; it < 13; ++it) {
            float bv = -2.f; int bs = 1 << 20;
#pragma unroll
            for (int k = 0; k < 32; ++k) { if (iv[k] > bv) { bv = iv[k]; bs = 4 * k + kg; } }
#pragma unroll
            for (int sh = 16; sh <= 32; sh <<= 1) { const float ov = shx(bv, sh, lane); const int os = shxi(bs, sh, lane); if (ov > bv || (ov == bv && os < bs)) { bv = ov; bs = os; } }
#pragma unroll
            for (int k = 0; k < 32; ++k) if (4 * k + kg == bs) iv[k] = -1.f;
#pragma unroll
            for (int wd = 0; wd < 4; ++wd) if ((bs >> 5) == wd) msk[wd] |= 1u << (bs & 31);
        }
    }
    LAS u32x2* otp = (LAS u32x2*)imp;
#pragma unroll
    for (int g = 0; g < 3; ++g)
#pragma unroll
        for (int dt = 0; dt < 4; ++dt) { u32x2 o; o.x = pk2(ob[g][dt].x, ob[g][dt].y); o.y = pk2(ob[g][dt].z, ob[g][dt].w); otp[(g * 4 + dt) * 64 + lane] = o; }
    {
#pragma unroll
        for (int g = 0; g < 3; ++g) { m[g] = -INFINITY; cm[g] = 0.f; lacc[g] = (f32x4){0.f, 0.f, 0.f, 0.f};
#pragma unroll
            for (int dt = 0; dt < 4; ++dt) ob[g][dt] = (f32x4){0.f, 0.f, 0.f, 0.f}; }
        const int nb = 2 * J + 2;
        u32x4 kr[2], vr[2]; unsigned mw = 0u;
        kr[0] = tile_load(Ks, tid); vr[0] = tile_load(Vs, tid);
        kr[1] = tile_load(Ks + ((nb > 1) ? 4096 : 0), tid); vr[1] = tile_load(Vs + ((nb > 1) ? 4096 : 0), tid);
        tile_store(Kb, tid, kr[0]); tile_store(Vb, tid, vr[0]); __syncthreads();
        for (int s0 = 0; s0 < nb; s0 += 2) {
#pragma unroll
            for (int u = 0; u < 2; ++u) {
                const int s = s0 + u;
                if (s < nb) {
                    if (s + 2 < nb) { kr[u] = tile_load(Ks + (s + 2) * 4096, tid); vr[u] = tile_load(Vs + (s + 2) * 4096, tid); }
                    const LAS bf16_t* Kt = Kb + (s & 1) * (TILE_B / 2); const LAS bf16_t* Vt = Vb + (s & 1) * (TILE_B / 2);
                    if ((s & 31) == 0) mw = (s == 0) ? msk[0] : (s == 32) ? msk[1] : (s == 64) ? msk[2] : msk[3];
                    const bool sel = ((mw >> (s & 31)) & 1u) != 0u;
                    if (__any(sel)) {
                        const bool selk[3] = {sel, sel, sel};
                        qk_tile<3>(Kt, qf, st, cm, lane, selk);
                        if (s == cur) {
#pragma unroll
                            for (int g = 0; g < 3; ++g)
#pragma unroll
                                for (int kt = 0; kt < 4; ++kt)
#pragma unroll
                                    for (int r = 0; r < 4; ++r) { const int kk = 16 * kt + 4 * kg + r; st[g][kt][r] = (kk <= tq) ? st[g][kt][r] : -INFINITY; }
                        }
                        softmax_tiles<3>(st, ob, lacc, m, cm, lane);
                        pv_tile<3, true>(Vt, st, ob, lacc, lane);
                    }
                    if (s + 1 < nb) { tile_store(Kb + ((s + 1) & 1) * (TILE_B / 2), tid, kr[u ^ 1]); tile_store(Vb + ((s + 1) & 1) * (TILE_B / 2), tid, vr[u ^ 1]); }
                }
                LDS_BAR();
            }
        }
#pragma unroll
        for (int g = 0; g < 3; ++g) { const float sc = sigm(NSA_GATEP[3 * g + 1]) / fmaxf(lacc[g].x, 1e-30f);
#pragma unroll
            for (int dt = 0; dt < 4; ++dt) { u32x2 o = otp[(g * 4 + dt) * 64 + lane]; acc_pk(o, ob[g][dt] * sc); otp[(g * 4 + dt) * 64 + lane] = o; } }
    }
    {
#pragma unroll
        for (int g = 0; g < 3; ++g) { m[g] = -INFINITY; cm[g] = 0.f; lacc[g] = (f32x4){0.f, 0.f, 0.f, 0.f};
#pragma unroll
            for (int dt = 0; dt < 4; ++dt) ob[g][dt] = (f32x4){0.f, 0.f, 0.f, 0.f}; }
        const int s_lo = (2 * J - 8 > 0) ? 2 * J - 8 : 0, s_hi = 2 * J + 1, nb = s_hi - s_lo + 1;
        u32x4 kr[2], vr[2];
        kr[0] = tile_load(Kw + s_lo * 4096, tid); vr[0] = tile_load(Vw + s_lo * 4096, tid);
        kr[1] = tile_load(Kw + (s_lo + ((nb > 1) ? 1 : 0)) * 4096, tid); vr[1] = tile_load(Vw + (s_lo + ((nb > 1) ? 1 : 0)) * 4096, tid);
        tile_store(Kb, tid, kr[0]); tile_store(Vb, tid, vr[0]); __syncthreads();
        for (int it0 = 0; it0 < nb; it0 += 2) {
#pragma unroll
            for (int u = 0; u < 2; ++u) {
                const int it = it0 + u;
                if (it < nb) {
                    const int s = s_lo + it;
                    if (it + 2 < nb) { kr[u] = tile_load(Kw + (s + 2) * 4096, tid); vr[u] = tile_load(Vw + (s + 2) * 4096, tid); }
                    const LAS bf16_t* Kt = Kb + (it & 1) * (TILE_B / 2); const LAS bf16_t* Vt = Vb + (it & 1) * (TILE_B / 2);
                    if (s <= cur && s >= cur - 8) {
                        qk_tile<3>(Kt, qf, st, cm, lane, keep3);
                        if (s == cur || s == cur - 8) {
#pragma unroll
                            for (int g = 0; g < 3; ++g)
#pragma unroll
                                for (int kt = 0; kt < 4; ++kt)
#pragma unroll
                                    for (int r = 0; r < 4; ++r) { const int kk = 16 * kt + 4 * kg + r; const bool ok = (s == cur) ? (kk <= tq) : (kk > tq); st[g][kt][r] = ok ? st[g][kt][r] : -INFINITY; }
                        }
                        softmax_tiles<3>(st, ob, lacc, m, cm, lane);
                        pv_tile<3, true>(Vt, st, ob, lacc, lane);
                    }
                    if (it + 1 < nb) { tile_store(Kb + ((it + 1) & 1) * (TILE_B / 2), tid, kr[u ^ 1]); tile_store(Vb + ((it + 1) & 1) * (TILE_B / 2), tid, vr[u ^ 1]); }
                }
                LDS_BAR();
            }
        }
        bf16_t* mixp = (bf16_t*)(F.ws + WS_HM) + ((b * SEQ + tq_abs) * D + 3 * kvh * 64 + 4 * kg);
#pragma unroll
        for (int g = 0; g < 3; ++g) { const float sc = sigm(NSA_GATEP[3 * g + 2]) / fmaxf(lacc[g].x, 1e-30f);
#pragma unroll
            for (int dt = 0; dt < 4; ++dt) { u32x2 o = otp[(g * 4 + dt) * 64 + lane]; acc_pk(o, ob[g][dt] * sc); *(u32x2*)(mixp + g * 64 + 16 * dt) = o; } }
    }
}

__device__ __forceinline__ void moba_task(Frame& F, int b, int h, int own) {
    const int lane = F.lane, tid = F.tid, wv = F.wave, q = lane & 15, kg = lane >> 4;
    LAS bf16_t* Kb = (LAS bf16_t*)(F.lds + AT_K0); LAS bf16_t* Vb = (LAS bf16_t*)(F.lds + AT_V0); LAS bf16_t* Km = (LAS bf16_t*)(F.lds + AT_KMEAN);
    const size_t slab = (size_t)(b * 4 + h) * SEQ * 64;
    const bf16_t* Qg = (const bf16_t*)(F.ws + WS_MQKV) + slab; const bf16_t* Kg = Qg + MQKV_STRIDE; const bf16_t* Vg = Kg + MQKV_STRIDE;
    const int tw0 = 256 * own + 32 * wv;
    bf16x8 qf[2][2];
#pragma unroll
    for (int rt = 0; rt < 2; ++rt) { const bf16_t* qp = Qg + ((tw0 + 16 * rt + q) * 64 + 8 * kg); qf[rt][0] = *(const bf16x8*)qp; qf[rt][1] = *(const bf16x8*)(qp + 32); }
    if (tid < 256) { const u32x4 v = *(const u32x4*)((const bf16_t*)(F.ws + WS_KMEAN) + (size_t)(b * 4 + h) * 2048 + (tid >> 3) * 64 + (tid & 7) * 8); *(LAS u32x4*)(Km + (tid >> 3) * KP + (tid & 7) * 8) = v; }
    __syncthreads();
    unsigned msk[2] = {0u, 0u};
    {
        f32x4 gs[2][2];
#pragma unroll
        for (int kt = 0; kt < 2; ++kt) { const bf16x8 k0 = lds_frag(Km, 16 * kt + q, 8 * kg), k1 = lds_frag(Km, 16 * kt + q, 32 + 8 * kg);
#pragma unroll
            for (int rt = 0; rt < 2; ++rt) { f32x4 z = (f32x4){0.f, 0.f, 0.f, 0.f}; z = MFMA16(k0, qf[rt][0], z); gs[rt][kt] = MFMA16(k1, qf[rt][1], z); } }
#pragma unroll
        for (int rt = 0; rt < 2; ++rt) {
            float gv[8];
#pragma unroll
            for (int kt = 0; kt < 2; ++kt)
#pragma unroll
                for (int r = 0; r < 4; ++r) { const int blk = 16 * kt + 4 * kg + r; gv[4 * kt + r] = (blk < own) ? gs[rt][kt][r] : -INFINITY; }
            for (int it = 0; it < 3; ++it) {
                float bv = -INFINITY; int bs = 1 << 20;
#pragma unroll
                for (int k = 0; k < 8; ++k) { const int blk = 16 * (k >> 2) + 4 * kg + (k & 3); if (gv[k] > bv) { bv = gv[k]; bs = blk; } }
#pragma unroll
                for (int sh = 16; sh <= 32; sh <<= 1) { const float ov = shx(bv, sh, lane); const int os = shxi(bs, sh, lane); if (ov > bv || (ov == bv && os < bs)) { bv = ov; bs = os; } }
                if (bs < 32) { msk[rt] |= 1u << bs;
#pragma unroll
                    for (int k = 0; k < 8; ++k) if (16 * (k >> 2) + 4 * kg + (k & 3) == bs) gv[k] = -INFINITY; }
            }
        }
    }
    float m[2] = {-INFINITY, -INFINITY}; float cm[2] = {0.f, 0.f}; f32x4 lacc[2] = {(f32x4){0.f, 0.f, 0.f, 0.f}, (f32x4){0.f, 0.f, 0.f, 0.f}};
    f32x4 ob[2][4], st[2][4];
#pragma unroll
    for (int rt = 0; rt < 2; ++rt)
#pragma unroll
        for (int dt = 0; dt < 4; ++dt) ob[rt][dt] = (f32x4){0.f, 0.f, 0.f, 0.f};
    const int ntile = 4 * own + 4;
    u32x4 kr[2], vr[2];
    kr[0] = tile_load(Kg, tid); vr[0] = tile_load(Vg, tid); kr[1] = tile_load(Kg + 4096, tid); vr[1] = tile_load(Vg + 4096, tid);
    tile_store(Kb, tid, kr[0]); tile_store(Vb, tid, vr[0]); __syncthreads();
    for (int tau0 = 0; tau0 < ntile; tau0 += 2) {
#pragma unroll
        for (int u = 0; u < 2; ++u) {
            const int tau = tau0 + u;
            if (tau + 2 < ntile) { kr[u] = tile_load(Kg + (tau + 2) * 4096, tid); vr[u] = tile_load(Vg + (tau + 2) * 4096, tid); }
            const LAS bf16_t* Kt = Kb + (tau & 1) * (TILE_B / 2); const LAS bf16_t* Vt = Vb + (tau & 1) * (TILE_B / 2);
            const int blk = tau >> 2;
            bool sel[2]; bool anyv = false;
#pragma unroll
            for (int rt = 0; rt < 2; ++rt) { sel[rt] = (blk < own) ? ((msk[rt] >> blk) & 1u) : (64 * (tau & 3) <= 32 * wv + 16 * rt + q); anyv = anyv || sel[rt]; }
            if (__any(anyv)) {
                const bool selk[2] = {(blk < own) ? sel[0] : true, (blk < own) ? sel[1] : true};
                qk_tile<2>(Kt, qf, st, cm, lane, selk);
                if (blk >= own) {
#pragma unroll
                    for (int rt = 0; rt < 2; ++rt) {
                        const int trel = 32 * wv + 16 * rt + q;
#pragma unroll
                        for (int kt = 0; kt < 4; ++kt)
#pragma unroll
                            for (int r = 0; r < 4; ++r) { const int kk = 64 * (tau & 3) + 16 * kt + 4 * kg + r; st[rt][kt][r] = (kk <= trel) ? st[rt][kt][r] : -INFINITY; }
                    }
                }
                softmax_tiles<2>(st, ob, lacc, m, cm, lane);
                pv_tile<2, true>(Vt, st, ob, lacc, lane);
            }
            if (tau + 1 < ntile) { tile_store(Kb + ((tau + 1) & 1) * (TILE_B / 2), tid, kr[u ^ 1]); tile_store(Vb + ((tau + 1) & 1) * (TILE_B / 2), tid, vr[u ^ 1]); }
            LDS_BAR();
        }
    }
#pragma unroll
    for (int rt = 0; rt < 2; ++rt) {
        const float sc = 1.f / fmaxf(lacc[rt].x, 1e-30f);
        bf16_t* mix = (bf16_t*)(F.ws + WS_HM) + ((b * SEQ + tw0 + 16 * rt + q) * D + 384 + h * 64 + 4 * kg);
#pragma unroll
        for (int dt = 0; dt < 4; ++dt) { const f32x4 v = ob[rt][dt] * sc; u32x2 o; o.x = pk2(v.x, v.y); o.y = pk2(v.z, v.w); *(u32x2*)(mix + 16 * dt) = o; }
    }
}

constexpr int R2_RING = 16384, R2_SLOT = 12288;
__device__ __forceinline__ void r2_issue(const bf16_t* pt, const bf16_t* zp, LAS unsigned char* slot) {
#pragma unroll
    for (int mt = 0; mt < 2; ++mt)
#pragma unroll
        for (int ks = 0; ks < 4; ++ks) __builtin_amdgcn_global_load_lds((const unsigned*)(pt + mt * 2048 + ks * 16), (LAS unsigned*)(slot + (mt * 4 + ks) * 1024), 16, 0, 0);
#pragma unroll
    for (int mt = 0; mt < 2; ++mt)
#pragma unroll
        for (int q = 0; q < 2; ++q) __builtin_amdgcn_global_load_lds((const unsigned*)(zp + mt * 2048 + q * 8), (LAS unsigned*)(slot + 8192 + (mt * 2 + q) * 1024), 16, 0, 0);
}
__device__ __forceinline__ void r2_wave(Frame& F, int widx) {
    const int chain = widx >> 1, hf = widx & 1, lane = F.lane, c31 = lane & 31, hi = lane >> 5;
    LAS bf16_t* sb = (LAS bf16_t*)(F.lds + R2_SBUF + F.wave * (32 * KP * 2));
    LAS unsigned char* ring = F.lds + R2_RING + F.wave * (4 * R2_SLOT);
    for (int i = lane; i < 32 * KP / 2; i += 64) ((LAS unsigned*)sb)[i] = 0u;
    const bf16_t* PTl = (const bf16_t*)(F.ws + WS_PT) + (size_t)chain * 128 * 4096 + c31 * 64 + 8 * hi;
    const bf16_t* ZPl = (const bf16_t*)(F.ws + WS_ZS) + (size_t)chain * 128 * 4096 + (hf * 64 + lane) * 16;
    bf16_t* SS = (bf16_t*)(F.ws + WS_SS) + (size_t)chain * 128 * 4096 + (32 * hf) * 64;
    r2_issue(PTl, ZPl, ring); r2_issue(PTl + 4096, ZPl + 4096, ring + R2_SLOT); r2_issue(PTl + 2 * 4096, ZPl + 2 * 4096, ring + 2 * R2_SLOT);
#pragma unroll 1
    for (int c = 0; c < 128; ++c) {
        const int cn = (c + 3 < 128) ? c + 3 : 127;
        r2_issue(PTl + cn * 4096, ZPl + cn * 4096, ring + ((c + 3) & 3) * R2_SLOT);
        asm volatile("s_waitcnt vmcnt(36)" ::: "memory");
        const LAS unsigned char* sl = ring + (c & 3) * R2_SLOT + lane * 16;
        f32x16 acc[2];
#pragma unroll
        for (int mt = 0; mt < 2; ++mt)
#pragma unroll
            for (int q = 0; q < 2; ++q) { const u32x4 z = *(const LAS u32x4*)(sl + 8192 + (mt * 2 + q) * 1024);
                acc[mt][8 * q + 0] = __uint_as_float(z.x << 16); acc[mt][8 * q + 1] = __uint_as_float(z.x & 0xffff0000u); acc[mt][8 * q + 2] = __uint_as_float(z.y << 16); acc[mt][8 * q + 3] = __uint_as_float(z.y & 0xffff0000u);
                acc[mt][8 * q + 4] = __uint_as_float(z.z << 16); acc[mt][8 * q + 5] = __uint_as_float(z.z & 0xffff0000u); acc[mt][8 * q + 6] = __uint_as_float(z.w << 16); acc[mt][8 * q + 7] = __uint_as_float(z.w & 0xffff0000u); }
#pragma unroll
        for (int ks = 0; ks < 4; ++ks) {
            const bf16x8 bx = *(const LAS bf16x8*)(sb + c31 * KP + 16 * ks + 8 * hi);
#pragma unroll
            for (int mt = 0; mt < 2; ++mt) { const bf16x8 pa = *(const LAS bf16x8*)(sl + (mt * 4 + ks) * 1024); acc[mt] = MFMA32(pa, bx, acc[mt]); }
        }
#pragma unroll
        for (int mt = 0; mt < 2; ++mt)
#pragma unroll
            for (int r = 0; r < 16; ++r) sb[c31 * KP + 32 * mt + (r & 3) + 8 * (r >> 2) + 4 * hi] = f2bf(acc[mt][r]);
        bf16_t* ss = SS + c * 4096;
#pragma unroll
        for (int j = 0; j < 4; ++j) { const int qd = lane + 64 * j, row = qd >> 3, ch = qd & 7; *(u32x4*)(ss + row * 64 + ch * 8) = *(const LAS u32x4*)(sb + row * KP + ch * 8); }
    }
    asm volatile("s_waitcnt vmcnt(0)" ::: "memory");
}

struct TaskTable { unsigned short v[512]; };
constexpr TaskTable make_tasks() {
    TaskTable t{}; int n = 0, a = 63, am = 0, c = 31, cm = 0;
    while (a >= 0 || c >= 0) {
        const int ca = (a >= 0) ? 96 * a + 1344 : -1, cc = (c >= 0) ? 128 * c + 128 : -1;
        if (ca >= cc) { t.v[n++] = (unsigned short)(0 * 512 + am * 64 + a); if (++am == 4) { am = 0; --a; } }
        else { t.v[n++] = (unsigned short)(1 * 512 + cm * 64 + c); if (++cm == 8) { cm = 0; --c; } }
    }
    return t;
}
__device__ const TaskTable g_tasks = make_tasks();

__device__ __forceinline__ void r3_task(Frame& F, int layer, int task) {
    const int chain = task >> 7, c = task & 127, b = chain / 6, h = chain % 6, lane = F.lane, c31 = lane & 31, hi = lane >> 5;
    const bf16_t* S0 = (const bf16_t*)(F.ws + WS_SS) + (size_t)(task - 1) * 4096;
    const bf16_t* YT = (const bf16_t*)(F.ws + WS_YT) + (size_t)task * 4096;
    const bf16_t* Y0 = (const bf16_t*)(F.ws + WS_Y0) + (size_t)task * 4096;
    const bf16_t* rf = (const bf16_t*)(F.ws + WS_RFEAT);
    const bf16_t* gut = (const bf16_t*)(F.ws + WS_GUPT) + (size_t)(h * 64) * 128;
    const float* mu = INF(F, I_MU) + layer * RW;
    f32x16 acc[2][2], gacc[2][2];
#pragma unroll
    for (int a = 0; a < 2; ++a)
#pragma unroll
        for (int n = 0; n < 2; ++n)
#pragma unroll
            for (int r = 0; r < 16; ++r) { acc[a][n][r] = 0.f; gacc[a][n][r] = 0.f; }
    if (c > 0) {
#pragma unroll
        for (int ks = 0; ks < 4; ++ks) {
            bf16x8 af[2], bfr[2];
#pragma unroll
            for (int mt = 0; mt < 2; ++mt) af[mt] = *(const bf16x8*)(S0 + (32 * mt + c31) * 64 + 16 * ks + 8 * hi);
#pragma unroll
            for (int nt = 0; nt < 2; ++nt) bfr[nt] = *(const bf16x8*)(YT + (32 * nt + c31) * 64 + 16 * ks + 8 * hi);
#pragma unroll
            for (int mt = 0; mt < 2; ++mt)
#pragma unroll
                for (int nt = 0; nt < 2; ++nt) acc[mt][nt] = MFMA32(af[mt], bfr[nt], acc[mt][nt]);
        }
    }
#pragma unroll
    for (int ks = 0; ks < 8; ++ks) {
        bf16x8 af[2], bfr[2];
#pragma unroll
        for (int mt = 0; mt < 2; ++mt) af[mt] = *(const bf16x8*)(gut + (32 * mt + c31) * 128 + 16 * ks + 8 * hi);
#pragma unroll
        for (int nt = 0; nt < 2; ++nt) {
            const int t = 64 * c + 32 * nt + c31, j0 = 16 * ks + 8 * hi; const size_t row = (size_t)b * SEQ + t;
            const u32x4 cu = *(const u32x4*)(rf + row * RW + 1280 + j0);
            u32x4 pv = (u32x4){0u, 0u, 0u, 0u}; if (t > 0) pv = *(const u32x4*)(rf + (row - 1) * RW + 1280 + j0);
            const f32x4 m0 = *(const f32x4*)(mu + 1280 + j0), m1 = *(const f32x4*)(mu + 1280 + j0 + 4);
            float cv[8], pw[8];
            cv[0] = __uint_as_float(cu.x << 16); cv[1] = __uint_as_float(cu.x & 0xffff0000u); cv[2] = __uint_as_float(cu.y << 16); cv[3] = __uint_as_float(cu.y & 0xffff0000u);
            cv[4] = __uint_as_float(cu.z << 16); cv[5] = __uint_as_float(cu.z & 0xffff0000u); cv[6] = __uint_as_float(cu.w << 16); cv[7] = __uint_as_float(cu.w & 0xffff0000u);
            pw[0] = __uint_as_float(pv.x << 16); pw[1] = __uint_as_float(pv.x & 0xffff0000u); pw[2] = __uint_as_float(pv.y << 16); pw[3] = __uint_as_float(pv.y & 0xffff0000u);
            pw[4] = __uint_as_float(pv.z << 16); pw[5] = __uint_as_float(pv.z & 0xffff0000u); pw[6] = __uint_as_float(pv.w << 16); pw[7] = __uint_as_float(pv.w & 0xffff0000u);
            const float mm[8] = {m0.x, m0.y, m0.z, m0.w, m1.x, m1.y, m1.z, m1.w};
            float sg[8];
#pragma unroll
            for (int k = 0; k < 8; ++k) sg[k] = sigm(cv[k] + (pw[k] - cv[k]) * mm[k]);
            u32x4 u; u.x = pk2(sg[0], sg[1]); u.y = pk2(sg[2], sg[3]); u.z = pk2(sg[4], sg[5]); u.w = pk2(sg[6], sg[7]);
            bfr[nt] = __builtin_bit_cast(bf16x8, u);
        }
#pragma unroll
        for (int mt = 0; mt < 2; ++mt)
#pragma unroll
            for (int nt = 0; nt < 2; ++nt) gacc[mt][nt] = MFMA32(af[mt], bfr[nt], gacc[mt][nt]);
    }
    const float* lnw = INF(F, I_LNW) + layer * 384 + h * 64; const float* lnb = INF(F, I_LNB) + layer * 384 + h * 64;
    const float* bonus = (const float*)(F.ws + WS_BONUS);
    bf16_t* mix = (bf16_t*)(F.ws + WS_HM);
#pragma unroll
    for (int nt = 0; nt < 2; ++nt) {
        const int tl = 32 * nt + c31, t = 64 * c + tl; const size_t row = (size_t)b * SEQ + t;
        float s = 0.f;
#pragma unroll
        for (int mt = 0; mt < 2; ++mt)
#pragma unroll
            for (int rq = 0; rq < 4; ++rq) {
                const u32x2 y = *(const u32x2*)(Y0 + tl * 64 + 32 * mt + 8 * rq + 4 * hi);
                acc[mt][nt][4 * rq + 0] += __uint_as_float(y.x << 16); acc[mt][nt][4 * rq + 1] += __uint_as_float(y.x & 0xffff0000u);
                acc[mt][nt][4 * rq + 2] += __uint_as_float(y.y << 16); acc[mt][nt][4 * rq + 3] += __uint_as_float(y.y & 0xffff0000u);
                s += (acc[mt][nt][4 * rq] + acc[mt][nt][4 * rq + 1]) + (acc[mt][nt][4 * rq + 2] + acc[mt][nt][4 * rq + 3]);
            }
        s += shx(s, 32, lane);
        const float mean = s * (1.f / 64.f);
        float vs = 0.f;
#pragma unroll
        for (int mt = 0; mt < 2; ++mt)
#pragma unroll
            for (int r = 0; r < 16; ++r) { const float d = acc[mt][nt][r] - mean; vs += d * d; }
        vs += shx(vs, 32, lane);
        const float rstd = rsqrtf(vs * (1.f / 64.f) + 64e-5f);
        const float bn = bonus[row * 8 + h];
#pragma unroll
        for (int mt = 0; mt < 2; ++mt)
#pragma unroll
            for (int rq = 0; rq < 4; ++rq) {
                const int v0 = 32 * mt + 8 * rq + 4 * hi;
                const u32x2 vc = *(const u32x2*)(rf + row * RW + 768 + h * 64 + v0);
                u32x2 vp = (u32x2){0u, 0u}; if (t > 0) vp = *(const u32x2*)(rf + (row - 1) * RW + 768 + h * 64 + v0);
                const f32x4 mv = *(const f32x4*)(mu + 768 + h * 64 + v0), lw = *(const f32x4*)(lnw + v0), lb = *(const f32x4*)(lnb + v0);
                const float vcur[4] = {__uint_as_float(vc.x << 16), __uint_as_float(vc.x & 0xffff0000u), __uint_as_float(vc.y << 16), __uint_as_float(vc.y & 0xffff0000u)};
                const float vprv[4] = {__uint_as_float(vp.x << 16), __uint_as_float(vp.x & 0xffff0000u), __uint_as_float(vp.y << 16), __uint_as_float(vp.y & 0xffff0000u)};
                const float mvv[4] = {mv.x, mv.y, mv.z, mv.w}, lwv[4] = {lw.x, lw.y, lw.z, lw.w}, lbv[4] = {lb.x, lb.y, lb.z, lb.w};
                float o[4];
#pragma unroll
                for (int k = 0; k < 4; ++k) {
                    const float vsh = vcur[k] + (vprv[k] - vcur[k]) * mvv[k];
                    const float y = (acc[mt][nt][4 * rq + k] - mean) * rstd * lwv[k] + lbv[k];
                    o[k] = (y + bn * vsh) * gacc[mt][nt][4 * rq + k];
                }
                u32x2 ov; ov.x = pk2(o[0], o[1]); ov.y = pk2(o[2], o[3]);
                *(u32x2*)(mix + row * D + 640 + h * 64 + v0) = ov;
            }
    }
}
__device__ __forceinline__ void mixnorm_rows(Frame& F, int layer, int m0, int nrows) {
    bf16_t* mix = (bf16_t*)(F.ws + WS_HM);
    const float* gn = INF(F, I_NNSA) + layer * 384; const float* gm = INF(F, I_NMOBA) + layer * 256;
    const int lane = F.lane;
    for (int m = m0 + F.wave; m < m0 + nrows; m += NWAVES) {
        unsigned* rowp = (unsigned*)(mix + (size_t)m * D);
        unsigned a[3], c[2]; float sa = 0.f, sc = 0.f;
#pragma unroll
        for (int j = 0; j < 3; ++j) { a[j] = rowp[lane + 64 * j]; const float x = __uint_as_float(a[j] << 16), y = __uint_as_float(a[j] & 0xffff0000u); sa += x * x + y * y; }
#pragma unroll
        for (int j = 0; j < 2; ++j) { c[j] = rowp[192 + lane + 64 * j]; const float x = __uint_as_float(c[j] << 16), y = __uint_as_float(c[j] & 0xffff0000u); sc += x * x + y * y; }
        const float ra = rsqrtf(wave_sum(sa, lane) * (1.f / 384.f) + NORM_EPS), rc = rsqrtf(wave_sum(sc, lane) * (1.f / 256.f) + NORM_EPS);
#pragma unroll
        for (int j = 0; j < 3; ++j) { const int col = 2 * (lane + 64 * j); rowp[lane + 64 * j] = pk2(__uint_as_float(a[j] << 16) * ra * gn[col], __uint_as_float(a[j] & 0xffff0000u) * ra * gn[col + 1]); }
#pragma unroll
        for (int j = 0; j < 2; ++j) { const int col = 2 * (lane + 64 * j); rowp[192 + lane + 64 * j] = pk2(__uint_as_float(c[j] << 16) * rc * gm[col], __uint_as_float(c[j] & 0xffff0000u) * rc * gm[col + 1]); }
    }
}
__device__ __forceinline__ void phase_e(Frame& F, int layer) {
    const int gw = F.bid * NWAVES + F.wave, NGW = F.G * NWAVES;
    (void)gw; (void)NGW; (void)layer;
}

constexpr int CW_TILE = 1536;
constexpr int CW_R2DONE = 512;
__device__ __forceinline__ void phase_d(Frame& F, int layer, int rep = 0) {
    if (F.bid < 12 && rep == 0) {
        await_count(F, F.ctl + CW_R1DONE + 64 * layer + F.bid, 16u);
        if (F.wave < 2) { r2_wave(F, F.bid * 2 + F.wave);
            __builtin_amdgcn_fence(__ATOMIC_RELEASE, "agent"); asm volatile("s_waitcnt vmcnt(0)" ::: "memory");
            if (F.lane == 0) (void)__hip_atomic_fetch_add(F.ctl + CW_R2DONE + 64 * layer, 1u, RLX_AGENT); }
        __syncthreads();
#if DBG_MODE == 4
        if (F.bid == 0 && layer == 0) __hip_atomic_store(F.ctl + 3200 + 30, (unsigned)__builtin_amdgcn_s_memrealtime(), RLX_AGENT);
#endif
    }
    LAUNDER(F);
    await_count(F, F.ctl + CW_PREP + 64 * layer, 64u);
    LAUNDER(F);
    volatile LAS int* tw = (volatile LAS int*)(F.lds + AT_MISC);
    unsigned* qh = F.ctl + CW_Q + 64 * layer + 16 * rep;
    const int ntask = (rep == 0) ? 512 + 192 + 128 : 512;
    for (;;) {
        if (F.tid == 0) tw[0] = (int)__hip_atomic_fetch_add(qh, 1u, RLX_AGENT);
        __syncthreads();
        const int k = __builtin_amdgcn_readfirstlane(tw[0]);
        __syncthreads();
        if (k >= ntask) break;
        LAUNDER(F);
        if (k >= 512 + 192) {
            const int tile = k - (512 + 192);
            await_count(F, F.ctl + CW_TILE + 128 * layer + tile, 6u);
            mixnorm_rows(F, layer, tile * 128, 128);
            continue;
        }
        if (k >= 512) {
            if (F.tid == 0) { unsigned sp = 0; while ((unsigned)__builtin_amdgcn_readfirstlane(__hip_atomic_load(F.ctl + CW_R2DONE + 64 * layer, RLX_AGENT)) < 24u) { __builtin_amdgcn_s_sleep(4); if (++sp > (1u << 24)) break; }
                __builtin_amdgcn_fence(__ATOMIC_ACQUIRE, "agent"); asm volatile("s_waitcnt vmcnt(0)" ::: "memory"); }
            __syncthreads();
            r3_task(F, layer, (k - 512) * 8 + F.wave);
            continue;
        }
        const int code = g_tasks.v[k], ty = code >> 9, mm = (code >> 6) & 7, jj = code & 63;
        if (ty == 0) nsa_task(F, mm >> 1, mm & 1, jj); else moba_task(F, mm >> 2, mm & 3, jj);
        if (rep == 0) {
            asm volatile("s_waitcnt vmcnt(0)" ::: "memory"); __syncthreads();
            if (F.tid == 0) { __builtin_amdgcn_fence(__ATOMIC_RELEASE, "agent"); asm volatile("s_waitcnt vmcnt(0)" ::: "memory");
                unsigned* tc = F.ctl + CW_TILE + 128 * layer;
                if (ty == 0) (void)__hip_atomic_fetch_add(tc + (mm >> 1) * 64 + jj, 1u, RLX_AGENT);
                else { (void)__hip_atomic_fetch_add(tc + (mm >> 2) * 64 + 2 * jj, 1u, RLX_AGENT); (void)__hip_atomic_fetch_add(tc + (mm >> 2) * 64 + 2 * jj + 1, 1u, RLX_AGENT); } }
        }
    }
}

__device__ __forceinline__ void phase_g1(Frame& F, int layer) {
    LAS float* wr = (LAS float*)F.lds;
    { const float* W = INF(F, I_WROUTER);
#pragma unroll 1
      for (int i0 = 0; i0 < 4096; i0 += 2048) { f32x4 t4[4];
#pragma unroll
          for (int u = 0; u < 4; ++u) t4[u] = *(const f32x4*)(W + 4 * (i0 + u * NTHR + F.tid));
#pragma unroll
          for (int u = 0; u < 4; ++u) { const int i = 4 * (i0 + u * NTHR + F.tid), k = i >> 4, e = i & 15;
              wr[e * 1028 + k] = t4[u].x; wr[(e + 1) * 1028 + k] = t4[u].y; wr[(e + 2) * 1028 + k] = t4[u].z; wr[(e + 3) * 1028 + k] = t4[u].w; } } }
    __syncthreads();
    const float* mod = (const float*)(F.ws + WS_MOD);
    bf16_t* H = (bf16_t*)(F.ws + WS_HM);
    unsigned* cnt = F.ctl + CW_CNT + 64 * layer;
    const float* rb = INF(F, I_RBIAS);
    const float* gn = INF(F, I_NFFN) + layer * D;
    const int gw = F.bid * NWAVES + F.wave, NGW = F.G * NWAVES;
    f32x4 vnext[4];
#pragma unroll
    for (int j = 0; j < 4; ++j) vnext[j] = *(const f32x4*)(F.out + (size_t)gw * D + 4 * F.lane + 256 * j);
    int px = 0, pm = 0; float pw = 0.f; int ridx = 0;
    for (int m = gw; m < T; m += NGW, ++ridx) {
        int lane = F.lane; asm volatile("" : "+v"(lane));
        const int b = m >> 13;
        const float* sh = mod + ((size_t)layer * BATCH + b) * 6144 + 3072; const float* sc = sh + 1024;
        f32x4 v[4]; float ss = 0.f;
#pragma unroll
        for (int j = 0; j < 4; ++j) { v[j] = vnext[j]; ss += (v[j].x * v[j].x + v[j].y * v[j].y) + (v[j].z * v[j].z + v[j].w * v[j].w); }
        { const int mn = (m + NGW < T) ? m + NGW : m;
#pragma unroll
          for (int j = 0; j < 4; ++j) vnext[j] = *(const f32x4*)(F.out + (size_t)mn * D + 4 * lane + 256 * j); }
        const float rstd = rsqrtf(wave_sum(ss, lane) * (1.f / D) + NORM_EPS);
        float lg[16]; f32x2_t lgp[16];
#pragma unroll
        for (int e = 0; e < 16; ++e) lgp[e] = (f32x2_t){0.f, 0.f};
#pragma unroll
        for (int j = 0; j < 4; ++j) { const int col = 4 * lane + 256 * j;
            const f32x4 g = *(const f32x4*)(gn + col), s1 = *(const f32x4*)(sc + col), s0 = *(const f32x4*)(sh + col);
            const float hx = v[j].x * rstd * g.x * (1.f + s1.x) + s0.x, hy = v[j].y * rstd * g.y * (1.f + s1.y) + s0.y, hz = v[j].z * rstd * g.z * (1.f + s1.z) + s0.z, hw = v[j].w * rstd * g.w * (1.f + s1.w) + s0.w;
            u32x2 o; o.x = pk2(hx, hy); o.y = pk2(hz, hw); *(u32x2*)(H + (size_t)m * D + col) = o;
            const f32x2_t h01 = {hx, hy}, h23 = {hz, hw};
#pragma unroll
            for (int e = 0; e < 16; ++e) { const f32x4 w4 = *(const LAS f32x4*)(wr + e * 1028 + col);
                lgp[e] = __builtin_elementwise_fma(h01, (f32x2_t){w4.x, w4.y}, lgp[e]); lgp[e] = __builtin_elementwise_fma(h23, (f32x2_t){w4.z, w4.w}, lgp[e]); }
        }
#pragma unroll
        for (int e = 0; e < 16; ++e) lg[e] = lgp[e].x + lgp[e].y;
        float r8[8], r4[4], r2[2], r1;
#pragma unroll
        for (int e = 0; e < 8; ++e) { auto sw = __builtin_amdgcn_permlane32_swap(__float_as_uint(lg[e]), __float_as_uint(lg[e + 8]), false, false); r8[e] = __uint_as_float(sw[0]) + __uint_as_float(sw[1]); }
#pragma unroll
        for (int e = 0; e < 4; ++e) { auto sw = __builtin_amdgcn_permlane16_swap(__float_as_uint(r8[e]), __float_as_uint(r8[e + 4]), false, false); r4[e] = __uint_as_float(sw[0]) + __uint_as_float(sw[1]); }
        { const bool up = (lane & 8) != 0;
#pragma unroll
          for (int e = 0; e < 2; ++e) { const float keep = up ? r4[e + 2] : r4[e], send = up ? r4[e] : r4[e + 2]; r2[e] = keep + dpp_mov<0x140>(send); } }
        { const bool up = (lane & 4) != 0; const float keep = up ? r2[1] : r2[0], send = up ? r2[0] : r2[1]; r1 = keep + dpp_mov<0x141>(send); }
        r1 += dpp_mov<0x4E>(r1); r1 += dpp_mov<0xB1>(r1);
        const int el = (((lane >> 5) & 1) << 3) | (((lane >> 4) & 1) << 2) | (((lane >> 3) & 1) << 1) | ((lane >> 2) & 1);
        const float affl = sigm(r1), bial = affl + rb[el];
        float aff[16], bia[16];
#pragma unroll
        for (int e = 0; e < 16; ++e) { const int src = ((e & 8) ? 32 : 0) | ((e & 4) ? 16 : 0) | ((e & 2) ? 8 : 0) | ((e & 1) ? 4 : 0);
            aff[e] = __uint_as_float(__builtin_amdgcn_readlane(__float_as_uint(affl), src)); bia[e] = __uint_as_float(__builtin_amdgcn_readlane(__float_as_uint(bial), src)); }
        int best = 0; float bscore = -INFINITY;
#pragma unroll
        for (int g = 0; g < 4; ++g) {
            float t1 = -INFINITY, t2 = -INFINITY;
#pragma unroll
            for (int k = 0; k < 4; ++k) { const float x = bia[4 * g + k]; if (x > t1) { t2 = t1; t1 = x; } else if (x > t2) t2 = x; }
            const float gs = t1 + t2; if (gs > bscore) { bscore = gs; best = g; }
        }
        float x4[4], a4[4];
#pragma unroll
        for (int k = 0; k < 4; ++k) { x4[k] = (best == 0) ? bia[k] : (best == 1) ? bia[4 + k] : (best == 2) ? bia[8 + k] : bia[12 + k]; a4[k] = (best == 0) ? aff[k] : (best == 1) ? aff[4 + k] : (best == 2) ? aff[8 + k] : aff[12 + k]; }
        int i1 = 0; float v1 = x4[0];
#pragma unroll
        for (int k = 1; k < 4; ++k) if (x4[k] > v1) { v1 = x4[k]; i1 = k; }
        int i2 = -1; float v2 = -INFINITY;
#pragma unroll
        for (int k = 0; k < 4; ++k) if (k != i1 && x4[k] > v2) { v2 = x4[k]; i2 = k; }
        float w1 = 0.f, w2 = 0.f;
#pragma unroll
        for (int k = 0; k < 4; ++k) { if (k == i1) w1 = a4[k]; if (k == i2) w2 = a4[k]; }
        const float ws = w1 + w2; w1 /= ws; w2 /= ws;
        if (lane == 2 * ridx) { px = 4 * best + i1; pm = m; pw = w1; }
        if (lane == 2 * ridx + 1) { px = 4 * best + i2; pm = m; pw = w2; }
    }
    {
        const int lane = F.lane; const int np = 2 * ridx;
        int rank = 0, total = 0, leader = 64;
        for (int j = 0; j < np; ++j) { const int xj = __builtin_amdgcn_readlane(px, j); const bool same = (xj == px); rank += (same && j < lane) ? 1 : 0; total += same ? 1 : 0; leader = (same && j < leader) ? j : leader; }
        int base = 0;
        if (lane < np && rank == 0) base = (int)__hip_atomic_fetch_add(cnt + px, (unsigned)total, RLX_AGENT);
        base = __builtin_amdgcn_ds_bpermute((leader & 63) << 2, base);
        if (lane < np) { const int idx = px * 16384 + base + rank; ((int*)(F.ws + WS_ELIST))[idx] = 2 * pm + (lane & 1); ((float*)(F.ws + WS_EWW))[idx] = pw; }
    }
    asm volatile("s_waitcnt vmcnt(0)" ::: "memory"); __syncthreads();
    if (F.wave == 0) {
        unsigned tk = 0;
        if (F.lane == 0) { __builtin_amdgcn_fence(__ATOMIC_RELEASE, "agent"); asm volatile("s_waitcnt vmcnt(0)" ::: "memory"); tk = __hip_atomic_fetch_add(cnt + 32, 1u, RLX_AGENT); }
        tk = (unsigned)__builtin_amdgcn_readfirstlane((int)tk);
        if (tk == (unsigned)F.G - 1u) {
            __builtin_amdgcn_fence(__ATOMIC_ACQUIRE, "agent");
            const int lane = F.lane;
            int* tile_e = (int*)(F.ws + WS_ROWINFO + layer * ROWINFO_LSTRIDE) + 2 * MAXROWS;
            const int c = (lane < 16) ? (int)__hip_atomic_load(cnt + (lane & 15), RLX_AGENT) : 0, nt = (c + 255) >> 8;
            int ofs = 0, tot = 0;
            for (int e = 0; e < 16; ++e) { const int ne = __builtin_amdgcn_readlane(nt, e) << 8; ofs += (e < lane) ? ne : 0; tot += ne; }
            if (lane < 16) { tile_e[TE_OFF + lane] = ofs; tile_e[TE_CNT + lane] = c; for (int j = 0; j < nt; ++j) tile_e[(ofs >> 8) + j] = lane; }
            if (lane == 0) tile_e[256] = tot >> 8;
        }
    }
}
__device__ __forceinline__ void phase_g2(Frame& F, int layer) {
    volatile LAS int* off = (volatile LAS int*)F.lds;
    unsigned* cnt = F.ctl + CW_CNT + 64 * layer;
    int* rowinfo = (int*)(F.ws + WS_ROWINFO + layer * ROWINFO_LSTRIDE); float* roww = (float*)(rowinfo + MAXROWS); int* tile_e = rowinfo + 2 * MAXROWS; int* ntl = tile_e + 256;
    if (F.tid == 0) { int o = 0; for (int e = 0; e < 16; ++e) { off[e] = o; const int c = (int)__hip_atomic_load(cnt + e, RLX_AGENT); o += ((c + 255) >> 8) << 8; } off[16] = o; }
    __syncthreads();
    if (F.bid == 0) {
        if (F.tid == 0) ntl[0] = off[16] >> 8;
        for (int e = 0; e < 16; ++e) {
            const int c = (int)__hip_atomic_load(cnt + e, RLX_AGENT), o0 = off[e], o1 = off[e + 1];
            for (int r = o0 + c + F.tid; r < o1; r += NTHR) { rowinfo[r] = -1; roww[r] = 0.f; }
            for (int tl = (o0 >> 8) + F.tid; tl < (o1 >> 8); tl += NTHR) tile_e[tl] = e;
        }
    }
    const int* route = (const int*)(F.ws + WS_ROUTE);
    const int gw = F.bid * NWAVES + F.wave, NGW = F.G * NWAVES, lane = F.lane;
    for (int m = gw; m < T; m += NGW) {
        const int* rp = route + (size_t)m * 8;
        const int e1 = ld_ctl(rp), e2 = ld_ctl(rp + 1), p1 = ld_ctl(rp + 2), p2 = ld_ctl(rp + 3);
        const int r1 = off[e1] + p1, r2 = off[e2] + p2;
        if (lane == 0) { rowinfo[r1] = 2 * m; rowinfo[r2] = 2 * m + 1; roww[r1] = __int_as_float(ld_ctl(rp + 4)); roww[r2] = __int_as_float(ld_ctl(rp + 5)); }
    }
}

#if DBG_MODE == 2
__device__ __forceinline__ void dbg_flag(Frame& F, bool bad, unsigned code) { if (__any(bad) && F.lane == 0) atomicCAS(F.ctl + CW_DBG, 0u, code); }
__device__ __forceinline__ void scan_bf16(Frame& F, size_t off, size_t n, unsigned code) {
    const unsigned* p = (const unsigned*)(F.ws + off); bool bad = false;
    for (size_t i = (size_t)F.bid * NTHR + F.tid; i < n / 2; i += (size_t)F.G * NTHR) { const unsigned u = p[i]; bad = bad || ((u & 0x7f80u) == 0x7f80u) || ((u & 0x7f800000u) == 0x7f800000u); }
    dbg_flag(F, bad, code); }
__device__ __forceinline__ void scan_f32p(Frame& F, const float* p, size_t n, unsigned code) {
    bool bad = false;
    for (size_t i = (size_t)F.bid * NTHR + F.tid; i < n; i += (size_t)F.G * NTHR) { const unsigned u = __float_as_uint(p[i]); bad = bad || ((u & 0x7f800000u) == 0x7f800000u); }
    dbg_flag(F, bad, code); }
__device__ __forceinline__ void dbg_check(Frame& F, int p) {
    const unsigned code = (unsigned)(p + 1);
    if (DBG_SUB >= 4) {
        if (p != DBG_P) return;
        const size_t off = (DBG_SUB == 4) ? WS_ZS : (DBG_SUB == 5) ? WS_PT : (DBG_SUB == 6) ? WS_YT : WS_Y0;
        const unsigned* q = (const unsigned*)(F.ws + off); unsigned mx = 0;
        for (size_t i = (size_t)F.bid * NTHR + F.tid; i < (size_t)1536 * 2048; i += (size_t)F.G * NTHR) { const unsigned u = q[i]; const unsigned e0 = (u >> 7) & 0xffu, e1 = (u >> 23) & 0xffu; mx = mx > e0 ? mx : e0; mx = mx > e1 ? mx : e1; }
#if DBG_CNT
        { unsigned cnt = 0; for (size_t i = (size_t)F.bid * NTHR + F.tid; i < (size_t)1536 * 2048; i += (size_t)F.G * NTHR) { const unsigned u = q[i]; cnt += (((u >> 7) & 0xffu) == 0xffu) + (((u >> 23) & 0xffu) == 0xffu); }
          if (cnt) atomicAdd(F.ctl + CW_DBG, cnt); return; }
#endif
        atomicMax(F.ctl + CW_DBG, mx); return; }
    if (DBG_SUB == 3 && p != 4) return;
    if (p == 0) { scan_f32p(F, (const float*)(F.ws + WS_COS), (size_t)T * 64, code); scan_f32p(F, (const float*)(F.ws + WS_MOD), 2 * 2 * 6144, code); return; }
    if (p > 10 * NL) return;
    const int sub = (p - 1) % 10;
    switch (sub) {
    case 0: scan_bf16(F, WS_HM, (size_t)T * D, code); scan_bf16(F, WS_WIN, (size_t)NPAD * D, code); scan_bf16(F, WS_WOUT, (size_t)D * D, code); scan_bf16(F, WS_WUP, (size_t)16 * 512 * D, code);
            scan_bf16(F, WS_WDN, (size_t)16 * D * 256, code); scan_bf16(F, WS_PHIW, (size_t)2 * 64 * 2048, code); scan_bf16(F, WS_GUPT, 384 * 128, code); scan_f32p(F, (const float*)(F.ws + WS_PHIB), 256, code); break;
    case 1: scan_bf16(F, WS_NQ, (size_t)T * 384, code); scan_bf16(F, WS_KV6, (size_t)6 * T * 128, code); scan_bf16(F, WS_MQKV, (size_t)3 * T * 256, code); scan_bf16(F, WS_RFEAT, (size_t)T * RW, code);
            scan_f32p(F, (const float*)(F.ws + WS_GATE), (size_t)T * 32, code); break;
    case 2: scan_bf16(F, WS_KCMP, 2 * 2 * 512 * 64, code); scan_bf16(F, WS_VCMP, 2 * 2 * 512 * 64, code); scan_bf16(F, WS_KMEAN, 2 * 4 * 32 * 64, code);
            scan_bf16(F, WS_PT, (size_t)1536 * 4096, code); scan_bf16(F, WS_ZS, (size_t)1536 * 4096, code); scan_bf16(F, WS_YT, (size_t)1536 * 4096, code); scan_bf16(F, WS_Y0, (size_t)1536 * 4096, code);
            scan_f32p(F, (const float*)(F.ws + WS_BONUS), (size_t)T * 8, code); break;
    case 3: {
#if DBG_SUB == 3
        if (p == 4) { const unsigned* hm = (const unsigned*)(F.ws + WS_HM); bool b1 = false, b2 = false, b4 = false;
            for (size_t i = (size_t)F.bid * NTHR + F.tid; i < (size_t)T * 512; i += (size_t)F.G * NTHR) { const unsigned u = hm[i]; const int col = (int)(i & 511) * 2; const bool bad = ((u & 0x7f80u) == 0x7f80u) || ((u & 0x7f800000u) == 0x7f800000u);
                if (col < 384) b1 = b1 || bad; else if (col < 640) b2 = b2 || bad; }
            const unsigned* zs = (const unsigned*)(F.ws + WS_ZS);
            for (size_t i = (size_t)F.bid * NTHR + F.tid; i < (size_t)1536 * 2048; i += (size_t)F.G * NTHR) { const unsigned u = zs[i]; b4 = b4 || ((u & 0x7f80u) == 0x7f80u) || ((u & 0x7f800000u) == 0x7f800000u); }
            const unsigned bits = (__any(b1) ? 1u : 0u) | (__any(b2) ? 2u : 0u) | (__any(b4) ? 4u : 0u);
            if (bits && F.lane == 0) atomicOr(F.ctl + CW_DBG, bits); }
#else
        scan_bf16(F, WS_HM, (size_t)T * D, code); scan_bf16(F, WS_ZS, (size_t)1536 * 4096, code);
#endif
        } break;
    case 4: scan_bf16(F, WS_HM, (size_t)T * D, code); break;
    case 5: scan_f32p(F, F.out, (size_t)T * D, code); break;
    case 6: scan_bf16(F, WS_HM, (size_t)T * D, code); break;
    case 7: scan_bf16(F, WS_SORTA, (size_t)MAXROWS * D, code); break;
    case 8: scan_bf16(F, WS_HID, (size_t)MAXROWS * 256, code); break;
    case 9: scan_bf16(F, WS_YS, (size_t)2 * T * D, code); break;
    }
}
#endif
struct Args { const void* in[31]; float* out; unsigned char* ws; int ph_lo, ph_hi; };
constexpr int N_PHASES = 2 + 10 * NL + (DBG_MODE ? 1 : 0);

__global__ void __launch_bounds__(NTHR, 2) hybrid_fwd(Args args) {
    extern __shared__ __attribute__((aligned(16))) unsigned char lds_raw[];
    Frame F;
    F.lds = (LAS unsigned char*)lds_raw;
    F.MISC = (volatile LAS unsigned*)(F.lds + MISC_OFF);
    F.tid = threadIdx.x; F.lane = F.tid & 63; F.wave = __builtin_amdgcn_readfirstlane(F.tid >> 6);
    F.G = gridDim.x; F.bid = blockIdx.x;
    F.ws = (unsigned char*)(GAS unsigned char*)args.ws; F.out = (float*)(GAS float*)args.out; F.ctl = (unsigned*)(GAS unsigned*)(args.ws + WS_CTL);
    for (int u = F.tid; u < (LDS_BYTES - RING_BYTES) / 4; u += NTHR) ((LAS unsigned*)(F.lds + RING_BYTES))[u] = 0u;
    __syncthreads();
    if (F.tid < 31) *(LAS unsigned long long*)(F.lds + IN_OFF + 8 * F.tid) = (unsigned long long)args.in[F.tid];
    __syncthreads();
#if MK_PER_PHASE
#define GRID_BAR() do { } while (0)
#else
    XcdBarrier bar = xcd_barrier_post(F.ctl + CW_BAR, F.MISC + 8);
#define GRID_BAR() do { LAUNDER(F); xcd_barrier(bar, F.tid); } while (0)
#endif
    const int lo = args.ph_lo, hi = args.ph_hi;
    for (int ph_ = lo; ph_ < hi; ++ph_) {
        int ph = ph_; asm volatile("" : "+s"(ph));
#if DBG_MODE == 2
        if (ph > 0) { LAUNDER(F); dbg_check(F, ph - 1); }
#endif
#if DBG_MODE == 4
        if (blockIdx.x == 0) { const unsigned tnow = (unsigned)__builtin_amdgcn_s_memrealtime(); __hip_atomic_store((unsigned*)(args.ws + WS_CTL) + 3200 + ph_, tnow, RLX_AGENT); }
#endif
        for (int rep = 0; rep < ((REPEAT_PH >= 0 && ph_ == REPEAT_PH) ? 2 : 1); ++rep) {
        if (rep) GRID_BAR();
        if (ph == 0) { if (PH_EN(10)) { LAUNDER(F); phase_pro(F); LAUNDER(F); phase_a(F, 0, false, true); } }
#if DBG_MODE
        else if (ph == N_PHASES - 1) { LAUNDER(F);
#if DBG_MODE == 4
            const float dv = 100.f * floorf(4.f * log2f((float)(unsigned)(ld_ctl((const int*)(F.ctl + 3200 + DBG_TPH1)) - ld_ctl((const int*)(F.ctl + 3200 + DBG_TPH0)))) + DBG_QOFF);
            const float dv2 = 10000.f * floorf(4.f * log2f((float)(unsigned)(ld_ctl((const int*)(F.ctl + 3200 + DBG_TPH3)) - ld_ctl((const int*)(F.ctl + 3200 + DBG_TPH2)))) + DBG_QOFF);
            for (int i = F.bid * NTHR + F.tid; i < T * D; i += F.G * NTHR) F.out[i] = (i == 0) ? dv2 : dv;
            if (0)
#else
            const float dv = sqrtf((float)ld_ctl((const int*)(F.ctl + CW_DBG)));
#endif
            for (int i = F.bid * NTHR + F.tid; i < T * D; i += F.G * NTHR) F.out[i] = dv; }
        else if (ph == N_PHASES - 2) { if (PH_EN(11)) { LAUNDER(F); norm_rows(F, 0, true); } }
#else
        else if (ph == N_PHASES - 1) { if (PH_EN(11)) { LAUNDER(F); norm_rows(F, 0, true); } }
#endif
        else {
            const int layer = (ph - 1) / 10, sub = (ph - 1) % 10;
            switch (sub) {
            case 0: if (PH_EN(0)) { LAUNDER(F); phase_a(F, layer, true, layer > 0); } break;
            case 1: if (PH_EN(1)) { LAUNDER(F); pg8::Gemm g{(const bf16_t*)(F.ws + WS_HM), (const bf16_t*)(F.ws + WS_WIN), T, NPAD, D}; pg8::StaticOrder S; S.init(T, NPAD, F.G, F.bid, NPAD / 256 - 1);
                      EpiInProj E{(bf16_t*)(F.ws + WS_NQ), (bf16_t*)(F.ws + WS_KV6), (bf16_t*)(F.ws + WS_MQKV), (bf16_t*)(F.ws + WS_RFEAT), (float*)(F.ws + WS_GATE), (const float*)(F.ws + WS_COS), (const float*)(F.ws + WS_SIN)};
                      if (rep == 0) pg8::gemm_phase<EpiInProj, pg8::StaticOrder, true, true>(F.lds, g, S, E, F.tid);
                      else { EpiNull EN{(float*)(F.ws + WS_GATE)}; pg8::gemm_phase<EpiNull, pg8::StaticOrder, true, true>(F.lds, g, S, EN, F.tid); } } break;
            case 2: if (PH_EN(2)) { LAUNDER(F); phase_c(F, layer); LAUNDER(F); phase_d(F, layer, rep); } break;
            case 3: break;
            case 4: if (PH_EN(4)) { LAUNDER(F); phase_e(F, layer); } break;
            case 5: if (PH_EN(5)) { LAUNDER(F); pg8::Gemm g{(const bf16_t*)(F.ws + WS_HM), (const bf16_t*)(F.ws + WS_WOUT), T, D, D}; pg8::StaticOrder S; S.init(T, D, F.G, F.bid);
                      EpiOutProj E{layer == 0 ? INF(F, I_X) : F.out, F.out, (const float*)(F.ws + WS_MOD) + (size_t)layer * BATCH * 6144 + 2048};
                      if (rep == 0) pg8::gemm_phase<EpiOutProj, pg8::StaticOrder, true, true>(F.lds, g, S, E, F.tid);
                      else { EpiNull EN{(float*)(F.ws + WS_GATE)}; pg8::gemm_phase<EpiNull, pg8::StaticOrder, true, true>(F.lds, g, S, EN, F.tid); } } break;
            case 6: if (PH_EN(6)) { LAUNDER(F); phase_g1(F, layer); } break;
            case 7: break;
            case 8: if (PH_EN(8)) { LAUNDER(F); const int* rowinfo = (const int*)(F.ws + WS_ROWINFO + layer * ROWINFO_LSTRIDE); const int* tile_e = rowinfo + 2 * MAXROWS;
                      const int ntl = __builtin_amdgcn_readfirstlane(ld_ctl(tile_e + 256));
                      pg8::Gemm g{(const bf16_t*)(F.ws + WS_HM), (const bf16_t*)(F.ws + WS_WUP), MAXROWS, 512, D};
                      MoeGatherOrder S{ntl, 2, F.G, F.bid, tile_e, (size_t)512 * D * 2, (const int*)(F.ws + WS_ELIST)};
                      EpiMoeUp E{(bf16_t*)(F.ws + WS_HID)};
                      pg8::gemm_phase<EpiMoeUp, MoeGatherOrder, true, true>(F.lds, g, S, E, F.tid); } break;
            case 9: if (PH_EN(9)) { LAUNDER(F); const int* rowinfo = (const int*)(F.ws + WS_ROWINFO + layer * ROWINFO_LSTRIDE); const int* tile_e = rowinfo + 2 * MAXROWS;
                      const int ntl = __builtin_amdgcn_readfirstlane(ld_ctl(tile_e + 256));
                      pg8::Gemm g{(const bf16_t*)(F.ws + WS_HID), (const bf16_t*)(F.ws + WS_WDN), MAXROWS, D, 256};
                      MoeOrder S{ntl, 4, F.G, F.bid, tile_e, (size_t)D * 256 * 2, (const int*)(F.ws + WS_ELIST)};
                      EpiMoeDown E{(bf16_t*)(F.ws + WS_YS), tile_e, (const int*)(F.ws + WS_ELIST), (const float*)(F.ws + WS_EWW)};
                      pg8::gemm_phase<EpiMoeDown, MoeOrder, true, true>(F.lds, g, S, E, F.tid); } break;
            }
        }
        }
#if EXTRA_BAR
        if (ph_ == 0) { for (int eb = 0; eb < EXTRA_BAR; ++eb) GRID_BAR(); }
#endif
        if (ph_ + 1 < hi && !(ph_ >= 1 && ph_ <= 10 * NL && (((ph_ - 1) % 10) == 2 || ((ph_ - 1) % 10) == 3 || ((ph_ - 1) % 10) == 7))) GRID_BAR();
    }
}

extern "C" void kernel_launch(void* const* d_in, const int* in_sizes, int n_in, void* d_out, int out_size, void* d_ws, size_t ws_size, hipStream_t stream) {
    static int grid = 0;
    if (grid == 0) {
        if (n_in != 31 || out_size != T * D || ws_size < WS_END) { fprintf(stderr, "kernel_launch: unexpected shapes: n_in %d out %d ws %zu (need %zu)\n", n_in, out_size, ws_size, (size_t)WS_END); grid = -1; return; }
        int dev = 0, cus = 0, per_cu = 0;
        if (hipGetDevice(&dev) != hipSuccess || hipDeviceGetAttribute(&cus, hipDeviceAttributeMultiprocessorCount, dev) != hipSuccess) { grid = -1; return; }
        if (hipFuncSetAttribute((const void*)hybrid_fwd, hipFuncAttributeMaxDynamicSharedMemorySize, LDS_BYTES) != hipSuccess) { fprintf(stderr, "kernel_launch: hipFuncSetAttribute failed\n"); grid = -1; return; }
        if (hipOccupancyMaxActiveBlocksPerMultiprocessor(&per_cu, (const void*)hybrid_fwd, NTHR, LDS_BYTES) != hipSuccess || per_cu < 1) fprintf(stderr, "kernel_launch: occupancy query says %d\n", per_cu);
        (void)hipGetLastError();
        grid = cus;
    }
    if (grid < 0) return;
    (void)hipMemsetAsync((char*)d_ws + WS_CTL, 0, CTL_ZERO_BYTES, stream);
    Args a{};
    for (int i = 0; i < 31; ++i) a.in[i] = d_in[i];
    a.out = (float*)d_out; a.ws = (unsigned char*)d_ws;
#if MK_PER_PHASE
    for (int ph = 0; ph < N_PHASES; ++ph) { a.ph_lo = ph; a.ph_hi = ph + 1; hipLaunchKernelGGL(hybrid_fwd, dim3(grid), dim3(NTHR), LDS_BYTES, stream, a); }
#else
    a.ph_lo = 0; a.ph_hi = N_PHASES;
    hipLaunchKernelGGL(hybrid_fwd, dim3(grid), dim3(NTHR), LDS_BYTES, stream, a);
#endif
}
```

```cpp
#include <hip/hip_runtime.h>
#include <cstdio>
#include <cstdint>
#include <cmath>
#ifndef PH_MASK
#define PH_MASK 0xfff
#endif
#define PH_EN(k) ((PH_MASK >> (k)) & 1)
#ifndef MK_PER_PHASE
#define MK_PER_PHASE 0
#endif
namespace pg8 {
#define PG8_LAS __attribute__((address_space(3)))
typedef unsigned short bf16_t;
typedef short bf16x8 __attribute__((ext_vector_type(8)));
typedef float f32x4 __attribute__((ext_vector_type(4)));
typedef unsigned u32x4 __attribute__((ext_vector_type(4)));
constexpr int BM = 256, BK = 64, HALF = 128, HTB = HALF * BK * 2  , STAGE_BYTES = 8 * HTB, NXCD = 8, WGM = 8;

__host__ __device__ __forceinline__ int lds_byte(int r, int c) { const int st = (r >> 4) * 2 + (c >> 5), rr = r & 15, cc = c & 31, ob = rr * 64 + cc * 2; return st * 1024 + (ob ^ (((ob >> 9) & 1) << 5)); }
__host__ __device__ __forceinline__ void stage_rc(int b, int& R, int& C) { const int st = b / 1024, sb = b % 1024, swz = sb ^ (((sb >> 9) & 1) << 5); R = (st >> 1) * 16 + swz / 64; C = (st & 1) * 32 + (swz % 64) / 2; }
__host__ __device__ __forceinline__ int perm32(int rho) { const int n = rho >> 4, i = rho & 15; return 8 * (i >> 2) + 4 * n + (i & 3); }

struct Unit { int pm, pn, mask; };
struct Gemm { const bf16_t* A; const bf16_t* Bt; int M, N, K; };

__host__ __device__ __forceinline__ bool tail_split(int i, int G, int c, int total, int& L, int& f, int& sub) {
    const int rounds = total / G, nfull = rounds * G, ntail = total - nfull; f = 1; sub = 0;
    if (i < rounds) { L = i * G + c; return true; }
    if (i > rounds || ntail == 0) return false;
    f = (4 * ntail <= G) ? 4 : (2 * ntail <= G) ? 2 : 1;
    if (c >= ntail * f) return false;
    L = nfull + c / f; sub = c % f; return true;
}
struct StaticOrder {
    int nM, nN, nwg, G, c, padpn;
    __host__ __device__ void init(int M, int N, int G_, int c_, int padpn_ = -1) { nM = M / BM; nN = N / BM; nwg = nM * nN; G = G_; c = c_; padpn = padpn_; }
    __host__ __device__ bool next(int i, Unit& u) const {
        int L, f, sub; if (!tail_split(i, G, c, nwg, L, f, sub)) return false;
        int wgid = L; { const int q = nwg / NXCD, r = nwg % NXCD, xcd = wgid % NXCD, off = wgid / NXCD; wgid = (xcd < r ? xcd * (q + 1) : r * (q + 1) + (xcd - r) * q) + off; }
        const int nig = WGM * nN, gid = wgid / nig, fm = gid * WGM, gsz = (nM - fm) < WGM ? (nM - fm) : WGM;
        u.pm = fm + ((wgid % nig) % gsz); u.pn = (wgid % nig) / gsz;
        const bool pad = (u.pn == padpn);
        u.mask = (f == 1) ? (pad ? 0x5 : 0xF) : (f == 2) ? (pad ? (sub ? 0x4 : 0x1) : (sub ? 0xA : 0x5)) : ((1 << sub) & (pad ? 0x5 : 0xF));
        return true;
    }
    static constexpr bool GATHER = false;
    __device__ __forceinline__ void arows(const Unit&, const int (&)[2], int (&o)[2][2]) const { o[0][0] = o[0][1] = o[1][0] = o[1][1] = 0; }
    __device__ __forceinline__ void a_ready(const Unit&) const {}
    __device__ __forceinline__ size_t boff(const Unit&) const { return 0; }
    __device__ __forceinline__ void done(const Unit&) const {}
};

template <class Epi, class Sched, bool ALIGN_EPI = false, bool SP2 = false>
__device__ __forceinline__ void gemm_phase(PG8_LAS unsigned char* lds, const Gemm g, const Sched& S, const Epi& E, const int tid_in) {
    const int tid = tid_in, wid = __builtin_amdgcn_readfirstlane(tid >> 6), lane = tid & 63, wr = wid >> 2, wc = wid & 3, fr = lane & 15, fq = lane >> 4;
    const int K = g.K, nt = K / BK;
    unsigned voffA[2], voffB[2];
    int RA[2], CA[2];
    unsigned gA_cur[2][2], gA_nxt[2][2];
    static_assert(!Sched::GATHER || SP2, "row-gathered A is wired into the SP2 loop only");
#pragma unroll
    for (int i = 0; i < 2; ++i) { int R, C; stage_rc(tid * 16 + i * 8192, R, C); const int Rb = Epi::PERM ? ((R & ~31) + perm32(R & 31)) : R;
        voffA[i] = (unsigned)(R * K + C) * 2u; voffB[i] = (unsigned)(Rb * K + C) * 2u; RA[i] = R; CA[i] = C; }
#define PG8_GROWS(u, o) do { int ar_[2][2]; S.arows(u, RA, ar_); _Pragma("unroll") for (int h_ = 0; h_ < 2; ++h_) _Pragma("unroll") for (int i_ = 0; i_ < 2; ++i_) o[h_][i_] = (unsigned)(ar_[h_][i_] * K + CA[i_]) * 2u; } while (0)
    const size_t kstep = (size_t)(BK * 2);
    const size_t hstep = (size_t)HALF * K * 2;
    const size_t tstep = 2 * hstep;
    const unsigned ldsw = (unsigned)wid * 1024u;
    const int aoff = lds_byte(wr * 64 + fr, fq * 8), boff = lds_byte(wc * 32 + fr, fq * 8);
#define PG8_SA(b, h) (((b) * 2 + (h)) * HTB)
#define PG8_SB(b, h) ((4 + (b) * 2 + (h)) * HTB)
#define PG8_STAGE(bufoff, gbase, voff) do { _Pragma("unroll") for (int _i = 0; _i < 2; ++_i) \
        __builtin_amdgcn_global_load_lds((const unsigned*)((const char*)(gbase) + (voff)[_i]), (PG8_LAS unsigned*)(lds + (bufoff) + ldsw + _i * 8192), 16, 0, 0); } while (0)
#define PG8_STAGE_A(bufoff, gbase, half, nx) do { if constexpr (Sched::GATHER) { _Pragma("unroll") for (int _i = 0; _i < 2; ++_i) { const unsigned vo_ = (nx) ? gA_nxt[half][_i] : gA_cur[half][_i]; \
        __builtin_amdgcn_global_load_lds((const unsigned*)((const char*)(gbase) + vo_), (PG8_LAS unsigned*)(lds + (bufoff) + ldsw + _i * 8192), 16, 0, 0); } } else { PG8_STAGE(bufoff, (gbase) + (half) * hstep, voffA); } } while (0)
#define PG8_LDA(dst, b, h) do { _Pragma("unroll") for (int m = 0; m < 4; ++m) _Pragma("unroll") for (int k = 0; k < 2; ++k) dst[m][k] = *(const PG8_LAS bf16x8*)(lds + PG8_SA(b, h) + aoff + m * 2048 + k * 1024); } while (0)
#define PG8_LDB(dst, b, h) do { _Pragma("unroll") for (int n = 0; n < 2; ++n) _Pragma("unroll") for (int k = 0; k < 2; ++k) dst[n][k] = *(const PG8_LAS bf16x8*)(lds + PG8_SB(b, h) + boff + n * 2048 + k * 1024); } while (0)
#define PG8_MMA(ai, bj, At, Bt) do { if (cmask & (1 << ((ai) * 2 + (bj)))) PG8_MMA_(ai, bj, At, Bt); } while (0)
#define PG8_MMA_(ai, bj, At, Bt) do { __builtin_amdgcn_s_setprio(1); _Pragma("unroll") for (int m = 0; m < 4; ++m) _Pragma("unroll") for (int n = 0; n < 2; ++n) _Pragma("unroll") for (int k = 0; k < 2; ++k) \
        acc[ai][bj][m][n] = __builtin_amdgcn_mfma_f32_16x16x32_bf16(Bt[n][k], At[m][k], acc[ai][bj][m][n], 0, 0, 0); __builtin_amdgcn_s_setprio(0); } while (0)
#define PG8_WAIT_V(n) asm volatile("s_waitcnt vmcnt(" #n ")" ::: "memory")
#define PG8_WAIT_L(n) asm volatile("s_waitcnt lgkmcnt(" #n ")" ::: "memory")
#define PG8_BAR __builtin_amdgcn_s_barrier()
#define PG8_SCHED __builtin_amdgcn_sched_barrier(0)
    Unit cur, nxt; int ui = 0;
    if (!S.next(0, cur)) return;
    f32x4 acc[2][2][4][2];
#pragma unroll
    for (int a = 0; a < 2; ++a)
#pragma unroll
        for (int b = 0; b < 2; ++b)
#pragma unroll
            for (int m = 0; m < 4; ++m)
#pragma unroll
                for (int n = 0; n < 2; ++n) acc[a][b][m][n] = (f32x4){0.f, 0.f, 0.f, 0.f};
    bf16x8 At[4][2], B0[2][2], B1[2][2];
    const char* cA = (const char*)g.A + (Sched::GATHER ? (size_t)0 : (size_t)cur.pm * tstep); const char* cB = (const char*)g.Bt + S.boff(cur) + (size_t)cur.pn * tstep;
    S.a_ready(cur);
    if constexpr (Sched::GATHER) { PG8_GROWS(cur, gA_cur); }
    if constexpr (SP2) {
        PG8_STAGE(PG8_SB(0, 0), cB, voffB); PG8_STAGE(PG8_SB(0, 1), cB + hstep, voffB); PG8_STAGE_A(PG8_SA(0, 0), cA, 0, false); PG8_STAGE_A(PG8_SA(0, 1), cA, 1, false);
        if (wr == 1) PG8_BAR;
        PG8_WAIT_V(2); PG8_BAR;
        PG8_STAGE(PG8_SB(1, 0), cB + kstep, voffB); PG8_STAGE_A(PG8_SA(1, 0), cA + kstep, 0, false); PG8_STAGE(PG8_SB(1, 1), cB + hstep + kstep, voffB);
        PG8_WAIT_V(6); PG8_BAR;
    } else {
        PG8_STAGE(PG8_SB(0, 0), cB, voffB); PG8_STAGE(PG8_SA(0, 0), cA, voffA); PG8_STAGE(PG8_SB(0, 1), cB + hstep, voffB); PG8_STAGE(PG8_SA(0, 1), cA + hstep, voffA);
        if (wr == 1) PG8_BAR;
        PG8_WAIT_V(4); PG8_BAR;
        PG8_STAGE(PG8_SB(1, 0), cB + kstep, voffB); PG8_STAGE(PG8_SA(1, 0), cA + kstep, voffA); PG8_STAGE(PG8_SB(1, 1), cB + hstep + kstep, voffB);
        PG8_WAIT_V(6); PG8_BAR;
    }
    for (;;) {
        const int cmask = __builtin_amdgcn_readfirstlane(cur.mask);
        const bool has_next = S.next(ui + 1, nxt);
        const char* nA = has_next ? (const char*)g.A + (Sched::GATHER ? (size_t)0 : (size_t)nxt.pm * tstep) : cA; const char* nB = has_next ? (const char*)g.Bt + S.boff(nxt) + (size_t)nxt.pn * tstep : cB;
        if constexpr (Sched::GATHER) { if (has_next) { PG8_GROWS(nxt, gA_nxt); } }
        for (int t = 0; t < nt; t += 2) {
            const bool last = (t == nt - 2);
            const char* a1 = cA + (size_t)(t + 1) * kstep;
            const char* a2 = last ? nA : cA + (size_t)(t + 2) * kstep; const char* b2 = last ? nB : cB + (size_t)(t + 2) * kstep;
            const char* a3 = a2 + kstep; const char* b3 = b2 + kstep;
            if (last && has_next) S.a_ready(nxt);
            const bool usen = last && has_next;
            if constexpr (SP2) {
            PG8_LDB(B0, 0, 0); PG8_LDB(B1, 0, 1); PG8_SCHED; PG8_LDA(At, 0, 0); PG8_STAGE_A(PG8_SA(1, 1), a1, 1, false);
            PG8_WAIT_V(8); PG8_WAIT_L(0); PG8_BAR; PG8_MMA(0, 0, At, B0); PG8_MMA(0, 1, At, B1); PG8_BAR; PG8_SCHED;
            PG8_LDA(At, 0, 1); PG8_STAGE(PG8_SB(0, 0), b2, voffB); PG8_STAGE(PG8_SB(0, 1), b2 + hstep, voffB); PG8_STAGE_A(PG8_SA(0, 0), a2, 0, usen);
            PG8_WAIT_V(8); PG8_WAIT_L(0); PG8_BAR; PG8_MMA(1, 0, At, B0); PG8_MMA(1, 1, At, B1); PG8_BAR; PG8_SCHED;
            PG8_LDB(B0, 1, 0); PG8_LDB(B1, 1, 1); PG8_SCHED; PG8_LDA(At, 1, 0); PG8_STAGE_A(PG8_SA(0, 1), a2, 1, usen);
            PG8_WAIT_V(8); PG8_WAIT_L(0); PG8_BAR; PG8_MMA(0, 0, At, B0); PG8_MMA(0, 1, At, B1); PG8_BAR; PG8_SCHED;
            PG8_LDA(At, 1, 1); PG8_STAGE(PG8_SB(1, 0), b3, voffB); PG8_STAGE(PG8_SB(1, 1), b3 + hstep, voffB); PG8_STAGE_A(PG8_SA(1, 0), a3, 0, usen);
            PG8_WAIT_V(8); PG8_WAIT_L(0); PG8_BAR; PG8_MMA(1, 0, At, B0); PG8_MMA(1, 1, At, B1); PG8_BAR; PG8_SCHED;
            } else {
            PG8_LDB(B0, 0, 0); PG8_SCHED; PG8_LDA(At, 0, 0); PG8_STAGE(PG8_SA(1, 1), a1 + hstep, voffA);
            PG8_WAIT_L(8); PG8_BAR; PG8_WAIT_L(0); PG8_MMA(0, 0, At, B0); PG8_BAR; PG8_SCHED;
            PG8_LDB(B1, 0, 1); PG8_STAGE(PG8_SB(0, 0), b2, voffB);
            PG8_BAR; PG8_WAIT_L(0); PG8_MMA(0, 1, At, B1); PG8_BAR;
            PG8_LDA(At, 0, 1); PG8_STAGE(PG8_SA(0, 0), a2, voffA);
            PG8_BAR; PG8_WAIT_L(0); PG8_MMA(1, 0, At, B0); PG8_BAR; PG8_SCHED;
            PG8_STAGE(PG8_SB(0, 1), b2 + hstep, voffB);
            PG8_WAIT_V(6); PG8_BAR; PG8_MMA(1, 1, At, B1); PG8_BAR;
            PG8_LDB(B0, 1, 0); PG8_SCHED; PG8_LDA(At, 1, 0); PG8_STAGE(PG8_SA(0, 1), a2 + hstep, voffA);
            PG8_WAIT_L(8); PG8_BAR; PG8_WAIT_L(0); PG8_MMA(0, 0, At, B0); PG8_BAR; PG8_SCHED;
            PG8_LDB(B1, 1, 1); PG8_STAGE(PG8_SB(1, 0), b3, voffB);
            PG8_BAR; PG8_WAIT_L(0); PG8_MMA(0, 1, At, B1); PG8_BAR;
            PG8_LDA(At, 1, 1); PG8_STAGE(PG8_SA(1, 0), a3, voffA);
            PG8_BAR; PG8_WAIT_L(0); PG8_MMA(1, 0, At, B0); PG8_BAR; PG8_SCHED;
            PG8_STAGE(PG8_SB(1, 1), b3 + hstep, voffB);
            PG8_WAIT_V(6); PG8_BAR; PG8_MMA(1, 1, At, B1); PG8_BAR;
            }
        }
        if constexpr (ALIGN_EPI) { if (wr == 0) PG8_BAR; }
        if constexpr (!Epi::AFTER_DRAIN) { E(acc, cur, wr, wc, 0, 0); S.done(cur); }
        if (!has_next) break;
#pragma unroll
        for (int a = 0; a < 2; ++a)
#pragma unroll
            for (int b = 0; b < 2; ++b)
#pragma unroll
                for (int m = 0; m < 4; ++m)
#pragma unroll
                    for (int n = 0; n < 2; ++n) acc[a][b][m][n] = (f32x4){0.f, 0.f, 0.f, 0.f};
        cur = nxt; cA = nA; cB = nB; ++ui;
        if constexpr (Sched::GATHER) {
#pragma unroll
            for (int h_ = 0; h_ < 2; ++h_)
#pragma unroll
                for (int i_ = 0; i_ < 2; ++i_) gA_cur[h_][i_] = gA_nxt[h_][i_]; }
        if constexpr (ALIGN_EPI) { if (wr == 1) PG8_BAR; }
    }
    PG8_WAIT_V(0);
    if constexpr (!ALIGN_EPI) { if (wr == 0) PG8_BAR; }
    PG8_BAR;
    if constexpr (Epi::AFTER_DRAIN) { E.fused(acc, cur, wr, wc, fr, fq, lds, wid, lane); S.done(cur); }
#undef PG8_SA
#undef PG8_SB
#undef PG8_STAGE
#undef PG8_STAGE_A
#undef PG8_GROWS
#undef PG8_LDA
#undef PG8_LDB
#undef PG8_MMA
#undef PG8_MMA_
#undef PG8_WAIT_V
#undef PG8_WAIT_L
#undef PG8_BAR
#undef PG8_SCHED
}
}

constexpr int BATCH = 2, SEQ = 8192, T = BATCH * SEQ, D = 1024, NL = 2;
constexpr int NPAD = 3584, RW = 1408, INCOLS = 3346;
constexpr int NWAVES = 8, NTHR = 512;
constexpr float LOG2E = 1.4426950408889634f;
constexpr float NORM_EPS = 1e-6f;

#define GAS __attribute__((address_space(1)))
#define LAS __attribute__((address_space(3)))
typedef unsigned short bf16_t;
typedef short bf16x8 __attribute__((ext_vector_type(8)));
typedef short s16x4 __attribute__((ext_vector_type(4)));
typedef short v4i16_t __attribute__((ext_vector_type(4)));
typedef float f32x4 __attribute__((ext_vector_type(4)));
typedef float f32x16 __attribute__((ext_vector_type(16)));
typedef unsigned u32x4 __attribute__((ext_vector_type(4)));
typedef unsigned u32x2 __attribute__((ext_vector_type(2)));
typedef GAS unsigned gu32;

constexpr size_t MiB = 1u << 20, KiB = 1u << 10;
constexpr size_t WS_CTL = 0, CTL_ZERO_BYTES = 64 * KiB;
constexpr size_t WS_COS = 1 * MiB, WS_SIN = 3 * MiB;
constexpr size_t WS_MOD = 5 * MiB;
constexpr size_t WS_PHIB = WS_MOD + 128 * KiB;
constexpr size_t WS_KMEAN = WS_MOD + 192 * KiB;
constexpr size_t WS_KCMP = WS_MOD + 256 * KiB;
constexpr size_t WS_VCMP = WS_KCMP + 256 * KiB;
constexpr size_t WS_BONUS = 6 * MiB;
constexpr size_t WS_GATE = 7 * MiB;
constexpr size_t WS_ROUTE = 9 * MiB;
constexpr size_t WS_ROWINFO = 10 * MiB;
constexpr size_t ROWINFO_LSTRIDE = 512 * KiB;
constexpr int MAXROWS = 36864;
constexpr size_t WS_RES = 78 * MiB;
constexpr size_t WS_ELIST = 9 * MiB;
constexpr size_t WS_EWW = 11 * MiB;
constexpr int TE_OFF = 272, TE_CNT = 304;
constexpr size_t WS_WIN = 12 * MiB;
constexpr size_t WS_WOUT = 19 * MiB;
constexpr size_t WS_WUP = 21 * MiB;
constexpr size_t WS_WDN = 37 * MiB;
constexpr size_t WS_PHIW = 45 * MiB;
constexpr size_t WS_GUPT = 45 * MiB + 512 * KiB;
constexpr size_t WS_WUPT = 45 * MiB + 640 * KiB;
constexpr size_t WS_AUPT = 45 * MiB + 704 * KiB;
constexpr size_t WS_LORA = 46 * MiB;
constexpr size_t WS_HM = 46 * MiB;
constexpr size_t WS_NQ = 78 * MiB;
constexpr size_t WS_KV6 = 90 * MiB;
constexpr size_t KV6_STRIDE = (size_t)BATCH * 2 * SEQ * 64;
constexpr size_t WS_MQKV = 114 * MiB;
constexpr size_t MQKV_STRIDE = (size_t)BATCH * 4 * SEQ * 64;
constexpr size_t WS_RFEAT = 138 * MiB;
constexpr size_t WS_SORTA = 78 * MiB;
constexpr size_t WS_HID = 150 * MiB;
constexpr size_t WS_PT = 182 * MiB;
constexpr size_t WS_ZS = 194 * MiB;
constexpr size_t WS_YT = 206 * MiB;
constexpr size_t WS_Y0 = 218 * MiB;
constexpr size_t WS_YS = 182 * MiB;
constexpr size_t WS_SS = 230 * MiB;
constexpr size_t WS_END = 256 * MiB;
constexpr int CW_Q = 64;
constexpr int CW_CNT = 1024;
constexpr int CW_BAR = 4096;
constexpr int CW_DBG = 3072;
#ifndef DBG_MODE
#define DBG_MODE 0
#endif
#ifndef EXTRA_BAR
#define EXTRA_BAR 0
#endif
#ifndef REPEAT_PH
#define REPEAT_PH -1
#endif
#ifndef DBG_TPH0
#define DBG_TPH0 0
#endif
#ifndef DBG_TPH1
#define DBG_TPH1 1
#endif
#ifndef DBG_QOFF
#define DBG_QOFF 0.0f
#endif
#ifndef DBG_TPH2
#define DBG_TPH2 0
#endif
#ifndef DBG_TPH3
#define DBG_TPH3 1
#endif
#ifndef DBG_SUB
#define DBG_SUB 4
#endif
#ifndef DBG_P
#define DBG_P 4
#endif
#ifndef DBG_CNT
#define DBG_CNT 1
#endif

#define RLX_AGENT __ATOMIC_RELAXED, __HIP_MEMORY_SCOPE_AGENT
#define LDS_WAIT() asm volatile("s_waitcnt lgkmcnt(0)" ::: "memory")
#define VM_WAIT() asm volatile("s_waitcnt vmcnt(0)" ::: "memory")
__device__ __forceinline__ float bf2f(bf16_t h) { return __uint_as_float(((unsigned)h) << 16); }
typedef float f32x2_t __attribute__((ext_vector_type(2)));
typedef __bf16 bf16x2_t __attribute__((ext_vector_type(2)));
__device__ __forceinline__ unsigned pk2(float lo, float hi) { const f32x2_t v = {lo, hi}; return __builtin_bit_cast(unsigned, __builtin_convertvector(v, bf16x2_t)); }
__device__ __forceinline__ bf16_t f2bf(float f) { return (bf16_t)(pk2(f, 0.f) & 0xffffu); }
__device__ __forceinline__ float shx(float v, int mask, int lane) { return __uint_as_float(__builtin_amdgcn_ds_bpermute((lane ^ mask) << 2, __float_as_uint(v))); }
__device__ __forceinline__ int shxi(int v, int mask, int lane) { return __builtin_amdgcn_ds_bpermute((lane ^ mask) << 2, v); }
template <int CTRL> __device__ __forceinline__ float dpp_mov(float v) { return __uint_as_float(__builtin_amdgcn_update_dpp(0u, __float_as_uint(v), CTRL, 0xf, 0xf, true)); }
__device__ __forceinline__ float half_sum32(float v) { const unsigned u = __float_as_uint(v); auto r = __builtin_amdgcn_permlane32_swap(u, u, false, false); return __uint_as_float(r[0]) + __uint_as_float(r[1]); }
__device__ __forceinline__ float row_sum16(float v) { const unsigned u = __float_as_uint(v); auto r = __builtin_amdgcn_permlane16_swap(u, u, false, false); return __uint_as_float(r[0]) + __uint_as_float(r[1]); }
__device__ __forceinline__ float wave_sum(float v, int lane) {
    (void)lane;
    v += dpp_mov<0xB1>(v); v += dpp_mov<0x4E>(v); v += dpp_mov<0x141>(v); v += dpp_mov<0x140>(v);
    return half_sum32(row_sum16(v));
}
__device__ __forceinline__ float tanh_fast(float x) { const float xc = fminf(fmaxf(x, -15.f), 15.f); return 1.f - 2.f * __builtin_amdgcn_rcpf(__builtin_amdgcn_exp2f(xc * (2.f * LOG2E)) + 1.f); }
__device__ __forceinline__ float sigm(float x) { return __builtin_amdgcn_rcpf(1.f + __expf(-x)); }
__device__ __forceinline__ int ld_ctl(const int* p) { return __hip_atomic_load(p, RLX_AGENT); }
__device__ __forceinline__ float ld_ctlf(const float* p) { return __uint_as_float(__hip_atomic_load((const unsigned*)p, RLX_AGENT)); }
#define MFMA16(a, b, c) __builtin_amdgcn_mfma_f32_16x16x32_bf16(a, b, c, 0, 0, 0)
#define MFMA32(a, b, c) __builtin_amdgcn_mfma_f32_32x32x16_bf16(a, b, c, 0, 0, 0)

#define XB_TMO      128
#define XB_XCNT(j)  (256  + 64 * (j))
#define XB_XSUB(j)  (1280 + 64 * (j))
#define XB_XGEN(j)  (2304 + 64 * (j))
#define XB_TOP      3328
#define XB_TOPGEN   3392
#define XCD_BAR_WORDS 3456
#define XB_SPIN_CAP (1u << 22)
__device__ __forceinline__ unsigned xb_ld(unsigned* p)              { return __hip_atomic_load(p, __ATOMIC_RELAXED, __HIP_MEMORY_SCOPE_AGENT); }
__device__ __forceinline__ unsigned xb_add(unsigned* p, unsigned v) { return __hip_atomic_fetch_add(p, v, __ATOMIC_RELAXED, __HIP_MEMORY_SCOPE_AGENT); }
__device__ __forceinline__ unsigned xb_xcc_id() { return (unsigned)__builtin_amdgcn_s_getreg((3 << 11) | 20) & 0xFu; }
#define XB_SPIN(cond, bar) do { unsigned _sp = 0; while (cond) { __builtin_amdgcn_s_sleep(1); \
    if ((++_sp & 255u) == 0u) { if (xb_ld(&(bar)[XB_TMO])) break; if (_sp > XB_SPIN_CAP) { atomicAdd(&(bar)[XB_TMO], 1u); break; } } } } while (0)
struct XcdBarrier { unsigned* bar; unsigned x; volatile LAS unsigned* st; };
__device__ __forceinline__ XcdBarrier xcd_barrier_post(unsigned* bar, volatile LAS unsigned* st) {
    XcdBarrier b; b.bar = bar; b.x = xb_xcc_id(); b.st = st;
    if (threadIdx.x == 0) (void)xb_add(&bar[XB_XCNT(b.x)], 1u);
    return b;
}
__device__ __forceinline__ void xcd_barrier_complete(unsigned* bar, unsigned x, unsigned& nloc, unsigned& nx) {
    const unsigned G = gridDim.x * gridDim.y * gridDim.z;
    unsigned sum, cnt, mine, sp = 0u;
    for (;;) {
        sum = 0u; cnt = 0u; mine = 0u;
#pragma unroll
        for (unsigned j = 0; j < 16; ++j) { const unsigned c = xb_ld(&bar[XB_XCNT(j)]); sum += c; cnt += (c > 0u) ? 1u : 0u; mine = (j == x) ? c : mine; }
        if (sum == G) break;
        __builtin_amdgcn_s_sleep(1);
        if ((++sp & 255u) == 0u) { if (xb_ld(&bar[XB_TMO])) break; if (sp > XB_SPIN_CAP) { atomicAdd(&bar[XB_TMO], 1u); break; } }
    }
    nloc = mine > 0u ? mine : 1u; nx = cnt > 0u ? cnt : 1u;
}
__device__ __forceinline__ void xcd_barrier(const XcdBarrier& b, const int tid) {
    asm volatile("s_waitcnt vmcnt(0)" ::: "memory");
    __syncthreads();
    if (tid == 0) {
        unsigned* bar = b.bar;
        __builtin_amdgcn_s_waitcnt(0);
        unsigned nloc = b.st[0], nx = b.st[1];
        if (nloc == 0u) { xcd_barrier_complete(bar, b.x, nloc, nx); b.st[0] = nloc; b.st[1] = nx; }
        const unsigned old = xb_add(&bar[XB_XSUB(b.x)], 1u);
        const unsigned gen = old / nloc;
        if (old + 1u == (gen + 1u) * nloc) {
            __builtin_amdgcn_fence(__ATOMIC_RELEASE, "agent");
            asm volatile("s_waitcnt vmcnt(0)" ::: "memory");
            const unsigned og = xb_add(&bar[XB_TOP], 1u);
            const unsigned tg = og / nx;
            if (og + 1u == (tg + 1u) * nx) xb_add(&bar[XB_TOPGEN], 1u);
            else XB_SPIN(xb_ld(&bar[XB_TOPGEN]) == tg, bar);
            __builtin_amdgcn_fence(__ATOMIC_ACQUIRE, "agent");
            xb_add(&bar[XB_XGEN(b.x)], 1u);
            asm volatile("s_waitcnt vmcnt(0)" ::: "memory");
        } else {
            XB_SPIN(xb_ld(&bar[XB_XGEN(b.x)]) == gen, bar);
            __builtin_amdgcn_fence(__ATOMIC_ACQUIRE, "agent");
            asm volatile("s_waitcnt vmcnt(0)" ::: "memory");
        }
    }
    __syncthreads();
}

constexpr int RING_BYTES = 131072, MISC_OFF = RING_BYTES + 320, LDS_BYTES = 147456;
struct Frame {
    LAS unsigned char* lds;
    volatile LAS unsigned* MISC;
    unsigned* ctl;
    int tid, lane, wave, G, bid;
    unsigned char* ws;
    float* out;
};
constexpr int IN_OFF = RING_BYTES + 1024;
__device__ __forceinline__ const float* inptr(const LAS unsigned char* lds, int k) {
    int z = 0; asm volatile("" : "+v"(z));
    const LAS unsigned* p = (const LAS unsigned*)(lds + IN_OFF + z) + 2 * k;
    const unsigned lo = __builtin_amdgcn_readfirstlane(p[0]), hi = __builtin_amdgcn_readfirstlane(p[1]);
    return (const float*)(const GAS float*)(((unsigned long long)hi << 32) | lo); }
#define INF(F, k) inptr((F).lds, k)
#define LAUNDER(F) do { GAS unsigned char* w_ = (GAS unsigned char*)(F).ws; GAS float* o_ = (GAS float*)(F).out; int g_ = (F).G, b_ = (F).bid, wv_ = (F).wave, z_ = 0; asm volatile("" : "+s"(w_), "+s"(o_), "+s"(g_), "+s"(b_), "+s"(wv_), "+s"(z_)); \
    int l_ = (int)__builtin_amdgcn_mbcnt_hi(~0u, __builtin_amdgcn_mbcnt_lo(~0u, (unsigned)z_)); asm volatile("" : "+v"(l_)); \
    (F).ws = (unsigned char*)w_; (F).out = (float*)o_; (F).ctl = (unsigned*)(GAS unsigned*)w_; (F).G = g_; (F).bid = b_; (F).wave = wv_; (F).lane = l_; (F).tid = wv_ * 64 + l_; } while (0)
enum { I_X = 0, I_C, I_POS, I_WMOD, I_BMOD, I_NMIX, I_NFFN, I_WIN, I_PHIW1, I_PHIW2, I_PHIPOS, I_MU, I_WUP, I_W0, I_AUP, I_A0, I_GUP, I_KK, I_KA, I_RK, I_LNW, I_LNB,
       I_NNSA, I_NMOBA, I_WOUT, I_WROUTER, I_RBIAS, I_MGATE, I_MUP, I_MDOWN, I_NFINAL };

__device__ const float g_invf[32] = {1.000000000e+00f, 7.498942018e-01f, 5.623413324e-01f, 4.216965139e-01f, 3.162277639e-01f, 2.371373773e-01f, 1.778279394e-01f, 1.333521456e-01f,
    1.000000015e-01f, 7.498942316e-02f, 5.623413250e-02f, 4.216964915e-02f, 3.162277490e-02f, 2.371373773e-02f, 1.778279431e-02f, 1.333521400e-02f, 9.999999776e-03f, 7.498942316e-03f,
    5.623413250e-03f, 4.216964822e-03f, 3.162277630e-03f, 2.371373819e-03f, 1.778279431e-03f, 1.333521446e-03f, 1.000000047e-03f, 7.498941850e-04f, 5.623413017e-04f, 4.216965172e-04f,
    3.162277571e-04f, 2.371373703e-04f, 1.778279402e-04f, 1.333521504e-04f};
__device__ __forceinline__ void phase_pro(Frame& F) {
    const int* pos = (const int*)INF(F, I_POS);
    float* cosT = (float*)(F.ws + WS_COS); float* sinT = (float*)(F.ws + WS_SIN);
    for (int idx = F.bid * NTHR + F.tid; idx < T * 32; idx += F.G * NTHR) {
        const int row = idx >> 5, i = idx & 31;
        const float ang = (float)pos[row] * g_invf[i];
        float sv, cv; sincosf(ang, &sv, &cv);
        cosT[idx] = cv; sinT[idx] = sv;
    }
    LAS float* red = (LAS float*)F.lds;
    for (int chunk = F.bid; chunk < NL * 96; chunk += F.G) {
        const int l = chunk / 96, j0 = (chunk % 96) * 64;
        const float* W = INF(F, I_WMOD) + (size_t)l * D * 6144 + j0 + F.lane;
        const float* c = INF(F, I_C);
        float a0 = 0.f, a1 = 0.f;
        const int k0 = F.wave * 128;
#pragma unroll 32
        for (int k = 0; k < 128; ++k) {
            const float w = W[(size_t)(k0 + k) * 6144];
            const float c0 = c[k0 + k], c1 = c[D + k0 + k];
            a0 += w * (c0 * sigm(c0)); a1 += w * (c1 * sigm(c1));
        }
        red[(F.wave * 2 + 0) * 64 + F.lane] = a0; red[(F.wave * 2 + 1) * 64 + F.lane] = a1;
        __syncthreads();
        if (F.wave < 2) {
            float s = INF(F, I_BMOD)[l * 6144 + j0 + F.lane];
#pragma unroll
            for (int w = 0; w < 8; ++w) s += red[(w * 2 + F.wave) * 64 + F.lane];
            ((float*)(F.ws + WS_MOD))[((size_t)l * BATCH + F.wave) * 6144 + j0 + F.lane] = s;
        }
        __syncthreads();
    }
}

__device__ __forceinline__ void transpose_item(int ldw, int K, bf16_t* WT, int n0, int k0, LAS float* scr, int lane, const float* src) {
    const int n4 = lane & 7, kr = lane >> 3;
#pragma unroll
    for (int i = 0; i < 8; ++i) { const int kk = 8 * i + kr; f32x4 v = (f32x4){0.f, 0.f, 0.f, 0.f};
        if (src) { const float* p = src + (size_t)(k0 + kk) * ldw; v.x = p[0]; v.y = p[1]; v.z = p[2]; v.w = p[3]; }
        scr[kk * 33 + 4 * n4] = v.x; scr[kk * 33 + 4 * n4 + 1] = v.y; scr[kk * 33 + 4 * n4 + 2] = v.z; scr[kk * 33 + 4 * n4 + 3] = v.w; }
    LDS_WAIT(); asm volatile("" ::: "memory");
    const int c = lane & 7;
#pragma unroll
    for (int j = 0; j < 4; ++j) { const int n = (lane >> 3) + 8 * j; const LAS float* sp = scr + (8 * c) * 33 + n;
        u32x4 o; o.x = pk2(sp[0 * 33], sp[1 * 33]); o.y = pk2(sp[2 * 33], sp[3 * 33]); o.z = pk2(sp[4 * 33], sp[5 * 33]); o.w = pk2(sp[6 * 33], sp[7 * 33]);
        *(u32x4*)(WT + (size_t)(n0 + n) * K + k0 + 8 * c) = o; }
    LDS_WAIT(); asm volatile("" ::: "memory");
}
__device__ __forceinline__ const float* cm_in(const float* W, int pos) {
        const int G = pos >> 6, p = pos & 63, w = p >> 5, n = (p >> 4) & 1, q = p & 15, d = 16 * w + q + 32 * n;
        int sc;
        if (G < 6) sc = G * 64 + d; else if (G < 18) sc = 384 + (G - 6) * 64 + d; else if (G < 30) sc = 1170 + (G - 18) * 64 + d;
        else if (G < 52) sc = 1938 + (G - 30) * 64 + d; else if (G == 52 && d < 18) sc = 1152 + d; else return nullptr;
        return W + sc; }
__device__ __forceinline__ const float* cm_up(const float* Wg, const float* Wu, int pos) { const int Wd = pos >> 5, n = (pos >> 4) & 1, q = pos & 15, f = 16 * Wd + q; return (n ? Wu : Wg) + f; }

__device__ __forceinline__ void norm_rows(Frame& F, int layer, bool final_) {
    const float* xin = INF(F, I_X);
    const bf16_t* ys = (const bf16_t*)(F.ws + WS_YS);
    const float* mod = (const float*)(F.ws + WS_MOD);
    bf16_t* H = (bf16_t*)(F.ws + WS_HM);
    const int gw = F.bid * NWAVES + F.wave, NGW = F.G * NWAVES;
    for (int m = gw; m < T; m += NGW) {
        const int b = m >> 13;
        f32x4 v[4]; float ss = 0.f;
        if (layer == 0 && !final_) {
#pragma unroll
            for (int j = 0; j < 4; ++j) v[j] = *(const f32x4*)(xin + (size_t)m * D + 4 * F.lane + 256 * j);
        } else {
            const int pl = final_ ? NL - 1 : layer - 1;
            const float* g2 = mod + ((size_t)pl * BATCH + b) * 6144 + 5120;
#pragma unroll
            for (int j = 0; j < 4; ++j) {
                const int col = 4 * F.lane + 256 * j;
                const u32x2 t2 = *(const u32x2*)((const bf16_t*)(F.ws + WS_RES) + (size_t)m * D + col);
                f32x4 x = (f32x4){__uint_as_float(t2.x << 16), __uint_as_float(t2.x & 0xffff0000u), __uint_as_float(t2.y << 16), __uint_as_float(t2.y & 0xffff0000u)};
                const u32x2 a = *(const u32x2*)(ys + (size_t)m * D + col), c = *(const u32x2*)(ys + (size_t)(T + m) * D + col);
                const f32x4 g = *(const f32x4*)(g2 + col);
                x.x += g.x * (__uint_as_float(a.x << 16) + __uint_as_float(c.x << 16));
                x.y += g.y * (__uint_as_float(a.x & 0xffff0000u) + __uint_as_float(c.x & 0xffff0000u));
                x.z += g.z * (__uint_as_float(a.y << 16) + __uint_as_float(c.y << 16));
                x.w += g.w * (__uint_as_float(a.y & 0xffff0000u) + __uint_as_float(c.y & 0xffff0000u));
                if (!final_) { u32x2 o; o.x = pk2(x.x, x.y); o.y = pk2(x.z, x.w); *(u32x2*)((bf16_t*)F.out + (size_t)m * D + col) = o;
                    x = (f32x4){__uint_as_float(o.x << 16), __uint_as_float(o.x & 0xffff0000u), __uint_as_float(o.y << 16), __uint_as_float(o.y & 0xffff0000u)}; }
                v[j] = x;
            }
        }
#pragma unroll
        for (int j = 0; j < 4; ++j) ss += (v[j].x * v[j].x + v[j].y * v[j].y) + (v[j].z * v[j].z + v[j].w * v[j].w);
        const float rstd = rsqrtf(wave_sum(ss, F.lane) * (1.f / D) + NORM_EPS);
#if DBG_MODE == 1
        if (final_) { float bad = 0.f;
#pragma unroll
            for (int j = 0; j < 4; ++j) { bad += (fabsf(v[j].x) <= 3e38f) ? 0.f : 1.f; bad += (fabsf(v[j].y) <= 3e38f) ? 0.f : 1.f; bad += (fabsf(v[j].z) <= 3e38f) ? 0.f : 1.f; bad += (fabsf(v[j].w) <= 3e38f) ? 0.f : 1.f; }
            bad = wave_sum(bad, F.lane); if (F.lane == 0 && bad > 0.f) atomicAdd(F.ctl + CW_DBG, (unsigned)bad); }
#endif
        if (final_) {
            const float* gn = INF(F, I_NFINAL);
#pragma unroll
            for (int j = 0; j < 4; ++j) { const int col = 4 * F.lane + 256 * j; const f32x4 g = *(const f32x4*)(gn + col);
                f32x4 o; o.x = v[j].x * rstd * g.x; o.y = v[j].y * rstd * g.y; o.z = v[j].z * rstd * g.z; o.w = v[j].w * rstd * g.w;
                *(f32x4*)(F.out + (size_t)m * D + col) = o; }
        } else {
            const float* gn = INF(F, I_NMIX) + layer * D;
            const float* sh = mod + ((size_t)layer * BATCH + b) * 6144; const float* sc = sh + 1024;
#pragma unroll
            for (int j = 0; j < 4; ++j) { const int col = 4 * F.lane + 256 * j;
                const f32x4 g = *(const f32x4*)(gn + col), s1 = *(const f32x4*)(sc + col), s0 = *(const f32x4*)(sh + col);
                u32x2 o; o.x = pk2(v[j].x * rstd * g.x * (1.f + s1.x) + s0.x, v[j].y * rstd * g.y * (1.f + s1.y) + s0.y);
                o.y = pk2(v[j].z * rstd * g.z * (1.f + s1.z) + s0.z, v[j].w * rstd * g.w * (1.f + s1.w) + s0.w);
                *(u32x2*)(H + (size_t)m * D + col) = o; }
        }
    }
}
__device__ __forceinline__ void phase_a(Frame& F, int layer, bool do_norm, bool do_conv) {
    if (do_norm) { norm_rows(F, layer, false); LAUNDER(F); }
    if (!do_conv) return;
    LAS float* scr = (LAS float*)(F.lds + F.wave * 16384);
    const int gw = F.bid * NWAVES + F.wave, NGW = F.G * NWAVES;
    constexpr int I_IN = 16 * 112, I_OUT = 16 * 32, I_UPI = 16 * 16 * 16, I_DN = 16 * 4 * 32, I_PHI = 2 * 32 * 2, I_GU = 2 * 12, I_LR = 2 * 12;
    constexpr int NIT = I_IN + I_OUT + I_UPI + I_DN + I_PHI + I_GU + I_LR;
    for (int it = gw; it < NIT; it += NGW) {
        int r = it;
        const int l31 = 4 * (F.lane & 7);
        if (r < I_IN) { const int kb = r / 112, nb = r % 112;
            transpose_item(INCOLS, D, (bf16_t*)(F.ws + WS_WIN), nb * 32, kb * 64, scr, F.lane, cm_in(INF(F, I_WIN) + (size_t)layer * D * INCOLS, nb * 32 + l31)); continue; } r -= I_IN;
        if (r < I_OUT) { const int kb = r / 32, nb = r % 32;
            transpose_item(D, D, (bf16_t*)(F.ws + WS_WOUT), nb * 32, kb * 64, scr, F.lane, INF(F, I_WOUT) + (size_t)layer * D * D + nb * 32 + l31); continue; } r -= I_OUT;
        if (r < I_UPI) { const int e = r / 256, q = r % 256, kb = q / 16, nb = q % 16;
            transpose_item(256, D, (bf16_t*)(F.ws + WS_WUP) + (size_t)e * 512 * D, nb * 32, kb * 64, scr, F.lane,
                           cm_up(INF(F, I_MGATE) + ((size_t)layer * 16 + e) * D * 256, INF(F, I_MUP) + ((size_t)layer * 16 + e) * D * 256, nb * 32 + l31)); continue; } r -= I_UPI;
        if (r < I_DN) { const int e = r / 128, q = r % 128, kb = q / 32, nb = q % 32;
            transpose_item(D, 256, (bf16_t*)(F.ws + WS_WDN) + (size_t)e * D * 256, nb * 32, kb * 64, scr, F.lane, INF(F, I_MDOWN) + ((size_t)layer * 16 + e) * 256 * D + nb * 32 + l31); continue; } r -= I_DN;
        if (r < I_PHI) { const int kv = r / 64, q = r % 64, kb = q / 2, nb = q % 2;
            transpose_item(64, 2048, (bf16_t*)(F.ws + WS_PHIW) + (size_t)kv * 64 * 2048, nb * 32, kb * 64, scr, F.lane, INF(F, I_PHIW1) + ((size_t)layer * 2 + kv) * 2048 * 64 + nb * 32 + l31); continue; } r -= I_PHI;
        if (r < I_GU) { const int kb = r / 12, nb = r % 12;
            transpose_item(384, 128, (bf16_t*)(F.ws + WS_GUPT), nb * 32, kb * 64, scr, F.lane, INF(F, I_GUP) + (size_t)layer * 128 * 384 + nb * 32 + l31); continue; } r -= I_GU;
        { const int which = r / 12, nb = r % 12;
            transpose_item(384, 64, (bf16_t*)(F.ws + (which ? WS_AUPT : WS_WUPT)), nb * 32, 0, scr, F.lane, INF(F, which ? I_AUP : I_WUP) + (size_t)layer * 64 * 384 + nb * 32 + l31); }
    }
    LAUNDER(F);
    if (F.bid == F.G - 1) {
        __syncthreads();
        LAS float* part = (LAS float*)F.lds;
#pragma unroll 1
        for (int kv = 0; kv < 2; ++kv) {
            const float* w1 = INF(F, I_PHIW1) + ((size_t)layer * 2 + kv) * 2048 * 64 + (size_t)F.wave * 256 * 64; const float* pp = INF(F, I_PHIPOS) + ((size_t)layer * 2 + kv) * 2048 + F.wave * 256;
            float a[4] = {0.f, 0.f, 0.f, 0.f};
#pragma unroll 1
            for (int k = 0; k < 256; k += 16) {
                float wv[16];
#pragma unroll
                for (int u = 0; u < 16; ++u) wv[u] = w1[(size_t)(k + u) * 64 + F.lane];
#pragma unroll
                for (int u = 0; u < 16; ++u) a[u & 3] += pp[k + u] * wv[u];
            }
            part[(F.wave * 2 + kv) * 64 + F.lane] = (a[0] + a[1]) + (a[2] + a[3]);
        }
        __syncthreads();
        if (F.wave < 2) { float sacc = 0.f;
#pragma unroll
            for (int w = 0; w < 8; ++w) sacc += part[(w * 2 + F.wave) * 64 + F.lane];
            ((float*)(F.ws + WS_PHIB))[(layer * 2 + F.wave) * 64 + F.lane] = sacc; }
    }
}

struct EpiInProj {
    static constexpr bool PERM = false, AFTER_DRAIN = false;
    bf16_t* nq; bf16_t* kv6; bf16_t* mqkv; bf16_t* rfeat; float* gate; const float* cosT; const float* sinT;
    __device__ __forceinline__ void operator()(const f32x4 (&acc)[2][2][4][2], const pg8::Unit& u, int wr, int wc, int fr_, int fq_) const {
        int z_ = 0; asm volatile("" : "+s"(z_)); int l_ = (int)__builtin_amdgcn_mbcnt_hi(~0u, __builtin_amdgcn_mbcnt_lo(~0u, (unsigned)z_)); asm volatile("" : "+v"(l_)); const int fr = l_ & 15, fq = l_ >> 4; (void)fr_; (void)fq_;
#pragma unroll
        for (int bj = 0; bj < 2; ++bj) {
            const int G = 4 * u.pn + 2 * bj + (wc >> 1), w = wc & 1;
            if (G >= 53) continue;
            const int qm = u.mask >> bj;
            const int d0 = 16 * w + 4 * fq;
            const bool rope = (G < 6) || (G == 10) || (G == 11) || (G == 14) || (G == 15) || (G >= 18 && G < 26);
            const float scl = (G < 6 || (G >= 18 && G < 22)) ? 0.125f * LOG2E : 1.0f;
#pragma unroll
            for (int ai = 0; ai < 2; ++ai) {
                if (!((qm >> (2 * ai)) & 1)) continue;
#pragma unroll
                for (int m = 0; m < 4; ++m) {
                    const int row = 256 * u.pm + 128 * ai + 64 * wr + 16 * m + fr, b = row >> 13, t = row & (SEQ - 1);
                    f32x4 x1 = acc[ai][bj][m][0], x2 = acc[ai][bj][m][1];
                    if (rope) {
                        const f32x4 c = *(const f32x4*)(cosT + (size_t)row * 32 + d0), s = *(const f32x4*)(sinT + (size_t)row * 32 + d0);
                        const f32x4 y1 = (x1 * c - x2 * s) * scl, y2 = (x2 * c + x1 * s) * scl; x1 = y1; x2 = y2;
                    }
                    if (G == 52) {
                        float* gp = gate + (size_t)row * 32;
                        *(f32x4*)(gp + d0) = x1;
                        continue;
                    }
                    bf16_t* dst;
                    if (G < 6) dst = nq + ((size_t)(b * 6 + G) * SEQ + t) * 64;
                    else if (G < 18) dst = kv6 + (size_t)((G - 6) >> 1) * KV6_STRIDE + ((size_t)(b * 2 + ((G - 6) & 1)) * SEQ + t) * 64;
                    else if (G < 30) dst = mqkv + (size_t)((G - 18) >> 2) * MQKV_STRIDE + ((size_t)(b * 4 + ((G - 18) & 3)) * SEQ + t) * 64;
                    else dst = rfeat + (size_t)row * RW + (G - 30) * 64;
                    auto sx = __builtin_amdgcn_permlane16_swap(pk2(x1.x, x1.y), pk2(x2.x, x2.y), false, false);
                    auto sy = __builtin_amdgcn_permlane16_swap(pk2(x1.z, x1.w), pk2(x2.z, x2.w), false, false);
                    u32x4 o; o.x = sx[0]; o.y = sy[0]; o.z = sx[1]; o.w = sy[1];
                    *(u32x4*)(dst + ((fq & 1) ? d0 - 4 + 32 : d0)) = o;
                }
            }
        }
    }
};
struct EpiNull {
    static constexpr bool PERM = false, AFTER_DRAIN = false;
    float* sink;
    __device__ __forceinline__ void operator()(const f32x4 (&acc)[2][2][4][2], const pg8::Unit& u, int wr, int wc, int fr_, int fq_) const {
        f32x4 s = (f32x4){0.f, 0.f, 0.f, 0.f};
#pragma unroll
        for (int ai = 0; ai < 2; ++ai)
#pragma unroll
            for (int bj = 0; bj < 2; ++bj)
#pragma unroll
                for (int m = 0; m < 4; ++m)
#pragma unroll
                    for (int n = 0; n < 2; ++n) s += acc[ai][bj][m][n];
        if (s.x + s.y + s.z + s.w == 123456.789f) sink[0] = s.x;
    }
};
template <bool F32IN>
struct EpiOutProjT {
    static constexpr bool PERM = false, AFTER_DRAIN = false;
    const float* xold_f; const bf16_t* xold_b; bf16_t* xnew; const float* g1;
    __device__ __forceinline__ void operator()(const f32x4 (&acc)[2][2][4][2], const pg8::Unit& u, int wr, int wc, int fr_, int fq_) const {
        int z_ = 0; asm volatile("" : "+s"(z_)); int l_ = (int)__builtin_amdgcn_mbcnt_hi(~0u, __builtin_amdgcn_mbcnt_lo(~0u, (unsigned)z_)); asm volatile("" : "+v"(l_)); const int fr = l_ & 15, fq = l_ >> 4; (void)fr_; (void)fq_;
#pragma unroll
        for (int ai = 0; ai < 2; ++ai)
#pragma unroll
            for (int m = 0; m < 4; ++m) {
                const int row = 256 * u.pm + 128 * ai + 64 * wr + 16 * m + fr, b = row >> 13;
#pragma unroll
                for (int bj = 0; bj < 2; ++bj)
#pragma unroll
                    for (int n = 0; n < 2; ++n) {
                        if (!((u.mask >> (2 * ai + bj)) & 1)) continue;
                        const int col = 256 * u.pn + 128 * bj + 32 * wc + 16 * n + 4 * fq;
                        const f32x4 g = *(const f32x4*)(g1 + (size_t)b * 6144 + col);
                        f32x4 xo;
                        if constexpr (F32IN) xo = *(const f32x4*)(xold_f + (size_t)row * D + col);
                        else { const u32x2 t2 = *(const u32x2*)(xold_b + (size_t)row * D + col); xo = (f32x4){__uint_as_float(t2.x << 16), __uint_as_float(t2.x & 0xffff0000u), __uint_as_float(t2.y << 16), __uint_as_float(t2.y & 0xffff0000u)}; }
                        const f32x4 xn = xo + g * acc[ai][bj][m][n];
                        u32x2 o; o.x = pk2(xn.x, xn.y); o.y = pk2(xn.z, xn.w);
                        *(u32x2*)(xnew + (size_t)row * D + col) = o;
                    }
            }
    }
};
struct EpiMoeUp {
    static constexpr bool PERM = false, AFTER_DRAIN = false;
    bf16_t* hid;
    __device__ __forceinline__ void operator()(const f32x4 (&acc)[2][2][4][2], const pg8::Unit& u, int wr, int wc, int fr_, int fq_) const {
        int z_ = 0; asm volatile("" : "+s"(z_)); int l_ = (int)__builtin_amdgcn_mbcnt_hi(~0u, __builtin_amdgcn_mbcnt_lo(~0u, (unsigned)z_)); asm volatile("" : "+v"(l_)); const int fr = l_ & 15, fq = l_ >> 4; (void)fr_; (void)fq_;
#pragma unroll
        for (int ai = 0; ai < 2; ++ai)
#pragma unroll
            for (int m = 0; m < 4; ++m) {
                const int row = 256 * u.pm + 128 * ai + 64 * wr + 16 * m + fr;
                u32x2 ob[2];
#pragma unroll
                for (int bj = 0; bj < 2; ++bj) { const f32x4 g = acc[ai][bj][m][0], up = acc[ai][bj][m][1];
                    ob[bj].x = pk2(g.x * sigm(g.x) * up.x, g.y * sigm(g.y) * up.y); ob[bj].y = pk2(g.z * sigm(g.z) * up.z, g.w * sigm(g.w) * up.w); }
                if (((u.mask >> (2 * ai)) & 3) == 3) {
                    auto sx = __builtin_amdgcn_permlane16_swap(ob[0].x, ob[1].x, false, false);
                    auto sy = __builtin_amdgcn_permlane16_swap(ob[0].y, ob[1].y, false, false);
                    u32x4 o; o.x = sx[0]; o.y = sy[0]; o.z = sx[1]; o.w = sy[1];
                    const int f0 = (fq & 1) ? 16 * (8 * u.pn + 4 + wc) + 4 * (fq - 1) : 16 * (8 * u.pn + wc) + 4 * fq;
                    *(u32x4*)(hid + (size_t)row * 256 + f0) = o;
                } else {
#pragma unroll
                    for (int bj = 0; bj < 2; ++bj) {
                        if (!((u.mask >> (2 * ai + bj)) & 1)) continue;
                        *(u32x2*)(hid + (size_t)row * 256 + 16 * (8 * u.pn + 4 * bj + wc) + 4 * fq) = ob[bj];
                    }
                }
            }
    }
};
struct EpiMoeDown {
    static constexpr bool PERM = false, AFTER_DRAIN = false;
    bf16_t* ys; const int* tile_e; const int* elist; const float* eww;
    __device__ __forceinline__ void operator()(const f32x4 (&acc)[2][2][4][2], const pg8::Unit& u, int wr, int wc, int fr_, int fq_) const {
        int z_ = 0; asm volatile("" : "+s"(z_)); int l_ = (int)__builtin_amdgcn_mbcnt_hi(~0u, __builtin_amdgcn_mbcnt_lo(~0u, (unsigned)z_)); asm volatile("" : "+v"(l_)); const int fr = l_ & 15, fq = l_ >> 4; (void)fr_; (void)fq_;
        const int e = __builtin_amdgcn_readfirstlane(ld_ctl(tile_e + u.pm)), off = __builtin_amdgcn_readfirstlane(ld_ctl(tile_e + TE_OFF + e)), cnt = __builtin_amdgcn_readfirstlane(ld_ctl(tile_e + TE_CNT + e));
        int ri[2][4]; float wv[2][4];
#pragma unroll
        for (int ai = 0; ai < 2; ++ai)
#pragma unroll
            for (int m = 0; m < 4; ++m) { const int local = 256 * u.pm + 128 * ai + 64 * wr + 16 * m + fr - off, idx = e * 16384 + (local < cnt ? local : 0); ri[ai][m] = elist[idx]; wv[ai][m] = eww[idx]; }
#pragma unroll
        for (int ai = 0; ai < 2; ++ai)
#pragma unroll
            for (int m = 0; m < 4; ++m) {
                const int local = 256 * u.pm + 128 * ai + 64 * wr + 16 * m + fr - off;
                if (local >= cnt) continue;
                const float w = wv[ai][m];
                bf16_t* dst = ys + ((size_t)(ri[ai][m] & 1) * T + (ri[ai][m] >> 1)) * D;
#pragma unroll
                for (int bj = 0; bj < 2; ++bj) {
                    if (!((u.mask >> (2 * ai + bj)) & 1)) continue;
                    const f32x4 v0 = acc[ai][bj][m][0] * w, v1 = acc[ai][bj][m][1] * w;
                    auto sx = __builtin_amdgcn_permlane16_swap(pk2(v0.x, v0.y), pk2(v1.x, v1.y), false, false);
                    auto sy = __builtin_amdgcn_permlane16_swap(pk2(v0.z, v0.w), pk2(v1.z, v1.w), false, false);
                    u32x4 o; o.x = sx[0]; o.y = sy[0]; o.z = sx[1]; o.w = sy[1];
                    const int col = 256 * u.pn + 128 * bj + 32 * wc + ((fq & 1) ? 16 + 4 * (fq - 1) : 4 * fq);
                    *(u32x4*)(dst + col) = o;
                }
            }
    }
};
template <bool GATHER_>
struct MoeOrderT {
    static constexpr bool GATHER = GATHER_;
    int ntiles, nN, G, c; const int* tile_e; size_t estride; const int* elist;
    __device__ __forceinline__ void arows(const pg8::Unit& u, const int (&RA)[2], int (&o)[2][2]) const {
        const int e = __builtin_amdgcn_readfirstlane(ld_ctl(tile_e + u.pm)), off = __builtin_amdgcn_readfirstlane(ld_ctl(tile_e + TE_OFF + e)), c = __builtin_amdgcn_readfirstlane(ld_ctl(tile_e + TE_CNT + e));
        int ri[2][2];
#pragma unroll
        for (int h = 0; h < 2; ++h)
#pragma unroll
            for (int i = 0; i < 2; ++i) { const int local = 256 * u.pm + 128 * h + RA[i] - off; ri[h][i] = elist[e * 16384 + (local < c ? local : 0)]; }
#pragma unroll
        for (int h = 0; h < 2; ++h)
#pragma unroll
            for (int i = 0; i < 2; ++i) { const int local = 256 * u.pm + 128 * h + RA[i] - off; o[h][i] = (local < c) ? (ri[h][i] >> 1) : 0; }
    }
    __device__ __forceinline__ bool next(int i, pg8::Unit& u) const { int L, f, sub; const int U = ntiles * nN;
        if ((G & 7) == 0) { const int x = c & 7, j = c >> 3, nb = G >> 3, U8 = (U + 7) >> 3, lo = x * U8, n = (lo + U8 <= U) ? U8 : (U > lo ? U - lo : 0);
            if (!pg8::tail_split(i, nb, j, n, L, f, sub)) return false; L += lo; }
        else if (!pg8::tail_split(i, G, c, U, L, f, sub)) return false;
        u.pm = L / nN; u.pn = L % nN; u.mask = (f == 1) ? 0xF : (f == 2) ? (sub ? 0xA : 0x5) : (1 << sub); return true; }
    __device__ __forceinline__ void a_ready(const pg8::Unit&) const {}
    __device__ __forceinline__ size_t boff(const pg8::Unit& u) const { return (size_t)__builtin_amdgcn_readfirstlane(ld_ctl(tile_e + u.pm)) * estride; }
    __device__ __forceinline__ void done(const pg8::Unit&) const {}
};
typedef MoeOrderT<false> MoeOrder;
typedef MoeOrderT<true> MoeGatherOrder;

__device__ __forceinline__ float gelu_tanh(float x) { const float u = 0.7978845608028654f * (x + 0.044715f * x * x * x); return 0.5f * x * (1.f + tanhf(u)); }

__device__ __forceinline__ void compress_unit(Frame& F, int layer, int u) {
    const int kvsel = u >> 5, b = (u >> 4) & 1, kvh = (u >> 3) & 1, rt = u & 7, i0 = 64 * rt;
    const bf16_t* src = (const bf16_t*)(F.ws + WS_KV6) + (size_t)kvsel * KV6_STRIDE + (size_t)(b * 2 + kvh) * SEQ * 64;
    const bf16_t* w1t = (const bf16_t*)(F.ws + WS_PHIW) + (size_t)kvsel * 64 * 2048;
    const int lane = F.lane, r = lane & 15, kg = lane >> 4;
    f32x4 acc[4][4];
#pragma unroll
    for (int a = 0; a < 4; ++a)
#pragma unroll
        for (int c = 0; c < 4; ++c) acc[a][c] = (f32x4){0.f, 0.f, 0.f, 0.f};
#pragma unroll 2
    for (int lq = 0; lq < 4; ++lq) {
        const int l = 4 * F.wave + lq;
#pragma unroll
        for (int ks = 0; ks < 2; ++ks) {
            bf16x8 af[4], bfr[4];
#pragma unroll
            for (int mt = 0; mt < 4; ++mt) af[mt] = *(const bf16x8*)(src + ((size_t)(16 * (i0 + 16 * mt + r) + l)) * 64 + 32 * ks + 8 * kg);
#pragma unroll
            for (int nt = 0; nt < 4; ++nt) bfr[nt] = *(const bf16x8*)(w1t + (size_t)(16 * nt + r) * 2048 + l * 64 + 32 * ks + 8 * kg);
#pragma unroll
            for (int mt = 0; mt < 4; ++mt)
#pragma unroll
                for (int nt = 0; nt < 4; ++nt) acc[mt][nt] = MFMA16(af[mt], bfr[nt], acc[mt][nt]);
        }
    }
    LAS float* part = (LAS float*)F.lds;
#pragma unroll
    for (int mt = 0; mt < 4; ++mt)
#pragma unroll
        for (int nt = 0; nt < 4; ++nt)
#pragma unroll
            for (int q = 0; q < 4; ++q) part[(F.wave * 64 + 16 * mt + 4 * kg + q) * 64 + 16 * nt + r] = acc[mt][nt][q];
    __syncthreads();
    const float* phib = (const float*)(F.ws + WS_PHIB) + (layer * 2 + kvsel) * 64;
    float hv[8];
    const int row = F.tid >> 3, e0 = (F.tid & 7) * 8;
#pragma unroll
    for (int k = 0; k < 8; ++k) { float s = phib[e0 + k];
#pragma unroll
        for (int w = 0; w < 8; ++w) s += part[(w * 64 + row) * 64 + e0 + k];
        hv[k] = gelu_tanh(s); }
    __syncthreads();
    LAS float* hb = (LAS float*)F.lds;
    LAS float* ob = (LAS float*)(F.lds + 32768);
#pragma unroll
    for (int k = 0; k < 8; ++k) hb[row * 65 + e0 + k] = hv[k];
    __syncthreads();
    const float* w2 = INF(F, I_PHIW2) + ((size_t)layer * 2 + kvsel) * 64 * 64;
    float o[8];
#pragma unroll
    for (int k = 0; k < 8; ++k) o[k] = 0.f;
#pragma unroll 8
    for (int e = 0; e < 64; ++e) { const float h = hb[row * 65 + e]; const f32x4 wa = *(const f32x4*)(w2 + e * 64 + e0), wb = *(const f32x4*)(w2 + e * 64 + e0 + 4);
        o[0] += h * wa.x; o[1] += h * wa.y; o[2] += h * wa.z; o[3] += h * wa.w; o[4] += h * wb.x; o[5] += h * wb.y; o[6] += h * wb.z; o[7] += h * wb.w; }
#pragma unroll
    for (int k = 0; k < 8; ++k) ob[row * 65 + e0 + k] = o[k];
    __syncthreads();
    const int i = i0 + row;
    bf16_t* dst = (bf16_t*)(F.ws + (kvsel ? WS_VCMP : WS_KCMP)) + ((size_t)(b * 2 + kvh) * 512 + i) * 64 + e0;
    float y[8];
    if (i >= 511) {
#pragma unroll
        for (int k = 0; k < 8; ++k) y[k] = 0.f;
    } else if (kvsel == 0) {
        const size_t pr = (size_t)b * SEQ + 16 * i + 31;
        const float* cs = (const float*)(F.ws + WS_COS) + pr * 32; const float* sn = (const float*)(F.ws + WS_SIN) + pr * 32;
#pragma unroll
        for (int k = 0; k < 8; ++k) { const int d = e0 + k, f = d & 31; const float x1 = ob[row * 65 + f], x2 = ob[row * 65 + f + 32];
            y[k] = (d < 32) ? (x1 * cs[f] - x2 * sn[f]) : (x2 * cs[f] + x1 * sn[f]); }
    } else {
#pragma unroll
        for (int k = 0; k < 8; ++k) y[k] = o[k];
    }
    u32x4 pk; pk.x = pk2(y[0], y[1]); pk.y = pk2(y[2], y[3]); pk.z = pk2(y[4], y[5]); pk.w = pk2(y[6], y[7]);
    *(u32x4*)dst = pk;
    __syncthreads();
}
__device__ __forceinline__ void kmean_task(Frame& F, int wt) {
    const int b = wt >> 7, h = (wt >> 5) & 3, blk = wt & 31, sub = F.lane >> 3, ch = F.lane & 7;
    const bf16_t* mk = (const bf16_t*)(F.ws + WS_MQKV) + MQKV_STRIDE + ((size_t)(b * 4 + h) * SEQ + 256 * blk) * 64;
    float a[8];
#pragma unroll
    for (int k = 0; k < 8; ++k) a[k] = 0.f;
#pragma unroll 8
    for (int it = 0; it < 32; ++it) {
        const u32x4 v = *(const u32x4*)(mk + (size_t)(8 * it + sub) * 64 + 8 * ch);
        a[0] += __uint_as_float(v.x << 16); a[1] += __uint_as_float(v.x & 0xffff0000u); a[2] += __uint_as_float(v.y << 16); a[3] += __uint_as_float(v.y & 0xffff0000u);
        a[4] += __uint_as_float(v.z << 16); a[5] += __uint_as_float(v.z & 0xffff0000u); a[6] += __uint_as_float(v.w << 16); a[7] += __uint_as_float(v.w & 0xffff0000u);
    }
#pragma unroll
    for (int k = 0; k < 8; ++k) { a[k] += shx(a[k], 8, F.lane); a[k] += shx(a[k], 16, F.lane); a[k] += shx(a[k], 32, F.lane); a[k] *= (1.f / 256.f); }
    if (sub == 0) { u32x4 o; o.x = pk2(a[0], a[1]); o.y = pk2(a[2], a[3]); o.z = pk2(a[4], a[5]); o.w = pk2(a[6], a[7]);
        *(u32x4*)((bf16_t*)(F.ws + WS_KMEAN) + ((size_t)(b * 4 + h) * 32 + blk) * 64 + 8 * ch) = o; }
}

constexpr int R1_TASK_OFF = 32768, R1_TASK_BYTES = 12288;
__device__ __forceinline__ unsigned bf_hi(float x) { return __float_as_uint(x) >> 16; }
__device__ __forceinline__ void r1_block(Frame& F, int layer, int bt) {
    const int chain = bt >> 4, b = chain / 6, h = chain % 6, lane0 = F.lane;
    const int chunk = 8 * (bt & 15) + F.wave, task = chain * 128 + chunk;
    LAS float* tb = (LAS float*)(F.lds + R1_TASK_OFF + F.wave * R1_TASK_BYTES);
    LAS float* Lr = tb; LAS float* Lw = tb + 512; LAS float* Lk = tb + 1024; LAS float* Lkk = tb + 1536; LAS float* Lbb = tb + 2048; LAS float* Lv = tb + 2560;
    const bf16_t* rf = (const bf16_t*)(F.ws + WS_RFEAT);
    const float* mu = INF(F, I_MU) + layer * RW;
    float* bonus = (float*)(F.ws + WS_BONUS);
    bf16_t* ytil = (bf16_t*)(F.ws + WS_YT) + (size_t)task * 4096; bf16_t* y0o = (bf16_t*)(F.ws + WS_Y0) + (size_t)task * 4096;
    bf16_t* lora = (bf16_t*)(F.ws + (task < 896 ? (size_t)242 * MiB + (size_t)task * 16384 : task < 1344 ? WS_WIN + (size_t)(task - 896) * 16384 : WS_ROUTE + (size_t)(task - 1344) * 16384));
    {
        const int c31 = lane0 & 31, hi = lane0 >> 5;
        f32x16 aw[2][2], aa[2][2];
#pragma unroll
        for (int mt = 0; mt < 2; ++mt)
#pragma unroll
            for (int nt = 0; nt < 2; ++nt)
#pragma unroll
                for (int r = 0; r < 16; ++r) { aw[mt][nt][r] = 0.f; aa[mt][nt][r] = 0.f; }
        const bf16_t* wt = (const bf16_t*)(F.ws + WS_WUPT) + (size_t)(h * 64) * 64; const bf16_t* at = (const bf16_t*)(F.ws + WS_AUPT) + (size_t)(h * 64) * 64;
#pragma unroll
        for (int ks = 0; ks < 4; ++ks) {
            const int j0 = 16 * ks + 8 * hi;
            bf16x8 fw[2], fa[2], bw[2], ba[2];
#pragma unroll
            for (int nt = 0; nt < 2; ++nt) { bw[nt] = *(const bf16x8*)(wt + (32 * nt + c31) * 64 + j0); ba[nt] = *(const bf16x8*)(at + (32 * nt + c31) * 64 + j0); }
#pragma unroll
            for (int mt = 0; mt < 2; ++mt) {
                const int t = 64 * chunk + 32 * mt + c31; const int rowi = b * SEQ + t;
                const u32x4 cw = *(const u32x4*)(rf + (size_t)rowi * RW + 1152 + j0), ca = *(const u32x4*)(rf + (size_t)rowi * RW + 1216 + j0);
                u32x4 pw = (u32x4){0u, 0u, 0u, 0u}, pa = (u32x4){0u, 0u, 0u, 0u};
                if (t > 0) { pw = *(const u32x4*)(rf + (size_t)(rowi - 1) * RW + 1152 + j0); pa = *(const u32x4*)(rf + (size_t)(rowi - 1) * RW + 1216 + j0); }
                const f32x4 mw0 = *(const f32x4*)(mu + 1152 + j0), mw1 = *(const f32x4*)(mu + 1152 + j0 + 4), ma0 = *(const f32x4*)(mu + 1216 + j0), ma1 = *(const f32x4*)(mu + 1216 + j0 + 4);
                const float mwv[8] = {mw0.x, mw0.y, mw0.z, mw0.w, mw1.x, mw1.y, mw1.z, mw1.w}, mav[8] = {ma0.x, ma0.y, ma0.z, ma0.w, ma1.x, ma1.y, ma1.z, ma1.w};
                const unsigned cwv[4] = {cw.x, cw.y, cw.z, cw.w}, pwv[4] = {pw.x, pw.y, pw.z, pw.w}, cav[4] = {ca.x, ca.y, ca.z, ca.w}, pav[4] = {pa.x, pa.y, pa.z, pa.w};
                float xw[8], xa[8];
#pragma unroll
                for (int k = 0; k < 4; ++k) {
                    const float c0 = __uint_as_float(cwv[k] << 16), c1 = __uint_as_float(cwv[k] & 0xffff0000u), p0 = __uint_as_float(pwv[k] << 16), p1 = __uint_as_float(pwv[k] & 0xffff0000u);
                    xw[2 * k] = tanh_fast(c0 + (p0 - c0) * mwv[2 * k]); xw[2 * k + 1] = tanh_fast(c1 + (p1 - c1) * mwv[2 * k + 1]);
                    const float d0 = __uint_as_float(cav[k] << 16), d1 = __uint_as_float(cav[k] & 0xffff0000u), q0 = __uint_as_float(pav[k] << 16), q1 = __uint_as_float(pav[k] & 0xffff0000u);
                    xa[2 * k] = d0 + (q0 - d0) * mav[2 * k]; xa[2 * k + 1] = d1 + (q1 - d1) * mav[2 * k + 1];
                }
                u32x4 uw, ua; uw.x = pk2(xw[0], xw[1]); uw.y = pk2(xw[2], xw[3]); uw.z = pk2(xw[4], xw[5]); uw.w = pk2(xw[6], xw[7]);
                ua.x = pk2(xa[0], xa[1]); ua.y = pk2(xa[2], xa[3]); ua.z = pk2(xa[4], xa[5]); ua.w = pk2(xa[6], xa[7]);
                fw[mt] = __builtin_bit_cast(bf16x8, uw); fa[mt] = __builtin_bit_cast(bf16x8, ua);
            }
#pragma unroll
            for (int mt = 0; mt < 2; ++mt)
#pragma unroll
                for (int nt = 0; nt < 2; ++nt) { aw[mt][nt] = MFMA32(fw[mt], bw[nt], aw[mt][nt]); aa[mt][nt] = MFMA32(fa[mt], ba[nt], aa[mt][nt]); }
        }
#pragma unroll
        for (int mt = 0; mt < 2; ++mt)
#pragma unroll
            for (int nt = 0; nt < 2; ++nt)
#pragma unroll
                for (int r = 0; r < 16; ++r) { const int tl = 32 * mt + (r & 3) + 8 * (r >> 2) + 4 * hi;
                    lora[tl * 64 + 32 * nt + c31] = f2bf(aw[mt][nt][r]); lora[4096 + tl * 64 + 32 * nt + c31] = f2bf(aa[mt][nt][r]); }
        asm volatile("s_waitcnt vmcnt(0)" ::: "memory");
    }
    float Wrun = 1.f;
    f32x16 XP[2][2], XZ[2][2];
    { const int c31 = lane0 & 31, hi = lane0 >> 5;
#pragma unroll
      for (int mt = 0; mt < 2; ++mt)
#pragma unroll
          for (int nt = 0; nt < 2; ++nt)
#pragma unroll
              for (int r = 0; r < 16; ++r) { XP[mt][nt][r] = (32 * mt + (r & 3) + 8 * (r >> 2) + 4 * hi == 32 * nt + c31) ? 1.f : 0.f; XZ[mt][nt][r] = 0.f; } }
#pragma unroll 1
    for (int sub = 0; sub < 8; ++sub) {
        int lane = lane0, hc = h * 64 + lane0; asm volatile("" : "+v"(lane), "+v"(hc));
#pragma unroll 1
        for (int half = 0; half < 2; ++half) {
            float rs4[4], ks4[4], vs4[4], aw4[4], aa4[4];
            const float mu_r = mu[hc], mu_k = mu[384 + hc], mu_v = mu[768 + hc];
            const float w0 = INF(F, I_W0)[layer * 384 + hc], a0 = INF(F, I_A0)[layer * 384 + hc];
#pragma unroll
            for (int q = 0; q < 4; ++q) {
                const int tl = 8 * sub + 4 * half + q, t = 64 * chunk + tl; const int rowi = b * SEQ + t;
                const bf16_t* cur = rf + (size_t)rowi * RW; const bf16_t* prv = cur - RW; const bool hp = t > 0;
                const float rc = bf2f(cur[hc]), kc = bf2f(cur[384 + hc]), vc = bf2f(cur[768 + hc]);
                const float rp = hp ? bf2f(prv[hc]) : 0.f, kp = hp ? bf2f(prv[384 + hc]) : 0.f, vp = hp ? bf2f(prv[768 + hc]) : 0.f;
                rs4[q] = rc + (rp - rc) * mu_r; ks4[q] = kc + (kp - kc) * mu_k; vs4[q] = vc + (vp - vc) * mu_v;
                aw4[q] = w0 + bf2f(lora[tl * 64 + lane]); aa4[q] = a0 + bf2f(lora[4096 + tl * 64 + lane]);
            }
            const float k_k = INF(F, I_KK)[layer * 384 + hc], k_a = INF(F, I_KA)[layer * 384 + hc], r_k = INF(F, I_RK)[layer * 384 + hc];
#pragma unroll
            for (int q = 0; q < 4; ++q) {
                const int tt = 4 * half + q; const int rowi = b * SEQ + 64 * chunk + 8 * sub + tt;
                const float dec = __expf(-0.606531f * sigm(aw4[q])), a = sigm(aa4[q]);
                float kk = ks4[q] * k_k; const float n2 = wave_sum(kk * kk, lane); kk = kk * __builtin_amdgcn_rsqf(fmaxf(n2, 1e-24f));
                const float km = ks4[q] * (1.f + (a - 1.f) * k_a);
                const float bn = wave_sum(rs4[q] * km * r_k, lane);
                const float Wprev = Wrun; Wrun *= dec; const float iW = __builtin_amdgcn_rcpf(Wrun);
                Lr[tt * 64 + lane] = rs4[q] * Wrun; Lk[tt * 64 + lane] = km * iW; Lkk[tt * 64 + lane] = -(kk * Wprev); Lbb[tt * 64 + lane] = kk * a * iW; Lv[tt * 64 + lane] = vs4[q];
                if (lane == 0) bonus[(size_t)rowi * 8 + h] = bn;
            }
        }
        LDS_WAIT(); asm volatile("" ::: "memory");
        const int c31 = lane & 31, hi = lane >> 5;
#pragma unroll 1
        for (int tt = 0; tt < 8; ++tt) {
            f32x4 k4[2][4], r4[2][4];
#pragma unroll
            for (int mt = 0; mt < 2; ++mt)
#pragma unroll
                for (int rq = 0; rq < 4; ++rq) { const int c0 = tt * 64 + 32 * mt + 8 * rq + 4 * hi;
                    k4[mt][rq] = *(const LAS f32x4*)(Lkk + c0); r4[mt][rq] = *(const LAS f32x4*)(Lr + c0); }
            float saP[2], saZ[2];
#pragma unroll
            for (int nt = 0; nt < 2; ++nt) { f32x2_t p2 = {0.f, 0.f}, z2 = {0.f, 0.f};
#pragma unroll
                for (int mt = 0; mt < 2; ++mt)
#pragma unroll
                    for (int r = 0; r < 16; r += 2) { const f32x2_t kk2 = {k4[mt][r >> 2][r & 3], k4[mt][r >> 2][(r & 3) + 1]};
                        const f32x2_t xp2 = {XP[mt][nt][r], XP[mt][nt][r + 1]}, xz2 = {XZ[mt][nt][r], XZ[mt][nt][r + 1]};
                        p2 = __builtin_elementwise_fma(xp2, kk2, p2); z2 = __builtin_elementwise_fma(xz2, kk2, z2); }
                float p = p2.x + p2.y, z = z2.x + z2.y;
                p = half_sum32(p); z = half_sum32(z); saP[nt] = p; saZ[nt] = z; }
            bf16x8 af[2], bP[2], bZ[2];
#pragma unroll
            for (int mt = 0; mt < 2; ++mt) { const float bbv = Lbb[tt * 64 + 32 * mt + c31], kv = Lk[tt * 64 + 32 * mt + c31];
                const unsigned bh = bf_hi(bbv), kh = bf_hi(kv); const unsigned bl = bf_hi(bbv - __uint_as_float(bh << 16)), kl = bf_hi(kv - __uint_as_float(kh << 16));
                u32x4 u; u.x = bh | (bl << 16); u.y = bh | (kh << 16); u.z = kl | (kh << 16); u.w = 0u;
                if (hi) u = (u32x4){0u, 0u, 0u, 0u};
                af[mt] = __builtin_bit_cast(bf16x8, u); }
#pragma unroll
            for (int nt = 0; nt < 2; ++nt) { const float vv = Lv[tt * 64 + 32 * nt + c31];
                const unsigned ph = bf_hi(saP[nt]), zh = bf_hi(saZ[nt]), vh = bf_hi(vv);
                const unsigned pl = bf_hi(saP[nt] - __uint_as_float(ph << 16)), zl = bf_hi(saZ[nt] - __uint_as_float(zh << 16)), vl = bf_hi(vv - __uint_as_float(vh << 16));
                u32x4 up, uz; up.x = ph | (ph << 16); up.y = pl; up.z = 0u; up.w = 0u;
                uz.x = zh | (zh << 16); uz.y = zl | (vh << 16); uz.z = vh | (vl << 16); uz.w = 0u;
                if (hi) { up = (u32x4){0u, 0u, 0u, 0u}; uz = (u32x4){0u, 0u, 0u, 0u}; }
                bP[nt] = __builtin_bit_cast(bf16x8, up); bZ[nt] = __builtin_bit_cast(bf16x8, uz); }
#pragma unroll
            for (int mt = 0; mt < 2; ++mt)
#pragma unroll
                for (int nt = 0; nt < 2; ++nt) { XP[mt][nt] = MFMA32(af[mt], bP[nt], XP[mt][nt]); XZ[mt][nt] = MFMA32(af[mt], bZ[nt], XZ[mt][nt]); }
#pragma unroll
            for (int nt = 0; nt < 2; ++nt) { f32x2_t p2 = {0.f, 0.f}, z2 = {0.f, 0.f};
#pragma unroll
                for (int mt = 0; mt < 2; ++mt)
#pragma unroll
                    for (int r = 0; r < 16; r += 2) { const f32x2_t rr2 = {r4[mt][r >> 2][r & 3], r4[mt][r >> 2][(r & 3) + 1]};
                        const f32x2_t xp2 = {XP[mt][nt][r], XP[mt][nt][r + 1]}, xz2 = {XZ[mt][nt][r], XZ[mt][nt][r + 1]};
                        p2 = __builtin_elementwise_fma(xp2, rr2, p2); z2 = __builtin_elementwise_fma(xz2, rr2, z2); }
                float p = p2.x + p2.y, z = z2.x + z2.y;
                p = half_sum32(p); z = half_sum32(z);
                if (hi == 0) { ytil[(8 * sub + tt) * 64 + 32 * nt + c31] = f2bf(p); y0o[(8 * sub + tt) * 64 + 32 * nt + c31] = f2bf(z); } }
        }
    }
    int lane_e = lane0; asm volatile("" : "+v"(lane_e));
    Lw[lane_e] = Wrun; LDS_WAIT(); asm volatile("" ::: "memory");
    { const int hi_ = lane_e >> 5;
#pragma unroll
      for (int mt = 0; mt < 2; ++mt)
#pragma unroll
          for (int rq = 0; rq < 4; ++rq) { const f32x4 wl = *(const LAS f32x4*)(Lw + 32 * mt + 8 * rq + 4 * hi_);
#pragma unroll
              for (int nt = 0; nt < 2; ++nt)
#pragma unroll
                  for (int k = 0; k < 4; ++k) { XP[mt][nt][4 * rq + k] *= wl[k]; XZ[mt][nt][4 * rq + k] *= wl[k]; } } }
    { const int c31 = lane_e & 31, hi = lane_e >> 5;
      bf16_t* PT = (bf16_t*)(F.ws + WS_PT) + (size_t)task * 4096;
      bf16_t* ZP = (bf16_t*)(F.ws + WS_ZS) + (size_t)task * 4096;
#pragma unroll
      for (int mt = 0; mt < 2; ++mt)
#pragma unroll
          for (int nt = 0; nt < 2; ++nt) {
#pragma unroll
              for (int r = 0; r < 16; ++r) PT[(32 * mt + (r & 3) + 8 * (r >> 2) + 4 * hi) * 64 + 32 * nt + c31] = f2bf(XP[mt][nt][r]);
              u32x4 a, c2; a.x = pk2(XZ[mt][nt][0], XZ[mt][nt][1]); a.y = pk2(XZ[mt][nt][2], XZ[mt][nt][3]); a.z = pk2(XZ[mt][nt][4], XZ[mt][nt][5]); a.w = pk2(XZ[mt][nt][6], XZ[mt][nt][7]);
              c2.x = pk2(XZ[mt][nt][8], XZ[mt][nt][9]); c2.y = pk2(XZ[mt][nt][10], XZ[mt][nt][11]); c2.z = pk2(XZ[mt][nt][12], XZ[mt][nt][13]); c2.w = pk2(XZ[mt][nt][14], XZ[mt][nt][15]);
              *(u32x4*)(ZP + ((mt * 2 + nt) * 64 + lane_e) * 16) = a; *(u32x4*)(ZP + ((mt * 2 + nt) * 64 + lane_e) * 16 + 8) = c2; } }
    __syncthreads();
}
constexpr int CW_PREP = 768;
constexpr int CW_R1DONE = 896;
__device__ __forceinline__ void publish_count(Frame& F, unsigned* word) {
    asm volatile("s_waitcnt vmcnt(0)" ::: "memory"); __syncthreads();
    if (F.tid == 0) { __builtin_amdgcn_fence(__ATOMIC_RELEASE, "agent"); asm volatile("s_waitcnt vmcnt(0)" ::: "memory"); (void)__hip_atomic_fetch_add(word, 1u, RLX_AGENT); }
}
__device__ __forceinline__ void await_count(Frame& F, unsigned* word, unsigned want) {
    if (F.tid == 0) { unsigned sp = 0; while ((unsigned)__builtin_amdgcn_readfirstlane(__hip_atomic_load(word, RLX_AGENT)) < want) { __builtin_amdgcn_s_sleep(4); if (++sp > (1u << 24)) break; }
        __builtin_amdgcn_fence(__ATOMIC_ACQUIRE, "agent"); asm volatile("s_waitcnt vmcnt(0)" ::: "memory"); }
    __syncthreads();
}
__device__ __forceinline__ void phase_c(Frame& F, int layer) {
    if (F.bid < 192) r1_block(F, layer, F.bid);
    else { compress_unit(F, layer, F.bid - 192); LAUNDER(F); if (F.bid < 224) kmean_task(F, (F.bid - 192) * 8 + F.wave); }
    LAUNDER(F);
    publish_count(F, F.ctl + ((F.bid < 192) ? CW_R1DONE + 64 * layer + (F.bid >> 4) : CW_PREP + 64 * layer));
}

constexpr int KP = 72;
constexpr int TILE_B = 64 * KP * 2;
constexpr int AT_K0 = 0, AT_V0 = 2 * TILE_B;
constexpr int AT_IMP = 4 * TILE_B;
constexpr int AT_MISC = AT_IMP + 8 * 8192;
constexpr int AT_KMEAN = AT_MISC + 256;
constexpr int R2_SBUF = 0;

__device__ __forceinline__ bf16x8 lds_frag(const LAS bf16_t* tile, int row, int col) { return *(const LAS bf16x8*)(tile + row * KP + col); }
__device__ __forceinline__ s16x4 lds_tr(const LAS bf16_t* p) { return __builtin_bit_cast(s16x4, __builtin_amdgcn_ds_read_tr16_b64_v4i16((LAS v4i16_t*)p)); }
__device__ __forceinline__ bf16x8 cat8(s16x4 a, s16x4 b) { bf16x8 r; r[0] = a[0]; r[1] = a[1]; r[2] = a[2]; r[3] = a[3]; r[4] = b[0]; r[5] = b[1]; r[6] = b[2]; r[7] = b[3]; return r; }
__device__ __forceinline__ bf16x8 pack8(const f32x4& a, const f32x4& b) { u32x4 u; u.x = pk2(a.x, a.y); u.y = pk2(a.z, a.w); u.z = pk2(b.x, b.y); u.w = pk2(b.z, b.w); return __builtin_bit_cast(bf16x8, u); }

template <int NH>
__device__ __forceinline__ void qk_tile(const LAS bf16_t* Kt, const bf16x8 (&qf)[NH][2], f32x4 (&st)[NH][4], const float (&cm)[NH], int lane, const bool (&keep)[NH]) {
    const int r = lane & 15, kg = lane >> 4;
    f32x4 ci[NH];
#pragma unroll
    for (int g = 0; g < NH; ++g) { const float c = keep[g] ? cm[g] : -INFINITY; ci[g] = (f32x4){c, c, c, c}; }
#pragma unroll
    for (int kt = 0; kt < 4; ++kt) {
        const bf16x8 k0 = lds_frag(Kt, 16 * kt + r, 8 * kg), k1 = lds_frag(Kt, 16 * kt + r, 32 + 8 * kg);
#pragma unroll
        for (int g = 0; g < NH; ++g) { f32x4 z = MFMA16(k0, qf[g][0], ci[g]); st[g][kt] = MFMA16(k1, qf[g][1], z); }
    }
}
template <int NH, bool DO_V>
__device__ __forceinline__ void pv_tile(const LAS bf16_t* Vt, const f32x4 (&p)[NH][4], f32x4 (&o)[NH][4], f32x4 (&lacc)[NH], int lane) {
    const int kg = lane >> 4, rr = (lane & 15) >> 2, cc = 4 * (lane & 3);
    const u32x4 one4 = (u32x4){0x3f803f80u, 0x3f803f80u, 0x3f803f80u, 0x3f803f80u};
    const bf16x8 ones = __builtin_bit_cast(bf16x8, one4);
#pragma unroll
    for (int i = 0; i < 2; ++i) {
        bf16x8 pf[NH];
#pragma unroll
        for (int g = 0; g < NH; ++g) { pf[g] = pack8(p[g][2 * i], p[g][2 * i + 1]); lacc[g] = MFMA16(ones, pf[g], lacc[g]); }
        if (DO_V) {
#pragma unroll
            for (int dt = 0; dt < 4; ++dt) {
                const s16x4 lo = lds_tr(Vt + (32 * i + 4 * kg + rr) * KP + 16 * dt + cc), hi = lds_tr(Vt + (32 * i + 16 + 4 * kg + rr) * KP + 16 * dt + cc);
                const bf16x8 vf = cat8(lo, hi);
#pragma unroll
                for (int g = 0; g < NH; ++g) o[g][dt] = MFMA16(vf, pf[g], o[g][dt]);
            }
        }
    }
}
__device__ __forceinline__ void softmax_tile(f32x4 (&st)[4], f32x4 (&o)[4], f32x4& lacc, float& mref, int lane) {
    float mx = -INFINITY;
#pragma unroll
    for (int kt = 0; kt < 4; ++kt) mx = fmaxf(fmaxf(mx, fmaxf(st[kt].x, st[kt].y)), fmaxf(st[kt].z, st[kt].w));
    mx = fmaxf(mx, shx(mx, 16, lane)); mx = fmaxf(mx, shx(mx, 32, lane));
    const bool fresh = (mref == -INFINITY);
    if (__any((fresh && mx > -INFINITY) || mx > 8.0f)) {
        const float d = fresh ? ((mx == -INFINITY) ? 0.f : mx) : fmaxf(mx, 0.f);
        const float alpha = fresh ? 1.f : __builtin_amdgcn_exp2f(-d);
        mref = fresh ? mx : mref + d;
        lacc = lacc * alpha;
#pragma unroll
        for (int dt = 0; dt < 4; ++dt) o[dt] = o[dt] * alpha;
#pragma unroll
        for (int kt = 0; kt < 4; ++kt) st[kt] = st[kt] - d;
    }
#pragma unroll
    for (int kt = 0; kt < 4; ++kt) {
        st[kt].x = __builtin_amdgcn_exp2f(st[kt].x); st[kt].y = __builtin_amdgcn_exp2f(st[kt].y);
        st[kt].z = __builtin_amdgcn_exp2f(st[kt].z); st[kt].w = __builtin_amdgcn_exp2f(st[kt].w);
    }
}
#define MX2(a, b) __builtin_elementwise_maximum((float)(a), (float)(b))
#define MX3(a, b, c) MX2(MX2(a, b), c)
template <int NH>
__device__ __forceinline__ void softmax_tiles(f32x4 (&st)[NH][4], f32x4 (&o)[NH][4], f32x4 (&lacc)[NH], float (&mref)[NH], float (&cm)[NH], int lane) {
    float mx[NH];
#pragma unroll
    for (int g = 0; g < NH; ++g) {
        float a = MX3(st[g][0].x, st[g][0].y, st[g][0].z), c = MX3(st[g][2].x, st[g][2].y, st[g][2].z);
        a = MX3(a, st[g][0].w, st[g][1].x); c = MX3(c, st[g][2].w, st[g][3].x);
        a = MX3(a, st[g][1].y, st[g][1].z); c = MX3(c, st[g][3].y, st[g][3].z);
        mx[g] = MX3(MX3(a, st[g][1].w, st[g][3].w), c, c); }
#pragma unroll
    for (int g = 0; g < NH; ++g)
#pragma unroll
        for (int kt = 0; kt < 4; ++kt) {
            st[g][kt].x = __builtin_amdgcn_exp2f(st[g][kt].x); st[g][kt].y = __builtin_amdgcn_exp2f(st[g][kt].y);
            st[g][kt].z = __builtin_amdgcn_exp2f(st[g][kt].z); st[g][kt].w = __builtin_amdgcn_exp2f(st[g][kt].w);
        }
#pragma unroll
    for (int g = 0; g < NH; ++g) { const unsigned u = __float_as_uint(mx[g]); auto a = __builtin_amdgcn_permlane16_swap(u, u, false, false); mx[g] = MX2(__uint_as_float(a[0]), __uint_as_float(a[1])); }
#pragma unroll
    for (int g = 0; g < NH; ++g) { const unsigned u = __float_as_uint(mx[g]); auto a = __builtin_amdgcn_permlane32_swap(u, u, false, false); mx[g] = MX2(__uint_as_float(a[0]), __uint_as_float(a[1])); }
    bool need = false;
#pragma unroll
    for (int g = 0; g < NH; ++g) need = need | (((mref[g] == -INFINITY) & (mx[g] > -INFINITY)) | (mx[g] > 8.0f));
    if (__any(need)) {
#pragma unroll
        for (int g = 0; g < NH; ++g) {
            const bool fresh = (mref[g] == -INFINITY);
            const float d = fresh ? ((mx[g] == -INFINITY) ? 0.f : fmaxf(mx[g], -100.f)) : fmaxf(mx[g], 0.f);
            const float pf = __builtin_amdgcn_exp2f(-d);
            const float alpha = fresh ? 1.f : pf;
            mref[g] = fresh ? ((mx[g] == -INFINITY) ? -INFINITY : d) : mref[g] + d;
            cm[g] = (mref[g] == -INFINITY) ? 0.f : -mref[g];
            lacc[g] = lacc[g] * alpha;
#pragma unroll
            for (int dt = 0; dt < 4; ++dt) o[g][dt] = o[g][dt] * alpha;
#pragma unroll
            for (int kt = 0; kt < 4; ++kt) st[g][kt] = st[g][kt] * pf;
        }
    }
}
__device__ __forceinline__ void acc_pk(u32x2& d, const f32x4& v) {
    const float a = __uint_as_float(d.x << 16) + v.x, b = __uint_as_float(d.x & 0xffff0000u) + v.y, c = __uint_as_float(d.y << 16) + v.z, e = __uint_as_float(d.y & 0xffff0000u) + v.w;
    d.x = pk2(a, b); d.y = pk2(c, e); }
__device__ __forceinline__ u32x4 tile_load(const bf16_t* g, int tid) { const int off = (tid >> 3) * 64 + (tid & 7) * 8; return *(const u32x4*)(g + off); }
__device__ __forceinline__ void tile_store(LAS bf16_t* t, int tid, u32x4 v) { *(LAS u32x4*)(t + (tid >> 3) * KP + (tid & 7) * 8) = v; }

#define LDS_BAR() do { asm volatile("s_waitcnt lgkmcnt(0)" ::: "memory"); __builtin_amdgcn_s_barrier(); asm volatile("" ::: "memory"); } while (0)
__device__ __forceinline__ void nsa_task(Frame& F, int b, int kvh, int J) {
    const int lane = F.lane, tid = F.tid, wv = F.wave, q = lane & 15, kg = lane >> 4;
    const int t0 = 128 * J, tw0 = t0 + 16 * wv, tq_abs = tw0 + q, cur = tw0 >> 6, tq = tq_abs & 63;
    LAS bf16_t* Kb = (LAS bf16_t*)(F.lds + AT_K0); LAS bf16_t* Vb = (LAS bf16_t*)(F.lds + AT_V0);
    LAS float* imp = (LAS float*)(F.lds + AT_IMP + wv * 8192);
    const bf16_t* kvbase = (const bf16_t*)(F.ws + WS_KV6);
    const size_t slab = (size_t)(b * 2 + kvh) * SEQ * 64;
    const bf16_t* Kcmp = (const bf16_t*)(F.ws + WS_KCMP) + (size_t)(b * 2 + kvh) * 512 * 64;
    const bf16_t* Vcmp = (const bf16_t*)(F.ws + WS_VCMP) + (size_t)(b * 2 + kvh) * 512 * 64;
    const bf16_t* Ks = kvbase + 2 * KV6_STRIDE + slab; const bf16_t* Vs = kvbase + 3 * KV6_STRIDE + slab;
    const bf16_t* Kw = kvbase + 4 * KV6_STRIDE + slab; const bf16_t* Vw = kvbase + 5 * KV6_STRIDE + slab;
    bf16x8 qf[3][2];
#pragma unroll
    for (int g = 0; g < 3; ++g) { const bf16_t* qp = (const bf16_t*)(F.ws + WS_NQ) + (((b * 6 + 3 * kvh + g) * SEQ + tq_abs) * 64 + 8 * kg);
        qf[g][0] = *(const bf16x8*)qp; qf[g][1] = *(const bf16x8*)(qp + 32); }
#define NSA_GATEP ((const float*)(F.ws + WS_GATE) + ((b * SEQ + tq_abs) * 32 + 9 * kvh))
    for (int i = lane; i < 2048; i += 64) imp[i] = 0.f;
    const int imax_blk = (t0 + 127 - 31) >> 4;
    const int ntc = (imax_blk >> 6) + 1;
    const int imax_w = (tw0 + 15 >= 31) ? ((tw0 + 15 - 31) >> 4) : -1;
    const int ivis = (tq_abs >= 31) ? ((tq_abs - 31) >> 4) : -1;
    float m[3] = {-INFINITY, -INFINITY, -INFINITY}; float cm[3] = {0.f, 0.f, 0.f};
    f32x4 lacc[3] = {(f32x4){0.f, 0.f, 0.f, 0.f}, (f32x4){0.f, 0.f, 0.f, 0.f}, (f32x4){0.f, 0.f, 0.f, 0.f}};
    f32x4 st[3][4];
    f32x4 ob[3][4];
    const bool keep3[3] = {true, true, true};
#pragma unroll
    for (int g = 0; g < 3; ++g)
#pragma unroll
        for (int dt = 0; dt < 4; ++dt) ob[g][dt] = (f32x4){0.f, 0.f, 0.f, 0.f};
    {
        u32x4 kr = tile_load(Kcmp, tid);
        tile_store(Kb, tid, kr); __syncthreads();
        for (int ct = 0; ct < ntc; ++ct) {
            if (ct + 1 < ntc) kr = tile_load(Kcmp + (ct + 1) * 4096, tid);
            const LAS bf16_t* Kt = Kb + (ct & 1) * (TILE_B / 2);
            if (64 * ct <= imax_w) {
                qk_tile<3>(Kt, qf, st, cm, lane, keep3);
#pragma unroll
                for (int g = 0; g < 3; ++g) {
#pragma unroll
                    for (int kt = 0; kt < 4; ++kt)
#pragma unroll
                        for (int r = 0; r < 4; ++r) { const int i = 64 * ct + 16 * kt + 4 * kg + r; st[g][kt][r] = (i <= ivis) ? st[g][kt][r] : -INFINITY; }
                }
                softmax_tiles<3>(st, ob, lacc, m, cm, lane);
                pv_tile<3, false>(Kt, st, ob, lacc, lane);
            }
            if (ct + 1 < ntc) tile_store(Kb + ((ct + 1) & 1) * (TILE_B / 2), tid, kr);
            LDS_BAR();
        }
    }
    float invl[3]; float msafe[3];
#pragma unroll
    for (int g = 0; g < 3; ++g) { msafe[g] = (m[g] == -INFINITY) ? 0.f : m[g]; invl[g] = 1.f / fmaxf(lacc[g].x, 1e-30f); }
    {
        u32x4 kr = tile_load(Kcmp, tid), vr = tile_load(Vcmp, tid);
        tile_store(Kb, tid, kr); tile_store(Vb, tid, vr); __syncthreads();
        for (int ct = 0; ct < ntc; ++ct) {
            if (ct + 1 < ntc) { kr = tile_load(Kcmp + (ct + 1) * 4096, tid); vr = tile_load(Vcmp + (ct + 1) * 4096, tid); }
            const LAS bf16_t* Kt = Kb + (ct & 1) * (TILE_B / 2); const LAS bf16_t* Vt = Vb + (ct & 1) * (TILE_B / 2);
            if (64 * ct <= imax_w) {
                qk_tile<3>(Kt, qf, st, cm, lane, keep3);
#pragma unroll
                for (int g = 0; g < 3; ++g)
#pragma unroll
                    for (int kt = 0; kt < 4; ++kt)
#pragma unroll
                        for (int r = 0; r < 4; ++r) { const int i = 64 * ct + 16 * kt + 4 * kg + r;
                            st[g][kt][r] = (i <= ivis) ? __builtin_amdgcn_exp2f(st[g][kt][r]) * invl[g] : 0.f; }
#pragma unroll
                for (int kt = 0; kt < 4; ++kt) {
                    float a = 0.f, c = 0.f;
#pragma unroll
                    for (int g = 0; g < 3; ++g) { a += (st[g][kt].x + st[g][kt].y) + st[g][kt].z; c += st[g][kt].w; }
                    c *= 0.5f; a += c;
                    const float recv = __uint_as_float(__builtin_amdgcn_ds_bpermute(((lane + 48) & 63) << 2, __float_as_uint(c)));
                    const int ktp = 4 * ct + kt;
                    imp[ktp * 64 + lane] += a + (kg != 0 ? recv : 0.f);
                    if (kg == 0 && ktp + 1 < 32) imp[(ktp + 1) * 64 + lane] += recv;
                }
                pv_tile<3, true>(Vt, st, ob, lacc, lane);
            }
            if (ct + 1 < ntc) { tile_store(Kb + ((ct + 1) & 1) * (TILE_B / 2), tid, kr); tile_store(Vb + ((ct + 1) & 1) * (TILE_B / 2), tid, vr); }
            LDS_BAR();
        }
    }
#pragma unroll
    for (int g = 0; g < 3; ++g) { const float sc = sigm(NSA_GATEP[3 * g + 0]);
#pragma unroll
        for (int dt = 0; dt < 4; ++dt) ob[g][dt] = ob[g][dt] * sc; }
    unsigned msk[4] = {0u, 0u, 0u, 0u};
    if (cur <= 15) {
        msk[0] = (cur == 31) ? 0xffffffffu : ((1u << (cur + 1)) - 1u);
    } else {
        float iv[32];
#pragma unroll
        for (int k = 0; k < 32; ++k) { const int s = 4 * k + kg; const float v = imp[k * 64 + lane]; iv[k] = (s >= 1 && s <= cur - 2) ? v : -1.f; }
        msk[0] = 1u; msk[cur >> 5] |= 1u << (cur & 31); msk[(cur - 1) >> 5] |= 1u << ((cur - 1) & 31);
        for (int it = 0; it < 13; ++it) {
            float bv = -2.f; int bs = 1 << 20;
#pragma unroll
            for (int k = 0; k < 32; ++k) { if (iv[k] > bv) { bv = iv[k]; bs = 4 * k + kg; } }
#pragma unroll
            for (int sh = 16; sh <= 32; sh <<= 1) { const float ov = shx(bv, sh, lane); const int os = shxi(bs, sh, lane); if (ov > bv || (ov == bv && os < bs)) { bv = ov; bs = os; } }
#pragma unroll
            for (int k = 0; k < 32; ++k) if (4 * k + kg == bs) iv[k] = -1.f;
#pragma unroll
            for (int wd = 0; wd < 4; ++wd) if ((bs >> 5) == wd) msk[wd] |= 1u << (bs & 31);
        }
    }
    LAS u32x2* otp = (LAS u32x2*)imp;
#pragma unroll
    for (int g = 0; g < 3; ++g)
#pragma unroll
        for (int dt = 0; dt < 4; ++dt) { u32x2 o; o.x = pk2(ob[g][dt].x, ob[g][dt].y); o.y = pk2(ob[g][dt].z, ob[g][dt].w); otp[(g * 4 + dt) * 64 + lane] = o; }
    {
#pragma unroll
        for (int g = 0; g < 3; ++g) { m[g] = -INFINITY; cm[g] = 0.f; lacc[g] = (f32x4){0.f, 0.f, 0.f, 0.f};
#pragma unroll
            for (int dt = 0; dt < 4; ++dt) ob[g][dt] = (f32x4){0.f, 0.f, 0.f, 0.f}; }
        const int nb = 2 * J + 2;
        u32x4 kr[2], vr[2]; unsigned mw = 0u;
        kr[0] = tile_load(Ks, tid); vr[0] = tile_load(Vs, tid);
        kr[1] = tile_load(Ks + ((nb > 1) ? 4096 : 0), tid); vr[1] = tile_load(Vs + ((nb > 1) ? 4096 : 0), tid);
        tile_store(Kb, tid, kr[0]); tile_store(Vb, tid, vr[0]); __syncthreads();
        for (int s0 = 0; s0 < nb; s0 += 2) {
#pragma unroll
            for (int u = 0; u < 2; ++u) {
                const int s = s0 + u;
                if (s < nb) {
                    if (s + 2 < nb) { kr[u] = tile_load(Ks + (s + 2) * 4096, tid); vr[u] = tile_load(Vs + (s + 2) * 4096, tid); }
                    const LAS bf16_t* Kt = Kb + (s & 1) * (TILE_B / 2); const LAS bf16_t* Vt = Vb + (s & 1) * (TILE_B / 2);
                    if ((s & 31) == 0) mw = (s == 0) ? msk[0] : (s == 32) ? msk[1] : (s == 64) ? msk[2] : msk[3];
                    const bool sel = ((mw >> (s & 31)) & 1u) != 0u;
                    if (__any(sel)) {
                        const bool selk[3] = {sel, sel, sel};
                        qk_tile<3>(Kt, qf, st, cm, lane, selk);
                        if (s == cur) {
#pragma unroll
                            for (int g = 0; g < 3; ++g)
#pragma unroll
                                for (int kt = 0; kt < 4; ++kt)
#pragma unroll
                                    for (int r = 0; r < 4; ++r) { const int kk = 16 * kt + 4 * kg + r; st[g][kt][r] = (kk <= tq) ? st[g][kt][r] : -INFINITY; }
                        }
                        softmax_tiles<3>(st, ob, lacc, m, cm, lane);
                        pv_tile<3, true>(Vt, st, ob, lacc, lane);
                    }
                    if (s + 1 < nb) { tile_store(Kb + ((s + 1) & 1) * (TILE_B / 2), tid, kr[u ^ 1]); tile_store(Vb + ((s + 1) & 1) * (TILE_B / 2), tid, vr[u ^ 1]); }
                }
                LDS_BAR();
            }
        }
#pragma unroll
        for (int g = 0; g < 3; ++g) { const float sc = sigm(NSA_GATEP[3 * g + 1]) / fmaxf(lacc[g].x, 1e-30f);
#pragma unroll
            for (int dt = 0; dt < 4; ++dt) { u32x2 o = otp[(g * 4 + dt) * 64 + lane]; acc_pk(o, ob[g][dt] * sc); otp[(g * 4 + dt) * 64 + lane] = o; } }
    }
    {
#pragma unroll
        for (int g = 0; g < 3; ++g) { m[g] = -INFINITY; cm[g] = 0.f; lacc[g] = (f32x4){0.f, 0.f, 0.f, 0.f};
#pragma unroll
            for (int dt = 0; dt < 4; ++dt) ob[g][dt] = (f32x4){0.f, 0.f, 0.f, 0.f}; }
        const int s_lo = (2 * J - 8 > 0) ? 2 * J - 8 : 0, s_hi = 2 * J + 1, nb = s_hi - s_lo + 1;
        u32x4 kr[2], vr[2];
        kr[0] = tile_load(Kw + s_lo * 4096, tid); vr[0] = tile_load(Vw + s_lo * 4096, tid);
        kr[1] = tile_load(Kw + (s_lo + ((nb > 1) ? 1 : 0)) * 4096, tid); vr[1] = tile_load(Vw + (s_lo + ((nb > 1) ? 1 : 0)) * 4096, tid);
        tile_store(Kb, tid, kr[0]); tile_store(Vb, tid, vr[0]); __syncthreads();
        for (int it0 = 0; it0 < nb; it0 += 2) {
#pragma unroll
            for (int u = 0; u < 2; ++u) {
                const int it = it0 + u;
                if (it < nb) {
                    const int s = s_lo + it;
                    if (it + 2 < nb) { kr[u] = tile_load(Kw + (s + 2) * 4096, tid); vr[u] = tile_load(Vw + (s + 2) * 4096, tid); }
                    const LAS bf16_t* Kt = Kb + (it & 1) * (TILE_B / 2); const LAS bf16_t* Vt = Vb + (it & 1) * (TILE_B / 2);
                    if (s <= cur && s >= cur - 8) {
                        qk_tile<3>(Kt, qf, st, cm, lane, keep3);
                        if (s == cur || s == cur - 8) {
#pragma unroll
                            for (int g = 0; g < 3; ++g)
#pragma unroll
                                for (int kt = 0; kt < 4; ++kt)
#pragma unroll
                                    for (int r = 0; r < 4; ++r) { const int kk = 16 * kt + 4 * kg + r; const bool ok = (s == cur) ? (kk <= tq) : (kk > tq); st[g][kt][r] = ok ? st[g][kt][r] : -INFINITY; }
                        }
                        softmax_tiles<3>(st, ob, lacc, m, cm, lane);
                        pv_tile<3, true>(Vt, st, ob, lacc, lane);
                    }
                    if (it + 1 < nb) { tile_store(Kb + ((it + 1) & 1) * (TILE_B / 2), tid, kr[u ^ 1]); tile_store(Vb + ((it + 1) & 1) * (TILE_B / 2), tid, vr[u ^ 1]); }
                }
                LDS_BAR();
            }
        }
        bf16_t* mixp = (bf16_t*)(F.ws + WS_HM) + ((b * SEQ + tq_abs) * D + 3 * kvh * 64 + 4 * kg);
#pragma unroll
        for (int g = 0; g < 3; ++g) { const float sc = sigm(NSA_GATEP[3 * g + 2]) / fmaxf(lacc[g].x, 1e-30f);
#pragma unroll
            for (int dt = 0; dt < 4; ++dt) { u32x2 o = otp[(g * 4 + dt) * 64 + lane]; acc_pk(o, ob[g][dt] * sc); *(u32x2*)(mixp + g * 64 + 16 * dt) = o; } }
    }
}

__device__ __forceinline__ void moba_task(Frame& F, int b, int h, int own) {
    const int lane = F.lane, tid = F.tid, wv = F.wave, q = lane & 15, kg = lane >> 4;
    LAS bf16_t* Kb = (LAS bf16_t*)(F.lds + AT_K0); LAS bf16_t* Vb = (LAS bf16_t*)(F.lds + AT_V0); LAS bf16_t* Km = (LAS bf16_t*)(F.lds + AT_KMEAN);
    const size_t slab = (size_t)(b * 4 + h) * SEQ * 64;
    const bf16_t* Qg = (const bf16_t*)(F.ws + WS_MQKV) + slab; const bf16_t* Kg = Qg + MQKV_STRIDE; const bf16_t* Vg = Kg + MQKV_STRIDE;
    const int tw0 = 256 * own + 32 * wv;
    bf16x8 qf[2][2];
#pragma unroll
    for (int rt = 0; rt < 2; ++rt) { const bf16_t* qp = Qg + ((tw0 + 16 * rt + q) * 64 + 8 * kg); qf[rt][0] = *(const bf16x8*)qp; qf[rt][1] = *(const bf16x8*)(qp + 32); }
    if (tid < 256) { const u32x4 v = *(const u32x4*)((const bf16_t*)(F.ws + WS_KMEAN) + (size_t)(b * 4 + h) * 2048 + (tid >> 3) * 64 + (tid & 7) * 8); *(LAS u32x4*)(Km + (tid >> 3) * KP + (tid & 7) * 8) = v; }
    __syncthreads();
    unsigned msk[2] = {0u, 0u};
    {
        f32x4 gs[2][2];
#pragma unroll
        for (int kt = 0; kt < 2; ++kt) { const bf16x8 k0 = lds_frag(Km, 16 * kt + q, 8 * kg), k1 = lds_frag(Km, 16 * kt + q, 32 + 8 * kg);
#pragma unroll
            for (int rt = 0; rt < 2; ++rt) { f32x4 z = (f32x4){0.f, 0.f, 0.f, 0.f}; z = MFMA16(k0, qf[rt][0], z); gs[rt][kt] = MFMA16(k1, qf[rt][1], z); } }
#pragma unroll
        for (int rt = 0; rt < 2; ++rt) {
            float gv[8];
#pragma unroll
            for (int kt = 0; kt < 2; ++kt)
#pragma unroll
                for (int r = 0; r < 4; ++r) { const int blk = 16 * kt + 4 * kg + r; gv[4 * kt + r] = (blk < own) ? gs[rt][kt][r] : -INFINITY; }
            for (int it = 0; it < 3; ++it) {
                float bv = -INFINITY; int bs = 1 << 20;
#pragma unroll
                for (int k = 0; k < 8; ++k) { const int blk = 16 * (k >> 2) + 4 * kg + (k & 3); if (gv[k] > bv) { bv = gv[k]; bs = blk; } }
#pragma unroll
                for (int sh = 16; sh <= 32; sh <<= 1) { const float ov = shx(bv, sh, lane); const int os = shxi(bs, sh, lane); if (ov > bv || (ov == bv && os < bs)) { bv = ov; bs = os; } }
                if (bs < 32) { msk[rt] |= 1u << bs;
#pragma unroll
                    for (int k = 0; k < 8; ++k) if (16 * (k >> 2) + 4 * kg + (k & 3) == bs) gv[k] = -INFINITY; }
            }
        }
    }
    float m[2] = {-INFINITY, -INFINITY}; float cm[2] = {0.f, 0.f}; f32x4 lacc[2] = {(f32x4){0.f, 0.f, 0.f, 0.f}, (f32x4){0.f, 0.f, 0.f, 0.f}};
    f32x4 ob[2][4], st[2][4];
#pragma unroll
    for (int rt = 0; rt < 2; ++rt)
#pragma unroll
        for (int dt = 0; dt < 4; ++dt) ob[rt][dt] = (f32x4){0.f, 0.f, 0.f, 0.f};
    const int ntile = 4 * own + 4;
    u32x4 kr[2], vr[2];
    kr[0] = tile_load(Kg, tid); vr[0] = tile_load(Vg, tid); kr[1] = tile_load(Kg + 4096, tid); vr[1] = tile_load(Vg + 4096, tid);
    tile_store(Kb, tid, kr[0]); tile_store(Vb, tid, vr[0]); __syncthreads();
    for (int tau0 = 0; tau0 < ntile; tau0 += 2) {
#pragma unroll
        for (int u = 0; u < 2; ++u) {
            const int tau = tau0 + u;
            if (tau + 2 < ntile) { kr[u] = tile_load(Kg + (tau + 2) * 4096, tid); vr[u] = tile_load(Vg + (tau + 2) * 4096, tid); }
            const LAS bf16_t* Kt = Kb + (tau & 1) * (TILE_B / 2); const LAS bf16_t* Vt = Vb + (tau & 1) * (TILE_B / 2);
            const int blk = tau >> 2;
            bool sel[2]; bool anyv = false;
#pragma unroll
            for (int rt = 0; rt < 2; ++rt) { sel[rt] = (blk < own) ? ((msk[rt] >> blk) & 1u) : (64 * (tau & 3) <= 32 * wv + 16 * rt + q); anyv = anyv || sel[rt]; }
            if (__any(anyv)) {
                const bool selk[2] = {(blk < own) ? sel[0] : true, (blk < own) ? sel[1] : true};
                qk_tile<2>(Kt, qf, st, cm, lane, selk);
                if (blk >= own) {
#pragma unroll
                    for (int rt = 0; rt < 2; ++rt) {
                        const int trel = 32 * wv + 16 * rt + q;
#pragma unroll
                        for (int kt = 0; kt < 4; ++kt)
#pragma unroll
                            for (int r = 0; r < 4; ++r) { const int kk = 64 * (tau & 3) + 16 * kt + 4 * kg + r; st[rt][kt][r] = (kk <= trel) ? st[rt][kt][r] : -INFINITY; }
                    }
                }
                softmax_tiles<2>(st, ob, lacc, m, cm, lane);
                pv_tile<2, true>(Vt, st, ob, lacc, lane);
            }
            if (tau + 1 < ntile) { tile_store(Kb + ((tau + 1) & 1) * (TILE_B / 2), tid, kr[u ^ 1]); tile_store(Vb + ((tau + 1) & 1) * (TILE_B / 2), tid, vr[u ^ 1]); }
            LDS_BAR();
        }
    }
#pragma unroll
    for (int rt = 0; rt < 2; ++rt) {
        const float sc = 1.f / fmaxf(lacc[rt].x, 1e-30f);
        bf16_t* mix = (bf16_t*)(F.ws + WS_HM) + ((b * SEQ + tw0 + 16 * rt + q) * D + 384 + h * 64 + 4 * kg);
#pragma unroll
        for (int dt = 0; dt < 4; ++dt) { const f32x4 v = ob[rt][dt] * sc; u32x2 o; o.x = pk2(v.x, v.y); o.y = pk2(v.z, v.w); *(u32x2*)(mix + 16 * dt) = o; }
    }
}

constexpr int R2_RING = 16384, R2_SLOT = 12288;
__device__ __forceinline__ void r2_issue(const bf16_t* pt, const bf16_t* zp, LAS unsigned char* slot) {
#pragma unroll
    for (int mt = 0; mt < 2; ++mt)
#pragma unroll
        for (int ks = 0; ks < 4; ++ks) __builtin_amdgcn_global_load_lds((const unsigned*)(pt + mt * 2048 + ks * 16), (LAS unsigned*)(slot + (mt * 4 + ks) * 1024), 16, 0, 0);
#pragma unroll
    for (int mt = 0; mt < 2; ++mt)
#pragma unroll
        for (int q = 0; q < 2; ++q) __builtin_amdgcn_global_load_lds((const unsigned*)(zp + mt * 2048 + q * 8), (LAS unsigned*)(slot + 8192 + (mt * 2 + q) * 1024), 16, 0, 0);
}
__device__ __forceinline__ void r2_wave(Frame& F, int widx) {
    const int chain = widx >> 1, hf = widx & 1, lane = F.lane, c31 = lane & 31, hi = lane >> 5;
    LAS bf16_t* sb = (LAS bf16_t*)(F.lds + R2_SBUF + F.wave * (32 * KP * 2));
    LAS unsigned char* ring = F.lds + R2_RING + F.wave * (4 * R2_SLOT);
    for (int i = lane; i < 32 * KP / 2; i += 64) ((LAS unsigned*)sb)[i] = 0u;
    const bf16_t* PTl = (const bf16_t*)(F.ws + WS_PT) + (size_t)chain * 128 * 4096 + c31 * 64 + 8 * hi;
    const bf16_t* ZPl = (const bf16_t*)(F.ws + WS_ZS) + (size_t)chain * 128 * 4096 + (hf * 64 + lane) * 16;
    bf16_t* SS = (bf16_t*)(F.ws + WS_SS) + (size_t)chain * 128 * 4096 + (32 * hf) * 64;
    r2_issue(PTl, ZPl, ring); r2_issue(PTl + 4096, ZPl + 4096, ring + R2_SLOT); r2_issue(PTl + 2 * 4096, ZPl + 2 * 4096, ring + 2 * R2_SLOT);
#pragma unroll 1
    for (int c = 0; c < 128; ++c) {
        const int cn = (c + 3 < 128) ? c + 3 : 127;
        r2_issue(PTl + cn * 4096, ZPl + cn * 4096, ring + ((c + 3) & 3) * R2_SLOT);
        asm volatile("s_waitcnt vmcnt(36)" ::: "memory");
        const LAS unsigned char* sl = ring + (c & 3) * R2_SLOT + lane * 16;
        f32x16 acc[2];
#pragma unroll
        for (int mt = 0; mt < 2; ++mt)
#pragma unroll
            for (int q = 0; q < 2; ++q) { const u32x4 z = *(const LAS u32x4*)(sl + 8192 + (mt * 2 + q) * 1024);
                acc[mt][8 * q + 0] = __uint_as_float(z.x << 16); acc[mt][8 * q + 1] = __uint_as_float(z.x & 0xffff0000u); acc[mt][8 * q + 2] = __uint_as_float(z.y << 16); acc[mt][8 * q + 3] = __uint_as_float(z.y & 0xffff0000u);
                acc[mt][8 * q + 4] = __uint_as_float(z.z << 16); acc[mt][8 * q + 5] = __uint_as_float(z.z & 0xffff0000u); acc[mt][8 * q + 6] = __uint_as_float(z.w << 16); acc[mt][8 * q + 7] = __uint_as_float(z.w & 0xffff0000u); }
#pragma unroll
        for (int ks = 0; ks < 4; ++ks) {
            const bf16x8 bx = *(const LAS bf16x8*)(sb + c31 * KP + 16 * ks + 8 * hi);
#pragma unroll
            for (int mt = 0; mt < 2; ++mt) { const bf16x8 pa = *(const LAS bf16x8*)(sl + (mt * 4 + ks) * 1024); acc[mt] = MFMA32(pa, bx, acc[mt]); }
        }
#pragma unroll
        for (int mt = 0; mt < 2; ++mt)
#pragma unroll
            for (int r = 0; r < 16; ++r) sb[c31 * KP + 32 * mt + (r & 3) + 8 * (r >> 2) + 4 * hi] = f2bf(acc[mt][r]);
        bf16_t* ss = SS + c * 4096;
#pragma unroll
        for (int j = 0; j < 4; ++j) { const int qd = lane + 64 * j, row = qd >> 3, ch = qd & 7; *(u32x4*)(ss + row * 64 + ch * 8) = *(const LAS u32x4*)(sb + row * KP + ch * 8); }
    }
    asm volatile("s_waitcnt vmcnt(0)" ::: "memory");
}

struct TaskTable { unsigned short v[512]; };
constexpr TaskTable make_tasks() {
    TaskTable t{}; int n = 0, a = 63, am = 0, c = 31, cm = 0;
    while (a >= 0 || c >= 0) {
        const int ca = (a >= 0) ? 96 * a + 1344 : -1, cc = (c >= 0) ? 128 * c + 128 : -1;
        if (ca >= cc) { t.v[n++] = (unsigned short)(0 * 512 + am * 64 + a); if (++am == 4) { am = 0; --a; } }
        else { t.v[n++] = (unsigned short)(1 * 512 + cm * 64 + c); if (++cm == 8) { cm = 0; --c; } }
    }
    return t;
}
__device__ const TaskTable g_tasks = make_tasks();

__device__ __forceinline__ void r3_task(Frame& F, int layer, int task) {
    const int chain = task >> 7, c = task & 127, b = chain / 6, h = chain % 6, lane = F.lane, c31 = lane & 31, hi = lane >> 5;
    const bf16_t* S0 = (const bf16_t*)(F.ws + WS_SS) + (size_t)(task - 1) * 4096;
    const bf16_t* YT = (const bf16_t*)(F.ws + WS_YT) + (size_t)task * 4096;
    const bf16_t* Y0 = (const bf16_t*)(F.ws + WS_Y0) + (size_t)task * 4096;
    const bf16_t* rf = (const bf16_t*)(F.ws + WS_RFEAT);
    const bf16_t* gut = (const bf16_t*)(F.ws + WS_GUPT) + (size_t)(h * 64) * 128;
    const float* mu = INF(F, I_MU) + layer * RW;
    f32x16 acc[2][2], gacc[2][2];
#pragma unroll
    for (int a = 0; a < 2; ++a)
#pragma unroll
        for (int n = 0; n < 2; ++n)
#pragma unroll
            for (int r = 0; r < 16; ++r) { acc[a][n][r] = 0.f; gacc[a][n][r] = 0.f; }
    if (c > 0) {
#pragma unroll
        for (int ks = 0; ks < 4; ++ks) {
            bf16x8 af[2], bfr[2];
#pragma unroll
            for (int mt = 0; mt < 2; ++mt) af[mt] = *(const bf16x8*)(S0 + (32 * mt + c31) * 64 + 16 * ks + 8 * hi);
#pragma unroll
            for (int nt = 0; nt < 2; ++nt) bfr[nt] = *(const bf16x8*)(YT + (32 * nt + c31) * 64 + 16 * ks + 8 * hi);
#pragma unroll
            for (int mt = 0; mt < 2; ++mt)
#pragma unroll
                for (int nt = 0; nt < 2; ++nt) acc[mt][nt] = MFMA32(af[mt], bfr[nt], acc[mt][nt]);
        }
    }
#pragma unroll
    for (int ks = 0; ks < 8; ++ks) {
        bf16x8 af[2], bfr[2];
#pragma unroll
        for (int mt = 0; mt < 2; ++mt) af[mt] = *(const bf16x8*)(gut + (32 * mt + c31) * 128 + 16 * ks + 8 * hi);
#pragma unroll
        for (int nt = 0; nt < 2; ++nt) {
            const int t = 64 * c + 32 * nt + c31, j0 = 16 * ks + 8 * hi; const size_t row = (size_t)b * SEQ + t;
            const u32x4 cu = *(const u32x4*)(rf + row * RW + 1280 + j0);
            u32x4 pv = (u32x4){0u, 0u, 0u, 0u}; if (t > 0) pv = *(const u32x4*)(rf + (row - 1) * RW + 1280 + j0);
            const f32x4 m0 = *(const f32x4*)(mu + 1280 + j0), m1 = *(const f32x4*)(mu + 1280 + j0 + 4);
            float cv[8], pw[8];
            cv[0] = __uint_as_float(cu.x << 16); cv[1] = __uint_as_float(cu.x & 0xffff0000u); cv[2] = __uint_as_float(cu.y << 16); cv[3] = __uint_as_float(cu.y & 0xffff0000u);
            cv[4] = __uint_as_float(cu.z << 16); cv[5] = __uint_as_float(cu.z & 0xffff0000u); cv[6] = __uint_as_float(cu.w << 16); cv[7] = __uint_as_float(cu.w & 0xffff0000u);
            pw[0] = __uint_as_float(pv.x << 16); pw[1] = __uint_as_float(pv.x & 0xffff0000u); pw[2] = __uint_as_float(pv.y << 16); pw[3] = __uint_as_float(pv.y & 0xffff0000u);
            pw[4] = __uint_as_float(pv.z << 16); pw[5] = __uint_as_float(pv.z & 0xffff0000u); pw[6] = __uint_as_float(pv.w << 16); pw[7] = __uint_as_float(pv.w & 0xffff0000u);
            const float mm[8] = {m0.x, m0.y, m0.z, m0.w, m1.x, m1.y, m1.z, m1.w};
            float sg[8];
#pragma unroll
            for (int k = 0; k < 8; ++k) sg[k] = sigm(cv[k] + (pw[k] - cv[k]) * mm[k]);
            u32x4 u; u.x = pk2(sg[0], sg[1]); u.y = pk2(sg[2], sg[3]); u.z = pk2(sg[4], sg[5]); u.w = pk2(sg[6], sg[7]);
            bfr[nt] = __builtin_bit_cast(bf16x8, u);
        }
#pragma unroll
        for (int mt = 0; mt < 2; ++mt)
#pragma unroll
            for (int nt = 0; nt < 2; ++nt) gacc[mt][nt] = MFMA32(af[mt], bfr[nt], gacc[mt][nt]);
    }
    const float* lnw = INF(F, I_LNW) + layer * 384 + h * 64; const float* lnb = INF(F, I_LNB) + layer * 384 + h * 64;
    const float* bonus = (const float*)(F.ws + WS_BONUS);
    bf16_t* mix = (bf16_t*)(F.ws + WS_HM);
#pragma unroll
    for (int nt = 0; nt < 2; ++nt) {
        const int tl = 32 * nt + c31, t = 64 * c + tl; const size_t row = (size_t)b * SEQ + t;
        float s = 0.f;
#pragma unroll
        for (int mt = 0; mt < 2; ++mt)
#pragma unroll
            for (int rq = 0; rq < 4; ++rq) {
                const u32x2 y = *(const u32x2*)(Y0 + tl * 64 + 32 * mt + 8 * rq + 4 * hi);
                acc[mt][nt][4 * rq + 0] += __uint_as_float(y.x << 16); acc[mt][nt][4 * rq + 1] += __uint_as_float(y.x & 0xffff0000u);
                acc[mt][nt][4 * rq + 2] += __uint_as_float(y.y << 16); acc[mt][nt][4 * rq + 3] += __uint_as_float(y.y & 0xffff0000u);
                s += (acc[mt][nt][4 * rq] + acc[mt][nt][4 * rq + 1]) + (acc[mt][nt][4 * rq + 2] + acc[mt][nt][4 * rq + 3]);
            }
        s += shx(s, 32, lane);
        const float mean = s * (1.f / 64.f);
        float vs = 0.f;
#pragma unroll
        for (int mt = 0; mt < 2; ++mt)
#pragma unroll
            for (int r = 0; r < 16; ++r) { const float d = acc[mt][nt][r] - mean; vs += d * d; }
        vs += shx(vs, 32, lane);
        const float rstd = rsqrtf(vs * (1.f / 64.f) + 64e-5f);
        const float bn = bonus[row * 8 + h];
#pragma unroll
        for (int mt = 0; mt < 2; ++mt)
#pragma unroll
            for (int rq = 0; rq < 4; ++rq) {
                const int v0 = 32 * mt + 8 * rq + 4 * hi;
                const u32x2 vc = *(const u32x2*)(rf + row * RW + 768 + h * 64 + v0);
                u32x2 vp = (u32x2){0u, 0u}; if (t > 0) vp = *(const u32x2*)(rf + (row - 1) * RW + 768 + h * 64 + v0);
                const f32x4 mv = *(const f32x4*)(mu + 768 + h * 64 + v0), lw = *(const f32x4*)(lnw + v0), lb = *(const f32x4*)(lnb + v0);
                const float vcur[4] = {__uint_as_float(vc.x << 16), __uint_as_float(vc.x & 0xffff0000u), __uint_as_float(vc.y << 16), __uint_as_float(vc.y & 0xffff0000u)};
                const float vprv[4] = {__uint_as_float(vp.x << 16), __uint_as_float(vp.x & 0xffff0000u), __uint_as_float(vp.y << 16), __uint_as_float(vp.y & 0xffff0000u)};
                const float mvv[4] = {mv.x, mv.y, mv.z, mv.w}, lwv[4] = {lw.x, lw.y, lw.z, lw.w}, lbv[4] = {lb.x, lb.y, lb.z, lb.w};
                float o[4];
#pragma unroll
                for (int k = 0; k < 4; ++k) {
                    const float vsh = vcur[k] + (vprv[k] - vcur[k]) * mvv[k];
                    const float y = (acc[mt][nt][4 * rq + k] - mean) * rstd * lwv[k] + lbv[k];
                    o[k] = (y + bn * vsh) * gacc[mt][nt][4 * rq + k];
                }
                u32x2 ov; ov.x = pk2(o[0], o[1]); ov.y = pk2(o[2], o[3]);
                *(u32x2*)(mix + row * D + 640 + h * 64 + v0) = ov;
            }
    }
}
__device__ __forceinline__ void mixnorm_rows(Frame& F, int layer, int m0, int nrows) {
    bf16_t* mix = (bf16_t*)(F.ws + WS_HM);
    const float* gn = INF(F, I_NNSA) + layer * 384; const float* gm = INF(F, I_NMOBA) + layer * 256;
    const int lane = F.lane;
    for (int m = m0 + F.wave; m < m0 + nrows; m += NWAVES) {
        unsigned* rowp = (unsigned*)(mix + (size_t)m * D);
        unsigned a[3], c[2]; float sa = 0.f, sc = 0.f;
#pragma unroll
        for (int j = 0; j < 3; ++j) { a[j] = rowp[lane + 64 * j]; const float x = __uint_as_float(a[j] << 16), y = __uint_as_float(a[j] & 0xffff0000u); sa += x * x + y * y; }
#pragma unroll
        for (int j = 0; j < 2; ++j) { c[j] = rowp[192 + lane + 64 * j]; const float x = __uint_as_float(c[j] << 16), y = __uint_as_float(c[j] & 0xffff0000u); sc += x * x + y * y; }
        const float ra = rsqrtf(wave_sum(sa, lane) * (1.f / 384.f) + NORM_EPS), rc = rsqrtf(wave_sum(sc, lane) * (1.f / 256.f) + NORM_EPS);
#pragma unroll
        for (int j = 0; j < 3; ++j) { const int col = 2 * (lane + 64 * j); rowp[lane + 64 * j] = pk2(__uint_as_float(a[j] << 16) * ra * gn[col], __uint_as_float(a[j] & 0xffff0000u) * ra * gn[col + 1]); }
#pragma unroll
        for (int j = 0; j < 2; ++j) { const int col = 2 * (lane + 64 * j); rowp[192 + lane + 64 * j] = pk2(__uint_as_float(c[j] << 16) * rc * gm[col], __uint_as_float(c[j] & 0xffff0000u) * rc * gm[col + 1]); }
    }
}
__device__ __forceinline__ void phase_e(Frame& F, int layer) {
    const int gw = F.bid * NWAVES + F.wave, NGW = F.G * NWAVES;
    (void)gw; (void)NGW; (void)layer;
}

constexpr int CW_TILE = 1536;
constexpr int CW_R2DONE = 512;
__device__ __forceinline__ void phase_d(Frame& F, int layer, int rep = 0) {
    if (F.bid < 12 && rep == 0) {
        await_count(F, F.ctl + CW_R1DONE + 64 * layer + F.bid, 16u);
        if (F.wave < 2) { r2_wave(F, F.bid * 2 + F.wave);
            __builtin_amdgcn_fence(__ATOMIC_RELEASE, "agent"); asm volatile("s_waitcnt vmcnt(0)" ::: "memory");
            if (F.lane == 0) (void)__hip_atomic_fetch_add(F.ctl + CW_R2DONE + 64 * layer, 1u, RLX_AGENT); }
        __syncthreads();
#if DBG_MODE == 4
        if (F.bid == 0 && layer == 0) __hip_atomic_store(F.ctl + 3200 + 30, (unsigned)__builtin_amdgcn_s_memrealtime(), RLX_AGENT);
#endif
    }
    LAUNDER(F);
    await_count(F, F.ctl + CW_PREP + 64 * layer, 64u);
    LAUNDER(F);
    volatile LAS int* tw = (volatile LAS int*)(F.lds + AT_MISC);
    unsigned* qh = F.ctl + CW_Q + 64 * layer + 16 * rep;
    const int ntask = (rep == 0) ? 512 + 192 + 128 : 512;
    for (;;) {
        if (F.tid == 0) tw[0] = (int)__hip_atomic_fetch_add(qh, 1u, RLX_AGENT);
        __syncthreads();
        const int k = __builtin_amdgcn_readfirstlane(tw[0]);
        __syncthreads();
        if (k >= ntask) break;
        LAUNDER(F);
        if (k >= 512 + 192) {
            const int tile = k - (512 + 192);
            await_count(F, F.ctl + CW_TILE + 128 * layer + tile, 6u);
            mixnorm_rows(F, layer, tile * 128, 128);
            continue;
        }
        if (k >= 512) {
            if (F.tid == 0) { unsigned sp = 0; while ((unsigned)__builtin_amdgcn_readfirstlane(__hip_atomic_load(F.ctl + CW_R2DONE + 64 * layer, RLX_AGENT)) < 24u) { __builtin_amdgcn_s_sleep(4); if (++sp > (1u << 24)) break; }
                __builtin_amdgcn_fence(__ATOMIC_ACQUIRE, "agent"); asm volatile("s_waitcnt vmcnt(0)" ::: "memory"); }
            __syncthreads();
            r3_task(F, layer, (k - 512) * 8 + F.wave);
            continue;
        }
        const int code = g_tasks.v[k], ty = code >> 9, mm = (code >> 6) & 7, jj = code & 63;
        if (ty == 0) nsa_task(F, mm >> 1, mm & 1, jj); else moba_task(F, mm >> 2, mm & 3, jj);
        if (rep == 0) {
            asm volatile("s_waitcnt vmcnt(0)" ::: "memory"); __syncthreads();
            if (F.tid == 0) { __builtin_amdgcn_fence(__ATOMIC_RELEASE, "agent"); asm volatile("s_waitcnt vmcnt(0)" ::: "memory");
                unsigned* tc = F.ctl + CW_TILE + 128 * layer;
                if (ty == 0) (void)__hip_atomic_fetch_add(tc + (mm >> 1) * 64 + jj, 1u, RLX_AGENT);
                else { (void)__hip_atomic_fetch_add(tc + (mm >> 2) * 64 + 2 * jj, 1u, RLX_AGENT); (void)__hip_atomic_fetch_add(tc + (mm >> 2) * 64 + 2 * jj + 1, 1u, RLX_AGENT); } }
        }
    }
}

__device__ __forceinline__ void phase_g1(Frame& F, int layer) {
    LAS float* wr = (LAS float*)F.lds;
    { const float* W = INF(F, I_WROUTER);
#pragma unroll 1
      for (int i0 = 0; i0 < 4096; i0 += 2048) { f32x4 t4[4];
#pragma unroll
          for (int u = 0; u < 4; ++u) t4[u] = *(const f32x4*)(W + 4 * (i0 + u * NTHR + F.tid));
#pragma unroll
          for (int u = 0; u < 4; ++u) { const int i = 4 * (i0 + u * NTHR + F.tid), k = i >> 4, e = i & 15;
              wr[e * 1028 + k] = t4[u].x; wr[(e + 1) * 1028 + k] = t4[u].y; wr[(e + 2) * 1028 + k] = t4[u].z; wr[(e + 3) * 1028 + k] = t4[u].w; } } }
    __syncthreads();
    const float* mod = (const float*)(F.ws + WS_MOD);
    bf16_t* H = (bf16_t*)(F.ws + WS_HM);
    unsigned* cnt = F.ctl + CW_CNT + 64 * layer;
    const float* rb = INF(F, I_RBIAS);
    const float* gn = INF(F, I_NFFN) + layer * D;
    const int gw = F.bid * NWAVES + F.wave, NGW = F.G * NWAVES;
    const bf16_t* res = (const bf16_t*)(F.ws + WS_RES);
    u32x2 vnext[4];
#pragma unroll
    for (int j = 0; j < 4; ++j) vnext[j] = *(const u32x2*)(res + (size_t)gw * D + 4 * F.lane + 256 * j);
    int px = 0, pm = 0; float pw = 0.f; int ridx = 0;
    for (int m = gw; m < T; m += NGW, ++ridx) {
        int lane = F.lane; asm volatile("" : "+v"(lane));
        const int b = m >> 13;
        const float* sh = mod + ((size_t)layer * BATCH + b) * 6144 + 3072; const float* sc = sh + 1024;
        f32x4 v[4]; float ss = 0.f;
#pragma unroll
        for (int j = 0; j < 4; ++j) { const u32x2 t2 = vnext[j]; v[j] = (f32x4){__uint_as_float(t2.x << 16), __uint_as_float(t2.x & 0xffff0000u), __uint_as_float(t2.y << 16), __uint_as_float(t2.y & 0xffff0000u)};
            ss += (v[j].x * v[j].x + v[j].y * v[j].y) + (v[j].z * v[j].z + v[j].w * v[j].w); }
        const float rstd = rsqrtf(wave_sum(ss, lane) * (1.f / D) + NORM_EPS);
        float lg[16]; f32x2_t lgp[16];
#pragma unroll
        for (int e = 0; e < 16; ++e) lgp[e] = (f32x2_t){0.f, 0.f};
#pragma unroll
        for (int j = 0; j < 4; ++j) { const int col = 4 * lane + 256 * j;
            const f32x4 g = *(const f32x4*)(gn + col), s1 = *(const f32x4*)(sc + col), s0 = *(const f32x4*)(sh + col);
            const float hx = v[j].x * rstd * g.x * (1.f + s1.x) + s0.x, hy = v[j].y * rstd * g.y * (1.f + s1.y) + s0.y, hz = v[j].z * rstd * g.z * (1.f + s1.z) + s0.z, hw = v[j].w * rstd * g.w * (1.f + s1.w) + s0.w;
            u32x2 o; o.x = pk2(hx, hy); o.y = pk2(hz, hw); *(u32x2*)(H + (size_t)m * D + col) = o;
            const f32x2_t h01 = {hx, hy}, h23 = {hz, hw};
#pragma unroll
            for (int e = 0; e < 16; ++e) { const f32x4 w4 = *(const LAS f32x4*)(wr + e * 1028 + col);
                lgp[e] = __builtin_elementwise_fma(h01, (f32x2_t){w4.x, w4.y}, lgp[e]); lgp[e] = __builtin_elementwise_fma(h23, (f32x2_t){w4.z, w4.w}, lgp[e]); }
        }
#pragma unroll
        for (int e = 0; e < 16; ++e) lg[e] = lgp[e].x + lgp[e].y;
        { const int mn = (m + NGW < T) ? m + NGW : m;
#pragma unroll
          for (int j = 0; j < 4; ++j) vnext[j] = *(const u32x2*)(res + (size_t)mn * D + 4 * lane + 256 * j); }
        float r8[8], r4[4], r2[2], r1;
#pragma unroll
        for (int e = 0; e < 8; ++e) { auto sw = __builtin_amdgcn_permlane32_swap(__float_as_uint(lg[e]), __float_as_uint(lg[e + 8]), false, false); r8[e] = __uint_as_float(sw[0]) + __uint_as_float(sw[1]); }
#pragma unroll
        for (int e = 0; e < 4; ++e) { auto sw = __builtin_amdgcn_permlane16_swap(__float_as_uint(r8[e]), __float_as_uint(r8[e + 4]), false, false); r4[e] = __uint_as_float(sw[0]) + __uint_as_float(sw[1]); }
        { const bool up = (lane & 8) != 0;
#pragma unroll
          for (int e = 0; e < 2; ++e) { const float keep = up ? r4[e + 2] : r4[e], send = up ? r4[e] : r4[e + 2]; r2[e] = keep + dpp_mov<0x140>(send); } }
        { const bool up = (lane & 4) != 0; const float keep = up ? r2[1] : r2[0], send = up ? r2[0] : r2[1]; r1 = keep + dpp_mov<0x141>(send); }
        r1 += dpp_mov<0x4E>(r1); r1 += dpp_mov<0xB1>(r1);
        const int el = (((lane >> 5) & 1) << 3) | (((lane >> 4) & 1) << 2) | (((lane >> 3) & 1) << 1) | ((lane >> 2) & 1);
        const float affl = sigm(r1), bial = affl + rb[el];
        float aff[16], bia[16];
#pragma unroll
        for (int e = 0; e < 16; ++e) { const int src = ((e & 8) ? 32 : 0) | ((e & 4) ? 16 : 0) | ((e & 2) ? 8 : 0) | ((e & 1) ? 4 : 0);
            aff[e] = __uint_as_float(__builtin_amdgcn_readlane(__float_as_uint(affl), src)); bia[e] = __uint_as_float(__builtin_amdgcn_readlane(__float_as_uint(bial), src)); }
        int best = 0; float bscore = -INFINITY;
#pragma unroll
        for (int g = 0; g < 4; ++g) {
            float t1 = -INFINITY, t2 = -INFINITY;
#pragma unroll
            for (int k = 0; k < 4; ++k) { const float x = bia[4 * g + k]; if (x > t1) { t2 = t1; t1 = x; } else if (x > t2) t2 = x; }
            const float gs = t1 + t2; if (gs > bscore) { bscore = gs; best = g; }
        }
        float x4[4], a4[4];
#pragma unroll
        for (int k = 0; k < 4; ++k) { x4[k] = (best == 0) ? bia[k] : (best == 1) ? bia[4 + k] : (best == 2) ? bia[8 + k] : bia[12 + k]; a4[k] = (best == 0) ? aff[k] : (best == 1) ? aff[4 + k] : (best == 2) ? aff[8 + k] : aff[12 + k]; }
        int i1 = 0; float v1 = x4[0];
#pragma unroll
        for (int k = 1; k < 4; ++k) if (x4[k] > v1) { v1 = x4[k]; i1 = k; }
        int i2 = -1; float v2 = -INFINITY;
#pragma unroll
        for (int k = 0; k < 4; ++k) if (k != i1 && x4[k] > v2) { v2 = x4[k]; i2 = k; }
        float w1 = 0.f, w2 = 0.f;
#pragma unroll
        for (int k = 0; k < 4; ++k) { if (k == i1) w1 = a4[k]; if (k == i2) w2 = a4[k]; }
        const float ws = w1 + w2; w1 /= ws; w2 /= ws;
        if (lane == 2 * ridx) { px = 4 * best + i1; pm = m; pw = w1; }
        if (lane == 2 * ridx + 1) { px = 4 * best + i2; pm = m; pw = w2; }
    }
    LAUNDER(F);
    {
        const int lane = F.lane; const int np = 2 * ridx;
        int rank = 0, total = 0, leader = 64;
        for (int j = 0; j < np; ++j) { const int xj = __builtin_amdgcn_readlane(px, j); const bool same = (xj == px); rank += (same && j < lane) ? 1 : 0; total += same ? 1 : 0; leader = (same && j < leader) ? j : leader; }
        int base = 0;
        if (lane < np && rank == 0) base = (int)__hip_atomic_fetch_add(cnt + px, (unsigned)total, RLX_AGENT);
        base = __builtin_amdgcn_ds_bpermute((leader & 63) << 2, base);
        if (lane < np) { const int idx = px * 16384 + base + rank; ((int*)(F.ws + WS_ELIST))[idx] = 2 * pm + (lane & 1); ((float*)(F.ws + WS_EWW))[idx] = pw; }
    }
    asm volatile("s_waitcnt vmcnt(0)" ::: "memory"); __syncthreads();
    if (F.wave == 0) {
        unsigned tk = 0;
        if (F.lane == 0) { __builtin_amdgcn_fence(__ATOMIC_RELEASE, "agent"); asm volatile("s_waitcnt vmcnt(0)" ::: "memory"); tk = __hip_atomic_fetch_add(cnt + 32, 1u, RLX_AGENT); }
        tk = (unsigned)__builtin_amdgcn_readfirstlane((int)tk);
        if (tk == (unsigned)F.G - 1u) {
            __builtin_amdgcn_fence(__ATOMIC_ACQUIRE, "agent");
            const int lane = F.lane;
            int* tile_e = (int*)(F.ws + WS_ROWINFO + layer * ROWINFO_LSTRIDE) + 2 * MAXROWS;
            const int c = (lane < 16) ? (int)__hip_atomic_load(cnt + (lane & 15), RLX_AGENT) : 0, nt = (c + 255) >> 8;
            int ofs = 0, tot = 0;
            for (int e = 0; e < 16; ++e) { const int ne = __builtin_amdgcn_readlane(nt, e) << 8; ofs += (e < lane) ? ne : 0; tot += ne; }
            if (lane < 16) { tile_e[TE_OFF + lane] = ofs; tile_e[TE_CNT + lane] = c; for (int j = 0; j < nt; ++j) tile_e[(ofs >> 8) + j] = lane; }
            if (lane == 0) tile_e[256] = tot >> 8;
        }
    }
}
__device__ __forceinline__ void phase_g2(Frame& F, int layer) {
    volatile LAS int* off = (volatile LAS int*)F.lds;
    unsigned* cnt = F.ctl + CW_CNT + 64 * layer;
    int* rowinfo = (int*)(F.ws + WS_ROWINFO + layer * ROWINFO_LSTRIDE); float* roww = (float*)(rowinfo + MAXROWS); int* tile_e = rowinfo + 2 * MAXROWS; int* ntl = tile_e + 256;
    if (F.tid == 0) { int o = 0; for (int e = 0; e < 16; ++e) { off[e] = o; const int c = (int)__hip_atomic_load(cnt + e, RLX_AGENT); o += ((c + 255) >> 8) << 8; } off[16] = o; }
    __syncthreads();
    if (F.bid == 0) {
        if (F.tid == 0) ntl[0] = off[16] >> 8;
        for (int e = 0; e < 16; ++e) {
            const int c = (int)__hip_atomic_load(cnt + e, RLX_AGENT), o0 = off[e], o1 = off[e + 1];
            for (int r = o0 + c + F.tid; r < o1; r += NTHR) { rowinfo[r] = -1; roww[r] = 0.f; }
            for (int tl = (o0 >> 8) + F.tid; tl < (o1 >> 8); tl += NTHR) tile_e[tl] = e;
        }
    }
    const int* route = (const int*)(F.ws + WS_ROUTE);
    const int gw = F.bid * NWAVES + F.wave, NGW = F.G * NWAVES, lane = F.lane;
    for (int m = gw; m < T; m += NGW) {
        const int* rp = route + (size_t)m * 8;
        const int e1 = ld_ctl(rp), e2 = ld_ctl(rp + 1), p1 = ld_ctl(rp + 2), p2 = ld_ctl(rp + 3);
        const int r1 = off[e1] + p1, r2 = off[e2] + p2;
        if (lane == 0) { rowinfo[r1] = 2 * m; rowinfo[r2] = 2 * m + 1; roww[r1] = __int_as_float(ld_ctl(rp + 4)); roww[r2] = __int_as_float(ld_ctl(rp + 5)); }
    }
}

#if DBG_MODE == 2
__device__ __forceinline__ void dbg_flag(Frame& F, bool bad, unsigned code) { if (__any(bad) && F.lane == 0) atomicCAS(F.ctl + CW_DBG, 0u, code); }
__device__ __forceinline__ void scan_bf16(Frame& F, size_t off, size_t n, unsigned code) {
    const unsigned* p = (const unsigned*)(F.ws + off); bool bad = false;
    for (size_t i = (size_t)F.bid * NTHR + F.tid; i < n / 2; i += (size_t)F.G * NTHR) { const unsigned u = p[i]; bad = bad || ((u & 0x7f80u) == 0x7f80u) || ((u & 0x7f800000u) == 0x7f800000u); }
    dbg_flag(F, bad, code); }
__device__ __forceinline__ void scan_f32p(Frame& F, const float* p, size_t n, unsigned code) {
    bool bad = false;
    for (size_t i = (size_t)F.bid * NTHR + F.tid; i < n; i += (size_t)F.G * NTHR) { const unsigned u = __float_as_uint(p[i]); bad = bad || ((u & 0x7f800000u) == 0x7f800000u); }
    dbg_flag(F, bad, code); }
__device__ __forceinline__ void dbg_check(Frame& F, int p) {
    const unsigned code = (unsigned)(p + 1);
    if (DBG_SUB >= 4) {
        if (p != DBG_P) return;
        const size_t off = (DBG_SUB == 4) ? WS_ZS : (DBG_SUB == 5) ? WS_PT : (DBG_SUB == 6) ? WS_YT : WS_Y0;
        const unsigned* q = (const unsigned*)(F.ws + off); unsigned mx = 0;
        for (size_t i = (size_t)F.bid * NTHR + F.tid; i < (size_t)1536 * 2048; i += (size_t)F.G * NTHR) { const unsigned u = q[i]; const unsigned e0 = (u >> 7) & 0xffu, e1 = (u >> 23) & 0xffu; mx = mx > e0 ? mx : e0; mx = mx > e1 ? mx : e1; }
#if DBG_CNT
        { unsigned cnt = 0; for (size_t i = (size_t)F.bid * NTHR + F.tid; i < (size_t)1536 * 2048; i += (size_t)F.G * NTHR) { const unsigned u = q[i]; cnt += (((u >> 7) & 0xffu) == 0xffu) + (((u >> 23) & 0xffu) == 0xffu); }
          if (cnt) atomicAdd(F.ctl + CW_DBG, cnt); return; }
#endif
        atomicMax(F.ctl + CW_DBG, mx); return; }
    if (DBG_SUB == 3 && p != 4) return;
    if (p == 0) { scan_f32p(F, (const float*)(F.ws + WS_COS), (size_t)T * 64, code); scan_f32p(F, (const float*)(F.ws + WS_MOD), 2 * 2 * 6144, code); return; }
    if (p > 10 * NL) return;
    const int sub = (p - 1) % 10;
    switch (sub) {
    case 0: scan_bf16(F, WS_HM, (size_t)T * D, code); scan_bf16(F, WS_WIN, (size_t)NPAD * D, code); scan_bf16(F, WS_WOUT, (size_t)D * D, code); scan_bf16(F, WS_WUP, (size_t)16 * 512 * D, code);
            scan_bf16(F, WS_WDN, (size_t)16 * D * 256, code); scan_bf16(F, WS_PHIW, (size_t)2 * 64 * 2048, code); scan_bf16(F, WS_GUPT, 384 * 128, code); scan_f32p(F, (const float*)(F.ws + WS_PHIB), 256, code); break;
    case 1: scan_bf16(F, WS_NQ, (size_t)T * 384, code); scan_bf16(F, WS_KV6, (size_t)6 * T * 128, code); scan_bf16(F, WS_MQKV, (size_t)3 * T * 256, code); scan_bf16(F, WS_RFEAT, (size_t)T * RW, code);
            scan_f32p(F, (const float*)(F.ws + WS_GATE), (size_t)T * 32, code); break;
    case 2: scan_bf16(F, WS_KCMP, 2 * 2 * 512 * 64, code); scan_bf16(F, WS_VCMP, 2 * 2 * 512 * 64, code); scan_bf16(F, WS_KMEAN, 2 * 4 * 32 * 64, code);
            scan_bf16(F, WS_PT, (size_t)1536 * 4096, code); scan_bf16(F, WS_ZS, (size_t)1536 * 4096, code); scan_bf16(F, WS_YT, (size_t)1536 * 4096, code); scan_bf16(F, WS_Y0, (size_t)1536 * 4096, code);
            scan_f32p(F, (const float*)(F.ws + WS_BONUS), (size_t)T * 8, code); break;
    case 3: {
#if DBG_SUB == 3
        if (p == 4) { const unsigned* hm = (const unsigned*)(F.ws + WS_HM); bool b1 = false, b2 = false, b4 = false;
            for (size_t i = (size_t)F.bid * NTHR + F.tid; i < (size_t)T * 512; i += (size_t)F.G * NTHR) { const unsigned u = hm[i]; const int col = (int)(i & 511) * 2; const bool bad = ((u & 0x7f80u) == 0x7f80u) || ((u & 0x7f800000u) == 0x7f800000u);
                if (col < 384) b1 = b1 || bad; else if (col < 640) b2 = b2 || bad; }
            const unsigned* zs = (const unsigned*)(F.ws + WS_ZS);
            for (size_t i = (size_t)F.bid * NTHR + F.tid; i < (size_t)1536 * 2048; i += (size_t)F.G * NTHR) { const unsigned u = zs[i]; b4 = b4 || ((u & 0x7f80u) == 0x7f80u) || ((u & 0x7f800000u) == 0x7f800000u); }
            const unsigned bits = (__any(b1) ? 1u : 0u) | (__any(b2) ? 2u : 0u) | (__any(b4) ? 4u : 0u);
            if (bits && F.lane == 0) atomicOr(F.ctl + CW_DBG, bits); }
#else
        scan_bf16(F, WS_HM, (size_t)T * D, code); scan_bf16(F, WS_ZS, (size_t)1536 * 4096, code);
#endif
        } break;
    case 4: scan_bf16(F, WS_HM, (size_t)T * D, code); break;
    case 5: scan_f32p(F, F.out, (size_t)T * D, code); break;
    case 6: scan_bf16(F, WS_HM, (size_t)T * D, code); break;
    case 7: scan_bf16(F, WS_SORTA, (size_t)MAXROWS * D, code); break;
    case 8: scan_bf16(F, WS_HID, (size_t)MAXROWS * 256, code); break;
    case 9: scan_bf16(F, WS_YS, (size_t)2 * T * D, code); break;
    }
}
#endif
struct Args { const void* in[31]; float* out; unsigned char* ws; int ph_lo, ph_hi; };
constexpr int N_PHASES = 2 + 10 * NL + (DBG_MODE ? 1 : 0);

__global__ void __launch_bounds__(NTHR, 2) hybrid_fwd(Args args) {
    extern __shared__ __attribute__((aligned(16))) unsigned char lds_raw[];
    Frame F;
    F.lds = (LAS unsigned char*)lds_raw;
    F.MISC = (volatile LAS unsigned*)(F.lds + MISC_OFF);
    F.tid = threadIdx.x; F.lane = F.tid & 63; F.wave = __builtin_amdgcn_readfirstlane(F.tid >> 6);
    F.G = gridDim.x; F.bid = blockIdx.x;
    F.ws = (unsigned char*)(GAS unsigned char*)args.ws; F.out = (float*)(GAS float*)args.out; F.ctl = (unsigned*)(GAS unsigned*)(args.ws + WS_CTL);
    for (int u = F.tid; u < (LDS_BYTES - RING_BYTES) / 4; u += NTHR) ((LAS unsigned*)(F.lds + RING_BYTES))[u] = 0u;
    __syncthreads();
    if (F.tid < 31) *(LAS unsigned long long*)(F.lds + IN_OFF + 8 * F.tid) = (unsigned long long)args.in[F.tid];
    __syncthreads();
#if MK_PER_PHASE
#define GRID_BAR() do { } while (0)
#else
    XcdBarrier bar = xcd_barrier_post(F.ctl + CW_BAR, F.MISC + 8);
#define GRID_BAR() do { LAUNDER(F); xcd_barrier(bar, F.tid); } while (0)
#endif
    const int lo = args.ph_lo, hi = args.ph_hi;
    for (int ph_ = lo; ph_ < hi; ++ph_) {
        int ph = ph_; asm volatile("" : "+s"(ph));
#if DBG_MODE == 2
        if (ph > 0) { LAUNDER(F); dbg_check(F, ph - 1); }
#endif
#if DBG_MODE == 4
        if (blockIdx.x == 0) { const unsigned tnow = (unsigned)__builtin_amdgcn_s_memrealtime(); __hip_atomic_store((unsigned*)(args.ws + WS_CTL) + 3200 + ph_, tnow, RLX_AGENT); }
#endif
        for (int rep = 0; rep < ((REPEAT_PH >= 0 && ph_ == REPEAT_PH) ? 2 : 1); ++rep) {
        if (rep) GRID_BAR();
        if (ph == 0) { if (PH_EN(10)) { LAUNDER(F); phase_pro(F); LAUNDER(F); phase_a(F, 0, false, true); } }
#if DBG_MODE
        else if (ph == N_PHASES - 1) { LAUNDER(F);
#if DBG_MODE == 4
            const float dv = 100.f * floorf(4.f * log2f((float)(unsigned)(ld_ctl((const int*)(F.ctl + 3200 + DBG_TPH1)) - ld_ctl((const int*)(F.ctl + 3200 + DBG_TPH0)))) + DBG_QOFF);
            const float dv2 = 10000.f * floorf(4.f * log2f((float)(unsigned)(ld_ctl((const int*)(F.ctl + 3200 + DBG_TPH3)) - ld_ctl((const int*)(F.ctl + 3200 + DBG_TPH2)))) + DBG_QOFF);
            for (int i = F.bid * NTHR + F.tid; i < T * D; i += F.G * NTHR) F.out[i] = (i == 0) ? dv2 : dv;
            if (0)
#else
            const float dv = sqrtf((float)ld_ctl((const int*)(F.ctl + CW_DBG)));
#endif
            for (int i = F.bid * NTHR + F.tid; i < T * D; i += F.G * NTHR) F.out[i] = dv; }
        else if (ph == N_PHASES - 2) { if (PH_EN(11)) { LAUNDER(F); norm_rows(F, 0, true); } }
#else
        else if (ph == N_PHASES - 1) { if (PH_EN(11)) { LAUNDER(F); norm_rows(F, 0, true); } }
#endif
        else {
            const int layer = (ph - 1) / 10, sub = (ph - 1) % 10;
            switch (sub) {
            case 0: if (PH_EN(0)) { LAUNDER(F); phase_a(F, layer, true, layer > 0); } break;
            case 1: if (PH_EN(1)) { LAUNDER(F); pg8::Gemm g{(const bf16_t*)(F.ws + WS_HM), (const bf16_t*)(F.ws + WS_WIN), T, NPAD, D}; pg8::StaticOrder S; S.init(T, NPAD, F.G, F.bid, NPAD / 256 - 1);
                      EpiInProj E{(bf16_t*)(F.ws + WS_NQ), (bf16_t*)(F.ws + WS_KV6), (bf16_t*)(F.ws + WS_MQKV), (bf16_t*)(F.ws + WS_RFEAT), (float*)(F.ws + WS_GATE), (const float*)(F.ws + WS_COS), (const float*)(F.ws + WS_SIN)};
                      if (rep == 0) pg8::gemm_phase<EpiInProj, pg8::StaticOrder, true, true>(F.lds, g, S, E, F.tid);
                      else { EpiNull EN{(float*)(F.ws + WS_GATE)}; pg8::gemm_phase<EpiNull, pg8::StaticOrder, true, true>(F.lds, g, S, EN, F.tid); } } break;
            case 2: if (PH_EN(2)) { LAUNDER(F); phase_c(F, layer); LAUNDER(F); phase_d(F, layer, rep); } break;
            case 3: break;
            case 4: if (PH_EN(4)) { LAUNDER(F); phase_e(F, layer); } break;
            case 5: if (PH_EN(5)) { LAUNDER(F); pg8::Gemm g{(const bf16_t*)(F.ws + WS_HM), (const bf16_t*)(F.ws + WS_WOUT), T, D, D}; pg8::StaticOrder S; S.init(T, D, F.G, F.bid);
                      const float* g1p = (const float*)(F.ws + WS_MOD) + (size_t)layer * BATCH * 6144 + 2048;
                      if (layer == 0) { EpiOutProjT<true> E{INF(F, I_X), (const bf16_t*)F.out, (bf16_t*)(F.ws + WS_RES), g1p}; pg8::gemm_phase<EpiOutProjT<true>, pg8::StaticOrder, true, true>(F.lds, g, S, E, F.tid); }
                      else { EpiOutProjT<false> E{(const float*)nullptr, (const bf16_t*)F.out, (bf16_t*)(F.ws + WS_RES), g1p}; pg8::gemm_phase<EpiOutProjT<false>, pg8::StaticOrder, true, true>(F.lds, g, S, E, F.tid); } } break;
            case 6: if (PH_EN(6)) { LAUNDER(F); phase_g1(F, layer); } break;
            case 7: break;
            case 8: if (PH_EN(8)) { LAUNDER(F); const int* rowinfo = (const int*)(F.ws + WS_ROWINFO + layer * ROWINFO_LSTRIDE); const int* tile_e = rowinfo + 2 * MAXROWS;
                      const int ntl = __builtin_amdgcn_readfirstlane(ld_ctl(tile_e + 256));
                      pg8::Gemm g{(const bf16_t*)(F.ws + WS_HM), (const bf16_t*)(F.ws + WS_WUP), MAXROWS, 512, D};
                      MoeGatherOrder S{ntl, 2, F.G, F.bid, tile_e, (size_t)512 * D * 2, (const int*)(F.ws + WS_ELIST)};
                      EpiMoeUp E{(bf16_t*)(F.ws + WS_HID)};
                      pg8::gemm_phase<EpiMoeUp, MoeGatherOrder, true, true>(F.lds, g, S, E, F.tid); } break;
            case 9: if (PH_EN(9)) { LAUNDER(F); const int* rowinfo = (const int*)(F.ws + WS_ROWINFO + layer * ROWINFO_LSTRIDE); const int* tile_e = rowinfo + 2 * MAXROWS;
                      const int ntl = __builtin_amdgcn_readfirstlane(ld_ctl(tile_e + 256));
                      pg8::Gemm g{(const bf16_t*)(F.ws + WS_HID), (const bf16_t*)(F.ws + WS_WDN), MAXROWS, D, 256};
                      MoeOrder S{ntl, 4, F.G, F.bid, tile_e, (size_t)D * 256 * 2, (const int*)(F.ws + WS_ELIST)};
                      EpiMoeDown E{(bf16_t*)(F.ws + WS_YS), tile_e, (const int*)(F.ws + WS_ELIST), (const float*)(F.ws + WS_EWW)};
                      pg8::gemm_phase<EpiMoeDown, MoeOrder, true, true>(F.lds, g, S, E, F.tid); } break;
            }
        }
        }
#if EXTRA_BAR
        if (ph_ == 0) { for (int eb = 0; eb < EXTRA_BAR; ++eb) GRID_BAR(); }
#endif
        if (ph_ + 1 < hi && !(ph_ >= 1 && ph_ <= 10 * NL && (((ph_ - 1) % 10) == 2 || ((ph_ - 1) % 10) == 3 || ((ph_ - 1) % 10) == 7))) GRID_BAR();
    }
}

extern "C" void kernel_launch(void* const* d_in, const int* in_sizes, int n_in, void* d_out, int out_size, void* d_ws, size_t ws_size, hipStream_t stream) {
    static int grid = 0;
    if (grid == 0) {
        if (n_in != 31 || out_size != T * D || ws_size < WS_END) { fprintf(stderr, "kernel_launch: unexpected shapes: n_in %d out %d ws %zu (need %zu)\n", n_in, out_size, ws_size, (size_t)WS_END); grid = -1; return; }
        int dev = 0, cus = 0, per_cu = 0;
        if (hipGetDevice(&dev) != hipSuccess || hipDeviceGetAttribute(&cus, hipDeviceAttributeMultiprocessorCount, dev) != hipSuccess) { grid = -1; return; }
        if (hipFuncSetAttribute((const void*)hybrid_fwd, hipFuncAttributeMaxDynamicSharedMemorySize, LDS_BYTES) != hipSuccess) { fprintf(stderr, "kernel_launch: hipFuncSetAttribute failed\n"); grid = -1; return; }
        if (hipOccupancyMaxActiveBlocksPerMultiprocessor(&per_cu, (const void*)hybrid_fwd, NTHR, LDS_BYTES) != hipSuccess || per_cu < 1) fprintf(stderr, "kernel_launch: occupancy query says %d\n", per_cu);
        (void)hipGetLastError();
        grid = cus;
    }
    if (grid < 0) return;
    (void)hipMemsetAsync((char*)d_ws + WS_CTL, 0, CTL_ZERO_BYTES, stream);
    Args a{};
    for (int i = 0; i < 31; ++i) a.in[i] = d_in[i];
    a.out = (float*)d_out; a.ws = (unsigned char*)d_ws;
#if MK_PER_PHASE
    for (int ph = 0; ph < N_PHASES; ++ph) { a.ph_lo = ph; a.ph_hi = ph + 1; hipLaunchKernelGGL(hybrid_fwd, dim3(grid), dim3(NTHR), LDS_BYTES, stream, a); }
#else
    a.ph_lo = 0; a.ph_hi = N_PHASES;
    hipLaunchKernelGGL(hybrid_fwd, dim3(grid), dim3(NTHR), LDS_BYTES, stream, a);
#endif
}
```

```cpp
#include <hip/hip_runtime.h>
#include <cstdio>
#include <cstdint>
#include <cmath>
#ifndef PH_MASK
#define PH_MASK 0xfff
#endif
#define PH_EN(k) ((PH_MASK >> (k)) & 1)
#ifndef MK_PER_PHASE
#define MK_PER_PHASE 0
#endif
namespace pg8 {
#define PG8_LAS __attribute__((address_space(3)))
typedef unsigned short bf16_t;
typedef short bf16x8 __attribute__((ext_vector_type(8)));
typedef float f32x4 __attribute__((ext_vector_type(4)));
typedef unsigned u32x4 __attribute__((ext_vector_type(4)));
constexpr int BM = 256, BK = 64, HALF = 128, HTB = HALF * BK * 2  , STAGE_BYTES = 8 * HTB, NXCD = 8, WGM = 8;

__host__ __device__ __forceinline__ int lds_byte(int r, int c) { const int st = (r >> 4) * 2 + (c >> 5), rr = r & 15, cc = c & 31, ob = rr * 64 + cc * 2; return st * 1024 + (ob ^ (((ob >> 9) & 1) << 5)); }
__host__ __device__ __forceinline__ void stage_rc(int b, int& R, int& C) { const int st = b / 1024, sb = b % 1024, swz = sb ^ (((sb >> 9) & 1) << 5); R = (st >> 1) * 16 + swz / 64; C = (st & 1) * 32 + (swz % 64) / 2; }
__host__ __device__ __forceinline__ int perm32(int rho) { const int n = rho >> 4, i = rho & 15; return 8 * (i >> 2) + 4 * n + (i & 3); }

struct Unit { int pm, pn, mask; };
struct Gemm { const bf16_t* A; const bf16_t* Bt; int M, N, K; };

__host__ __device__ __forceinline__ bool tail_split(int i, int G, int c, int total, int& L, int& f, int& sub) {
    const int rounds = total / G, nfull = rounds * G, ntail = total - nfull; f = 1; sub = 0;
    if (i < rounds) { L = i * G + c; return true; }
    if (i > rounds || ntail == 0) return false;
    f = (4 * ntail <= G) ? 4 : (2 * ntail <= G) ? 2 : 1;
    if (c >= ntail * f) return false;
    L = nfull + c / f; sub = c % f; return true;
}
struct StaticOrder {
    int nM, nN, nwg, G, c, padpn;
    __host__ __device__ void init(int M, int N, int G_, int c_, int padpn_ = -1) { nM = M / BM; nN = N / BM; nwg = nM * nN; G = G_; c = c_; padpn = padpn_; }
    __host__ __device__ bool next(int i, Unit& u) const {
        int L, f, sub; if (!tail_split(i, G, c, nwg, L, f, sub)) return false;
        int wgid = L; { const int q = nwg / NXCD, r = nwg % NXCD, xcd = wgid % NXCD, off = wgid / NXCD; wgid = (xcd < r ? xcd * (q + 1) : r * (q + 1) + (xcd - r) * q) + off; }
        const int nig = WGM * nN, gid = wgid / nig, fm = gid * WGM, gsz = (nM - fm) < WGM ? (nM - fm) : WGM;
        u.pm = fm + ((wgid % nig) % gsz); u.pn = (wgid % nig) / gsz;
        const bool pad = (u.pn == padpn);
        u.mask = (f == 1) ? (pad ? 0x5 : 0xF) : (f == 2) ? (pad ? (sub ? 0x4 : 0x1) : (sub ? 0xA : 0x5)) : ((1 << sub) & (pad ? 0x5 : 0xF));
        return true;
    }
    static constexpr bool GATHER = false;
    __device__ __forceinline__ void arows(const Unit&, const int (&)[2], int (&o)[2][2]) const { o[0][0] = o[0][1] = o[1][0] = o[1][1] = 0; }
    __device__ __forceinline__ void a_ready(const Unit&) const {}
    __device__ __forceinline__ size_t boff(const Unit&) const { return 0; }
    __device__ __forceinline__ void done(const Unit&) const {}
};

template <class Epi, class Sched, bool ALIGN_EPI = false, bool SP2 = false>
__device__ __forceinline__ void gemm_phase(PG8_LAS unsigned char* lds, const Gemm g, const Sched& S, const Epi& E, const int tid_in) {
    const int tid = tid_in, wid = __builtin_amdgcn_readfirstlane(tid >> 6), lane = tid & 63, wr = wid >> 2, wc = wid & 3, fr = lane & 15, fq = lane >> 4;
    const int K = g.K, nt = K / BK;
    unsigned voffA[2], voffB[2];
    int RA[2], CA[2];
    unsigned gA_cur[2][2], gA_nxt[2][2];
    static_assert(!Sched::GATHER || SP2, "row-gathered A is wired into the SP2 loop only");
#pragma unroll
    for (int i = 0; i < 2; ++i) { int R, C; stage_rc(tid * 16 + i * 8192, R, C); const int Rb = Epi::PERM ? ((R & ~31) + perm32(R & 31)) : R;
        voffA[i] = (unsigned)(R * K + C) * 2u; voffB[i] = (unsigned)(Rb * K + C) * 2u; RA[i] = R; CA[i] = C; }
#define PG8_GROWS(u, o) do { int ar_[2][2]; S.arows(u, RA, ar_); _Pragma("unroll") for (int h_ = 0; h_ < 2; ++h_) _Pragma("unroll") for (int i_ = 0; i_ < 2; ++i_) o[h_][i_] = (unsigned)(ar_[h_][i_] * K + CA[i_]) * 2u; } while (0)
    const size_t kstep = (size_t)(BK * 2);
    const size_t hstep = (size_t)HALF * K * 2;
    const size_t tstep = 2 * hstep;
    const unsigned ldsw = (unsigned)wid * 1024u;
    const int aoff = lds_byte(wr * 64 + fr, fq * 8), boff = lds_byte(wc * 32 + fr, fq * 8);
#define PG8_SA(b, h) (((b) * 2 + (h)) * HTB)
#define PG8_SB(b, h) ((4 + (b) * 2 + (h)) * HTB)
#define PG8_STAGE(bufoff, gbase, voff) do { _Pragma("unroll") for (int _i = 0; _i < 2; ++_i) \
        __builtin_amdgcn_global_load_lds((const unsigned*)((const char*)(gbase) + (voff)[_i]), (PG8_LAS unsigned*)(lds + (bufoff) + ldsw + _i * 8192), 16, 0, 0); } while (0)
#define PG8_STAGE_A(bufoff, gbase, half, nx) do { if constexpr (Sched::GATHER) { _Pragma("unroll") for (int _i = 0; _i < 2; ++_i) { const unsigned vo_ = (nx) ? gA_nxt[half][_i] : gA_cur[half][_i]; \
        __builtin_amdgcn_global_load_lds((const unsigned*)((const char*)(gbase) + vo_), (PG8_LAS unsigned*)(lds + (bufoff) + ldsw + _i * 8192), 16, 0, 0); } } else { PG8_STAGE(bufoff, (gbase) + (half) * hstep, voffA); } } while (0)
#define PG8_LDA(dst, b, h) do { _Pragma("unroll") for (int m = 0; m < 4; ++m) _Pragma("unroll") for (int k = 0; k < 2; ++k) dst[m][k] = *(const PG8_LAS bf16x8*)(lds + PG8_SA(b, h) + aoff + m * 2048 + k * 1024); } while (0)
#define PG8_LDB(dst, b, h) do { _Pragma("unroll") for (int n = 0; n < 2; ++n) _Pragma("unroll") for (int k = 0; k < 2; ++k) dst[n][k] = *(const PG8_LAS bf16x8*)(lds + PG8_SB(b, h) + boff + n * 2048 + k * 1024); } while (0)
#define PG8_MMA(ai, bj, At, Bt) do { if (cmask & (1 << ((ai) * 2 + (bj)))) PG8_MMA_(ai, bj, At, Bt); } while (0)
#define PG8_MMA_(ai, bj, At, Bt) do { __builtin_amdgcn_s_setprio(1); _Pragma("unroll") for (int m = 0; m < 4; ++m) _Pragma("unroll") for (int n = 0; n < 2; ++n) _Pragma("unroll") for (int k = 0; k < 2; ++k) \
        acc[ai][bj][m][n] = __builtin_amdgcn_mfma_f32_16x16x32_bf16(Bt[n][k], At[m][k], acc[ai][bj][m][n], 0, 0, 0); __builtin_amdgcn_s_setprio(0); } while (0)
#define PG8_WAIT_V(n) asm volatile("s_waitcnt vmcnt(" #n ")" ::: "memory")
#define PG8_WAIT_L(n) asm volatile("s_waitcnt lgkmcnt(" #n ")" ::: "memory")
#define PG8_BAR __builtin_amdgcn_s_barrier()
#define PG8_SCHED __builtin_amdgcn_sched_barrier(0)
    Unit cur, nxt; int ui = 0;
    if (!S.next(0, cur)) return;
    f32x4 acc[2][2][4][2];
#pragma unroll
    for (int a = 0; a < 2; ++a)
#pragma unroll
        for (int b = 0; b < 2; ++b)
#pragma unroll
            for (int m = 0; m < 4; ++m)
#pragma unroll
                for (int n = 0; n < 2; ++n) acc[a][b][m][n] = (f32x4){0.f, 0.f, 0.f, 0.f};
    bf16x8 At[4][2], B0[2][2], B1[2][2];
    const char* cA = (const char*)g.A + (Sched::GATHER ? (size_t)0 : (size_t)cur.pm * tstep); const char* cB = (const char*)g.Bt + S.boff(cur) + (size_t)cur.pn * tstep;
    S.a_ready(cur);
    if constexpr (Sched::GATHER) { PG8_GROWS(cur, gA_cur); }
    if constexpr (SP2) {
        PG8_STAGE(PG8_SB(0, 0), cB, voffB); PG8_STAGE(PG8_SB(0, 1), cB + hstep, voffB); PG8_STAGE_A(PG8_SA(0, 0), cA, 0, false); PG8_STAGE_A(PG8_SA(0, 1), cA, 1, false);
        if (wr == 1) PG8_BAR;
        PG8_WAIT_V(2); PG8_BAR;
        PG8_STAGE(PG8_SB(1, 0), cB + kstep, voffB); PG8_STAGE_A(PG8_SA(1, 0), cA + kstep, 0, false); PG8_STAGE(PG8_SB(1, 1), cB + hstep + kstep, voffB);
        PG8_WAIT_V(6); PG8_BAR;
    } else {
        PG8_STAGE(PG8_SB(0, 0), cB, voffB); PG8_STAGE(PG8_SA(0, 0), cA, voffA); PG8_STAGE(PG8_SB(0, 1), cB + hstep, voffB); PG8_STAGE(PG8_SA(0, 1), cA + hstep, voffA);
        if (wr == 1) PG8_BAR;
        PG8_WAIT_V(4); PG8_BAR;
        PG8_STAGE(PG8_SB(1, 0), cB + kstep, voffB); PG8_STAGE(PG8_SA(1, 0), cA + kstep, voffA); PG8_STAGE(PG8_SB(1, 1), cB + hstep + kstep, voffB);
        PG8_WAIT_V(6); PG8_BAR;
    }
    for (;;) {
        const int cmask = __builtin_amdgcn_readfirstlane(cur.mask);
        const bool has_next = S.next(ui + 1, nxt);
        const char* nA = has_next ? (const char*)g.A + (Sched::GATHER ? (size_t)0 : (size_t)nxt.pm * tstep) : cA; const char* nB = has_next ? (const char*)g.Bt + S.boff(nxt) + (size_t)nxt.pn * tstep : cB;
        if constexpr (Sched::GATHER) { if (has_next) { PG8_GROWS(nxt, gA_nxt); } }
        for (int t = 0; t < nt; t += 2) {
            const bool last = (t == nt - 2);
            const char* a1 = cA + (size_t)(t + 1) * kstep;
            const char* a2 = last ? nA : cA + (size_t)(t + 2) * kstep; const char* b2 = last ? nB : cB + (size_t)(t + 2) * kstep;
            const char* a3 = a2 + kstep; const char* b3 = b2 + kstep;
            if (last && has_next) S.a_ready(nxt);
            const bool usen = last && has_next;
            if constexpr (SP2) {
            PG8_LDB(B0, 0, 0); PG8_LDB(B1, 0, 1); PG8_SCHED; PG8_LDA(At, 0, 0); PG8_STAGE_A(PG8_SA(1, 1), a1, 1, false);
            PG8_WAIT_V(8); PG8_WAIT_L(0); PG8_BAR; PG8_MMA(0, 0, At, B0); PG8_MMA(0, 1, At, B1); PG8_BAR; PG8_SCHED;
            PG8_LDA(At, 0, 1); PG8_STAGE(PG8_SB(0, 0), b2, voffB); PG8_STAGE(PG8_SB(0, 1), b2 + hstep, voffB); PG8_STAGE_A(PG8_SA(0, 0), a2, 0, usen);
            PG8_WAIT_V(8); PG8_WAIT_L(0); PG8_BAR; PG8_MMA(1, 0, At, B0); PG8_MMA(1, 1, At, B1); PG8_BAR; PG8_SCHED;
            PG8_LDB(B0, 1, 0); PG8_LDB(B1, 1, 1); PG8_SCHED; PG8_LDA(At, 1, 0); PG8_STAGE_A(PG8_SA(0, 1), a2, 1, usen);
            PG8_WAIT_V(8); PG8_WAIT_L(0); PG8_BAR; PG8_MMA(0, 0, At, B0); PG8_MMA(0, 1, At, B1); PG8_BAR; PG8_SCHED;
            PG8_LDA(At, 1, 1); PG8_STAGE(PG8_SB(1, 0), b3, voffB); PG8_STAGE(PG8_SB(1, 1), b3 + hstep, voffB); PG8_STAGE_A(PG8_SA(1, 0), a3, 0, usen);
            PG8_WAIT_V(8); PG8_WAIT_L(0); PG8_BAR; PG8_MMA(1, 0, At, B0); PG8_MMA(1, 1, At, B1); PG8_BAR; PG8_SCHED;
            } else {
            PG8_LDB(B0, 0, 0); PG8_SCHED; PG8_LDA(At, 0, 0); PG8_STAGE(PG8_SA(1, 1), a1 + hstep, voffA);
            PG8_WAIT_L(8); PG8_BAR; PG8_WAIT_L(0); PG8_MMA(0, 0, At, B0); PG8_BAR; PG8_SCHED;
            PG8_LDB(B1, 0, 1); PG8_STAGE(PG8_SB(0, 0), b2, voffB);
            PG8_BAR; PG8_WAIT_L(0); PG8_MMA(0, 1, At, B1); PG8_BAR;
            PG8_LDA(At, 0, 1); PG8_STAGE(PG8_SA(0, 0), a2, voffA);
            PG8_BAR; PG8_WAIT_L(0); PG8_MMA(1, 0, At, B0); PG8_BAR; PG8_SCHED;
            PG8_STAGE(PG8_SB(0, 1), b2 + hstep, voffB);
            PG8_WAIT_V(6); PG8_BAR; PG8_MMA(1, 1, At, B1); PG8_BAR;
            PG8_LDB(B0, 1, 0); PG8_SCHED; PG8_LDA(At, 1, 0); PG8_STAGE(PG8_SA(0, 1), a2 + hstep, voffA);
            PG8_WAIT_L(8); PG8_BAR; PG8_WAIT_L(0); PG8_MMA(0, 0, At, B0); PG8_BAR; PG8_SCHED;
            PG8_LDB(B1, 1, 1); PG8_STAGE(PG8_SB(1, 0), b3, voffB);
            PG8_BAR; PG8_WAIT_L(0); PG8_MMA(0, 1, At, B1); PG8_BAR;
            PG8_LDA(At, 1, 1); PG8_STAGE(PG8_SA(1, 0), a3, voffA);
            PG8_BAR; PG8_WAIT_L(0); PG8_MMA(1, 0, At, B0); PG8_BAR; PG8_SCHED;
            PG8_STAGE(PG8_SB(1, 1), b3 + hstep, voffB);
            PG8_WAIT_V(6); PG8_BAR; PG8_MMA(1, 1, At, B1); PG8_BAR;
            }
        }
        if constexpr (ALIGN_EPI) { if (wr == 0) PG8_BAR; }
        if constexpr (!Epi::AFTER_DRAIN) { E(acc, cur, wr, wc, 0, 0); S.done(cur); }
        if (!has_next) break;
#pragma unroll
        for (int a = 0; a < 2; ++a)
#pragma unroll
            for (int b = 0; b < 2; ++b)
#pragma unroll
                for (int m = 0; m < 4; ++m)
#pragma unroll
                    for (int n = 0; n < 2; ++n) acc[a][b][m][n] = (f32x4){0.f, 0.f, 0.f, 0.f};
        cur = nxt; cA = nA; cB = nB; ++ui;
        if constexpr (Sched::GATHER) {
#pragma unroll
            for (int h_ = 0; h_ < 2; ++h_)
#pragma unroll
                for (int i_ = 0; i_ < 2; ++i_) gA_cur[h_][i_] = gA_nxt[h_][i_]; }
        if constexpr (ALIGN_EPI) { if (wr == 1) PG8_BAR; }
    }
    PG8_WAIT_V(0);
    if constexpr (!ALIGN_EPI) { if (wr == 0) PG8_BAR; }
    PG8_BAR;
    if constexpr (Epi::AFTER_DRAIN) { E.fused(acc, cur, wr, wc, fr, fq, lds, wid, lane); S.done(cur); }
#undef PG8_SA
#undef PG8_SB
#undef PG8_STAGE
#undef PG8_STAGE_A
#undef PG8_GROWS
#undef PG8_LDA
#undef PG8_LDB
#undef PG8_MMA
#undef PG8_MMA_
#undef PG8_WAIT_V
#undef PG8_WAIT_L
#undef PG8_BAR
#undef PG8_SCHED
}
}

constexpr int BATCH = 2, SEQ = 8192, T = BATCH * SEQ, D = 1024, NL = 2;
constexpr int NPAD = 3584, RW = 1408, INCOLS = 3346;
constexpr int NWAVES = 8, NTHR = 512;
constexpr float LOG2E = 1.4426950408889634f;
constexpr float NORM_EPS = 1e-6f;

#define GAS __attribute__((address_space(1)))
#define LAS __attribute__((address_space(3)))
typedef unsigned short bf16_t;
typedef short bf16x8 __attribute__((ext_vector_type(8)));
typedef short s16x4 __attribute__((ext_vector_type(4)));
typedef short v4i16_t __attribute__((ext_vector_type(4)));
typedef float f32x4 __attribute__((ext_vector_type(4)));
typedef float f32x16 __attribute__((ext_vector_type(16)));
typedef unsigned u32x4 __attribute__((ext_vector_type(4)));
typedef unsigned u32x2 __attribute__((ext_vector_type(2)));
typedef GAS unsigned gu32;

constexpr size_t MiB = 1u << 20, KiB = 1u << 10;
constexpr size_t WS_CTL = 0, CTL_ZERO_BYTES = 64 * KiB;
constexpr size_t WS_COS = 1 * MiB, WS_SIN = 3 * MiB;
constexpr size_t WS_MOD = 5 * MiB;
constexpr size_t WS_PHIB = WS_MOD + 128 * KiB;
constexpr size_t WS_KMEAN = WS_MOD + 192 * KiB;
constexpr size_t WS_KCMP = WS_MOD + 256 * KiB;
constexpr size_t WS_VCMP = WS_KCMP + 256 * KiB;
constexpr size_t WS_BONUS = 6 * MiB;
constexpr size_t WS_GATE = 7 * MiB;
constexpr size_t WS_ROUTE = 9 * MiB;
constexpr size_t WS_ROWINFO = 10 * MiB;
constexpr size_t ROWINFO_LSTRIDE = 512 * KiB;
constexpr int MAXROWS = 36864;
constexpr size_t WS_RES = 78 * MiB;
constexpr size_t WS_ELIST = 9 * MiB;
constexpr size_t WS_EWW = 11 * MiB;
constexpr int TE_OFF = 272, TE_CNT = 304;
constexpr size_t WS_WIN = 12 * MiB;
constexpr size_t WS_WOUT = 19 * MiB;
constexpr size_t WS_WUP = 21 * MiB;
constexpr size_t WS_WDN = 37 * MiB;
constexpr size_t WS_PHIW = 45 * MiB;
constexpr size_t WS_GUPT = 45 * MiB + 512 * KiB;
constexpr size_t WS_WUPT = 45 * MiB + 640 * KiB;
constexpr size_t WS_AUPT = 45 * MiB + 704 * KiB;
constexpr size_t WS_LORA = 46 * MiB;
constexpr size_t WS_HM = 46 * MiB;
constexpr size_t WS_NQ = 78 * MiB;
constexpr size_t WS_KV6 = 90 * MiB;
constexpr size_t KV6_STRIDE = (size_t)BATCH * 2 * SEQ * 64;
constexpr size_t WS_MQKV = 114 * MiB;
constexpr size_t MQKV_STRIDE = (size_t)BATCH * 4 * SEQ * 64;
constexpr size_t WS_RFEAT = 138 * MiB;
constexpr size_t WS_SORTA = 78 * MiB;
constexpr size_t WS_HID = 150 * MiB;
constexpr size_t WS_PT = 182 * MiB;
constexpr size_t WS_ZS = 194 * MiB;
constexpr size_t WS_YT = 206 * MiB;
constexpr size_t WS_Y0 = 218 * MiB;
constexpr size_t WS_YS = 182 * MiB;
constexpr size_t WS_SS = 230 * MiB;
constexpr size_t WS_END = 256 * MiB;
constexpr int CW_Q = 64;
constexpr int CW_CNT = 1024;
constexpr int CW_BAR = 4096;
constexpr int CW_DBG = 3072;
#ifndef DBG_MODE
#define DBG_MODE 0
#endif
#ifndef EXTRA_BAR
#define EXTRA_BAR 0
#endif
#ifndef REPEAT_PH
#define REPEAT_PH -1
#endif
#ifndef DBG_TPH0
#define DBG_TPH0 0
#endif
#ifndef DBG_TPH1
#define DBG_TPH1 1
#endif
#ifndef DBG_QOFF
#define DBG_QOFF 0.0f
#endif
#ifndef DBG_TPH2
#define DBG_TPH2 0
#endif
#ifndef DBG_TPH3
#define DBG_TPH3 1
#endif
#ifndef DBG_SUB
#define DBG_SUB 4
#endif
#ifndef DBG_P
#define DBG_P 4
#endif
#ifndef DBG_CNT
#define DBG_CNT 1
#endif

#define RLX_AGENT __ATOMIC_RELAXED, __HIP_MEMORY_SCOPE_AGENT
#define LDS_WAIT() asm volatile("s_waitcnt lgkmcnt(0)" ::: "memory")
#define VM_WAIT() asm volatile("s_waitcnt vmcnt(0)" ::: "memory")
__device__ __forceinline__ float bf2f(bf16_t h) { return __uint_as_float(((unsigned)h) << 16); }
typedef float f32x2_t __attribute__((ext_vector_type(2)));
typedef __bf16 bf16x2_t __attribute__((ext_vector_type(2)));
__device__ __forceinline__ unsigned pk2(float lo, float hi) { const f32x2_t v = {lo, hi}; return __builtin_bit_cast(unsigned, __builtin_convertvector(v, bf16x2_t)); }
__device__ __forceinline__ bf16_t f2bf(float f) { return (bf16_t)(pk2(f, 0.f) & 0xffffu); }
__device__ __forceinline__ float shx(float v, int mask, int lane) { return __uint_as_float(__builtin_amdgcn_ds_bpermute((lane ^ mask) << 2, __float_as_uint(v))); }
__device__ __forceinline__ int shxi(int v, int mask, int lane) { return __builtin_amdgcn_ds_bpermute((lane ^ mask) << 2, v); }
template <int CTRL> __device__ __forceinline__ float dpp_mov(float v) { return __uint_as_float(__builtin_amdgcn_update_dpp(0u, __float_as_uint(v), CTRL, 0xf, 0xf, true)); }
__device__ __forceinline__ float half_sum32(float v) { const unsigned u = __float_as_uint(v); auto r = __builtin_amdgcn_permlane32_swap(u, u, false, false); return __uint_as_float(r[0]) + __uint_as_float(r[1]); }
__device__ __forceinline__ float row_sum16(float v) { const unsigned u = __float_as_uint(v); auto r = __builtin_amdgcn_permlane16_swap(u, u, false, false); return __uint_as_float(r[0]) + __uint_as_float(r[1]); }
__device__ __forceinline__ float wave_sum(float v, int lane) {
    (void)lane;
    v += dpp_mov<0xB1>(v); v += dpp_mov<0x4E>(v); v += dpp_mov<0x141>(v); v += dpp_mov<0x140>(v);
    return half_sum32(row_sum16(v));
}
__device__ __forceinline__ float tanh_fast(float x) { const float xc = fminf(fmaxf(x, -15.f), 15.f); return 1.f - 2.f * __builtin_amdgcn_rcpf(__builtin_amdgcn_exp2f(xc * (2.f * LOG2E)) + 1.f); }
__device__ __forceinline__ float sigm(float x) { return __builtin_amdgcn_rcpf(1.f + __expf(-x)); }
__device__ __forceinline__ int ld_ctl(const int* p) { return __hip_atomic_load(p, RLX_AGENT); }
__device__ __forceinline__ float ld_ctlf(const float* p) { return __uint_as_float(__hip_atomic_load((const unsigned*)p, RLX_AGENT)); }
#define MFMA16(a, b, c) __builtin_amdgcn_mfma_f32_16x16x32_bf16(a, b, c, 0, 0, 0)
#define MFMA32(a, b, c) __builtin_amdgcn_mfma_f32_32x32x16_bf16(a, b, c, 0, 0, 0)

#define XB_TMO      128
#define XB_XCNT(j)  (256  + 64 * (j))
#define XB_XSUB(j)  (1280 + 64 * (j))
#define XB_XGEN(j)  (2304 + 64 * (j))
#define XB_TOP      3328
#define XB_TOPGEN   3392
#define XCD_BAR_WORDS 3456
#define XB_SPIN_CAP (1u << 22)
__device__ __forceinline__ unsigned xb_ld(unsigned* p)              { return __hip_atomic_load(p, __ATOMIC_RELAXED, __HIP_MEMORY_SCOPE_AGENT); }
__device__ __forceinline__ unsigned xb_add(unsigned* p, unsigned v) { return __hip_atomic_fetch_add(p, v, __ATOMIC_RELAXED, __HIP_MEMORY_SCOPE_AGENT); }
__device__ __forceinline__ unsigned xb_xcc_id() { return (unsigned)__builtin_amdgcn_s_getreg((3 << 11) | 20) & 0xFu; }
#define XB_SPIN(cond, bar) do { unsigned _sp = 0; while (cond) { __builtin_amdgcn_s_sleep(1); \
    if ((++_sp & 255u) == 0u) { if (xb_ld(&(bar)[XB_TMO])) break; if (_sp > XB_SPIN_CAP) { atomicAdd(&(bar)[XB_TMO], 1u); break; } } } } while (0)
struct XcdBarrier { unsigned* bar; unsigned x; volatile LAS unsigned* st; };
__device__ __forceinline__ XcdBarrier xcd_barrier_post(unsigned* bar, volatile LAS unsigned* st) {
    XcdBarrier b; b.bar = bar; b.x = xb_xcc_id(); b.st = st;
    if (threadIdx.x == 0) (void)xb_add(&bar[XB_XCNT(b.x)], 1u);
    return b;
}
__device__ __forceinline__ void xcd_barrier_complete(unsigned* bar, unsigned x, unsigned& nloc, unsigned& nx) {
    const unsigned G = gridDim.x * gridDim.y * gridDim.z;
    unsigned sum, cnt, mine, sp = 0u;
    for (;;) {
        sum = 0u; cnt = 0u; mine = 0u;
#pragma unroll
        for (unsigned j = 0; j < 16; ++j) { const unsigned c = xb_ld(&bar[XB_XCNT(j)]); sum += c; cnt += (c > 0u) ? 1u : 0u; mine = (j == x) ? c : mine; }
        if (sum == G) break;
        __builtin_amdgcn_s_sleep(1);
        if ((++sp & 255u) == 0u) { if (xb_ld(&bar[XB_TMO])) break; if (sp > XB_SPIN_CAP) { atomicAdd(&bar[XB_TMO], 1u); break; } }
    }
    nloc = mine > 0u ? mine : 1u; nx = cnt > 0u ? cnt : 1u;
}
__device__ __forceinline__ void xcd_barrier(const XcdBarrier& b, const int tid) {
    asm volatile("s_waitcnt vmcnt(0)" ::: "memory");
    __syncthreads();
    if (tid == 0) {
        unsigned* bar = b.bar;
        __builtin_amdgcn_s_waitcnt(0);
        unsigned nloc = b.st[0], nx = b.st[1];
        if (nloc == 0u) { xcd_barrier_complete(bar, b.x, nloc, nx); b.st[0] = nloc; b.st[1] = nx; }
        const unsigned old = xb_add(&bar[XB_XSUB(b.x)], 1u);
        const unsigned gen = old / nloc;
        if (old + 1u == (gen + 1u) * nloc) {
            __builtin_amdgcn_fence(__ATOMIC_RELEASE, "agent");
            asm volatile("s_waitcnt vmcnt(0)" ::: "memory");
            const unsigned og = xb_add(&bar[XB_TOP], 1u);
            const unsigned tg = og / nx;
            if (og + 1u == (tg + 1u) * nx) xb_add(&bar[XB_TOPGEN], 1u);
            else XB_SPIN(xb_ld(&bar[XB_TOPGEN]) == tg, bar);
            __builtin_amdgcn_fence(__ATOMIC_ACQUIRE, "agent");
            xb_add(&bar[XB_XGEN(b.x)], 1u);
            asm volatile("s_waitcnt vmcnt(0)" ::: "memory");
        } else {
            XB_SPIN(xb_ld(&bar[XB_XGEN(b.x)]) == gen, bar);
            __builtin_amdgcn_fence(__ATOMIC_ACQUIRE, "agent");
            asm volatile("s_waitcnt vmcnt(0)" ::: "memory");
        }
    }
    __syncthreads();
}

constexpr int RING_BYTES = 131072, MISC_OFF = RING_BYTES + 320, LDS_BYTES = 147456;
struct Frame {
    LAS unsigned char* lds;
    volatile LAS unsigned* MISC;
    unsigned* ctl;
    int tid, lane, wave, G, bid;
    unsigned char* ws;
    float* out;
};
constexpr int IN_OFF = RING_BYTES + 1024;
__device__ __forceinline__ const float* inptr(const LAS unsigned char* lds, int k) {
    int z = 0; asm volatile("" : "+v"(z));
    const LAS unsigned* p = (const LAS unsigned*)(lds + IN_OFF + z) + 2 * k;
    const unsigned lo = __builtin_amdgcn_readfirstlane(p[0]), hi = __builtin_amdgcn_readfirstlane(p[1]);
    return (const float*)(const GAS float*)(((unsigned long long)hi << 32) | lo); }
#define INF(F, k) inptr((F).lds, k)
#define LAUNDER(F) do { GAS unsigned char* w_ = (GAS unsigned char*)(F).ws; GAS float* o_ = (GAS float*)(F).out; int g_ = (F).G, b_ = (F).bid, wv_ = (F).wave, z_ = 0; asm volatile("" : "+s"(w_), "+s"(o_), "+s"(g_), "+s"(b_), "+s"(wv_), "+s"(z_)); \
    int l_ = (int)__builtin_amdgcn_mbcnt_hi(~0u, __builtin_amdgcn_mbcnt_lo(~0u, (unsigned)z_)); asm volatile("" : "+v"(l_)); \
    (F).ws = (unsigned char*)w_; (F).out = (float*)o_; (F).ctl = (unsigned*)(GAS unsigned*)w_; (F).G = g_; (F).bid = b_; (F).wave = wv_; (F).lane = l_; (F).tid = wv_ * 64 + l_; } while (0)
enum { I_X = 0, I_C, I_POS, I_WMOD, I_BMOD, I_NMIX, I_NFFN, I_WIN, I_PHIW1, I_PHIW2, I_PHIPOS, I_MU, I_WUP, I_W0, I_AUP, I_A0, I_GUP, I_KK, I_KA, I_RK, I_LNW, I_LNB,
       I_NNSA, I_NMOBA, I_WOUT, I_WROUTER, I_RBIAS, I_MGATE, I_MUP, I_MDOWN, I_NFINAL };

__device__ const float g_invf[32] = {1.000000000e+00f, 7.498942018e-01f, 5.623413324e-01f, 4.216965139e-01f, 3.162277639e-01f, 2.371373773e-01f, 1.778279394e-01f, 1.333521456e-01f,
    1.000000015e-01f, 7.498942316e-02f, 5.623413250e-02f, 4.216964915e-02f, 3.162277490e-02f, 2.371373773e-02f, 1.778279431e-02f, 1.333521400e-02f, 9.999999776e-03f, 7.498942316e-03f,
    5.623413250e-03f, 4.216964822e-03f, 3.162277630e-03f, 2.371373819e-03f, 1.778279431e-03f, 1.333521446e-03f, 1.000000047e-03f, 7.498941850e-04f, 5.623413017e-04f, 4.216965172e-04f,
    3.162277571e-04f, 2.371373703e-04f, 1.778279402e-04f, 1.333521504e-04f};
__device__ __forceinline__ void phase_pro(Frame& F) {
    const int* pos = (const int*)INF(F, I_POS);
    float* cosT = (float*)(F.ws + WS_COS); float* sinT = (float*)(F.ws + WS_SIN);
    for (int idx = F.bid * NTHR + F.tid; idx < T * 32; idx += F.G * NTHR) {
        const int row = idx >> 5, i = idx & 31;
        const float ang = (float)pos[row] * g_invf[i];
        float sv, cv; sincosf(ang, &sv, &cv);
        cosT[idx] = cv; sinT[idx] = sv;
    }
    LAS float* red = (LAS float*)F.lds;
    for (int chunk = F.bid; chunk < NL * 96; chunk += F.G) {
        const int l = chunk / 96, j0 = (chunk % 96) * 64;
        const float* W = INF(F, I_WMOD) + (size_t)l * D * 6144 + j0 + F.lane;
        const float* c = INF(F, I_C);
        float a0 = 0.f, a1 = 0.f;
        const int k0 = F.wave * 128;
#pragma unroll 32
        for (int k = 0; k < 128; ++k) {
            const float w = W[(size_t)(k0 + k) * 6144];
            const float c0 = c[k0 + k], c1 = c[D + k0 + k];
            a0 += w * (c0 * sigm(c0)); a1 += w * (c1 * sigm(c1));
        }
        red[(F.wave * 2 + 0) * 64 + F.lane] = a0; red[(F.wave * 2 + 1) * 64 + F.lane] = a1;
        __syncthreads();
        if (F.wave < 2) {
            float s = INF(F, I_BMOD)[l * 6144 + j0 + F.lane];
#pragma unroll
            for (int w = 0; w < 8; ++w) s += red[(w * 2 + F.wave) * 64 + F.lane];
            ((float*)(F.ws + WS_MOD))[((size_t)l * BATCH + F.wave) * 6144 + j0 + F.lane] = s;
        }
        __syncthreads();
    }
}

__device__ __forceinline__ void transpose_item(int ldw, int K, bf16_t* WT, int n0, int k0, LAS float* scr, int lane, const float* src) {
    const int n4 = lane & 7, kr = lane >> 3;
#pragma unroll
    for (int i = 0; i < 8; ++i) { const int kk = 8 * i + kr; f32x4 v = (f32x4){0.f, 0.f, 0.f, 0.f};
        if (src) { const float* p = src + (size_t)(k0 + kk) * ldw; v.x = p[0]; v.y = p[1]; v.z = p[2]; v.w = p[3]; }
        scr[kk * 33 + 4 * n4] = v.x; scr[kk * 33 + 4 * n4 + 1] = v.y; scr[kk * 33 + 4 * n4 + 2] = v.z; scr[kk * 33 + 4 * n4 + 3] = v.w; }
    LDS_WAIT(); asm volatile("" ::: "memory");
    const int c = lane & 7;
#pragma unroll
    for (int j = 0; j < 4; ++j) { const int n = (lane >> 3) + 8 * j; const LAS float* sp = scr + (8 * c) * 33 + n;
        u32x4 o; o.x = pk2(sp[0 * 33], sp[1 * 33]); o.y = pk2(sp[2 * 33], sp[3 * 33]); o.z = pk2(sp[4 * 33], sp[5 * 33]); o.w = pk2(sp[6 * 33], sp[7 * 33]);
        *(u32x4*)(WT + (size_t)(n0 + n) * K + k0 + 8 * c) = o; }
    LDS_WAIT(); asm volatile("" ::: "memory");
}
__device__ __forceinline__ const float* cm_in(const float* W, int pos) {
        const int G = pos >> 6, p = pos & 63, w = p >> 5, n = (p >> 4) & 1, q = p & 15, d = 16 * w + q + 32 * n;
        int sc;
        if (G < 6) sc = G * 64 + d; else if (G < 18) sc = 384 + (G - 6) * 64 + d; else if (G < 30) sc = 1170 + (G - 18) * 64 + d;
        else if (G < 52) sc = 1938 + (G - 30) * 64 + d; else if (G == 52 && d < 18) sc = 1152 + d; else return nullptr;
        return W + sc; }
__device__ __forceinline__ const float* cm_up(const float* Wg, const float* Wu, int pos) { const int Wd = pos >> 5, n = (pos >> 4) & 1, q = pos & 15, f = 16 * Wd + q; return (n ? Wu : Wg) + f; }

__device__ __forceinline__ void norm_rows(Frame& F, int layer, bool final_) {
    const float* xin = INF(F, I_X);
    const bf16_t* ys = (const bf16_t*)(F.ws + WS_YS);
    const float* mod = (const float*)(F.ws + WS_MOD);
    bf16_t* H = (bf16_t*)(F.ws + WS_HM);
    const int gw = F.bid * NWAVES + F.wave, NGW = F.G * NWAVES;
    for (int m = gw; m < T; m += NGW) {
        const int b = m >> 13;
        f32x4 v[4]; float ss = 0.f;
        if (layer == 0 && !final_) {
#pragma unroll
            for (int j = 0; j < 4; ++j) v[j] = *(const f32x4*)(xin + (size_t)m * D + 4 * F.lane + 256 * j);
        } else {
            const int pl = final_ ? NL - 1 : layer - 1;
            const float* g2 = mod + ((size_t)pl * BATCH + b) * 6144 + 5120;
#pragma unroll
            for (int j = 0; j < 4; ++j) {
                const int col = 4 * F.lane + 256 * j;
                const u32x2 t2 = *(const u32x2*)((const bf16_t*)(F.ws + WS_RES) + (size_t)m * D + col);
                f32x4 x = (f32x4){__uint_as_float(t2.x << 16), __uint_as_float(t2.x & 0xffff0000u), __uint_as_float(t2.y << 16), __uint_as_float(t2.y & 0xffff0000u)};
                const u32x2 a = *(const u32x2*)(ys + (size_t)m * D + col), c = *(const u32x2*)(ys + (size_t)(T + m) * D + col);
                const f32x4 g = *(const f32x4*)(g2 + col);
                x.x += g.x * (__uint_as_float(a.x << 16) + __uint_as_float(c.x << 16));
                x.y += g.y * (__uint_as_float(a.x & 0xffff0000u) + __uint_as_float(c.x & 0xffff0000u));
                x.z += g.z * (__uint_as_float(a.y << 16) + __uint_as_float(c.y << 16));
                x.w += g.w * (__uint_as_float(a.y & 0xffff0000u) + __uint_as_float(c.y & 0xffff0000u));
                if (!final_) { u32x2 o; o.x = pk2(x.x, x.y); o.y = pk2(x.z, x.w); *(u32x2*)((bf16_t*)F.out + (size_t)m * D + col) = o;
                    x = (f32x4){__uint_as_float(o.x << 16), __uint_as_float(o.x & 0xffff0000u), __uint_as_float(o.y << 16), __uint_as_float(o.y & 0xffff0000u)}; }
                v[j] = x;
            }
        }
#pragma unroll
        for (int j = 0; j < 4; ++j) ss += (v[j].x * v[j].x + v[j].y * v[j].y) + (v[j].z * v[j].z + v[j].w * v[j].w);
        const float rstd = rsqrtf(wave_sum(ss, F.lane) * (1.f / D) + NORM_EPS);
#if DBG_MODE == 1
        if (final_) { float bad = 0.f;
#pragma unroll
            for (int j = 0; j < 4; ++j) { bad += (fabsf(v[j].x) <= 3e38f) ? 0.f : 1.f; bad += (fabsf(v[j].y) <= 3e38f) ? 0.f : 1.f; bad += (fabsf(v[j].z) <= 3e38f) ? 0.f : 1.f; bad += (fabsf(v[j].w) <= 3e38f) ? 0.f : 1.f; }
            bad = wave_sum(bad, F.lane); if (F.lane == 0 && bad > 0.f) atomicAdd(F.ctl + CW_DBG, (unsigned)bad); }
#endif
        if (final_) {
            const float* gn = INF(F, I_NFINAL);
#pragma unroll
            for (int j = 0; j < 4; ++j) { const int col = 4 * F.lane + 256 * j; const f32x4 g = *(const f32x4*)(gn + col);
                f32x4 o; o.x = v[j].x * rstd * g.x; o.y = v[j].y * rstd * g.y; o.z = v[j].z * rstd * g.z; o.w = v[j].w * rstd * g.w;
                *(f32x4*)(F.out + (size_t)m * D + col) = o; }
        } else {
            const float* gn = INF(F, I_NMIX) + layer * D;
            const float* sh = mod + ((size_t)layer * BATCH + b) * 6144; const float* sc = sh + 1024;
#pragma unroll
            for (int j = 0; j < 4; ++j) { const int col = 4 * F.lane + 256 * j;
                const f32x4 g = *(const f32x4*)(gn + col), s1 = *(const f32x4*)(sc + col), s0 = *(const f32x4*)(sh + col);
                u32x2 o; o.x = pk2(v[j].x * rstd * g.x * (1.f + s1.x) + s0.x, v[j].y * rstd * g.y * (1.f + s1.y) + s0.y);
                o.y = pk2(v[j].z * rstd * g.z * (1.f + s1.z) + s0.z, v[j].w * rstd * g.w * (1.f + s1.w) + s0.w);
                *(u32x2*)(H + (size_t)m * D + col) = o; }
        }
    }
}
__device__ __forceinline__ void phase_a(Frame& F, int layer, bool do_norm, bool do_conv) {
    if (do_norm) { norm_rows(F, layer, false); LAUNDER(F); }
    if (!do_conv) return;
    LAS float* scr = (LAS float*)(F.lds + F.wave * 16384);
    const int gw = F.bid * NWAVES + F.wave, NGW = F.G * NWAVES;
    constexpr int I_IN = 16 * 112, I_OUT = 16 * 32, I_UPI = 16 * 16 * 16, I_DN = 16 * 4 * 32, I_PHI = 2 * 32 * 2, I_GU = 2 * 12, I_LR = 2 * 12;
    constexpr int NIT = I_IN + I_OUT + I_UPI + I_DN + I_PHI + I_GU + I_LR;
    for (int it = gw; it < NIT; it += NGW) {
        int r = it;
        const int l31 = 4 * (F.lane & 7);
        if (r < I_IN) { const int kb = r / 112, nb = r % 112;
            transpose_item(INCOLS, D, (bf16_t*)(F.ws + WS_WIN), nb * 32, kb * 64, scr, F.lane, cm_in(INF(F, I_WIN) + (size_t)layer * D * INCOLS, nb * 32 + l31)); continue; } r -= I_IN;
        if (r < I_OUT) { const int kb = r / 32, nb = r % 32;
            transpose_item(D, D, (bf16_t*)(F.ws + WS_WOUT), nb * 32, kb * 64, scr, F.lane, INF(F, I_WOUT) + (size_t)layer * D * D + nb * 32 + l31); continue; } r -= I_OUT;
        if (r < I_UPI) { const int e = r / 256, q = r % 256, kb = q / 16, nb = q % 16;
            transpose_item(256, D, (bf16_t*)(F.ws + WS_WUP) + (size_t)e * 512 * D, nb * 32, kb * 64, scr, F.lane,
                           cm_up(INF(F, I_MGATE) + ((size_t)layer * 16 + e) * D * 256, INF(F, I_MUP) + ((size_t)layer * 16 + e) * D * 256, nb * 32 + l31)); continue; } r -= I_UPI;
        if (r < I_DN) { const int e = r / 128, q = r % 128, kb = q / 32, nb = q % 32;
            transpose_item(D, 256, (bf16_t*)(F.ws + WS_WDN) + (size_t)e * D * 256, nb * 32, kb * 64, scr, F.lane, INF(F, I_MDOWN) + ((size_t)layer * 16 + e) * 256 * D + nb * 32 + l31); continue; } r -= I_DN;
        if (r < I_PHI) { const int kv = r / 64, q = r % 64, kb = q / 2, nb = q % 2;
            transpose_item(64, 2048, (bf16_t*)(F.ws + WS_PHIW) + (size_t)kv * 64 * 2048, nb * 32, kb * 64, scr, F.lane, INF(F, I_PHIW1) + ((size_t)layer * 2 + kv) * 2048 * 64 + nb * 32 + l31); continue; } r -= I_PHI;
        if (r < I_GU) { const int kb = r / 12, nb = r % 12;
            transpose_item(384, 128, (bf16_t*)(F.ws + WS_GUPT), nb * 32, kb * 64, scr, F.lane, INF(F, I_GUP) + (size_t)layer * 128 * 384 + nb * 32 + l31); continue; } r -= I_GU;
        { const int which = r / 12, nb = r % 12;
            transpose_item(384, 64, (bf16_t*)(F.ws + (which ? WS_AUPT : WS_WUPT)), nb * 32, 0, scr, F.lane, INF(F, which ? I_AUP : I_WUP) + (size_t)layer * 64 * 384 + nb * 32 + l31); }
    }
    LAUNDER(F);
    if (F.bid == F.G - 1) {
        __syncthreads();
        LAS float* part = (LAS float*)F.lds;
#pragma unroll 1
        for (int kv = 0; kv < 2; ++kv) {
            const float* w1 = INF(F, I_PHIW1) + ((size_t)layer * 2 + kv) * 2048 * 64 + (size_t)F.wave * 256 * 64; const float* pp = INF(F, I_PHIPOS) + ((size_t)layer * 2 + kv) * 2048 + F.wave * 256;
            float a[4] = {0.f, 0.f, 0.f, 0.f};
#pragma unroll 1
            for (int k = 0; k < 256; k += 16) {
                float wv[16];
#pragma unroll
                for (int u = 0; u < 16; ++u) wv[u] = w1[(size_t)(k + u) * 64 + F.lane];
#pragma unroll
                for (int u = 0; u < 16; ++u) a[u & 3] += pp[k + u] * wv[u];
            }
            part[(F.wave * 2 + kv) * 64 + F.lane] = (a[0] + a[1]) + (a[2] + a[3]);
        }
        __syncthreads();
        if (F.wave < 2) { float sacc = 0.f;
#pragma unroll
            for (int w = 0; w < 8; ++w) sacc += part[(w * 2 + F.wave) * 64 + F.lane];
            ((float*)(F.ws + WS_PHIB))[(layer * 2 + F.wave) * 64 + F.lane] = sacc; }
    }
}

struct EpiInProj {
    static constexpr bool PERM = false, AFTER_DRAIN = false;
    bf16_t* nq; bf16_t* kv6; bf16_t* mqkv; bf16_t* rfeat; float* gate; const float* cosT; const float* sinT;
    __device__ __forceinline__ void operator()(const f32x4 (&acc)[2][2][4][2], const pg8::Unit& u, int wr, int wc, int fr_, int fq_) const {
        int z_ = 0; asm volatile("" : "+s"(z_)); int l_ = (int)__builtin_amdgcn_mbcnt_hi(~0u, __builtin_amdgcn_mbcnt_lo(~0u, (unsigned)z_)); asm volatile("" : "+v"(l_)); const int fr = l_ & 15, fq = l_ >> 4; (void)fr_; (void)fq_;
#pragma unroll
        for (int bj = 0; bj < 2; ++bj) {
            const int G = 4 * u.pn + 2 * bj + (wc >> 1), w = wc & 1;
            if (G >= 53) continue;
            const int qm = u.mask >> bj;
            const int d0 = 16 * w + 4 * fq;
            const bool rope = (G < 6) || (G == 10) || (G == 11) || (G == 14) || (G == 15) || (G >= 18 && G < 26);
            const float scl = (G < 6 || (G >= 18 && G < 22)) ? 0.125f * LOG2E : 1.0f;
#pragma unroll
            for (int ai = 0; ai < 2; ++ai) {
                if (!((qm >> (2 * ai)) & 1)) continue;
#pragma unroll
                for (int m = 0; m < 4; ++m) {
                    const int row = 256 * u.pm + 128 * ai + 64 * wr + 16 * m + fr, b = row >> 13, t = row & (SEQ - 1);
                    f32x4 x1 = acc[ai][bj][m][0], x2 = acc[ai][bj][m][1];
                    if (rope) {
                        const f32x4 c = *(const f32x4*)(cosT + (size_t)row * 32 + d0), s = *(const f32x4*)(sinT + (size_t)row * 32 + d0);
                        const f32x4 y1 = (x1 * c - x2 * s) * scl, y2 = (x2 * c + x1 * s) * scl; x1 = y1; x2 = y2;
                    }
                    if (G == 52) {
                        float* gp = gate + (size_t)row * 32;
                        *(f32x4*)(gp + d0) = x1;
                        continue;
                    }
                    bf16_t* dst;
                    if (G < 6) dst = nq + ((size_t)(b * 6 + G) * SEQ + t) * 64;
                    else if (G < 18) dst = kv6 + (size_t)((G - 6) >> 1) * KV6_STRIDE + ((size_t)(b * 2 + ((G - 6) & 1)) * SEQ + t) * 64;
                    else if (G < 30) dst = mqkv + (size_t)((G - 18) >> 2) * MQKV_STRIDE + ((size_t)(b * 4 + ((G - 18) & 3)) * SEQ + t) * 64;
                    else dst = rfeat + (size_t)row * RW + (G - 30) * 64;
                    auto sx = __builtin_amdgcn_permlane16_swap(pk2(x1.x, x1.y), pk2(x2.x, x2.y), false, false);
                    auto sy = __builtin_amdgcn_permlane16_swap(pk2(x1.z, x1.w), pk2(x2.z, x2.w), false, false);
                    u32x4 o; o.x = sx[0]; o.y = sy[0]; o.z = sx[1]; o.w = sy[1];
                    *(u32x4*)(dst + ((fq & 1) ? d0 - 4 + 32 : d0)) = o;
                }
            }
        }
    }
};
struct EpiNull {
    static constexpr bool PERM = false, AFTER_DRAIN = false;
    float* sink;
    __device__ __forceinline__ void operator()(const f32x4 (&acc)[2][2][4][2], const pg8::Unit& u, int wr, int wc, int fr_, int fq_) const {
        f32x4 s = (f32x4){0.f, 0.f, 0.f, 0.f};
#pragma unroll
        for (int ai = 0; ai < 2; ++ai)
#pragma unroll
            for (int bj = 0; bj < 2; ++bj)
#pragma unroll
                for (int m = 0; m < 4; ++m)
#pragma unroll
                    for (int n = 0; n < 2; ++n) s += acc[ai][bj][m][n];
        if (s.x + s.y + s.z + s.w == 123456.789f) sink[0] = s.x;
    }
};
template <bool F32IN>
struct EpiOutProjT {
    static constexpr bool PERM = false, AFTER_DRAIN = false;
    const float* xold_f; const bf16_t* xold_b; bf16_t* xnew; const float* g1;
    __device__ __forceinline__ void operator()(const f32x4 (&acc)[2][2][4][2], const pg8::Unit& u, int wr, int wc, int fr_, int fq_) const {
        int z_ = 0; asm volatile("" : "+s"(z_)); int l_ = (int)__builtin_amdgcn_mbcnt_hi(~0u, __builtin_amdgcn_mbcnt_lo(~0u, (unsigned)z_)); asm volatile("" : "+v"(l_)); const int fr = l_ & 15, fq = l_ >> 4; (void)fr_; (void)fq_;
#pragma unroll
        for (int ai = 0; ai < 2; ++ai)
#pragma unroll
            for (int m = 0; m < 4; ++m) {
                const int row = 256 * u.pm + 128 * ai + 64 * wr + 16 * m + fr, b = row >> 13;
#pragma unroll
                for (int bj = 0; bj < 2; ++bj) {
                    if (!((u.mask >> (2 * ai + bj)) & 1)) continue;
                    u32x2 o2[2];
#pragma unroll
                    for (int n = 0; n < 2; ++n) {
                        const int col = 256 * u.pn + 128 * bj + 32 * wc + 16 * n + 4 * fq;
                        const f32x4 g = *(const f32x4*)(g1 + (size_t)b * 6144 + col);
                        f32x4 xo;
                        if constexpr (F32IN) xo = *(const f32x4*)(xold_f + (size_t)row * D + col);
                        else { const u32x2 t2 = *(const u32x2*)(xold_b + (size_t)row * D + col); xo = (f32x4){__uint_as_float(t2.x << 16), __uint_as_float(t2.x & 0xffff0000u), __uint_as_float(t2.y << 16), __uint_as_float(t2.y & 0xffff0000u)}; }
                        const f32x4 xn = xo + g * acc[ai][bj][m][n];
                        o2[n].x = pk2(xn.x, xn.y); o2[n].y = pk2(xn.z, xn.w);
                    }
                    auto sx = __builtin_amdgcn_permlane16_swap(o2[0].x, o2[1].x, false, false);
                    auto sy = __builtin_amdgcn_permlane16_swap(o2[0].y, o2[1].y, false, false);
                    u32x4 o; o.x = sx[0]; o.y = sy[0]; o.z = sx[1]; o.w = sy[1];
                    *(u32x4*)(xnew + (size_t)row * D + 256 * u.pn + 128 * bj + 32 * wc + ((fq & 1) ? 16 + 4 * (fq - 1) : 4 * fq)) = o;
                }
            }
    }
};
struct EpiMoeUp {
    static constexpr bool PERM = false, AFTER_DRAIN = false;
    bf16_t* hid;
    __device__ __forceinline__ void operator()(const f32x4 (&acc)[2][2][4][2], const pg8::Unit& u, int wr, int wc, int fr_, int fq_) const {
        int z_ = 0; asm volatile("" : "+s"(z_)); int l_ = (int)__builtin_amdgcn_mbcnt_hi(~0u, __builtin_amdgcn_mbcnt_lo(~0u, (unsigned)z_)); asm volatile("" : "+v"(l_)); const int fr = l_ & 15, fq = l_ >> 4; (void)fr_; (void)fq_;
#pragma unroll
        for (int ai = 0; ai < 2; ++ai)
#pragma unroll
            for (int m = 0; m < 4; ++m) {
                const int row = 256 * u.pm + 128 * ai + 64 * wr + 16 * m + fr;
                u32x2 ob[2];
#pragma unroll
                for (int bj = 0; bj < 2; ++bj) { const f32x4 g = acc[ai][bj][m][0], up = acc[ai][bj][m][1];
                    ob[bj].x = pk2(g.x * sigm(g.x) * up.x, g.y * sigm(g.y) * up.y); ob[bj].y = pk2(g.z * sigm(g.z) * up.z, g.w * sigm(g.w) * up.w); }
                if (((u.mask >> (2 * ai)) & 3) == 3) {
                    auto sx = __builtin_amdgcn_permlane16_swap(ob[0].x, ob[1].x, false, false);
                    auto sy = __builtin_amdgcn_permlane16_swap(ob[0].y, ob[1].y, false, false);
                    u32x4 o; o.x = sx[0]; o.y = sy[0]; o.z = sx[1]; o.w = sy[1];
                    const int f0 = (fq & 1) ? 16 * (8 * u.pn + 4 + wc) + 4 * (fq - 1) : 16 * (8 * u.pn + wc) + 4 * fq;
                    *(u32x4*)(hid + (size_t)row * 256 + f0) = o;
                } else {
#pragma unroll
                    for (int bj = 0; bj < 2; ++bj) {
                        if (!((u.mask >> (2 * ai + bj)) & 1)) continue;
                        *(u32x2*)(hid + (size_t)row * 256 + 16 * (8 * u.pn + 4 * bj + wc) + 4 * fq) = ob[bj];
                    }
                }
            }
    }
};
struct EpiMoeDown {
    static constexpr bool PERM = false, AFTER_DRAIN = false;
    bf16_t* ys; const int* tile_e; const int* elist; const float* eww;
    __device__ __forceinline__ void operator()(const f32x4 (&acc)[2][2][4][2], const pg8::Unit& u, int wr, int wc, int fr_, int fq_) const {
        int z_ = 0; asm volatile("" : "+s"(z_)); int l_ = (int)__builtin_amdgcn_mbcnt_hi(~0u, __builtin_amdgcn_mbcnt_lo(~0u, (unsigned)z_)); asm volatile("" : "+v"(l_)); const int fr = l_ & 15, fq = l_ >> 4; (void)fr_; (void)fq_;
        const int e = __builtin_amdgcn_readfirstlane(ld_ctl(tile_e + u.pm)), off = __builtin_amdgcn_readfirstlane(ld_ctl(tile_e + TE_OFF + e)), cnt = __builtin_amdgcn_readfirstlane(ld_ctl(tile_e + TE_CNT + e));
        int ri[2][4]; float wv[2][4];
#pragma unroll
        for (int ai = 0; ai < 2; ++ai)
#pragma unroll
            for (int m = 0; m < 4; ++m) { const int local = 256 * u.pm + 128 * ai + 64 * wr + 16 * m + fr - off, idx = e * 16384 + (local < cnt ? local : 0); ri[ai][m] = elist[idx]; wv[ai][m] = eww[idx]; }
#pragma unroll
        for (int ai = 0; ai < 2; ++ai)
#pragma unroll
            for (int m = 0; m < 4; ++m) {
                const int local = 256 * u.pm + 128 * ai + 64 * wr + 16 * m + fr - off;
                if (local >= cnt) continue;
                const float w = wv[ai][m];
                bf16_t* dst = ys + ((size_t)(ri[ai][m] & 1) * T + (ri[ai][m] >> 1)) * D;
#pragma unroll
                for (int bj = 0; bj < 2; ++bj) {
                    if (!((u.mask >> (2 * ai + bj)) & 1)) continue;
                    const f32x4 v0 = acc[ai][bj][m][0] * w, v1 = acc[ai][bj][m][1] * w;
                    auto sx = __builtin_amdgcn_permlane16_swap(pk2(v0.x, v0.y), pk2(v1.x, v1.y), false, false);
                    auto sy = __builtin_amdgcn_permlane16_swap(pk2(v0.z, v0.w), pk2(v1.z, v1.w), false, false);
                    u32x4 o; o.x = sx[0]; o.y = sy[0]; o.z = sx[1]; o.w = sy[1];
                    const int col = 256 * u.pn + 128 * bj + 32 * wc + ((fq & 1) ? 16 + 4 * (fq - 1) : 4 * fq);
                    *(u32x4*)(dst + col) = o;
                }
            }
    }
};
template <bool GATHER_>
struct MoeOrderT {
    static constexpr bool GATHER = GATHER_;
    int ntiles, nN, G, c; const int* tile_e; size_t estride; const int* elist;
    __device__ __forceinline__ void arows(const pg8::Unit& u, const int (&RA)[2], int (&o)[2][2]) const {
        const int e = __builtin_amdgcn_readfirstlane(ld_ctl(tile_e + u.pm)), off = __builtin_amdgcn_readfirstlane(ld_ctl(tile_e + TE_OFF + e)), c = __builtin_amdgcn_readfirstlane(ld_ctl(tile_e + TE_CNT + e));
        int ri[2][2];
#pragma unroll
        for (int h = 0; h < 2; ++h)
#pragma unroll
            for (int i = 0; i < 2; ++i) { const int local = 256 * u.pm + 128 * h + RA[i] - off; ri[h][i] = elist[e * 16384 + (local < c ? local : 0)]; }
#pragma unroll
        for (int h = 0; h < 2; ++h)
#pragma unroll
            for (int i = 0; i < 2; ++i) { const int local = 256 * u.pm + 128 * h + RA[i] - off; o[h][i] = (local < c) ? (ri[h][i] >> 1) : 0; }
    }
    __device__ __forceinline__ bool next(int i, pg8::Unit& u) const { int L, f, sub; const int U = ntiles * nN;
        if ((G & 7) == 0) { const int x = c & 7, j = c >> 3, nb = G >> 3, U8 = (U + 7) >> 3, lo = x * U8, n = (lo + U8 <= U) ? U8 : (U > lo ? U - lo : 0);
            if (!pg8::tail_split(i, nb, j, n, L, f, sub)) return false; L += lo; }
        else if (!pg8::tail_split(i, G, c, U, L, f, sub)) return false;
        u.pm = L / nN; u.pn = L % nN; u.mask = (f == 1) ? 0xF : (f == 2) ? (sub ? 0xA : 0x5) : (1 << sub); return true; }
    __device__ __forceinline__ void a_ready(const pg8::Unit&) const {}
    __device__ __forceinline__ size_t boff(const pg8::Unit& u) const { return (size_t)__builtin_amdgcn_readfirstlane(ld_ctl(tile_e + u.pm)) * estride; }
    __device__ __forceinline__ void done(const pg8::Unit&) const {}
};
typedef MoeOrderT<false> MoeOrder;
typedef MoeOrderT<true> MoeGatherOrder;

__device__ __forceinline__ float gelu_tanh(float x) { const float u = 0.7978845608028654f * (x + 0.044715f * x * x * x); return 0.5f * x * (1.f + tanhf(u)); }

__device__ __forceinline__ void compress_unit(Frame& F, int layer, int u) {
    const int kvsel = u >> 5, b = (u >> 4) & 1, kvh = (u >> 3) & 1, rt = u & 7, i0 = 64 * rt;
    const bf16_t* src = (const bf16_t*)(F.ws + WS_KV6) + (size_t)kvsel * KV6_STRIDE + (size_t)(b * 2 + kvh) * SEQ * 64;
    const bf16_t* w1t = (const bf16_t*)(F.ws + WS_PHIW) + (size_t)kvsel * 64 * 2048;
    const int lane = F.lane, r = lane & 15, kg = lane >> 4;
    f32x4 acc[4][4];
#pragma unroll
    for (int a = 0; a < 4; ++a)
#pragma unroll
        for (int c = 0; c < 4; ++c) acc[a][c] = (f32x4){0.f, 0.f, 0.f, 0.f};
#pragma unroll 2
    for (int lq = 0; lq < 4; ++lq) {
        const int l = 4 * F.wave + lq;
#pragma unroll
        for (int ks = 0; ks < 2; ++ks) {
            bf16x8 af[4], bfr[4];
#pragma unroll
            for (int mt = 0; mt < 4; ++mt) af[mt] = *(const bf16x8*)(src + ((size_t)(16 * (i0 + 16 * mt + r) + l)) * 64 + 32 * ks + 8 * kg);
#pragma unroll
            for (int nt = 0; nt < 4; ++nt) bfr[nt] = *(const bf16x8*)(w1t + (size_t)(16 * nt + r) * 2048 + l * 64 + 32 * ks + 8 * kg);
#pragma unroll
            for (int mt = 0; mt < 4; ++mt)
#pragma unroll
                for (int nt = 0; nt < 4; ++nt) acc[mt][nt] = MFMA16(af[mt], bfr[nt], acc[mt][nt]);
        }
    }
    LAS float* part = (LAS float*)F.lds;
#pragma unroll
    for (int mt = 0; mt < 4; ++mt)
#pragma unroll
        for (int nt = 0; nt < 4; ++nt)
#pragma unroll
            for (int q = 0; q < 4; ++q) part[(F.wave * 64 + 16 * mt + 4 * kg + q) * 64 + 16 * nt + r] = acc[mt][nt][q];
    __syncthreads();
    const float* phib = (const float*)(F.ws + WS_PHIB) + (layer * 2 + kvsel) * 64;
    float hv[8];
    const int row = F.tid >> 3, e0 = (F.tid & 7) * 8;
#pragma unroll
    for (int k = 0; k < 8; ++k) { float s = phib[e0 + k];
#pragma unroll
        for (int w = 0; w < 8; ++w) s += part[(w * 64 + row) * 64 + e0 + k];
        hv[k] = gelu_tanh(s); }
    __syncthreads();
    LAS float* hb = (LAS float*)F.lds;
    LAS float* ob = (LAS float*)(F.lds + 32768);
#pragma unroll
    for (int k = 0; k < 8; ++k) hb[row * 65 + e0 + k] = hv[k];
    __syncthreads();
    const float* w2 = INF(F, I_PHIW2) + ((size_t)layer * 2 + kvsel) * 64 * 64;
    float o[8];
#pragma unroll
    for (int k = 0; k < 8; ++k) o[k] = 0.f;
#pragma unroll 8
    for (int e = 0; e < 64; ++e) { const float h = hb[row * 65 + e]; const f32x4 wa = *(const f32x4*)(w2 + e * 64 + e0), wb = *(const f32x4*)(w2 + e * 64 + e0 + 4);
        o[0] += h * wa.x; o[1] += h * wa.y; o[2] += h * wa.z; o[3] += h * wa.w; o[4] += h * wb.x; o[5] += h * wb.y; o[6] += h * wb.z; o[7] += h * wb.w; }
#pragma unroll
    for (int k = 0; k < 8; ++k) ob[row * 65 + e0 + k] = o[k];
    __syncthreads();
    const int i = i0 + row;
    bf16_t* dst = (bf16_t*)(F.ws + (kvsel ? WS_VCMP : WS_KCMP)) + ((size_t)(b * 2 + kvh) * 512 + i) * 64 + e0;
    float y[8];
    if (i >= 511) {
#pragma unroll
        for (int k = 0; k < 8; ++k) y[k] = 0.f;
    } else if (kvsel == 0) {
        const size_t pr = (size_t)b * SEQ + 16 * i + 31;
        const float* cs = (const float*)(F.ws + WS_COS) + pr * 32; const float* sn = (const float*)(F.ws + WS_SIN) + pr * 32;
#pragma unroll
        for (int k = 0; k < 8; ++k) { const int d = e0 + k, f = d & 31; const float x1 = ob[row * 65 + f], x2 = ob[row * 65 + f + 32];
            y[k] = (d < 32) ? (x1 * cs[f] - x2 * sn[f]) : (x2 * cs[f] + x1 * sn[f]); }
    } else {
#pragma unroll
        for (int k = 0; k < 8; ++k) y[k] = o[k];
    }
    u32x4 pk; pk.x = pk2(y[0], y[1]); pk.y = pk2(y[2], y[3]); pk.z = pk2(y[4], y[5]); pk.w = pk2(y[6], y[7]);
    *(u32x4*)dst = pk;
    __syncthreads();
}
__device__ __forceinline__ void kmean_task(Frame& F, int wt) {
    const int b = wt >> 7, h = (wt >> 5) & 3, blk = wt & 31, sub = F.lane >> 3, ch = F.lane & 7;
    const bf16_t* mk = (const bf16_t*)(F.ws + WS_MQKV) + MQKV_STRIDE + ((size_t)(b * 4 + h) * SEQ + 256 * blk) * 64;
    float a[8];
#pragma unroll
    for (int k = 0; k < 8; ++k) a[k] = 0.f;
#pragma unroll 8
    for (int it = 0; it < 32; ++it) {
        const u32x4 v = *(const u32x4*)(mk + (size_t)(8 * it + sub) * 64 + 8 * ch);
        a[0] += __uint_as_float(v.x << 16); a[1] += __uint_as_float(v.x & 0xffff0000u); a[2] += __uint_as_float(v.y << 16); a[3] += __uint_as_float(v.y & 0xffff0000u);
        a[4] += __uint_as_float(v.z << 16); a[5] += __uint_as_float(v.z & 0xffff0000u); a[6] += __uint_as_float(v.w << 16); a[7] += __uint_as_float(v.w & 0xffff0000u);
    }
#pragma unroll
    for (int k = 0; k < 8; ++k) { a[k] += shx(a[k], 8, F.lane); a[k] += shx(a[k], 16, F.lane); a[k] += shx(a[k], 32, F.lane); a[k] *= (1.f / 256.f); }
    if (sub == 0) { u32x4 o; o.x = pk2(a[0], a[1]); o.y = pk2(a[2], a[3]); o.z = pk2(a[4], a[5]); o.w = pk2(a[6], a[7]);
        *(u32x4*)((bf16_t*)(F.ws + WS_KMEAN) + ((size_t)(b * 4 + h) * 32 + blk) * 64 + 8 * ch) = o; }
}

constexpr int R1_TASK_OFF = 32768, R1_TASK_BYTES = 12288;
__device__ __forceinline__ unsigned bf_hi(float x) { return __float_as_uint(x) >> 16; }
__device__ __forceinline__ void r1_block(Frame& F, int layer, int bt) {
    const int chain = bt >> 4, b = chain / 6, h = chain % 6, lane0 = F.lane;
    const int chunk = 8 * (bt & 15) + F.wave, task = chain * 128 + chunk;
    LAS float* tb = (LAS float*)(F.lds + R1_TASK_OFF + F.wave * R1_TASK_BYTES);
    LAS float* Lr = tb; LAS float* Lw = tb + 512; LAS float* Lk = tb + 1024; LAS float* Lkk = tb + 1536; LAS float* Lbb = tb + 2048; LAS float* Lv = tb + 2560;
    const bf16_t* rf = (const bf16_t*)(F.ws + WS_RFEAT);
    const float* mu = INF(F, I_MU) + layer * RW;
    float* bonus = (float*)(F.ws + WS_BONUS);
    bf16_t* ytil = (bf16_t*)(F.ws + WS_YT) + (size_t)task * 4096; bf16_t* y0o = (bf16_t*)(F.ws + WS_Y0) + (size_t)task * 4096;
    bf16_t* lora = (bf16_t*)(F.ws + (task < 896 ? (size_t)242 * MiB + (size_t)task * 16384 : task < 1344 ? WS_WIN + (size_t)(task - 896) * 16384 : WS_ROUTE + (size_t)(task - 1344) * 16384));
    {
        const int c31 = lane0 & 31, hi = lane0 >> 5;
        f32x16 aw[2][2], aa[2][2];
#pragma unroll
        for (int mt = 0; mt < 2; ++mt)
#pragma unroll
            for (int nt = 0; nt < 2; ++nt)
#pragma unroll
                for (int r = 0; r < 16; ++r) { aw[mt][nt][r] = 0.f; aa[mt][nt][r] = 0.f; }
        const bf16_t* wt = (const bf16_t*)(F.ws + WS_WUPT) + (size_t)(h * 64) * 64; const bf16_t* at = (const bf16_t*)(F.ws + WS_AUPT) + (size_t)(h * 64) * 64;
#pragma unroll
        for (int ks = 0; ks < 4; ++ks) {
            const int j0 = 16 * ks + 8 * hi;
            bf16x8 fw[2], fa[2], bw[2], ba[2];
#pragma unroll
            for (int nt = 0; nt < 2; ++nt) { bw[nt] = *(const bf16x8*)(wt + (32 * nt + c31) * 64 + j0); ba[nt] = *(const bf16x8*)(at + (32 * nt + c31) * 64 + j0); }
#pragma unroll
            for (int mt = 0; mt < 2; ++mt) {
                const int t = 64 * chunk + 32 * mt + c31; const int rowi = b * SEQ + t;
                const u32x4 cw = *(const u32x4*)(rf + (size_t)rowi * RW + 1152 + j0), ca = *(const u32x4*)(rf + (size_t)rowi * RW + 1216 + j0);
                u32x4 pw = (u32x4){0u, 0u, 0u, 0u}, pa = (u32x4){0u, 0u, 0u, 0u};
                if (t > 0) { pw = *(const u32x4*)(rf + (size_t)(rowi - 1) * RW + 1152 + j0); pa = *(const u32x4*)(rf + (size_t)(rowi - 1) * RW + 1216 + j0); }
                const f32x4 mw0 = *(const f32x4*)(mu + 1152 + j0), mw1 = *(const f32x4*)(mu + 1152 + j0 + 4), ma0 = *(const f32x4*)(mu + 1216 + j0), ma1 = *(const f32x4*)(mu + 1216 + j0 + 4);
                const float mwv[8] = {mw0.x, mw0.y, mw0.z, mw0.w, mw1.x, mw1.y, mw1.z, mw1.w}, mav[8] = {ma0.x, ma0.y, ma0.z, ma0.w, ma1.x, ma1.y, ma1.z, ma1.w};
                const unsigned cwv[4] = {cw.x, cw.y, cw.z, cw.w}, pwv[4] = {pw.x, pw.y, pw.z, pw.w}, cav[4] = {ca.x, ca.y, ca.z, ca.w}, pav[4] = {pa.x, pa.y, pa.z, pa.w};
                float xw[8], xa[8];
#pragma unroll
                for (int k = 0; k < 4; ++k) {
                    const float c0 = __uint_as_float(cwv[k] << 16), c1 = __uint_as_float(cwv[k] & 0xffff0000u), p0 = __uint_as_float(pwv[k] << 16), p1 = __uint_as_float(pwv[k] & 0xffff0000u);
                    xw[2 * k] = tanh_fast(c0 + (p0 - c0) * mwv[2 * k]); xw[2 * k + 1] = tanh_fast(c1 + (p1 - c1) * mwv[2 * k + 1]);
                    const float d0 = __uint_as_float(cav[k] << 16), d1 = __uint_as_float(cav[k] & 0xffff0000u), q0 = __uint_as_float(pav[k] << 16), q1 = __uint_as_float(pav[k] & 0xffff0000u);
                    xa[2 * k] = d0 + (q0 - d0) * mav[2 * k]; xa[2 * k + 1] = d1 + (q1 - d1) * mav[2 * k + 1];
                }
                u32x4 uw, ua; uw.x = pk2(xw[0], xw[1]); uw.y = pk2(xw[2], xw[3]); uw.z = pk2(xw[4], xw[5]); uw.w = pk2(xw[6], xw[7]);
                ua.x = pk2(xa[0], xa[1]); ua.y = pk2(xa[2], xa[3]); ua.z = pk2(xa[4], xa[5]); ua.w = pk2(xa[6], xa[7]);
                fw[mt] = __builtin_bit_cast(bf16x8, uw); fa[mt] = __builtin_bit_cast(bf16x8, ua);
            }
#pragma unroll
            for (int mt = 0; mt < 2; ++mt)
#pragma unroll
                for (int nt = 0; nt < 2; ++nt) { aw[mt][nt] = MFMA32(fw[mt], bw[nt], aw[mt][nt]); aa[mt][nt] = MFMA32(fa[mt], ba[nt], aa[mt][nt]); }
        }
#pragma unroll
        for (int mt = 0; mt < 2; ++mt)
#pragma unroll
            for (int nt = 0; nt < 2; ++nt)
#pragma unroll
                for (int r = 0; r < 16; ++r) { const int tl = 32 * mt + (r & 3) + 8 * (r >> 2) + 4 * hi;
                    lora[tl * 64 + 32 * nt + c31] = f2bf(aw[mt][nt][r]); lora[4096 + tl * 64 + 32 * nt + c31] = f2bf(aa[mt][nt][r]); }
        asm volatile("s_waitcnt vmcnt(0)" ::: "memory");
    }
    float Wrun = 1.f;
    f32x16 XP[2][2], XZ[2][2];
    { const int c31 = lane0 & 31, hi = lane0 >> 5;
#pragma unroll
      for (int mt = 0; mt < 2; ++mt)
#pragma unroll
          for (int nt = 0; nt < 2; ++nt)
#pragma unroll
              for (int r = 0; r < 16; ++r) { XP[mt][nt][r] = (32 * mt + (r & 3) + 8 * (r >> 2) + 4 * hi == 32 * nt + c31) ? 1.f : 0.f; XZ[mt][nt][r] = 0.f; } }
#pragma unroll 1
    for (int sub = 0; sub < 8; ++sub) {
        int lane = lane0, hc = h * 64 + lane0; asm volatile("" : "+v"(lane), "+v"(hc));
#pragma unroll 1
        for (int half = 0; half < 2; ++half) {
            float rs4[4], ks4[4], vs4[4], aw4[4], aa4[4];
            const float mu_r = mu[hc], mu_k = mu[384 + hc], mu_v = mu[768 + hc];
            const float w0 = INF(F, I_W0)[layer * 384 + hc], a0 = INF(F, I_A0)[layer * 384 + hc];
#pragma unroll
            for (int q = 0; q < 4; ++q) {
                const int tl = 8 * sub + 4 * half + q, t = 64 * chunk + tl; const int rowi = b * SEQ + t;
                const bf16_t* cur = rf + (size_t)rowi * RW; const bf16_t* prv = cur - RW; const bool hp = t > 0;
                const float rc = bf2f(cur[hc]), kc = bf2f(cur[384 + hc]), vc = bf2f(cur[768 + hc]);
                const float rp = hp ? bf2f(prv[hc]) : 0.f, kp = hp ? bf2f(prv[384 + hc]) : 0.f, vp = hp ? bf2f(prv[768 + hc]) : 0.f;
                rs4[q] = rc + (rp - rc) * mu_r; ks4[q] = kc + (kp - kc) * mu_k; vs4[q] = vc + (vp - vc) * mu_v;
                aw4[q] = w0 + bf2f(lora[tl * 64 + lane]); aa4[q] = a0 + bf2f(lora[4096 + tl * 64 + lane]);
            }
            const float k_k = INF(F, I_KK)[layer * 384 + hc], k_a = INF(F, I_KA)[layer * 384 + hc], r_k = INF(F, I_RK)[layer * 384 + hc];
#pragma unroll
            for (int q = 0; q < 4; ++q) {
                const int tt = 4 * half + q; const int rowi = b * SEQ + 64 * chunk + 8 * sub + tt;
                const float dec = __expf(-0.606531f * sigm(aw4[q])), a = sigm(aa4[q]);
                float kk = ks4[q] * k_k; const float n2 = wave_sum(kk * kk, lane); kk = kk * __builtin_amdgcn_rsqf(fmaxf(n2, 1e-24f));
                const float km = ks4[q] * (1.f + (a - 1.f) * k_a);
                const float bn = wave_sum(rs4[q] * km * r_k, lane);
                const float Wprev = Wrun; Wrun *= dec; const float iW = __builtin_amdgcn_rcpf(Wrun);
                Lr[tt * 64 + lane] = rs4[q] * Wrun; Lk[tt * 64 + lane] = km * iW; Lkk[tt * 64 + lane] = -(kk * Wprev); Lbb[tt * 64 + lane] = kk * a * iW; Lv[tt * 64 + lane] = vs4[q];
                if (lane == 0) bonus[(size_t)rowi * 8 + h] = bn;
            }
        }
        LDS_WAIT(); asm volatile("" ::: "memory");
        const int c31 = lane & 31, hi = lane >> 5;
#pragma unroll 1
        for (int tt = 0; tt < 8; ++tt) {
            f32x4 k4[2][4], r4[2][4];
#pragma unroll
            for (int mt = 0; mt < 2; ++mt)
#pragma unroll
                for (int rq = 0; rq < 4; ++rq) { const int c0 = tt * 64 + 32 * mt + 8 * rq + 4 * hi;
                    k4[mt][rq] = *(const LAS f32x4*)(Lkk + c0); r4[mt][rq] = *(const LAS f32x4*)(Lr + c0); }
            float saP[2], saZ[2];
#pragma unroll
            for (int nt = 0; nt < 2; ++nt) { f32x2_t p2 = {0.f, 0.f}, z2 = {0.f, 0.f};
#pragma unroll
                for (int mt = 0; mt < 2; ++mt)
#pragma unroll
                    for (int r = 0; r < 16; r += 2) { const f32x2_t kk2 = {k4[mt][r >> 2][r & 3], k4[mt][r >> 2][(r & 3) + 1]};
                        const f32x2_t xp2 = {XP[mt][nt][r], XP[mt][nt][r + 1]}, xz2 = {XZ[mt][nt][r], XZ[mt][nt][r + 1]};
                        p2 = __builtin_elementwise_fma(xp2, kk2, p2); z2 = __builtin_elementwise_fma(xz2, kk2, z2); }
                float p = p2.x + p2.y, z = z2.x + z2.y;
                p = half_sum32(p); z = half_sum32(z); saP[nt] = p; saZ[nt] = z; }
            bf16x8 af[2], bP[2], bZ[2];
#pragma unroll
            for (int mt = 0; mt < 2; ++mt) { const float bbv = Lbb[tt * 64 + 32 * mt + c31], kv = Lk[tt * 64 + 32 * mt + c31];
                const unsigned bh = bf_hi(bbv), kh = bf_hi(kv); const unsigned bl = bf_hi(bbv - __uint_as_float(bh << 16)), kl = bf_hi(kv - __uint_as_float(kh << 16));
                u32x4 u; u.x = bh | (bl << 16); u.y = bh | (kh << 16); u.z = kl | (kh << 16); u.w = 0u;
                if (hi) u = (u32x4){0u, 0u, 0u, 0u};
                af[mt] = __builtin_bit_cast(bf16x8, u); }
#pragma unroll
            for (int nt = 0; nt < 2; ++nt) { const float vv = Lv[tt * 64 + 32 * nt + c31];
                const unsigned ph = bf_hi(saP[nt]), zh = bf_hi(saZ[nt]), vh = bf_hi(vv);
                const unsigned pl = bf_hi(saP[nt] - __uint_as_float(ph << 16)), zl = bf_hi(saZ[nt] - __uint_as_float(zh << 16)), vl = bf_hi(vv - __uint_as_float(vh << 16));
                u32x4 up, uz; up.x = ph | (ph << 16); up.y = pl; up.z = 0u; up.w = 0u;
                uz.x = zh | (zh << 16); uz.y = zl | (vh << 16); uz.z = vh | (vl << 16); uz.w = 0u;
                if (hi) { up = (u32x4){0u, 0u, 0u, 0u}; uz = (u32x4){0u, 0u, 0u, 0u}; }
                bP[nt] = __builtin_bit_cast(bf16x8, up); bZ[nt] = __builtin_bit_cast(bf16x8, uz); }
#pragma unroll
            for (int mt = 0; mt < 2; ++mt)
#pragma unroll
                for (int nt = 0; nt < 2; ++nt) { XP[mt][nt] = MFMA32(af[mt], bP[nt], XP[mt][nt]); XZ[mt][nt] = MFMA32(af[mt], bZ[nt], XZ[mt][nt]); }
#pragma unroll
            for (int nt = 0; nt < 2; ++nt) { f32x2_t p2 = {0.f, 0.f}, z2 = {0.f, 0.f};
#pragma unroll
                for (int mt = 0; mt < 2; ++mt)
#pragma unroll
                    for (int r = 0; r < 16; r += 2) { const f32x2_t rr2 = {r4[mt][r >> 2][r & 3], r4[mt][r >> 2][(r & 3) + 1]};
                        const f32x2_t xp2 = {XP[mt][nt][r], XP[mt][nt][r + 1]}, xz2 = {XZ[mt][nt][r], XZ[mt][nt][r + 1]};
                        p2 = __builtin_elementwise_fma(xp2, rr2, p2); z2 = __builtin_elementwise_fma(xz2, rr2, z2); }
                float p = p2.x + p2.y, z = z2.x + z2.y;
                p = half_sum32(p); z = half_sum32(z);
                if (hi == 0) { ytil[(8 * sub + tt) * 64 + 32 * nt + c31] = f2bf(p); y0o[(8 * sub + tt) * 64 + 32 * nt + c31] = f2bf(z); } }
        }
    }
    int lane_e = lane0; asm volatile("" : "+v"(lane_e));
    Lw[lane_e] = Wrun; LDS_WAIT(); asm volatile("" ::: "memory");
    { const int hi_ = lane_e >> 5;
#pragma unroll
      for (int mt = 0; mt < 2; ++mt)
#pragma unroll
          for (int rq = 0; rq < 4; ++rq) { const f32x4 wl = *(const LAS f32x4*)(Lw + 32 * mt + 8 * rq + 4 * hi_);
#pragma unroll
              for (int nt = 0; nt < 2; ++nt)
#pragma unroll
                  for (int k = 0; k < 4; ++k) { XP[mt][nt][4 * rq + k] *= wl[k]; XZ[mt][nt][4 * rq + k] *= wl[k]; } } }
    { const int c31 = lane_e & 31, hi = lane_e >> 5;
      bf16_t* PT = (bf16_t*)(F.ws + WS_PT) + (size_t)task * 4096;
      bf16_t* ZP = (bf16_t*)(F.ws + WS_ZS) + (size_t)task * 4096;
#pragma unroll
      for (int mt = 0; mt < 2; ++mt)
#pragma unroll
          for (int nt = 0; nt < 2; ++nt) {
#pragma unroll
              for (int r = 0; r < 16; ++r) PT[(32 * mt + (r & 3) + 8 * (r >> 2) + 4 * hi) * 64 + 32 * nt + c31] = f2bf(XP[mt][nt][r]);
              u32x4 a, c2; a.x = pk2(XZ[mt][nt][0], XZ[mt][nt][1]); a.y = pk2(XZ[mt][nt][2], XZ[mt][nt][3]); a.z = pk2(XZ[mt][nt][4], XZ[mt][nt][5]); a.w = pk2(XZ[mt][nt][6], XZ[mt][nt][7]);
              c2.x = pk2(XZ[mt][nt][8], XZ[mt][nt][9]); c2.y = pk2(XZ[mt][nt][10], XZ[mt][nt][11]); c2.z = pk2(XZ[mt][nt][12], XZ[mt][nt][13]); c2.w = pk2(XZ[mt][nt][14], XZ[mt][nt][15]);
              *(u32x4*)(ZP + ((mt * 2 + nt) * 64 + lane_e) * 16) = a; *(u32x4*)(ZP + ((mt * 2 + nt) * 64 + lane_e) * 16 + 8) = c2; } }
    __syncthreads();
}
constexpr int CW_PREP = 768;
constexpr int CW_R1DONE = 896;
__device__ __forceinline__ void publish_count(Frame& F, unsigned* word) {
    asm volatile("s_waitcnt vmcnt(0)" ::: "memory"); __syncthreads();
    if (F.tid == 0) { __builtin_amdgcn_fence(__ATOMIC_RELEASE, "agent"); asm volatile("s_waitcnt vmcnt(0)" ::: "memory"); (void)__hip_atomic_fetch_add(word, 1u, RLX_AGENT); }
}
__device__ __forceinline__ void await_count(Frame& F, unsigned* word, unsigned want) {
    if (F.tid == 0) { unsigned sp = 0; while ((unsigned)__builtin_amdgcn_readfirstlane(__hip_atomic_load(word, RLX_AGENT)) < want) { __builtin_amdgcn_s_sleep(4); if (++sp > (1u << 24)) break; }
        __builtin_amdgcn_fence(__ATOMIC_ACQUIRE, "agent"); asm volatile("s_waitcnt vmcnt(0)" ::: "memory"); }
    __syncthreads();
}
__device__ __forceinline__ void phase_c(Frame& F, int layer) {
    if (F.bid < 192) r1_block(F, layer, F.bid);
    else { compress_unit(F, layer, F.bid - 192); LAUNDER(F); if (F.bid < 224) kmean_task(F, (F.bid - 192) * 8 + F.wave); }
    LAUNDER(F);
    publish_count(F, F.ctl + ((F.bid < 192) ? CW_R1DONE + 64 * layer + (F.bid >> 4) : CW_PREP + 64 * layer));
}

constexpr int KP = 72;
constexpr int TILE_B = 64 * KP * 2;
constexpr int AT_K0 = 0, AT_V0 = 2 * TILE_B;
constexpr int AT_IMP = 4 * TILE_B;
constexpr int AT_MISC = AT_IMP + 8 * 8192;
constexpr int AT_KMEAN = AT_MISC + 256;
constexpr int R2_SBUF = 0;

__device__ __forceinline__ bf16x8 lds_frag(const LAS bf16_t* tile, int row, int col) { return *(const LAS bf16x8*)(tile + row * KP + col); }
__device__ __forceinline__ s16x4 lds_tr(const LAS bf16_t* p) { return __builtin_bit_cast(s16x4, __builtin_amdgcn_ds_read_tr16_b64_v4i16((LAS v4i16_t*)p)); }
__device__ __forceinline__ bf16x8 cat8(s16x4 a, s16x4 b) { bf16x8 r; r[0] = a[0]; r[1] = a[1]; r[2] = a[2]; r[3] = a[3]; r[4] = b[0]; r[5] = b[1]; r[6] = b[2]; r[7] = b[3]; return r; }
__device__ __forceinline__ bf16x8 pack8(const f32x4& a, const f32x4& b) { u32x4 u; u.x = pk2(a.x, a.y); u.y = pk2(a.z, a.w); u.z = pk2(b.x, b.y); u.w = pk2(b.z, b.w); return __builtin_bit_cast(bf16x8, u); }

template <int NH>
__device__ __forceinline__ void qk_tile(const LAS bf16_t* Kt, const bf16x8 (&qf)[NH][2], f32x4 (&st)[NH][4], const float (&cm)[NH], int lane, const bool (&keep)[NH]) {
    const int r = lane & 15, kg = lane >> 4;
    f32x4 ci[NH];
#pragma unroll
    for (int g = 0; g < NH; ++g) { const float c = keep[g] ? cm[g] : -INFINITY; ci[g] = (f32x4){c, c, c, c}; }
#pragma unroll
    for (int kt = 0; kt < 4; ++kt) {
        const bf16x8 k0 = lds_frag(Kt, 16 * kt + r, 8 * kg), k1 = lds_frag(Kt, 16 * kt + r, 32 + 8 * kg);
#pragma unroll
        for (int g = 0; g < NH; ++g) { f32x4 z = MFMA16(k0, qf[g][0], ci[g]); st[g][kt] = MFMA16(k1, qf[g][1], z); }
    }
}
template <int NH, bool DO_V>
__device__ __forceinline__ void pv_tile(const LAS bf16_t* Vt, const f32x4 (&p)[NH][4], f32x4 (&o)[NH][4], f32x4 (&lacc)[NH], int lane) {
    const int kg = lane >> 4, rr = (lane & 15) >> 2, cc = 4 * (lane & 3);
    const u32x4 one4 = (u32x4){0x3f803f80u, 0x3f803f80u, 0x3f803f80u, 0x3f803f80u};
    const bf16x8 ones = __builtin_bit_cast(bf16x8, one4);
#pragma unroll
    for (int i = 0; i < 2; ++i) {
        bf16x8 pf[NH];
#pragma unroll
        for (int g = 0; g < NH; ++g) { pf[g] = pack8(p[g][2 * i], p[g][2 * i + 1]); lacc[g] = MFMA16(ones, pf[g], lacc[g]); }
        if (DO_V) {
#pragma unroll
            for (int dt = 0; dt < 4; ++dt) {
                const s16x4 lo = lds_tr(Vt + (32 * i + 4 * kg + rr) * KP + 16 * dt + cc), hi = lds_tr(Vt + (32 * i + 16 + 4 * kg + rr) * KP + 16 * dt + cc);
                const bf16x8 vf = cat8(lo, hi);
#pragma unroll
                for (int g = 0; g < NH; ++g) o[g][dt] = MFMA16(vf, pf[g], o[g][dt]);
            }
        }
    }
}
__device__ __forceinline__ void softmax_tile(f32x4 (&st)[4], f32x4 (&o)[4], f32x4& lacc, float& mref, int lane) {
    float mx = -INFINITY;
#pragma unroll
    for (int kt = 0; kt < 4; ++kt) mx = fmaxf(fmaxf(mx, fmaxf(st[kt].x, st[kt].y)), fmaxf(st[kt].z, st[kt].w));
    mx = fmaxf(mx, shx(mx, 16, lane)); mx = fmaxf(mx, shx(mx, 32, lane));
    const bool fresh = (mref == -INFINITY);
    if (__any((fresh && mx > -INFINITY) || mx > 8.0f)) {
        const float d = fresh ? ((mx == -INFINITY) ? 0.f : mx) : fmaxf(mx, 0.f);
        const float alpha = fresh ? 1.f : __builtin_amdgcn_exp2f(-d);
        mref = fresh ? mx : mref + d;
        lacc = lacc * alpha;
#pragma unroll
        for (int dt = 0; dt < 4; ++dt) o[dt] = o[dt] * alpha;
#pragma unroll
        for (int kt = 0; kt < 4; ++kt) st[kt] = st[kt] - d;
    }
#pragma unroll
    for (int kt = 0; kt < 4; ++kt) {
        st[kt].x = __builtin_amdgcn_exp2f(st[kt].x); st[kt].y = __builtin_amdgcn_exp2f(st[kt].y);
        st[kt].z = __builtin_amdgcn_exp2f(st[kt].z); st[kt].w = __builtin_amdgcn_exp2f(st[kt].w);
    }
}
#define MX2(a, b) __builtin_elementwise_maximum((float)(a), (float)(b))
#define MX3(a, b, c) MX2(MX2(a, b), c)
template <int NH>
__device__ __forceinline__ void softmax_tiles(f32x4 (&st)[NH][4], f32x4 (&o)[NH][4], f32x4 (&lacc)[NH], float (&mref)[NH], float (&cm)[NH], int lane) {
    float mx[NH];
#pragma unroll
    for (int g = 0; g < NH; ++g) {
        float a = MX3(st[g][0].x, st[g][0].y, st[g][0].z), c = MX3(st[g][2].x, st[g][2].y, st[g][2].z);
        a = MX3(a, st[g][0].w, st[g][1].x); c = MX3(c, st[g][2].w, st[g][3].x);
        a = MX3(a, st[g][1].y, st[g][1].z); c = MX3(c, st[g][3].y, st[g][3].z);
        mx[g] = MX3(MX3(a, st[g][1].w, st[g][3].w), c, c); }
#pragma unroll
    for (int g = 0; g < NH; ++g)
#pragma unroll
        for (int kt = 0; kt < 4; ++kt) {
            st[g][kt].x = __builtin_amdgcn_exp2f(st[g][kt].x); st[g][kt].y = __builtin_amdgcn_exp2f(st[g][kt].y);
            st[g][kt].z = __builtin_amdgcn_exp2f(st[g][kt].z); st[g][kt].w = __builtin_amdgcn_exp2f(st[g][kt].w);
        }
#pragma unroll
    for (int g = 0; g < NH; ++g) { const unsigned u = __float_as_uint(mx[g]); auto a = __builtin_amdgcn_permlane16_swap(u, u, false, false); mx[g] = MX2(__uint_as_float(a[0]), __uint_as_float(a[1])); }
#pragma unroll
    for (int g = 0; g < NH; ++g) { const unsigned u = __float_as_uint(mx[g]); auto a = __builtin_amdgcn_permlane32_swap(u, u, false, false); mx[g] = MX2(__uint_as_float(a[0]), __uint_as_float(a[1])); }
    bool need = false;
#pragma unroll
    for (int g = 0; g < NH; ++g) need = need | (((mref[g] == -INFINITY) & (mx[g] > -INFINITY)) | (mx[g] > 8.0f));
    if (__any(need)) {
#pragma unroll
        for (int g = 0; g < NH; ++g) {
            const bool fresh = (mref[g] == -INFINITY);
            const float d = fresh ? ((mx[g] == -INFINITY) ? 0.f : fmaxf(mx[g], -100.f)) : fmaxf(mx[g], 0.f);
            const float pf = __builtin_amdgcn_exp2f(-d);
            const float alpha = fresh ? 1.f : pf;
            mref[g] = fresh ? ((mx[g] == -INFINITY) ? -INFINITY : d) : mref[g] + d;
            cm[g] = (mref[g] == -INFINITY) ? 0.f : -mref[g];
            lacc[g] = lacc[g] * alpha;
#pragma unroll
            for (int dt = 0; dt < 4; ++dt) o[g][dt] = o[g][dt] * alpha;
#pragma unroll
            for (int kt = 0; kt < 4; ++kt) st[g][kt] = st[g][kt] * pf;
        }
    }
}
__device__ __forceinline__ void acc_pk(u32x2& d, const f32x4& v) {
    const float a = __uint_as_float(d.x << 16) + v.x, b = __uint_as_float(d.x & 0xffff0000u) + v.y, c = __uint_as_float(d.y << 16) + v.z, e = __uint_as_float(d.y & 0xffff0000u) + v.w;
    d.x = pk2(a, b); d.y = pk2(c, e); }
__device__ __forceinline__ u32x4 tile_load(const bf16_t* g, int tid) { const int off = (tid >> 3) * 64 + (tid & 7) * 8; return *(const u32x4*)(g + off); }
__device__ __forceinline__ void tile_store(LAS bf16_t* t, int tid, u32x4 v) { *(LAS u32x4*)(t + (tid >> 3) * KP + (tid & 7) * 8) = v; }

#define LDS_BAR() do { asm volatile("s_waitcnt lgkmcnt(0)" ::: "memory"); __builtin_amdgcn_s_barrier(); asm volatile("" ::: "memory"); } while (0)
__device__ __forceinline__ void nsa_task(Frame& F, int b, int kvh, int J) {
    const int lane = F.lane, tid = F.tid, wv = F.wave, q = lane & 15, kg = lane >> 4;
    const int t0 = 128 * J, tw0 = t0 + 16 * wv, tq_abs = tw0 + q, cur = tw0 >> 6, tq = tq_abs & 63;
    LAS bf16_t* Kb = (LAS bf16_t*)(F.lds + AT_K0); LAS bf16_t* Vb = (LAS bf16_t*)(F.lds + AT_V0);
    LAS float* imp = (LAS float*)(F.lds + AT_IMP + wv * 8192);
    const bf16_t* kvbase = (const bf16_t*)(F.ws + WS_KV6);
    const size_t slab = (size_t)(b * 2 + kvh) * SEQ * 64;
    const bf16_t* Kcmp = (const bf16_t*)(F.ws + WS_KCMP) + (size_t)(b * 2 + kvh) * 512 * 64;
    const bf16_t* Vcmp = (const bf16_t*)(F.ws + WS_VCMP) + (size_t)(b * 2 + kvh) * 512 * 64;
    const bf16_t* Ks = kvbase + 2 * KV6_STRIDE + slab; const bf16_t* Vs = kvbase + 3 * KV6_STRIDE + slab;
    const bf16_t* Kw = kvbase + 4 * KV6_STRIDE + slab; const bf16_t* Vw = kvbase + 5 * KV6_STRIDE + slab;
    bf16x8 qf[3][2];
#pragma unroll
    for (int g = 0; g < 3; ++g) { const bf16_t* qp = (const bf16_t*)(F.ws + WS_NQ) + (((b * 6 + 3 * kvh + g) * SEQ + tq_abs) * 64 + 8 * kg);
        qf[g][0] = *(const bf16x8*)qp; qf[g][1] = *(const bf16x8*)(qp + 32); }
#define NSA_GATEP ((const float*)(F.ws + WS_GATE) + ((b * SEQ + tq_abs) * 32 + 9 * kvh))
    for (int i = lane; i < 2048; i += 64) imp[i] = 0.f;
    const int imax_blk = (t0 + 127 - 31) >> 4;
    const int ntc = (imax_blk >> 6) + 1;
    const int imax_w = (tw0 + 15 >= 31) ? ((tw0 + 15 - 31) >> 4) : -1;
    const int ivis = (tq_abs >= 31) ? ((tq_abs - 31) >> 4) : -1;
    float m[3] = {-INFINITY, -INFINITY, -INFINITY}; float cm[3] = {0.f, 0.f, 0.f};
    f32x4 lacc[3] = {(f32x4){0.f, 0.f, 0.f, 0.f}, (f32x4){0.f, 0.f, 0.f, 0.f}, (f32x4){0.f, 0.f, 0.f, 0.f}};
    f32x4 st[3][4];
    f32x4 ob[3][4];
    const bool keep3[3] = {true, true, true};
#pragma unroll
    for (int g = 0; g < 3; ++g)
#pragma unroll
        for (int dt = 0; dt < 4; ++dt) ob[g][dt] = (f32x4){0.f, 0.f, 0.f, 0.f};
    {
        u32x4 kr = tile_load(Kcmp, tid);
        tile_store(Kb, tid, kr); __syncthreads();
        for (int ct = 0; ct < ntc; ++ct) {
            if (ct + 1 < ntc) kr = tile_load(Kcmp + (ct + 1) * 4096, tid);
            const LAS bf16_t* Kt = Kb + (ct & 1) * (TILE_B / 2);
            if (64 * ct <= imax_w) {
                qk_tile<3>(Kt, qf, st, cm, lane, keep3);
#pragma unroll
                for (int g = 0; g < 3; ++g) {
#pragma unroll
                    for (int kt = 0; kt < 4; ++kt)
#pragma unroll
                        for (int r = 0; r < 4; ++r) { const int i = 64 * ct + 16 * kt + 4 * kg + r; st[g][kt][r] = (i <= ivis) ? st[g][kt][r] : -INFINITY; }
                }
                softmax_tiles<3>(st, ob, lacc, m, cm, lane);
                pv_tile<3, false>(Kt, st, ob, lacc, lane);
            }
            if (ct + 1 < ntc) tile_store(Kb + ((ct + 1) & 1) * (TILE_B / 2), tid, kr);
            LDS_BAR();
        }
    }
    float invl[3]; float msafe[3];
#pragma unroll
    for (int g = 0; g < 3; ++g) { msafe[g] = (m[g] == -INFINITY) ? 0.f : m[g]; invl[g] = 1.f / fmaxf(lacc[g].x, 1e-30f); }
    {
        u32x4 kr = tile_load(Kcmp, tid), vr = tile_load(Vcmp, tid);
        tile_store(Kb, tid, kr); tile_store(Vb, tid, vr); __syncthreads();
        for (int ct = 0; ct < ntc; ++ct) {
            if (ct + 1 < ntc) { kr = tile_load(Kcmp + (ct + 1) * 4096, tid); vr = tile_load(Vcmp + (ct + 1) * 4096, tid); }
            const LAS bf16_t* Kt = Kb + (ct & 1) * (TILE_B / 2); const LAS bf16_t* Vt = Vb + (ct & 1) * (TILE_B / 2);
            if (64 * ct <= imax_w) {
                qk_tile<3>(Kt, qf, st, cm, lane, keep3);
#pragma unroll
                for (int g = 0; g < 3; ++g)
#pragma unroll
                    for (int kt = 0; kt < 4; ++kt)
#pragma unroll
                        for (int r = 0; r < 4; ++r) { const int i = 64 * ct + 16 * kt + 4 * kg + r;
                            st[g][kt][r] = (i <= ivis) ? __builtin_amdgcn_exp2f(st[g][kt][r]) * invl[g] : 0.f; }
#pragma unroll
                for (int kt = 0; kt < 4; ++kt) {
                    float a = 0.f, c = 0.f;
#pragma unroll
                    for (int g = 0; g < 3; ++g) { a += (st[g][kt].x + st[g][kt].y) + st[g][kt].z; c += st[g][kt].w; }
                    c *= 0.5f; a += c;
                    const float recv = __uint_as_float(__builtin_amdgcn_ds_bpermute(((lane + 48) & 63) << 2, __float_as_uint(c)));
                    const int ktp = 4 * ct + kt;
                    imp[ktp * 64 + lane] += a + (kg != 0 ? recv : 0.f);
                    if (kg == 0 && ktp + 1 < 32) imp[(ktp + 1) * 64 + lane] += recv;
                }
                pv_tile<3, true>(Vt, st, ob, lacc, lane);
            }
            if (ct + 1 < ntc) { tile_store(Kb + ((ct + 1) & 1) * (TILE_B / 2), tid, kr); tile_store(Vb + ((ct + 1) & 1) * (TILE_B / 2), tid, vr); }
            LDS_BAR();
        }
    }
#pragma unroll
    for (int g = 0; g < 3; ++g) { const float sc = sigm(NSA_GATEP[3 * g + 0]);
#pragma unroll
        for (int dt = 0; dt < 4; ++dt) ob[g][dt] = ob[g][dt] * sc; }
    unsigned msk[4] = {0u, 0u, 0u, 0u};
    if (cur <= 15) {
        msk[0] = (cur == 31) ? 0xffffffffu : ((1u << (cur + 1)) - 1u);
    } else {
        float iv[32];
#pragma unroll
        for (int k = 0; k < 32; ++k) { const int s = 4 * k + kg; const float v = imp[k * 64 + lane]; iv[k] = (s >= 1 && s <= cur - 2) ? v : -1.f; }
        msk[0] = 1u; msk[cur >> 5] |= 1u << (cur & 31); msk[(cur - 1) >> 5] |= 1u << ((cur - 1) & 31);
        for (int it = 0; it < 13; ++it) {
            float bv = -2.f; int bs = 1 << 20;
#pragma unroll
            for (int k = 0; k < 32; ++k) { if (iv[k] > bv) { bv = iv[k]; bs = 4 * k + kg; } }
#pragma unroll
            for (int sh = 16; sh <= 32; sh <<= 1) { const float ov = shx(bv, sh, lane); const int os = shxi(bs, sh, lane); if (ov > bv || (ov == bv && os < bs)) { bv = ov; bs = os; } }
#pragma unroll
            for (int k = 0; k < 32; ++k) if (4 * k + kg == bs) iv[k] = -1.f;
#pragma unroll
            for (int wd = 0; wd < 4; ++wd) if ((bs >> 5) == wd) msk[wd] |= 1u << (bs & 31);
        }
    }
    LAS u32x2* otp = (LAS u32x2*)imp;
#pragma unroll
    for (int g = 0; g < 3; ++g)
#pragma unroll
        for (int dt = 0; dt < 4; ++dt) { u32x2 o; o.x = pk2(ob[g][dt].x, ob[g][dt].y); o.y = pk2(ob[g][dt].z, ob[g][dt].w); otp[(g * 4 + dt) * 64 + lane] = o; }
    {
#pragma unroll
        for (int g = 0; g < 3; ++g) { m[g] = -INFINITY; cm[g] = 0.f; lacc[g] = (f32x4){0.f, 0.f, 0.f, 0.f};
#pragma unroll
            for (int dt = 0; dt < 4; ++dt) ob[g][dt] = (f32x4){0.f, 0.f, 0.f, 0.f}; }
        const int nb = 2 * J + 2;
        u32x4 kr[2], vr[2]; unsigned mw = 0u;
        kr[0] = tile_load(Ks, tid); vr[0] = tile_load(Vs, tid);
        kr[1] = tile_load(Ks + ((nb > 1) ? 4096 : 0), tid); vr[1] = tile_load(Vs + ((nb > 1) ? 4096 : 0), tid);
        tile_store(Kb, tid, kr[0]); tile_store(Vb, tid, vr[0]); __syncthreads();
        for (int s0 = 0; s0 < nb; s0 += 2) {
#pragma unroll
            for (int u = 0; u < 2; ++u) {
                const int s = s0 + u;
                if (s < nb) {
                    if (s + 2 < nb) { kr[u] = tile_load(Ks + (s + 2) * 4096, tid); vr[u] = tile_load(Vs + (s + 2) * 4096, tid); }
                    const LAS bf16_t* Kt = Kb + (s & 1) * (TILE_B / 2); const LAS bf16_t* Vt = Vb + (s & 1) * (TILE_B / 2);
                    if ((s & 31) == 0) mw = (s == 0) ? msk[0] : (s == 32) ? msk[1] : (s == 64) ? msk[2] : msk[3];
                    const bool sel = ((mw >> (s & 31)) & 1u) != 0u;
                    if (__any(sel)) {
                        const bool selk[3] = {sel, sel, sel};
                        qk_tile<3>(Kt, qf, st, cm, lane, selk);
                        if (s == cur) {
#pragma unroll
                            for (int g = 0; g < 3; ++g)
#pragma unroll
                                for (int kt = 0; kt < 4; ++kt)
#pragma unroll
                                    for (int r = 0; r < 4; ++r) { const int kk = 16 * kt + 4 * kg + r; st[g][kt][r] = (kk <= tq) ? st[g][kt][r] : -INFINITY; }
                        }
                        softmax_tiles<3>(st, ob, lacc, m, cm, lane);
                        pv_tile<3, true>(Vt, st, ob, lacc, lane);
                    }
                    if (s + 1 < nb) { tile_store(Kb + ((s + 1) & 1) * (TILE_B / 2), tid, kr[u ^ 1]); tile_store(Vb + ((s + 1) & 1) * (TILE_B / 2), tid, vr[u ^ 1]); }
                }
                LDS_BAR();
            }
        }
#pragma unroll
        for (int g = 0; g < 3; ++g) { const float sc = sigm(NSA_GATEP[3 * g + 1]) / fmaxf(lacc[g].x, 1e-30f);
#pragma unroll
            for (int dt = 0; dt < 4; ++dt) { u32x2 o = otp[(g * 4 + dt) * 64 + lane]; acc_pk(o, ob[g][dt] * sc); otp[(g * 4 + dt) * 64 + lane] = o; } }
    }
    {
#pragma unroll
        for (int g = 0; g < 3; ++g) { m[g] = -INFINITY; cm[g] = 0.f; lacc[g] = (f32x4){0.f, 0.f, 0.f, 0.f};
#pragma unroll
            for (int dt = 0; dt < 4; ++dt) ob[g][dt] = (f32x4){0.f, 0.f, 0.f, 0.f}; }
        const int s_lo = (2 * J - 8 > 0) ? 2 * J - 8 : 0, s_hi = 2 * J + 1, nb = s_hi - s_lo + 1;
        u32x4 kr[2], vr[2];
        kr[0] = tile_load(Kw + s_lo * 4096, tid); vr[0] = tile_load(Vw + s_lo * 4096, tid);
        kr[1] = tile_load(Kw + (s_lo + ((nb > 1) ? 1 : 0)) * 4096, tid); vr[1] = tile_load(Vw + (s_lo + ((nb > 1) ? 1 : 0)) * 4096, tid);
        tile_store(Kb, tid, kr[0]); tile_store(Vb, tid, vr[0]); __syncthreads();
        for (int it0 = 0; it0 < nb; it0 += 2) {
#pragma unroll
            for (int u = 0; u < 2; ++u) {
                const int it = it0 + u;
                if (it < nb) {
                    const int s = s_lo + it;
                    if (it + 2 < nb) { kr[u] = tile_load(Kw + (s + 2) * 4096, tid); vr[u] = tile_load(Vw + (s + 2) * 4096, tid); }
                    const LAS bf16_t* Kt = Kb + (it & 1) * (TILE_B / 2); const LAS bf16_t* Vt = Vb + (it & 1) * (TILE_B / 2);
                    if (s <= cur && s >= cur - 8) {
                        qk_tile<3>(Kt, qf, st, cm, lane, keep3);
                        if (s == cur || s == cur - 8) {
#pragma unroll
                            for (int g = 0; g < 3; ++g)
#pragma unroll
                                for (int kt = 0; kt < 4; ++kt)
#pragma unroll
                                    for (int r = 0; r < 4; ++r) { const int kk = 16 * kt + 4 * kg + r; const bool ok = (s == cur) ? (kk <= tq) : (kk > tq); st[g][kt][r] = ok ? st[g][kt][r] : -INFINITY; }
                        }
                        softmax_tiles<3>(st, ob, lacc, m, cm, lane);
                        pv_tile<3, true>(Vt, st, ob, lacc, lane);
                    }
                    if (it + 1 < nb) { tile_store(Kb + ((it + 1) & 1) * (TILE_B / 2), tid, kr[u ^ 1]); tile_store(Vb + ((it + 1) & 1) * (TILE_B / 2), tid, vr[u ^ 1]); }
                }
                LDS_BAR();
            }
        }
        bf16_t* mixp = (bf16_t*)(F.ws + WS_HM) + ((b * SEQ + tq_abs) * D + 3 * kvh * 64 + 4 * kg);
#pragma unroll
        for (int g = 0; g < 3; ++g) { const float sc = sigm(NSA_GATEP[3 * g + 2]) / fmaxf(lacc[g].x, 1e-30f);
#pragma unroll
            for (int dt = 0; dt < 4; ++dt) { u32x2 o = otp[(g * 4 + dt) * 64 + lane]; acc_pk(o, ob[g][dt] * sc); *(u32x2*)(mixp + g * 64 + 16 * dt) = o; } }
    }
}

__device__ __forceinline__ void moba_task(Frame& F, int b, int h, int own) {
    const int lane = F.lane, tid = F.tid, wv = F.wave, q = lane & 15, kg = lane >> 4;
    LAS bf16_t* Kb = (LAS bf16_t*)(F.lds + AT_K0); LAS bf16_t* Vb = (LAS bf16_t*)(F.lds + AT_V0); LAS bf16_t* Km = (LAS bf16_t*)(F.lds + AT_KMEAN);
    const size_t slab = (size_t)(b * 4 + h) * SEQ * 64;
    const bf16_t* Qg = (const bf16_t*)(F.ws + WS_MQKV) + slab; const bf16_t* Kg = Qg + MQKV_STRIDE; const bf16_t* Vg = Kg + MQKV_STRIDE;
    const int tw0 = 256 * own + 32 * wv;
    bf16x8 qf[2][2];
#pragma unroll
    for (int rt = 0; rt < 2; ++rt) { const bf16_t* qp = Qg + ((tw0 + 16 * rt + q) * 64 + 8 * kg); qf[rt][0] = *(const bf16x8*)qp; qf[rt][1] = *(const bf16x8*)(qp + 32); }
    if (tid < 256) { const u32x4 v = *(const u32x4*)((const bf16_t*)(F.ws + WS_KMEAN) + (size_t)(b * 4 + h) * 2048 + (tid >> 3) * 64 + (tid & 7) * 8); *(LAS u32x4*)(Km + (tid >> 3) * KP + (tid & 7) * 8) = v; }
    __syncthreads();
    unsigned msk[2] = {0u, 0u};
    {
        f32x4 gs[2][2];
#pragma unroll
        for (int kt = 0; kt < 2; ++kt) { const bf16x8 k0 = lds_frag(Km, 16 * kt + q, 8 * kg), k1 = lds_frag(Km, 16 * kt + q, 32 + 8 * kg);
#pragma unroll
            for (int rt = 0; rt < 2; ++rt) { f32x4 z = (f32x4){0.f, 0.f, 0.f, 0.f}; z = MFMA16(k0, qf[rt][0], z); gs[rt][kt] = MFMA16(k1, qf[rt][1], z); } }
#pragma unroll
        for (int rt = 0; rt < 2; ++rt) {
            float gv[8];
#pragma unroll
            for (int kt = 0; kt < 2; ++kt)
#pragma unroll
                for (int r = 0; r < 4; ++r) { const int blk = 16 * kt + 4 * kg + r; gv[4 * kt + r] = (blk < own) ? gs[rt][kt][r] : -INFINITY; }
            for (int it = 0; it < 3; ++it) {
                float bv = -INFINITY; int bs = 1 << 20;
#pragma unroll
                for (int k = 0; k < 8; ++k) { const int blk = 16 * (k >> 2) + 4 * kg + (k & 3); if (gv[k] > bv) { bv = gv[k]; bs = blk; } }
#pragma unroll
                for (int sh = 16; sh <= 32; sh <<= 1) { const float ov = shx(bv, sh, lane); const int os = shxi(bs, sh, lane); if (ov > bv || (ov == bv && os < bs)) { bv = ov; bs = os; } }
                if (bs < 32) { msk[rt] |= 1u << bs;
#pragma unroll
                    for (int k = 0; k < 8; ++k) if (16 * (k >> 2) + 4 * kg + (k & 3) == bs) gv[k] = -INFINITY; }
            }
        }
    }
    float m[2] = {-INFINITY, -INFINITY}; float cm[2] = {0.f, 0.f}; f32x4 lacc[2] = {(f32x4){0.f, 0.f, 0.f, 0.f}, (f32x4){0.f, 0.f, 0.f, 0.f}};
    f32x4 ob[2][4], st[2][4];
#pragma unroll
    for (int rt = 0; rt < 2; ++rt)
#pragma unroll
        for (int dt = 0; dt < 4; ++dt) ob[rt][dt] = (f32x4){0.f, 0.f, 0.f, 0.f};
    const int ntile = 4 * own + 4;
    u32x4 kr[2], vr[2];
    kr[0] = tile_load(Kg, tid); vr[0] = tile_load(Vg, tid); kr[1] = tile_load(Kg + 4096, tid); vr[1] = tile_load(Vg + 4096, tid);
    tile_store(Kb, tid, kr[0]); tile_store(Vb, tid, vr[0]); __syncthreads();
    for (int tau0 = 0; tau0 < ntile; tau0 += 2) {
#pragma unroll
        for (int u = 0; u < 2; ++u) {
            const int tau = tau0 + u;
            if (tau + 2 < ntile) { kr[u] = tile_load(Kg + (tau + 2) * 4096, tid); vr[u] = tile_load(Vg + (tau + 2) * 4096, tid); }
            const LAS bf16_t* Kt = Kb + (tau & 1) * (TILE_B / 2); const LAS bf16_t* Vt = Vb + (tau & 1) * (TILE_B / 2);
            const int blk = tau >> 2;
            bool sel[2]; bool anyv = false;
#pragma unroll
            for (int rt = 0; rt < 2; ++rt) { sel[rt] = (blk < own) ? ((msk[rt] >> blk) & 1u) : (64 * (tau & 3) <= 32 * wv + 16 * rt + q); anyv = anyv || sel[rt]; }
            if (__any(anyv)) {
                const bool selk[2] = {(blk < own) ? sel[0] : true, (blk < own) ? sel[1] : true};
                qk_tile<2>(Kt, qf, st, cm, lane, selk);
                if (blk >= own) {
#pragma unroll
                    for (int rt = 0; rt < 2; ++rt) {
                        const int trel = 32 * wv + 16 * rt + q;
#pragma unroll
                        for (int kt = 0; kt < 4; ++kt)
#pragma unroll
                            for (int r = 0; r < 4; ++r) { const int kk = 64 * (tau & 3) + 16 * kt + 4 * kg + r; st[rt][kt][r] = (kk <= trel) ? st[rt][kt][r] : -INFINITY; }
                    }
                }
                softmax_tiles<2>(st, ob, lacc, m, cm, lane);
                pv_tile<2, true>(Vt, st, ob, lacc, lane);
            }
            if (tau + 1 < ntile) { tile_store(Kb + ((tau + 1) & 1) * (TILE_B / 2), tid, kr[u ^ 1]); tile_store(Vb + ((tau + 1) & 1) * (TILE_B / 2), tid, vr[u ^ 1]); }
            LDS_BAR();
        }
    }
#pragma unroll
    for (int rt = 0; rt < 2; ++rt) {
        const float sc = 1.f / fmaxf(lacc[rt].x, 1e-30f);
        bf16_t* mix = (bf16_t*)(F.ws + WS_HM) + ((b * SEQ + tw0 + 16 * rt + q) * D + 384 + h * 64 + 4 * kg);
#pragma unroll
        for (int dt = 0; dt < 4; ++dt) { const f32x4 v = ob[rt][dt] * sc; u32x2 o; o.x = pk2(v.x, v.y); o.y = pk2(v.z, v.w); *(u32x2*)(mix + 16 * dt) = o; }
    }
}

constexpr int R2_RING = 16384, R2_SLOT = 12288;
__device__ __forceinline__ void r2_issue(const bf16_t* pt, const bf16_t* zp, LAS unsigned char* slot) {
#pragma unroll
    for (int mt = 0; mt < 2; ++mt)
#pragma unroll
        for (int ks = 0; ks < 4; ++ks) __builtin_amdgcn_global_load_lds((const unsigned*)(pt + mt * 2048 + ks * 16), (LAS unsigned*)(slot + (mt * 4 + ks) * 1024), 16, 0, 0);
#pragma unroll
    for (int mt = 0; mt < 2; ++mt)
#pragma unroll
        for (int q = 0; q < 2; ++q) __builtin_amdgcn_global_load_lds((const unsigned*)(zp + mt * 2048 + q * 8), (LAS unsigned*)(slot + 8192 + (mt * 2 + q) * 1024), 16, 0, 0);
}
__device__ __forceinline__ void r2_wave(Frame& F, int widx) {
    const int chain = widx >> 1, hf = widx & 1, lane = F.lane, c31 = lane & 31, hi = lane >> 5;
    LAS bf16_t* sb = (LAS bf16_t*)(F.lds + R2_SBUF + F.wave * (32 * KP * 2));
    LAS unsigned char* ring = F.lds + R2_RING + F.wave * (4 * R2_SLOT);
    for (int i = lane; i < 32 * KP / 2; i += 64) ((LAS unsigned*)sb)[i] = 0u;
    const bf16_t* PTl = (const bf16_t*)(F.ws + WS_PT) + (size_t)chain * 128 * 4096 + c31 * 64 + 8 * hi;
    const bf16_t* ZPl = (const bf16_t*)(F.ws + WS_ZS) + (size_t)chain * 128 * 4096 + (hf * 64 + lane) * 16;
    bf16_t* SS = (bf16_t*)(F.ws + WS_SS) + (size_t)chain * 128 * 4096 + (32 * hf) * 64;
    r2_issue(PTl, ZPl, ring); r2_issue(PTl + 4096, ZPl + 4096, ring + R2_SLOT); r2_issue(PTl + 2 * 4096, ZPl + 2 * 4096, ring + 2 * R2_SLOT);
#pragma unroll 1
    for (int c = 0; c < 128; ++c) {
        const int cn = (c + 3 < 128) ? c + 3 : 127;
        r2_issue(PTl + cn * 4096, ZPl + cn * 4096, ring + ((c + 3) & 3) * R2_SLOT);
        asm volatile("s_waitcnt vmcnt(36)" ::: "memory");
        const LAS unsigned char* sl = ring + (c & 3) * R2_SLOT + lane * 16;
        f32x16 acc[2];
#pragma unroll
        for (int mt = 0; mt < 2; ++mt)
#pragma unroll
            for (int q = 0; q < 2; ++q) { const u32x4 z = *(const LAS u32x4*)(sl + 8192 + (mt * 2 + q) * 1024);
                acc[mt][8 * q + 0] = __uint_as_float(z.x << 16); acc[mt][8 * q + 1] = __uint_as_float(z.x & 0xffff0000u); acc[mt][8 * q + 2] = __uint_as_float(z.y << 16); acc[mt][8 * q + 3] = __uint_as_float(z.y & 0xffff0000u);
                acc[mt][8 * q + 4] = __uint_as_float(z.z << 16); acc[mt][8 * q + 5] = __uint_as_float(z.z & 0xffff0000u); acc[mt][8 * q + 6] = __uint_as_float(z.w << 16); acc[mt][8 * q + 7] = __uint_as_float(z.w & 0xffff0000u); }
#pragma unroll
        for (int ks = 0; ks < 4; ++ks) {
            const bf16x8 bx = *(const LAS bf16x8*)(sb + c31 * KP + 16 * ks + 8 * hi);
#pragma unroll
            for (int mt = 0; mt < 2; ++mt) { const bf16x8 pa = *(const LAS bf16x8*)(sl + (mt * 4 + ks) * 1024); acc[mt] = MFMA32(pa, bx, acc[mt]); }
        }
#pragma unroll
        for (int mt = 0; mt < 2; ++mt)
#pragma unroll
            for (int r = 0; r < 16; ++r) sb[c31 * KP + 32 * mt + (r & 3) + 8 * (r >> 2) + 4 * hi] = f2bf(acc[mt][r]);
        bf16_t* ss = SS + c * 4096;
#pragma unroll
        for (int j = 0; j < 4; ++j) { const int qd = lane + 64 * j, row = qd >> 3, ch = qd & 7; *(u32x4*)(ss + row * 64 + ch * 8) = *(const LAS u32x4*)(sb + row * KP + ch * 8); }
    }
    asm volatile("s_waitcnt vmcnt(0)" ::: "memory");
}

struct TaskTable { unsigned short v[512]; };
constexpr TaskTable make_tasks() {
    TaskTable t{}; int n = 0, a = 63, am = 0, c = 31, cm = 0;
    while (a >= 0 || c >= 0) {
        const int ca = (a >= 0) ? 96 * a + 1344 : -1, cc = (c >= 0) ? 128 * c + 128 : -1;
        if (ca >= cc) { t.v[n++] = (unsigned short)(0 * 512 + am * 64 + a); if (++am == 4) { am = 0; --a; } }
        else { t.v[n++] = (unsigned short)(1 * 512 + cm * 64 + c); if (++cm == 8) { cm = 0; --c; } }
    }
    return t;
}
__device__ const TaskTable g_tasks = make_tasks();

__device__ __forceinline__ void r3_task(Frame& F, int layer, int task) {
    const int chain = task >> 7, c = task & 127, b = chain / 6, h = chain % 6, lane = F.lane, c31 = lane & 31, hi = lane >> 5;
    const bf16_t* S0 = (const bf16_t*)(F.ws + WS_SS) + (size_t)(task - 1) * 4096;
    const bf16_t* YT = (const bf16_t*)(F.ws + WS_YT) + (size_t)task * 4096;
    const bf16_t* Y0 = (const bf16_t*)(F.ws + WS_Y0) + (size_t)task * 4096;
    const bf16_t* rf = (const bf16_t*)(F.ws + WS_RFEAT);
    const bf16_t* gut = (const bf16_t*)(F.ws + WS_GUPT) + (size_t)(h * 64) * 128;
    const float* mu = INF(F, I_MU) + layer * RW;
    f32x16 acc[2][2], gacc[2][2];
#pragma unroll
    for (int a = 0; a < 2; ++a)
#pragma unroll
        for (int n = 0; n < 2; ++n)
#pragma unroll
            for (int r = 0; r < 16; ++r) { acc[a][n][r] = 0.f; gacc[a][n][r] = 0.f; }
    if (c > 0) {
#pragma unroll
        for (int ks = 0; ks < 4; ++ks) {
            bf16x8 af[2], bfr[2];
#pragma unroll
            for (int mt = 0; mt < 2; ++mt) af[mt] = *(const bf16x8*)(S0 + (32 * mt + c31) * 64 + 16 * ks + 8 * hi);
#pragma unroll
            for (int nt = 0; nt < 2; ++nt) bfr[nt] = *(const bf16x8*)(YT + (32 * nt + c31) * 64 + 16 * ks + 8 * hi);
#pragma unroll
            for (int mt = 0; mt < 2; ++mt)
#pragma unroll
                for (int nt = 0; nt < 2; ++nt) acc[mt][nt] = MFMA32(af[mt], bfr[nt], acc[mt][nt]);
        }
    }
#pragma unroll
    for (int ks = 0; ks < 8; ++ks) {
        bf16x8 af[2], bfr[2];
#pragma unroll
        for (int mt = 0; mt < 2; ++mt) af[mt] = *(const bf16x8*)(gut + (32 * mt + c31) * 128 + 16 * ks + 8 * hi);
#pragma unroll
        for (int nt = 0; nt < 2; ++nt) {
            const int t = 64 * c + 32 * nt + c31, j0 = 16 * ks + 8 * hi; const size_t row = (size_t)b * SEQ + t;
            const u32x4 cu = *(const u32x4*)(rf + row * RW + 1280 + j0);
            u32x4 pv = (u32x4){0u, 0u, 0u, 0u}; if (t > 0) pv = *(const u32x4*)(rf + (row - 1) * RW + 1280 + j0);
            const f32x4 m0 = *(const f32x4*)(mu + 1280 + j0), m1 = *(const f32x4*)(mu + 1280 + j0 + 4);
            float cv[8], pw[8];
            cv[0] = __uint_as_float(cu.x << 16); cv[1] = __uint_as_float(cu.x & 0xffff0000u); cv[2] = __uint_as_float(cu.y << 16); cv[3] = __uint_as_float(cu.y & 0xffff0000u);
            cv[4] = __uint_as_float(cu.z << 16); cv[5] = __uint_as_float(cu.z & 0xffff0000u); cv[6] = __uint_as_float(cu.w << 16); cv[7] = __uint_as_float(cu.w & 0xffff0000u);
            pw[0] = __uint_as_float(pv.x << 16); pw[1] = __uint_as_float(pv.x & 0xffff0000u); pw[2] = __uint_as_float(pv.y << 16); pw[3] = __uint_as_float(pv.y & 0xffff0000u);
            pw[4] = __uint_as_float(pv.z << 16); pw[5] = __uint_as_float(pv.z & 0xffff0000u); pw[6] = __uint_as_float(pv.w << 16); pw[7] = __uint_as_float(pv.w & 0xffff0000u);
            const float mm[8] = {m0.x, m0.y, m0.z, m0.w, m1.x, m1.y, m1.z, m1.w};
            float sg[8];
#pragma unroll
            for (int k = 0; k < 8; ++k) sg[k] = sigm(cv[k] + (pw[k] - cv[k]) * mm[k]);
            u32x4 u; u.x = pk2(sg[0], sg[1]); u.y = pk2(sg[2], sg[3]); u.z = pk2(sg[4], sg[5]); u.w = pk2(sg[6], sg[7]);
            bfr[nt] = __builtin_bit_cast(bf16x8, u);
        }
#pragma unroll
        for (int mt = 0; mt < 2; ++mt)
#pragma unroll
            for (int nt = 0; nt < 2; ++nt) gacc[mt][nt] = MFMA32(af[mt], bfr[nt], gacc[mt][nt]);
    }
    const float* lnw = INF(F, I_LNW) + layer * 384 + h * 64; const float* lnb = INF(F, I_LNB) + layer * 384 + h * 64;
    const float* bonus = (const float*)(F.ws + WS_BONUS);
    bf16_t* mix = (bf16_t*)(F.ws + WS_HM);
#pragma unroll
    for (int nt = 0; nt < 2; ++nt) {
        const int tl = 32 * nt + c31, t = 64 * c + tl; const size_t row = (size_t)b * SEQ + t;
        float s = 0.f;
#pragma unroll
        for (int mt = 0; mt < 2; ++mt)
#pragma unroll
            for (int rq = 0; rq < 4; ++rq) {
                const u32x2 y = *(const u32x2*)(Y0 + tl * 64 + 32 * mt + 8 * rq + 4 * hi);
                acc[mt][nt][4 * rq + 0] += __uint_as_float(y.x << 16); acc[mt][nt][4 * rq + 1] += __uint_as_float(y.x & 0xffff0000u);
                acc[mt][nt][4 * rq + 2] += __uint_as_float(y.y << 16); acc[mt][nt][4 * rq + 3] += __uint_as_float(y.y & 0xffff0000u);
                s += (acc[mt][nt][4 * rq] + acc[mt][nt][4 * rq + 1]) + (acc[mt][nt][4 * rq + 2] + acc[mt][nt][4 * rq + 3]);
            }
        s += shx(s, 32, lane);
        const float mean = s * (1.f / 64.f);
        float vs = 0.f;
#pragma unroll
        for (int mt = 0; mt < 2; ++mt)
#pragma unroll
            for (int r = 0; r < 16; ++r) { const float d = acc[mt][nt][r] - mean; vs += d * d; }
        vs += shx(vs, 32, lane);
        const float rstd = rsqrtf(vs * (1.f / 64.f) + 64e-5f);
        const float bn = bonus[row * 8 + h];
#pragma unroll
        for (int mt = 0; mt < 2; ++mt)
#pragma unroll
            for (int rq = 0; rq < 4; ++rq) {
                const int v0 = 32 * mt + 8 * rq + 4 * hi;
                const u32x2 vc = *(const u32x2*)(rf + row * RW + 768 + h * 64 + v0);
                u32x2 vp = (u32x2){0u, 0u}; if (t > 0) vp = *(const u32x2*)(rf + (row - 1) * RW + 768 + h * 64 + v0);
                const f32x4 mv = *(const f32x4*)(mu + 768 + h * 64 + v0), lw = *(const f32x4*)(lnw + v0), lb = *(const f32x4*)(lnb + v0);
                const float vcur[4] = {__uint_as_float(vc.x << 16), __uint_as_float(vc.x & 0xffff0000u), __uint_as_float(vc.y << 16), __uint_as_float(vc.y & 0xffff0000u)};
                const float vprv[4] = {__uint_as_float(vp.x << 16), __uint_as_float(vp.x & 0xffff0000u), __uint_as_float(vp.y << 16), __uint_as_float(vp.y & 0xffff0000u)};
                const float mvv[4] = {mv.x, mv.y, mv.z, mv.w}, lwv[4] = {lw.x, lw.y, lw.z, lw.w}, lbv[4] = {lb.x, lb.y, lb.z, lb.w};
                float o[4];
#pragma unroll
                for (int k = 0; k < 4; ++k) {
                    const float vsh = vcur[k] + (vprv[k] - vcur[k]) * mvv[k];
                    const float y = (acc[mt][nt][4 * rq + k] - mean) * rstd * lwv[k] + lbv[k];
                    o[k] = (y + bn * vsh) * gacc[mt][nt][4 * rq + k];
                }
                u32x2 ov; ov.x = pk2(o[0], o[1]); ov.y = pk2(o[2], o[3]);
                *(u32x2*)(mix + row * D + 640 + h * 64 + v0) = ov;
            }
    }
}
__device__ __forceinline__ void mixnorm_rows(Frame& F, int layer, int m0, int nrows) {
    bf16_t* mix = (bf16_t*)(F.ws + WS_HM);
    const float* gn = INF(F, I_NNSA) + layer * 384; const float* gm = INF(F, I_NMOBA) + layer * 256;
    const int lane = F.lane;
    for (int m = m0 + F.wave; m < m0 + nrows; m += NWAVES) {
        unsigned* rowp = (unsigned*)(mix + (size_t)m * D);
        unsigned a[3], c[2]; float sa = 0.f, sc = 0.f;
#pragma unroll
        for (int j = 0; j < 3; ++j) { a[j] = rowp[lane + 64 * j]; const float x = __uint_as_float(a[j] << 16), y = __uint_as_float(a[j] & 0xffff0000u); sa += x * x + y * y; }
#pragma unroll
        for (int j = 0; j < 2; ++j) { c[j] = rowp[192 + lane + 64 * j]; const float x = __uint_as_float(c[j] << 16), y = __uint_as_float(c[j] & 0xffff0000u); sc += x * x + y * y; }
        const float ra = rsqrtf(wave_sum(sa, lane) * (1.f / 384.f) + NORM_EPS), rc = rsqrtf(wave_sum(sc, lane) * (1.f / 256.f) + NORM_EPS);
#pragma unroll
        for (int j = 0; j < 3; ++j) { const int col = 2 * (lane + 64 * j); rowp[lane + 64 * j] = pk2(__uint_as_float(a[j] << 16) * ra * gn[col], __uint_as_float(a[j] & 0xffff0000u) * ra * gn[col + 1]); }
#pragma unroll
        for (int j = 0; j < 2; ++j) { const int col = 2 * (lane + 64 * j); rowp[192 + lane + 64 * j] = pk2(__uint_as_float(c[j] << 16) * rc * gm[col], __uint_as_float(c[j] & 0xffff0000u) * rc * gm[col + 1]); }
    }
}
__device__ __forceinline__ void phase_e(Frame& F, int layer) {
    const int gw = F.bid * NWAVES + F.wave, NGW = F.G * NWAVES;
    (void)gw; (void)NGW; (void)layer;
}

constexpr int CW_TILE = 1536;
constexpr int CW_R2DONE = 512;
__device__ __forceinline__ void phase_d(Frame& F, int layer, int rep = 0) {
    if (F.bid < 12 && rep == 0) {
        await_count(F, F.ctl + CW_R1DONE + 64 * layer + F.bid, 16u);
        if (F.wave < 2) { r2_wave(F, F.bid * 2 + F.wave);
            __builtin_amdgcn_fence(__ATOMIC_RELEASE, "agent"); asm volatile("s_waitcnt vmcnt(0)" ::: "memory");
            if (F.lane == 0) (void)__hip_atomic_fetch_add(F.ctl + CW_R2DONE + 64 * layer, 1u, RLX_AGENT); }
        __syncthreads();
#if DBG_MODE == 4
        if (F.bid == 0 && layer == 0) __hip_atomic_store(F.ctl + 3200 + 30, (unsigned)__builtin_amdgcn_s_memrealtime(), RLX_AGENT);
#endif
    }
    LAUNDER(F);
    await_count(F, F.ctl + CW_PREP + 64 * layer, 64u);
    LAUNDER(F);
    volatile LAS int* tw = (volatile LAS int*)(F.lds + AT_MISC);
    unsigned* qh = F.ctl + CW_Q + 64 * layer + 16 * rep;
    const int ntask = (rep == 0) ? 512 + 192 + 128 : 512;
    for (;;) {
        if (F.tid == 0) tw[0] = (int)__hip_atomic_fetch_add(qh, 1u, RLX_AGENT);
        __syncthreads();
        const int k = __builtin_amdgcn_readfirstlane(tw[0]);
        __syncthreads();
        if (k >= ntask) break;
        LAUNDER(F);
        if (k >= 512 + 192) {
            const int tile = k - (512 + 192);
            await_count(F, F.ctl + CW_TILE + 128 * layer + tile, 6u);
            mixnorm_rows(F, layer, tile * 128, 128);
            continue;
        }
        if (k >= 512) {
            if (F.tid == 0) { unsigned sp = 0; while ((unsigned)__builtin_amdgcn_readfirstlane(__hip_atomic_load(F.ctl + CW_R2DONE + 64 * layer, RLX_AGENT)) < 24u) { __builtin_amdgcn_s_sleep(4); if (++sp > (1u << 24)) break; }
                __builtin_amdgcn_fence(__ATOMIC_ACQUIRE, "agent"); asm volatile("s_waitcnt vmcnt(0)" ::: "memory"); }
            __syncthreads();
            r3_task(F, layer, (k - 512) * 8 + F.wave);
            continue;
        }
        const int code = g_tasks.v[k], ty = code >> 9, mm = (code >> 6) & 7, jj = code & 63;
        if (ty == 0) nsa_task(F, mm >> 1, mm & 1, jj); else moba_task(F, mm >> 2, mm & 3, jj);
        if (rep == 0) {
            asm volatile("s_waitcnt vmcnt(0)" ::: "memory"); __syncthreads();
            if (F.tid == 0) { __builtin_amdgcn_fence(__ATOMIC_RELEASE, "agent"); asm volatile("s_waitcnt vmcnt(0)" ::: "memory");
                unsigned* tc = F.ctl + CW_TILE + 128 * layer;
                if (ty == 0) (void)__hip_atomic_fetch_add(tc + (mm >> 1) * 64 + jj, 1u, RLX_AGENT);
                else { (void)__hip_atomic_fetch_add(tc + (mm >> 2) * 64 + 2 * jj, 1u, RLX_AGENT); (void)__hip_atomic_fetch_add(tc + (mm >> 2) * 64 + 2 * jj + 1, 1u, RLX_AGENT); } }
        }
    }
}

__device__ __forceinline__ void phase_g1(Frame& F, int layer) {
    LAS float* wr = (LAS float*)F.lds;
    { const float* W = INF(F, I_WROUTER);
#pragma unroll 1
      for (int i0 = 0; i0 < 4096; i0 += 2048) { f32x4 t4[4];
#pragma unroll
          for (int u = 0; u < 4; ++u) t4[u] = *(const f32x4*)(W + 4 * (i0 + u * NTHR + F.tid));
#pragma unroll
          for (int u = 0; u < 4; ++u) { const int i = 4 * (i0 + u * NTHR + F.tid), k = i >> 4, e = i & 15;
              wr[e * 1028 + k] = t4[u].x; wr[(e + 1) * 1028 + k] = t4[u].y; wr[(e + 2) * 1028 + k] = t4[u].z; wr[(e + 3) * 1028 + k] = t4[u].w; } } }
    __syncthreads();
    const float* mod = (const float*)(F.ws + WS_MOD);
    bf16_t* H = (bf16_t*)(F.ws + WS_HM);
    unsigned* cnt = F.ctl + CW_CNT + 64 * layer;
    const float* rb = INF(F, I_RBIAS);
    const float* gn = INF(F, I_NFFN) + layer * D;
    const int gw = F.bid * NWAVES + F.wave, NGW = F.G * NWAVES;
    const bf16_t* res = (const bf16_t*)(F.ws + WS_RES);
    u32x2 vnext[4];
#pragma unroll
    for (int j = 0; j < 4; ++j) vnext[j] = *(const u32x2*)(res + (size_t)gw * D + 4 * F.lane + 256 * j);
    int px = 0, pm = 0; float pw = 0.f; int ridx = 0;
    for (int m = gw; m < T; m += NGW, ++ridx) {
        int lane = F.lane; asm volatile("" : "+v"(lane));
        const int b = m >> 13;
        const float* sh = mod + ((size_t)layer * BATCH + b) * 6144 + 3072; const float* sc = sh + 1024;
        f32x4 v[4]; float ss = 0.f;
#pragma unroll
        for (int j = 0; j < 4; ++j) { const u32x2 t2 = vnext[j]; v[j] = (f32x4){__uint_as_float(t2.x << 16), __uint_as_float(t2.x & 0xffff0000u), __uint_as_float(t2.y << 16), __uint_as_float(t2.y & 0xffff0000u)};
            ss += (v[j].x * v[j].x + v[j].y * v[j].y) + (v[j].z * v[j].z + v[j].w * v[j].w); }
        const float rstd = rsqrtf(wave_sum(ss, lane) * (1.f / D) + NORM_EPS);
        float lg[16]; f32x2_t lgp[16];
#pragma unroll
        for (int e = 0; e < 16; ++e) lgp[e] = (f32x2_t){0.f, 0.f};
#pragma unroll
        for (int j = 0; j < 4; ++j) { const int col = 4 * lane + 256 * j;
            const f32x4 g = *(const f32x4*)(gn + col), s1 = *(const f32x4*)(sc + col), s0 = *(const f32x4*)(sh + col);
            const float hx = v[j].x * rstd * g.x * (1.f + s1.x) + s0.x, hy = v[j].y * rstd * g.y * (1.f + s1.y) + s0.y, hz = v[j].z * rstd * g.z * (1.f + s1.z) + s0.z, hw = v[j].w * rstd * g.w * (1.f + s1.w) + s0.w;
            u32x2 o; o.x = pk2(hx, hy); o.y = pk2(hz, hw); *(u32x2*)(H + (size_t)m * D + col) = o;
            const f32x2_t h01 = {hx, hy}, h23 = {hz, hw};
#pragma unroll
            for (int e = 0; e < 16; ++e) { const f32x4 w4 = *(const LAS f32x4*)(wr + e * 1028 + col);
                lgp[e] = __builtin_elementwise_fma(h01, (f32x2_t){w4.x, w4.y}, lgp[e]); lgp[e] = __builtin_elementwise_fma(h23, (f32x2_t){w4.z, w4.w}, lgp[e]); }
        }
#pragma unroll
        for (int e = 0; e < 16; ++e) lg[e] = lgp[e].x + lgp[e].y;
        { const int mn = (m + NGW < T) ? m + NGW : m;
#pragma unroll
          for (int j = 0; j < 4; ++j) vnext[j] = *(const u32x2*)(res + (size_t)mn * D + 4 * lane + 256 * j); }
        float r8[8], r4[4], r2[2], r1;
#pragma unroll
        for (int e = 0; e < 8; ++e) { auto sw = __builtin_amdgcn_permlane32_swap(__float_as_uint(lg[e]), __float_as_uint(lg[e + 8]), false, false); r8[e] = __uint_as_float(sw[0]) + __uint_as_float(sw[1]); }
#pragma unroll
        for (int e = 0; e < 4; ++e) { auto sw = __builtin_amdgcn_permlane16_swap(__float_as_uint(r8[e]), __float_as_uint(r8[e + 4]), false, false); r4[e] = __uint_as_float(sw[0]) + __uint_as_float(sw[1]); }
        { const bool up = (lane & 8) != 0;
#pragma unroll
          for (int e = 0; e < 2; ++e) { const float keep = up ? r4[e + 2] : r4[e], send = up ? r4[e] : r4[e + 2]; r2[e] = keep + dpp_mov<0x140>(send); } }
        { const bool up = (lane & 4) != 0; const float keep = up ? r2[1] : r2[0], send = up ? r2[0] : r2[1]; r1 = keep + dpp_mov<0x141>(send); }
        r1 += dpp_mov<0x4E>(r1); r1 += dpp_mov<0xB1>(r1);
        const int el = (((lane >> 5) & 1) << 3) | (((lane >> 4) & 1) << 2) | (((lane >> 3) & 1) << 1) | ((lane >> 2) & 1);
        const float affl = sigm(r1), bial = affl + rb[el];
        float aff[16], bia[16];
#pragma unroll
        for (int e = 0; e < 16; ++e) { const int src = ((e & 8) ? 32 : 0) | ((e & 4) ? 16 : 0) | ((e & 2) ? 8 : 0) | ((e & 1) ? 4 : 0);
            aff[e] = __uint_as_float(__builtin_amdgcn_readlane(__float_as_uint(affl), src)); bia[e] = __uint_as_float(__builtin_amdgcn_readlane(__float_as_uint(bial), src)); }
        int best = 0; float bscore = -INFINITY;
#pragma unroll
        for (int g = 0; g < 4; ++g) {
            float t1 = -INFINITY, t2 = -INFINITY;
#pragma unroll
            for (int k = 0; k < 4; ++k) { const float x = bia[4 * g + k]; if (x > t1) { t2 = t1; t1 = x; } else if (x > t2) t2 = x; }
            const float gs = t1 + t2; if (gs > bscore) { bscore = gs; best = g; }
        }
        float x4[4], a4[4];
#pragma unroll
        for (int k = 0; k < 4; ++k) { x4[k] = (best == 0) ? bia[k] : (best == 1) ? bia[4 + k] : (best == 2) ? bia[8 + k] : bia[12 + k]; a4[k] = (best == 0) ? aff[k] : (best == 1) ? aff[4 + k] : (best == 2) ? aff[8 + k] : aff[12 + k]; }
        int i1 = 0; float v1 = x4[0];
#pragma unroll
        for (int k = 1; k < 4; ++k) if (x4[k] > v1) { v1 = x4[k]; i1 = k; }
        int i2 = -1; float v2 = -INFINITY;
#pragma unroll
        for (int k = 0; k < 4; ++k) if (k != i1 && x4[k] > v2) { v2 = x4[k]; i2 = k; }
        float w1 = 0.f, w2 = 0.f;
#pragma unroll
        for (int k = 0; k < 4; ++k) { if (k == i1) w1 = a4[k]; if (k == i2) w2 = a4[k]; }
        const float ws = w1 + w2; w1 /= ws; w2 /= ws;
        if (lane == 2 * ridx) { px = 4 * best + i1; pm = m; pw = w1; }
        if (lane == 2 * ridx + 1) { px = 4 * best + i2; pm = m; pw = w2; }
    }
    LAUNDER(F);
    {
        const int lane = F.lane; const int np = 2 * ridx;
        int rank = 0, total = 0, leader = 64;
        for (int j = 0; j < np; ++j) { const int xj = __builtin_amdgcn_readlane(px, j); const bool same = (xj == px); rank += (same && j < lane) ? 1 : 0; total += same ? 1 : 0; leader = (same && j < leader) ? j : leader; }
        int base = 0;
        if (lane < np && rank == 0) base = (int)__hip_atomic_fetch_add(cnt + px, (unsigned)total, RLX_AGENT);
        base = __builtin_amdgcn_ds_bpermute((leader & 63) << 2, base);
        if (lane < np) { const int idx = px * 16384 + base + rank; ((int*)(F.ws + WS_ELIST))[idx] = 2 * pm + (lane & 1); ((float*)(F.ws + WS_EWW))[idx] = pw; }
    }
    asm volatile("s_waitcnt vmcnt(0)" ::: "memory"); __syncthreads();
    if (F.wave == 0) {
        unsigned tk = 0;
        if (F.lane == 0) { __builtin_amdgcn_fence(__ATOMIC_RELEASE, "agent"); asm volatile("s_waitcnt vmcnt(0)" ::: "memory"); tk = __hip_atomic_fetch_add(cnt + 32, 1u, RLX_AGENT); }
        tk = (unsigned)__builtin_amdgcn_readfirstlane((int)tk);
        if (tk == (unsigned)F.G - 1u) {
            __builtin_amdgcn_fence(__ATOMIC_ACQUIRE, "agent");
            const int lane = F.lane;
            int* tile_e = (int*)(F.ws + WS_ROWINFO + layer * ROWINFO_LSTRIDE) + 2 * MAXROWS;
            const int c = (lane < 16) ? (int)__hip_atomic_load(cnt + (lane & 15), RLX_AGENT) : 0, nt = (c + 255) >> 8;
            int ofs = 0, tot = 0;
            for (int e = 0; e < 16; ++e) { const int ne = __builtin_amdgcn_readlane(nt, e) << 8; ofs += (e < lane) ? ne : 0; tot += ne; }
            if (lane < 16) { tile_e[TE_OFF + lane] = ofs; tile_e[TE_CNT + lane] = c; for (int j = 0; j < nt; ++j) tile_e[(ofs >> 8) + j] = lane; }
            if (lane == 0) tile_e[256] = tot >> 8;
        }
    }
}
__device__ __forceinline__ void phase_g2(Frame& F, int layer) {
    volatile LAS int* off = (volatile LAS int*)F.lds;
    unsigned* cnt = F.ctl + CW_CNT + 64 * layer;
    int* rowinfo = (int*)(F.ws + WS_ROWINFO + layer * ROWINFO_LSTRIDE); float* roww = (float*)(rowinfo + MAXROWS); int* tile_e = rowinfo + 2 * MAXROWS; int* ntl = tile_e + 256;
    if (F.tid == 0) { int o = 0; for (int e = 0; e < 16; ++e) { off[e] = o; const int c = (int)__hip_atomic_load(cnt + e, RLX_AGENT); o += ((c + 255) >> 8) << 8; } off[16] = o; }
    __syncthreads();
    if (F.bid == 0) {
        if (F.tid == 0) ntl[0] = off[16] >> 8;
        for (int e = 0; e < 16; ++e) {
            const int c = (int)__hip_atomic_load(cnt + e, RLX_AGENT), o0 = off[e], o1 = off[e + 1];
            for (int r = o0 + c + F.tid; r < o1; r += NTHR) { rowinfo[r] = -1; roww[r] = 0.f; }
            for (int tl = (o0 >> 8) + F.tid; tl < (o1 >> 8); tl += NTHR) tile_e[tl] = e;
        }
    }
    const int* route = (const int*)(F.ws + WS_ROUTE);
    const int gw = F.bid * NWAVES + F.wave, NGW = F.G * NWAVES, lane = F.lane;
    for (int m = gw; m < T; m += NGW) {
        const int* rp = route + (size_t)m * 8;
        const int e1 = ld_ctl(rp), e2 = ld_ctl(rp + 1), p1 = ld_ctl(rp + 2), p2 = ld_ctl(rp + 3);
        const int r1 = off[e1] + p1, r2 = off[e2] + p2;
        if (lane == 0) { rowinfo[r1] = 2 * m; rowinfo[r2] = 2 * m + 1; roww[r1] = __int_as_float(ld_ctl(rp + 4)); roww[r2] = __int_as_float(ld_ctl(rp + 5)); }
    }
}

#if DBG_MODE == 2
__device__ __forceinline__ void dbg_flag(Frame& F, bool bad, unsigned code) { if (__any(bad) && F.lane == 0) atomicCAS(F.ctl + CW_DBG, 0u, code); }
__device__ __forceinline__ void scan_bf16(Frame& F, size_t off, size_t n, unsigned code) {
    const unsigned* p = (const unsigned*)(F.ws + off); bool bad = false;
    for (size_t i = (size_t)F.bid * NTHR + F.tid; i < n / 2; i += (size_t)F.G * NTHR) { const unsigned u = p[i]; bad = bad || ((u & 0x7f80u) == 0x7f80u) || ((u & 0x7f800000u) == 0x7f800000u); }
    dbg_flag(F, bad, code); }
__device__ __forceinline__ void scan_f32p(Frame& F, const float* p, size_t n, unsigned code) {
    bool bad = false;
    for (size_t i = (size_t)F.bid * NTHR + F.tid; i < n; i += (size_t)F.G * NTHR) { const unsigned u = __float_as_uint(p[i]); bad = bad || ((u & 0x7f800000u) == 0x7f800000u); }
    dbg_flag(F, bad, code); }
__device__ __forceinline__ void dbg_check(Frame& F, int p) {
    const unsigned code = (unsigned)(p + 1);
    if (DBG_SUB >= 4) {
        if (p != DBG_P) return;
        const size_t off = (DBG_SUB == 4) ? WS_ZS : (DBG_SUB == 5) ? WS_PT : (DBG_SUB == 6) ? WS_YT : WS_Y0;
        const unsigned* q = (const unsigned*)(F.ws + off); unsigned mx = 0;
        for (size_t i = (size_t)F.bid * NTHR + F.tid; i < (size_t)1536 * 2048; i += (size_t)F.G * NTHR) { const unsigned u = q[i]; const unsigned e0 = (u >> 7) & 0xffu, e1 = (u >> 23) & 0xffu; mx = mx > e0 ? mx : e0; mx = mx > e1 ? mx : e1; }
#if DBG_CNT
        { unsigned cnt = 0; for (size_t i = (size_t)F.bid * NTHR + F.tid; i < (size_t)1536 * 2048; i += (size_t)F.G * NTHR) { const unsigned u = q[i]; cnt += (((u >> 7) & 0xffu) == 0xffu) + (((u >> 23) & 0xffu) == 0xffu); }
          if (cnt) atomicAdd(F.ctl + CW_DBG, cnt); return; }
#endif
        atomicMax(F.ctl + CW_DBG, mx); return; }
    if (DBG_SUB == 3 && p != 4) return;
    if (p == 0) { scan_f32p(F, (const float*)(F.ws + WS_COS), (size_t)T * 64, code); scan_f32p(F, (const float*)(F.ws + WS_MOD), 2 * 2 * 6144, code); return; }
    if (p > 10 * NL) return;
    const int sub = (p - 1) % 10;
    switch (sub) {
    case 0: scan_bf16(F, WS_HM, (size_t)T * D, code); scan_bf16(F, WS_WIN, (size_t)NPAD * D, code); scan_bf16(F, WS_WOUT, (size_t)D * D, code); scan_bf16(F, WS_WUP, (size_t)16 * 512 * D, code);
            scan_bf16(F, WS_WDN, (size_t)16 * D * 256, code); scan_bf16(F, WS_PHIW, (size_t)2 * 64 * 2048, code); scan_bf16(F, WS_GUPT, 384 * 128, code); scan_f32p(F, (const float*)(F.ws + WS_PHIB), 256, code); break;
    case 1: scan_bf16(F, WS_NQ, (size_t)T * 384, code); scan_bf16(F, WS_KV6, (size_t)6 * T * 128, code); scan_bf16(F, WS_MQKV, (size_t)3 * T * 256, code); scan_bf16(F, WS_RFEAT, (size_t)T * RW, code);
            scan_f32p(F, (const float*)(F.ws + WS_GATE), (size_t)T * 32, code); break;
    case 2: scan_bf16(F, WS_KCMP, 2 * 2 * 512 * 64, code); scan_bf16(F, WS_VCMP, 2 * 2 * 512 * 64, code); scan_bf16(F, WS_KMEAN, 2 * 4 * 32 * 64, code);
            scan_bf16(F, WS_PT, (size_t)1536 * 4096, code); scan_bf16(F, WS_ZS, (size_t)1536 * 4096, code); scan_bf16(F, WS_YT, (size_t)1536 * 4096, code); scan_bf16(F, WS_Y0, (size_t)1536 * 4096, code);
            scan_f32p(F, (const float*)(F.ws + WS_BONUS), (size_t)T * 8, code); break;
    case 3: {
#if DBG_SUB == 3
        if (p == 4) { const unsigned* hm = (const unsigned*)(F.ws + WS_HM); bool b1 = false, b2 = false, b4 = false;
            for (size_t i = (size_t)F.bid * NTHR + F.tid; i < (size_t)T * 512; i += (size_t)F.G * NTHR) { const unsigned u = hm[i]; const int col = (int)(i & 511) * 2; const bool bad = ((u & 0x7f80u) == 0x7f80u) || ((u & 0x7f800000u) == 0x7f800000u);
                if (col < 384) b1 = b1 || bad; else if (col < 640) b2 = b2 || bad; }
            const unsigned* zs = (const unsigned*)(F.ws + WS_ZS);
            for (size_t i = (size_t)F.bid * NTHR + F.tid; i < (size_t)1536 * 2048; i += (size_t)F.G * NTHR) { const unsigned u = zs[i]; b4 = b4 || ((u & 0x7f80u) == 0x7f80u) || ((u & 0x7f800000u) == 0x7f800000u); }
            const unsigned bits = (__any(b1) ? 1u : 0u) | (__any(b2) ? 2u : 0u) | (__any(b4) ? 4u : 0u);
            if (bits && F.lane == 0) atomicOr(F.ctl + CW_DBG, bits); }
#else
        scan_bf16(F, WS_HM, (size_t)T * D, code); scan_bf16(F, WS_ZS, (size_t)1536 * 4096, code);
#endif
        } break;
    case 4: scan_bf16(F, WS_HM, (size_t)T * D, code); break;
    case 5: scan_f32p(F, F.out, (size_t)T * D, code); break;
    case 6: scan_bf16(F, WS_HM, (size_t)T * D, code); break;
    case 7: scan_bf16(F, WS_SORTA, (size_t)MAXROWS * D, code); break;
    case 8: scan_bf16(F, WS_HID, (size_t)MAXROWS * 256, code); break;
    case 9: scan_bf16(F, WS_YS, (size_t)2 * T * D, code); break;
    }
}
#endif
struct Args { const void* in[31]; float* out; unsigned char* ws; int ph_lo, ph_hi; };
constexpr int N_PHASES = 2 + 10 * NL + (DBG_MODE ? 1 : 0);

__global__ void __launch_bounds__(NTHR, 2) hybrid_fwd(Args args) {
    extern __shared__ __attribute__((aligned(16))) unsigned char lds_raw[];
    Frame F;
    F.lds = (LAS unsigned char*)lds_raw;
    F.MISC = (volatile LAS unsigned*)(F.lds + MISC_OFF);
    F.tid = threadIdx.x; F.lane = F.tid & 63; F.wave = __builtin_amdgcn_readfirstlane(F.tid >> 6);
    F.G = gridDim.x; F.bid = blockIdx.x;
    F.ws = (unsigned char*)(GAS unsigned char*)args.ws; F.out = (float*)(GAS float*)args.out; F.ctl = (unsigned*)(GAS unsigned*)(args.ws + WS_CTL);
    for (int u = F.tid; u < (LDS_BYTES - RING_BYTES) / 4; u += NTHR) ((LAS unsigned*)(F.lds + RING_BYTES))[u] = 0u;
    __syncthreads();
    if (F.tid < 31) *(LAS unsigned long long*)(F.lds + IN_OFF + 8 * F.tid) = (unsigned long long)args.in[F.tid];
    __syncthreads();
#if MK_PER_PHASE
#define GRID_BAR() do { } while (0)
#else
    XcdBarrier bar = xcd_barrier_post(F.ctl + CW_BAR, F.MISC + 8);
#define GRID_BAR() do { LAUNDER(F); xcd_barrier(bar, F.tid); } while (0)
#endif
    const int lo = args.ph_lo, hi = args.ph_hi;
    for (int ph_ = lo; ph_ < hi; ++ph_) {
        int ph = ph_; asm volatile("" : "+s"(ph));
#if DBG_MODE == 2
        if (ph > 0) { LAUNDER(F); dbg_check(F, ph - 1); }
#endif
#if DBG_MODE == 4
        if (blockIdx.x == 0) { const unsigned tnow = (unsigned)__builtin_amdgcn_s_memrealtime(); __hip_atomic_store((unsigned*)(args.ws + WS_CTL) + 3200 + ph_, tnow, RLX_AGENT); }
#endif
        for (int rep = 0; rep < ((REPEAT_PH >= 0 && ph_ == REPEAT_PH) ? 2 : 1); ++rep) {
        if (rep) GRID_BAR();
        if (ph == 0) { if (PH_EN(10)) { LAUNDER(F); phase_pro(F); LAUNDER(F); phase_a(F, 0, false, true); } }
#if DBG_MODE
        else if (ph == N_PHASES - 1) { LAUNDER(F);
#if DBG_MODE == 4
            const float dv = 100.f * floorf(4.f * log2f((float)(unsigned)(ld_ctl((const int*)(F.ctl + 3200 + DBG_TPH1)) - ld_ctl((const int*)(F.ctl + 3200 + DBG_TPH0)))) + DBG_QOFF);
            const float dv2 = 10000.f * floorf(4.f * log2f((float)(unsigned)(ld_ctl((const int*)(F.ctl + 3200 + DBG_TPH3)) - ld_ctl((const int*)(F.ctl + 3200 + DBG_TPH2)))) + DBG_QOFF);
            for (int i = F.bid * NTHR + F.tid; i < T * D; i += F.G * NTHR) F.out[i] = (i == 0) ? dv2 : dv;
            if (0)
#else
            const float dv = sqrtf((float)ld_ctl((const int*)(F.ctl + CW_DBG)));
#endif
            for (int i = F.bid * NTHR + F.tid; i < T * D; i += F.G * NTHR) F.out[i] = dv; }
        else if (ph == N_PHASES - 2) { if (PH_EN(11)) { LAUNDER(F); norm_rows(F, 0, true); } }
#else
        else if (ph == N_PHASES - 1) { if (PH_EN(11)) { LAUNDER(F); norm_rows(F, 0, true); } }
#endif
        else {
            const int layer = (ph - 1) / 10, sub = (ph - 1) % 10;
            switch (sub) {
            case 0: if (PH_EN(0)) { LAUNDER(F); phase_a(F, layer, true, layer > 0); } break;
            case 1: if (PH_EN(1)) { LAUNDER(F); pg8::Gemm g{(const bf16_t*)(F.ws + WS_HM), (const bf16_t*)(F.ws + WS_WIN), T, NPAD, D}; pg8::StaticOrder S; S.init(T, NPAD, F.G, F.bid, NPAD / 256 - 1);
                      EpiInProj E{(bf16_t*)(F.ws + WS_NQ), (bf16_t*)(F.ws + WS_KV6), (bf16_t*)(F.ws + WS_MQKV), (bf16_t*)(F.ws + WS_RFEAT), (float*)(F.ws + WS_GATE), (const float*)(F.ws + WS_COS), (const float*)(F.ws + WS_SIN)};
                      if (rep == 0) pg8::gemm_phase<EpiInProj, pg8::StaticOrder, true, true>(F.lds, g, S, E, F.tid);
                      else { EpiNull EN{(float*)(F.ws + WS_GATE)}; pg8::gemm_phase<EpiNull, pg8::StaticOrder, true, true>(F.lds, g, S, EN, F.tid); } } break;
            case 2: if (PH_EN(2)) { LAUNDER(F); phase_c(F, layer); LAUNDER(F); phase_d(F, layer, rep); } break;
            case 3: break;
            case 4: if (PH_EN(4)) { LAUNDER(F); phase_e(F, layer); } break;
            case 5: if (PH_EN(5)) { LAUNDER(F); pg8::Gemm g{(const bf16_t*)(F.ws + WS_HM), (const bf16_t*)(F.ws + WS_WOUT), T, D, D}; pg8::StaticOrder S; S.init(T, D, F.G, F.bid);
                      const float* g1p = (const float*)(F.ws + WS_MOD) + (size_t)layer * BATCH * 6144 + 2048;
                      if (layer == 0) { EpiOutProjT<true> E{INF(F, I_X), (const bf16_t*)F.out, (bf16_t*)(F.ws + WS_RES), g1p}; pg8::gemm_phase<EpiOutProjT<true>, pg8::StaticOrder, true, true>(F.lds, g, S, E, F.tid); }
                      else { EpiOutProjT<false> E{(const float*)nullptr, (const bf16_t*)F.out, (bf16_t*)(F.ws + WS_RES), g1p}; pg8::gemm_phase<EpiOutProjT<false>, pg8::StaticOrder, true, true>(F.lds, g, S, E, F.tid); } } break;
            case 6: if (PH_EN(6)) { LAUNDER(F); phase_g1(F, layer); } break;
            case 7: break;
            case 8: if (PH_EN(8)) { LAUNDER(F); const int* rowinfo = (const int*)(F.ws + WS_ROWINFO + layer * ROWINFO_LSTRIDE); const int* tile_e = rowinfo + 2 * MAXROWS;
                      const int ntl = __builtin_amdgcn_readfirstlane(ld_ctl(tile_e + 256));
                      pg8::Gemm g{(const bf16_t*)(F.ws + WS_HM), (const bf16_t*)(F.ws + WS_WUP), MAXROWS, 512, D};
                      MoeGatherOrder S{ntl, 2, F.G, F.bid, tile_e, (size_t)512 * D * 2, (const int*)(F.ws + WS_ELIST)};
                      EpiMoeUp E{(bf16_t*)(F.ws + WS_HID)};
                      pg8::gemm_phase<EpiMoeUp, MoeGatherOrder, true, true>(F.lds, g, S, E, F.tid); } break;
            case 9: if (PH_EN(9)) { LAUNDER(F); const int* rowinfo = (const int*)(F.ws + WS_ROWINFO + layer * ROWINFO_LSTRIDE); const int* tile_e = rowinfo + 2 * MAXROWS;
                      const int ntl = __builtin_amdgcn_readfirstlane(ld_ctl(tile_e + 256));
                      pg8::Gemm g{(const bf16_t*)(F.ws + WS_HID), (const bf16_t*)(F.ws + WS_WDN), MAXROWS, D, 256};
                      MoeOrder S{ntl, 4, F.G, F.bid, tile_e, (size_t)D * 256 * 2, (const int*)(F.ws + WS_ELIST)};
                      EpiMoeDown E{(bf16_t*)(F.ws + WS_YS), tile_e, (const int*)(F.ws + WS_ELIST), (const float*)(F.ws + WS_EWW)};
                      pg8::gemm_phase<EpiMoeDown, MoeOrder, true, true>(F.lds, g, S, E, F.tid); } break;
            }
        }
        }
#if EXTRA_BAR
        if (ph_ == 0) { for (int eb = 0; eb < EXTRA_BAR; ++eb) GRID_BAR(); }
#endif
        if (ph_ + 1 < hi && !(ph_ >= 1 && ph_ <= 10 * NL && (((ph_ - 1) % 10) == 2 || ((ph_ - 1) % 10) == 3 || ((ph_ - 1) % 10) == 7))) GRID_BAR();
    }
}

extern "C" void kernel_launch(void* const* d_in, const int* in_sizes, int n_in, void* d_out, int out_size, void* d_ws, size_t ws_size, hipStream_t stream) {
    static int grid = 0;
    if (grid == 0) {
        if (n_in != 31 || out_size != T * D || ws_size < WS_END) { fprintf(stderr, "kernel_launch: unexpected shapes: n_in %d out %d ws %zu (need %zu)\n", n_in, out_size, ws_size, (size_t)WS_END); grid = -1; return; }
        int dev = 0, cus = 0, per_cu = 0;
        if (hipGetDevice(&dev) != hipSuccess || hipDeviceGetAttribute(&cus, hipDeviceAttributeMultiprocessorCount, dev) != hipSuccess) { grid = -1; return; }
        if (hipFuncSetAttribute((const void*)hybrid_fwd, hipFuncAttributeMaxDynamicSharedMemorySize, LDS_BYTES) != hipSuccess) { fprintf(stderr, "kernel_launch: hipFuncSetAttribute failed\n"); grid = -1; return; }
        if (hipOccupancyMaxActiveBlocksPerMultiprocessor(&per_cu, (const void*)hybrid_fwd, NTHR, LDS_BYTES) != hipSuccess || per_cu < 1) fprintf(stderr, "kernel_launch: occupancy query says %d\n", per_cu);
        (void)hipGetLastError();
        grid = cus;
    }
    if (grid < 0) return;
    (void)hipMemsetAsync((char*)d_ws + WS_CTL, 0, CTL_ZERO_BYTES, stream);
    Args a{};
    for (int i = 0; i < 31; ++i) a.in[i] = d_in[i];
    a.out = (float*)d_out; a.ws = (unsigned char*)d_ws;
#if MK_PER_PHASE
    for (int ph = 0; ph < N_PHASES; ++ph) { a.ph_lo = ph; a.ph_hi = ph + 1; hipLaunchKernelGGL(hybrid_fwd, dim3(grid), dim3(NTHR), LDS_BYTES, stream, a); }
#else
    a.ph_lo = 0; a.ph_hi = N_PHASES;
    hipLaunchKernelGGL(hybrid_fwd, dim3(grid), dim3(NTHR), LDS_BYTES, stream, a);
#endif
}
```

```cpp
#include <hip/hip_runtime.h>
#include <cstdio>
#include <cstdint>
#include <cmath>
#ifndef PH_MASK
#define PH_MASK 0xfff
#endif
#define PH_EN(k) ((PH_MASK >> (k)) & 1)
#ifndef MK_PER_PHASE
#define MK_PER_PHASE 0
#endif
namespace pg8 {
#define PG8_LAS __attribute__((address_space(3)))
typedef unsigned short bf16_t;
typedef short bf16x8 __attribute__((ext_vector_type(8)));
typedef float f32x4 __attribute__((ext_vector_type(4)));
typedef unsigned u32x4 __attribute__((ext_vector_type(4)));
constexpr int BM = 256, BK = 64, HALF = 128, HTB = HALF * BK * 2  , STAGE_BYTES = 8 * HTB, NXCD = 8, WGM = 8;

__host__ __device__ __forceinline__ int lds_byte(int r, int c) { const int st = (r >> 4) * 2 + (c >> 5), rr = r & 15, cc = c & 31, ob = rr * 64 + cc * 2; return st * 1024 + (ob ^ (((ob >> 9) & 1) << 5)); }
__host__ __device__ __forceinline__ void stage_rc(int b, int& R, int& C) { const int st = b / 1024, sb = b % 1024, swz = sb ^ (((sb >> 9) & 1) << 5); R = (st >> 1) * 16 + swz / 64; C = (st & 1) * 32 + (swz % 64) / 2; }
__host__ __device__ __forceinline__ int perm32(int rho) { const int n = rho >> 4, i = rho & 15; return 8 * (i >> 2) + 4 * n + (i & 3); }

struct Unit { int pm, pn, mask; };
struct Gemm { const bf16_t* A; const bf16_t* Bt; int M, N, K; };

__host__ __device__ __forceinline__ bool tail_split(int i, int G, int c, int total, int& L, int& f, int& sub) {
    const int rounds = total / G, nfull = rounds * G, ntail = total - nfull; f = 1; sub = 0;
    if (i < rounds) { L = i * G + c; return true; }
    if (i > rounds || ntail == 0) return false;
    f = (4 * ntail <= G) ? 4 : (2 * ntail <= G) ? 2 : 1;
    if (c >= ntail * f) return false;
    L = nfull + c / f; sub = c % f; return true;
}
struct StaticOrder {
    int nM, nN, nwg, G, c, padpn;
    __host__ __device__ void init(int M, int N, int G_, int c_, int padpn_ = -1) { nM = M / BM; nN = N / BM; nwg = nM * nN; G = G_; c = c_; padpn = padpn_; }
    __host__ __device__ bool next(int i, Unit& u) const {
        int L, f, sub; if (!tail_split(i, G, c, nwg, L, f, sub)) return false;
        int wgid = L; { const int q = nwg / NXCD, r = nwg % NXCD, xcd = wgid % NXCD, off = wgid / NXCD; wgid = (xcd < r ? xcd * (q + 1) : r * (q + 1) + (xcd - r) * q) + off; }
        const int nig = WGM * nN, gid = wgid / nig, fm = gid * WGM, gsz = (nM - fm) < WGM ? (nM - fm) : WGM;
        u.pm = fm + ((wgid % nig) % gsz); u.pn = (wgid % nig) / gsz;
        const bool pad = (u.pn == padpn);
        u.mask = (f == 1) ? (pad ? 0x5 : 0xF) : (f == 2) ? (pad ? (sub ? 0x4 : 0x1) : (sub ? 0xA : 0x5)) : ((1 << sub) & (pad ? 0x5 : 0xF));
        return true;
    }
    static constexpr bool GATHER = false;
    __device__ __forceinline__ void arows(const Unit&, const int (&)[2], int (&o)[2][2]) const { o[0][0] = o[0][1] = o[1][0] = o[1][1] = 0; }
    __device__ __forceinline__ void a_ready(const Unit&) const {}
    __device__ __forceinline__ size_t boff(const Unit&) const { return 0; }
    __device__ __forceinline__ void done(const Unit&) const {}
};

template <class Epi, class Sched, bool ALIGN_EPI = false, bool SP2 = false>
__device__ __forceinline__ void gemm_phase(PG8_LAS unsigned char* lds, const Gemm g, const Sched& S, const Epi& E, const int tid_in) {
    const int tid = tid_in, wid = __builtin_amdgcn_readfirstlane(tid >> 6), lane = tid & 63, wr = wid >> 2, wc = wid & 3, fr = lane & 15, fq = lane >> 4;
    const int K = g.K, nt = K / BK;
    unsigned voffA[2], voffB[2];
    int RA[2], CA[2];
    unsigned gA_cur[2][2], gA_nxt[2][2];
    static_assert(!Sched::GATHER || SP2, "row-gathered A is wired into the SP2 loop only");
#pragma unroll
    for (int i = 0; i < 2; ++i) { int R, C; stage_rc(tid * 16 + i * 8192, R, C); const int Rb = Epi::PERM ? ((R & ~31) + perm32(R & 31)) : R;
        voffA[i] = (unsigned)(R * K + C) * 2u; voffB[i] = (unsigned)(Rb * K + C) * 2u; RA[i] = R; CA[i] = C; }
#define PG8_GROWS(u, o) do { int ar_[2][2]; S.arows(u, RA, ar_); _Pragma("unroll") for (int h_ = 0; h_ < 2; ++h_) _Pragma("unroll") for (int i_ = 0; i_ < 2; ++i_) o[h_][i_] = (unsigned)(ar_[h_][i_] * K + CA[i_]) * 2u; } while (0)
    const size_t kstep = (size_t)(BK * 2);
    const size_t hstep = (size_t)HALF * K * 2;
    const size_t tstep = 2 * hstep;
    const unsigned ldsw = (unsigned)wid * 1024u;
    const int aoff = lds_byte(wr * 64 + fr, fq * 8), boff = lds_byte(wc * 32 + fr, fq * 8);
#define PG8_SA(b, h) (((b) * 2 + (h)) * HTB)
#define PG8_SB(b, h) ((4 + (b) * 2 + (h)) * HTB)
#define PG8_STAGE(bufoff, gbase, voff) do { _Pragma("unroll") for (int _i = 0; _i < 2; ++_i) \
        __builtin_amdgcn_global_load_lds((const unsigned*)((const char*)(gbase) + (voff)[_i]), (PG8_LAS unsigned*)(lds + (bufoff) + ldsw + _i * 8192), 16, 0, 0); } while (0)
#define PG8_STAGE_A(bufoff, gbase, half, nx) do { if constexpr (Sched::GATHER) { _Pragma("unroll") for (int _i = 0; _i < 2; ++_i) { const unsigned vo_ = (nx) ? gA_nxt[half][_i] : gA_cur[half][_i]; \
        __builtin_amdgcn_global_load_lds((const unsigned*)((const char*)(gbase) + vo_), (PG8_LAS unsigned*)(lds + (bufoff) + ldsw + _i * 8192), 16, 0, 0); } } else { PG8_STAGE(bufoff, (gbase) + (half) * hstep, voffA); } } while (0)
#define PG8_LDA(dst, b, h) do { _Pragma("unroll") for (int m = 0; m < 4; ++m) _Pragma("unroll") for (int k = 0; k < 2; ++k) dst[m][k] = *(const PG8_LAS bf16x8*)(lds + PG8_SA(b, h) + aoff + m * 2048 + k * 1024); } while (0)
#define PG8_LDB(dst, b, h) do { _Pragma("unroll") for (int n = 0; n < 2; ++n) _Pragma("unroll") for (int k = 0; k < 2; ++k) dst[n][k] = *(const PG8_LAS bf16x8*)(lds + PG8_SB(b, h) + boff + n * 2048 + k * 1024); } while (0)
#define PG8_MMA(ai, bj, At, Bt) do { if (cmask & (1 << ((ai) * 2 + (bj)))) PG8_MMA_(ai, bj, At, Bt); } while (0)
#define PG8_MMA_(ai, bj, At, Bt) do { __builtin_amdgcn_s_setprio(1); _Pragma("unroll") for (int m = 0; m < 4; ++m) _Pragma("unroll") for (int n = 0; n < 2; ++n) _Pragma("unroll") for (int k = 0; k < 2; ++k) \
        acc[ai][bj][m][n] = __builtin_amdgcn_mfma_f32_16x16x32_bf16(Bt[n][k], At[m][k], acc[ai][bj][m][n], 0, 0, 0); __builtin_amdgcn_s_setprio(0); } while (0)
#define PG8_WAIT_V(n) asm volatile("s_waitcnt vmcnt(" #n ")" ::: "memory")
#define PG8_WAIT_L(n) asm volatile("s_waitcnt lgkmcnt(" #n ")" ::: "memory")
#define PG8_BAR __builtin_amdgcn_s_barrier()
#define PG8_SCHED __builtin_amdgcn_sched_barrier(0)
    Unit cur, nxt; int ui = 0;
    if (!S.next(0, cur)) return;
    f32x4 acc[2][2][4][2];
#pragma unroll
    for (int a = 0; a < 2; ++a)
#pragma unroll
        for (int b = 0; b < 2; ++b)
#pragma unroll
            for (int m = 0; m < 4; ++m)
#pragma unroll
                for (int n = 0; n < 2; ++n) acc[a][b][m][n] = (f32x4){0.f, 0.f, 0.f, 0.f};
    bf16x8 At[4][2], B0[2][2], B1[2][2];
    const char* cA = (const char*)g.A + (Sched::GATHER ? (size_t)0 : (size_t)cur.pm * tstep); const char* cB = (const char*)g.Bt + S.boff(cur) + (size_t)cur.pn * tstep;
    S.a_ready(cur);
    if constexpr (Sched::GATHER) { PG8_GROWS(cur, gA_cur); }
    if constexpr (SP2) {
        PG8_STAGE(PG8_SB(0, 0), cB, voffB); PG8_STAGE(PG8_SB(0, 1), cB + hstep, voffB); PG8_STAGE_A(PG8_SA(0, 0), cA, 0, false); PG8_STAGE_A(PG8_SA(0, 1), cA, 1, false);
        if (wr == 1) PG8_BAR;
        PG8_WAIT_V(2); PG8_BAR;
        PG8_STAGE(PG8_SB(1, 0), cB + kstep, voffB); PG8_STAGE_A(PG8_SA(1, 0), cA + kstep, 0, false); PG8_STAGE(PG8_SB(1, 1), cB + hstep + kstep, voffB);
        PG8_WAIT_V(6); PG8_BAR;
    } else {
        PG8_STAGE(PG8_SB(0, 0), cB, voffB); PG8_STAGE(PG8_SA(0, 0), cA, voffA); PG8_STAGE(PG8_SB(0, 1), cB + hstep, voffB); PG8_STAGE(PG8_SA(0, 1), cA + hstep, voffA);
        if (wr == 1) PG8_BAR;
        PG8_WAIT_V(4); PG8_BAR;
        PG8_STAGE(PG8_SB(1, 0), cB + kstep, voffB); PG8_STAGE(PG8_SA(1, 0), cA + kstep, voffA); PG8_STAGE(PG8_SB(1, 1), cB + hstep + kstep, voffB);
        PG8_WAIT_V(6); PG8_BAR;
    }
    for (;;) {
        const int cmask = __builtin_amdgcn_readfirstlane(cur.mask);
        const bool has_next = S.next(ui + 1, nxt);
        const char* nA = has_next ? (const char*)g.A + (Sched::GATHER ? (size_t)0 : (size_t)nxt.pm * tstep) : cA; const char* nB = has_next ? (const char*)g.Bt + S.boff(nxt) + (size_t)nxt.pn * tstep : cB;
        if constexpr (Sched::GATHER) { if (has_next) { PG8_GROWS(nxt, gA_nxt); } }
        for (int t = 0; t < nt; t += 2) {
            const bool last = (t == nt - 2);
            const char* a1 = cA + (size_t)(t + 1) * kstep;
            const char* a2 = last ? nA : cA + (size_t)(t + 2) * kstep; const char* b2 = last ? nB : cB + (size_t)(t + 2) * kstep;
            const char* a3 = a2 + kstep; const char* b3 = b2 + kstep;
            if (last && has_next) S.a_ready(nxt);
            const bool usen = last && has_next;
            if constexpr (SP2) {
            PG8_LDB(B0, 0, 0); PG8_LDB(B1, 0, 1); PG8_SCHED; PG8_LDA(At, 0, 0); PG8_STAGE_A(PG8_SA(1, 1), a1, 1, false);
            PG8_WAIT_V(8); PG8_WAIT_L(0); PG8_BAR; PG8_MMA(0, 0, At, B0); PG8_MMA(0, 1, At, B1); PG8_BAR; PG8_SCHED;
            PG8_LDA(At, 0, 1); PG8_STAGE(PG8_SB(0, 0), b2, voffB); PG8_STAGE(PG8_SB(0, 1), b2 + hstep, voffB); PG8_STAGE_A(PG8_SA(0, 0), a2, 0, usen);
            PG8_WAIT_V(8); PG8_WAIT_L(0); PG8_BAR; PG8_MMA(1, 0, At, B0); PG8_MMA(1, 1, At, B1); PG8_BAR; PG8_SCHED;
            PG8_LDB(B0, 1, 0); PG8_LDB(B1, 1, 1); PG8_SCHED; PG8_LDA(At, 1, 0); PG8_STAGE_A(PG8_SA(0, 1), a2, 1, usen);
            PG8_WAIT_V(8); PG8_WAIT_L(0); PG8_BAR; PG8_MMA(0, 0, At, B0); PG8_MMA(0, 1, At, B1); PG8_BAR; PG8_SCHED;
            PG8_LDA(At, 1, 1); PG8_STAGE(PG8_SB(1, 0), b3, voffB); PG8_STAGE(PG8_SB(1, 1), b3 + hstep, voffB); PG8_STAGE_A(PG8_SA(1, 0), a3, 0, usen);
            PG8_WAIT_V(8); PG8_WAIT_L(0); PG8_BAR; PG8_MMA(1, 0, At, B0); PG8_MMA(1, 1, At, B1); PG8_BAR; PG8_SCHED;
            } else {
            PG8_LDB(B0, 0, 0); PG8_SCHED; PG8_LDA(At, 0, 0); PG8_STAGE(PG8_SA(1, 1), a1 + hstep, voffA);
            PG8_WAIT_L(8); PG8_BAR; PG8_WAIT_L(0); PG8_MMA(0, 0, At, B0); PG8_BAR; PG8_SCHED;
            PG8_LDB(B1, 0, 1); PG8_STAGE(PG8_SB(0, 0), b2, voffB);
            PG8_BAR; PG8_WAIT_L(0); PG8_MMA(0, 1, At, B1); PG8_BAR;
            PG8_LDA(At, 0, 1); PG8_STAGE(PG8_SA(0, 0), a2, voffA);
            PG8_BAR; PG8_WAIT_L(0); PG8_MMA(1, 0, At, B0); PG8_BAR; PG8_SCHED;
            PG8_STAGE(PG8_SB(0, 1), b2 + hstep, voffB);
            PG8_WAIT_V(6); PG8_BAR; PG8_MMA(1, 1, At, B1); PG8_BAR;
            PG8_LDB(B0, 1, 0); PG8_SCHED; PG8_LDA(At, 1, 0); PG8_STAGE(PG8_SA(0, 1), a2 + hstep, voffA);
            PG8_WAIT_L(8); PG8_BAR; PG8_WAIT_L(0); PG8_MMA(0, 0, At, B0); PG8_BAR; PG8_SCHED;
            PG8_LDB(B1, 1, 1); PG8_STAGE(PG8_SB(1, 0), b3, voffB);
            PG8_BAR; PG8_WAIT_L(0); PG8_MMA(0, 1, At, B1); PG8_BAR;
            PG8_LDA(At, 1, 1); PG8_STAGE(PG8_SA(1, 0), a3, voffA);
            PG8_BAR; PG8_WAIT_L(0); PG8_MMA(1, 0, At, B0); PG8_BAR; PG8_SCHED;
            PG8_STAGE(PG8_SB(1, 1), b3 + hstep, voffB);
            PG8_WAIT_V(6); PG8_BAR; PG8_MMA(1, 1, At, B1); PG8_BAR;
            }
        }
        if constexpr (ALIGN_EPI) { if (wr == 0) PG8_BAR; }
        if constexpr (!Epi::AFTER_DRAIN) { E(acc, cur, wr, wc, 0, 0); S.done(cur); }
        if (!has_next) break;
#pragma unroll
        for (int a = 0; a < 2; ++a)
#pragma unroll
            for (int b = 0; b < 2; ++b)
#pragma unroll
                for (int m = 0; m < 4; ++m)
#pragma unroll
                    for (int n = 0; n < 2; ++n) acc[a][b][m][n] = (f32x4){0.f, 0.f, 0.f, 0.f};
        cur = nxt; cA = nA; cB = nB; ++ui;
        if constexpr (Sched::GATHER) {
#pragma unroll
            for (int h_ = 0; h_ < 2; ++h_)
#pragma unroll
                for (int i_ = 0; i_ < 2; ++i_) gA_cur[h_][i_] = gA_nxt[h_][i_]; }
        if constexpr (ALIGN_EPI) { if (wr == 1) PG8_BAR; }
    }
    PG8_WAIT_V(0);
    if constexpr (!ALIGN_EPI) { if (wr == 0) PG8_BAR; }
    PG8_BAR;
    if constexpr (Epi::AFTER_DRAIN) { E.fused(acc, cur, wr, wc, fr, fq, lds, wid, lane); S.done(cur); }
#undef PG8_SA
#undef PG8_SB
#undef PG8_STAGE
#undef PG8_STAGE_A
#undef PG8_GROWS
#undef PG8_LDA
#undef PG8_LDB
#undef PG8_MMA
#undef PG8_MMA_
#undef PG8_WAIT_V
#undef PG8_WAIT_L
#undef PG8_BAR
#undef PG8_SCHED
}
}

constexpr int BATCH = 2, SEQ = 8192, T = BATCH * SEQ, D = 1024, NL = 2;
constexpr int NPAD = 3584, RW = 1408, INCOLS = 3346;
constexpr int NWAVES = 8, NTHR = 512;
constexpr float LOG2E = 1.4426950408889634f;
constexpr float NORM_EPS = 1e-6f;

#define GAS __attribute__((address_space(1)))
#define LAS __attribute__((address_space(3)))
typedef unsigned short bf16_t;
typedef short bf16x8 __attribute__((ext_vector_type(8)));
typedef short s16x4 __attribute__((ext_vector_type(4)));
typedef short v4i16_t __attribute__((ext_vector_type(4)));
typedef float f32x4 __attribute__((ext_vector_type(4)));
typedef float f32x16 __attribute__((ext_vector_type(16)));
typedef unsigned u32x4 __attribute__((ext_vector_type(4)));
typedef unsigned u32x2 __attribute__((ext_vector_type(2)));
typedef GAS unsigned gu32;

constexpr size_t MiB = 1u << 20, KiB = 1u << 10;
constexpr size_t WS_CTL = 0, CTL_ZERO_BYTES = 64 * KiB;
constexpr size_t WS_COS = 1 * MiB, WS_SIN = 3 * MiB;
constexpr size_t WS_MOD = 5 * MiB;
constexpr size_t WS_PHIB = WS_MOD + 128 * KiB;
constexpr size_t WS_KMEAN = WS_MOD + 192 * KiB;
constexpr size_t WS_KCMP = WS_MOD + 256 * KiB;
constexpr size_t WS_VCMP = WS_KCMP + 256 * KiB;
constexpr size_t WS_BONUS = 6 * MiB;
constexpr size_t WS_GATE = 7 * MiB;
constexpr size_t WS_ROUTE = 9 * MiB;
constexpr size_t WS_ROWINFO = 10 * MiB;
constexpr size_t ROWINFO_LSTRIDE = 512 * KiB;
constexpr int MAXROWS = 36864;
constexpr size_t WS_RES = 78 * MiB;
constexpr size_t WS_ELIST = 9 * MiB;
constexpr size_t WS_EWW = 11 * MiB;
constexpr int TE_OFF = 272, TE_CNT = 304;
constexpr size_t WS_WIN = 12 * MiB;
constexpr size_t WS_WOUT = 19 * MiB;
constexpr size_t WS_WUP = 21 * MiB;
constexpr size_t WS_WDN = 37 * MiB;
constexpr size_t WS_PHIW = 45 * MiB;
constexpr size_t WS_GUPT = 45 * MiB + 512 * KiB;
constexpr size_t WS_WUPT = 45 * MiB + 640 * KiB;
constexpr size_t WS_AUPT = 45 * MiB + 704 * KiB;
constexpr size_t WS_LORA = 46 * MiB;
constexpr size_t WS_HM = 46 * MiB;
constexpr size_t WS_NQ = 78 * MiB;
constexpr size_t WS_KV6 = 90 * MiB;
constexpr size_t KV6_STRIDE = (size_t)BATCH * 2 * SEQ * 64;
constexpr size_t WS_MQKV = 114 * MiB;
constexpr size_t MQKV_STRIDE = (size_t)BATCH * 4 * SEQ * 64;
constexpr size_t WS_RFEAT = 138 * MiB;
constexpr size_t WS_SORTA = 78 * MiB;
constexpr size_t WS_HID = 150 * MiB;
constexpr size_t WS_PT = 182 * MiB;
constexpr size_t WS_ZS = 194 * MiB;
constexpr size_t WS_YT = 206 * MiB;
constexpr size_t WS_Y0 = 218 * MiB;
constexpr size_t WS_YS = 182 * MiB;
constexpr size_t WS_SS = 230 * MiB;
constexpr size_t WS_END = 256 * MiB;
constexpr int CW_Q = 64;
constexpr int CW_CNT = 1024;
constexpr int CW_BAR = 4096;
constexpr int CW_DBG = 3072;
#ifndef DBG_MODE
#define DBG_MODE 0
#endif
#ifndef EXTRA_BAR
#define EXTRA_BAR 0
#endif
#ifndef REPEAT_PH
#define REPEAT_PH -1
#endif
#ifndef DBG_TPH0
#define DBG_TPH0 0
#endif
#ifndef DBG_TPH1
#define DBG_TPH1 1
#endif
#ifndef DBG_QOFF
#define DBG_QOFF 0.0f
#endif
#ifndef DBG_TPH2
#define DBG_TPH2 0
#endif
#ifndef DBG_TPH3
#define DBG_TPH3 1
#endif
#ifndef DBG_SUB
#define DBG_SUB 4
#endif
#ifndef DBG_P
#define DBG_P 4
#endif
#ifndef DBG_CNT
#define DBG_CNT 1
#endif

#define RLX_AGENT __ATOMIC_RELAXED, __HIP_MEMORY_SCOPE_AGENT
#define LDS_WAIT() asm volatile("s_waitcnt lgkmcnt(0)" ::: "memory")
#define VM_WAIT() asm volatile("s_waitcnt vmcnt(0)" ::: "memory")
__device__ __forceinline__ float bf2f(bf16_t h) { return __uint_as_float(((unsigned)h) << 16); }
typedef float f32x2_t __attribute__((ext_vector_type(2)));
typedef __bf16 bf16x2_t __attribute__((ext_vector_type(2)));
__device__ __forceinline__ unsigned pk2(float lo, float hi) { const f32x2_t v = {lo, hi}; return __builtin_bit_cast(unsigned, __builtin_convertvector(v, bf16x2_t)); }
__device__ __forceinline__ bf16_t f2bf(float f) { return (bf16_t)(pk2(f, 0.f) & 0xffffu); }
__device__ __forceinline__ float shx(float v, int mask, int lane) { return __uint_as_float(__builtin_amdgcn_ds_bpermute((lane ^ mask) << 2, __float_as_uint(v))); }
__device__ __forceinline__ int shxi(int v, int mask, int lane) { return __builtin_amdgcn_ds_bpermute((lane ^ mask) << 2, v); }
template <int CTRL> __device__ __forceinline__ float dpp_mov(float v) { return __uint_as_float(__builtin_amdgcn_update_dpp(0u, __float_as_uint(v), CTRL, 0xf, 0xf, true)); }
__device__ __forceinline__ float half_sum32(float v) { const unsigned u = __float_as_uint(v); auto r = __builtin_amdgcn_permlane32_swap(u, u, false, false); return __uint_as_float(r[0]) + __uint_as_float(r[1]); }
__device__ __forceinline__ float row_sum16(float v) { const unsigned u = __float_as_uint(v); auto r = __builtin_amdgcn_permlane16_swap(u, u, false, false); return __uint_as_float(r[0]) + __uint_as_float(r[1]); }
__device__ __forceinline__ float wave_sum(float v, int lane) {
    (void)lane;
    v += dpp_mov<0xB1>(v); v += dpp_mov<0x4E>(v); v += dpp_mov<0x141>(v); v += dpp_mov<0x140>(v);
    return half_sum32(row_sum16(v));
}
__device__ __forceinline__ float tanh_fast(float x) { const float xc = fminf(fmaxf(x, -15.f), 15.f); return 1.f - 2.f * __builtin_amdgcn_rcpf(__builtin_amdgcn_exp2f(xc * (2.f * LOG2E)) + 1.f); }
__device__ __forceinline__ float sigm(float x) { return __builtin_amdgcn_rcpf(1.f + __expf(-x)); }
__device__ __forceinline__ int ld_ctl(const int* p) { return __hip_atomic_load(p, RLX_AGENT); }
__device__ __forceinline__ float ld_ctlf(const float* p) { return __uint_as_float(__hip_atomic_load((const unsigned*)p, RLX_AGENT)); }
#define MFMA16(a, b, c) __builtin_amdgcn_mfma_f32_16x16x32_bf16(a, b, c, 0, 0, 0)
#define MFMA32(a, b, c) __builtin_amdgcn_mfma_f32_32x32x16_bf16(a, b, c, 0, 0, 0)

#define XB_TMO      128
#define XB_XCNT(j)  (256  + 64 * (j))
#define XB_XSUB(j)  (1280 + 64 * (j))
#define XB_XGEN(j)  (2304 + 64 * (j))
#define XB_TOP      3328
#define XB_TOPGEN   3392
#define XCD_BAR_WORDS 3456
#define XB_SPIN_CAP (1u << 22)
__device__ __forceinline__ unsigned xb_ld(unsigned* p)              { return __hip_atomic_load(p, __ATOMIC_RELAXED, __HIP_MEMORY_SCOPE_AGENT); }
__device__ __forceinline__ unsigned xb_add(unsigned* p, unsigned v) { return __hip_atomic_fetch_add(p, v, __ATOMIC_RELAXED, __HIP_MEMORY_SCOPE_AGENT); }
__device__ __forceinline__ unsigned xb_xcc_id() { return (unsigned)__builtin_amdgcn_s_getreg((3 << 11) | 20) & 0xFu; }
#define XB_SPIN(cond, bar) do { unsigned _sp = 0; while (cond) { __builtin_amdgcn_s_sleep(1); \
    if ((++_sp & 255u) == 0u) { if (xb_ld(&(bar)[XB_TMO])) break; if (_sp > XB_SPIN_CAP) { atomicAdd(&(bar)[XB_TMO], 1u); break; } } } } while (0)
struct XcdBarrier { unsigned* bar; unsigned x; volatile LAS unsigned* st; };
__device__ __forceinline__ XcdBarrier xcd_barrier_post(unsigned* bar, volatile LAS unsigned* st) {
    XcdBarrier b; b.bar = bar; b.x = xb_xcc_id(); b.st = st;
    if (threadIdx.x == 0) (void)xb_add(&bar[XB_XCNT(b.x)], 1u);
    return b;
}
__device__ __forceinline__ void xcd_barrier_complete(unsigned* bar, unsigned x, unsigned& nloc, unsigned& nx) {
    const unsigned G = gridDim.x * gridDim.y * gridDim.z;
    unsigned sum, cnt, mine, sp = 0u;
    for (;;) {
        sum = 0u; cnt = 0u; mine = 0u;
#pragma unroll
        for (unsigned j = 0; j < 16; ++j) { const unsigned c = xb_ld(&bar[XB_XCNT(j)]); sum += c; cnt += (c > 0u) ? 1u : 0u; mine = (j == x) ? c : mine; }
        if (sum == G) break;
        __builtin_amdgcn_s_sleep(1);
        if ((++sp & 255u) == 0u) { if (xb_ld(&bar[XB_TMO])) break; if (sp > XB_SPIN_CAP) { atomicAdd(&bar[XB_TMO], 1u); break; } }
    }
    nloc = mine > 0u ? mine : 1u; nx = cnt > 0u ? cnt : 1u;
}
__device__ __forceinline__ void xcd_barrier(const XcdBarrier& b, const int tid) {
    asm volatile("s_waitcnt vmcnt(0)" ::: "memory");
    __syncthreads();
    if (tid == 0) {
        unsigned* bar = b.bar;
        __builtin_amdgcn_s_waitcnt(0);
        unsigned nloc = b.st[0], nx = b.st[1];
        if (nloc == 0u) { xcd_barrier_complete(bar, b.x, nloc, nx); b.st[0] = nloc; b.st[1] = nx; }
        const unsigned old = xb_add(&bar[XB_XSUB(b.x)], 1u);
        const unsigned gen = old / nloc;
        if (old + 1u == (gen + 1u) * nloc) {
            __builtin_amdgcn_fence(__ATOMIC_RELEASE, "agent");
            asm volatile("s_waitcnt vmcnt(0)" ::: "memory");
            const unsigned og = xb_add(&bar[XB_TOP], 1u);
            const unsigned tg = og / nx;
            if (og + 1u == (tg + 1u) * nx) xb_add(&bar[XB_TOPGEN], 1u);
            else XB_SPIN(xb_ld(&bar[XB_TOPGEN]) == tg, bar);
            __builtin_amdgcn_fence(__ATOMIC_ACQUIRE, "agent");
            xb_add(&bar[XB_XGEN(b.x)], 1u);
            asm volatile("s_waitcnt vmcnt(0)" ::: "memory");
        } else {
            XB_SPIN(xb_ld(&bar[XB_XGEN(b.x)]) == gen, bar);
            __builtin_amdgcn_fence(__ATOMIC_ACQUIRE, "agent");
            asm volatile("s_waitcnt vmcnt(0)" ::: "memory");
        }
    }
    __syncthreads();
}

constexpr int RING_BYTES = 131072, MISC_OFF = RING_BYTES + 320, LDS_BYTES = 147456;
struct Frame {
    LAS unsigned char* lds;
    volatile LAS unsigned* MISC;
    unsigned* ctl;
    int tid, lane, wave, G, bid;
    unsigned char* ws;
    float* out;
};
constexpr int IN_OFF = RING_BYTES + 1024;
__device__ __forceinline__ const float* inptr(const LAS unsigned char* lds, int k) {
    int z = 0; asm volatile("" : "+v"(z));
    const LAS unsigned* p = (const LAS unsigned*)(lds + IN_OFF + z) + 2 * k;
    const unsigned lo = __builtin_amdgcn_readfirstlane(p[0]), hi = __builtin_amdgcn_readfirstlane(p[1]);
    return (const float*)(const GAS float*)(((unsigned long long)hi << 32) | lo); }
#define INF(F, k) inptr((F).lds, k)
#define LAUNDER(F) do { GAS unsigned char* w_ = (GAS unsigned char*)(F).ws; GAS float* o_ = (GAS float*)(F).out; int g_ = (F).G, b_ = (F).bid, wv_ = (F).wave, z_ = 0; asm volatile("" : "+s"(w_), "+s"(o_), "+s"(g_), "+s"(b_), "+s"(wv_), "+s"(z_)); \
    int l_ = (int)__builtin_amdgcn_mbcnt_hi(~0u, __builtin_amdgcn_mbcnt_lo(~0u, (unsigned)z_)); asm volatile("" : "+v"(l_)); \
    (F).ws = (unsigned char*)w_; (F).out = (float*)o_; (F).ctl = (unsigned*)(GAS unsigned*)w_; (F).G = g_; (F).bid = b_; (F).wave = wv_; (F).lane = l_; (F).tid = wv_ * 64 + l_; } while (0)
enum { I_X = 0, I_C, I_POS, I_WMOD, I_BMOD, I_NMIX, I_NFFN, I_WIN, I_PHIW1, I_PHIW2, I_PHIPOS, I_MU, I_WUP, I_W0, I_AUP, I_A0, I_GUP, I_KK, I_KA, I_RK, I_LNW, I_LNB,
       I_NNSA, I_NMOBA, I_WOUT, I_WROUTER, I_RBIAS, I_MGATE, I_MUP, I_MDOWN, I_NFINAL };

__device__ const float g_invf[32] = {1.000000000e+00f, 7.498942018e-01f, 5.623413324e-01f, 4.216965139e-01f, 3.162277639e-01f, 2.371373773e-01f, 1.778279394e-01f, 1.333521456e-01f,
    1.000000015e-01f, 7.498942316e-02f, 5.623413250e-02f, 4.216964915e-02f, 3.162277490e-02f, 2.371373773e-02f, 1.778279431e-02f, 1.333521400e-02f, 9.999999776e-03f, 7.498942316e-03f,
    5.623413250e-03f, 4.216964822e-03f, 3.162277630e-03f, 2.371373819e-03f, 1.778279431e-03f, 1.333521446e-03f, 1.000000047e-03f, 7.498941850e-04f, 5.623413017e-04f, 4.216965172e-04f,
    3.162277571e-04f, 2.371373703e-04f, 1.778279402e-04f, 1.333521504e-04f};
__device__ __forceinline__ void phase_pro(Frame& F) {
    const int* pos = (const int*)INF(F, I_POS);
    float* cosT = (float*)(F.ws + WS_COS); float* sinT = (float*)(F.ws + WS_SIN);
    for (int idx = F.bid * NTHR + F.tid; idx < T * 32; idx += F.G * NTHR) {
        const int row = idx >> 5, i = idx & 31;
        const float ang = (float)pos[row] * g_invf[i];
        float sv, cv; sincosf(ang, &sv, &cv);
        cosT[idx] = cv; sinT[idx] = sv;
    }
    LAS float* red = (LAS float*)F.lds;
    for (int chunk = F.bid; chunk < NL * 96; chunk += F.G) {
        const int l = chunk / 96, j0 = (chunk % 96) * 64;
        const float* W = INF(F, I_WMOD) + (size_t)l * D * 6144 + j0 + F.lane;
        const float* c = INF(F, I_C);
        float a0 = 0.f, a1 = 0.f;
        const int k0 = F.wave * 128;
#pragma unroll 32
        for (int k = 0; k < 128; ++k) {
            const float w = W[(size_t)(k0 + k) * 6144];
            const float c0 = c[k0 + k], c1 = c[D + k0 + k];
            a0 += w * (c0 * sigm(c0)); a1 += w * (c1 * sigm(c1));
        }
        red[(F.wave * 2 + 0) * 64 + F.lane] = a0; red[(F.wave * 2 + 1) * 64 + F.lane] = a1;
        __syncthreads();
        if (F.wave < 2) {
            float s = INF(F, I_BMOD)[l * 6144 + j0 + F.lane];
#pragma unroll
            for (int w = 0; w < 8; ++w) s += red[(w * 2 + F.wave) * 64 + F.lane];
            ((float*)(F.ws + WS_MOD))[((size_t)l * BATCH + F.wave) * 6144 + j0 + F.lane] = s;
        }
        __syncthreads();
    }
}

__device__ __forceinline__ void transpose_item(int ldw, int K, bf16_t* WT, int n0, int k0, LAS float* scr, int lane, const float* src) {
    const int n4 = lane & 7, kr = lane >> 3;
#pragma unroll
    for (int i = 0; i < 8; ++i) { const int kk = 8 * i + kr; f32x4 v = (f32x4){0.f, 0.f, 0.f, 0.f};
        if (src) { const float* p = src + (size_t)(k0 + kk) * ldw; v.x = p[0]; v.y = p[1]; v.z = p[2]; v.w = p[3]; }
        scr[kk * 33 + 4 * n4] = v.x; scr[kk * 33 + 4 * n4 + 1] = v.y; scr[kk * 33 + 4 * n4 + 2] = v.z; scr[kk * 33 + 4 * n4 + 3] = v.w; }
    LDS_WAIT(); asm volatile("" ::: "memory");
    const int c = lane & 7;
#pragma unroll
    for (int j = 0; j < 4; ++j) { const int n = (lane >> 3) + 8 * j; const LAS float* sp = scr + (8 * c) * 33 + n;
        u32x4 o; o.x = pk2(sp[0 * 33], sp[1 * 33]); o.y = pk2(sp[2 * 33], sp[3 * 33]); o.z = pk2(sp[4 * 33], sp[5 * 33]); o.w = pk2(sp[6 * 33], sp[7 * 33]);
        *(u32x4*)(WT + (size_t)(n0 + n) * K + k0 + 8 * c) = o; }
    LDS_WAIT(); asm volatile("" ::: "memory");
}
__device__ __forceinline__ const float* cm_in(const float* W, int pos) {
        const int G = pos >> 6, p = pos & 63, w = p >> 5, n = (p >> 4) & 1, q = p & 15, d = 16 * w + q + 32 * n;
        int sc;
        if (G < 6) sc = G * 64 + d; else if (G < 18) sc = 384 + (G - 6) * 64 + d; else if (G < 30) sc = 1170 + (G - 18) * 64 + d;
        else if (G < 52) sc = 1938 + (G - 30) * 64 + d; else if (G == 52 && d < 18) sc = 1152 + d; else return nullptr;
        return W + sc; }
__device__ __forceinline__ const float* cm_up(const float* Wg, const float* Wu, int pos) { const int Wd = pos >> 5, n = (pos >> 4) & 1, q = pos & 15, f = 16 * Wd + q; return (n ? Wu : Wg) + f; }

__device__ __forceinline__ void norm_rows(Frame& F, int layer, bool final_) {
    const float* xin = INF(F, I_X);
    const bf16_t* ys = (const bf16_t*)(F.ws + WS_YS);
    const float* mod = (const float*)(F.ws + WS_MOD);
    bf16_t* H = (bf16_t*)(F.ws + WS_HM);
    const int gw = F.bid * NWAVES + F.wave, NGW = F.G * NWAVES;
    for (int m = gw; m < T; m += NGW) {
        const int b = m >> 13;
        f32x4 v[4]; float ss = 0.f;
        if (layer == 0 && !final_) {
#pragma unroll
            for (int j = 0; j < 4; ++j) v[j] = *(const f32x4*)(xin + (size_t)m * D + 4 * F.lane + 256 * j);
        } else {
            const int pl = final_ ? NL - 1 : layer - 1;
            const float* g2 = mod + ((size_t)pl * BATCH + b) * 6144 + 5120;
#pragma unroll
            for (int j = 0; j < 4; ++j) {
                const int col = 4 * F.lane + 256 * j;
                const u32x2 t2 = *(const u32x2*)((const bf16_t*)(F.ws + WS_RES) + (size_t)m * D + col);
                f32x4 x = (f32x4){__uint_as_float(t2.x << 16), __uint_as_float(t2.x & 0xffff0000u), __uint_as_float(t2.y << 16), __uint_as_float(t2.y & 0xffff0000u)};
                const u32x2 a = *(const u32x2*)(ys + (size_t)m * D + col), c = *(const u32x2*)(ys + (size_t)(T + m) * D + col);
                const f32x4 g = *(const f32x4*)(g2 + col);
                x.x += g.x * (__uint_as_float(a.x << 16) + __uint_as_float(c.x << 16));
                x.y += g.y * (__uint_as_float(a.x & 0xffff0000u) + __uint_as_float(c.x & 0xffff0000u));
                x.z += g.z * (__uint_as_float(a.y << 16) + __uint_as_float(c.y << 16));
                x.w += g.w * (__uint_as_float(a.y & 0xffff0000u) + __uint_as_float(c.y & 0xffff0000u));
                if (!final_) { u32x2 o; o.x = pk2(x.x, x.y); o.y = pk2(x.z, x.w); *(u32x2*)((bf16_t*)F.out + (size_t)m * D + col) = o;
                    x = (f32x4){__uint_as_float(o.x << 16), __uint_as_float(o.x & 0xffff0000u), __uint_as_float(o.y << 16), __uint_as_float(o.y & 0xffff0000u)}; }
                v[j] = x;
            }
        }
#pragma unroll
        for (int j = 0; j < 4; ++j) ss += (v[j].x * v[j].x + v[j].y * v[j].y) + (v[j].z * v[j].z + v[j].w * v[j].w);
        const float rstd = rsqrtf(wave_sum(ss, F.lane) * (1.f / D) + NORM_EPS);
#if DBG_MODE == 1
        if (final_) { float bad = 0.f;
#pragma unroll
            for (int j = 0; j < 4; ++j) { bad += (fabsf(v[j].x) <= 3e38f) ? 0.f : 1.f; bad += (fabsf(v[j].y) <= 3e38f) ? 0.f : 1.f; bad += (fabsf(v[j].z) <= 3e38f) ? 0.f : 1.f; bad += (fabsf(v[j].w) <= 3e38f) ? 0.f : 1.f; }
            bad = wave_sum(bad, F.lane); if (F.lane == 0 && bad > 0.f) atomicAdd(F.ctl + CW_DBG, (unsigned)bad); }
#endif
        if (final_) {
            const float* gn = INF(F, I_NFINAL);
#pragma unroll
            for (int j = 0; j < 4; ++j) { const int col = 4 * F.lane + 256 * j; const f32x4 g = *(const f32x4*)(gn + col);
                f32x4 o; o.x = v[j].x * rstd * g.x; o.y = v[j].y * rstd * g.y; o.z = v[j].z * rstd * g.z; o.w = v[j].w * rstd * g.w;
                *(f32x4*)(F.out + (size_t)m * D + col) = o; }
        } else {
            const float* gn = INF(F, I_NMIX) + layer * D;
            const float* sh = mod + ((size_t)layer * BATCH + b) * 6144; const float* sc = sh + 1024;
#pragma unroll
            for (int j = 0; j < 4; ++j) { const int col = 4 * F.lane + 256 * j;
                const f32x4 g = *(const f32x4*)(gn + col), s1 = *(const f32x4*)(sc + col), s0 = *(const f32x4*)(sh + col);
                u32x2 o; o.x = pk2(v[j].x * rstd * g.x * (1.f + s1.x) + s0.x, v[j].y * rstd * g.y * (1.f + s1.y) + s0.y);
                o.y = pk2(v[j].z * rstd * g.z * (1.f + s1.z) + s0.z, v[j].w * rstd * g.w * (1.f + s1.w) + s0.w);
                *(u32x2*)(H + (size_t)m * D + col) = o; }
        }
    }
}
__device__ __forceinline__ void phase_a(Frame& F, int layer, bool do_norm, bool do_conv) {
    if (do_norm) { norm_rows(F, layer, false); LAUNDER(F); }
    if (!do_conv) return;
    LAS float* scr = (LAS float*)(F.lds + F.wave * 16384);
    const int gw = F.bid * NWAVES + F.wave, NGW = F.G * NWAVES;
    constexpr int I_IN = 16 * 112, I_OUT = 16 * 32, I_UPI = 16 * 16 * 16, I_DN = 16 * 4 * 32, I_PHI = 2 * 32 * 2, I_GU = 2 * 12, I_LR = 2 * 12;
    constexpr int NIT = I_IN + I_OUT + I_UPI + I_DN + I_PHI + I_GU + I_LR;
    for (int it = gw; it < NIT; it += NGW) {
        int r = it;
        const int l31 = 4 * (F.lane & 7);
        if (r < I_IN) { const int kb = r / 112, nb = r % 112;
            transpose_item(INCOLS, D, (bf16_t*)(F.ws + WS_WIN), nb * 32, kb * 64, scr, F.lane, cm_in(INF(F, I_WIN) + (size_t)layer * D * INCOLS, nb * 32 + l31)); continue; } r -= I_IN;
        if (r < I_OUT) { const int kb = r / 32, nb = r % 32;
            transpose_item(D, D, (bf16_t*)(F.ws + WS_WOUT), nb * 32, kb * 64, scr, F.lane, INF(F, I_WOUT) + (size_t)layer * D * D + nb * 32 + l31); continue; } r -= I_OUT;
        if (r < I_UPI) { const int e = r / 256, q = r % 256, kb = q / 16, nb = q % 16;
            transpose_item(256, D, (bf16_t*)(F.ws + WS_WUP) + (size_t)e * 512 * D, nb * 32, kb * 64, scr, F.lane,
                           cm_up(INF(F, I_MGATE) + ((size_t)layer * 16 + e) * D * 256, INF(F, I_MUP) + ((size_t)layer * 16 + e) * D * 256, nb * 32 + l31)); continue; } r -= I_UPI;
        if (r < I_DN) { const int e = r / 128, q = r % 128, kb = q / 32, nb = q % 32;
            transpose_item(D, 256, (bf16_t*)(F.ws + WS_WDN) + (size_t)e * D * 256, nb * 32, kb * 64, scr, F.lane, INF(F, I_MDOWN) + ((size_t)layer * 16 + e) * 256 * D + nb * 32 + l31); continue; } r -= I_DN;
        if (r < I_PHI) { const int kv = r / 64, q = r % 64, kb = q / 2, nb = q % 2;
            transpose_item(64, 2048, (bf16_t*)(F.ws + WS_PHIW) + (size_t)kv * 64 * 2048, nb * 32, kb * 64, scr, F.lane, INF(F, I_PHIW1) + ((size_t)layer * 2 + kv) * 2048 * 64 + nb * 32 + l31); continue; } r -= I_PHI;
        if (r < I_GU) { const int kb = r / 12, nb = r % 12;
            transpose_item(384, 128, (bf16_t*)(F.ws + WS_GUPT), nb * 32, kb * 64, scr, F.lane, INF(F, I_GUP) + (size_t)layer * 128 * 384 + nb * 32 + l31); continue; } r -= I_GU;
        { const int which = r / 12, nb = r % 12;
            transpose_item(384, 64, (bf16_t*)(F.ws + (which ? WS_AUPT : WS_WUPT)), nb * 32, 0, scr, F.lane, INF(F, which ? I_AUP : I_WUP) + (size_t)layer * 64 * 384 + nb * 32 + l31); }
    }
    LAUNDER(F);
    if (F.bid == F.G - 1) {
        __syncthreads();
        LAS float* part = (LAS float*)F.lds;
#pragma unroll 1
        for (int kv = 0; kv < 2; ++kv) {
            const float* w1 = INF(F, I_PHIW1) + ((size_t)layer * 2 + kv) * 2048 * 64 + (size_t)F.wave * 256 * 64; const float* pp = INF(F, I_PHIPOS) + ((size_t)layer * 2 + kv) * 2048 + F.wave * 256;
            float a[4] = {0.f, 0.f, 0.f, 0.f};
#pragma unroll 1
            for (int k = 0; k < 256; k += 16) {
                float wv[16];
#pragma unroll
                for (int u = 0; u < 16; ++u) wv[u] = w1[(size_t)(k + u) * 64 + F.lane];
#pragma unroll
                for (int u = 0; u < 16; ++u) a[u & 3] += pp[k + u] * wv[u];
            }
            part[(F.wave * 2 + kv) * 64 + F.lane] = (a[0] + a[1]) + (a[2] + a[3]);
        }
        __syncthreads();
        if (F.wave < 2) { float sacc = 0.f;
#pragma unroll
            for (int w = 0; w < 8; ++w) sacc += part[(w * 2 + F.wave) * 64 + F.lane];
            ((float*)(F.ws + WS_PHIB))[(layer * 2 + F.wave) * 64 + F.lane] = sacc; }
    }
}

struct EpiInProj {
    static constexpr bool PERM = false, AFTER_DRAIN = false;
    bf16_t* nq; bf16_t* kv6; bf16_t* mqkv; bf16_t* rfeat; float* gate; const float* cosT; const float* sinT;
    __device__ __forceinline__ void operator()(const f32x4 (&acc)[2][2][4][2], const pg8::Unit& u, int wr, int wc, int fr_, int fq_) const {
        int z_ = 0; asm volatile("" : "+s"(z_)); int l_ = (int)__builtin_amdgcn_mbcnt_hi(~0u, __builtin_amdgcn_mbcnt_lo(~0u, (unsigned)z_)); asm volatile("" : "+v"(l_)); const int fr = l_ & 15, fq = l_ >> 4; (void)fr_; (void)fq_;
#pragma unroll
        for (int bj = 0; bj < 2; ++bj) {
            const int G = 4 * u.pn + 2 * bj + (wc >> 1), w = wc & 1;
            if (G >= 53) continue;
            const int qm = u.mask >> bj;
            const int d0 = 16 * w + 4 * fq;
            const bool rope = (G < 6) || (G == 10) || (G == 11) || (G == 14) || (G == 15) || (G >= 18 && G < 26);
            const float scl = (G < 6 || (G >= 18 && G < 22)) ? 0.125f * LOG2E : 1.0f;
#pragma unroll
            for (int ai = 0; ai < 2; ++ai) {
                if (!((qm >> (2 * ai)) & 1)) continue;
#pragma unroll
                for (int m = 0; m < 4; ++m) {
                    const int row = 256 * u.pm + 128 * ai + 64 * wr + 16 * m + fr, b = row >> 13, t = row & (SEQ - 1);
                    f32x4 x1 = acc[ai][bj][m][0], x2 = acc[ai][bj][m][1];
                    if (rope) {
                        const f32x4 c = *(const f32x4*)(cosT + (size_t)row * 32 + d0), s = *(const f32x4*)(sinT + (size_t)row * 32 + d0);
                        const f32x4 y1 = (x1 * c - x2 * s) * scl, y2 = (x2 * c + x1 * s) * scl; x1 = y1; x2 = y2;
                    }
                    if (G == 52) {
                        float* gp = gate + (size_t)row * 32;
                        *(f32x4*)(gp + d0) = x1;
                        continue;
                    }
                    bf16_t* dst;
                    if (G < 6) dst = nq + ((size_t)(b * 6 + G) * SEQ + t) * 64;
                    else if (G < 18) dst = kv6 + (size_t)((G - 6) >> 1) * KV6_STRIDE + ((size_t)(b * 2 + ((G - 6) & 1)) * SEQ + t) * 64;
                    else if (G < 30) dst = mqkv + (size_t)((G - 18) >> 2) * MQKV_STRIDE + ((size_t)(b * 4 + ((G - 18) & 3)) * SEQ + t) * 64;
                    else dst = rfeat + (size_t)row * RW + (G - 30) * 64;
                    auto sx = __builtin_amdgcn_permlane16_swap(pk2(x1.x, x1.y), pk2(x2.x, x2.y), false, false);
                    auto sy = __builtin_amdgcn_permlane16_swap(pk2(x1.z, x1.w), pk2(x2.z, x2.w), false, false);
                    u32x4 o; o.x = sx[0]; o.y = sy[0]; o.z = sx[1]; o.w = sy[1];
                    *(u32x4*)(dst + ((fq & 1) ? d0 - 4 + 32 : d0)) = o;
                }
            }
        }
    }
};
struct EpiNull {
    static constexpr bool PERM = false, AFTER_DRAIN = false;
    float* sink;
    __device__ __forceinline__ void operator()(const f32x4 (&acc)[2][2][4][2], const pg8::Unit& u, int wr, int wc, int fr_, int fq_) const {
        f32x4 s = (f32x4){0.f, 0.f, 0.f, 0.f};
#pragma unroll
        for (int ai = 0; ai < 2; ++ai)
#pragma unroll
            for (int bj = 0; bj < 2; ++bj)
#pragma unroll
                for (int m = 0; m < 4; ++m)
#pragma unroll
                    for (int n = 0; n < 2; ++n) s += acc[ai][bj][m][n];
        if (s.x + s.y + s.z + s.w == 123456.789f) sink[0] = s.x;
    }
};
template <bool F32IN>
struct EpiOutProjT {
    static constexpr bool PERM = false, AFTER_DRAIN = false;
    const float* xold_f; const bf16_t* xold_b; bf16_t* xnew; const float* g1;
    __device__ __forceinline__ void operator()(const f32x4 (&acc)[2][2][4][2], const pg8::Unit& u, int wr, int wc, int fr_, int fq_) const {
        int z_ = 0; asm volatile("" : "+s"(z_)); int l_ = (int)__builtin_amdgcn_mbcnt_hi(~0u, __builtin_amdgcn_mbcnt_lo(~0u, (unsigned)z_)); asm volatile("" : "+v"(l_)); const int fr = l_ & 15, fq = l_ >> 4; (void)fr_; (void)fq_;
#pragma unroll
        for (int ai = 0; ai < 2; ++ai)
#pragma unroll
            for (int m = 0; m < 4; ++m) {
                const int row = 256 * u.pm + 128 * ai + 64 * wr + 16 * m + fr, b = row >> 13;
#pragma unroll
                for (int bj = 0; bj < 2; ++bj) {
                    if (!((u.mask >> (2 * ai + bj)) & 1)) continue;
                    u32x2 o2[2];
#pragma unroll
                    for (int n = 0; n < 2; ++n) {
                        const int col = 256 * u.pn + 128 * bj + 32 * wc + 16 * n + 4 * fq;
                        const f32x4 g = *(const f32x4*)(g1 + (size_t)b * 6144 + col);
                        f32x4 xo;
                        if constexpr (F32IN) xo = *(const f32x4*)(xold_f + (size_t)row * D + col);
                        else { const u32x2 t2 = *(const u32x2*)(xold_b + (size_t)row * D + col); xo = (f32x4){__uint_as_float(t2.x << 16), __uint_as_float(t2.x & 0xffff0000u), __uint_as_float(t2.y << 16), __uint_as_float(t2.y & 0xffff0000u)}; }
                        const f32x4 xn = xo + g * acc[ai][bj][m][n];
                        o2[n].x = pk2(xn.x, xn.y); o2[n].y = pk2(xn.z, xn.w);
                    }
                    auto sx = __builtin_amdgcn_permlane16_swap(o2[0].x, o2[1].x, false, false);
                    auto sy = __builtin_amdgcn_permlane16_swap(o2[0].y, o2[1].y, false, false);
                    u32x4 o; o.x = sx[0]; o.y = sy[0]; o.z = sx[1]; o.w = sy[1];
                    *(u32x4*)(xnew + (size_t)row * D + 256 * u.pn + 128 * bj + 32 * wc + ((fq & 1) ? 16 + 4 * (fq - 1) : 4 * fq)) = o;
                }
            }
    }
};
struct EpiMoeUp {
    static constexpr bool PERM = false, AFTER_DRAIN = false;
    bf16_t* hid;
    __device__ __forceinline__ void operator()(const f32x4 (&acc)[2][2][4][2], const pg8::Unit& u, int wr, int wc, int fr_, int fq_) const {
        int z_ = 0; asm volatile("" : "+s"(z_)); int l_ = (int)__builtin_amdgcn_mbcnt_hi(~0u, __builtin_amdgcn_mbcnt_lo(~0u, (unsigned)z_)); asm volatile("" : "+v"(l_)); const int fr = l_ & 15, fq = l_ >> 4; (void)fr_; (void)fq_;
#pragma unroll
        for (int ai = 0; ai < 2; ++ai)
#pragma unroll
            for (int m = 0; m < 4; ++m) {
                const int row = 256 * u.pm + 128 * ai + 64 * wr + 16 * m + fr;
                u32x2 ob[2];
#pragma unroll
                for (int bj = 0; bj < 2; ++bj) { const f32x4 g = acc[ai][bj][m][0], up = acc[ai][bj][m][1];
                    ob[bj].x = pk2(g.x * sigm(g.x) * up.x, g.y * sigm(g.y) * up.y); ob[bj].y = pk2(g.z * sigm(g.z) * up.z, g.w * sigm(g.w) * up.w); }
                if (((u.mask >> (2 * ai)) & 3) == 3) {
                    auto sx = __builtin_amdgcn_permlane16_swap(ob[0].x, ob[1].x, false, false);
                    auto sy = __builtin_amdgcn_permlane16_swap(ob[0].y, ob[1].y, false, false);
                    u32x4 o; o.x = sx[0]; o.y = sy[0]; o.z = sx[1]; o.w = sy[1];
                    const int f0 = (fq & 1) ? 16 * (8 * u.pn + 4 + wc) + 4 * (fq - 1) : 16 * (8 * u.pn + wc) + 4 * fq;
                    *(u32x4*)(hid + (size_t)row * 256 + f0) = o;
                } else {
#pragma unroll
                    for (int bj = 0; bj < 2; ++bj) {
                        if (!((u.mask >> (2 * ai + bj)) & 1)) continue;
                        *(u32x2*)(hid + (size_t)row * 256 + 16 * (8 * u.pn + 4 * bj + wc) + 4 * fq) = ob[bj];
                    }
                }
            }
    }
};
struct EpiMoeDown {
    static constexpr bool PERM = false, AFTER_DRAIN = false;
    bf16_t* ys; const int* tile_e; const int* elist; const float* eww;
    __device__ __forceinline__ void operator()(const f32x4 (&acc)[2][2][4][2], const pg8::Unit& u, int wr, int wc, int fr_, int fq_) const {
        int z_ = 0; asm volatile("" : "+s"(z_)); int l_ = (int)__builtin_amdgcn_mbcnt_hi(~0u, __builtin_amdgcn_mbcnt_lo(~0u, (unsigned)z_)); asm volatile("" : "+v"(l_)); const int fr = l_ & 15, fq = l_ >> 4; (void)fr_; (void)fq_;
        const int e = __builtin_amdgcn_readfirstlane(ld_ctl(tile_e + u.pm)), off = __builtin_amdgcn_readfirstlane(ld_ctl(tile_e + TE_OFF + e)), cnt = __builtin_amdgcn_readfirstlane(ld_ctl(tile_e + TE_CNT + e));
        int ri[2][4]; float wv[2][4];
#pragma unroll
        for (int ai = 0; ai < 2; ++ai)
#pragma unroll
            for (int m = 0; m < 4; ++m) { const int local = 256 * u.pm + 128 * ai + 64 * wr + 16 * m + fr - off, idx = e * 16384 + (local < cnt ? local : 0); ri[ai][m] = elist[idx]; wv[ai][m] = eww[idx]; }
#pragma unroll
        for (int ai = 0; ai < 2; ++ai)
#pragma unroll
            for (int m = 0; m < 4; ++m) {
                const int local = 256 * u.pm + 128 * ai + 64 * wr + 16 * m + fr - off;
                if (local >= cnt) continue;
                const float w = wv[ai][m];
                bf16_t* dst = ys + ((size_t)(ri[ai][m] & 1) * T + (ri[ai][m] >> 1)) * D;
#pragma unroll
                for (int bj = 0; bj < 2; ++bj) {
                    if (!((u.mask >> (2 * ai + bj)) & 1)) continue;
                    const f32x4 v0 = acc[ai][bj][m][0] * w, v1 = acc[ai][bj][m][1] * w;
                    auto sx = __builtin_amdgcn_permlane16_swap(pk2(v0.x, v0.y), pk2(v1.x, v1.y), false, false);
                    auto sy = __builtin_amdgcn_permlane16_swap(pk2(v0.z, v0.w), pk2(v1.z, v1.w), false, false);
                    u32x4 o; o.x = sx[0]; o.y = sy[0]; o.z = sx[1]; o.w = sy[1];
                    const int col = 256 * u.pn + 128 * bj + 32 * wc + ((fq & 1) ? 16 + 4 * (fq - 1) : 4 * fq);
                    *(u32x4*)(dst + col) = o;
                }
            }
    }
};
template <bool GATHER_>
struct MoeOrderT {
    static constexpr bool GATHER = GATHER_;
    int ntiles, nN, G, c; const int* tile_e; size_t estride; const int* elist;
    __device__ __forceinline__ void arows(const pg8::Unit& u, const int (&RA)[2], int (&o)[2][2]) const {
        const int e = __builtin_amdgcn_readfirstlane(ld_ctl(tile_e + u.pm)), off = __builtin_amdgcn_readfirstlane(ld_ctl(tile_e + TE_OFF + e)), c = __builtin_amdgcn_readfirstlane(ld_ctl(tile_e + TE_CNT + e));
        int ri[2][2];
#pragma unroll
        for (int h = 0; h < 2; ++h)
#pragma unroll
            for (int i = 0; i < 2; ++i) { const int local = 256 * u.pm + 128 * h + RA[i] - off; ri[h][i] = elist[e * 16384 + (local < c ? local : 0)]; }
#pragma unroll
        for (int h = 0; h < 2; ++h)
#pragma unroll
            for (int i = 0; i < 2; ++i) { const int local = 256 * u.pm + 128 * h + RA[i] - off; o[h][i] = (local < c) ? (ri[h][i] >> 1) : 0; }
    }
    __device__ __forceinline__ bool next(int i, pg8::Unit& u) const { int L, f, sub; const int U = ntiles * nN;
        if ((G & 7) == 0) { const int x = c & 7, j = c >> 3, nb = G >> 3, U8 = (U + 7) >> 3, lo = x * U8, n = (lo + U8 <= U) ? U8 : (U > lo ? U - lo : 0);
            if (!pg8::tail_split(i, nb, j, n, L, f, sub)) return false; L += lo; }
        else if (!pg8::tail_split(i, G, c, U, L, f, sub)) return false;
        u.pm = L / nN; u.pn = L % nN; u.mask = (f == 1) ? 0xF : (f == 2) ? (sub ? 0xA : 0x5) : (1 << sub); return true; }
    __device__ __forceinline__ void a_ready(const pg8::Unit&) const {}
    __device__ __forceinline__ size_t boff(const pg8::Unit& u) const { return (size_t)__builtin_amdgcn_readfirstlane(ld_ctl(tile_e + u.pm)) * estride; }
    __device__ __forceinline__ void done(const pg8::Unit&) const {}
};
typedef MoeOrderT<false> MoeOrder;
typedef MoeOrderT<true> MoeGatherOrder;

__device__ __forceinline__ float gelu_tanh(float x) { const float u = 0.7978845608028654f * (x + 0.044715f * x * x * x); return 0.5f * x * (1.f + tanhf(u)); }

__device__ __forceinline__ void compress_unit(Frame& F, int layer, int u) {
    const int kvsel = u >> 5, b = (u >> 4) & 1, kvh = (u >> 3) & 1, rt = u & 7, i0 = 64 * rt;
    const bf16_t* src = (const bf16_t*)(F.ws + WS_KV6) + (size_t)kvsel * KV6_STRIDE + (size_t)(b * 2 + kvh) * SEQ * 64;
    const bf16_t* w1t = (const bf16_t*)(F.ws + WS_PHIW) + (size_t)kvsel * 64 * 2048;
    const int lane = F.lane, r = lane & 15, kg = lane >> 4;
    f32x4 acc[4][4];
#pragma unroll
    for (int a = 0; a < 4; ++a)
#pragma unroll
        for (int c = 0; c < 4; ++c) acc[a][c] = (f32x4){0.f, 0.f, 0.f, 0.f};
#pragma unroll 2
    for (int lq = 0; lq < 4; ++lq) {
        const int l = 4 * F.wave + lq;
#pragma unroll
        for (int ks = 0; ks < 2; ++ks) {
            bf16x8 af[4], bfr[4];
#pragma unroll
            for (int mt = 0; mt < 4; ++mt) af[mt] = *(const bf16x8*)(src + ((size_t)(16 * (i0 + 16 * mt + r) + l)) * 64 + 32 * ks + 8 * kg);
#pragma unroll
            for (int nt = 0; nt < 4; ++nt) bfr[nt] = *(const bf16x8*)(w1t + (size_t)(16 * nt + r) * 2048 + l * 64 + 32 * ks + 8 * kg);
#pragma unroll
            for (int mt = 0; mt < 4; ++mt)
#pragma unroll
                for (int nt = 0; nt < 4; ++nt) acc[mt][nt] = MFMA16(af[mt], bfr[nt], acc[mt][nt]);
        }
    }
    LAS float* part = (LAS float*)F.lds;
#pragma unroll
    for (int mt = 0; mt < 4; ++mt)
#pragma unroll
        for (int nt = 0; nt < 4; ++nt)
#pragma unroll
            for (int q = 0; q < 4; ++q) part[(F.wave * 64 + 16 * mt + 4 * kg + q) * 64 + 16 * nt + r] = acc[mt][nt][q];
    __syncthreads();
    const float* phib = (const float*)(F.ws + WS_PHIB) + (layer * 2 + kvsel) * 64;
    float hv[8];
    const int row = F.tid >> 3, e0 = (F.tid & 7) * 8;
#pragma unroll
    for (int k = 0; k < 8; ++k) { float s = phib[e0 + k];
#pragma unroll
        for (int w = 0; w < 8; ++w) s += part[(w * 64 + row) * 64 + e0 + k];
        hv[k] = gelu_tanh(s); }
    __syncthreads();
    LAS float* hb = (LAS float*)F.lds;
    LAS float* ob = (LAS float*)(F.lds + 32768);
#pragma unroll
    for (int k = 0; k < 8; ++k) hb[row * 65 + e0 + k] = hv[k];
    __syncthreads();
    const float* w2 = INF(F, I_PHIW2) + ((size_t)layer * 2 + kvsel) * 64 * 64;
    float o[8];
#pragma unroll
    for (int k = 0; k < 8; ++k) o[k] = 0.f;
#pragma unroll 8
    for (int e = 0; e < 64; ++e) { const float h = hb[row * 65 + e]; const f32x4 wa = *(const f32x4*)(w2 + e * 64 + e0), wb = *(const f32x4*)(w2 + e * 64 + e0 + 4);
        o[0] += h * wa.x; o[1] += h * wa.y; o[2] += h * wa.z; o[3] += h * wa.w; o[4] += h * wb.x; o[5] += h * wb.y; o[6] += h * wb.z; o[7] += h * wb.w; }
#pragma unroll
    for (int k = 0; k < 8; ++k) ob[row * 65 + e0 + k] = o[k];
    __syncthreads();
    const int i = i0 + row;
    bf16_t* dst = (bf16_t*)(F.ws + (kvsel ? WS_VCMP : WS_KCMP)) + ((size_t)(b * 2 + kvh) * 512 + i) * 64 + e0;
    float y[8];
    if (i >= 511) {
#pragma unroll
        for (int k = 0; k < 8; ++k) y[k] = 0.f;
    } else if (kvsel == 0) {
        const size_t pr = (size_t)b * SEQ + 16 * i + 31;
        const float* cs = (const float*)(F.ws + WS_COS) + pr * 32; const float* sn = (const float*)(F.ws + WS_SIN) + pr * 32;
#pragma unroll
        for (int k = 0; k < 8; ++k) { const int d = e0 + k, f = d & 31; const float x1 = ob[row * 65 + f], x2 = ob[row * 65 + f + 32];
            y[k] = (d < 32) ? (x1 * cs[f] - x2 * sn[f]) : (x2 * cs[f] + x1 * sn[f]); }
    } else {
#pragma unroll
        for (int k = 0; k < 8; ++k) y[k] = o[k];
    }
    u32x4 pk; pk.x = pk2(y[0], y[1]); pk.y = pk2(y[2], y[3]); pk.z = pk2(y[4], y[5]); pk.w = pk2(y[6], y[7]);
    *(u32x4*)dst = pk;
    __syncthreads();
}
__device__ __forceinline__ void kmean_task(Frame& F, int wt) {
    const int b = wt >> 7, h = (wt >> 5) & 3, blk = wt & 31, sub = F.lane >> 3, ch = F.lane & 7;
    const bf16_t* mk = (const bf16_t*)(F.ws + WS_MQKV) + MQKV_STRIDE + ((size_t)(b * 4 + h) * SEQ + 256 * blk) * 64;
    float a[8];
#pragma unroll
    for (int k = 0; k < 8; ++k) a[k] = 0.f;
#pragma unroll 8
    for (int it = 0; it < 32; ++it) {
        const u32x4 v = *(const u32x4*)(mk + (size_t)(8 * it + sub) * 64 + 8 * ch);
        a[0] += __uint_as_float(v.x << 16); a[1] += __uint_as_float(v.x & 0xffff0000u); a[2] += __uint_as_float(v.y << 16); a[3] += __uint_as_float(v.y & 0xffff0000u);
        a[4] += __uint_as_float(v.z << 16); a[5] += __uint_as_float(v.z & 0xffff0000u); a[6] += __uint_as_float(v.w << 16); a[7] += __uint_as_float(v.w & 0xffff0000u);
    }
#pragma unroll
    for (int k = 0; k < 8; ++k) { a[k] += shx(a[k], 8, F.lane); a[k] += shx(a[k], 16, F.lane); a[k] += shx(a[k], 32, F.lane); a[k] *= (1.f / 256.f); }
    if (sub == 0) { u32x4 o; o.x = pk2(a[0], a[1]); o.y = pk2(a[2], a[3]); o.z = pk2(a[4], a[5]); o.w = pk2(a[6], a[7]);
        *(u32x4*)((bf16_t*)(F.ws + WS_KMEAN) + ((size_t)(b * 4 + h) * 32 + blk) * 64 + 8 * ch) = o; }
}

constexpr int R1_TASK_OFF = 32768, R1_TASK_BYTES = 12288;
__device__ __forceinline__ unsigned bf_hi(float x) { return __float_as_uint(x) >> 16; }
__device__ __forceinline__ void r1_block(Frame& F, int layer, int bt) {
    const int chain = bt >> 4, b = chain / 6, h = chain % 6, lane0 = F.lane;
    const int chunk = 8 * (bt & 15) + F.wave, task = chain * 128 + chunk;
    LAS float* tb = (LAS float*)(F.lds + R1_TASK_OFF + F.wave * R1_TASK_BYTES);
    LAS float* Lr = tb; LAS float* Lw = tb + 512; LAS float* Lk = tb + 1024; LAS float* Lkk = tb + 1536; LAS float* Lbb = tb + 2048; LAS float* Lv = tb + 2560;
    const bf16_t* rf = (const bf16_t*)(F.ws + WS_RFEAT);
    const float* mu = INF(F, I_MU) + layer * RW;
    float* bonus = (float*)(F.ws + WS_BONUS);
    bf16_t* ytil = (bf16_t*)(F.ws + WS_YT) + (size_t)task * 4096; bf16_t* y0o = (bf16_t*)(F.ws + WS_Y0) + (size_t)task * 4096;
    bf16_t* lora = (bf16_t*)(F.ws + (task < 896 ? (size_t)242 * MiB + (size_t)task * 16384 : task < 1344 ? WS_WIN + (size_t)(task - 896) * 16384 : WS_ROUTE + (size_t)(task - 1344) * 16384));
    {
        const int c31 = lane0 & 31, hi = lane0 >> 5;
        f32x16 aw[2][2], aa[2][2];
#pragma unroll
        for (int mt = 0; mt < 2; ++mt)
#pragma unroll
            for (int nt = 0; nt < 2; ++nt)
#pragma unroll
                for (int r = 0; r < 16; ++r) { aw[mt][nt][r] = 0.f; aa[mt][nt][r] = 0.f; }
        const bf16_t* wt = (const bf16_t*)(F.ws + WS_WUPT) + (size_t)(h * 64) * 64; const bf16_t* at = (const bf16_t*)(F.ws + WS_AUPT) + (size_t)(h * 64) * 64;
#pragma unroll
        for (int ks = 0; ks < 4; ++ks) {
            const int j0 = 16 * ks + 8 * hi;
            bf16x8 fw[2], fa[2], bw[2], ba[2];
#pragma unroll
            for (int nt = 0; nt < 2; ++nt) { bw[nt] = *(const bf16x8*)(wt + (32 * nt + c31) * 64 + j0); ba[nt] = *(const bf16x8*)(at + (32 * nt + c31) * 64 + j0); }
#pragma unroll
            for (int mt = 0; mt < 2; ++mt) {
                const int t = 64 * chunk + 32 * mt + c31; const int rowi = b * SEQ + t;
                const u32x4 cw = *(const u32x4*)(rf + (size_t)rowi * RW + 1152 + j0), ca = *(const u32x4*)(rf + (size_t)rowi * RW + 1216 + j0);
                u32x4 pw = (u32x4){0u, 0u, 0u, 0u}, pa = (u32x4){0u, 0u, 0u, 0u};
                if (t > 0) { pw = *(const u32x4*)(rf + (size_t)(rowi - 1) * RW + 1152 + j0); pa = *(const u32x4*)(rf + (size_t)(rowi - 1) * RW + 1216 + j0); }
                const f32x4 mw0 = *(const f32x4*)(mu + 1152 + j0), mw1 = *(const f32x4*)(mu + 1152 + j0 + 4), ma0 = *(const f32x4*)(mu + 1216 + j0), ma1 = *(const f32x4*)(mu + 1216 + j0 + 4);
                const float mwv[8] = {mw0.x, mw0.y, mw0.z, mw0.w, mw1.x, mw1.y, mw1.z, mw1.w}, mav[8] = {ma0.x, ma0.y, ma0.z, ma0.w, ma1.x, ma1.y, ma1.z, ma1.w};
                const unsigned cwv[4] = {cw.x, cw.y, cw.z, cw.w}, pwv[4] = {pw.x, pw.y, pw.z, pw.w}, cav[4] = {ca.x, ca.y, ca.z, ca.w}, pav[4] = {pa.x, pa.y, pa.z, pa.w};
                float xw[8], xa[8];
#pragma unroll
                for (int k = 0; k < 4; ++k) {
                    const float c0 = __uint_as_float(cwv[k] << 16), c1 = __uint_as_float(cwv[k] & 0xffff0000u), p0 = __uint_as_float(pwv[k] << 16), p1 = __uint_as_float(pwv[k] & 0xffff0000u);
                    xw[2 * k] = tanh_fast(c0 + (p0 - c0) * mwv[2 * k]); xw[2 * k + 1] = tanh_fast(c1 + (p1 - c1) * mwv[2 * k + 1]);
                    const float d0 = __uint_as_float(cav[k] << 16), d1 = __uint_as_float(cav[k] & 0xffff0000u), q0 = __uint_as_float(pav[k] << 16), q1 = __uint_as_float(pav[k] & 0xffff0000u);
                    xa[2 * k] = d0 + (q0 - d0) * mav[2 * k]; xa[2 * k + 1] = d1 + (q1 - d1) * mav[2 * k + 1];
                }
                u32x4 uw, ua; uw.x = pk2(xw[0], xw[1]); uw.y = pk2(xw[2], xw[3]); uw.z = pk2(xw[4], xw[5]); uw.w = pk2(xw[6], xw[7]);
                ua.x = pk2(xa[0], xa[1]); ua.y = pk2(xa[2], xa[3]); ua.z = pk2(xa[4], xa[5]); ua.w = pk2(xa[6], xa[7]);
                fw[mt] = __builtin_bit_cast(bf16x8, uw); fa[mt] = __builtin_bit_cast(bf16x8, ua);
            }
#pragma unroll
            for (int mt = 0; mt < 2; ++mt)
#pragma unroll
                for (int nt = 0; nt < 2; ++nt) { aw[mt][nt] = MFMA32(fw[mt], bw[nt], aw[mt][nt]); aa[mt][nt] = MFMA32(fa[mt], ba[nt], aa[mt][nt]); }
        }
#pragma unroll
        for (int mt = 0; mt < 2; ++mt)
#pragma unroll
            for (int nt = 0; nt < 2; ++nt)
#pragma unroll
                for (int r = 0; r < 16; ++r) { const int tl = 32 * mt + (r & 3) + 8 * (r >> 2) + 4 * hi;
                    lora[tl * 64 + 32 * nt + c31] = f2bf(aw[mt][nt][r]); lora[4096 + tl * 64 + 32 * nt + c31] = f2bf(aa[mt][nt][r]); }
        asm volatile("s_waitcnt vmcnt(0)" ::: "memory");
    }
    float Wrun = 1.f;
    f32x16 XP[2][2], XZ[2][2];
    { const int c31 = lane0 & 31, hi = lane0 >> 5;
#pragma unroll
      for (int mt = 0; mt < 2; ++mt)
#pragma unroll
          for (int nt = 0; nt < 2; ++nt)
#pragma unroll
              for (int r = 0; r < 16; ++r) { XP[mt][nt][r] = (32 * mt + (r & 3) + 8 * (r >> 2) + 4 * hi == 32 * nt + c31) ? 1.f : 0.f; XZ[mt][nt][r] = 0.f; } }
#pragma unroll 1
    for (int sub = 0; sub < 8; ++sub) {
        int lane = lane0, hc = h * 64 + lane0; asm volatile("" : "+v"(lane), "+v"(hc));
#pragma unroll 1
        for (int half = 0; half < 2; ++half) {
            float rs4[4], ks4[4], vs4[4], aw4[4], aa4[4];
            const float mu_r = mu[hc], mu_k = mu[384 + hc], mu_v = mu[768 + hc];
            const float w0 = INF(F, I_W0)[layer * 384 + hc], a0 = INF(F, I_A0)[layer * 384 + hc];
#pragma unroll
            for (int q = 0; q < 4; ++q) {
                const int tl = 8 * sub + 4 * half + q, t = 64 * chunk + tl; const int rowi = b * SEQ + t;
                const bf16_t* cur = rf + (size_t)rowi * RW; const bf16_t* prv = cur - RW; const bool hp = t > 0;
                const float rc = bf2f(cur[hc]), kc = bf2f(cur[384 + hc]), vc = bf2f(cur[768 + hc]);
                const float rp = hp ? bf2f(prv[hc]) : 0.f, kp = hp ? bf2f(prv[384 + hc]) : 0.f, vp = hp ? bf2f(prv[768 + hc]) : 0.f;
                rs4[q] = rc + (rp - rc) * mu_r; ks4[q] = kc + (kp - kc) * mu_k; vs4[q] = vc + (vp - vc) * mu_v;
                aw4[q] = w0 + bf2f(lora[tl * 64 + lane]); aa4[q] = a0 + bf2f(lora[4096 + tl * 64 + lane]);
            }
            const float k_k = INF(F, I_KK)[layer * 384 + hc], k_a = INF(F, I_KA)[layer * 384 + hc], r_k = INF(F, I_RK)[layer * 384 + hc];
#pragma unroll
            for (int q = 0; q < 4; ++q) {
                const int tt = 4 * half + q; const int rowi = b * SEQ + 64 * chunk + 8 * sub + tt;
                const float dec = __expf(-0.606531f * sigm(aw4[q])), a = sigm(aa4[q]);
                float kk = ks4[q] * k_k; const float n2 = wave_sum(kk * kk, lane); kk = kk * __builtin_amdgcn_rsqf(fmaxf(n2, 1e-24f));
                const float km = ks4[q] * (1.f + (a - 1.f) * k_a);
                const float bn = wave_sum(rs4[q] * km * r_k, lane);
                const float Wprev = Wrun; Wrun *= dec; const float iW = __builtin_amdgcn_rcpf(Wrun);
                Lr[tt * 64 + lane] = rs4[q] * Wrun; Lk[tt * 64 + lane] = km * iW; Lkk[tt * 64 + lane] = -(kk * Wprev); Lbb[tt * 64 + lane] = kk * a * iW; Lv[tt * 64 + lane] = vs4[q];
                if (lane == 0) bonus[(size_t)rowi * 8 + h] = bn;
            }
        }
        LDS_WAIT(); asm volatile("" ::: "memory");
        const int c31 = lane & 31, hi = lane >> 5;
#pragma unroll 1
        for (int tt = 0; tt < 8; ++tt) {
            f32x4 k4[2][4], r4[2][4];
#pragma unroll
            for (int mt = 0; mt < 2; ++mt)
#pragma unroll
                for (int rq = 0; rq < 4; ++rq) { const int c0 = tt * 64 + 32 * mt + 8 * rq + 4 * hi;
                    k4[mt][rq] = *(const LAS f32x4*)(Lkk + c0); r4[mt][rq] = *(const LAS f32x4*)(Lr + c0); }
            float saP[2], saZ[2];
#pragma unroll
            for (int nt = 0; nt < 2; ++nt) { f32x2_t p2 = {0.f, 0.f}, z2 = {0.f, 0.f};
#pragma unroll
                for (int mt = 0; mt < 2; ++mt)
#pragma unroll
                    for (int r = 0; r < 16; r += 2) { const f32x2_t kk2 = {k4[mt][r >> 2][r & 3], k4[mt][r >> 2][(r & 3) + 1]};
                        const f32x2_t xp2 = {XP[mt][nt][r], XP[mt][nt][r + 1]}, xz2 = {XZ[mt][nt][r], XZ[mt][nt][r + 1]};
                        p2 = __builtin_elementwise_fma(xp2, kk2, p2); z2 = __builtin_elementwise_fma(xz2, kk2, z2); }
                float p = p2.x + p2.y, z = z2.x + z2.y;
                p = half_sum32(p); z = half_sum32(z); saP[nt] = p; saZ[nt] = z; }
            bf16x8 af[2], bP[2], bZ[2];
#pragma unroll
            for (int mt = 0; mt < 2; ++mt) { const float bbv = Lbb[tt * 64 + 32 * mt + c31], kv = Lk[tt * 64 + 32 * mt + c31];
                const unsigned bh = bf_hi(bbv), kh = bf_hi(kv); const unsigned bl = bf_hi(bbv - __uint_as_float(bh << 16)), kl = bf_hi(kv - __uint_as_float(kh << 16));
                u32x4 u; u.x = bh | (bl << 16); u.y = bh | (kh << 16); u.z = kl | (kh << 16); u.w = 0u;
                if (hi) u = (u32x4){0u, 0u, 0u, 0u};
                af[mt] = __builtin_bit_cast(bf16x8, u); }
#pragma unroll
            for (int nt = 0; nt < 2; ++nt) { const float vv = Lv[tt * 64 + 32 * nt + c31];
                const unsigned ph = bf_hi(saP[nt]), zh = bf_hi(saZ[nt]), vh = bf_hi(vv);
                const unsigned pl = bf_hi(saP[nt] - __uint_as_float(ph << 16)), zl = bf_hi(saZ[nt] - __uint_as_float(zh << 16)), vl = bf_hi(vv - __uint_as_float(vh << 16));
                u32x4 up, uz; up.x = ph | (ph << 16); up.y = pl; up.z = 0u; up.w = 0u;
                uz.x = zh | (zh << 16); uz.y = zl | (vh << 16); uz.z = vh | (vl << 16); uz.w = 0u;
                if (hi) { up = (u32x4){0u, 0u, 0u, 0u}; uz = (u32x4){0u, 0u, 0u, 0u}; }
                bP[nt] = __builtin_bit_cast(bf16x8, up); bZ[nt] = __builtin_bit_cast(bf16x8, uz); }
#pragma unroll
            for (int mt = 0; mt < 2; ++mt)
#pragma unroll
                for (int nt = 0; nt < 2; ++nt) { XP[mt][nt] = MFMA32(af[mt], bP[nt], XP[mt][nt]); XZ[mt][nt] = MFMA32(af[mt], bZ[nt], XZ[mt][nt]); }
#pragma unroll
            for (int nt = 0; nt < 2; ++nt) { f32x2_t p2 = {0.f, 0.f}, z2 = {0.f, 0.f};
#pragma unroll
                for (int mt = 0; mt < 2; ++mt)
#pragma unroll
                    for (int r = 0; r < 16; r += 2) { const f32x2_t rr2 = {r4[mt][r >> 2][r & 3], r4[mt][r >> 2][(r & 3) + 1]};
                        const f32x2_t xp2 = {XP[mt][nt][r], XP[mt][nt][r + 1]}, xz2 = {XZ[mt][nt][r], XZ[mt][nt][r + 1]};
                        p2 = __builtin_elementwise_fma(xp2, rr2, p2); z2 = __builtin_elementwise_fma(xz2, rr2, z2); }
                float p = p2.x + p2.y, z = z2.x + z2.y;
                p = half_sum32(p); z = half_sum32(z);
                if (hi == 0) { ytil[(8 * sub + tt) * 64 + 32 * nt + c31] = f2bf(p); y0o[(8 * sub + tt) * 64 + 32 * nt + c31] = f2bf(z); } }
        }
    }
    int lane_e = lane0; asm volatile("" : "+v"(lane_e));
    Lw[lane_e] = Wrun; LDS_WAIT(); asm volatile("" ::: "memory");
    { const int hi_ = lane_e >> 5;
#pragma unroll
      for (int mt = 0; mt < 2; ++mt)
#pragma unroll
          for (int rq = 0; rq < 4; ++rq) { const f32x4 wl = *(const LAS f32x4*)(Lw + 32 * mt + 8 * rq + 4 * hi_);
#pragma unroll
              for (int nt = 0; nt < 2; ++nt)
#pragma unroll
                  for (int k = 0; k < 4; ++k) { XP[mt][nt][4 * rq + k] *= wl[k]; XZ[mt][nt][4 * rq + k] *= wl[k]; } } }
    { const int c31 = lane_e & 31, hi = lane_e >> 5;
      bf16_t* PT = (bf16_t*)(F.ws + WS_PT) + (size_t)task * 4096;
      bf16_t* ZP = (bf16_t*)(F.ws + WS_ZS) + (size_t)task * 4096;
#pragma unroll
      for (int mt = 0; mt < 2; ++mt)
#pragma unroll
          for (int nt = 0; nt < 2; ++nt) {
#pragma unroll
              for (int r = 0; r < 16; ++r) PT[(32 * mt + (r & 3) + 8 * (r >> 2) + 4 * hi) * 64 + 32 * nt + c31] = f2bf(XP[mt][nt][r]);
              u32x4 a, c2; a.x = pk2(XZ[mt][nt][0], XZ[mt][nt][1]); a.y = pk2(XZ[mt][nt][2], XZ[mt][nt][3]); a.z = pk2(XZ[mt][nt][4], XZ[mt][nt][5]); a.w = pk2(XZ[mt][nt][6], XZ[mt][nt][7]);
              c2.x = pk2(XZ[mt][nt][8], XZ[mt][nt][9]); c2.y = pk2(XZ[mt][nt][10], XZ[mt][nt][11]); c2.z = pk2(XZ[mt][nt][12], XZ[mt][nt][13]); c2.w = pk2(XZ[mt][nt][14], XZ[mt][nt][15]);
              *(u32x4*)(ZP + ((mt * 2 + nt) * 64 + lane_e) * 16) = a; *(u32x4*)(ZP + ((mt * 2 + nt) * 64 + lane_e) * 16 + 8) = c2; } }
    __syncthreads();
}
constexpr int CW_PREP = 768;
constexpr int CW_R1DONE = 896;
__device__ __forceinline__ void publish_count(Frame& F, unsigned* word) {
    asm volatile("s_waitcnt vmcnt(0)" ::: "memory"); __syncthreads();
    if (F.tid == 0) { __builtin_amdgcn_fence(__ATOMIC_RELEASE, "agent"); asm volatile("s_waitcnt vmcnt(0)" ::: "memory"); (void)__hip_atomic_fetch_add(word, 1u, RLX_AGENT); }
}
__device__ __forceinline__ void await_count(Frame& F, unsigned* word, unsigned want) {
    if (F.tid == 0) { unsigned sp = 0; while ((unsigned)__builtin_amdgcn_readfirstlane(__hip_atomic_load(word, RLX_AGENT)) < want) { __builtin_amdgcn_s_sleep(4); if (++sp > (1u << 24)) break; }
        __builtin_amdgcn_fence(__ATOMIC_ACQUIRE, "agent"); asm volatile("s_waitcnt vmcnt(0)" ::: "memory"); }
    __syncthreads();
}
__device__ __forceinline__ void phase_c(Frame& F, int layer) {
    if (F.bid < 192) r1_block(F, layer, F.bid);
    else { compress_unit(F, layer, F.bid - 192); LAUNDER(F); if (F.bid < 224) kmean_task(F, (F.bid - 192) * 8 + F.wave); }
    LAUNDER(F);
    publish_count(F, F.ctl + ((F.bid < 192) ? CW_R1DONE + 64 * layer + (F.bid >> 4) : CW_PREP + 64 * layer));
}

constexpr int KP = 72;
constexpr int TILE_B = 64 * KP * 2;
constexpr int AT_K0 = 0, AT_V0 = 2 * TILE_B;
constexpr int AT_IMP = 4 * TILE_B;
constexpr int AT_MISC = AT_IMP + 8 * 8192;
constexpr int AT_KMEAN = AT_MISC + 256;
constexpr int R2_SBUF = 0;

__device__ __forceinline__ bf16x8 lds_frag(const LAS bf16_t* tile, int row, int col) { return *(const LAS bf16x8*)(tile + row * KP + col); }
__device__ __forceinline__ s16x4 lds_tr(const LAS bf16_t* p) { return __builtin_bit_cast(s16x4, __builtin_amdgcn_ds_read_tr16_b64_v4i16((LAS v4i16_t*)p)); }
__device__ __forceinline__ bf16x8 cat8(s16x4 a, s16x4 b) { bf16x8 r; r[0] = a[0]; r[1] = a[1]; r[2] = a[2]; r[3] = a[3]; r[4] = b[0]; r[5] = b[1]; r[6] = b[2]; r[7] = b[3]; return r; }
__device__ __forceinline__ bf16x8 pack8(const f32x4& a, const f32x4& b) { u32x4 u; u.x = pk2(a.x, a.y); u.y = pk2(a.z, a.w); u.z = pk2(b.x, b.y); u.w = pk2(b.z, b.w); return __builtin_bit_cast(bf16x8, u); }

template <int NH>
__device__ __forceinline__ void qk_tile(const LAS bf16_t* Kt, const bf16x8 (&qf)[NH][2], f32x4 (&st)[NH][4], const float (&cm)[NH], int lane, const bool (&keep)[NH]) {
    const int r = lane & 15, kg = lane >> 4;
    f32x4 ci[NH];
#pragma unroll
    for (int g = 0; g < NH; ++g) { const float c = keep[g] ? cm[g] : -INFINITY; ci[g] = (f32x4){c, c, c, c}; }
#pragma unroll
    for (int kt = 0; kt < 4; ++kt) {
        const bf16x8 k0 = lds_frag(Kt, 16 * kt + r, 8 * kg), k1 = lds_frag(Kt, 16 * kt + r, 32 + 8 * kg);
#pragma unroll
        for (int g = 0; g < NH; ++g) { f32x4 z = MFMA16(k0, qf[g][0], ci[g]); st[g][kt] = MFMA16(k1, qf[g][1], z); }
    }
}
template <int NH, bool DO_V>
__device__ __forceinline__ void pv_tile(const LAS bf16_t* Vt, const f32x4 (&p)[NH][4], f32x4 (&o)[NH][4], f32x4 (&lacc)[NH], int lane) {
    const int kg = lane >> 4, rr = (lane & 15) >> 2, cc = 4 * (lane & 3);
    const u32x4 one4 = (u32x4){0x3f803f80u, 0x3f803f80u, 0x3f803f80u, 0x3f803f80u};
    const bf16x8 ones = __builtin_bit_cast(bf16x8, one4);
#pragma unroll
    for (int i = 0; i < 2; ++i) {
        bf16x8 pf[NH];
#pragma unroll
        for (int g = 0; g < NH; ++g) { pf[g] = pack8(p[g][2 * i], p[g][2 * i + 1]); lacc[g] = MFMA16(ones, pf[g], lacc[g]); }
        if (DO_V) {
#pragma unroll
            for (int dt = 0; dt < 4; ++dt) {
                const s16x4 lo = lds_tr(Vt + (32 * i + 4 * kg + rr) * KP + 16 * dt + cc), hi = lds_tr(Vt + (32 * i + 16 + 4 * kg + rr) * KP + 16 * dt + cc);
                const bf16x8 vf = cat8(lo, hi);
#pragma unroll
                for (int g = 0; g < NH; ++g) o[g][dt] = MFMA16(vf, pf[g], o[g][dt]);
            }
        }
    }
}
__device__ __forceinline__ void softmax_tile(f32x4 (&st)[4], f32x4 (&o)[4], f32x4& lacc, float& mref, int lane) {
    float mx = -INFINITY;
#pragma unroll
    for (int kt = 0; kt < 4; ++kt) mx = fmaxf(fmaxf(mx, fmaxf(st[kt].x, st[kt].y)), fmaxf(st[kt].z, st[kt].w));
    mx = fmaxf(mx, shx(mx, 16, lane)); mx = fmaxf(mx, shx(mx, 32, lane));
    const bool fresh = (mref == -INFINITY);
    if (__any((fresh && mx > -INFINITY) || mx > 8.0f)) {
        const float d = fresh ? ((mx == -INFINITY) ? 0.f : mx) : fmaxf(mx, 0.f);
        const float alpha = fresh ? 1.f : __builtin_amdgcn_exp2f(-d);
        mref = fresh ? mx : mref + d;
        lacc = lacc * alpha;
#pragma unroll
        for (int dt = 0; dt < 4; ++dt) o[dt] = o[dt] * alpha;
#pragma unroll
        for (int kt = 0; kt < 4; ++kt) st[kt] = st[kt] - d;
    }
#pragma unroll
    for (int kt = 0; kt < 4; ++kt) {
        st[kt].x = __builtin_amdgcn_exp2f(st[kt].x); st[kt].y = __builtin_amdgcn_exp2f(st[kt].y);
        st[kt].z = __builtin_amdgcn_exp2f(st[kt].z); st[kt].w = __builtin_amdgcn_exp2f(st[kt].w);
    }
}
#define MX2(a, b) __builtin_elementwise_maximum((float)(a), (float)(b))
#define MX3(a, b, c) MX2(MX2(a, b), c)
template <int NH>
__device__ __forceinline__ void softmax_tiles(f32x4 (&st)[NH][4], f32x4 (&o)[NH][4], f32x4 (&lacc)[NH], float (&mref)[NH], float (&cm)[NH], int lane) {
    float mx[NH];
#pragma unroll
    for (int g = 0; g < NH; ++g) {
        float a = MX3(st[g][0].x, st[g][0].y, st[g][0].z), c = MX3(st[g][2].x, st[g][2].y, st[g][2].z);
        a = MX3(a, st[g][0].w, st[g][1].x); c = MX3(c, st[g][2].w, st[g][3].x);
        a = MX3(a, st[g][1].y, st[g][1].z); c = MX3(c, st[g][3].y, st[g][3].z);
        mx[g] = MX3(MX3(a, st[g][1].w, st[g][3].w), c, c); }
#pragma unroll
    for (int g = 0; g < NH; ++g)
#pragma unroll
        for (int kt = 0; kt < 4; ++kt) {
            st[g][kt].x = __builtin_amdgcn_exp2f(st[g][kt].x); st[g][kt].y = __builtin_amdgcn_exp2f(st[g][kt].y);
            st[g][kt].z = __builtin_amdgcn_exp2f(st[g][kt].z); st[g][kt].w = __builtin_amdgcn_exp2f(st[g][kt].w);
        }
#pragma unroll
    for (int g = 0; g < NH; ++g) { const unsigned u = __float_as_uint(mx[g]); auto a = __builtin_amdgcn_permlane16_swap(u, u, false, false); mx[g] = MX2(__uint_as_float(a[0]), __uint_as_float(a[1])); }
#pragma unroll
    for (int g = 0; g < NH; ++g) { const unsigned u = __float_as_uint(mx[g]); auto a = __builtin_amdgcn_permlane32_swap(u, u, false, false); mx[g] = MX2(__uint_as_float(a[0]), __uint_as_float(a[1])); }
    bool need = false;
#pragma unroll
    for (int g = 0; g < NH; ++g) need = need | (((mref[g] == -INFINITY) & (mx[g] > -INFINITY)) | (mx[g] > 8.0f));
    if (__any(need)) {
#pragma unroll
        for (int g = 0; g < NH; ++g) {
            const bool fresh = (mref[g] == -INFINITY);
            const float d = fresh ? ((mx[g] == -INFINITY) ? 0.f : fmaxf(mx[g], -100.f)) : fmaxf(mx[g], 0.f);
            const float pf = __builtin_amdgcn_exp2f(-d);
            const float alpha = fresh ? 1.f : pf;
            mref[g] = fresh ? ((mx[g] == -INFINITY) ? -INFINITY : d) : mref[g] + d;
            cm[g] = (mref[g] == -INFINITY) ? 0.f : -mref[g];
            lacc[g] = lacc[g] * alpha;
#pragma unroll
            for (int dt = 0; dt < 4; ++dt) o[g][dt] = o[g][dt] * alpha;
#pragma unroll
            for (int kt = 0; kt < 4; ++kt) st[g][kt] = st[g][kt] * pf;
        }
    }
}
__device__ __forceinline__ void acc_pk(u32x2& d, const f32x4& v) {
    const float a = __uint_as_float(d.x << 16) + v.x, b = __uint_as_float(d.x & 0xffff0000u) + v.y, c = __uint_as_float(d.y << 16) + v.z, e = __uint_as_float(d.y & 0xffff0000u) + v.w;
    d.x = pk2(a, b); d.y = pk2(c, e); }
__device__ __forceinline__ u32x4 tile_load(const bf16_t* g, int tid) { const int off = (tid >> 3) * 64 + (tid & 7) * 8; return *(const u32x4*)(g + off); }
__device__ __forceinline__ void tile_store(LAS bf16_t* t, int tid, u32x4 v) { *(LAS u32x4*)(t + (tid >> 3) * KP + (tid & 7) * 8) = v; }

#define LDS_BAR() do { asm volatile("s_waitcnt lgkmcnt(0)" ::: "memory"); __builtin_amdgcn_s_barrier(); asm volatile("" ::: "memory"); } while (0)
__device__ __forceinline__ void nsa_task(Frame& F, int b, int kvh, int J) {
    const int lane = F.lane, tid = F.tid, wv = F.wave, q = lane & 15, kg = lane >> 4;
    const int t0 = 128 * J, tw0 = t0 + 16 * wv, tq_abs = tw0 + q, cur = tw0 >> 6, tq = tq_abs & 63;
    LAS bf16_t* Kb = (LAS bf16_t*)(F.lds + AT_K0); LAS bf16_t* Vb = (LAS bf16_t*)(F.lds + AT_V0);
    LAS float* imp = (LAS float*)(F.lds + AT_IMP + wv * 8192);
    const bf16_t* kvbase = (const bf16_t*)(F.ws + WS_KV6);
    const size_t slab = (size_t)(b * 2 + kvh) * SEQ * 64;
    const bf16_t* Kcmp = (const bf16_t*)(F.ws + WS_KCMP) + (size_t)(b * 2 + kvh) * 512 * 64;
    const bf16_t* Vcmp = (const bf16_t*)(F.ws + WS_VCMP) + (size_t)(b * 2 + kvh) * 512 * 64;
    const bf16_t* Ks = kvbase + 2 * KV6_STRIDE + slab; const bf16_t* Vs = kvbase + 3 * KV6_STRIDE + slab;
    const bf16_t* Kw = kvbase + 4 * KV6_STRIDE + slab; const bf16_t* Vw = kvbase + 5 * KV6_STRIDE + slab;
    bf16x8 qf[3][2];
#pragma unroll
    for (int g = 0; g < 3; ++g) { const bf16_t* qp = (const bf16_t*)(F.ws + WS_NQ) + (((b * 6 + 3 * kvh + g) * SEQ + tq_abs) * 64 + 8 * kg);
        qf[g][0] = *(const bf16x8*)qp; qf[g][1] = *(const bf16x8*)(qp + 32); }
#define NSA_GATEP ((const float*)(F.ws + WS_GATE) + ((b * SEQ + tq_abs) * 32 + 9 * kvh))
    for (int i = lane; i < 2048; i += 64) imp[i] = 0.f;
    const int imax_blk = (t0 + 127 - 31) >> 4;
    const int ntc = (imax_blk >> 6) + 1;
    const int imax_w = (tw0 + 15 >= 31) ? ((tw0 + 15 - 31) >> 4) : -1;
    const int ivis = (tq_abs >= 31) ? ((tq_abs - 31) >> 4) : -1;
    float m[3] = {-INFINITY, -INFINITY, -INFINITY}; float cm[3] = {0.f, 0.f, 0.f};
    f32x4 lacc[3] = {(f32x4){0.f, 0.f, 0.f, 0.f}, (f32x4){0.f, 0.f, 0.f, 0.f}, (f32x4){0.f, 0.f, 0.f, 0.f}};
    f32x4 st[3][4];
    f32x4 ob[3][4];
    const bool keep3[3] = {true, true, true};
#pragma unroll
    for (int g = 0; g < 3; ++g)
#pragma unroll
        for (int dt = 0; dt < 4; ++dt) ob[g][dt] = (f32x4){0.f, 0.f, 0.f, 0.f};
    {
        u32x4 kr = tile_load(Kcmp, tid);
        tile_store(Kb, tid, kr); __syncthreads();
        for (int ct = 0; ct < ntc; ++ct) {
            if (ct + 1 < ntc) kr = tile_load(Kcmp + (ct + 1) * 4096, tid);
            const LAS bf16_t* Kt = Kb + (ct & 1) * (TILE_B / 2);
            if (64 * ct <= imax_w) {
                qk_tile<3>(Kt, qf, st, cm, lane, keep3);
#pragma unroll
                for (int g = 0; g < 3; ++g) {
#pragma unroll
                    for (int kt = 0; kt < 4; ++kt)
#pragma unroll
                        for (int r = 0; r < 4; ++r) { const int i = 64 * ct + 16 * kt + 4 * kg + r; st[g][kt][r] = (i <= ivis) ? st[g][kt][r] : -INFINITY; }
                }
                softmax_tiles<3>(st, ob, lacc, m, cm, lane);
                pv_tile<3, false>(Kt, st, ob, lacc, lane);
            }
            if (ct + 1 < ntc) tile_store(Kb + ((ct + 1) & 1) * (TILE_B / 2), tid, kr);
            LDS_BAR();
        }
    }
    float invl[3]; float msafe[3];
#pragma unroll
    for (int g = 0; g < 3; ++g) { msafe[g] = (m[g] == -INFINITY) ? 0.f : m[g]; invl[g] = 1.f / fmaxf(lacc[g].x, 1e-30f); }
    {
        u32x4 kr = tile_load(Kcmp, tid), vr = tile_load(Vcmp, tid);
        tile_store(Kb, tid, kr); tile_store(Vb, tid, vr); __syncthreads();
        for (int ct = 0; ct < ntc; ++ct) {
            if (ct + 1 < ntc) { kr = tile_load(Kcmp + (ct + 1) * 4096, tid); vr = tile_load(Vcmp + (ct + 1) * 4096, tid); }
            const LAS bf16_t* Kt = Kb + (ct & 1) * (TILE_B / 2); const LAS bf16_t* Vt = Vb + (ct & 1) * (TILE_B / 2);
            if (64 * ct <= imax_w) {
                qk_tile<3>(Kt, qf, st, cm, lane, keep3);
#pragma unroll
                for (int g = 0; g < 3; ++g)
#pragma unroll
                    for (int kt = 0; kt < 4; ++kt)
#pragma unroll
                        for (int r = 0; r < 4; ++r) { const int i = 64 * ct + 16 * kt + 4 * kg + r;
                            st[g][kt][r] = (i <= ivis) ? __builtin_amdgcn_exp2f(st[g][kt][r]) * invl[g] : 0.f; }
#pragma unroll
                for (int kt = 0; kt < 4; ++kt) {
                    float a = 0.f, c = 0.f;
#pragma unroll
                    for (int g = 0; g < 3; ++g) { a += (st[g][kt].x + st[g][kt].y) + st[g][kt].z; c += st[g][kt].w; }
                    c *= 0.5f; a += c;
                    const float recv = __uint_as_float(__builtin_amdgcn_ds_bpermute(((lane + 48) & 63) << 2, __float_as_uint(c)));
                    const int ktp = 4 * ct + kt;
                    imp[ktp * 64 + lane] += a + (kg != 0 ? recv : 0.f);
                    if (kg == 0 && ktp + 1 < 32) imp[(ktp + 1) * 64 + lane] += recv;
                }
                pv_tile<3, true>(Vt, st, ob, lacc, lane);
            }
            if (ct + 1 < ntc) { tile_store(Kb + ((ct + 1) & 1) * (TILE_B / 2), tid, kr); tile_store(Vb + ((ct + 1) & 1) * (TILE_B / 2), tid, vr); }
            LDS_BAR();
        }
    }
#pragma unroll
    for (int g = 0; g < 3; ++g) { const float sc = sigm(NSA_GATEP[3 * g + 0]);
#pragma unroll
        for (int dt = 0; dt < 4; ++dt) ob[g][dt] = ob[g][dt] * sc; }
    unsigned msk[4] = {0u, 0u, 0u, 0u};
    if (cur <= 15) {
        msk[0] = (cur == 31) ? 0xffffffffu : ((1u << (cur + 1)) - 1u);
    } else {
        float iv[32];
#pragma unroll
        for (int k = 0; k < 32; ++k) { const int s = 4 * k + kg; const float v = imp[k * 64 + lane]; iv[k] = (s >= 1 && s <= cur - 2) ? v : -1.f; }
        msk[0] = 1u; msk[cur >> 5] |= 1u << (cur & 31); msk[(cur - 1) >> 5] |= 1u << ((cur - 1) & 31);
        for (int it = 0; it < 13; ++it) {
            float bv = -2.f; int bs = 1 << 20;
#pragma unroll
            for (int k = 0; k < 32; ++k) { if (iv[k] > bv) { bv = iv[k]; bs = 4 * k + kg; } }
#pragma unroll
            for (int sh = 16; sh <= 32; sh <<= 1) { const float ov = shx(bv, sh, lane); const int os = shxi(bs, sh, lane); if (ov > bv || (ov == bv && os < bs)) { bv = ov; bs = os; } }
#pragma unroll
            for (int k = 0; k < 32; ++k) if (4 * k + kg == bs) iv[k] = -1.f;
#pragma unroll
            for (int wd = 0; wd < 4; ++wd) if ((bs >> 5) == wd) msk[wd] |= 1u << (bs & 31);
        }
    }
    LAS u32x2* otp = (LAS u32x2*)imp;
#pragma unroll
    for (int g = 0; g < 3; ++g)
#pragma unroll
        for (int dt = 0; dt < 4; ++dt) { u32x2 o; o.x = pk2(ob[g][dt].x, ob[g][dt].y); o.y = pk2(ob[g][dt].z, ob[g][dt].w); otp[(g * 4 + dt) * 64 + lane] = o; }
    {
#pragma unroll
        for (int g = 0; g < 3; ++g) { m[g] = -INFINITY; cm[g] = 0.f; lacc[g] = (f32x4){0.f, 0.f, 0.f, 0.f};
#pragma unroll
            for (int dt = 0; dt < 4; ++dt) ob[g][dt] = (f32x4){0.f, 0.f, 0.f, 0.f}; }
        const int nb = 2 * J + 2;
        u32x4 kr[2], vr[2]; unsigned mw = 0u;
        kr[0] = tile_load(Ks, tid); vr[0] = tile_load(Vs, tid);
        kr[1] = tile_load(Ks + ((nb > 1) ? 4096 : 0), tid); vr[1] = tile_load(Vs + ((nb > 1) ? 4096 : 0), tid);
        tile_store(Kb, tid, kr[0]); tile_store(Vb, tid, vr[0]); __syncthreads();
        for (int s0 = 0; s0 < nb; s0 += 2) {
#pragma unroll
            for (int u = 0; u < 2; ++u) {
                const int s = s0 + u;
                if (s < nb) {
                    if (s + 2 < nb) { kr[u] = tile_load(Ks + (s + 2) * 4096, tid); vr[u] = tile_load(Vs + (s + 2) * 4096, tid); }
                    const LAS bf16_t* Kt = Kb + (s & 1) * (TILE_B / 2); const LAS bf16_t* Vt = Vb + (s & 1) * (TILE_B / 2);
                    if ((s & 31) == 0) mw = (s == 0) ? msk[0] : (s == 32) ? msk[1] : (s == 64) ? msk[2] : msk[3];
                    const bool sel = ((mw >> (s & 31)) & 1u) != 0u;
                    if (__any(sel)) {
                        const bool selk[3] = {sel, sel, sel};
                        qk_tile<3>(Kt, qf, st, cm, lane, selk);
                        if (s == cur) {
#pragma unroll
                            for (int g = 0; g < 3; ++g)
#pragma unroll
                                for (int kt = 0; kt < 4; ++kt)
#pragma unroll
                                    for (int r = 0; r < 4; ++r) { const int kk = 16 * kt + 4 * kg + r; st[g][kt][r] = (kk <= tq) ? st[g][kt][r] : -INFINITY; }
                        }
                        softmax_tiles<3>(st, ob, lacc, m, cm, lane);
                        pv_tile<3, true>(Vt, st, ob, lacc, lane);
                    }
                    if (s + 1 < nb) { tile_store(Kb + ((s + 1) & 1) * (TILE_B / 2), tid, kr[u ^ 1]); tile_store(Vb + ((s + 1) & 1) * (TILE_B / 2), tid, vr[u ^ 1]); }
                }
                LDS_BAR();
            }
        }
#pragma unroll
        for (int g = 0; g < 3; ++g) { const float sc = sigm(NSA_GATEP[3 * g + 1]) / fmaxf(lacc[g].x, 1e-30f);
#pragma unroll
            for (int dt = 0; dt < 4; ++dt) { u32x2 o = otp[(g * 4 + dt) * 64 + lane]; acc_pk(o, ob[g][dt] * sc); otp[(g * 4 + dt) * 64 + lane] = o; } }
    }
    {
#pragma unroll
        for (int g = 0; g < 3; ++g) { m[g] = -INFINITY; cm[g] = 0.f; lacc[g] = (f32x4){0.f, 0.f, 0.f, 0.f};
#pragma unroll
            for (int dt = 0; dt < 4; ++dt) ob[g][dt] = (f32x4){0.f, 0.f, 0.f, 0.f}; }
        const int s_lo = (2 * J - 8 > 0) ? 2 * J - 8 : 0, s_hi = 2 * J + 1, nb = s_hi - s_lo + 1;
        u32x4 kr[2], vr[2];
        kr[0] = tile_load(Kw + s_lo * 4096, tid); vr[0] = tile_load(Vw + s_lo * 4096, tid);
        kr[1] = tile_load(Kw + (s_lo + ((nb > 1) ? 1 : 0)) * 4096, tid); vr[1] = tile_load(Vw + (s_lo + ((nb > 1) ? 1 : 0)) * 4096, tid);
        tile_store(Kb, tid, kr[0]); tile_store(Vb, tid, vr[0]); __syncthreads();
        for (int it0 = 0; it0 < nb; it0 += 2) {
#pragma unroll
            for (int u = 0; u < 2; ++u) {
                const int it = it0 + u;
                if (it < nb) {
                    const int s = s_lo + it;
                    if (it + 2 < nb) { kr[u] = tile_load(Kw + (s + 2) * 4096, tid); vr[u] = tile_load(Vw + (s + 2) * 4096, tid); }
                    const LAS bf16_t* Kt = Kb + (it & 1) * (TILE_B / 2); const LAS bf16_t* Vt = Vb + (it & 1) * (TILE_B / 2);
                    if (s <= cur && s >= cur - 8) {
                        qk_tile<3>(Kt, qf, st, cm, lane, keep3);
                        if (s == cur || s == cur - 8) {
#pragma unroll
                            for (int g = 0; g < 3; ++g)
#pragma unroll
                                for (int kt = 0; kt < 4; ++kt)
#pragma unroll
                                    for (int r = 0; r < 4; ++r) { const int kk = 16 * kt + 4 * kg + r; const bool ok = (s == cur) ? (kk <= tq) : (kk > tq); st[g][kt][r] = ok ? st[g][kt][r] : -INFINITY; }
                        }
                        softmax_tiles<3>(st, ob, lacc, m, cm, lane);
                        pv_tile<3, true>(Vt, st, ob, lacc, lane);
                    }
                    if (it + 1 < nb) { tile_store(Kb + ((it + 1) & 1) * (TILE_B / 2), tid, kr[u ^ 1]); tile_store(Vb + ((it + 1) & 1) * (TILE_B / 2), tid, vr[u ^ 1]); }
                }
                LDS_BAR();
            }
        }
        bf16_t* mixp = (bf16_t*)(F.ws + WS_HM) + ((b * SEQ + tq_abs) * D + 3 * kvh * 64 + 4 * kg);
#pragma unroll
        for (int g = 0; g < 3; ++g) { const float sc = sigm(NSA_GATEP[3 * g + 2]) / fmaxf(lacc[g].x, 1e-30f);
#pragma unroll
            for (int dt = 0; dt < 4; ++dt) { u32x2 o = otp[(g * 4 + dt) * 64 + lane]; acc_pk(o, ob[g][dt] * sc); *(u32x2*)(mixp + g * 64 + 16 * dt) = o; } }
    }
}

__device__ __forceinline__ void moba_task(Frame& F, int b, int h, int own) {
    const int lane = F.lane, tid = F.tid, wv = F.wave, q = lane & 15, kg = lane >> 4;
    LAS bf16_t* Kb = (LAS bf16_t*)(F.lds + AT_K0); LAS bf16_t* Vb = (LAS bf16_t*)(F.lds + AT_V0); LAS bf16_t* Km = (LAS bf16_t*)(F.lds + AT_KMEAN);
    const size_t slab = (size_t)(b * 4 + h) * SEQ * 64;
    const bf16_t* Qg = (const bf16_t*)(F.ws + WS_MQKV) + slab; const bf16_t* Kg = Qg + MQKV_STRIDE; const bf16_t* Vg = Kg + MQKV_STRIDE;
    const int tw0 = 256 * own + 32 * wv;
    bf16x8 qf[2][2];
#pragma unroll
    for (int rt = 0; rt < 2; ++rt) { const bf16_t* qp = Qg + ((tw0 + 16 * rt + q) * 64 + 8 * kg); qf[rt][0] = *(const bf16x8*)qp; qf[rt][1] = *(const bf16x8*)(qp + 32); }
    if (tid < 256) { const u32x4 v = *(const u32x4*)((const bf16_t*)(F.ws + WS_KMEAN) + (size_t)(b * 4 + h) * 2048 + (tid >> 3) * 64 + (tid & 7) * 8); *(LAS u32x4*)(Km + (tid >> 3) * KP + (tid & 7) * 8) = v; }
    __syncthreads();
    unsigned msk[2] = {0u, 0u};
    {
        f32x4 gs[2][2];
#pragma unroll
        for (int kt = 0; kt < 2; ++kt) { const bf16x8 k0 = lds_frag(Km, 16 * kt + q, 8 * kg), k1 = lds_frag(Km, 16 * kt + q, 32 + 8 * kg);
#pragma unroll
            for (int rt = 0; rt < 2; ++rt) { f32x4 z = (f32x4){0.f, 0.f, 0.f, 0.f}; z = MFMA16(k0, qf[rt][0], z); gs[rt][kt] = MFMA16(k1, qf[rt][1], z); } }
#pragma unroll
        for (int rt = 0; rt < 2; ++rt) {
            float gv[8];
#pragma unroll
            for (int kt = 0; kt < 2; ++kt)
#pragma unroll
                for (int r = 0; r < 4; ++r) { const int blk = 16 * kt + 4 * kg + r; gv[4 * kt + r] = (blk < own) ? gs[rt][kt][r] : -INFINITY; }
            for (int it = 0; it < 3; ++it) {
                float bv = -INFINITY; int bs = 1 << 20;
#pragma unroll
                for (int k = 0; k < 8; ++k) { const int blk = 16 * (k >> 2) + 4 * kg + (k & 3); if (gv[k] > bv) { bv = gv[k]; bs = blk; } }
#pragma unroll
                for (int sh = 16; sh <= 32; sh <<= 1) { const float ov = shx(bv, sh, lane); const int os = shxi(bs, sh, lane); if (ov > bv || (ov == bv && os < bs)) { bv = ov; bs = os; } }
                if (bs < 32) { msk[rt] |= 1u << bs;
#pragma unroll
                    for (int k = 0; k < 8; ++k) if (16 * (k >> 2) + 4 * kg + (k & 3) == bs) gv[k] = -INFINITY; }
            }
        }
    }
    float m[2] = {-INFINITY, -INFINITY}; float cm[2] = {0.f, 0.f}; f32x4 lacc[2] = {(f32x4){0.f, 0.f, 0.f, 0.f}, (f32x4){0.f, 0.f, 0.f, 0.f}};
    f32x4 ob[2][4], st[2][4];
#pragma unroll
    for (int rt = 0; rt < 2; ++rt)
#pragma unroll
        for (int dt = 0; dt < 4; ++dt) ob[rt][dt] = (f32x4){0.f, 0.f, 0.f, 0.f};
    const int ntile = 4 * own + 4;
    u32x4 kr[2], vr[2];
    kr[0] = tile_load(Kg, tid); vr[0] = tile_load(Vg, tid); kr[1] = tile_load(Kg + 4096, tid); vr[1] = tile_load(Vg + 4096, tid);
    tile_store(Kb, tid, kr[0]); tile_store(Vb, tid, vr[0]); __syncthreads();
    for (int tau0 = 0; tau0 < ntile; tau0 += 2) {
#pragma unroll
        for (int u = 0; u < 2; ++u) {
            const int tau = tau0 + u;
            if (tau + 2 < ntile) { kr[u] = tile_load(Kg + (tau + 2) * 4096, tid); vr[u] = tile_load(Vg + (tau + 2) * 4096, tid); }
            const LAS bf16_t* Kt = Kb + (tau & 1) * (TILE_B / 2); const LAS bf16_t* Vt = Vb + (tau & 1) * (TILE_B / 2);
            const int blk = tau >> 2;
            bool sel[2]; bool anyv = false;
#pragma unroll
            for (int rt = 0; rt < 2; ++rt) { sel[rt] = (blk < own) ? ((msk[rt] >> blk) & 1u) : (64 * (tau & 3) <= 32 * wv + 16 * rt + q); anyv = anyv || sel[rt]; }
            if (__any(anyv)) {
                const bool selk[2] = {(blk < own) ? sel[0] : true, (blk < own) ? sel[1] : true};
                qk_tile<2>(Kt, qf, st, cm, lane, selk);
                if (blk >= own) {
#pragma unroll
                    for (int rt = 0; rt < 2; ++rt) {
                        const int trel = 32 * wv + 16 * rt + q;
#pragma unroll
                        for (int kt = 0; kt < 4; ++kt)
#pragma unroll
                            for (int r = 0; r < 4; ++r) { const int kk = 64 * (tau & 3) + 16 * kt + 4 * kg + r; st[rt][kt][r] = (kk <= trel) ? st[rt][kt][r] : -INFINITY; }
                    }
                }
                softmax_tiles<2>(st, ob, lacc, m, cm, lane);
                pv_tile<2, true>(Vt, st, ob, lacc, lane);
            }
            if (tau + 1 < ntile) { tile_store(Kb + ((tau + 1) & 1) * (TILE_B / 2), tid, kr[u ^ 1]); tile_store(Vb + ((tau + 1) & 1) * (TILE_B / 2), tid, vr[u ^ 1]); }
            LDS_BAR();
        }
    }
#pragma unroll
    for (int rt = 0; rt < 2; ++rt) {
        const float sc = 1.f / fmaxf(lacc[rt].x, 1e-30f);
        bf16_t* mix = (bf16_t*)(F.ws + WS_HM) + ((b * SEQ + tw0 + 16 * rt + q) * D + 384 + h * 64 + 4 * kg);
#pragma unroll
        for (int dt = 0; dt < 4; ++dt) { const f32x4 v = ob[rt][dt] * sc; u32x2 o; o.x = pk2(v.x, v.y); o.y = pk2(v.z, v.w); *(u32x2*)(mix + 16 * dt) = o; }
    }
}

constexpr int R2_RING = 16384, R2_SLOT = 12288;
__device__ __forceinline__ void r2_issue(const bf16_t* pt, const bf16_t* zp, LAS unsigned char* slot) {
#pragma unroll
    for (int mt = 0; mt < 2; ++mt)
#pragma unroll
        for (int ks = 0; ks < 4; ++ks) __builtin_amdgcn_global_load_lds((const unsigned*)(pt + mt * 2048 + ks * 16), (LAS unsigned*)(slot + (mt * 4 + ks) * 1024), 16, 0, 0);
#pragma unroll
    for (int mt = 0; mt < 2; ++mt)
#pragma unroll
        for (int q = 0; q < 2; ++q) __builtin_amdgcn_global_load_lds((const unsigned*)(zp + mt * 2048 + q * 8), (LAS unsigned*)(slot + 8192 + (mt * 2 + q) * 1024), 16, 0, 0);
}
__device__ __forceinline__ void r2_wave(Frame& F, int widx) {
    const int chain = widx >> 1, hf = widx & 1, lane = F.lane, c31 = lane & 31, hi = lane >> 5;
    LAS bf16_t* sb = (LAS bf16_t*)(F.lds + R2_SBUF + F.wave * (32 * KP * 2));
    LAS unsigned char* ring = F.lds + R2_RING + F.wave * (4 * R2_SLOT);
    for (int i = lane; i < 32 * KP / 2; i += 64) ((LAS unsigned*)sb)[i] = 0u;
    const bf16_t* PTl = (const bf16_t*)(F.ws + WS_PT) + (size_t)chain * 128 * 4096 + c31 * 64 + 8 * hi;
    const bf16_t* ZPl = (const bf16_t*)(F.ws + WS_ZS) + (size_t)chain * 128 * 4096 + (hf * 64 + lane) * 16;
    bf16_t* SS = (bf16_t*)(F.ws + WS_SS) + (size_t)chain * 128 * 4096 + (32 * hf) * 64;
    r2_issue(PTl, ZPl, ring); r2_issue(PTl + 4096, ZPl + 4096, ring + R2_SLOT); r2_issue(PTl + 2 * 4096, ZPl + 2 * 4096, ring + 2 * R2_SLOT);
#pragma unroll 1
    for (int c = 0; c < 128; ++c) {
        const int cn = (c + 3 < 128) ? c + 3 : 127;
        r2_issue(PTl + cn * 4096, ZPl + cn * 4096, ring + ((c + 3) & 3) * R2_SLOT);
        asm volatile("s_waitcnt vmcnt(36)" ::: "memory");
        const LAS unsigned char* sl = ring + (c & 3) * R2_SLOT + lane * 16;
        f32x16 acc[2];
#pragma unroll
        for (int mt = 0; mt < 2; ++mt)
#pragma unroll
            for (int q = 0; q < 2; ++q) { const u32x4 z = *(const LAS u32x4*)(sl + 8192 + (mt * 2 + q) * 1024);
                acc[mt][8 * q + 0] = __uint_as_float(z.x << 16); acc[mt][8 * q + 1] = __uint_as_float(z.x & 0xffff0000u); acc[mt][8 * q + 2] = __uint_as_float(z.y << 16); acc[mt][8 * q + 3] = __uint_as_float(z.y & 0xffff0000u);
                acc[mt][8 * q + 4] = __uint_as_float(z.z << 16); acc[mt][8 * q + 5] = __uint_as_float(z.z & 0xffff0000u); acc[mt][8 * q + 6] = __uint_as_float(z.w << 16); acc[mt][8 * q + 7] = __uint_as_float(z.w & 0xffff0000u); }
#pragma unroll
        for (int ks = 0; ks < 4; ++ks) {
            const bf16x8 bx = *(const LAS bf16x8*)(sb + c31 * KP + 16 * ks + 8 * hi);
#pragma unroll
            for (int mt = 0; mt < 2; ++mt) { const bf16x8 pa = *(const LAS bf16x8*)(sl + (mt * 4 + ks) * 1024); acc[mt] = MFMA32(pa, bx, acc[mt]); }
        }
#pragma unroll
        for (int mt = 0; mt < 2; ++mt)
#pragma unroll
            for (int r = 0; r < 16; ++r) sb[c31 * KP + 32 * mt + (r & 3) + 8 * (r >> 2) + 4 * hi] = f2bf(acc[mt][r]);
        bf16_t* ss = SS + c * 4096;
#pragma unroll
        for (int j = 0; j < 4; ++j) { const int qd = lane + 64 * j, row = qd >> 3, ch = qd & 7; *(u32x4*)(ss + row * 64 + ch * 8) = *(const LAS u32x4*)(sb + row * KP + ch * 8); }
    }
    asm volatile("s_waitcnt vmcnt(0)" ::: "memory");
}

struct TaskTable { unsigned short v[512]; };
constexpr TaskTable make_tasks() {
    TaskTable t{}; int n = 0, a = 63, am = 0, c = 31, cm = 0;
    while (a >= 0 || c >= 0) {
        const int ca = (a >= 0) ? 96 * a + 1344 : -1, cc = (c >= 0) ? 128 * c + 128 : -1;
        if (ca >= cc) { t.v[n++] = (unsigned short)(0 * 512 + am * 64 + a); if (++am == 4) { am = 0; --a; } }
        else { t.v[n++] = (unsigned short)(1 * 512 + cm * 64 + c); if (++cm == 8) { cm = 0; --c; } }
    }
    return t;
}
__device__ const TaskTable g_tasks = make_tasks();

__device__ __forceinline__ void r3_task(Frame& F, int layer, int task) {
    const int chain = task >> 7, c = task & 127, b = chain / 6, h = chain % 6, lane = F.lane, c31 = lane & 31, hi = lane >> 5;
    const bf16_t* S0 = (const bf16_t*)(F.ws + WS_SS) + (size_t)(task - 1) * 4096;
    const bf16_t* YT = (const bf16_t*)(F.ws + WS_YT) + (size_t)task * 4096;
    const bf16_t* Y0 = (const bf16_t*)(F.ws + WS_Y0) + (size_t)task * 4096;
    const bf16_t* rf = (const bf16_t*)(F.ws + WS_RFEAT);
    const bf16_t* gut = (const bf16_t*)(F.ws + WS_GUPT) + (size_t)(h * 64) * 128;
    const float* mu = INF(F, I_MU) + layer * RW;
    f32x16 acc[2][2], gacc[2][2];
#pragma unroll
    for (int a = 0; a < 2; ++a)
#pragma unroll
        for (int n = 0; n < 2; ++n)
#pragma unroll
            for (int r = 0; r < 16; ++r) { acc[a][n][r] = 0.f; gacc[a][n][r] = 0.f; }
    if (c > 0) {
#pragma unroll
        for (int ks = 0; ks < 4; ++ks) {
            bf16x8 af[2], bfr[2];
#pragma unroll
            for (int mt = 0; mt < 2; ++mt) af[mt] = *(const bf16x8*)(S0 + (32 * mt + c31) * 64 + 16 * ks + 8 * hi);
#pragma unroll
            for (int nt = 0; nt < 2; ++nt) bfr[nt] = *(const bf16x8*)(YT + (32 * nt + c31) * 64 + 16 * ks + 8 * hi);
#pragma unroll
            for (int mt = 0; mt < 2; ++mt)
#pragma unroll
                for (int nt = 0; nt < 2; ++nt) acc[mt][nt] = MFMA32(af[mt], bfr[nt], acc[mt][nt]);
        }
    }
#pragma unroll
    for (int ks = 0; ks < 8; ++ks) {
        bf16x8 af[2], bfr[2];
#pragma unroll
        for (int mt = 0; mt < 2; ++mt) af[mt] = *(const bf16x8*)(gut + (32 * mt + c31) * 128 + 16 * ks + 8 * hi);
#pragma unroll
        for (int nt = 0; nt < 2; ++nt) {
            const int t = 64 * c + 32 * nt + c31, j0 = 16 * ks + 8 * hi; const size_t row = (size_t)b * SEQ + t;
            const u32x4 cu = *(const u32x4*)(rf + row * RW + 1280 + j0);
            u32x4 pv = (u32x4){0u, 0u, 0u, 0u}; if (t > 0) pv = *(const u32x4*)(rf + (row - 1) * RW + 1280 + j0);
            const f32x4 m0 = *(const f32x4*)(mu + 1280 + j0), m1 = *(const f32x4*)(mu + 1280 + j0 + 4);
            float cv[8], pw[8];
            cv[0] = __uint_as_float(cu.x << 16); cv[1] = __uint_as_float(cu.x & 0xffff0000u); cv[2] = __uint_as_float(cu.y << 16); cv[3] = __uint_as_float(cu.y & 0xffff0000u);
            cv[4] = __uint_as_float(cu.z << 16); cv[5] = __uint_as_float(cu.z & 0xffff0000u); cv[6] = __uint_as_float(cu.w << 16); cv[7] = __uint_as_float(cu.w & 0xffff0000u);
            pw[0] = __uint_as_float(pv.x << 16); pw[1] = __uint_as_float(pv.x & 0xffff0000u); pw[2] = __uint_as_float(pv.y << 16); pw[3] = __uint_as_float(pv.y & 0xffff0000u);
            pw[4] = __uint_as_float(pv.z << 16); pw[5] = __uint_as_float(pv.z & 0xffff0000u); pw[6] = __uint_as_float(pv.w << 16); pw[7] = __uint_as_float(pv.w & 0xffff0000u);
            const float mm[8] = {m0.x, m0.y, m0.z, m0.w, m1.x, m1.y, m1.z, m1.w};
            float sg[8];
#pragma unroll
            for (int k = 0; k < 8; ++k) sg[k] = sigm(cv[k] + (pw[k] - cv[k]) * mm[k]);
            u32x4 u; u.x = pk2(sg[0], sg[1]); u.y = pk2(sg[2], sg[3]); u.z = pk2(sg[4], sg[5]); u.w = pk2(sg[6], sg[7]);
            bfr[nt] = __builtin_bit_cast(bf16x8, u);
        }
#pragma unroll
        for (int mt = 0; mt < 2; ++mt)
#pragma unroll
            for (int nt = 0; nt < 2; ++nt) gacc[mt][nt] = MFMA32(af[mt], bfr[nt], gacc[mt][nt]);
    }
    const float* lnw = INF(F, I_LNW) + layer * 384 + h * 64; const float* lnb = INF(F, I_LNB) + layer * 384 + h * 64;
    const float* bonus = (const float*)(F.ws + WS_BONUS);
    bf16_t* mix = (bf16_t*)(F.ws + WS_HM);
#pragma unroll
    for (int nt = 0; nt < 2; ++nt) {
        const int tl = 32 * nt + c31, t = 64 * c + tl; const size_t row = (size_t)b * SEQ + t;
        float s = 0.f;
#pragma unroll
        for (int mt = 0; mt < 2; ++mt)
#pragma unroll
            for (int rq = 0; rq < 4; ++rq) {
                const u32x2 y = *(const u32x2*)(Y0 + tl * 64 + 32 * mt + 8 * rq + 4 * hi);
                acc[mt][nt][4 * rq + 0] += __uint_as_float(y.x << 16); acc[mt][nt][4 * rq + 1] += __uint_as_float(y.x & 0xffff0000u);
                acc[mt][nt][4 * rq + 2] += __uint_as_float(y.y << 16); acc[mt][nt][4 * rq + 3] += __uint_as_float(y.y & 0xffff0000u);
                s += (acc[mt][nt][4 * rq] + acc[mt][nt][4 * rq + 1]) + (acc[mt][nt][4 * rq + 2] + acc[mt][nt][4 * rq + 3]);
            }
        s += shx(s, 32, lane);
        const float mean = s * (1.f / 64.f);
        float vs = 0.f;
#pragma unroll
        for (int mt = 0; mt < 2; ++mt)
#pragma unroll
            for (int r = 0; r < 16; ++r) { const float d = acc[mt][nt][r] - mean; vs += d * d; }
        vs += shx(vs, 32, lane);
        const float rstd = rsqrtf(vs * (1.f / 64.f) + 64e-5f);
        const float bn = bonus[row * 8 + h];
        u32x2 vcs[2][4], vps[2][4];
#pragma unroll
        for (int mt = 0; mt < 2; ++mt)
#pragma unroll
            for (int rq = 0; rq < 4; ++rq) { const int v0 = 32 * mt + 8 * rq + 4 * hi;
                vcs[mt][rq] = *(const u32x2*)(rf + row * RW + 768 + h * 64 + v0);
                vps[mt][rq] = (u32x2){0u, 0u}; if (t > 0) vps[mt][rq] = *(const u32x2*)(rf + (row - 1) * RW + 768 + h * 64 + v0); }
#pragma unroll
        for (int mt = 0; mt < 2; ++mt)
#pragma unroll
            for (int rq = 0; rq < 4; ++rq) {
                const int v0 = 32 * mt + 8 * rq + 4 * hi;
                const u32x2 vc = vcs[mt][rq], vp = vps[mt][rq];
                const f32x4 mv = *(const f32x4*)(mu + 768 + h * 64 + v0), lw = *(const f32x4*)(lnw + v0), lb = *(const f32x4*)(lnb + v0);
                const float vcur[4] = {__uint_as_float(vc.x << 16), __uint_as_float(vc.x & 0xffff0000u), __uint_as_float(vc.y << 16), __uint_as_float(vc.y & 0xffff0000u)};
                const float vprv[4] = {__uint_as_float(vp.x << 16), __uint_as_float(vp.x & 0xffff0000u), __uint_as_float(vp.y << 16), __uint_as_float(vp.y & 0xffff0000u)};
                const float mvv[4] = {mv.x, mv.y, mv.z, mv.w}, lwv[4] = {lw.x, lw.y, lw.z, lw.w}, lbv[4] = {lb.x, lb.y, lb.z, lb.w};
                float o[4];
#pragma unroll
                for (int k = 0; k < 4; ++k) {
                    const float vsh = vcur[k] + (vprv[k] - vcur[k]) * mvv[k];
                    const float y = (acc[mt][nt][4 * rq + k] - mean) * rstd * lwv[k] + lbv[k];
                    o[k] = (y + bn * vsh) * gacc[mt][nt][4 * rq + k];
                }
                u32x2 ov; ov.x = pk2(o[0], o[1]); ov.y = pk2(o[2], o[3]);
                *(u32x2*)(mix + row * D + 640 + h * 64 + v0) = ov;
            }
    }
}
__device__ __forceinline__ void mixnorm_rows(Frame& F, int layer, int m0, int nrows) {
    bf16_t* mix = (bf16_t*)(F.ws + WS_HM);
    const float* gn = INF(F, I_NNSA) + layer * 384; const float* gm = INF(F, I_NMOBA) + layer * 256;
    const int lane = F.lane;
    for (int mb = m0 + F.wave; mb < m0 + nrows; mb += 8 * NWAVES) {
        unsigned a[8][3], c[8][2];
#pragma unroll
        for (int i = 0; i < 8; ++i) { const int m = mb + i * NWAVES; const unsigned* rowp = (const unsigned*)(mix + (size_t)((m < m0 + nrows) ? m : mb) * D);
#pragma unroll
            for (int j = 0; j < 3; ++j) a[i][j] = rowp[lane + 64 * j];
#pragma unroll
            for (int j = 0; j < 2; ++j) c[i][j] = rowp[192 + lane + 64 * j]; }
#pragma unroll
        for (int i = 0; i < 8; ++i) { const int m = mb + i * NWAVES; if (m >= m0 + nrows) break;
            unsigned* rowp = (unsigned*)(mix + (size_t)m * D);
            float sa = 0.f, sc = 0.f;
#pragma unroll
            for (int j = 0; j < 3; ++j) { const float x = __uint_as_float(a[i][j] << 16), y = __uint_as_float(a[i][j] & 0xffff0000u); sa += x * x + y * y; }
#pragma unroll
            for (int j = 0; j < 2; ++j) { const float x = __uint_as_float(c[i][j] << 16), y = __uint_as_float(c[i][j] & 0xffff0000u); sc += x * x + y * y; }
            const float ra = rsqrtf(wave_sum(sa, lane) * (1.f / 384.f) + NORM_EPS), rc = rsqrtf(wave_sum(sc, lane) * (1.f / 256.f) + NORM_EPS);
#pragma unroll
            for (int j = 0; j < 3; ++j) { const int col = 2 * (lane + 64 * j); rowp[lane + 64 * j] = pk2(__uint_as_float(a[i][j] << 16) * ra * gn[col], __uint_as_float(a[i][j] & 0xffff0000u) * ra * gn[col + 1]); }
#pragma unroll
            for (int j = 0; j < 2; ++j) { const int col = 2 * (lane + 64 * j); rowp[192 + lane + 64 * j] = pk2(__uint_as_float(c[i][j] << 16) * rc * gm[col], __uint_as_float(c[i][j] & 0xffff0000u) * rc * gm[col + 1]); }
        }
    }
}
__device__ __forceinline__ void phase_e(Frame& F, int layer) {
    const int gw = F.bid * NWAVES + F.wave, NGW = F.G * NWAVES;
    (void)gw; (void)NGW; (void)layer;
}

constexpr int CW_TILE = 1536;
constexpr int CW_R2DONE = 512;
__device__ __forceinline__ void phase_d(Frame& F, int layer, int rep = 0) {
    if (F.bid < 12 && rep == 0) {
        await_count(F, F.ctl + CW_R1DONE + 64 * layer + F.bid, 16u);
        if (F.wave < 2) { r2_wave(F, F.bid * 2 + F.wave);
            __builtin_amdgcn_fence(__ATOMIC_RELEASE, "agent"); asm volatile("s_waitcnt vmcnt(0)" ::: "memory");
            if (F.lane == 0) (void)__hip_atomic_fetch_add(F.ctl + CW_R2DONE + 64 * layer, 1u, RLX_AGENT); }
        __syncthreads();
#if DBG_MODE == 4
        if (F.bid == 0 && layer == 0) __hip_atomic_store(F.ctl + 3200 + 30, (unsigned)__builtin_amdgcn_s_memrealtime(), RLX_AGENT);
#endif
    }
    LAUNDER(F);
    await_count(F, F.ctl + CW_PREP + 64 * layer, 64u);
    LAUNDER(F);
    volatile LAS int* tw = (volatile LAS int*)(F.lds + AT_MISC);
    unsigned* qh = F.ctl + CW_Q + 64 * layer + 16 * rep;
    const int ntask = (rep == 0) ? 512 + 192 + 128 : 512;
    for (;;) {
        if (F.tid == 0) tw[0] = (int)__hip_atomic_fetch_add(qh, 1u, RLX_AGENT);
        __syncthreads();
        const int k = __builtin_amdgcn_readfirstlane(tw[0]);
        __syncthreads();
        if (k >= ntask) break;
        LAUNDER(F);
        if (k >= 512 + 192) {
            const int tile = k - (512 + 192);
            await_count(F, F.ctl + CW_TILE + 128 * layer + tile, 6u);
            mixnorm_rows(F, layer, tile * 128, 128);
            continue;
        }
        if (k >= 512) {
            if (F.tid == 0) { unsigned sp = 0; while ((unsigned)__builtin_amdgcn_readfirstlane(__hip_atomic_load(F.ctl + CW_R2DONE + 64 * layer, RLX_AGENT)) < 24u) { __builtin_amdgcn_s_sleep(4); if (++sp > (1u << 24)) break; }
                __builtin_amdgcn_fence(__ATOMIC_ACQUIRE, "agent"); asm volatile("s_waitcnt vmcnt(0)" ::: "memory"); }
            __syncthreads();
            r3_task(F, layer, (k - 512) * 8 + F.wave);
            continue;
        }
        const int code = g_tasks.v[k], ty = code >> 9, mm = (code >> 6) & 7, jj = code & 63;
        if (ty == 0) nsa_task(F, mm >> 1, mm & 1, jj); else moba_task(F, mm >> 2, mm & 3, jj);
        if (rep == 0) {
            asm volatile("s_waitcnt vmcnt(0)" ::: "memory"); __syncthreads();
            if (F.tid == 0) { __builtin_amdgcn_fence(__ATOMIC_RELEASE, "agent"); asm volatile("s_waitcnt vmcnt(0)" ::: "memory");
                unsigned* tc = F.ctl + CW_TILE + 128 * layer;
                if (ty == 0) (void)__hip_atomic_fetch_add(tc + (mm >> 1) * 64 + jj, 1u, RLX_AGENT);
                else { (void)__hip_atomic_fetch_add(tc + (mm >> 2) * 64 + 2 * jj, 1u, RLX_AGENT); (void)__hip_atomic_fetch_add(tc + (mm >> 2) * 64 + 2 * jj + 1, 1u, RLX_AGENT); } }
        }
    }
}

__device__ __forceinline__ void phase_g1(Frame& F, int layer) {
    LAS float* wr = (LAS float*)F.lds;
    { const float* W = INF(F, I_WROUTER);
#pragma unroll 1
      for (int i0 = 0; i0 < 4096; i0 += 2048) { f32x4 t4[4];
#pragma unroll
          for (int u = 0; u < 4; ++u) t4[u] = *(const f32x4*)(W + 4 * (i0 + u * NTHR + F.tid));
#pragma unroll
          for (int u = 0; u < 4; ++u) { const int i = 4 * (i0 + u * NTHR + F.tid), k = i >> 4, e = i & 15;
              wr[e * 1028 + k] = t4[u].x; wr[(e + 1) * 1028 + k] = t4[u].y; wr[(e + 2) * 1028 + k] = t4[u].z; wr[(e + 3) * 1028 + k] = t4[u].w; } } }
    __syncthreads();
    const float* mod = (const float*)(F.ws + WS_MOD);
    bf16_t* H = (bf16_t*)(F.ws + WS_HM);
    unsigned* cnt = F.ctl + CW_CNT + 64 * layer;
    const float* rb = INF(F, I_RBIAS);
    const float* gn = INF(F, I_NFFN) + layer * D;
    const int gw = F.bid * NWAVES + F.wave, NGW = F.G * NWAVES;
    const bf16_t* res = (const bf16_t*)(F.ws + WS_RES);
    u32x2 vnext[4];
#pragma unroll
    for (int j = 0; j < 4; ++j) vnext[j] = *(const u32x2*)(res + (size_t)gw * D + 4 * F.lane + 256 * j);
    int px = 0, pm = 0; float pw = 0.f; int ridx = 0;
    for (int m = gw; m < T; m += NGW, ++ridx) {
        int lane = F.lane; asm volatile("" : "+v"(lane));
        const int b = m >> 13;
        const float* sh = mod + ((size_t)layer * BATCH + b) * 6144 + 3072; const float* sc = sh + 1024;
        f32x4 v[4]; float ss = 0.f;
#pragma unroll
        for (int j = 0; j < 4; ++j) { const u32x2 t2 = vnext[j]; v[j] = (f32x4){__uint_as_float(t2.x << 16), __uint_as_float(t2.x & 0xffff0000u), __uint_as_float(t2.y << 16), __uint_as_float(t2.y & 0xffff0000u)};
            ss += (v[j].x * v[j].x + v[j].y * v[j].y) + (v[j].z * v[j].z + v[j].w * v[j].w); }
        const float rstd = rsqrtf(wave_sum(ss, lane) * (1.f / D) + NORM_EPS);
        float lg[16]; f32x2_t lgp[16];
#pragma unroll
        for (int e = 0; e < 16; ++e) lgp[e] = (f32x2_t){0.f, 0.f};
#pragma unroll
        for (int j = 0; j < 4; ++j) { const int col = 4 * lane + 256 * j;
            const f32x4 g = *(const f32x4*)(gn + col), s1 = *(const f32x4*)(sc + col), s0 = *(const f32x4*)(sh + col);
            const float hx = v[j].x * rstd * g.x * (1.f + s1.x) + s0.x, hy = v[j].y * rstd * g.y * (1.f + s1.y) + s0.y, hz = v[j].z * rstd * g.z * (1.f + s1.z) + s0.z, hw = v[j].w * rstd * g.w * (1.f + s1.w) + s0.w;
            u32x2 o; o.x = pk2(hx, hy); o.y = pk2(hz, hw); *(u32x2*)(H + (size_t)m * D + col) = o;
            const f32x2_t h01 = {hx, hy}, h23 = {hz, hw};
#pragma unroll
            for (int e = 0; e < 16; ++e) { const f32x4 w4 = *(const LAS f32x4*)(wr + e * 1028 + col);
                lgp[e] = __builtin_elementwise_fma(h01, (f32x2_t){w4.x, w4.y}, lgp[e]); lgp[e] = __builtin_elementwise_fma(h23, (f32x2_t){w4.z, w4.w}, lgp[e]); }
        }
#pragma unroll
        for (int e = 0; e < 16; ++e) lg[e] = lgp[e].x + lgp[e].y;
        { const int mn = (m + NGW < T) ? m + NGW : m;
#pragma unroll
          for (int j = 0; j < 4; ++j) vnext[j] = *(const u32x2*)(res + (size_t)mn * D + 4 * lane + 256 * j); }
        float r8[8], r4[4], r2[2], r1;
#pragma unroll
        for (int e = 0; e < 8; ++e) { auto sw = __builtin_amdgcn_permlane32_swap(__float_as_uint(lg[e]), __float_as_uint(lg[e + 8]), false, false); r8[e] = __uint_as_float(sw[0]) + __uint_as_float(sw[1]); }
#pragma unroll
        for (int e = 0; e < 4; ++e) { auto sw = __builtin_amdgcn_permlane16_swap(__float_as_uint(r8[e]), __float_as_uint(r8[e + 4]), false, false); r4[e] = __uint_as_float(sw[0]) + __uint_as_float(sw[1]); }
        { const bool up = (lane & 8) != 0;
#pragma unroll
          for (int e = 0; e < 2; ++e) { const float keep = up ? r4[e + 2] : r4[e], send = up ? r4[e] : r4[e + 2]; r2[e] = keep + dpp_mov<0x140>(send); } }
        { const bool up = (lane & 4) != 0; const float keep = up ? r2[1] : r2[0], send = up ? r2[0] : r2[1]; r1 = keep + dpp_mov<0x141>(send); }
        r1 += dpp_mov<0x4E>(r1); r1 += dpp_mov<0xB1>(r1);
        const int el = (((lane >> 5) & 1) << 3) | (((lane >> 4) & 1) << 2) | (((lane >> 3) & 1) << 1) | ((lane >> 2) & 1);
        const float affl = sigm(r1), bial = affl + rb[el];
        float aff[16], bia[16];
#pragma unroll
        for (int e = 0; e < 16; ++e) { const int src = ((e & 8) ? 32 : 0) | ((e & 4) ? 16 : 0) | ((e & 2) ? 8 : 0) | ((e & 1) ? 4 : 0);
            aff[e] = __uint_as_float(__builtin_amdgcn_readlane(__float_as_uint(affl), src)); bia[e] = __uint_as_float(__builtin_amdgcn_readlane(__float_as_uint(bial), src)); }
        int best = 0; float bscore = -INFINITY;
#pragma unroll
        for (int g = 0; g < 4; ++g) {
            float t1 = -INFINITY, t2 = -INFINITY;
#pragma unroll
            for (int k = 0; k < 4; ++k) { const float x = bia[4 * g + k]; if (x > t1) { t2 = t1; t1 = x; } else if (x > t2) t2 = x; }
            const float gs = t1 + t2; if (gs > bscore) { bscore = gs; best = g; }
        }
        float x4[4], a4[4];
#pragma unroll
        for (int k = 0; k < 4; ++k) { x4[k] = (best == 0) ? bia[k] : (best == 1) ? bia[4 + k] : (best == 2) ? bia[8 + k] : bia[12 + k]; a4[k] = (best == 0) ? aff[k] : (best == 1) ? aff[4 + k] : (best == 2) ? aff[8 + k] : aff[12 + k]; }
        int i1 = 0; float v1 = x4[0];
#pragma unroll
        for (int k = 1; k < 4; ++k) if (x4[k] > v1) { v1 = x4[k]; i1 = k; }
        int i2 = -1; float v2 = -INFINITY;
#pragma unroll
        for (int k = 0; k < 4; ++k) if (k != i1 && x4[k] > v2) { v2 = x4[k]; i2 = k; }
        float w1 = 0.f, w2 = 0.f;
#pragma unroll
        for (int k = 0; k < 4; ++k) { if (k == i1) w1 = a4[k]; if (k == i2) w2 = a4[k]; }
        const float ws = w1 + w2; w1 /= ws; w2 /= ws;
        if (lane == 2 * ridx) { px = 4 * best + i1; pm = m; pw = w1; }
        if (lane == 2 * ridx + 1) { px = 4 * best + i2; pm = m; pw = w2; }
    }
    LAUNDER(F);
    {
        const int lane = F.lane; const int np = 2 * ridx;
        int rank = 0, total = 0, leader = 64;
        for (int j = 0; j < np; ++j) { const int xj = __builtin_amdgcn_readlane(px, j); const bool same = (xj == px); rank += (same && j < lane) ? 1 : 0; total += same ? 1 : 0; leader = (same && j < leader) ? j : leader; }
        int base = 0;
        if (lane < np && rank == 0) base = (int)__hip_atomic_fetch_add(cnt + px, (unsigned)total, RLX_AGENT);
        base = __builtin_amdgcn_ds_bpermute((leader & 63) << 2, base);
        if (lane < np) { const int idx = px * 16384 + base + rank; ((int*)(F.ws + WS_ELIST))[idx] = 2 * pm + (lane & 1); ((float*)(F.ws + WS_EWW))[idx] = pw; }
    }
    asm volatile("s_waitcnt vmcnt(0)" ::: "memory"); __syncthreads();
    if (F.wave == 0) {
        unsigned tk = 0;
        if (F.lane == 0) { __builtin_amdgcn_fence(__ATOMIC_RELEASE, "agent"); asm volatile("s_waitcnt vmcnt(0)" ::: "memory"); tk = __hip_atomic_fetch_add(cnt + 32, 1u, RLX_AGENT); }
        tk = (unsigned)__builtin_amdgcn_readfirstlane((int)tk);
        if (tk == (unsigned)F.G - 1u) {
            __builtin_amdgcn_fence(__ATOMIC_ACQUIRE, "agent");
            const int lane = F.lane;
            int* tile_e = (int*)(F.ws + WS_ROWINFO + layer * ROWINFO_LSTRIDE) + 2 * MAXROWS;
            const int c = (lane < 16) ? (int)__hip_atomic_load(cnt + (lane & 15), RLX_AGENT) : 0, nt = (c + 255) >> 8;
            int ofs = 0, tot = 0;
            for (int e = 0; e < 16; ++e) { const int ne = __builtin_amdgcn_readlane(nt, e) << 8; ofs += (e < lane) ? ne : 0; tot += ne; }
            if (lane < 16) { tile_e[TE_OFF + lane] = ofs; tile_e[TE_CNT + lane] = c; for (int j = 0; j < nt; ++j) tile_e[(ofs >> 8) + j] = lane; }
            if (lane == 0) tile_e[256] = tot >> 8;
        }
    }
}
__device__ __forceinline__ void phase_g2(Frame& F, int layer) {
    volatile LAS int* off = (volatile LAS int*)F.lds;
    unsigned* cnt = F.ctl + CW_CNT + 64 * layer;
    int* rowinfo = (int*)(F.ws + WS_ROWINFO + layer * ROWINFO_LSTRIDE); float* roww = (float*)(rowinfo + MAXROWS); int* tile_e = rowinfo + 2 * MAXROWS; int* ntl = tile_e + 256;
    if (F.tid == 0) { int o = 0; for (int e = 0; e < 16; ++e) { off[e] = o; const int c = (int)__hip_atomic_load(cnt + e, RLX_AGENT); o += ((c + 255) >> 8) << 8; } off[16] = o; }
    __syncthreads();
    if (F.bid == 0) {
        if (F.tid == 0) ntl[0] = off[16] >> 8;
        for (int e = 0; e < 16; ++e) {
            const int c = (int)__hip_atomic_load(cnt + e, RLX_AGENT), o0 = off[e], o1 = off[e + 1];
            for (int r = o0 + c + F.tid; r < o1; r += NTHR) { rowinfo[r] = -1; roww[r] = 0.f; }
            for (int tl = (o0 >> 8) + F.tid; tl < (o1 >> 8); tl += NTHR) tile_e[tl] = e;
        }
    }
    const int* route = (const int*)(F.ws + WS_ROUTE);
    const int gw = F.bid * NWAVES + F.wave, NGW = F.G * NWAVES, lane = F.lane;
    for (int m = gw; m < T; m += NGW) {
        const int* rp = route + (size_t)m * 8;
        const int e1 = ld_ctl(rp), e2 = ld_ctl(rp + 1), p1 = ld_ctl(rp + 2), p2 = ld_ctl(rp + 3);
        const int r1 = off[e1] + p1, r2 = off[e2] + p2;
        if (lane == 0) { rowinfo[r1] = 2 * m; rowinfo[r2] = 2 * m + 1; roww[r1] = __int_as_float(ld_ctl(rp + 4)); roww[r2] = __int_as_float(ld_ctl(rp + 5)); }
    }
}

#if DBG_MODE == 2
__device__ __forceinline__ void dbg_flag(Frame& F, bool bad, unsigned code) { if (__any(bad) && F.lane == 0) atomicCAS(F.ctl + CW_DBG, 0u, code); }
__device__ __forceinline__ void scan_bf16(Frame& F, size_t off, size_t n, unsigned code) {
    const unsigned* p = (const unsigned*)(F.ws + off); bool bad = false;
    for (size_t i = (size_t)F.bid * NTHR + F.tid; i < n / 2; i += (size_t)F.G * NTHR) { const unsigned u = p[i]; bad = bad || ((u & 0x7f80u) == 0x7f80u) || ((u & 0x7f800000u) == 0x7f800000u); }
    dbg_flag(F, bad, code); }
__device__ __forceinline__ void scan_f32p(Frame& F, const float* p, size_t n, unsigned code) {
    bool bad = false;
    for (size_t i = (size_t)F.bid * NTHR + F.tid; i < n; i += (size_t)F.G * NTHR) { const unsigned u = __float_as_uint(p[i]); bad = bad || ((u & 0x7f800000u) == 0x7f800000u); }
    dbg_flag(F, bad, code); }
__device__ __forceinline__ void dbg_check(Frame& F, int p) {
    const unsigned code = (unsigned)(p + 1);
    if (DBG_SUB >= 4) {
        if (p != DBG_P) return;
        const size_t off = (DBG_SUB == 4) ? WS_ZS : (DBG_SUB == 5) ? WS_PT : (DBG_SUB == 6) ? WS_YT : WS_Y0;
        const unsigned* q = (const unsigned*)(F.ws + off); unsigned mx = 0;
        for (size_t i = (size_t)F.bid * NTHR + F.tid; i < (size_t)1536 * 2048; i += (size_t)F.G * NTHR) { const unsigned u = q[i]; const unsigned e0 = (u >> 7) & 0xffu, e1 = (u >> 23) & 0xffu; mx = mx > e0 ? mx : e0; mx = mx > e1 ? mx : e1; }
#if DBG_CNT
        { unsigned cnt = 0; for (size_t i = (size_t)F.bid * NTHR + F.tid; i < (size_t)1536 * 2048; i += (size_t)F.G * NTHR) { const unsigned u = q[i]; cnt += (((u >> 7) & 0xffu) == 0xffu) + (((u >> 23) & 0xffu) == 0xffu); }
          if (cnt) atomicAdd(F.ctl + CW_DBG, cnt); return; }
#endif
        atomicMax(F.ctl + CW_DBG, mx); return; }
    if (DBG_SUB == 3 && p != 4) return;
    if (p == 0) { scan_f32p(F, (const float*)(F.ws + WS_COS), (size_t)T * 64, code); scan_f32p(F, (const float*)(F.ws + WS_MOD), 2 * 2 * 6144, code); return; }
    if (p > 10 * NL) return;
    const int sub = (p - 1) % 10;
    switch (sub) {
    case 0: scan_bf16(F, WS_HM, (size_t)T * D, code); scan_bf16(F, WS_WIN, (size_t)NPAD * D, code); scan_bf16(F, WS_WOUT, (size_t)D * D, code); scan_bf16(F, WS_WUP, (size_t)16 * 512 * D, code);
            scan_bf16(F, WS_WDN, (size_t)16 * D * 256, code); scan_bf16(F, WS_PHIW, (size_t)2 * 64 * 2048, code); scan_bf16(F, WS_GUPT, 384 * 128, code); scan_f32p(F, (const float*)(F.ws + WS_PHIB), 256, code); break;
    case 1: scan_bf16(F, WS_NQ, (size_t)T * 384, code); scan_bf16(F, WS_KV6, (size_t)6 * T * 128, code); scan_bf16(F, WS_MQKV, (size_t)3 * T * 256, code); scan_bf16(F, WS_RFEAT, (size_t)T * RW, code);
            scan_f32p(F, (const float*)(F.ws + WS_GATE), (size_t)T * 32, code); break;
    case 2: scan_bf16(F, WS_KCMP, 2 * 2 * 512 * 64, code); scan_bf16(F, WS_VCMP, 2 * 2 * 512 * 64, code); scan_bf16(F, WS_KMEAN, 2 * 4 * 32 * 64, code);
            scan_bf16(F, WS_PT, (size_t)1536 * 4096, code); scan_bf16(F, WS_ZS, (size_t)1536 * 4096, code); scan_bf16(F, WS_YT, (size_t)1536 * 4096, code); scan_bf16(F, WS_Y0, (size_t)1536 * 4096, code);
            scan_f32p(F, (const float*)(F.ws + WS_BONUS), (size_t)T * 8, code); break;
    case 3: {
#if DBG_SUB == 3
        if (p == 4) { const unsigned* hm = (const unsigned*)(F.ws + WS_HM); bool b1 = false, b2 = false, b4 = false;
            for (size_t i = (size_t)F.bid * NTHR + F.tid; i < (size_t)T * 512; i += (size_t)F.G * NTHR) { const unsigned u = hm[i]; const int col = (int)(i & 511) * 2; const bool bad = ((u & 0x7f80u) == 0x7f80u) || ((u & 0x7f800000u) == 0x7f800000u);
                if (col < 384) b1 = b1 || bad; else if (col < 640) b2 = b2 || bad; }
            const unsigned* zs = (const unsigned*)(F.ws + WS_ZS);
            for (size_t i = (size_t)F.bid * NTHR + F.tid; i < (size_t)1536 * 2048; i += (size_t)F.G * NTHR) { const unsigned u = zs[i]; b4 = b4 || ((u & 0x7f80u) == 0x7f80u) || ((u & 0x7f800000u) == 0x7f800000u); }
            const unsigned bits = (__any(b1) ? 1u : 0u) | (__any(b2) ? 2u : 0u) | (__any(b4) ? 4u : 0u);
            if (bits && F.lane == 0) atomicOr(F.ctl + CW_DBG, bits); }
#else
        scan_bf16(F, WS_HM, (size_t)T * D, code); scan_bf16(F, WS_ZS, (size_t)1536 * 4096, code);
#endif
        } break;
    case 4: scan_bf16(F, WS_HM, (size_t)T * D, code); break;
    case 5: scan_f32p(F, F.out, (size_t)T * D, code); break;
    case 6: scan_bf16(F, WS_HM, (size_t)T * D, code); break;
    case 7: scan_bf16(F, WS_SORTA, (size_t)MAXROWS * D, code); break;
    case 8: scan_bf16(F, WS_HID, (size_t)MAXROWS * 256, code); break;
    case 9: scan_bf16(F, WS_YS, (size_t)2 * T * D, code); break;
    }
}
#endif
struct Args { const void* in[31]; float* out; unsigned char* ws; int ph_lo, ph_hi; };
constexpr int N_PHASES = 2 + 10 * NL + (DBG_MODE ? 1 : 0);

__global__ void __launch_bounds__(NTHR, 2) hybrid_fwd(Args args) {
    extern __shared__ __attribute__((aligned(16))) unsigned char lds_raw[];
    Frame F;
    F.lds = (LAS unsigned char*)lds_raw;
    F.MISC = (volatile LAS unsigned*)(F.lds + MISC_OFF);
    F.tid = threadIdx.x; F.lane = F.tid & 63; F.wave = __builtin_amdgcn_readfirstlane(F.tid >> 6);
    F.G = gridDim.x; F.bid = blockIdx.x;
    F.ws = (unsigned char*)(GAS unsigned char*)args.ws; F.out = (float*)(GAS float*)args.out; F.ctl = (unsigned*)(GAS unsigned*)(args.ws + WS_CTL);
    for (int u = F.tid; u < (LDS_BYTES - RING_BYTES) / 4; u += NTHR) ((LAS unsigned*)(F.lds + RING_BYTES))[u] = 0u;
    __syncthreads();
    if (F.tid < 31) *(LAS unsigned long long*)(F.lds + IN_OFF + 8 * F.tid) = (unsigned long long)args.in[F.tid];
    __syncthreads();
#if MK_PER_PHASE
#define GRID_BAR() do { } while (0)
#else
    XcdBarrier bar = xcd_barrier_post(F.ctl + CW_BAR, F.MISC + 8);
#define GRID_BAR() do { LAUNDER(F); xcd_barrier(bar, F.tid); } while (0)
#endif
    const int lo = args.ph_lo, hi = args.ph_hi;
    for (int ph_ = lo; ph_ < hi; ++ph_) {
        int ph = ph_; asm volatile("" : "+s"(ph));
#if DBG_MODE == 2
        if (ph > 0) { LAUNDER(F); dbg_check(F, ph - 1); }
#endif
#if DBG_MODE == 4
        if (blockIdx.x == 0) { const unsigned tnow = (unsigned)__builtin_amdgcn_s_memrealtime(); __hip_atomic_store((unsigned*)(args.ws + WS_CTL) + 3200 + ph_, tnow, RLX_AGENT); }
#endif
        for (int rep = 0; rep < ((REPEAT_PH >= 0 && ph_ == REPEAT_PH) ? 2 : 1); ++rep) {
        if (rep) GRID_BAR();
        if (ph == 0) { if (PH_EN(10)) { LAUNDER(F); phase_pro(F); LAUNDER(F); phase_a(F, 0, false, true); } }
#if DBG_MODE
        else if (ph == N_PHASES - 1) { LAUNDER(F);
#if DBG_MODE == 4
            const float dv = 100.f * floorf(4.f * log2f((float)(unsigned)(ld_ctl((const int*)(F.ctl + 3200 + DBG_TPH1)) - ld_ctl((const int*)(F.ctl + 3200 + DBG_TPH0)))) + DBG_QOFF);
            const float dv2 = 10000.f * floorf(4.f * log2f((float)(unsigned)(ld_ctl((const int*)(F.ctl + 3200 + DBG_TPH3)) - ld_ctl((const int*)(F.ctl + 3200 + DBG_TPH2)))) + DBG_QOFF);
            for (int i = F.bid * NTHR + F.tid; i < T * D; i += F.G * NTHR) F.out[i] = (i == 0) ? dv2 : dv;
            if (0)
#else
            const float dv = sqrtf((float)ld_ctl((const int*)(F.ctl + CW_DBG)));
#endif
            for (int i = F.bid * NTHR + F.tid; i < T * D; i += F.G * NTHR) F.out[i] = dv; }
        else if (ph == N_PHASES - 2) { if (PH_EN(11)) { LAUNDER(F); norm_rows(F, 0, true); } }
#else
        else if (ph == N_PHASES - 1) { if (PH_EN(11)) { LAUNDER(F); norm_rows(F, 0, true); } }
#endif
        else {
            const int layer = (ph - 1) / 10, sub = (ph - 1) % 10;
            switch (sub) {
            case 0: if (PH_EN(0)) { LAUNDER(F); phase_a(F, layer, true, layer > 0); } break;
            case 1: if (PH_EN(1)) { LAUNDER(F); pg8::Gemm g{(const bf16_t*)(F.ws + WS_HM), (const bf16_t*)(F.ws + WS_WIN), T, NPAD, D}; pg8::StaticOrder S; S.init(T, NPAD, F.G, F.bid, NPAD / 256 - 1);
                      EpiInProj E{(bf16_t*)(F.ws + WS_NQ), (bf16_t*)(F.ws + WS_KV6), (bf16_t*)(F.ws + WS_MQKV), (bf16_t*)(F.ws + WS_RFEAT), (float*)(F.ws + WS_GATE), (const float*)(F.ws + WS_COS), (const float*)(F.ws + WS_SIN)};
                      if (rep == 0) pg8::gemm_phase<EpiInProj, pg8::StaticOrder, true, true>(F.lds, g, S, E, F.tid);
                      else { EpiNull EN{(float*)(F.ws + WS_GATE)}; pg8::gemm_phase<EpiNull, pg8::StaticOrder, true, true>(F.lds, g, S, EN, F.tid); } } break;
            case 2: if (PH_EN(2)) { LAUNDER(F); phase_c(F, layer); LAUNDER(F); phase_d(F, layer, rep); } break;
            case 3: break;
            case 4: if (PH_EN(4)) { LAUNDER(F); phase_e(F, layer); } break;
            case 5: if (PH_EN(5)) { LAUNDER(F); pg8::Gemm g{(const bf16_t*)(F.ws + WS_HM), (const bf16_t*)(F.ws + WS_WOUT), T, D, D}; pg8::StaticOrder S; S.init(T, D, F.G, F.bid);
                      const float* g1p = (const float*)(F.ws + WS_MOD) + (size_t)layer * BATCH * 6144 + 2048;
                      if (layer == 0) { EpiOutProjT<true> E{INF(F, I_X), (const bf16_t*)F.out, (bf16_t*)(F.ws + WS_RES), g1p}; pg8::gemm_phase<EpiOutProjT<true>, pg8::StaticOrder, true, true>(F.lds, g, S, E, F.tid); }
                      else { EpiOutProjT<false> E{(const float*)nullptr, (const bf16_t*)F.out, (bf16_t*)(F.ws + WS_RES), g1p}; pg8::gemm_phase<EpiOutProjT<false>, pg8::StaticOrder, true, true>(F.lds, g, S, E, F.tid); } } break;
            case 6: if (PH_EN(6)) { LAUNDER(F); phase_g1(F, layer); } break;
            case 7: break;
            case 8: if (PH_EN(8)) { LAUNDER(F); const int* rowinfo = (const int*)(F.ws + WS_ROWINFO + layer * ROWINFO_LSTRIDE); const int* tile_e = rowinfo + 2 * MAXROWS;
                      const int ntl = __builtin_amdgcn_readfirstlane(ld_ctl(tile_e + 256));
                      pg8::Gemm g{(const bf16_t*)(F.ws + WS_HM), (const bf16_t*)(F.ws + WS_WUP), MAXROWS, 512, D};
                      MoeGatherOrder S{ntl, 2, F.G, F.bid, tile_e, (size_t)512 * D * 2, (const int*)(F.ws + WS_ELIST)};
                      EpiMoeUp E{(bf16_t*)(F.ws + WS_HID)};
                      pg8::gemm_phase<EpiMoeUp, MoeGatherOrder, true, true>(F.lds, g, S, E, F.tid); } break;
            case 9: if (PH_EN(9)) { LAUNDER(F); const int* rowinfo = (const int*)(F.ws + WS_ROWINFO + layer * ROWINFO_LSTRIDE); const int* tile_e = rowinfo + 2 * MAXROWS;
                      const int ntl = __builtin_amdgcn_readfirstlane(ld_ctl(tile_e + 256));
                      pg8::Gemm g{(const bf16_t*)(F.ws + WS_HID), (const bf16_t*)(F.ws + WS_WDN), MAXROWS, D, 256};
                      MoeOrder S{ntl, 4, F.G, F.bid, tile_e, (size_t)D * 256 * 2, (const int*)(F.ws + WS_ELIST)};
                      EpiMoeDown E{(bf16_t*)(F.ws + WS_YS), tile_e, (const int*)(F.ws + WS_ELIST), (const float*)(F.ws + WS_EWW)};
                      pg8::gemm_phase<EpiMoeDown, MoeOrder, true, true>(F.lds, g, S, E, F.tid); } break;
            }
        }
        }
#if EXTRA_BAR
        if (ph_ == 0) { for (int eb = 0; eb < EXTRA_BAR; ++eb) GRID_BAR(); }
#endif
        if (ph_ + 1 < hi && !(ph_ >= 1 && ph_ <= 10 * NL && (((ph_ - 1) % 10) == 2 || ((ph_ - 1) % 10) == 3 || ((ph_ - 1) % 10) == 7))) GRID_BAR();
    }
}

extern "C" void kernel_launch(void* const* d_in, const int* in_sizes, int n_in, void* d_out, int out_size, void* d_ws, size_t ws_size, hipStream_t stream) {
    static int grid = 0;
    if (grid == 0) {
        if (n_in != 31 || out_size != T * D || ws_size < WS_END) { fprintf(stderr, "kernel_launch: unexpected shapes: n_in %d out %d ws %zu (need %zu)\n", n_in, out_size, ws_size, (size_t)WS_END); grid = -1; return; }
        int dev = 0, cus = 0, per_cu = 0;
        if (hipGetDevice(&dev) != hipSuccess || hipDeviceGetAttribute(&cus, hipDeviceAttributeMultiprocessorCount, dev) != hipSuccess) { grid = -1; return; }
        if (hipFuncSetAttribute((const void*)hybrid_fwd, hipFuncAttributeMaxDynamicSharedMemorySize, LDS_BYTES) != hipSuccess) { fprintf(stderr, "kernel_launch: hipFuncSetAttribute failed\n"); grid = -1; return; }
        if (hipOccupancyMaxActiveBlocksPerMultiprocessor(&per_cu, (const void*)hybrid_fwd, NTHR, LDS_BYTES) != hipSuccess || per_cu < 1) fprintf(stderr, "kernel_launch: occupancy query says %d\n", per_cu);
        (void)hipGetLastError();
        grid = cus;
    }
    if (grid < 0) return;
    (void)hipMemsetAsync((char*)d_ws + WS_CTL, 0, CTL_ZERO_BYTES, stream);
    Args a{};
    for (int i = 0; i < 31; ++i) a.in[i] = d_in[i];
    a.out = (float*)d_out; a.ws = (unsigned char*)d_ws;
#if MK_PER_PHASE
    for (int ph = 0; ph < N_PHASES; ++ph) { a.ph_lo = ph; a.ph_hi = ph + 1; hipLaunchKernelGGL(hybrid_fwd, dim3(grid), dim3(NTHR), LDS_BYTES, stream, a); }
#else
    a.ph_lo = 0; a.ph_hi = N_PHASES;
    hipLaunchKernelGGL(hybrid_fwd, dim3(grid), dim3(NTHR), LDS_BYTES, stream, a);
#endif
}
```

```cpp
#include <hip/hip_runtime.h>
#include <cstdio>
#include <cstdint>
#include <cmath>
#ifndef PH_MASK
#define PH_MASK 0xfff
#endif
#define PH_EN(k) ((PH_MASK >> (k)) & 1)
#ifndef MK_PER_PHASE
#define MK_PER_PHASE 0
#endif
namespace pg8 {
#define PG8_LAS __attribute__((address_space(3)))
typedef unsigned short bf16_t;
typedef short bf16x8 __attribute__((ext_vector_type(8)));
typedef float f32x4 __attribute__((ext_vector_type(4)));
typedef unsigned u32x4 __attribute__((ext_vector_type(4)));
constexpr int BM = 256, BK = 64, HALF = 128, HTB = HALF * BK * 2  , STAGE_BYTES = 8 * HTB, NXCD = 8, WGM = 8;

__host__ __device__ __forceinline__ int lds_byte(int r, int c) { const int st = (r >> 4) * 2 + (c >> 5), rr = r & 15, cc = c & 31, ob = rr * 64 + cc * 2; return st * 1024 + (ob ^ (((ob >> 9) & 1) << 5)); }
__host__ __device__ __forceinline__ void stage_rc(int b, int& R, int& C) { const int st = b / 1024, sb = b % 1024, swz = sb ^ (((sb >> 9) & 1) << 5); R = (st >> 1) * 16 + swz / 64; C = (st & 1) * 32 + (swz % 64) / 2; }
__host__ __device__ __forceinline__ int perm32(int rho) { const int n = rho >> 4, i = rho & 15; return 8 * (i >> 2) + 4 * n + (i & 3); }

struct Unit { int pm, pn, mask; };
struct Gemm { const bf16_t* A; const bf16_t* Bt; int M, N, K; };

__host__ __device__ __forceinline__ bool tail_split(int i, int G, int c, int total, int& L, int& f, int& sub) {
    const int rounds = total / G, nfull = rounds * G, ntail = total - nfull; f = 1; sub = 0;
    if (i < rounds) { L = i * G + c; return true; }
    if (i > rounds || ntail == 0) return false;
    f = (4 * ntail <= G) ? 4 : (2 * ntail <= G) ? 2 : 1;
    if (c >= ntail * f) return false;
    L = nfull + c / f; sub = c % f; return true;
}
struct StaticOrder {
    int nM, nN, nwg, G, c, padpn;
    __host__ __device__ void init(int M, int N, int G_, int c_, int padpn_ = -1) { nM = M / BM; nN = N / BM; nwg = nM * nN; G = G_; c = c_; padpn = padpn_; }
    __host__ __device__ bool next(int i, Unit& u) const {
        int L, f, sub; if (!tail_split(i, G, c, nwg, L, f, sub)) return false;
        int wgid = L; { const int q = nwg / NXCD, r = nwg % NXCD, xcd = wgid % NXCD, off = wgid / NXCD; wgid = (xcd < r ? xcd * (q + 1) : r * (q + 1) + (xcd - r) * q) + off; }
        const int nig = WGM * nN, gid = wgid / nig, fm = gid * WGM, gsz = (nM - fm) < WGM ? (nM - fm) : WGM;
        u.pm = fm + ((wgid % nig) % gsz); u.pn = (wgid % nig) / gsz;
        const bool pad = (u.pn == padpn);
        u.mask = (f == 1) ? (pad ? 0x5 : 0xF) : (f == 2) ? (pad ? (sub ? 0x4 : 0x1) : (sub ? 0xA : 0x5)) : ((1 << sub) & (pad ? 0x5 : 0xF));
        return true;
    }
    static constexpr bool GATHER = false;
    __device__ __forceinline__ void arows(const Unit&, const int (&)[2], int (&o)[2][2]) const { o[0][0] = o[0][1] = o[1][0] = o[1][1] = 0; }
    __device__ __forceinline__ void a_ready(const Unit&) const {}
    __device__ __forceinline__ size_t boff(const Unit&) const { return 0; }
    __device__ __forceinline__ void done(const Unit&) const {}
};

template <class Epi, class Sched, bool ALIGN_EPI = false, bool SP2 = false>
__device__ __forceinline__ void gemm_phase(PG8_LAS unsigned char* lds, const Gemm g, const Sched& S, const Epi& E, const int tid_in) {
    const int tid = tid_in, wid = __builtin_amdgcn_readfirstlane(tid >> 6), lane = tid & 63, wr = wid >> 2, wc = wid & 3, fr = lane & 15, fq = lane >> 4;
    const int K = g.K, nt = K / BK;
    unsigned voffA[2], voffB[2];
    int RA[2], CA[2];
    unsigned gA_cur[2][2], gA_nxt[2][2];
    static_assert(!Sched::GATHER || SP2, "row-gathered A is wired into the SP2 loop only");
#pragma unroll
    for (int i = 0; i < 2; ++i) { int R, C; stage_rc(tid * 16 + i * 8192, R, C); const int Rb = Epi::PERM ? ((R & ~31) + perm32(R & 31)) : R;
        voffA[i] = (unsigned)(R * K + C) * 2u; voffB[i] = (unsigned)(Rb * K + C) * 2u; RA[i] = R; CA[i] = C; }
#define PG8_GROWS(u, o) do { int ar_[2][2]; S.arows(u, RA, ar_); _Pragma("unroll") for (int h_ = 0; h_ < 2; ++h_) _Pragma("unroll") for (int i_ = 0; i_ < 2; ++i_) o[h_][i_] = (unsigned)(ar_[h_][i_] * K + CA[i_]) * 2u; } while (0)
    const size_t kstep = (size_t)(BK * 2);
    const size_t hstep = (size_t)HALF * K * 2;
    const size_t tstep = 2 * hstep;
    const unsigned ldsw = (unsigned)wid * 1024u;
    const int aoff = lds_byte(wr * 64 + fr, fq * 8), boff = lds_byte(wc * 32 + fr, fq * 8);
#define PG8_SA(b, h) (((b) * 2 + (h)) * HTB)
#define PG8_SB(b, h) ((4 + (b) * 2 + (h)) * HTB)
#define PG8_STAGE(bufoff, gbase, voff) do { _Pragma("unroll") for (int _i = 0; _i < 2; ++_i) \
        __builtin_amdgcn_global_load_lds((const unsigned*)((const char*)(gbase) + (voff)[_i]), (PG8_LAS unsigned*)(lds + (bufoff) + ldsw + _i * 8192), 16, 0, 0); } while (0)
#define PG8_STAGE_A(bufoff, gbase, half, nx) do { if constexpr (Sched::GATHER) { _Pragma("unroll") for (int _i = 0; _i < 2; ++_i) { const unsigned vo_ = (nx) ? gA_nxt[half][_i] : gA_cur[half][_i]; \
        __builtin_amdgcn_global_load_lds((const unsigned*)((const char*)(gbase) + vo_), (PG8_LAS unsigned*)(lds + (bufoff) + ldsw + _i * 8192), 16, 0, 0); } } else { PG8_STAGE(bufoff, (gbase) + (half) * hstep, voffA); } } while (0)
#define PG8_LDA(dst, b, h) do { _Pragma("unroll") for (int m = 0; m < 4; ++m) _Pragma("unroll") for (int k = 0; k < 2; ++k) dst[m][k] = *(const PG8_LAS bf16x8*)(lds + PG8_SA(b, h) + aoff + m * 2048 + k * 1024); } while (0)
#define PG8_LDB(dst, b, h) do { _Pragma("unroll") for (int n = 0; n < 2; ++n) _Pragma("unroll") for (int k = 0; k < 2; ++k) dst[n][k] = *(const PG8_LAS bf16x8*)(lds + PG8_SB(b, h) + boff + n * 2048 + k * 1024); } while (0)
#define PG8_MMA(ai, bj, At, Bt) do { if (cmask & (1 << ((ai) * 2 + (bj)))) PG8_MMA_(ai, bj, At, Bt); } while (0)
#define PG8_MMA_(ai, bj, At, Bt) do { __builtin_amdgcn_s_setprio(1); _Pragma("unroll") for (int m = 0; m < 4; ++m) _Pragma("unroll") for (int n = 0; n < 2; ++n) _Pragma("unroll") for (int k = 0; k < 2; ++k) \
        acc[ai][bj][m][n] = __builtin_amdgcn_mfma_f32_16x16x32_bf16(Bt[n][k], At[m][k], acc[ai][bj][m][n], 0, 0, 0); __builtin_amdgcn_s_setprio(0); } while (0)
#define PG8_WAIT_V(n) asm volatile("s_waitcnt vmcnt(" #n ")" ::: "memory")
#define PG8_WAIT_L(n) asm volatile("s_waitcnt lgkmcnt(" #n ")" ::: "memory")
#define PG8_BAR __builtin_amdgcn_s_barrier()
#define PG8_SCHED __builtin_amdgcn_sched_barrier(0)
    Unit cur, nxt; int ui = 0;
    if (!S.next(0, cur)) return;
    f32x4 acc[2][2][4][2];
#pragma unroll
    for (int a = 0; a < 2; ++a)
#pragma unroll
        for (int b = 0; b < 2; ++b)
#pragma unroll
            for (int m = 0; m < 4; ++m)
#pragma unroll
                for (int n = 0; n < 2; ++n) acc[a][b][m][n] = (f32x4){0.f, 0.f, 0.f, 0.f};
    bf16x8 At[4][2], B0[2][2], B1[2][2];
    const char* cA = (const char*)g.A + (Sched::GATHER ? (size_t)0 : (size_t)cur.pm * tstep); const char* cB = (const char*)g.Bt + S.boff(cur) + (size_t)cur.pn * tstep;
    S.a_ready(cur);
    if constexpr (Sched::GATHER) { PG8_GROWS(cur, gA_cur); }
    if constexpr (SP2) {
        PG8_STAGE(PG8_SB(0, 0), cB, voffB); PG8_STAGE(PG8_SB(0, 1), cB + hstep, voffB); PG8_STAGE_A(PG8_SA(0, 0), cA, 0, false); PG8_STAGE_A(PG8_SA(0, 1), cA, 1, false);
        if (wr == 1) PG8_BAR;
        PG8_WAIT_V(2); PG8_BAR;
        PG8_STAGE(PG8_SB(1, 0), cB + kstep, voffB); PG8_STAGE_A(PG8_SA(1, 0), cA + kstep, 0, false); PG8_STAGE(PG8_SB(1, 1), cB + hstep + kstep, voffB);
        PG8_WAIT_V(6); PG8_BAR;
    } else {
        PG8_STAGE(PG8_SB(0, 0), cB, voffB); PG8_STAGE(PG8_SA(0, 0), cA, voffA); PG8_STAGE(PG8_SB(0, 1), cB + hstep, voffB); PG8_STAGE(PG8_SA(0, 1), cA + hstep, voffA);
        if (wr == 1) PG8_BAR;
        PG8_WAIT_V(4); PG8_BAR;
        PG8_STAGE(PG8_SB(1, 0), cB + kstep, voffB); PG8_STAGE(PG8_SA(1, 0), cA + kstep, voffA); PG8_STAGE(PG8_SB(1, 1), cB + hstep + kstep, voffB);
        PG8_WAIT_V(6); PG8_BAR;
    }
    for (;;) {
        const int cmask = __builtin_amdgcn_readfirstlane(cur.mask);
        const bool has_next = S.next(ui + 1, nxt);
        const char* nA = has_next ? (const char*)g.A + (Sched::GATHER ? (size_t)0 : (size_t)nxt.pm * tstep) : cA; const char* nB = has_next ? (const char*)g.Bt + S.boff(nxt) + (size_t)nxt.pn * tstep : cB;
        if constexpr (Sched::GATHER) { if (has_next) { PG8_GROWS(nxt, gA_nxt); } }
        for (int t = 0; t < nt; t += 2) {
            const bool last = (t == nt - 2);
            const char* a1 = cA + (size_t)(t + 1) * kstep;
            const char* a2 = last ? nA : cA + (size_t)(t + 2) * kstep; const char* b2 = last ? nB : cB + (size_t)(t + 2) * kstep;
            const char* a3 = a2 + kstep; const char* b3 = b2 + kstep;
            if (last && has_next) S.a_ready(nxt);
            const bool usen = last && has_next;
            if constexpr (SP2) {
            PG8_LDB(B0, 0, 0); PG8_LDB(B1, 0, 1); PG8_SCHED; PG8_LDA(At, 0, 0); PG8_STAGE_A(PG8_SA(1, 1), a1, 1, false);
            PG8_WAIT_V(8); PG8_WAIT_L(0); PG8_BAR; PG8_MMA(0, 0, At, B0); PG8_MMA(0, 1, At, B1); PG8_BAR; PG8_SCHED;
            PG8_LDA(At, 0, 1); PG8_STAGE(PG8_SB(0, 0), b2, voffB); PG8_STAGE(PG8_SB(0, 1), b2 + hstep, voffB); PG8_STAGE_A(PG8_SA(0, 0), a2, 0, usen);
            PG8_WAIT_V(8); PG8_WAIT_L(0); PG8_BAR; PG8_MMA(1, 0, At, B0); PG8_MMA(1, 1, At, B1); PG8_BAR; PG8_SCHED;
            PG8_LDB(B0, 1, 0); PG8_LDB(B1, 1, 1); PG8_SCHED; PG8_LDA(At, 1, 0); PG8_STAGE_A(PG8_SA(0, 1), a2, 1, usen);
            PG8_WAIT_V(8); PG8_WAIT_L(0); PG8_BAR; PG8_MMA(0, 0, At, B0); PG8_MMA(0, 1, At, B1); PG8_BAR; PG8_SCHED;
            PG8_LDA(At, 1, 1); PG8_STAGE(PG8_SB(1, 0), b3, voffB); PG8_STAGE(PG8_SB(1, 1), b3 + hstep, voffB); PG8_STAGE_A(PG8_SA(1, 0), a3, 0, usen);
            PG8_WAIT_V(8); PG8_WAIT_L(0); PG8_BAR; PG8_MMA(1, 0, At, B0); PG8_MMA(1, 1, At, B1); PG8_BAR; PG8_SCHED;
            } else {
            PG8_LDB(B0, 0, 0); PG8_SCHED; PG8_LDA(At, 0, 0); PG8_STAGE(PG8_SA(1, 1), a1 + hstep, voffA);
            PG8_WAIT_L(8); PG8_BAR; PG8_WAIT_L(0); PG8_MMA(0, 0, At, B0); PG8_BAR; PG8_SCHED;
            PG8_LDB(B1, 0, 1); PG8_STAGE(PG8_SB(0, 0), b2, voffB);
            PG8_BAR; PG8_WAIT_L(0); PG8_MMA(0, 1, At, B1); PG8_BAR;
            PG8_LDA(At, 0, 1); PG8_STAGE(PG8_SA(0, 0), a2, voffA);
            PG8_BAR; PG8_WAIT_L(0); PG8_MMA(1, 0, At, B0); PG8_BAR; PG8_SCHED;
            PG8_STAGE(PG8_SB(0, 1), b2 + hstep, voffB);
            PG8_WAIT_V(6); PG8_BAR; PG8_MMA(1, 1, At, B1); PG8_BAR;
            PG8_LDB(B0, 1, 0); PG8_SCHED; PG8_LDA(At, 1, 0); PG8_STAGE(PG8_SA(0, 1), a2 + hstep, voffA);
            PG8_WAIT_L(8); PG8_BAR; PG8_WAIT_L(0); PG8_MMA(0, 0, At, B0); PG8_BAR; PG8_SCHED;
            PG8_LDB(B1, 1, 1); PG8_STAGE(PG8_SB(1, 0), b3, voffB);
            PG8_BAR; PG8_WAIT_L(0); PG8_MMA(0, 1, At, B1); PG8_BAR;
            PG8_LDA(At, 1, 1); PG8_STAGE(PG8_SA(1, 0), a3, voffA);
            PG8_BAR; PG8_WAIT_L(0); PG8_MMA(1, 0, At, B0); PG8_BAR; PG8_SCHED;
            PG8_STAGE(PG8_SB(1, 1), b3 + hstep, voffB);
            PG8_WAIT_V(6); PG8_BAR; PG8_MMA(1, 1, At, B1); PG8_BAR;
            }
        }
        if constexpr (ALIGN_EPI) { if (wr == 0) PG8_BAR; }
        if constexpr (!Epi::AFTER_DRAIN) { E(acc, cur, wr, wc, 0, 0); S.done(cur); }
        if (!has_next) break;
#pragma unroll
        for (int a = 0; a < 2; ++a)
#pragma unroll
            for (int b = 0; b < 2; ++b)
#pragma unroll
                for (int m = 0; m < 4; ++m)
#pragma unroll
                    for (int n = 0; n < 2; ++n) acc[a][b][m][n] = (f32x4){0.f, 0.f, 0.f, 0.f};
        cur = nxt; cA = nA; cB = nB; ++ui;
        if constexpr (Sched::GATHER) {
#pragma unroll
            for (int h_ = 0; h_ < 2; ++h_)
#pragma unroll
                for (int i_ = 0; i_ < 2; ++i_) gA_cur[h_][i_] = gA_nxt[h_][i_]; }
        if constexpr (ALIGN_EPI) { if (wr == 1) PG8_BAR; }
    }
    PG8_WAIT_V(0);
    if constexpr (!ALIGN_EPI) { if (wr == 0) PG8_BAR; }
    PG8_BAR;
    if constexpr (Epi::AFTER_DRAIN) { E.fused(acc, cur, wr, wc, fr, fq, lds, wid, lane); S.done(cur); }
#undef PG8_SA
#undef PG8_SB
#undef PG8_STAGE
#undef PG8_STAGE_A
#undef PG8_GROWS
#undef PG8_LDA
#undef PG8_LDB
#undef PG8_MMA
#undef PG8_MMA_
#undef PG8_WAIT_V
#undef PG8_WAIT_L
#undef PG8_BAR
#undef PG8_SCHED
}
}

constexpr int BATCH = 2, SEQ = 8192, T = BATCH * SEQ, D = 1024, NL = 2;
constexpr int NPAD = 3584, RW = 1408, INCOLS = 3346;
constexpr int NWAVES = 8, NTHR = 512;
constexpr float LOG2E = 1.4426950408889634f;
constexpr float NORM_EPS = 1e-6f;

#define GAS __attribute__((address_space(1)))
#define LAS __attribute__((address_space(3)))
typedef unsigned short bf16_t;
typedef short bf16x8 __attribute__((ext_vector_type(8)));
typedef short s16x4 __attribute__((ext_vector_type(4)));
typedef short v4i16_t __attribute__((ext_vector_type(4)));
typedef float f32x4 __attribute__((ext_vector_type(4)));
typedef float f32x16 __attribute__((ext_vector_type(16)));
typedef unsigned u32x4 __attribute__((ext_vector_type(4)));
typedef unsigned u32x2 __attribute__((ext_vector_type(2)));
typedef GAS unsigned gu32;

constexpr size_t MiB = 1u << 20, KiB = 1u << 10;
constexpr size_t WS_CTL = 0, CTL_ZERO_BYTES = 64 * KiB;
constexpr size_t WS_COS = 1 * MiB, WS_SIN = 3 * MiB;
constexpr size_t WS_MOD = 5 * MiB;
constexpr size_t WS_PHIB = WS_MOD + 128 * KiB;
constexpr size_t WS_KMEAN = WS_MOD + 192 * KiB;
constexpr size_t WS_KCMP = WS_MOD + 256 * KiB;
constexpr size_t WS_VCMP = WS_KCMP + 256 * KiB;
constexpr size_t WS_BONUS = 6 * MiB;
constexpr size_t WS_GATE = 7 * MiB;
constexpr size_t WS_ROUTE = 9 * MiB;
constexpr size_t WS_ROWINFO = 10 * MiB;
constexpr size_t ROWINFO_LSTRIDE = 512 * KiB;
constexpr int MAXROWS = 36864;
constexpr size_t WS_RES = 78 * MiB;
constexpr size_t WS_ELIST = 9 * MiB;
constexpr size_t WS_EWW = 11 * MiB;
constexpr int TE_OFF = 272, TE_CNT = 304, TE_TBASE = 320, TE_TCNT = 640;
constexpr size_t WS_WIN = 12 * MiB;
constexpr size_t WS_WOUT = 19 * MiB;
constexpr size_t WS_WUP = 21 * MiB;
constexpr size_t WS_WDN = 37 * MiB;
constexpr size_t WS_PHIW = 45 * MiB;
constexpr size_t WS_GUPT = 45 * MiB + 512 * KiB;
constexpr size_t WS_WUPT = 45 * MiB + 640 * KiB;
constexpr size_t WS_AUPT = 45 * MiB + 704 * KiB;
constexpr size_t WS_LORA = 46 * MiB;
constexpr size_t WS_HM = 46 * MiB;
constexpr size_t WS_NQ = 78 * MiB;
constexpr size_t WS_KV6 = 90 * MiB;
constexpr size_t KV6_STRIDE = (size_t)BATCH * 2 * SEQ * 64;
constexpr size_t WS_MQKV = 114 * MiB;
constexpr size_t MQKV_STRIDE = (size_t)BATCH * 4 * SEQ * 64;
constexpr size_t WS_RFEAT = 138 * MiB;
constexpr size_t WS_SORTA = 78 * MiB;
constexpr size_t WS_HID = 150 * MiB;
constexpr size_t WS_PT = 182 * MiB;
constexpr size_t WS_ZS = 194 * MiB;
constexpr size_t WS_YT = 206 * MiB;
constexpr size_t WS_Y0 = 218 * MiB;
constexpr size_t WS_YS = 182 * MiB;
constexpr size_t WS_SS = 230 * MiB;
constexpr size_t WS_END = 256 * MiB;
constexpr int CW_Q = 64;
constexpr int CW_CNT = 1024;
constexpr int CW_BAR = 4096;
constexpr int CW_DBG = 3072;
#ifndef DBG_MODE
#define DBG_MODE 0
#endif
#ifndef EXTRA_BAR
#define EXTRA_BAR 0
#endif
#ifndef REPEAT_PH
#define REPEAT_PH -1
#endif
#ifndef DBG_TPH0
#define DBG_TPH0 0
#endif
#ifndef DBG_TPH1
#define DBG_TPH1 1
#endif
#ifndef DBG_QOFF
#define DBG_QOFF 0.0f
#endif
#ifndef DBG_TPH2
#define DBG_TPH2 0
#endif
#ifndef DBG_TPH3
#define DBG_TPH3 1
#endif
#ifndef DBG_SUB
#define DBG_SUB 4
#endif
#ifndef DBG_P
#define DBG_P 4
#endif
#ifndef DBG_CNT
#define DBG_CNT 1
#endif

#define RLX_AGENT __ATOMIC_RELAXED, __HIP_MEMORY_SCOPE_AGENT
#define LDS_WAIT() asm volatile("s_waitcnt lgkmcnt(0)" ::: "memory")
#define VM_WAIT() asm volatile("s_waitcnt vmcnt(0)" ::: "memory")
__device__ __forceinline__ float bf2f(bf16_t h) { return __uint_as_float(((unsigned)h) << 16); }
typedef float f32x2_t __attribute__((ext_vector_type(2)));
typedef __bf16 bf16x2_t __attribute__((ext_vector_type(2)));
__device__ __forceinline__ unsigned pk2(float lo, float hi) { const f32x2_t v = {lo, hi}; return __builtin_bit_cast(unsigned, __builtin_convertvector(v, bf16x2_t)); }
__device__ __forceinline__ bf16_t f2bf(float f) { return (bf16_t)(pk2(f, 0.f) & 0xffffu); }
__device__ __forceinline__ float shx(float v, int mask, int lane) { return __uint_as_float(__builtin_amdgcn_ds_bpermute((lane ^ mask) << 2, __float_as_uint(v))); }
__device__ __forceinline__ int shxi(int v, int mask, int lane) { return __builtin_amdgcn_ds_bpermute((lane ^ mask) << 2, v); }
template <int CTRL> __device__ __forceinline__ float dpp_mov(float v) { return __uint_as_float(__builtin_amdgcn_update_dpp(0u, __float_as_uint(v), CTRL, 0xf, 0xf, true)); }
__device__ __forceinline__ float half_sum32(float v) { const unsigned u = __float_as_uint(v); auto r = __builtin_amdgcn_permlane32_swap(u, u, false, false); return __uint_as_float(r[0]) + __uint_as_float(r[1]); }
__device__ __forceinline__ float row_sum16(float v) { const unsigned u = __float_as_uint(v); auto r = __builtin_amdgcn_permlane16_swap(u, u, false, false); return __uint_as_float(r[0]) + __uint_as_float(r[1]); }
__device__ __forceinline__ float wave_sum(float v, int lane) {
    (void)lane;
    v += dpp_mov<0xB1>(v); v += dpp_mov<0x4E>(v); v += dpp_mov<0x141>(v); v += dpp_mov<0x140>(v);
    return half_sum32(row_sum16(v));
}
__device__ __forceinline__ float tanh_fast(float x) { const float xc = fminf(fmaxf(x, -15.f), 15.f); return 1.f - 2.f * __builtin_amdgcn_rcpf(__builtin_amdgcn_exp2f(xc * (2.f * LOG2E)) + 1.f); }
__device__ __forceinline__ float sigm(float x) { return __builtin_amdgcn_rcpf(1.f + __expf(-x)); }
__device__ __forceinline__ int ld_ctl(const int* p) { return __hip_atomic_load(p, RLX_AGENT); }
__device__ __forceinline__ float ld_ctlf(const float* p) { return __uint_as_float(__hip_atomic_load((const unsigned*)p, RLX_AGENT)); }
#define MFMA16(a, b, c) __builtin_amdgcn_mfma_f32_16x16x32_bf16(a, b, c, 0, 0, 0)
#define MFMA32(a, b, c) __builtin_amdgcn_mfma_f32_32x32x16_bf16(a, b, c, 0, 0, 0)

#define XB_TMO      128
#define XB_XCNT(j)  (256  + 64 * (j))
#define XB_XSUB(j)  (1280 + 64 * (j))
#define XB_XGEN(j)  (2304 + 64 * (j))
#define XB_TOP      3328
#define XB_TOPGEN   3392
#define XCD_BAR_WORDS 3456
#define XB_SPIN_CAP (1u << 22)
__device__ __forceinline__ unsigned xb_ld(unsigned* p)              { return __hip_atomic_load(p, __ATOMIC_RELAXED, __HIP_MEMORY_SCOPE_AGENT); }
__device__ __forceinline__ unsigned xb_add(unsigned* p, unsigned v) { return __hip_atomic_fetch_add(p, v, __ATOMIC_RELAXED, __HIP_MEMORY_SCOPE_AGENT); }
__device__ __forceinline__ unsigned xb_xcc_id() { return (unsigned)__builtin_amdgcn_s_getreg((3 << 11) | 20) & 0xFu; }
#define XB_SPIN(cond, bar) do { unsigned _sp = 0; while (cond) { __builtin_amdgcn_s_sleep(1); \
    if ((++_sp & 255u) == 0u) { if (xb_ld(&(bar)[XB_TMO])) break; if (_sp > XB_SPIN_CAP) { atomicAdd(&(bar)[XB_TMO], 1u); break; } } } } while (0)
struct XcdBarrier { unsigned* bar; unsigned x; volatile LAS unsigned* st; };
__device__ __forceinline__ XcdBarrier xcd_barrier_post(unsigned* bar, volatile LAS unsigned* st) {
    XcdBarrier b; b.bar = bar; b.x = xb_xcc_id(); b.st = st;
    if (threadIdx.x == 0) (void)xb_add(&bar[XB_XCNT(b.x)], 1u);
    return b;
}
__device__ __forceinline__ void xcd_barrier_complete(unsigned* bar, unsigned x, unsigned& nloc, unsigned& nx) {
    const unsigned G = gridDim.x * gridDim.y * gridDim.z;
    unsigned sum, cnt, mine, sp = 0u;
    for (;;) {
        sum = 0u; cnt = 0u; mine = 0u;
#pragma unroll
        for (unsigned j = 0; j < 16; ++j) { const unsigned c = xb_ld(&bar[XB_XCNT(j)]); sum += c; cnt += (c > 0u) ? 1u : 0u; mine = (j == x) ? c : mine; }
        if (sum == G) break;
        __builtin_amdgcn_s_sleep(1);
        if ((++sp & 255u) == 0u) { if (xb_ld(&bar[XB_TMO])) break; if (sp > XB_SPIN_CAP) { atomicAdd(&bar[XB_TMO], 1u); break; } }
    }
    nloc = mine > 0u ? mine : 1u; nx = cnt > 0u ? cnt : 1u;
}
__device__ __forceinline__ void xcd_barrier(const XcdBarrier& b, const int tid) {
    asm volatile("s_waitcnt vmcnt(0)" ::: "memory");
    __syncthreads();
    if (tid == 0) {
        unsigned* bar = b.bar;
        __builtin_amdgcn_s_waitcnt(0);
        unsigned nloc = b.st[0], nx = b.st[1];
        if (nloc == 0u) { xcd_barrier_complete(bar, b.x, nloc, nx); b.st[0] = nloc; b.st[1] = nx; }
        const unsigned old = xb_add(&bar[XB_XSUB(b.x)], 1u);
        const unsigned gen = old / nloc;
        if (old + 1u == (gen + 1u) * nloc) {
            __builtin_amdgcn_fence(__ATOMIC_RELEASE, "agent");
            asm volatile("s_waitcnt vmcnt(0)" ::: "memory");
            const unsigned og = xb_add(&bar[XB_TOP], 1u);
            const unsigned tg = og / nx;
            if (og + 1u == (tg + 1u) * nx) xb_add(&bar[XB_TOPGEN], 1u);
            else XB_SPIN(xb_ld(&bar[XB_TOPGEN]) == tg, bar);
            __builtin_amdgcn_fence(__ATOMIC_ACQUIRE, "agent");
            xb_add(&bar[XB_XGEN(b.x)], 1u);
            asm volatile("s_waitcnt vmcnt(0)" ::: "memory");
        } else {
            XB_SPIN(xb_ld(&bar[XB_XGEN(b.x)]) == gen, bar);
            __builtin_amdgcn_fence(__ATOMIC_ACQUIRE, "agent");
            asm volatile("s_waitcnt vmcnt(0)" ::: "memory");
        }
    }
    __syncthreads();
}

constexpr int RING_BYTES = 131072, MISC_OFF = RING_BYTES + 320, LDS_BYTES = 147456;
struct Frame {
    LAS unsigned char* lds;
    volatile LAS unsigned* MISC;
    unsigned* ctl;
    int tid, lane, wave, G, bid;
    unsigned char* ws;
    float* out;
};
constexpr int IN_OFF = RING_BYTES + 1024;
__device__ __forceinline__ const float* inptr(const LAS unsigned char* lds, int k) {
    int z = 0; asm volatile("" : "+v"(z));
    const LAS unsigned* p = (const LAS unsigned*)(lds + IN_OFF + z) + 2 * k;
    const unsigned lo = __builtin_amdgcn_readfirstlane(p[0]), hi = __builtin_amdgcn_readfirstlane(p[1]);
    return (const float*)(const GAS float*)(((unsigned long long)hi << 32) | lo); }
#define INF(F, k) inptr((F).lds, k)
#define LAUNDER(F) do { GAS unsigned char* w_ = (GAS unsigned char*)(F).ws; GAS float* o_ = (GAS float*)(F).out; int g_ = (F).G, b_ = (F).bid, wv_ = (F).wave, z_ = 0; asm volatile("" : "+s"(w_), "+s"(o_), "+s"(g_), "+s"(b_), "+s"(wv_), "+s"(z_)); \
    int l_ = (int)__builtin_amdgcn_mbcnt_hi(~0u, __builtin_amdgcn_mbcnt_lo(~0u, (unsigned)z_)); asm volatile("" : "+v"(l_)); \
    (F).ws = (unsigned char*)w_; (F).out = (float*)o_; (F).ctl = (unsigned*)(GAS unsigned*)w_; (F).G = g_; (F).bid = b_; (F).wave = wv_; (F).lane = l_; (F).tid = wv_ * 64 + l_; } while (0)
enum { I_X = 0, I_C, I_POS, I_WMOD, I_BMOD, I_NMIX, I_NFFN, I_WIN, I_PHIW1, I_PHIW2, I_PHIPOS, I_MU, I_WUP, I_W0, I_AUP, I_A0, I_GUP, I_KK, I_KA, I_RK, I_LNW, I_LNB,
       I_NNSA, I_NMOBA, I_WOUT, I_WROUTER, I_RBIAS, I_MGATE, I_MUP, I_MDOWN, I_NFINAL };

__device__ const float g_invf[32] = {1.000000000e+00f, 7.498942018e-01f, 5.623413324e-01f, 4.216965139e-01f, 3.162277639e-01f, 2.371373773e-01f, 1.778279394e-01f, 1.333521456e-01f,
    1.000000015e-01f, 7.498942316e-02f, 5.623413250e-02f, 4.216964915e-02f, 3.162277490e-02f, 2.371373773e-02f, 1.778279431e-02f, 1.333521400e-02f, 9.999999776e-03f, 7.498942316e-03f,
    5.623413250e-03f, 4.216964822e-03f, 3.162277630e-03f, 2.371373819e-03f, 1.778279431e-03f, 1.333521446e-03f, 1.000000047e-03f, 7.498941850e-04f, 5.623413017e-04f, 4.216965172e-04f,
    3.162277571e-04f, 2.371373703e-04f, 1.778279402e-04f, 1.333521504e-04f};
__device__ __forceinline__ void phase_pro(Frame& F) {
    const int* pos = (const int*)INF(F, I_POS);
    float* cosT = (float*)(F.ws + WS_COS); float* sinT = (float*)(F.ws + WS_SIN);
    for (int idx = F.bid * NTHR + F.tid; idx < T * 32; idx += F.G * NTHR) {
        const int row = idx >> 5, i = idx & 31;
        const float ang = (float)pos[row] * g_invf[i];
        float sv, cv; sincosf(ang, &sv, &cv);
        cosT[idx] = cv; sinT[idx] = sv;
    }
    LAS float* red = (LAS float*)F.lds;
    for (int chunk = F.bid; chunk < NL * 96; chunk += F.G) {
        const int l = chunk / 96, j0 = (chunk % 96) * 64;
        const float* W = INF(F, I_WMOD) + (size_t)l * D * 6144 + j0 + F.lane;
        const float* c = INF(F, I_C);
        float a0 = 0.f, a1 = 0.f;
        const int k0 = F.wave * 128;
#pragma unroll 32
        for (int k = 0; k < 128; ++k) {
            const float w = W[(size_t)(k0 + k) * 6144];
            const float c0 = c[k0 + k], c1 = c[D + k0 + k];
            a0 += w * (c0 * sigm(c0)); a1 += w * (c1 * sigm(c1));
        }
        red[(F.wave * 2 + 0) * 64 + F.lane] = a0; red[(F.wave * 2 + 1) * 64 + F.lane] = a1;
        __syncthreads();
        if (F.wave < 2) {
            float s = INF(F, I_BMOD)[l * 6144 + j0 + F.lane];
#pragma unroll
            for (int w = 0; w < 8; ++w) s += red[(w * 2 + F.wave) * 64 + F.lane];
            ((float*)(F.ws + WS_MOD))[((size_t)l * BATCH + F.wave) * 6144 + j0 + F.lane] = s;
        }
        __syncthreads();
    }
}

__device__ __forceinline__ void transpose_item(int ldw, int K, bf16_t* WT, int n0, int k0, LAS float* scr, int lane, const float* src) {
    const int n4 = lane & 7, kr = lane >> 3;
#pragma unroll
    for (int i = 0; i < 8; ++i) { const int kk = 8 * i + kr; f32x4 v = (f32x4){0.f, 0.f, 0.f, 0.f};
        if (src) { const float* p = src + (size_t)(k0 + kk) * ldw; v.x = p[0]; v.y = p[1]; v.z = p[2]; v.w = p[3]; }
        scr[kk * 33 + 4 * n4] = v.x; scr[kk * 33 + 4 * n4 + 1] = v.y; scr[kk * 33 + 4 * n4 + 2] = v.z; scr[kk * 33 + 4 * n4 + 3] = v.w; }
    LDS_WAIT(); asm volatile("" ::: "memory");
    const int c = lane & 7;
#pragma unroll
    for (int j = 0; j < 4; ++j) { const int n = (lane >> 3) + 8 * j; const LAS float* sp = scr + (8 * c) * 33 + n;
        u32x4 o; o.x = pk2(sp[0 * 33], sp[1 * 33]); o.y = pk2(sp[2 * 33], sp[3 * 33]); o.z = pk2(sp[4 * 33], sp[5 * 33]); o.w = pk2(sp[6 * 33], sp[7 * 33]);
        *(u32x4*)(WT + (size_t)(n0 + n) * K + k0 + 8 * c) = o; }
    LDS_WAIT(); asm volatile("" ::: "memory");
}
__device__ __forceinline__ const float* cm_in(const float* W, int pos) {
        const int G = pos >> 6, p = pos & 63, w = p >> 5, n = (p >> 4) & 1, q = p & 15, d = 16 * w + q + 32 * n;
        int sc;
        if (G < 6) sc = G * 64 + d; else if (G < 18) sc = 384 + (G - 6) * 64 + d; else if (G < 30) sc = 1170 + (G - 18) * 64 + d;
        else if (G < 52) sc = 1938 + (G - 30) * 64 + d; else if (G == 52 && d < 18) sc = 1152 + d; else return nullptr;
        return W + sc; }
__device__ __forceinline__ const float* cm_up(const float* Wg, const float* Wu, int pos) { const int Wd = pos >> 5, n = (pos >> 4) & 1, q = pos & 15, f = 16 * Wd + q; return (n ? Wu : Wg) + f; }

__device__ __forceinline__ void norm_rows(Frame& F, int layer, bool final_) {
    const float* xin = INF(F, I_X);
    const bf16_t* ys = (const bf16_t*)(F.ws + WS_YS);
    const float* mod = (const float*)(F.ws + WS_MOD);
    bf16_t* H = (bf16_t*)(F.ws + WS_HM);
    const int gw = F.bid * NWAVES + F.wave, NGW = F.G * NWAVES;
    for (int m = gw; m < T; m += NGW) {
        const int b = m >> 13;
        f32x4 v[4]; float ss = 0.f;
        if (layer == 0 && !final_) {
#pragma unroll
            for (int j = 0; j < 4; ++j) v[j] = *(const f32x4*)(xin + (size_t)m * D + 4 * F.lane + 256 * j);
        } else {
            const int pl = final_ ? NL - 1 : layer - 1;
            const float* g2 = mod + ((size_t)pl * BATCH + b) * 6144 + 5120;
#pragma unroll
            for (int j = 0; j < 4; ++j) {
                const int col = 4 * F.lane + 256 * j;
                const u32x2 t2 = *(const u32x2*)((const bf16_t*)(F.ws + WS_RES) + (size_t)m * D + col);
                f32x4 x = (f32x4){__uint_as_float(t2.x << 16), __uint_as_float(t2.x & 0xffff0000u), __uint_as_float(t2.y << 16), __uint_as_float(t2.y & 0xffff0000u)};
                const u32x2 a = *(const u32x2*)(ys + (size_t)m * D + col), c = *(const u32x2*)(ys + (size_t)(T + m) * D + col);
                const f32x4 g = *(const f32x4*)(g2 + col);
                x.x += g.x * (__uint_as_float(a.x << 16) + __uint_as_float(c.x << 16));
                x.y += g.y * (__uint_as_float(a.x & 0xffff0000u) + __uint_as_float(c.x & 0xffff0000u));
                x.z += g.z * (__uint_as_float(a.y << 16) + __uint_as_float(c.y << 16));
                x.w += g.w * (__uint_as_float(a.y & 0xffff0000u) + __uint_as_float(c.y & 0xffff0000u));
                if (!final_) { u32x2 o; o.x = pk2(x.x, x.y); o.y = pk2(x.z, x.w); *(u32x2*)((bf16_t*)F.out + (size_t)m * D + col) = o;
                    x = (f32x4){__uint_as_float(o.x << 16), __uint_as_float(o.x & 0xffff0000u), __uint_as_float(o.y << 16), __uint_as_float(o.y & 0xffff0000u)}; }
                v[j] = x;
            }
        }
#pragma unroll
        for (int j = 0; j < 4; ++j) ss += (v[j].x * v[j].x + v[j].y * v[j].y) + (v[j].z * v[j].z + v[j].w * v[j].w);
        const float rstd = rsqrtf(wave_sum(ss, F.lane) * (1.f / D) + NORM_EPS);
#if DBG_MODE == 1
        if (final_) { float bad = 0.f;
#pragma unroll
            for (int j = 0; j < 4; ++j) { bad += (fabsf(v[j].x) <= 3e38f) ? 0.f : 1.f; bad += (fabsf(v[j].y) <= 3e38f) ? 0.f : 1.f; bad += (fabsf(v[j].z) <= 3e38f) ? 0.f : 1.f; bad += (fabsf(v[j].w) <= 3e38f) ? 0.f : 1.f; }
            bad = wave_sum(bad, F.lane); if (F.lane == 0 && bad > 0.f) atomicAdd(F.ctl + CW_DBG, (unsigned)bad); }
#endif
        if (final_) {
            const float* gn = INF(F, I_NFINAL);
#pragma unroll
            for (int j = 0; j < 4; ++j) { const int col = 4 * F.lane + 256 * j; const f32x4 g = *(const f32x4*)(gn + col);
                f32x4 o; o.x = v[j].x * rstd * g.x; o.y = v[j].y * rstd * g.y; o.z = v[j].z * rstd * g.z; o.w = v[j].w * rstd * g.w;
                *(f32x4*)(F.out + (size_t)m * D + col) = o; }
        } else {
            const float* gn = INF(F, I_NMIX) + layer * D;
            const float* sh = mod + ((size_t)layer * BATCH + b) * 6144; const float* sc = sh + 1024;
#pragma unroll
            for (int j = 0; j < 4; ++j) { const int col = 4 * F.lane + 256 * j;
                const f32x4 g = *(const f32x4*)(gn + col), s1 = *(const f32x4*)(sc + col), s0 = *(const f32x4*)(sh + col);
                u32x2 o; o.x = pk2(v[j].x * rstd * g.x * (1.f + s1.x) + s0.x, v[j].y * rstd * g.y * (1.f + s1.y) + s0.y);
                o.y = pk2(v[j].z * rstd * g.z * (1.f + s1.z) + s0.z, v[j].w * rstd * g.w * (1.f + s1.w) + s0.w);
                *(u32x2*)(H + (size_t)m * D + col) = o; }
        }
    }
}
__device__ __forceinline__ void phase_a(Frame& F, int layer, bool do_norm, bool do_conv) {
    if (do_norm) { norm_rows(F, layer, false); LAUNDER(F); }
    if (!do_conv) return;
    LAS float* scr = (LAS float*)(F.lds + F.wave * 16384);
    const int gw = F.bid * NWAVES + F.wave, NGW = F.G * NWAVES;
    constexpr int I_IN = 16 * 112, I_OUT = 16 * 32, I_UPI = 16 * 16 * 16, I_DN = 16 * 4 * 32, I_PHI = 2 * 32 * 2, I_GU = 2 * 12, I_LR = 2 * 12;
    constexpr int NIT = I_IN + I_OUT + I_UPI + I_DN + I_PHI + I_GU + I_LR;
    for (int it = gw; it < NIT; it += NGW) {
        int r = it;
        const int l31 = 4 * (F.lane & 7);
        if (r < I_IN) { const int kb = r / 112, nb = r % 112;
            transpose_item(INCOLS, D, (bf16_t*)(F.ws + WS_WIN), nb * 32, kb * 64, scr, F.lane, cm_in(INF(F, I_WIN) + (size_t)layer * D * INCOLS, nb * 32 + l31)); continue; } r -= I_IN;
        if (r < I_OUT) { const int kb = r / 32, nb = r % 32;
            transpose_item(D, D, (bf16_t*)(F.ws + WS_WOUT), nb * 32, kb * 64, scr, F.lane, INF(F, I_WOUT) + (size_t)layer * D * D + nb * 32 + l31); continue; } r -= I_OUT;
        if (r < I_UPI) { const int e = r / 256, q = r % 256, kb = q / 16, nb = q % 16;
            transpose_item(256, D, (bf16_t*)(F.ws + WS_WUP) + (size_t)e * 512 * D, nb * 32, kb * 64, scr, F.lane,
                           cm_up(INF(F, I_MGATE) + ((size_t)layer * 16 + e) * D * 256, INF(F, I_MUP) + ((size_t)layer * 16 + e) * D * 256, nb * 32 + l31)); continue; } r -= I_UPI;
        if (r < I_DN) { const int e = r / 128, q = r % 128, kb = q / 32, nb = q % 32;
            transpose_item(D, 256, (bf16_t*)(F.ws + WS_WDN) + (size_t)e * D * 256, nb * 32, kb * 64, scr, F.lane, INF(F, I_MDOWN) + ((size_t)layer * 16 + e) * 256 * D + nb * 32 + l31); continue; } r -= I_DN;
        if (r < I_PHI) { const int kv = r / 64, q = r % 64, kb = q / 2, nb = q % 2;
            transpose_item(64, 2048, (bf16_t*)(F.ws + WS_PHIW) + (size_t)kv * 64 * 2048, nb * 32, kb * 64, scr, F.lane, INF(F, I_PHIW1) + ((size_t)layer * 2 + kv) * 2048 * 64 + nb * 32 + l31); continue; } r -= I_PHI;
        if (r < I_GU) { const int kb = r / 12, nb = r % 12;
            transpose_item(384, 128, (bf16_t*)(F.ws + WS_GUPT), nb * 32, kb * 64, scr, F.lane, INF(F, I_GUP) + (size_t)layer * 128 * 384 + nb * 32 + l31); continue; } r -= I_GU;
        { const int which = r / 12, nb = r % 12;
            transpose_item(384, 64, (bf16_t*)(F.ws + (which ? WS_AUPT : WS_WUPT)), nb * 32, 0, scr, F.lane, INF(F, which ? I_AUP : I_WUP) + (size_t)layer * 64 * 384 + nb * 32 + l31); }
    }
    LAUNDER(F);
    if (F.bid == F.G - 1) {
        __syncthreads();
        LAS float* part = (LAS float*)F.lds;
#pragma unroll 1
        for (int kv = 0; kv < 2; ++kv) {
            const float* w1 = INF(F, I_PHIW1) + ((size_t)layer * 2 + kv) * 2048 * 64 + (size_t)F.wave * 256 * 64; const float* pp = INF(F, I_PHIPOS) + ((size_t)layer * 2 + kv) * 2048 + F.wave * 256;
            float a[4] = {0.f, 0.f, 0.f, 0.f};
#pragma unroll 1
            for (int k = 0; k < 256; k += 16) {
                float wv[16];
#pragma unroll
                for (int u = 0; u < 16; ++u) wv[u] = w1[(size_t)(k + u) * 64 + F.lane];
#pragma unroll
                for (int u = 0; u < 16; ++u) a[u & 3] += pp[k + u] * wv[u];
            }
            part[(F.wave * 2 + kv) * 64 + F.lane] = (a[0] + a[1]) + (a[2] + a[3]);
        }
        __syncthreads();
        if (F.wave < 2) { float sacc = 0.f;
#pragma unroll
            for (int w = 0; w < 8; ++w) sacc += part[(w * 2 + F.wave) * 64 + F.lane];
            ((float*)(F.ws + WS_PHIB))[(layer * 2 + F.wave) * 64 + F.lane] = sacc; }
    }
}

struct EpiInProj {
    static constexpr bool PERM = false, AFTER_DRAIN = false;
    bf16_t* nq; bf16_t* kv6; bf16_t* mqkv; bf16_t* rfeat; float* gate; const float* cosT; const float* sinT;
    __device__ __forceinline__ void operator()(const f32x4 (&acc)[2][2][4][2], const pg8::Unit& u, int wr, int wc, int fr_, int fq_) const {
        int z_ = 0; asm volatile("" : "+s"(z_)); int l_ = (int)__builtin_amdgcn_mbcnt_hi(~0u, __builtin_amdgcn_mbcnt_lo(~0u, (unsigned)z_)); asm volatile("" : "+v"(l_)); const int fr = l_ & 15, fq = l_ >> 4; (void)fr_; (void)fq_;
#pragma unroll
        for (int bj = 0; bj < 2; ++bj) {
            const int G = 4 * u.pn + 2 * bj + (wc >> 1), w = wc & 1;
            if (G >= 53) continue;
            const int qm = u.mask >> bj;
            const int d0 = 16 * w + 4 * fq;
            const bool rope = (G < 6) || (G == 10) || (G == 11) || (G == 14) || (G == 15) || (G >= 18 && G < 26);
            const float scl = (G < 6 || (G >= 18 && G < 22)) ? 0.125f * LOG2E : 1.0f;
#pragma unroll
            for (int ai = 0; ai < 2; ++ai) {
                if (!((qm >> (2 * ai)) & 1)) continue;
#pragma unroll
                for (int m = 0; m < 4; ++m) {
                    const int row = 256 * u.pm + 128 * ai + 64 * wr + 16 * m + fr, b = row >> 13, t = row & (SEQ - 1);
                    f32x4 x1 = acc[ai][bj][m][0], x2 = acc[ai][bj][m][1];
                    if (rope) {
                        const f32x4 c = *(const f32x4*)(cosT + (size_t)row * 32 + d0), s = *(const f32x4*)(sinT + (size_t)row * 32 + d0);
                        const f32x4 y1 = (x1 * c - x2 * s) * scl, y2 = (x2 * c + x1 * s) * scl; x1 = y1; x2 = y2;
                    }
                    if (G == 52) {
                        float* gp = gate + (size_t)row * 32;
                        *(f32x4*)(gp + d0) = x1;
                        continue;
                    }
                    bf16_t* dst;
                    if (G < 6) dst = nq + ((size_t)(b * 6 + G) * SEQ + t) * 64;
                    else if (G < 18) dst = kv6 + (size_t)((G - 6) >> 1) * KV6_STRIDE + ((size_t)(b * 2 + ((G - 6) & 1)) * SEQ + t) * 64;
                    else if (G < 30) dst = mqkv + (size_t)((G - 18) >> 2) * MQKV_STRIDE + ((size_t)(b * 4 + ((G - 18) & 3)) * SEQ + t) * 64;
                    else dst = rfeat + (size_t)row * RW + (G - 30) * 64;
                    auto sx = __builtin_amdgcn_permlane16_swap(pk2(x1.x, x1.y), pk2(x2.x, x2.y), false, false);
                    auto sy = __builtin_amdgcn_permlane16_swap(pk2(x1.z, x1.w), pk2(x2.z, x2.w), false, false);
                    u32x4 o; o.x = sx[0]; o.y = sy[0]; o.z = sx[1]; o.w = sy[1];
                    *(u32x4*)(dst + ((fq & 1) ? d0 - 4 + 32 : d0)) = o;
                }
            }
        }
    }
};
struct EpiNull {
    static constexpr bool PERM = false, AFTER_DRAIN = false;
    float* sink;
    __device__ __forceinline__ void operator()(const f32x4 (&acc)[2][2][4][2], const pg8::Unit& u, int wr, int wc, int fr_, int fq_) const {
        f32x4 s = (f32x4){0.f, 0.f, 0.f, 0.f};
#pragma unroll
        for (int ai = 0; ai < 2; ++ai)
#pragma unroll
            for (int bj = 0; bj < 2; ++bj)
#pragma unroll
                for (int m = 0; m < 4; ++m)
#pragma unroll
                    for (int n = 0; n < 2; ++n) s += acc[ai][bj][m][n];
        if (s.x + s.y + s.z + s.w == 123456.789f) sink[0] = s.x;
    }
};
template <bool F32IN>
struct EpiOutProjT {
    static constexpr bool PERM = false, AFTER_DRAIN = false;
    const float* xold_f; const bf16_t* xold_b; bf16_t* xnew; const float* g1;
    __device__ __forceinline__ void operator()(const f32x4 (&acc)[2][2][4][2], const pg8::Unit& u, int wr, int wc, int fr_, int fq_) const {
        int z_ = 0; asm volatile("" : "+s"(z_)); int l_ = (int)__builtin_amdgcn_mbcnt_hi(~0u, __builtin_amdgcn_mbcnt_lo(~0u, (unsigned)z_)); asm volatile("" : "+v"(l_)); const int fr = l_ & 15, fq = l_ >> 4; (void)fr_; (void)fq_;
#pragma unroll
        for (int ai = 0; ai < 2; ++ai)
#pragma unroll
            for (int m = 0; m < 4; ++m) {
                const int row = 256 * u.pm + 128 * ai + 64 * wr + 16 * m + fr, b = row >> 13;
#pragma unroll
                for (int bj = 0; bj < 2; ++bj) {
                    if (!((u.mask >> (2 * ai + bj)) & 1)) continue;
                    u32x2 o2[2];
#pragma unroll
                    for (int n = 0; n < 2; ++n) {
                        const int col = 256 * u.pn + 128 * bj + 32 * wc + 16 * n + 4 * fq;
                        const f32x4 g = *(const f32x4*)(g1 + (size_t)b * 6144 + col);
                        f32x4 xo;
                        if constexpr (F32IN) xo = *(const f32x4*)(xold_f + (size_t)row * D + col);
                        else { const u32x2 t2 = *(const u32x2*)(xold_b + (size_t)row * D + col); xo = (f32x4){__uint_as_float(t2.x << 16), __uint_as_float(t2.x & 0xffff0000u), __uint_as_float(t2.y << 16), __uint_as_float(t2.y & 0xffff0000u)}; }
                        const f32x4 xn = xo + g * acc[ai][bj][m][n];
                        o2[n].x = pk2(xn.x, xn.y); o2[n].y = pk2(xn.z, xn.w);
                    }
                    auto sx = __builtin_amdgcn_permlane16_swap(o2[0].x, o2[1].x, false, false);
                    auto sy = __builtin_amdgcn_permlane16_swap(o2[0].y, o2[1].y, false, false);
                    u32x4 o; o.x = sx[0]; o.y = sy[0]; o.z = sx[1]; o.w = sy[1];
                    *(u32x4*)(xnew + (size_t)row * D + 256 * u.pn + 128 * bj + 32 * wc + ((fq & 1) ? 16 + 4 * (fq - 1) : 4 * fq)) = o;
                }
            }
    }
};
struct EpiMoeUp {
    static constexpr bool PERM = false, AFTER_DRAIN = false;
    bf16_t* hid;
    __device__ __forceinline__ void operator()(const f32x4 (&acc)[2][2][4][2], const pg8::Unit& u, int wr, int wc, int fr_, int fq_) const {
        int z_ = 0; asm volatile("" : "+s"(z_)); int l_ = (int)__builtin_amdgcn_mbcnt_hi(~0u, __builtin_amdgcn_mbcnt_lo(~0u, (unsigned)z_)); asm volatile("" : "+v"(l_)); const int fr = l_ & 15, fq = l_ >> 4; (void)fr_; (void)fq_;
#pragma unroll
        for (int ai = 0; ai < 2; ++ai)
#pragma unroll
            for (int m = 0; m < 4; ++m) {
                const int row = 256 * u.pm + 128 * ai + 64 * wr + 16 * m + fr;
                u32x2 ob[2];
#pragma unroll
                for (int bj = 0; bj < 2; ++bj) { const f32x4 g = acc[ai][bj][m][0], up = acc[ai][bj][m][1];
                    ob[bj].x = pk2(g.x * sigm(g.x) * up.x, g.y * sigm(g.y) * up.y); ob[bj].y = pk2(g.z * sigm(g.z) * up.z, g.w * sigm(g.w) * up.w); }
                if (((u.mask >> (2 * ai)) & 3) == 3) {
                    auto sx = __builtin_amdgcn_permlane16_swap(ob[0].x, ob[1].x, false, false);
                    auto sy = __builtin_amdgcn_permlane16_swap(ob[0].y, ob[1].y, false, false);
                    u32x4 o; o.x = sx[0]; o.y = sy[0]; o.z = sx[1]; o.w = sy[1];
                    const int f0 = (fq & 1) ? 16 * (8 * u.pn + 4 + wc) + 4 * (fq - 1) : 16 * (8 * u.pn + wc) + 4 * fq;
                    *(u32x4*)(hid + (size_t)row * 256 + f0) = o;
                } else {
#pragma unroll
                    for (int bj = 0; bj < 2; ++bj) {
                        if (!((u.mask >> (2 * ai + bj)) & 1)) continue;
                        *(u32x2*)(hid + (size_t)row * 256 + 16 * (8 * u.pn + 4 * bj + wc) + 4 * fq) = ob[bj];
                    }
                }
            }
    }
};
struct EpiMoeDown {
    static constexpr bool PERM = false, AFTER_DRAIN = false;
    bf16_t* ys; const int* tile_e; const int* elist; const float* eww;
    __device__ __forceinline__ void operator()(const f32x4 (&acc)[2][2][4][2], const pg8::Unit& u, int wr, int wc, int fr_, int fq_) const {
        int z_ = 0; asm volatile("" : "+s"(z_)); int l_ = (int)__builtin_amdgcn_mbcnt_hi(~0u, __builtin_amdgcn_mbcnt_lo(~0u, (unsigned)z_)); asm volatile("" : "+v"(l_)); const int fr = l_ & 15, fq = l_ >> 4; (void)fr_; (void)fq_;
        const int e = __builtin_amdgcn_readfirstlane(ld_ctl(tile_e + u.pm)), off = __builtin_amdgcn_readfirstlane(ld_ctl(tile_e + TE_TBASE + u.pm)), cnt = __builtin_amdgcn_readfirstlane(ld_ctl(tile_e + TE_TCNT + u.pm));
        int ri[2][4]; float wv[2][4];
#pragma unroll
        for (int ai = 0; ai < 2; ++ai)
#pragma unroll
            for (int m = 0; m < 4; ++m) { const int local = 256 * u.pm + 128 * ai + 64 * wr + 16 * m + fr - off, idx = e * 16384 + (local < cnt ? local : 0); ri[ai][m] = elist[idx]; wv[ai][m] = eww[idx]; }
#pragma unroll
        for (int ai = 0; ai < 2; ++ai)
#pragma unroll
            for (int m = 0; m < 4; ++m) {
                const int local = 256 * u.pm + 128 * ai + 64 * wr + 16 * m + fr - off;
                if (local >= cnt) continue;
                const float w = wv[ai][m];
                bf16_t* dst = ys + ((size_t)(ri[ai][m] & 1) * T + (ri[ai][m] >> 1)) * D;
#pragma unroll
                for (int bj = 0; bj < 2; ++bj) {
                    if (!((u.mask >> (2 * ai + bj)) & 1)) continue;
                    const f32x4 v0 = acc[ai][bj][m][0] * w, v1 = acc[ai][bj][m][1] * w;
                    auto sx = __builtin_amdgcn_permlane16_swap(pk2(v0.x, v0.y), pk2(v1.x, v1.y), false, false);
                    auto sy = __builtin_amdgcn_permlane16_swap(pk2(v0.z, v0.w), pk2(v1.z, v1.w), false, false);
                    u32x4 o; o.x = sx[0]; o.y = sy[0]; o.z = sx[1]; o.w = sy[1];
                    const int col = 256 * u.pn + 128 * bj + 32 * wc + ((fq & 1) ? 16 + 4 * (fq - 1) : 4 * fq);
                    *(u32x4*)(dst + col) = o;
                }
            }
    }
};
template <bool GATHER_>
struct MoeOrderT {
    static constexpr bool GATHER = GATHER_;
    int ntiles, nN, G, c; const int* tile_e; size_t estride; const int* elist;
    __device__ __forceinline__ void arows(const pg8::Unit& u, const int (&RA)[2], int (&o)[2][2]) const {
        const int e = __builtin_amdgcn_readfirstlane(ld_ctl(tile_e + u.pm)), off = __builtin_amdgcn_readfirstlane(ld_ctl(tile_e + TE_TBASE + u.pm)), c = __builtin_amdgcn_readfirstlane(ld_ctl(tile_e + TE_TCNT + u.pm));
        int ri[2][2];
#pragma unroll
        for (int h = 0; h < 2; ++h)
#pragma unroll
            for (int i = 0; i < 2; ++i) { const int local = 256 * u.pm + 128 * h + RA[i] - off; ri[h][i] = elist[e * 16384 + (local < c ? local : 0)]; }
#pragma unroll
        for (int h = 0; h < 2; ++h)
#pragma unroll
            for (int i = 0; i < 2; ++i) { const int local = 256 * u.pm + 128 * h + RA[i] - off; o[h][i] = (local < c) ? (ri[h][i] >> 1) : 0; }
    }
    __device__ __forceinline__ bool next(int i, pg8::Unit& u) const { int L, f, sub; const int U = ntiles * nN;
        if ((G & 7) == 0) { const int x = c & 7, j = c >> 3, nb = G >> 3, U8 = (U + 7) >> 3, lo = x * U8, n = (lo + U8 <= U) ? U8 : (U > lo ? U - lo : 0);
            if (!pg8::tail_split(i, nb, j, n, L, f, sub)) return false; L += lo; }
        else if (!pg8::tail_split(i, G, c, U, L, f, sub)) return false;
        u.pm = L / nN; u.pn = L % nN; u.mask = (f == 1) ? 0xF : (f == 2) ? (sub ? 0xA : 0x5) : (1 << sub); return true; }
    __device__ __forceinline__ void a_ready(const pg8::Unit&) const {}
    __device__ __forceinline__ size_t boff(const pg8::Unit& u) const { return (size_t)__builtin_amdgcn_readfirstlane(ld_ctl(tile_e + u.pm)) * estride; }
    __device__ __forceinline__ void done(const pg8::Unit&) const {}
};
typedef MoeOrderT<false> MoeOrder;
typedef MoeOrderT<true> MoeGatherOrder;

__device__ __forceinline__ float gelu_tanh(float x) { const float u = 0.7978845608028654f * (x + 0.044715f * x * x * x); return 0.5f * x * (1.f + tanhf(u)); }

__device__ __forceinline__ void compress_unit(Frame& F, int layer, int u) {
    const int kvsel = u >> 5, b = (u >> 4) & 1, kvh = (u >> 3) & 1, rt = u & 7, i0 = 64 * rt;
    const bf16_t* src = (const bf16_t*)(F.ws + WS_KV6) + (size_t)kvsel * KV6_STRIDE + (size_t)(b * 2 + kvh) * SEQ * 64;
    const bf16_t* w1t = (const bf16_t*)(F.ws + WS_PHIW) + (size_t)kvsel * 64 * 2048;
    const int lane = F.lane, r = lane & 15, kg = lane >> 4;
    f32x4 acc[4][4];
#pragma unroll
    for (int a = 0; a < 4; ++a)
#pragma unroll
        for (int c = 0; c < 4; ++c) acc[a][c] = (f32x4){0.f, 0.f, 0.f, 0.f};
#pragma unroll 2
    for (int lq = 0; lq < 4; ++lq) {
        const int l = 4 * F.wave + lq;
#pragma unroll
        for (int ks = 0; ks < 2; ++ks) {
            bf16x8 af[4], bfr[4];
#pragma unroll
            for (int mt = 0; mt < 4; ++mt) af[mt] = *(const bf16x8*)(src + ((size_t)(16 * (i0 + 16 * mt + r) + l)) * 64 + 32 * ks + 8 * kg);
#pragma unroll
            for (int nt = 0; nt < 4; ++nt) bfr[nt] = *(const bf16x8*)(w1t + (size_t)(16 * nt + r) * 2048 + l * 64 + 32 * ks + 8 * kg);
#pragma unroll
            for (int mt = 0; mt < 4; ++mt)
#pragma unroll
                for (int nt = 0; nt < 4; ++nt) acc[mt][nt] = MFMA16(af[mt], bfr[nt], acc[mt][nt]);
        }
    }
    LAS float* part = (LAS float*)F.lds;
#pragma unroll
    for (int mt = 0; mt < 4; ++mt)
#pragma unroll
        for (int nt = 0; nt < 4; ++nt)
#pragma unroll
            for (int q = 0; q < 4; ++q) part[(F.wave * 64 + 16 * mt + 4 * kg + q) * 64 + 16 * nt + r] = acc[mt][nt][q];
    __syncthreads();
    const float* phib = (const float*)(F.ws + WS_PHIB) + (layer * 2 + kvsel) * 64;
    float hv[8];
    const int row = F.tid >> 3, e0 = (F.tid & 7) * 8;
#pragma unroll
    for (int k = 0; k < 8; ++k) { float s = phib[e0 + k];
#pragma unroll
        for (int w = 0; w < 8; ++w) s += part[(w * 64 + row) * 64 + e0 + k];
        hv[k] = gelu_tanh(s); }
    __syncthreads();
    LAS float* hb = (LAS float*)F.lds;
    LAS float* ob = (LAS float*)(F.lds + 32768);
#pragma unroll
    for (int k = 0; k < 8; ++k) hb[row * 65 + e0 + k] = hv[k];
    __syncthreads();
    const float* w2 = INF(F, I_PHIW2) + ((size_t)layer * 2 + kvsel) * 64 * 64;
    float o[8];
#pragma unroll
    for (int k = 0; k < 8; ++k) o[k] = 0.f;
#pragma unroll 8
    for (int e = 0; e < 64; ++e) { const float h = hb[row * 65 + e]; const f32x4 wa = *(const f32x4*)(w2 + e * 64 + e0), wb = *(const f32x4*)(w2 + e * 64 + e0 + 4);
        o[0] += h * wa.x; o[1] += h * wa.y; o[2] += h * wa.z; o[3] += h * wa.w; o[4] += h * wb.x; o[5] += h * wb.y; o[6] += h * wb.z; o[7] += h * wb.w; }
#pragma unroll
    for (int k = 0; k < 8; ++k) ob[row * 65 + e0 + k] = o[k];
    __syncthreads();
    const int i = i0 + row;
    bf16_t* dst = (bf16_t*)(F.ws + (kvsel ? WS_VCMP : WS_KCMP)) + ((size_t)(b * 2 + kvh) * 512 + i) * 64 + e0;
    float y[8];
    if (i >= 511) {
#pragma unroll
        for (int k = 0; k < 8; ++k) y[k] = 0.f;
    } else if (kvsel == 0) {
        const size_t pr = (size_t)b * SEQ + 16 * i + 31;
        const float* cs = (const float*)(F.ws + WS_COS) + pr * 32; const float* sn = (const float*)(F.ws + WS_SIN) + pr * 32;
#pragma unroll
        for (int k = 0; k < 8; ++k) { const int d = e0 + k, f = d & 31; const float x1 = ob[row * 65 + f], x2 = ob[row * 65 + f + 32];
            y[k] = (d < 32) ? (x1 * cs[f] - x2 * sn[f]) : (x2 * cs[f] + x1 * sn[f]); }
    } else {
#pragma unroll
        for (int k = 0; k < 8; ++k) y[k] = o[k];
    }
    u32x4 pk; pk.x = pk2(y[0], y[1]); pk.y = pk2(y[2], y[3]); pk.z = pk2(y[4], y[5]); pk.w = pk2(y[6], y[7]);
    *(u32x4*)dst = pk;
    __syncthreads();
}
__device__ __forceinline__ void kmean_task(Frame& F, int wt) {
    const int b = wt >> 7, h = (wt >> 5) & 3, blk = wt & 31, sub = F.lane >> 3, ch = F.lane & 7;
    const bf16_t* mk = (const bf16_t*)(F.ws + WS_MQKV) + MQKV_STRIDE + ((size_t)(b * 4 + h) * SEQ + 256 * blk) * 64;
    float a[8];
#pragma unroll
    for (int k = 0; k < 8; ++k) a[k] = 0.f;
#pragma unroll 8
    for (int it = 0; it < 32; ++it) {
        const u32x4 v = *(const u32x4*)(mk + (size_t)(8 * it + sub) * 64 + 8 * ch);
        a[0] += __uint_as_float(v.x << 16); a[1] += __uint_as_float(v.x & 0xffff0000u); a[2] += __uint_as_float(v.y << 16); a[3] += __uint_as_float(v.y & 0xffff0000u);
        a[4] += __uint_as_float(v.z << 16); a[5] += __uint_as_float(v.z & 0xffff0000u); a[6] += __uint_as_float(v.w << 16); a[7] += __uint_as_float(v.w & 0xffff0000u);
    }
#pragma unroll
    for (int k = 0; k < 8; ++k) { a[k] += shx(a[k], 8, F.lane); a[k] += shx(a[k], 16, F.lane); a[k] += shx(a[k], 32, F.lane); a[k] *= (1.f / 256.f); }
    if (sub == 0) { u32x4 o; o.x = pk2(a[0], a[1]); o.y = pk2(a[2], a[3]); o.z = pk2(a[4], a[5]); o.w = pk2(a[6], a[7]);
        *(u32x4*)((bf16_t*)(F.ws + WS_KMEAN) + ((size_t)(b * 4 + h) * 32 + blk) * 64 + 8 * ch) = o; }
}

constexpr int R1_TASK_OFF = 32768, R1_TASK_BYTES = 12288;
__device__ __forceinline__ unsigned bf_hi(float x) { return __float_as_uint(x) >> 16; }
__device__ __forceinline__ void r1_block(Frame& F, int layer, int bt) {
    const int chain = bt >> 4, b = chain / 6, h = chain % 6, lane0 = F.lane;
    const int chunk = 8 * (bt & 15) + F.wave, task = chain * 128 + chunk;
    LAS float* tb = (LAS float*)(F.lds + R1_TASK_OFF + F.wave * R1_TASK_BYTES);
    LAS float* Lr = tb; LAS float* Lw = tb + 512; LAS float* Lk = tb + 1024; LAS float* Lkk = tb + 1536; LAS float* Lbb = tb + 2048; LAS float* Lv = tb + 2560;
    const bf16_t* rf = (const bf16_t*)(F.ws + WS_RFEAT);
    const float* mu = INF(F, I_MU) + layer * RW;
    float* bonus = (float*)(F.ws + WS_BONUS);
    bf16_t* ytil = (bf16_t*)(F.ws + WS_YT) + (size_t)task * 4096; bf16_t* y0o = (bf16_t*)(F.ws + WS_Y0) + (size_t)task * 4096;
    bf16_t* lora = (bf16_t*)(F.ws + (task < 896 ? (size_t)242 * MiB + (size_t)task * 16384 : task < 1344 ? WS_WIN + (size_t)(task - 896) * 16384 : WS_ROUTE + (size_t)(task - 1344) * 16384));
    {
        const int c31 = lane0 & 31, hi = lane0 >> 5;
        f32x16 aw[2][2], aa[2][2];
#pragma unroll
        for (int mt = 0; mt < 2; ++mt)
#pragma unroll
            for (int nt = 0; nt < 2; ++nt)
#pragma unroll
                for (int r = 0; r < 16; ++r) { aw[mt][nt][r] = 0.f; aa[mt][nt][r] = 0.f; }
        const bf16_t* wt = (const bf16_t*)(F.ws + WS_WUPT) + (size_t)(h * 64) * 64; const bf16_t* at = (const bf16_t*)(F.ws + WS_AUPT) + (size_t)(h * 64) * 64;
#pragma unroll
        for (int ks = 0; ks < 4; ++ks) {
            const int j0 = 16 * ks + 8 * hi;
            bf16x8 fw[2], fa[2], bw[2], ba[2];
#pragma unroll
            for (int nt = 0; nt < 2; ++nt) { bw[nt] = *(const bf16x8*)(wt + (32 * nt + c31) * 64 + j0); ba[nt] = *(const bf16x8*)(at + (32 * nt + c31) * 64 + j0); }
#pragma unroll
            for (int mt = 0; mt < 2; ++mt) {
                const int t = 64 * chunk + 32 * mt + c31; const int rowi = b * SEQ + t;
                const u32x4 cw = *(const u32x4*)(rf + (size_t)rowi * RW + 1152 + j0), ca = *(const u32x4*)(rf + (size_t)rowi * RW + 1216 + j0);
                u32x4 pw = (u32x4){0u, 0u, 0u, 0u}, pa = (u32x4){0u, 0u, 0u, 0u};
                if (t > 0) { pw = *(const u32x4*)(rf + (size_t)(rowi - 1) * RW + 1152 + j0); pa = *(const u32x4*)(rf + (size_t)(rowi - 1) * RW + 1216 + j0); }
                const f32x4 mw0 = *(const f32x4*)(mu + 1152 + j0), mw1 = *(const f32x4*)(mu + 1152 + j0 + 4), ma0 = *(const f32x4*)(mu + 1216 + j0), ma1 = *(const f32x4*)(mu + 1216 + j0 + 4);
                const float mwv[8] = {mw0.x, mw0.y, mw0.z, mw0.w, mw1.x, mw1.y, mw1.z, mw1.w}, mav[8] = {ma0.x, ma0.y, ma0.z, ma0.w, ma1.x, ma1.y, ma1.z, ma1.w};
                const unsigned cwv[4] = {cw.x, cw.y, cw.z, cw.w}, pwv[4] = {pw.x, pw.y, pw.z, pw.w}, cav[4] = {ca.x, ca.y, ca.z, ca.w}, pav[4] = {pa.x, pa.y, pa.z, pa.w};
                float xw[8], xa[8];
#pragma unroll
                for (int k = 0; k < 4; ++k) {
                    const float c0 = __uint_as_float(cwv[k] << 16), c1 = __uint_as_float(cwv[k] & 0xffff0000u), p0 = __uint_as_float(pwv[k] << 16), p1 = __uint_as_float(pwv[k] & 0xffff0000u);
                    xw[2 * k] = tanh_fast(c0 + (p0 - c0) * mwv[2 * k]); xw[2 * k + 1] = tanh_fast(c1 + (p1 - c1) * mwv[2 * k + 1]);
                    const float d0 = __uint_as_float(cav[k] << 16), d1 = __uint_as_float(cav[k] & 0xffff0000u), q0 = __uint_as_float(pav[k] << 16), q1 = __uint_as_float(pav[k] & 0xffff0000u);
                    xa[2 * k] = d0 + (q0 - d0) * mav[2 * k]; xa[2 * k + 1] = d1 + (q1 - d1) * mav[2 * k + 1];
                }
                u32x4 uw, ua; uw.x = pk2(xw[0], xw[1]); uw.y = pk2(xw[2], xw[3]); uw.z = pk2(xw[4], xw[5]); uw.w = pk2(xw[6], xw[7]);
                ua.x = pk2(xa[0], xa[1]); ua.y = pk2(xa[2], xa[3]); ua.z = pk2(xa[4], xa[5]); ua.w = pk2(xa[6], xa[7]);
                fw[mt] = __builtin_bit_cast(bf16x8, uw); fa[mt] = __builtin_bit_cast(bf16x8, ua);
            }
#pragma unroll
            for (int mt = 0; mt < 2; ++mt)
#pragma unroll
                for (int nt = 0; nt < 2; ++nt) { aw[mt][nt] = MFMA32(fw[mt], bw[nt], aw[mt][nt]); aa[mt][nt] = MFMA32(fa[mt], ba[nt], aa[mt][nt]); }
        }
#pragma unroll
        for (int mt = 0; mt < 2; ++mt)
#pragma unroll
            for (int nt = 0; nt < 2; ++nt)
#pragma unroll
                for (int r = 0; r < 16; ++r) { const int tl = 32 * mt + (r & 3) + 8 * (r >> 2) + 4 * hi;
                    lora[tl * 64 + 32 * nt + c31] = f2bf(aw[mt][nt][r]); lora[4096 + tl * 64 + 32 * nt + c31] = f2bf(aa[mt][nt][r]); }
        asm volatile("s_waitcnt vmcnt(0)" ::: "memory");
    }
    float Wrun = 1.f;
    f32x16 XP[2][2], XZ[2][2];
    { const int c31 = lane0 & 31, hi = lane0 >> 5;
#pragma unroll
      for (int mt = 0; mt < 2; ++mt)
#pragma unroll
          for (int nt = 0; nt < 2; ++nt)
#pragma unroll
              for (int r = 0; r < 16; ++r) { XP[mt][nt][r] = (32 * mt + (r & 3) + 8 * (r >> 2) + 4 * hi == 32 * nt + c31) ? 1.f : 0.f; XZ[mt][nt][r] = 0.f; } }
#pragma unroll 1
    for (int sub = 0; sub < 8; ++sub) {
        int lane = lane0, hc = h * 64 + lane0; asm volatile("" : "+v"(lane), "+v"(hc));
#pragma unroll 1
        for (int half = 0; half < 2; ++half) {
            float rs4[4], ks4[4], vs4[4], aw4[4], aa4[4];
            const float mu_r = mu[hc], mu_k = mu[384 + hc], mu_v = mu[768 + hc];
            const float w0 = INF(F, I_W0)[layer * 384 + hc], a0 = INF(F, I_A0)[layer * 384 + hc];
#pragma unroll
            for (int q = 0; q < 4; ++q) {
                const int tl = 8 * sub + 4 * half + q, t = 64 * chunk + tl; const int rowi = b * SEQ + t;
                const bf16_t* cur = rf + (size_t)rowi * RW; const bf16_t* prv = cur - RW; const bool hp = t > 0;
                const float rc = bf2f(cur[hc]), kc = bf2f(cur[384 + hc]), vc = bf2f(cur[768 + hc]);
                const float rp = hp ? bf2f(prv[hc]) : 0.f, kp = hp ? bf2f(prv[384 + hc]) : 0.f, vp = hp ? bf2f(prv[768 + hc]) : 0.f;
                rs4[q] = rc + (rp - rc) * mu_r; ks4[q] = kc + (kp - kc) * mu_k; vs4[q] = vc + (vp - vc) * mu_v;
                aw4[q] = w0 + bf2f(lora[tl * 64 + lane]); aa4[q] = a0 + bf2f(lora[4096 + tl * 64 + lane]);
            }
            const float k_k = INF(F, I_KK)[layer * 384 + hc], k_a = INF(F, I_KA)[layer * 384 + hc], r_k = INF(F, I_RK)[layer * 384 + hc];
#pragma unroll
            for (int q = 0; q < 4; ++q) {
                const int tt = 4 * half + q; const int rowi = b * SEQ + 64 * chunk + 8 * sub + tt;
                const float dec = __expf(-0.606531f * sigm(aw4[q])), a = sigm(aa4[q]);
                float kk = ks4[q] * k_k; const float n2 = wave_sum(kk * kk, lane); kk = kk * __builtin_amdgcn_rsqf(fmaxf(n2, 1e-24f));
                const float km = ks4[q] * (1.f + (a - 1.f) * k_a);
                const float bn = wave_sum(rs4[q] * km * r_k, lane);
                const float Wprev = Wrun; Wrun *= dec; const float iW = __builtin_amdgcn_rcpf(Wrun);
                Lr[tt * 64 + lane] = rs4[q] * Wrun; Lk[tt * 64 + lane] = km * iW; Lkk[tt * 64 + lane] = -(kk * Wprev); Lbb[tt * 64 + lane] = kk * a * iW; Lv[tt * 64 + lane] = vs4[q];
                if (lane == 0) bonus[(size_t)rowi * 8 + h] = bn;
            }
        }
        LDS_WAIT(); asm volatile("" ::: "memory");
        const int c31 = lane & 31, hi = lane >> 5;
#pragma unroll 1
        for (int tt = 0; tt < 8; ++tt) {
            f32x4 k4[2][4], r4[2][4];
#pragma unroll
            for (int mt = 0; mt < 2; ++mt)
#pragma unroll
                for (int rq = 0; rq < 4; ++rq) { const int c0 = tt * 64 + 32 * mt + 8 * rq + 4 * hi;
                    k4[mt][rq] = *(const LAS f32x4*)(Lkk + c0); r4[mt][rq] = *(const LAS f32x4*)(Lr + c0); }
            float saP[2], saZ[2];
#pragma unroll
            for (int nt = 0; nt < 2; ++nt) { f32x2_t p2 = {0.f, 0.f}, z2 = {0.f, 0.f};
#pragma unroll
                for (int mt = 0; mt < 2; ++mt)
#pragma unroll
                    for (int r = 0; r < 16; r += 2) { const f32x2_t kk2 = {k4[mt][r >> 2][r & 3], k4[mt][r >> 2][(r & 3) + 1]};
                        const f32x2_t xp2 = {XP[mt][nt][r], XP[mt][nt][r + 1]}, xz2 = {XZ[mt][nt][r], XZ[mt][nt][r + 1]};
                        p2 = __builtin_elementwise_fma(xp2, kk2, p2); z2 = __builtin_elementwise_fma(xz2, kk2, z2); }
                float p = p2.x + p2.y, z = z2.x + z2.y;
                p = half_sum32(p); z = half_sum32(z); saP[nt] = p; saZ[nt] = z; }
            bf16x8 af[2], bP[2], bZ[2];
#pragma unroll
            for (int mt = 0; mt < 2; ++mt) { const float bbv = Lbb[tt * 64 + 32 * mt + c31], kv = Lk[tt * 64 + 32 * mt + c31];
                const unsigned bh = bf_hi(bbv), kh = bf_hi(kv); const unsigned bl = bf_hi(bbv - __uint_as_float(bh << 16)), kl = bf_hi(kv - __uint_as_float(kh << 16));
                u32x4 u; u.x = bh | (bl << 16); u.y = bh | (kh << 16); u.z = kl | (kh << 16); u.w = 0u;
                if (hi) u = (u32x4){0u, 0u, 0u, 0u};
                af[mt] = __builtin_bit_cast(bf16x8, u); }
#pragma unroll
            for (int nt = 0; nt < 2; ++nt) { const float vv = Lv[tt * 64 + 32 * nt + c31];
                const unsigned ph = bf_hi(saP[nt]), zh = bf_hi(saZ[nt]), vh = bf_hi(vv);
                const unsigned pl = bf_hi(saP[nt] - __uint_as_float(ph << 16)), zl = bf_hi(saZ[nt] - __uint_as_float(zh << 16)), vl = bf_hi(vv - __uint_as_float(vh << 16));
                u32x4 up, uz; up.x = ph | (ph << 16); up.y = pl; up.z = 0u; up.w = 0u;
                uz.x = zh | (zh << 16); uz.y = zl | (vh << 16); uz.z = vh | (vl << 16); uz.w = 0u;
                if (hi) { up = (u32x4){0u, 0u, 0u, 0u}; uz = (u32x4){0u, 0u, 0u, 0u}; }
                bP[nt] = __builtin_bit_cast(bf16x8, up); bZ[nt] = __builtin_bit_cast(bf16x8, uz); }
#pragma unroll
            for (int mt = 0; mt < 2; ++mt)
#pragma unroll
                for (int nt = 0; nt < 2; ++nt) { XP[mt][nt] = MFMA32(af[mt], bP[nt], XP[mt][nt]); XZ[mt][nt] = MFMA32(af[mt], bZ[nt], XZ[mt][nt]); }
#pragma unroll
            for (int nt = 0; nt < 2; ++nt) { f32x2_t p2 = {0.f, 0.f}, z2 = {0.f, 0.f};
#pragma unroll
                for (int mt = 0; mt < 2; ++mt)
#pragma unroll
                    for (int r = 0; r < 16; r += 2) { const f32x2_t rr2 = {r4[mt][r >> 2][r & 3], r4[mt][r >> 2][(r & 3) + 1]};
                        const f32x2_t xp2 = {XP[mt][nt][r], XP[mt][nt][r + 1]}, xz2 = {XZ[mt][nt][r], XZ[mt][nt][r + 1]};
                        p2 = __builtin_elementwise_fma(xp2, rr2, p2); z2 = __builtin_elementwise_fma(xz2, rr2, z2); }
                float p = p2.x + p2.y, z = z2.x + z2.y;
                p = half_sum32(p); z = half_sum32(z);
                if (hi == 0) { ytil[(8 * sub + tt) * 64 + 32 * nt + c31] = f2bf(p); y0o[(8 * sub + tt) * 64 + 32 * nt + c31] = f2bf(z); } }
        }
    }
    int lane_e = lane0; asm volatile("" : "+v"(lane_e));
    Lw[lane_e] = Wrun; LDS_WAIT(); asm volatile("" ::: "memory");
    { const int hi_ = lane_e >> 5;
#pragma unroll
      for (int mt = 0; mt < 2; ++mt)
#pragma unroll
          for (int rq = 0; rq < 4; ++rq) { const f32x4 wl = *(const LAS f32x4*)(Lw + 32 * mt + 8 * rq + 4 * hi_);
#pragma unroll
              for (int nt = 0; nt < 2; ++nt)
#pragma unroll
                  for (int k = 0; k < 4; ++k) { XP[mt][nt][4 * rq + k] *= wl[k]; XZ[mt][nt][4 * rq + k] *= wl[k]; } } }
    { const int c31 = lane_e & 31, hi = lane_e >> 5;
      bf16_t* PT = (bf16_t*)(F.ws + WS_PT) + (size_t)task * 4096;
      bf16_t* ZP = (bf16_t*)(F.ws + WS_ZS) + (size_t)task * 4096;
#pragma unroll
      for (int mt = 0; mt < 2; ++mt)
#pragma unroll
          for (int nt = 0; nt < 2; ++nt) {
#pragma unroll
              for (int r = 0; r < 16; ++r) PT[(32 * mt + (r & 3) + 8 * (r >> 2) + 4 * hi) * 64 + 32 * nt + c31] = f2bf(XP[mt][nt][r]);
              u32x4 a, c2; a.x = pk2(XZ[mt][nt][0], XZ[mt][nt][1]); a.y = pk2(XZ[mt][nt][2], XZ[mt][nt][3]); a.z = pk2(XZ[mt][nt][4], XZ[mt][nt][5]); a.w = pk2(XZ[mt][nt][6], XZ[mt][nt][7]);
              c2.x = pk2(XZ[mt][nt][8], XZ[mt][nt][9]); c2.y = pk2(XZ[mt][nt][10], XZ[mt][nt][11]); c2.z = pk2(XZ[mt][nt][12], XZ[mt][nt][13]); c2.w = pk2(XZ[mt][nt][14], XZ[mt][nt][15]);
              *(u32x4*)(ZP + ((mt * 2 + nt) * 64 + lane_e) * 16) = a; *(u32x4*)(ZP + ((mt * 2 + nt) * 64 + lane_e) * 16 + 8) = c2; } }
    __syncthreads();
}
constexpr int CW_PREP = 768;
constexpr int CW_R1DONE = 896;
__device__ __forceinline__ void publish_count(Frame& F, unsigned* word) {
    asm volatile("s_waitcnt vmcnt(0)" ::: "memory"); __syncthreads();
    if (F.tid == 0) { __builtin_amdgcn_fence(__ATOMIC_RELEASE, "agent"); asm volatile("s_waitcnt vmcnt(0)" ::: "memory"); (void)__hip_atomic_fetch_add(word, 1u, RLX_AGENT); }
}
__device__ __forceinline__ void await_count(Frame& F, unsigned* word, unsigned want) {
    if (F.tid == 0) { unsigned sp = 0; while ((unsigned)__builtin_amdgcn_readfirstlane(__hip_atomic_load(word, RLX_AGENT)) < want) { __builtin_amdgcn_s_sleep(4); if (++sp > (1u << 24)) break; }
        __builtin_amdgcn_fence(__ATOMIC_ACQUIRE, "agent"); asm volatile("s_waitcnt vmcnt(0)" ::: "memory"); }
    __syncthreads();
}
__device__ __forceinline__ void phase_c(Frame& F, int layer) {
    if (F.bid < 192) r1_block(F, layer, F.bid);
    else { compress_unit(F, layer, F.bid - 192); LAUNDER(F); if (F.bid < 224) kmean_task(F, (F.bid - 192) * 8 + F.wave); }
    LAUNDER(F);
    publish_count(F, F.ctl + ((F.bid < 192) ? CW_R1DONE + 64 * layer + (F.bid >> 4) : CW_PREP + 64 * layer));
}

constexpr int KP = 72;
constexpr int TILE_B = 64 * KP * 2;
constexpr int AT_K0 = 0, AT_V0 = 2 * TILE_B;
constexpr int AT_IMP = 4 * TILE_B;
constexpr int AT_MISC = AT_IMP + 8 * 8192;
constexpr int AT_KMEAN = AT_MISC + 256;
constexpr int R2_SBUF = 0;

__device__ __forceinline__ bf16x8 lds_frag(const LAS bf16_t* tile, int row, int col) { return *(const LAS bf16x8*)(tile + row * KP + col); }
__device__ __forceinline__ s16x4 lds_tr(const LAS bf16_t* p) { return __builtin_bit_cast(s16x4, __builtin_amdgcn_ds_read_tr16_b64_v4i16((LAS v4i16_t*)p)); }
__device__ __forceinline__ bf16x8 cat8(s16x4 a, s16x4 b) { bf16x8 r; r[0] = a[0]; r[1] = a[1]; r[2] = a[2]; r[3] = a[3]; r[4] = b[0]; r[5] = b[1]; r[6] = b[2]; r[7] = b[3]; return r; }
__device__ __forceinline__ bf16x8 pack8(const f32x4& a, const f32x4& b) { u32x4 u; u.x = pk2(a.x, a.y); u.y = pk2(a.z, a.w); u.z = pk2(b.x, b.y); u.w = pk2(b.z, b.w); return __builtin_bit_cast(bf16x8, u); }

template <int NH>
__device__ __forceinline__ void qk_tile(const LAS bf16_t* Kt, const bf16x8 (&qf)[NH][2], f32x4 (&st)[NH][4], const float (&cm)[NH], int lane, const bool (&keep)[NH]) {
    const int r = lane & 15, kg = lane >> 4;
    f32x4 ci[NH];
#pragma unroll
    for (int g = 0; g < NH; ++g) { const float c = keep[g] ? cm[g] : -INFINITY; ci[g] = (f32x4){c, c, c, c}; }
#pragma unroll
    for (int kt = 0; kt < 4; ++kt) {
        const bf16x8 k0 = lds_frag(Kt, 16 * kt + r, 8 * kg), k1 = lds_frag(Kt, 16 * kt + r, 32 + 8 * kg);
#pragma unroll
        for (int g = 0; g < NH; ++g) { f32x4 z = MFMA16(k0, qf[g][0], ci[g]); st[g][kt] = MFMA16(k1, qf[g][1], z); }
    }
}
template <int NH, bool DO_V>
__device__ __forceinline__ void pv_tile(const LAS bf16_t* Vt, const f32x4 (&p)[NH][4], f32x4 (&o)[NH][4], f32x4 (&lacc)[NH], int lane) {
    const int kg = lane >> 4, rr = (lane & 15) >> 2, cc = 4 * (lane & 3);
    const u32x4 one4 = (u32x4){0x3f803f80u, 0x3f803f80u, 0x3f803f80u, 0x3f803f80u};
    const bf16x8 ones = __builtin_bit_cast(bf16x8, one4);
#pragma unroll
    for (int i = 0; i < 2; ++i) {
        bf16x8 pf[NH];
#pragma unroll
        for (int g = 0; g < NH; ++g) { pf[g] = pack8(p[g][2 * i], p[g][2 * i + 1]); lacc[g] = MFMA16(ones, pf[g], lacc[g]); }
        if (DO_V) {
#pragma unroll
            for (int dt = 0; dt < 4; ++dt) {
                const s16x4 lo = lds_tr(Vt + (32 * i + 4 * kg + rr) * KP + 16 * dt + cc), hi = lds_tr(Vt + (32 * i + 16 + 4 * kg + rr) * KP + 16 * dt + cc);
                const bf16x8 vf = cat8(lo, hi);
#pragma unroll
                for (int g = 0; g < NH; ++g) o[g][dt] = MFMA16(vf, pf[g], o[g][dt]);
            }
        }
    }
}
__device__ __forceinline__ void softmax_tile(f32x4 (&st)[4], f32x4 (&o)[4], f32x4& lacc, float& mref, int lane) {
    float mx = -INFINITY;
#pragma unroll
    for (int kt = 0; kt < 4; ++kt) mx = fmaxf(fmaxf(mx, fmaxf(st[kt].x, st[kt].y)), fmaxf(st[kt].z, st[kt].w));
    mx = fmaxf(mx, shx(mx, 16, lane)); mx = fmaxf(mx, shx(mx, 32, lane));
    const bool fresh = (mref == -INFINITY);
    if (__any((fresh && mx > -INFINITY) || mx > 8.0f)) {
        const float d = fresh ? ((mx == -INFINITY) ? 0.f : mx) : fmaxf(mx, 0.f);
        const float alpha = fresh ? 1.f : __builtin_amdgcn_exp2f(-d);
        mref = fresh ? mx : mref + d;
        lacc = lacc * alpha;
#pragma unroll
        for (int dt = 0; dt < 4; ++dt) o[dt] = o[dt] * alpha;
#pragma unroll
        for (int kt = 0; kt < 4; ++kt) st[kt] = st[kt] - d;
    }
#pragma unroll
    for (int kt = 0; kt < 4; ++kt) {
        st[kt].x = __builtin_amdgcn_exp2f(st[kt].x); st[kt].y = __builtin_amdgcn_exp2f(st[kt].y);
        st[kt].z = __builtin_amdgcn_exp2f(st[kt].z); st[kt].w = __builtin_amdgcn_exp2f(st[kt].w);
    }
}
#define MX2(a, b) __builtin_elementwise_maximum((float)(a), (float)(b))
#define MX3(a, b, c) MX2(MX2(a, b), c)
template <int NH>
__device__ __forceinline__ void softmax_tiles(f32x4 (&st)[NH][4], f32x4 (&o)[NH][4], f32x4 (&lacc)[NH], float (&mref)[NH], float (&cm)[NH], int lane) {
    float mx[NH];
#pragma unroll
    for (int g = 0; g < NH; ++g) {
        float a = MX3(st[g][0].x, st[g][0].y, st[g][0].z), c = MX3(st[g][2].x, st[g][2].y, st[g][2].z);
        a = MX3(a, st[g][0].w, st[g][1].x); c = MX3(c, st[g][2].w, st[g][3].x);
        a = MX3(a, st[g][1].y, st[g][1].z); c = MX3(c, st[g][3].y, st[g][3].z);
        mx[g] = MX3(MX3(a, st[g][1].w, st[g][3].w), c, c); }
#pragma unroll
    for (int g = 0; g < NH; ++g)
#pragma unroll
        for (int kt = 0; kt < 4; ++kt) {
            st[g][kt].x = __builtin_amdgcn_exp2f(st[g][kt].x); st[g][kt].y = __builtin_amdgcn_exp2f(st[g][kt].y);
            st[g][kt].z = __builtin_amdgcn_exp2f(st[g][kt].z); st[g][kt].w = __builtin_amdgcn_exp2f(st[g][kt].w);
        }
#pragma unroll
    for (int g = 0; g < NH; ++g) { const unsigned u = __float_as_uint(mx[g]); auto a = __builtin_amdgcn_permlane16_swap(u, u, false, false); mx[g] = MX2(__uint_as_float(a[0]), __uint_as_float(a[1])); }
#pragma unroll
    for (int g = 0; g < NH; ++g) { const unsigned u = __float_as_uint(mx[g]); auto a = __builtin_amdgcn_permlane32_swap(u, u, false, false); mx[g] = MX2(__uint_as_float(a[0]), __uint_as_float(a[1])); }
    bool need = false;
#pragma unroll
    for (int g = 0; g < NH; ++g) need = need | (((mref[g] == -INFINITY) & (mx[g] > -INFINITY)) | (mx[g] > 8.0f));
    if (__any(need)) {
#pragma unroll
        for (int g = 0; g < NH; ++g) {
            const bool fresh = (mref[g] == -INFINITY);
            const float d = fresh ? ((mx[g] == -INFINITY) ? 0.f : fmaxf(mx[g], -100.f)) : fmaxf(mx[g], 0.f);
            const float pf = __builtin_amdgcn_exp2f(-d);
            const float alpha = fresh ? 1.f : pf;
            mref[g] = fresh ? ((mx[g] == -INFINITY) ? -INFINITY : d) : mref[g] + d;
            cm[g] = (mref[g] == -INFINITY) ? 0.f : -mref[g];
            lacc[g] = lacc[g] * alpha;
#pragma unroll
            for (int dt = 0; dt < 4; ++dt) o[g][dt] = o[g][dt] * alpha;
#pragma unroll
            for (int kt = 0; kt < 4; ++kt) st[g][kt] = st[g][kt] * pf;
        }
    }
}
__device__ __forceinline__ void acc_pk(u32x2& d, const f32x4& v) {
    const float a = __uint_as_float(d.x << 16) + v.x, b = __uint_as_float(d.x & 0xffff0000u) + v.y, c = __uint_as_float(d.y << 16) + v.z, e = __uint_as_float(d.y & 0xffff0000u) + v.w;
    d.x = pk2(a, b); d.y = pk2(c, e); }
__device__ __forceinline__ u32x4 tile_load(const bf16_t* g, int tid) { const int off = (tid >> 3) * 64 + (tid & 7) * 8; return *(const u32x4*)(g + off); }
__device__ __forceinline__ void tile_store(LAS bf16_t* t, int tid, u32x4 v) { *(LAS u32x4*)(t + (tid >> 3) * KP + (tid & 7) * 8) = v; }

#define LDS_BAR() do { asm volatile("s_waitcnt lgkmcnt(0)" ::: "memory"); __builtin_amdgcn_s_barrier(); asm volatile("" ::: "memory"); } while (0)
__device__ __forceinline__ void nsa_task(Frame& F, int b, int kvh, int J) {
    const int lane = F.lane, tid = F.tid, wv = F.wave, q = lane & 15, kg = lane >> 4;
    const int t0 = 128 * J, tw0 = t0 + 16 * wv, tq_abs = tw0 + q, cur = tw0 >> 6, tq = tq_abs & 63;
    LAS bf16_t* Kb = (LAS bf16_t*)(F.lds + AT_K0); LAS bf16_t* Vb = (LAS bf16_t*)(F.lds + AT_V0);
    LAS float* imp = (LAS float*)(F.lds + AT_IMP + wv * 8192);
    const bf16_t* kvbase = (const bf16_t*)(F.ws + WS_KV6);
    const size_t slab = (size_t)(b * 2 + kvh) * SEQ * 64;
    const bf16_t* Kcmp = (const bf16_t*)(F.ws + WS_KCMP) + (size_t)(b * 2 + kvh) * 512 * 64;
    const bf16_t* Vcmp = (const bf16_t*)(F.ws + WS_VCMP) + (size_t)(b * 2 + kvh) * 512 * 64;
    const bf16_t* Ks = kvbase + 2 * KV6_STRIDE + slab; const bf16_t* Vs = kvbase + 3 * KV6_STRIDE + slab;
    const bf16_t* Kw = kvbase + 4 * KV6_STRIDE + slab; const bf16_t* Vw = kvbase + 5 * KV6_STRIDE + slab;
    bf16x8 qf[3][2];
#pragma unroll
    for (int g = 0; g < 3; ++g) { const bf16_t* qp = (const bf16_t*)(F.ws + WS_NQ) + (((b * 6 + 3 * kvh + g) * SEQ + tq_abs) * 64 + 8 * kg);
        qf[g][0] = *(const bf16x8*)qp; qf[g][1] = *(const bf16x8*)(qp + 32); }
#define NSA_GATEP ((const float*)(F.ws + WS_GATE) + ((b * SEQ + tq_abs) * 32 + 9 * kvh))
    for (int i = lane; i < 2048; i += 64) imp[i] = 0.f;
    const int imax_blk = (t0 + 127 - 31) >> 4;
    const int ntc = (imax_blk >> 6) + 1;
    const int imax_w = (tw0 + 15 >= 31) ? ((tw0 + 15 - 31) >> 4) : -1;
    const int ivis = (tq_abs >= 31) ? ((tq_abs - 31) >> 4) : -1;
    float m[3] = {-INFINITY, -INFINITY, -INFINITY}; float cm[3] = {0.f, 0.f, 0.f};
    f32x4 lacc[3] = {(f32x4){0.f, 0.f, 0.f, 0.f}, (f32x4){0.f, 0.f, 0.f, 0.f}, (f32x4){0.f, 0.f, 0.f, 0.f}};
    f32x4 st[3][4];
    f32x4 ob[3][4];
    const bool keep3[3] = {true, true, true};
#pragma unroll
    for (int g = 0; g < 3; ++g)
#pragma unroll
        for (int dt = 0; dt < 4; ++dt) ob[g][dt] = (f32x4){0.f, 0.f, 0.f, 0.f};
    {
        u32x4 kr = tile_load(Kcmp, tid);
        tile_store(Kb, tid, kr); __syncthreads();
        for (int ct = 0; ct < ntc; ++ct) {
            if (ct + 1 < ntc) kr = tile_load(Kcmp + (ct + 1) * 4096, tid);
            const LAS bf16_t* Kt = Kb + (ct & 1) * (TILE_B / 2);
            if (64 * ct <= imax_w) {
                qk_tile<3>(Kt, qf, st, cm, lane, keep3);
#pragma unroll
                for (int g = 0; g < 3; ++g) {
#pragma unroll
                    for (int kt = 0; kt < 4; ++kt)
#pragma unroll
                        for (int r = 0; r < 4; ++r) { const int i = 64 * ct + 16 * kt + 4 * kg + r; st[g][kt][r] = (i <= ivis) ? st[g][kt][r] : -INFINITY; }
                }
                softmax_tiles<3>(st, ob, lacc, m, cm, lane);
                pv_tile<3, false>(Kt, st, ob, lacc, lane);
            }
            if (ct + 1 < ntc) tile_store(Kb + ((ct + 1) & 1) * (TILE_B / 2), tid, kr);
            LDS_BAR();
        }
    }
    float invl[3]; float msafe[3];
#pragma unroll
    for (int g = 0; g < 3; ++g) { msafe[g] = (m[g] == -INFINITY) ? 0.f : m[g]; invl[g] = 1.f / fmaxf(lacc[g].x, 1e-30f); }
    {
        u32x4 kr = tile_load(Kcmp, tid), vr = tile_load(Vcmp, tid);
        tile_store(Kb, tid, kr); tile_store(Vb, tid, vr); __syncthreads();
        for (int ct = 0; ct < ntc; ++ct) {
            if (ct + 1 < ntc) { kr = tile_load(Kcmp + (ct + 1) * 4096, tid); vr = tile_load(Vcmp + (ct + 1) * 4096, tid); }
            const LAS bf16_t* Kt = Kb + (ct & 1) * (TILE_B / 2); const LAS bf16_t* Vt = Vb + (ct & 1) * (TILE_B / 2);
            if (64 * ct <= imax_w) {
                qk_tile<3>(Kt, qf, st, cm, lane, keep3);
#pragma unroll
                for (int g = 0; g < 3; ++g)
#pragma unroll
                    for (int kt = 0; kt < 4; ++kt)
#pragma unroll
                        for (int r = 0; r < 4; ++r) { const int i = 64 * ct + 16 * kt + 4 * kg + r;
                            st[g][kt][r] = (i <= ivis) ? __builtin_amdgcn_exp2f(st[g][kt][r]) * invl[g] : 0.f; }
#pragma unroll
                for (int kt = 0; kt < 4; ++kt) {
                    float a = 0.f, c = 0.f;
#pragma unroll
                    for (int g = 0; g < 3; ++g) { a += (st[g][kt].x + st[g][kt].y) + st[g][kt].z; c += st[g][kt].w; }
                    c *= 0.5f; a += c;
                    const float recv = __uint_as_float(__builtin_amdgcn_ds_bpermute(((lane + 48) & 63) << 2, __float_as_uint(c)));
                    const int ktp = 4 * ct + kt;
                    imp[ktp * 64 + lane] += a + (kg != 0 ? recv : 0.f);
                    if (kg == 0 && ktp + 1 < 32) imp[(ktp + 1) * 64 + lane] += recv;
                }
                pv_tile<3, true>(Vt, st, ob, lacc, lane);
            }
            if (ct + 1 < ntc) { tile_store(Kb + ((ct + 1) & 1) * (TILE_B / 2), tid, kr); tile_store(Vb + ((ct + 1) & 1) * (TILE_B / 2), tid, vr); }
            LDS_BAR();
        }
    }
#pragma unroll
    for (int g = 0; g < 3; ++g) { const float sc = sigm(NSA_GATEP[3 * g + 0]);
#pragma unroll
        for (int dt = 0; dt < 4; ++dt) ob[g][dt] = ob[g][dt] * sc; }
    unsigned msk[4] = {0u, 0u, 0u, 0u};
    if (cur <= 15) {
        msk[0] = (cur == 31) ? 0xffffffffu : ((1u << (cur + 1)) - 1u);
    } else {
        float iv[32];
#pragma unroll
        for (int k = 0; k < 32; ++k) { const int s = 4 * k + kg; const float v = imp[k * 64 + lane]; iv[k] = (s >= 1 && s <= cur - 2) ? v : -1.f; }
        msk[0] = 1u; msk[cur >> 5] |= 1u << (cur & 31); msk[(cur - 1) >> 5] |= 1u << ((cur - 1) & 31);
        for (int it = 0; it < 13; ++it) {
            float bv = -2.f; int bs = 1 << 20;
#pragma unroll
            for (int k = 0; k < 32; ++k) { if (iv[k] > bv) { bv = iv[k]; bs = 4 * k + kg; } }
#pragma unroll
            for (int sh = 16; sh <= 32; sh <<= 1) { const float ov = shx(bv, sh, lane); const int os = shxi(bs, sh, lane); if (ov > bv || (ov == bv && os < bs)) { bv = ov; bs = os; } }
#pragma unroll
            for (int k = 0; k < 32; ++k) if (4 * k + kg == bs) iv[k] = -1.f;
#pragma unroll
            for (int wd = 0; wd < 4; ++wd) if ((bs >> 5) == wd) msk[wd] |= 1u << (bs & 31);
        }
    }
    LAS u32x2* otp = (LAS u32x2*)imp;
#pragma unroll
    for (int g = 0; g < 3; ++g)
#pragma unroll
        for (int dt = 0; dt < 4; ++dt) { u32x2 o; o.x = pk2(ob[g][dt].x, ob[g][dt].y); o.y = pk2(ob[g][dt].z, ob[g][dt].w); otp[(g * 4 + dt) * 64 + lane] = o; }
    {
#pragma unroll
        for (int g = 0; g < 3; ++g) { m[g] = -INFINITY; cm[g] = 0.f; lacc[g] = (f32x4){0.f, 0.f, 0.f, 0.f};
#pragma unroll
            for (int dt = 0; dt < 4; ++dt) ob[g][dt] = (f32x4){0.f, 0.f, 0.f, 0.f}; }
        const int nb = 2 * J + 2;
        u32x4 kr[2], vr[2]; unsigned mw = 0u;
        kr[0] = tile_load(Ks, tid); vr[0] = tile_load(Vs, tid);
        kr[1] = tile_load(Ks + ((nb > 1) ? 4096 : 0), tid); vr[1] = tile_load(Vs + ((nb > 1) ? 4096 : 0), tid);
        tile_store(Kb, tid, kr[0]); tile_store(Vb, tid, vr[0]); __syncthreads();
        for (int s0 = 0; s0 < nb; s0 += 2) {
#pragma unroll
            for (int u = 0; u < 2; ++u) {
                const int s = s0 + u;
                if (s < nb) {
                    if (s + 2 < nb) { kr[u] = tile_load(Ks + (s + 2) * 4096, tid); vr[u] = tile_load(Vs + (s + 2) * 4096, tid); }
                    const LAS bf16_t* Kt = Kb + (s & 1) * (TILE_B / 2); const LAS bf16_t* Vt = Vb + (s & 1) * (TILE_B / 2);
                    if ((s & 31) == 0) mw = (s == 0) ? msk[0] : (s == 32) ? msk[1] : (s == 64) ? msk[2] : msk[3];
                    const bool sel = ((mw >> (s & 31)) & 1u) != 0u;
                    if (__any(sel)) {
                        const bool selk[3] = {sel, sel, sel};
                        qk_tile<3>(Kt, qf, st, cm, lane, selk);
                        if (s == cur) {
#pragma unroll
                            for (int g = 0; g < 3; ++g)
#pragma unroll
                                for (int kt = 0; kt < 4; ++kt)
#pragma unroll
                                    for (int r = 0; r < 4; ++r) { const int kk = 16 * kt + 4 * kg + r; st[g][kt][r] = (kk <= tq) ? st[g][kt][r] : -INFINITY; }
                        }
                        softmax_tiles<3>(st, ob, lacc, m, cm, lane);
                        pv_tile<3, true>(Vt, st, ob, lacc, lane);
                    }
                    if (s + 1 < nb) { tile_store(Kb + ((s + 1) & 1) * (TILE_B / 2), tid, kr[u ^ 1]); tile_store(Vb + ((s + 1) & 1) * (TILE_B / 2), tid, vr[u ^ 1]); }
                }
                LDS_BAR();
            }
        }
#pragma unroll
        for (int g = 0; g < 3; ++g) { const float sc = sigm(NSA_GATEP[3 * g + 1]) / fmaxf(lacc[g].x, 1e-30f);
#pragma unroll
            for (int dt = 0; dt < 4; ++dt) { u32x2 o = otp[(g * 4 + dt) * 64 + lane]; acc_pk(o, ob[g][dt] * sc); otp[(g * 4 + dt) * 64 + lane] = o; } }
    }
    {
#pragma unroll
        for (int g = 0; g < 3; ++g) { m[g] = -INFINITY; cm[g] = 0.f; lacc[g] = (f32x4){0.f, 0.f, 0.f, 0.f};
#pragma unroll
            for (int dt = 0; dt < 4; ++dt) ob[g][dt] = (f32x4){0.f, 0.f, 0.f, 0.f}; }
        const int s_lo = (2 * J - 8 > 0) ? 2 * J - 8 : 0, s_hi = 2 * J + 1, nb = s_hi - s_lo + 1;
        u32x4 kr[2], vr[2];
        kr[0] = tile_load(Kw + s_lo * 4096, tid); vr[0] = tile_load(Vw + s_lo * 4096, tid);
        kr[1] = tile_load(Kw + (s_lo + ((nb > 1) ? 1 : 0)) * 4096, tid); vr[1] = tile_load(Vw + (s_lo + ((nb > 1) ? 1 : 0)) * 4096, tid);
        tile_store(Kb, tid, kr[0]); tile_store(Vb, tid, vr[0]); __syncthreads();
        for (int it0 = 0; it0 < nb; it0 += 2) {
#pragma unroll
            for (int u = 0; u < 2; ++u) {
                const int it = it0 + u;
                if (it < nb) {
                    const int s = s_lo + it;
                    if (it + 2 < nb) { kr[u] = tile_load(Kw + (s + 2) * 4096, tid); vr[u] = tile_load(Vw + (s + 2) * 4096, tid); }
                    const LAS bf16_t* Kt = Kb + (it & 1) * (TILE_B / 2); const LAS bf16_t* Vt = Vb + (it & 1) * (TILE_B / 2);
                    if (s <= cur && s >= cur - 8) {
                        qk_tile<3>(Kt, qf, st, cm, lane, keep3);
                        if (s == cur || s == cur - 8) {
#pragma unroll
                            for (int g = 0; g < 3; ++g)
#pragma unroll
                                for (int kt = 0; kt < 4; ++kt)
#pragma unroll
                                    for (int r = 0; r < 4; ++r) { const int kk = 16 * kt + 4 * kg + r; const bool ok = (s == cur) ? (kk <= tq) : (kk > tq); st[g][kt][r] = ok ? st[g][kt][r] : -INFINITY; }
                        }
                        softmax_tiles<3>(st, ob, lacc, m, cm, lane);
                        pv_tile<3, true>(Vt, st, ob, lacc, lane);
                    }
                    if (it + 1 < nb) { tile_store(Kb + ((it + 1) & 1) * (TILE_B / 2), tid, kr[u ^ 1]); tile_store(Vb + ((it + 1) & 1) * (TILE_B / 2), tid, vr[u ^ 1]); }
                }
                LDS_BAR();
            }
        }
        bf16_t* mixp = (bf16_t*)(F.ws + WS_HM) + ((b * SEQ + tq_abs) * D + 3 * kvh * 64 + 4 * kg);
#pragma unroll
        for (int g = 0; g < 3; ++g) { const float sc = sigm(NSA_GATEP[3 * g + 2]) / fmaxf(lacc[g].x, 1e-30f);
#pragma unroll
            for (int dt = 0; dt < 4; ++dt) { u32x2 o = otp[(g * 4 + dt) * 64 + lane]; acc_pk(o, ob[g][dt] * sc); *(u32x2*)(mixp + g * 64 + 16 * dt) = o; } }
    }
}

__device__ __forceinline__ void moba_task(Frame& F, int b, int h, int own) {
    const int lane = F.lane, tid = F.tid, wv = F.wave, q = lane & 15, kg = lane >> 4;
    LAS bf16_t* Kb = (LAS bf16_t*)(F.lds + AT_K0); LAS bf16_t* Vb = (LAS bf16_t*)(F.lds + AT_V0); LAS bf16_t* Km = (LAS bf16_t*)(F.lds + AT_KMEAN);
    const size_t slab = (size_t)(b * 4 + h) * SEQ * 64;
    const bf16_t* Qg = (const bf16_t*)(F.ws + WS_MQKV) + slab; const bf16_t* Kg = Qg + MQKV_STRIDE; const bf16_t* Vg = Kg + MQKV_STRIDE;
    const int tw0 = 256 * own + 32 * wv;
    bf16x8 qf[2][2];
#pragma unroll
    for (int rt = 0; rt < 2; ++rt) { const bf16_t* qp = Qg + ((tw0 + 16 * rt + q) * 64 + 8 * kg); qf[rt][0] = *(const bf16x8*)qp; qf[rt][1] = *(const bf16x8*)(qp + 32); }
    if (tid < 256) { const u32x4 v = *(const u32x4*)((const bf16_t*)(F.ws + WS_KMEAN) + (size_t)(b * 4 + h) * 2048 + (tid >> 3) * 64 + (tid & 7) * 8); *(LAS u32x4*)(Km + (tid >> 3) * KP + (tid & 7) * 8) = v; }
    __syncthreads();
    unsigned msk[2] = {0u, 0u};
    {
        f32x4 gs[2][2];
#pragma unroll
        for (int kt = 0; kt < 2; ++kt) { const bf16x8 k0 = lds_frag(Km, 16 * kt + q, 8 * kg), k1 = lds_frag(Km, 16 * kt + q, 32 + 8 * kg);
#pragma unroll
            for (int rt = 0; rt < 2; ++rt) { f32x4 z = (f32x4){0.f, 0.f, 0.f, 0.f}; z = MFMA16(k0, qf[rt][0], z); gs[rt][kt] = MFMA16(k1, qf[rt][1], z); } }
#pragma unroll
        for (int rt = 0; rt < 2; ++rt) {
            float gv[8];
#pragma unroll
            for (int kt = 0; kt < 2; ++kt)
#pragma unroll
                for (int r = 0; r < 4; ++r) { const int blk = 16 * kt + 4 * kg + r; gv[4 * kt + r] = (blk < own) ? gs[rt][kt][r] : -INFINITY; }
            for (int it = 0; it < 3; ++it) {
                float bv = -INFINITY; int bs = 1 << 20;
#pragma unroll
                for (int k = 0; k < 8; ++k) { const int blk = 16 * (k >> 2) + 4 * kg + (k & 3); if (gv[k] > bv) { bv = gv[k]; bs = blk; } }
#pragma unroll
                for (int sh = 16; sh <= 32; sh <<= 1) { const float ov = shx(bv, sh, lane); const int os = shxi(bs, sh, lane); if (ov > bv || (ov == bv && os < bs)) { bv = ov; bs = os; } }
                if (bs < 32) { msk[rt] |= 1u << bs;
#pragma unroll
                    for (int k = 0; k < 8; ++k) if (16 * (k >> 2) + 4 * kg + (k & 3) == bs) gv[k] = -INFINITY; }
            }
        }
    }
    float m[2] = {-INFINITY, -INFINITY}; float cm[2] = {0.f, 0.f}; f32x4 lacc[2] = {(f32x4){0.f, 0.f, 0.f, 0.f}, (f32x4){0.f, 0.f, 0.f, 0.f}};
    f32x4 ob[2][4], st[2][4];
#pragma unroll
    for (int rt = 0; rt < 2; ++rt)
#pragma unroll
        for (int dt = 0; dt < 4; ++dt) ob[rt][dt] = (f32x4){0.f, 0.f, 0.f, 0.f};
    const int ntile = 4 * own + 4;
    u32x4 kr[2], vr[2];
    kr[0] = tile_load(Kg, tid); vr[0] = tile_load(Vg, tid); kr[1] = tile_load(Kg + 4096, tid); vr[1] = tile_load(Vg + 4096, tid);
    tile_store(Kb, tid, kr[0]); tile_store(Vb, tid, vr[0]); __syncthreads();
    for (int tau0 = 0; tau0 < ntile; tau0 += 2) {
#pragma unroll
        for (int u = 0; u < 2; ++u) {
            const int tau = tau0 + u;
            if (tau + 2 < ntile) { kr[u] = tile_load(Kg + (tau + 2) * 4096, tid); vr[u] = tile_load(Vg + (tau + 2) * 4096, tid); }
            const LAS bf16_t* Kt = Kb + (tau & 1) * (TILE_B / 2); const LAS bf16_t* Vt = Vb + (tau & 1) * (TILE_B / 2);
            const int blk = tau >> 2;
            bool sel[2]; bool anyv = false;
#pragma unroll
            for (int rt = 0; rt < 2; ++rt) { sel[rt] = (blk < own) ? ((msk[rt] >> blk) & 1u) : (64 * (tau & 3) <= 32 * wv + 16 * rt + q); anyv = anyv || sel[rt]; }
            if (__any(anyv)) {
                const bool selk[2] = {(blk < own) ? sel[0] : true, (blk < own) ? sel[1] : true};
                qk_tile<2>(Kt, qf, st, cm, lane, selk);
                if (blk >= own) {
#pragma unroll
                    for (int rt = 0; rt < 2; ++rt) {
                        const int trel = 32 * wv + 16 * rt + q;
#pragma unroll
                        for (int kt = 0; kt < 4; ++kt)
#pragma unroll
                            for (int r = 0; r < 4; ++r) { const int kk = 64 * (tau & 3) + 16 * kt + 4 * kg + r; st[rt][kt][r] = (kk <= trel) ? st[rt][kt][r] : -INFINITY; }
                    }
                }
                softmax_tiles<2>(st, ob, lacc, m, cm, lane);
                pv_tile<2, true>(Vt, st, ob, lacc, lane);
            }
            if (tau + 1 < ntile) { tile_store(Kb + ((tau + 1) & 1) * (TILE_B / 2), tid, kr[u ^ 1]); tile_store(Vb + ((tau + 1) & 1) * (TILE_B / 2), tid, vr[u ^ 1]); }
            LDS_BAR();
        }
    }
#pragma unroll
    for (int rt = 0; rt < 2; ++rt) {
        const float sc = 1.f / fmaxf(lacc[rt].x, 1e-30f);
        bf16_t* mix = (bf16_t*)(F.ws + WS_HM) + ((b * SEQ + tw0 + 16 * rt + q) * D + 384 + h * 64 + 4 * kg);
#pragma unroll
        for (int dt = 0; dt < 4; ++dt) { const f32x4 v = ob[rt][dt] * sc; u32x2 o; o.x = pk2(v.x, v.y); o.y = pk2(v.z, v.w); *(u32x2*)(mix + 16 * dt) = o; }
    }
}

constexpr int R2_RING = 16384, R2_SLOT = 12288;
__device__ __forceinline__ void r2_issue(const bf16_t* pt, const bf16_t* zp, LAS unsigned char* slot) {
#pragma unroll
    for (int mt = 0; mt < 2; ++mt)
#pragma unroll
        for (int ks = 0; ks < 4; ++ks) __builtin_amdgcn_global_load_lds((const unsigned*)(pt + mt * 2048 + ks * 16), (LAS unsigned*)(slot + (mt * 4 + ks) * 1024), 16, 0, 0);
#pragma unroll
    for (int mt = 0; mt < 2; ++mt)
#pragma unroll
        for (int q = 0; q < 2; ++q) __builtin_amdgcn_global_load_lds((const unsigned*)(zp + mt * 2048 + q * 8), (LAS unsigned*)(slot + 8192 + (mt * 2 + q) * 1024), 16, 0, 0);
}
__device__ __forceinline__ void r2_wave(Frame& F, int widx) {
    const int chain = widx >> 1, hf = widx & 1, lane = F.lane, c31 = lane & 31, hi = lane >> 5;
    LAS bf16_t* sb = (LAS bf16_t*)(F.lds + R2_SBUF + F.wave * (32 * KP * 2));
    LAS unsigned char* ring = F.lds + R2_RING + F.wave * (4 * R2_SLOT);
    for (int i = lane; i < 32 * KP / 2; i += 64) ((LAS unsigned*)sb)[i] = 0u;
    const bf16_t* PTl = (const bf16_t*)(F.ws + WS_PT) + (size_t)chain * 128 * 4096 + c31 * 64 + 8 * hi;
    const bf16_t* ZPl = (const bf16_t*)(F.ws + WS_ZS) + (size_t)chain * 128 * 4096 + (hf * 64 + lane) * 16;
    bf16_t* SS = (bf16_t*)(F.ws + WS_SS) + (size_t)chain * 128 * 4096 + (32 * hf) * 64;
    r2_issue(PTl, ZPl, ring); r2_issue(PTl + 4096, ZPl + 4096, ring + R2_SLOT); r2_issue(PTl + 2 * 4096, ZPl + 2 * 4096, ring + 2 * R2_SLOT);
#pragma unroll 1
    for (int c = 0; c < 128; ++c) {
        const int cn = (c + 3 < 128) ? c + 3 : 127;
        r2_issue(PTl + cn * 4096, ZPl + cn * 4096, ring + ((c + 3) & 3) * R2_SLOT);
        asm volatile("s_waitcnt vmcnt(36)" ::: "memory");
        const LAS unsigned char* sl = ring + (c & 3) * R2_SLOT + lane * 16;
        f32x16 acc[2];
#pragma unroll
        for (int mt = 0; mt < 2; ++mt)
#pragma unroll
            for (int q = 0; q < 2; ++q) { const u32x4 z = *(const LAS u32x4*)(sl + 8192 + (mt * 2 + q) * 1024);
                acc[mt][8 * q + 0] = __uint_as_float(z.x << 16); acc[mt][8 * q + 1] = __uint_as_float(z.x & 0xffff0000u); acc[mt][8 * q + 2] = __uint_as_float(z.y << 16); acc[mt][8 * q + 3] = __uint_as_float(z.y & 0xffff0000u);
                acc[mt][8 * q + 4] = __uint_as_float(z.z << 16); acc[mt][8 * q + 5] = __uint_as_float(z.z & 0xffff0000u); acc[mt][8 * q + 6] = __uint_as_float(z.w << 16); acc[mt][8 * q + 7] = __uint_as_float(z.w & 0xffff0000u); }
#pragma unroll
        for (int ks = 0; ks < 4; ++ks) {
            const bf16x8 bx = *(const LAS bf16x8*)(sb + c31 * KP + 16 * ks + 8 * hi);
#pragma unroll
            for (int mt = 0; mt < 2; ++mt) { const bf16x8 pa = *(const LAS bf16x8*)(sl + (mt * 4 + ks) * 1024); acc[mt] = MFMA32(pa, bx, acc[mt]); }
        }
#pragma unroll
        for (int mt = 0; mt < 2; ++mt)
#pragma unroll
            for (int r = 0; r < 16; ++r) sb[c31 * KP + 32 * mt + (r & 3) + 8 * (r >> 2) + 4 * hi] = f2bf(acc[mt][r]);
        bf16_t* ss = SS + c * 4096;
#pragma unroll
        for (int j = 0; j < 4; ++j) { const int qd = lane + 64 * j, row = qd >> 3, ch = qd & 7; *(u32x4*)(ss + row * 64 + ch * 8) = *(const LAS u32x4*)(sb + row * KP + ch * 8); }
    }
    asm volatile("s_waitcnt vmcnt(0)" ::: "memory");
}

struct TaskTable { unsigned short v[512]; };
constexpr TaskTable make_tasks() {
    TaskTable t{}; int n = 0, a = 63, am = 0, c = 31, cm = 0;
    while (a >= 0 || c >= 0) {
        const int ca = (a >= 0) ? 96 * a + 1344 : -1, cc = (c >= 0) ? 128 * c + 128 : -1;
        if (ca >= cc) { t.v[n++] = (unsigned short)(0 * 512 + am * 64 + a); if (++am == 4) { am = 0; --a; } }
        else { t.v[n++] = (unsigned short)(1 * 512 + cm * 64 + c); if (++cm == 8) { cm = 0; --c; } }
    }
    return t;
}
__device__ const TaskTable g_tasks = make_tasks();

__device__ __forceinline__ void r3_task(Frame& F, int layer, int task) {
    const int chain = task >> 7, c = task & 127, b = chain / 6, h = chain % 6, lane = F.lane, c31 = lane & 31, hi = lane >> 5;
    const bf16_t* S0 = (const bf16_t*)(F.ws + WS_SS) + (size_t)(task - 1) * 4096;
    const bf16_t* YT = (const bf16_t*)(F.ws + WS_YT) + (size_t)task * 4096;
    const bf16_t* Y0 = (const bf16_t*)(F.ws + WS_Y0) + (size_t)task * 4096;
    const bf16_t* rf = (const bf16_t*)(F.ws + WS_RFEAT);
    const bf16_t* gut = (const bf16_t*)(F.ws + WS_GUPT) + (size_t)(h * 64) * 128;
    const float* mu = INF(F, I_MU) + layer * RW;
    f32x16 acc[2][2], gacc[2][2];
#pragma unroll
    for (int a = 0; a < 2; ++a)
#pragma unroll
        for (int n = 0; n < 2; ++n)
#pragma unroll
            for (int r = 0; r < 16; ++r) { acc[a][n][r] = 0.f; gacc[a][n][r] = 0.f; }
    if (c > 0) {
#pragma unroll
        for (int ks = 0; ks < 4; ++ks) {
            bf16x8 af[2], bfr[2];
#pragma unroll
            for (int mt = 0; mt < 2; ++mt) af[mt] = *(const bf16x8*)(S0 + (32 * mt + c31) * 64 + 16 * ks + 8 * hi);
#pragma unroll
            for (int nt = 0; nt < 2; ++nt) bfr[nt] = *(const bf16x8*)(YT + (32 * nt + c31) * 64 + 16 * ks + 8 * hi);
#pragma unroll
            for (int mt = 0; mt < 2; ++mt)
#pragma unroll
                for (int nt = 0; nt < 2; ++nt) acc[mt][nt] = MFMA32(af[mt], bfr[nt], acc[mt][nt]);
        }
    }
#pragma unroll
    for (int ks = 0; ks < 8; ++ks) {
        bf16x8 af[2], bfr[2];
#pragma unroll
        for (int mt = 0; mt < 2; ++mt) af[mt] = *(const bf16x8*)(gut + (32 * mt + c31) * 128 + 16 * ks + 8 * hi);
#pragma unroll
        for (int nt = 0; nt < 2; ++nt) {
            const int t = 64 * c + 32 * nt + c31, j0 = 16 * ks + 8 * hi; const size_t row = (size_t)b * SEQ + t;
            const u32x4 cu = *(const u32x4*)(rf + row * RW + 1280 + j0);
            u32x4 pv = (u32x4){0u, 0u, 0u, 0u}; if (t > 0) pv = *(const u32x4*)(rf + (row - 1) * RW + 1280 + j0);
            const f32x4 m0 = *(const f32x4*)(mu + 1280 + j0), m1 = *(const f32x4*)(mu + 1280 + j0 + 4);
            float cv[8], pw[8];
            cv[0] = __uint_as_float(cu.x << 16); cv[1] = __uint_as_float(cu.x & 0xffff0000u); cv[2] = __uint_as_float(cu.y << 16); cv[3] = __uint_as_float(cu.y & 0xffff0000u);
            cv[4] = __uint_as_float(cu.z << 16); cv[5] = __uint_as_float(cu.z & 0xffff0000u); cv[6] = __uint_as_float(cu.w << 16); cv[7] = __uint_as_float(cu.w & 0xffff0000u);
            pw[0] = __uint_as_float(pv.x << 16); pw[1] = __uint_as_float(pv.x & 0xffff0000u); pw[2] = __uint_as_float(pv.y << 16); pw[3] = __uint_as_float(pv.y & 0xffff0000u);
            pw[4] = __uint_as_float(pv.z << 16); pw[5] = __uint_as_float(pv.z & 0xffff0000u); pw[6] = __uint_as_float(pv.w << 16); pw[7] = __uint_as_float(pv.w & 0xffff0000u);
            const float mm[8] = {m0.x, m0.y, m0.z, m0.w, m1.x, m1.y, m1.z, m1.w};
            float sg[8];
#pragma unroll
            for (int k = 0; k < 8; ++k) sg[k] = sigm(cv[k] + (pw[k] - cv[k]) * mm[k]);
            u32x4 u; u.x = pk2(sg[0], sg[1]); u.y = pk2(sg[2], sg[3]); u.z = pk2(sg[4], sg[5]); u.w = pk2(sg[6], sg[7]);
            bfr[nt] = __builtin_bit_cast(bf16x8, u);
        }
#pragma unroll
        for (int mt = 0; mt < 2; ++mt)
#pragma unroll
            for (int nt = 0; nt < 2; ++nt) gacc[mt][nt] = MFMA32(af[mt], bfr[nt], gacc[mt][nt]);
    }
    const float* lnw = INF(F, I_LNW) + layer * 384 + h * 64; const float* lnb = INF(F, I_LNB) + layer * 384 + h * 64;
    const float* bonus = (const float*)(F.ws + WS_BONUS);
    bf16_t* mix = (bf16_t*)(F.ws + WS_HM);
#pragma unroll
    for (int nt = 0; nt < 2; ++nt) {
        const int tl = 32 * nt + c31, t = 64 * c + tl; const size_t row = (size_t)b * SEQ + t;
        float s = 0.f;
#pragma unroll
        for (int mt = 0; mt < 2; ++mt)
#pragma unroll
            for (int rq = 0; rq < 4; ++rq) {
                const u32x2 y = *(const u32x2*)(Y0 + tl * 64 + 32 * mt + 8 * rq + 4 * hi);
                acc[mt][nt][4 * rq + 0] += __uint_as_float(y.x << 16); acc[mt][nt][4 * rq + 1] += __uint_as_float(y.x & 0xffff0000u);
                acc[mt][nt][4 * rq + 2] += __uint_as_float(y.y << 16); acc[mt][nt][4 * rq + 3] += __uint_as_float(y.y & 0xffff0000u);
                s += (acc[mt][nt][4 * rq] + acc[mt][nt][4 * rq + 1]) + (acc[mt][nt][4 * rq + 2] + acc[mt][nt][4 * rq + 3]);
            }
        s += shx(s, 32, lane);
        const float mean = s * (1.f / 64.f);
        float vs = 0.f;
#pragma unroll
        for (int mt = 0; mt < 2; ++mt)
#pragma unroll
            for (int r = 0; r < 16; ++r) { const float d = acc[mt][nt][r] - mean; vs += d * d; }
        vs += shx(vs, 32, lane);
        const float rstd = rsqrtf(vs * (1.f / 64.f) + 64e-5f);
        const float bn = bonus[row * 8 + h];
        u32x2 vcs[2][4], vps[2][4];
#pragma unroll
        for (int mt = 0; mt < 2; ++mt)
#pragma unroll
            for (int rq = 0; rq < 4; ++rq) { const int v0 = 32 * mt + 8 * rq + 4 * hi;
                vcs[mt][rq] = *(const u32x2*)(rf + row * RW + 768 + h * 64 + v0);
                vps[mt][rq] = (u32x2){0u, 0u}; if (t > 0) vps[mt][rq] = *(const u32x2*)(rf + (row - 1) * RW + 768 + h * 64 + v0); }
#pragma unroll
        for (int mt = 0; mt < 2; ++mt)
#pragma unroll
            for (int rq = 0; rq < 4; ++rq) {
                const int v0 = 32 * mt + 8 * rq + 4 * hi;
                const u32x2 vc = vcs[mt][rq], vp = vps[mt][rq];
                const f32x4 mv = *(const f32x4*)(mu + 768 + h * 64 + v0), lw = *(const f32x4*)(lnw + v0), lb = *(const f32x4*)(lnb + v0);
                const float vcur[4] = {__uint_as_float(vc.x << 16), __uint_as_float(vc.x & 0xffff0000u), __uint_as_float(vc.y << 16), __uint_as_float(vc.y & 0xffff0000u)};
                const float vprv[4] = {__uint_as_float(vp.x << 16), __uint_as_float(vp.x & 0xffff0000u), __uint_as_float(vp.y << 16), __uint_as_float(vp.y & 0xffff0000u)};
                const float mvv[4] = {mv.x, mv.y, mv.z, mv.w}, lwv[4] = {lw.x, lw.y, lw.z, lw.w}, lbv[4] = {lb.x, lb.y, lb.z, lb.w};
                float o[4];
#pragma unroll
                for (int k = 0; k < 4; ++k) {
                    const float vsh = vcur[k] + (vprv[k] - vcur[k]) * mvv[k];
                    const float y = (acc[mt][nt][4 * rq + k] - mean) * rstd * lwv[k] + lbv[k];
                    o[k] = (y + bn * vsh) * gacc[mt][nt][4 * rq + k];
                }
                u32x2 ov; ov.x = pk2(o[0], o[1]); ov.y = pk2(o[2], o[3]);
                *(u32x2*)(mix + row * D + 640 + h * 64 + v0) = ov;
            }
    }
}
__device__ __forceinline__ void mixnorm_rows(Frame& F, int layer, int m0, int nrows) {
    bf16_t* mix = (bf16_t*)(F.ws + WS_HM);
    const float* gn = INF(F, I_NNSA) + layer * 384; const float* gm = INF(F, I_NMOBA) + layer * 256;
    const int lane = F.lane;
    for (int mb = m0 + F.wave; mb < m0 + nrows; mb += 8 * NWAVES) {
        unsigned a[8][3], c[8][2];
#pragma unroll
        for (int i = 0; i < 8; ++i) { const int m = mb + i * NWAVES; const unsigned* rowp = (const unsigned*)(mix + (size_t)((m < m0 + nrows) ? m : mb) * D);
#pragma unroll
            for (int j = 0; j < 3; ++j) a[i][j] = rowp[lane + 64 * j];
#pragma unroll
            for (int j = 0; j < 2; ++j) c[i][j] = rowp[192 + lane + 64 * j]; }
#pragma unroll
        for (int i = 0; i < 8; ++i) { const int m = mb + i * NWAVES; if (m >= m0 + nrows) break;
            unsigned* rowp = (unsigned*)(mix + (size_t)m * D);
            float sa = 0.f, sc = 0.f;
#pragma unroll
            for (int j = 0; j < 3; ++j) { const float x = __uint_as_float(a[i][j] << 16), y = __uint_as_float(a[i][j] & 0xffff0000u); sa += x * x + y * y; }
#pragma unroll
            for (int j = 0; j < 2; ++j) { const float x = __uint_as_float(c[i][j] << 16), y = __uint_as_float(c[i][j] & 0xffff0000u); sc += x * x + y * y; }
            const float ra = rsqrtf(wave_sum(sa, lane) * (1.f / 384.f) + NORM_EPS), rc = rsqrtf(wave_sum(sc, lane) * (1.f / 256.f) + NORM_EPS);
#pragma unroll
            for (int j = 0; j < 3; ++j) { const int col = 2 * (lane + 64 * j); rowp[lane + 64 * j] = pk2(__uint_as_float(a[i][j] << 16) * ra * gn[col], __uint_as_float(a[i][j] & 0xffff0000u) * ra * gn[col + 1]); }
#pragma unroll
            for (int j = 0; j < 2; ++j) { const int col = 2 * (lane + 64 * j); rowp[192 + lane + 64 * j] = pk2(__uint_as_float(c[i][j] << 16) * rc * gm[col], __uint_as_float(c[i][j] & 0xffff0000u) * rc * gm[col + 1]); }
        }
    }
}
__device__ __forceinline__ void phase_e(Frame& F, int layer) {
    const int gw = F.bid * NWAVES + F.wave, NGW = F.G * NWAVES;
    (void)gw; (void)NGW; (void)layer;
}

constexpr int CW_TILE = 1536;
constexpr int CW_R2DONE = 512;
__device__ __forceinline__ void phase_d(Frame& F, int layer, int rep = 0) {
    if (F.bid < 12 && rep == 0) {
        await_count(F, F.ctl + CW_R1DONE + 64 * layer + F.bid, 16u);
        if (F.wave < 2) { r2_wave(F, F.bid * 2 + F.wave);
            __builtin_amdgcn_fence(__ATOMIC_RELEASE, "agent"); asm volatile("s_waitcnt vmcnt(0)" ::: "memory");
            if (F.lane == 0) (void)__hip_atomic_fetch_add(F.ctl + CW_R2DONE + 64 * layer, 1u, RLX_AGENT); }
        __syncthreads();
#if DBG_MODE == 4
        if (F.bid == 0 && layer == 0) __hip_atomic_store(F.ctl + 3200 + 30, (unsigned)__builtin_amdgcn_s_memrealtime(), RLX_AGENT);
#endif
    }
    LAUNDER(F);
    await_count(F, F.ctl + CW_PREP + 64 * layer, 64u);
    LAUNDER(F);
    volatile LAS int* tw = (volatile LAS int*)(F.lds + AT_MISC);
    unsigned* qh = F.ctl + CW_Q + 64 * layer + 16 * rep;
    const int ntask = (rep == 0) ? 512 + 192 + 128 : 512;
    for (;;) {
        if (F.tid == 0) tw[0] = (int)__hip_atomic_fetch_add(qh, 1u, RLX_AGENT);
        __syncthreads();
        const int k = __builtin_amdgcn_readfirstlane(tw[0]);
        __syncthreads();
        if (k >= ntask) break;
        LAUNDER(F);
        if (k >= 512 + 192) {
            const int tile = k - (512 + 192);
            await_count(F, F.ctl + CW_TILE + 128 * layer + tile, 6u);
            mixnorm_rows(F, layer, tile * 128, 128);
            continue;
        }
        if (k >= 512) {
            if (F.tid == 0) { unsigned sp = 0; while ((unsigned)__builtin_amdgcn_readfirstlane(__hip_atomic_load(F.ctl + CW_R2DONE + 64 * layer, RLX_AGENT)) < 24u) { __builtin_amdgcn_s_sleep(4); if (++sp > (1u << 24)) break; }
                __builtin_amdgcn_fence(__ATOMIC_ACQUIRE, "agent"); asm volatile("s_waitcnt vmcnt(0)" ::: "memory"); }
            __syncthreads();
            r3_task(F, layer, (k - 512) * 8 + F.wave);
            continue;
        }
        const int code = g_tasks.v[k], ty = code >> 9, mm = (code >> 6) & 7, jj = code & 63;
        if (ty == 0) nsa_task(F, mm >> 1, mm & 1, jj); else moba_task(F, mm >> 2, mm & 3, jj);
        if (rep == 0) {
            asm volatile("s_waitcnt vmcnt(0)" ::: "memory"); __syncthreads();
            if (F.tid == 0) { __builtin_amdgcn_fence(__ATOMIC_RELEASE, "agent"); asm volatile("s_waitcnt vmcnt(0)" ::: "memory");
                unsigned* tc = F.ctl + CW_TILE + 128 * layer;
                if (ty == 0) (void)__hip_atomic_fetch_add(tc + (mm >> 1) * 64 + jj, 1u, RLX_AGENT);
                else { (void)__hip_atomic_fetch_add(tc + (mm >> 2) * 64 + 2 * jj, 1u, RLX_AGENT); (void)__hip_atomic_fetch_add(tc + (mm >> 2) * 64 + 2 * jj + 1, 1u, RLX_AGENT); } }
        }
    }
}

__device__ __forceinline__ void phase_g1(Frame& F, int layer) {
    LAS float* wr = (LAS float*)F.lds;
    { const float* W = INF(F, I_WROUTER);
#pragma unroll 1
      for (int i0 = 0; i0 < 4096; i0 += 2048) { f32x4 t4[4];
#pragma unroll
          for (int u = 0; u < 4; ++u) t4[u] = *(const f32x4*)(W + 4 * (i0 + u * NTHR + F.tid));
#pragma unroll
          for (int u = 0; u < 4; ++u) { const int i = 4 * (i0 + u * NTHR + F.tid), k = i >> 4, e = i & 15;
              wr[e * 1028 + k] = t4[u].x; wr[(e + 1) * 1028 + k] = t4[u].y; wr[(e + 2) * 1028 + k] = t4[u].z; wr[(e + 3) * 1028 + k] = t4[u].w; } } }
    __syncthreads();
    const float* mod = (const float*)(F.ws + WS_MOD);
    bf16_t* H = (bf16_t*)(F.ws + WS_HM);
    unsigned* cnt = F.ctl + CW_CNT + 64 * layer;
    const float* rb = INF(F, I_RBIAS);
    const float* gn = INF(F, I_NFFN) + layer * D;
    const int gw = F.bid * NWAVES + F.wave, NGW = F.G * NWAVES;
    const bf16_t* res = (const bf16_t*)(F.ws + WS_RES);
    u32x2 vnext[4];
#pragma unroll
    for (int j = 0; j < 4; ++j) vnext[j] = *(const u32x2*)(res + (size_t)gw * D + 4 * F.lane + 256 * j);
    int px = 0, pm = 0; float pw = 0.f; int ridx = 0;
    for (int m = gw; m < T; m += NGW, ++ridx) {
        int lane = F.lane; asm volatile("" : "+v"(lane));
        const int b = m >> 13;
        const float* sh = mod + ((size_t)layer * BATCH + b) * 6144 + 3072; const float* sc = sh + 1024;
        f32x4 v[4]; float ss = 0.f;
#pragma unroll
        for (int j = 0; j < 4; ++j) { const u32x2 t2 = vnext[j]; v[j] = (f32x4){__uint_as_float(t2.x << 16), __uint_as_float(t2.x & 0xffff0000u), __uint_as_float(t2.y << 16), __uint_as_float(t2.y & 0xffff0000u)};
            ss += (v[j].x * v[j].x + v[j].y * v[j].y) + (v[j].z * v[j].z + v[j].w * v[j].w); }
        const float rstd = rsqrtf(wave_sum(ss, lane) * (1.f / D) + NORM_EPS);
        float lg[16]; f32x2_t lgp[16];
#pragma unroll
        for (int e = 0; e < 16; ++e) lgp[e] = (f32x2_t){0.f, 0.f};
#pragma unroll
        for (int j = 0; j < 4; ++j) { const int col = 4 * lane + 256 * j;
            const f32x4 g = *(const f32x4*)(gn + col), s1 = *(const f32x4*)(sc + col), s0 = *(const f32x4*)(sh + col);
            const float hx = v[j].x * rstd * g.x * (1.f + s1.x) + s0.x, hy = v[j].y * rstd * g.y * (1.f + s1.y) + s0.y, hz = v[j].z * rstd * g.z * (1.f + s1.z) + s0.z, hw = v[j].w * rstd * g.w * (1.f + s1.w) + s0.w;
            u32x2 o; o.x = pk2(hx, hy); o.y = pk2(hz, hw); *(u32x2*)(H + (size_t)m * D + col) = o;
            const f32x2_t h01 = {hx, hy}, h23 = {hz, hw};
#pragma unroll
            for (int e = 0; e < 16; ++e) { const f32x4 w4 = *(const LAS f32x4*)(wr + e * 1028 + col);
                lgp[e] = __builtin_elementwise_fma(h01, (f32x2_t){w4.x, w4.y}, lgp[e]); lgp[e] = __builtin_elementwise_fma(h23, (f32x2_t){w4.z, w4.w}, lgp[e]); }
        }
#pragma unroll
        for (int e = 0; e < 16; ++e) lg[e] = lgp[e].x + lgp[e].y;
        { const int mn = (m + NGW < T) ? m + NGW : m;
#pragma unroll
          for (int j = 0; j < 4; ++j) vnext[j] = *(const u32x2*)(res + (size_t)mn * D + 4 * lane + 256 * j); }
        float r8[8], r4[4], r2[2], r1;
#pragma unroll
        for (int e = 0; e < 8; ++e) { auto sw = __builtin_amdgcn_permlane32_swap(__float_as_uint(lg[e]), __float_as_uint(lg[e + 8]), false, false); r8[e] = __uint_as_float(sw[0]) + __uint_as_float(sw[1]); }
#pragma unroll
        for (int e = 0; e < 4; ++e) { auto sw = __builtin_amdgcn_permlane16_swap(__float_as_uint(r8[e]), __float_as_uint(r8[e + 4]), false, false); r4[e] = __uint_as_float(sw[0]) + __uint_as_float(sw[1]); }
        { const bool up = (lane & 8) != 0;
#pragma unroll
          for (int e = 0; e < 2; ++e) { const float keep = up ? r4[e + 2] : r4[e], send = up ? r4[e] : r4[e + 2]; r2[e] = keep + dpp_mov<0x140>(send); } }
        { const bool up = (lane & 4) != 0; const float keep = up ? r2[1] : r2[0], send = up ? r2[0] : r2[1]; r1 = keep + dpp_mov<0x141>(send); }
        r1 += dpp_mov<0x4E>(r1); r1 += dpp_mov<0xB1>(r1);
        const int el = (((lane >> 5) & 1) << 3) | (((lane >> 4) & 1) << 2) | (((lane >> 3) & 1) << 1) | ((lane >> 2) & 1);
        const float affl = sigm(r1), bial = affl + rb[el];
        float aff[16], bia[16];
#pragma unroll
        for (int e = 0; e < 16; ++e) { const int src = ((e & 8) ? 32 : 0) | ((e & 4) ? 16 : 0) | ((e & 2) ? 8 : 0) | ((e & 1) ? 4 : 0);
            aff[e] = __uint_as_float(__builtin_amdgcn_readlane(__float_as_uint(affl), src)); bia[e] = __uint_as_float(__builtin_amdgcn_readlane(__float_as_uint(bial), src)); }
        int best = 0; float bscore = -INFINITY;
#pragma unroll
        for (int g = 0; g < 4; ++g) {
            float t1 = -INFINITY, t2 = -INFINITY;
#pragma unroll
            for (int k = 0; k < 4; ++k) { const float x = bia[4 * g + k]; if (x > t1) { t2 = t1; t1 = x; } else if (x > t2) t2 = x; }
            const float gs = t1 + t2; if (gs > bscore) { bscore = gs; best = g; }
        }
        float x4[4], a4[4];
#pragma unroll
        for (int k = 0; k < 4; ++k) { x4[k] = (best == 0) ? bia[k] : (best == 1) ? bia[4 + k] : (best == 2) ? bia[8 + k] : bia[12 + k]; a4[k] = (best == 0) ? aff[k] : (best == 1) ? aff[4 + k] : (best == 2) ? aff[8 + k] : aff[12 + k]; }
        int i1 = 0; float v1 = x4[0];
#pragma unroll
        for (int k = 1; k < 4; ++k) if (x4[k] > v1) { v1 = x4[k]; i1 = k; }
        int i2 = -1; float v2 = -INFINITY;
#pragma unroll
        for (int k = 0; k < 4; ++k) if (k != i1 && x4[k] > v2) { v2 = x4[k]; i2 = k; }
        float w1 = 0.f, w2 = 0.f;
#pragma unroll
        for (int k = 0; k < 4; ++k) { if (k == i1) w1 = a4[k]; if (k == i2) w2 = a4[k]; }
        const float ws = w1 + w2; w1 /= ws; w2 /= ws;
        if (lane == 2 * ridx) { px = 4 * best + i1; pm = m; pw = w1; }
        if (lane == 2 * ridx + 1) { px = 4 * best + i2; pm = m; pw = w2; }
    }
    LAUNDER(F);
    {
        const int lane = F.lane; const int np = 2 * ridx;
        int rank = 0, total = 0, leader = 64;
        for (int j = 0; j < np; ++j) { const int xj = __builtin_amdgcn_readlane(px, j); const bool same = (xj == px); rank += (same && j < lane) ? 1 : 0; total += same ? 1 : 0; leader = (same && j < leader) ? j : leader; }
        int base = 0;
        if (lane < np && rank == 0) base = (int)__hip_atomic_fetch_add(cnt + px, (unsigned)total, RLX_AGENT);
        base = __builtin_amdgcn_ds_bpermute((leader & 63) << 2, base);
        if (lane < np) { const int idx = px * 16384 + base + rank; ((int*)(F.ws + WS_ELIST))[idx] = 2 * pm + (lane & 1); ((float*)(F.ws + WS_EWW))[idx] = pw; }
    }
    asm volatile("s_waitcnt vmcnt(0)" ::: "memory"); __syncthreads();
    if (F.wave == 0) {
        unsigned tk = 0;
        if (F.lane == 0) { __builtin_amdgcn_fence(__ATOMIC_RELEASE, "agent"); asm volatile("s_waitcnt vmcnt(0)" ::: "memory"); tk = __hip_atomic_fetch_add(cnt + 32, 1u, RLX_AGENT); }
        tk = (unsigned)__builtin_amdgcn_readfirstlane((int)tk);
        if (tk == (unsigned)F.G - 1u) {
            __builtin_amdgcn_fence(__ATOMIC_ACQUIRE, "agent");
            const int lane = F.lane;
            int* tile_e = (int*)(F.ws + WS_ROWINFO + layer * ROWINFO_LSTRIDE) + 2 * MAXROWS;
            const int c = (lane < 16) ? (int)__hip_atomic_load(cnt + (lane & 15), RLX_AGENT) : 0, nt = (c + 255) >> 8;
            int ofs = 0, tot = 0;
            for (int e = 0; e < 16; ++e) { const int ne = __builtin_amdgcn_readlane(nt, e) << 8; ofs += (e < lane) ? ne : 0; tot += ne; }
            if (lane < 16) { tile_e[TE_OFF + lane] = ofs; tile_e[TE_CNT + lane] = c; for (int j = 0; j < nt; ++j) { const int t = (ofs >> 8) + j; tile_e[t] = lane; tile_e[TE_TBASE + t] = ofs; tile_e[TE_TCNT + t] = c; } }
            if (lane == 0) tile_e[256] = tot >> 8;
        }
    }
}
__device__ __forceinline__ void phase_g2(Frame& F, int layer) {
    volatile LAS int* off = (volatile LAS int*)F.lds;
    unsigned* cnt = F.ctl + CW_CNT + 64 * layer;
    int* rowinfo = (int*)(F.ws + WS_ROWINFO + layer * ROWINFO_LSTRIDE); float* roww = (float*)(rowinfo + MAXROWS); int* tile_e = rowinfo + 2 * MAXROWS; int* ntl = tile_e + 256;
    if (F.tid == 0) { int o = 0; for (int e = 0; e < 16; ++e) { off[e] = o; const int c = (int)__hip_atomic_load(cnt + e, RLX_AGENT); o += ((c + 255) >> 8) << 8; } off[16] = o; }
    __syncthreads();
    if (F.bid == 0) {
        if (F.tid == 0) ntl[0] = off[16] >> 8;
        for (int e = 0; e < 16; ++e) {
            const int c = (int)__hip_atomic_load(cnt + e, RLX_AGENT), o0 = off[e], o1 = off[e + 1];
            for (int r = o0 + c + F.tid; r < o1; r += NTHR) { rowinfo[r] = -1; roww[r] = 0.f; }
            for (int tl = (o0 >> 8) + F.tid; tl < (o1 >> 8); tl += NTHR) tile_e[tl] = e;
        }
    }
    const int* route = (const int*)(F.ws + WS_ROUTE);
    const int gw = F.bid * NWAVES + F.wave, NGW = F.G * NWAVES, lane = F.lane;
    for (int m = gw; m < T; m += NGW) {
        const int* rp = route + (size_t)m * 8;
        const int e1 = ld_ctl(rp), e2 = ld_ctl(rp + 1), p1 = ld_ctl(rp + 2), p2 = ld_ctl(rp + 3);
        const int r1 = off[e1] + p1, r2 = off[e2] + p2;
        if (lane == 0) { rowinfo[r1] = 2 * m; rowinfo[r2] = 2 * m + 1; roww[r1] = __int_as_float(ld_ctl(rp + 4)); roww[r2] = __int_as_float(ld_ctl(rp + 5)); }
    }
}

#if DBG_MODE == 2
__device__ __forceinline__ void dbg_flag(Frame& F, bool bad, unsigned code) { if (__any(bad) && F.lane == 0) atomicCAS(F.ctl + CW_DBG, 0u, code); }
__device__ __forceinline__ void scan_bf16(Frame& F, size_t off, size_t n, unsigned code) {
    const unsigned* p = (const unsigned*)(F.ws + off); bool bad = false;
    for (size_t i = (size_t)F.bid * NTHR + F.tid; i < n / 2; i += (size_t)F.G * NTHR) { const unsigned u = p[i]; bad = bad || ((u & 0x7f80u) == 0x7f80u) || ((u & 0x7f800000u) == 0x7f800000u); }
    dbg_flag(F, bad, code); }
__device__ __forceinline__ void scan_f32p(Frame& F, const float* p, size_t n, unsigned code) {
    bool bad = false;
    for (size_t i = (size_t)F.bid * NTHR + F.tid; i < n; i += (size_t)F.G * NTHR) { const unsigned u = __float_as_uint(p[i]); bad = bad || ((u & 0x7f800000u) == 0x7f800000u); }
    dbg_flag(F, bad, code); }
__device__ __forceinline__ void dbg_check(Frame& F, int p) {
    const unsigned code = (unsigned)(p + 1);
    if (DBG_SUB >= 4) {
        if (p != DBG_P) return;
        const size_t off = (DBG_SUB == 4) ? WS_ZS : (DBG_SUB == 5) ? WS_PT : (DBG_SUB == 6) ? WS_YT : WS_Y0;
        const unsigned* q = (const unsigned*)(F.ws + off); unsigned mx = 0;
        for (size_t i = (size_t)F.bid * NTHR + F.tid; i < (size_t)1536 * 2048; i += (size_t)F.G * NTHR) { const unsigned u = q[i]; const unsigned e0 = (u >> 7) & 0xffu, e1 = (u >> 23) & 0xffu; mx = mx > e0 ? mx : e0; mx = mx > e1 ? mx : e1; }
#if DBG_CNT
        { unsigned cnt = 0; for (size_t i = (size_t)F.bid * NTHR + F.tid; i < (size_t)1536 * 2048; i += (size_t)F.G * NTHR) { const unsigned u = q[i]; cnt += (((u >> 7) & 0xffu) == 0xffu) + (((u >> 23) & 0xffu) == 0xffu); }
          if (cnt) atomicAdd(F.ctl + CW_DBG, cnt); return; }
#endif
        atomicMax(F.ctl + CW_DBG, mx); return; }
    if (DBG_SUB == 3 && p != 4) return;
    if (p == 0) { scan_f32p(F, (const float*)(F.ws + WS_COS), (size_t)T * 64, code); scan_f32p(F, (const float*)(F.ws + WS_MOD), 2 * 2 * 6144, code); return; }
    if (p > 10 * NL) return;
    const int sub = (p - 1) % 10;
    switch (sub) {
    case 0: scan_bf16(F, WS_HM, (size_t)T * D, code); scan_bf16(F, WS_WIN, (size_t)NPAD * D, code); scan_bf16(F, WS_WOUT, (size_t)D * D, code); scan_bf16(F, WS_WUP, (size_t)16 * 512 * D, code);
            scan_bf16(F, WS_WDN, (size_t)16 * D * 256, code); scan_bf16(F, WS_PHIW, (size_t)2 * 64 * 2048, code); scan_bf16(F, WS_GUPT, 384 * 128, code); scan_f32p(F, (const float*)(F.ws + WS_PHIB), 256, code); break;
    case 1: scan_bf16(F, WS_NQ, (size_t)T * 384, code); scan_bf16(F, WS_KV6, (size_t)6 * T * 128, code); scan_bf16(F, WS_MQKV, (size_t)3 * T * 256, code); scan_bf16(F, WS_RFEAT, (size_t)T * RW, code);
            scan_f32p(F, (const float*)(F.ws + WS_GATE), (size_t)T * 32, code); break;
    case 2: scan_bf16(F, WS_KCMP, 2 * 2 * 512 * 64, code); scan_bf16(F, WS_VCMP, 2 * 2 * 512 * 64, code); scan_bf16(F, WS_KMEAN, 2 * 4 * 32 * 64, code);
            scan_bf16(F, WS_PT, (size_t)1536 * 4096, code); scan_bf16(F, WS_ZS, (size_t)1536 * 4096, code); scan_bf16(F, WS_YT, (size_t)1536 * 4096, code); scan_bf16(F, WS_Y0, (size_t)1536 * 4096, code);
            scan_f32p(F, (const float*)(F.ws + WS_BONUS), (size_t)T * 8, code); break;
    case 3: {
#if DBG_SUB == 3
        if (p == 4) { const unsigned* hm = (const unsigned*)(F.ws + WS_HM); bool b1 = false, b2 = false, b4 = false;
            for (size_t i = (size_t)F.bid * NTHR + F.tid; i < (size_t)T * 512; i += (size_t)F.G * NTHR) { const unsigned u = hm[i]; const int col = (int)(i & 511) * 2; const bool bad = ((u & 0x7f80u) == 0x7f80u) || ((u & 0x7f800000u) == 0x7f800000u);
                if (col < 384) b1 = b1 || bad; else if (col < 640) b2 = b2 || bad; }
            const unsigned* zs = (const unsigned*)(F.ws + WS_ZS);
            for (size_t i = (size_t)F.bid * NTHR + F.tid; i < (size_t)1536 * 2048; i += (size_t)F.G * NTHR) { const unsigned u = zs[i]; b4 = b4 || ((u & 0x7f80u) == 0x7f80u) || ((u & 0x7f800000u) == 0x7f800000u); }
            const unsigned bits = (__any(b1) ? 1u : 0u) | (__any(b2) ? 2u : 0u) | (__any(b4) ? 4u : 0u);
            if (bits && F.lane == 0) atomicOr(F.ctl + CW_DBG, bits); }
#else
        scan_bf16(F, WS_HM, (size_t)T * D, code); scan_bf16(F, WS_ZS, (size_t)1536 * 4096, code);
#endif
        } break;
    case 4: scan_bf16(F, WS_HM, (size_t)T * D, code); break;
    case 5: scan_f32p(F, F.out, (size_t)T * D, code); break;
    case 6: scan_bf16(F, WS_HM, (size_t)T * D, code); break;
    case 7: scan_bf16(F, WS_SORTA, (size_t)MAXROWS * D, code); break;
    case 8: scan_bf16(F, WS_HID, (size_t)MAXROWS * 256, code); break;
    case 9: scan_bf16(F, WS_YS, (size_t)2 * T * D, code); break;
    }
}
#endif
struct Args { const void* in[31]; float* out; unsigned char* ws; int ph_lo, ph_hi; };
constexpr int N_PHASES = 2 + 10 * NL + (DBG_MODE ? 1 : 0);

__global__ void __launch_bounds__(NTHR, 2) hybrid_fwd(Args args) {
    extern __shared__ __attribute__((aligned(16))) unsigned char lds_raw[];
    Frame F;
    F.lds = (LAS unsigned char*)lds_raw;
    F.MISC = (volatile LAS unsigned*)(F.lds + MISC_OFF);
    F.tid = threadIdx.x; F.lane = F.tid & 63; F.wave = __builtin_amdgcn_readfirstlane(F.tid >> 6);
    F.G = gridDim.x; F.bid = blockIdx.x;
    F.ws = (unsigned char*)(GAS unsigned char*)args.ws; F.out = (float*)(GAS float*)args.out; F.ctl = (unsigned*)(GAS unsigned*)(args.ws + WS_CTL);
    for (int u = F.tid; u < (LDS_BYTES - RING_BYTES) / 4; u += NTHR) ((LAS unsigned*)(F.lds + RING_BYTES))[u] = 0u;
    __syncthreads();
    if (F.tid < 31) *(LAS unsigned long long*)(F.lds + IN_OFF + 8 * F.tid) = (unsigned long long)args.in[F.tid];
    __syncthreads();
#if MK_PER_PHASE
#define GRID_BAR() do { } while (0)
#else
    XcdBarrier bar = xcd_barrier_post(F.ctl + CW_BAR, F.MISC + 8);
#define GRID_BAR() do { LAUNDER(F); xcd_barrier(bar, F.tid); } while (0)
#endif
    const int lo = args.ph_lo, hi = args.ph_hi;
    for (int ph_ = lo; ph_ < hi; ++ph_) {
        int ph = ph_; asm volatile("" : "+s"(ph));
#if DBG_MODE == 2
        if (ph > 0) { LAUNDER(F); dbg_check(F, ph - 1); }
#endif
#if DBG_MODE == 4
        if (blockIdx.x == 0) { const unsigned tnow = (unsigned)__builtin_amdgcn_s_memrealtime(); __hip_atomic_store((unsigned*)(args.ws + WS_CTL) + 3200 + ph_, tnow, RLX_AGENT); }
#endif
        for (int rep = 0; rep < ((REPEAT_PH >= 0 && ph_ == REPEAT_PH) ? 2 : 1); ++rep) {
        if (rep) GRID_BAR();
        if (ph == 0) { if (PH_EN(10)) { LAUNDER(F); phase_pro(F); LAUNDER(F); phase_a(F, 0, false, true); } }
#if DBG_MODE
        else if (ph == N_PHASES - 1) { LAUNDER(F);
#if DBG_MODE == 4
            const float dv = 100.f * floorf(4.f * log2f((float)(unsigned)(ld_ctl((const int*)(F.ctl + 3200 + DBG_TPH1)) - ld_ctl((const int*)(F.ctl + 3200 + DBG_TPH0)))) + DBG_QOFF);
            const float dv2 = 10000.f * floorf(4.f * log2f((float)(unsigned)(ld_ctl((const int*)(F.ctl + 3200 + DBG_TPH3)) - ld_ctl((const int*)(F.ctl + 3200 + DBG_TPH2)))) + DBG_QOFF);
            for (int i = F.bid * NTHR + F.tid; i < T * D; i += F.G * NTHR) F.out[i] = (i == 0) ? dv2 : dv;
            if (0)
#else
            const float dv = sqrtf((float)ld_ctl((const int*)(F.ctl + CW_DBG)));
#endif
            for (int i = F.bid * NTHR + F.tid; i < T * D; i += F.G * NTHR) F.out[i] = dv; }
        else if (ph == N_PHASES - 2) { if (PH_EN(11)) { LAUNDER(F); norm_rows(F, 0, true); } }
#else
        else if (ph == N_PHASES - 1) { if (PH_EN(11)) { LAUNDER(F); norm_rows(F, 0, true); } }
#endif
        else {
            const int layer = (ph - 1) / 10, sub = (ph - 1) % 10;
            switch (sub) {
            case 0: if (PH_EN(0)) { LAUNDER(F); phase_a(F, layer, true, layer > 0); } break;
            case 1: if (PH_EN(1)) { LAUNDER(F); pg8::Gemm g{(const bf16_t*)(F.ws + WS_HM), (const bf16_t*)(F.ws + WS_WIN), T, NPAD, D}; pg8::StaticOrder S; S.init(T, NPAD, F.G, F.bid, NPAD / 256 - 1);
                      EpiInProj E{(bf16_t*)(F.ws + WS_NQ), (bf16_t*)(F.ws + WS_KV6), (bf16_t*)(F.ws + WS_MQKV), (bf16_t*)(F.ws + WS_RFEAT), (float*)(F.ws + WS_GATE), (const float*)(F.ws + WS_COS), (const float*)(F.ws + WS_SIN)};
                      if (rep == 0) pg8::gemm_phase<EpiInProj, pg8::StaticOrder, true, true>(F.lds, g, S, E, F.tid);
                      else { EpiNull EN{(float*)(F.ws + WS_GATE)}; pg8::gemm_phase<EpiNull, pg8::StaticOrder, true, true>(F.lds, g, S, EN, F.tid); } } break;
            case 2: if (PH_EN(2)) { LAUNDER(F); phase_c(F, layer); LAUNDER(F); phase_d(F, layer, rep); } break;
            case 3: break;
            case 4: if (PH_EN(4)) { LAUNDER(F); phase_e(F, layer); } break;
            case 5: if (PH_EN(5)) { LAUNDER(F); pg8::Gemm g{(const bf16_t*)(F.ws + WS_HM), (const bf16_t*)(F.ws + WS_WOUT), T, D, D}; pg8::StaticOrder S; S.init(T, D, F.G, F.bid);
                      const float* g1p = (const float*)(F.ws + WS_MOD) + (size_t)layer * BATCH * 6144 + 2048;
                      if (layer == 0) { EpiOutProjT<true> E{INF(F, I_X), (const bf16_t*)F.out, (bf16_t*)(F.ws + WS_RES), g1p}; pg8::gemm_phase<EpiOutProjT<true>, pg8::StaticOrder, true, true>(F.lds, g, S, E, F.tid); }
                      else { EpiOutProjT<false> E{(const float*)nullptr, (const bf16_t*)F.out, (bf16_t*)(F.ws + WS_RES), g1p}; pg8::gemm_phase<EpiOutProjT<false>, pg8::StaticOrder, true, true>(F.lds, g, S, E, F.tid); } } break;
            case 6: if (PH_EN(6)) { LAUNDER(F); phase_g1(F, layer); } break;
            case 7: break;
            case 8: if (PH_EN(8)) { LAUNDER(F); const int* rowinfo = (const int*)(F.ws + WS_ROWINFO + layer * ROWINFO_LSTRIDE); const int* tile_e = rowinfo + 2 * MAXROWS;
                      const int ntl = __builtin_amdgcn_readfirstlane(ld_ctl(tile_e + 256));
                      pg8::Gemm g{(const bf16_t*)(F.ws + WS_HM), (const bf16_t*)(F.ws + WS_WUP), MAXROWS, 512, D};
                      MoeGatherOrder S{ntl, 2, F.G, F.bid, tile_e, (size_t)512 * D * 2, (const int*)(F.ws + WS_ELIST)};
                      EpiMoeUp E{(bf16_t*)(F.ws + WS_HID)};
                      pg8::gemm_phase<EpiMoeUp, MoeGatherOrder, true, true>(F.lds, g, S, E, F.tid); } break;
            case 9: if (PH_EN(9)) { LAUNDER(F); const int* rowinfo = (const int*)(F.ws + WS_ROWINFO + layer * ROWINFO_LSTRIDE); const int* tile_e = rowinfo + 2 * MAXROWS;
                      const int ntl = __builtin_amdgcn_readfirstlane(ld_ctl(tile_e + 256));
                      pg8::Gemm g{(const bf16_t*)(F.ws + WS_HID), (const bf16_t*)(F.ws + WS_WDN), MAXROWS, D, 256};
                      MoeOrder S{ntl, 4, F.G, F.bid, tile_e, (size_t)D * 256 * 2, (const int*)(F.ws + WS_ELIST)};
                      EpiMoeDown E{(bf16_t*)(F.ws + WS_YS), tile_e, (const int*)(F.ws + WS_ELIST), (const float*)(F.ws + WS_EWW)};
                      pg8::gemm_phase<EpiMoeDown, MoeOrder, true, true>(F.lds, g, S, E, F.tid); } break;
            }
        }
        }
#if EXTRA_BAR
        if (ph_ == 0) { for (int eb = 0; eb < EXTRA_BAR; ++eb) GRID_BAR(); }
#endif
        if (ph_ + 1 < hi && !(ph_ >= 1 && ph_ <= 10 * NL && (((ph_ - 1) % 10) == 2 || ((ph_ - 1) % 10) == 3 || ((ph_ - 1) % 10) == 7))) GRID_BAR();
    }
}

extern "C" void kernel_launch(void* const* d_in, const int* in_sizes, int n_in, void* d_out, int out_size, void* d_ws, size_t ws_size, hipStream_t stream) {
    static int grid = 0;
    if (grid == 0) {
        if (n_in != 31 || out_size != T * D || ws_size < WS_END) { fprintf(stderr, "kernel_launch: unexpected shapes: n_in %d out %d ws %zu (need %zu)\n", n_in, out_size, ws_size, (size_t)WS_END); grid = -1; return; }
        int dev = 0, cus = 0, per_cu = 0;
        if (hipGetDevice(&dev) != hipSuccess || hipDeviceGetAttribute(&cus, hipDeviceAttributeMultiprocessorCount, dev) != hipSuccess) { grid = -1; return; }
        if (hipFuncSetAttribute((const void*)hybrid_fwd, hipFuncAttributeMaxDynamicSharedMemorySize, LDS_BYTES) != hipSuccess) { fprintf(stderr, "kernel_launch: hipFuncSetAttribute failed\n"); grid = -1; return; }
        if (hipOccupancyMaxActiveBlocksPerMultiprocessor(&per_cu, (const void*)hybrid_fwd, NTHR, LDS_BYTES) != hipSuccess || per_cu < 1) fprintf(stderr, "kernel_launch: occupancy query says %d\n", per_cu);
        (void)hipGetLastError();
        grid = cus;
    }
    if (grid < 0) return;
    (void)hipMemsetAsync((char*)d_ws + WS_CTL, 0, CTL_ZERO_BYTES, stream);
    Args a{};
    for (int i = 0; i < 31; ++i) a.in[i] = d_in[i];
    a.out = (float*)d_out; a.ws = (unsigned char*)d_ws;
#if MK_PER_PHASE
    for (int ph = 0; ph < N_PHASES; ++ph) { a.ph_lo = ph; a.ph_hi = ph + 1; hipLaunchKernelGGL(hybrid_fwd, dim3(grid), dim3(NTHR), LDS_BYTES, stream, a); }
#else
    a.ph_lo = 0; a.ph_hi = N_PHASES;
    hipLaunchKernelGGL(hybrid_fwd, dim3(grid), dim3(NTHR), LDS_BYTES, stream, a);
#endif
}
```
